# Optimizing an MI355X kernel written in HIP

```python
import math
import jax, jax.numpy as jnp
from jax import lax
import numpy as np

D_MODEL = 1024
BATCH = 32
SEQ = 2048
DEPTH = 1

CTX_LEN = 256
GRID_W = 64
S5_WIDTH = 512
S5_GROUP = 16
S5_GROUPS = S5_WIDTH // S5_GROUP
S5_STATE = 64
RW_WIDTH = D_MODEL - S5_WIDTH
RW_HEAD = 64
RW_HEADS = RW_WIDTH // RW_HEAD
RW_DECAY_LORA = 32
RW_AAA_LORA = 32
RW_GATE_LORA = 96
RW_COLS = 3 * RW_WIDTH + RW_DECAY_LORA + RW_AAA_LORA + RW_GATE_LORA
IN_COLS = S5_WIDTH + RW_COLS
PEER_HEADS = 8
PEER_NKEYS = 128
PEER_EXPERTS = PEER_NKEYS * PEER_NKEYS
PEER_QDIM = 256
PEER_HALF = PEER_QDIM // 2
PEER_TOPK = 16
PEER_BLOCK = 128
NORM_EPS = 1e-6
GN_EPS = 64e-5

kernel_name = "hybrid_s5_rwkv7_peer_dit_block"

F32 = jnp.float32


def rmsnorm(x, g):
    xf = x.astype(F32)
    y = xf * lax.rsqrt(jnp.mean(xf * xf, axis=-1, keepdims=True) + NORM_EPS)
    return y.astype(x.dtype) * g


def modulate(h, shift, scale):
    return h * (1 + scale) + shift


def s5_discretize(a_re, a_im, log_dt, b_re, b_im):
    a_re, a_im = a_re.astype(F32), a_im.astype(F32)
    b_re, b_im = b_re.astype(F32), b_im.astype(F32)
    dt = jnp.exp(log_dt.astype(F32))[:, None]
    mag = jnp.exp(dt * a_re)
    ab_re, ab_im = mag * jnp.cos(dt * a_im), mag * jnp.sin(dt * a_im)
    nr, ni = ab_re - 1.0, ab_im
    den = a_re * a_re + a_im * a_im
    cf_re = (nr * a_re + ni * a_im) / den
    cf_im = (ni * a_re - nr * a_im) / den
    bb_re = cf_re[..., None] * b_re - cf_im[..., None] * b_im
    bb_im = cf_re[..., None] * b_im + cf_im[..., None] * b_re
    return ab_re, ab_im, bb_re, bb_im


def _complex_affine_combine(e1, e2):
    a1r, a1i, b1r, b1i = e1
    a2r, a2i, b2r, b2i = e2
    return (a2r * a1r - a2i * a1i, a2r * a1i + a2i * a1r,
            a2r * b1r - a2i * b1i + b2r, a2r * b1i + a2i * b1r + b2i)


def s5_scan(u, disc, h0):
    ab_re, ab_im, bb_re, bb_im = disc
    bn, length, _ = u.shape
    uf = u.astype(F32).reshape(bn, length, S5_GROUPS, S5_GROUP)
    bu_re = jnp.einsum('blgh,gph->blgp', uf, bb_re)
    bu_im = jnp.einsum('blgh,gph->blgp', uf, bb_im)
    if h0 is not None:
        h0_re, h0_im = h0
        bu_re = bu_re.at[:, 0].add(ab_re * h0_re - ab_im * h0_im)
        bu_im = bu_im.at[:, 0].add(ab_re * h0_im + ab_im * h0_re)
    a_re = jnp.broadcast_to(ab_re, (1, length) + ab_re.shape)
    a_im = jnp.broadcast_to(ab_im, (1, length) + ab_im.shape)
    _, _, h_re, h_im = lax.associative_scan(_complex_affine_combine, (a_re, a_im, bu_re, bu_im), axis=1)
    return h_re, h_im


def s5_readout(h, c_re, c_im):
    h_re, h_im = h
    y = (jnp.einsum('blgp,ghp->blgh', h_re, c_re.astype(F32))
         - jnp.einsum('blgp,ghp->blgh', h_im, c_im.astype(F32)))
    return y.reshape(y.shape[0], y.shape[1], S5_WIDTH)


def s5_glu(y, w, b):
    y1 = jax.nn.gelu(y, approximate=False)
    return y1 * jax.nn.sigmoid(y1 @ w + b)


def s5_mixer(u_ctx, u_lat, p, need_ctx):
    y_lat = p['s5_d'] * u_lat
    y_ctx = p['s5_d'] * u_ctx if need_ctx else None
    for d in range(2):
        disc = s5_discretize(p['s5_a_re'][d], p['s5_a_im'][d], p['s5_log_dt'][d],
                             p['s5_b_re'][d], p['s5_b_im'][d])
        flip = (lambda t: jnp.flip(t, axis=1)) if d == 1 else (lambda t: t)
        hc = s5_scan(flip(u_ctx), disc, None)
        hl = s5_scan(flip(u_lat), disc, (hc[0][:, -1], hc[1][:, -1]))
        y_lat = y_lat + flip(s5_readout(hl, p['s5_c_re'][d], p['s5_c_im'][d]))
        if need_ctx:
            y_ctx = y_ctx + flip(s5_readout(hc, p['s5_c_re'][d], p['s5_c_im'][d]))
    out_lat = s5_glu(y_lat, p['s5_w_glu'], p['s5_b_glu']).astype(u_lat.dtype)
    out_ctx = s5_glu(y_ctx, p['s5_w_glu'], p['s5_b_glu']).astype(u_ctx.dtype) if need_ctx else None
    return out_lat, out_ctx


def shift_grid(z, rows):
    bn, length, ch = z.shape
    zg = z.reshape(bn, rows, GRID_W, ch)
    left = jnp.pad(zg[:, :, :-1], ((0, 0), (0, 0), (1, 0), (0, 0)))
    right = jnp.pad(zg[:, :, 1:], ((0, 0), (0, 0), (0, 1), (0, 0)))
    up = jnp.pad(zg[:, :-1], ((0, 0), (1, 0), (0, 0), (0, 0)))
    down = jnp.pad(zg[:, 1:], ((0, 0), (0, 1), (0, 0), (0, 0)))
    sel = jnp.arange(ch) % 4
    out = jnp.where(sel == 0, left, jnp.where(sel == 1, right, jnp.where(sel == 2, up, down)))
    return out.reshape(bn, length, ch)


def shift_seq(z):
    prev = jnp.pad(z[:, :-1], ((0, 0), (1, 0), (0, 0)))
    nxt = jnp.pad(z[:, 1:], ((0, 0), (0, 1), (0, 0)))
    return jnp.where(jnp.arange(z.shape[-1]) % 2 == 0, prev, nxt)


def _heads(t):
    return t.reshape(t.shape[0], t.shape[1], RW_HEADS, RW_HEAD).astype(F32)


def rwkv_streams(z, shifted, p):
    z = z + (shifted - z) * p['rw_mu']
    cuts = [RW_WIDTH, 2 * RW_WIDTH, 3 * RW_WIDTH, 3 * RW_WIDTH + RW_DECAY_LORA,
            3 * RW_WIDTH + RW_DECAY_LORA + RW_AAA_LORA]
    r, k, v, wl, al, gl = jnp.split(z, cuts, axis=-1)
    g = jax.nn.sigmoid(gl) @ p['rw_w_g2']
    kk = _heads(k * p['rw_k_k'])
    kk = kk * lax.rsqrt(jnp.sum(kk * kk, axis=-1, keepdims=True) + 1e-12)
    return {'r': _heads(r), 'k': k, 'v': _heads(v), 'wl': wl, 'al': al, 'g': g, 'kk': kk}


def rwkv_direction(st, p, d):
    w = -jax.nn.softplus(-(p['rw_w0'][d] + jnp.tanh(st['wl']) @ p['rw_w_w2'][d])) - 0.5
    decay = jnp.exp(-jnp.exp(w.astype(F32)))
    a = jax.nn.sigmoid(p['rw_a0'][d] + st['al'] @ p['rw_w_a2'][d])
    kd = _heads(st['k'] * (1 + (a - 1) * p['rw_k_a']))
    bonus = jnp.sum(st['r'] * kd * p['rw_r_k'].astype(F32), axis=-1, keepdims=True) * st['v']
    tm = lambda t: jnp.moveaxis(t, 1, 0)
    xs = (tm(st['r']), tm(_heads(decay)), tm(kd), tm(st['v']), tm(st['kk']), tm(_heads(a)))
    return xs, bonus


def rwkv_scan(xs, s0, reverse):
    def step(s, inp):
        r, w, k, v, kk, a = inp
        sa = jnp.einsum('bhvk,bhk->bhv', s, -kk)
        s = s * w[:, :, None, :] + sa[..., None] * (kk * a)[:, :, None, :] + v[..., None] * k[:, :, None, :]
        return s, jnp.einsum('bhvk,bhk->bhv', s, r)
    return lax.scan(step, s0, xs, reverse=reverse)


def rwkv_output(ys_f, ys_b, bonus, g, p, dtype):
    y = jnp.moveaxis(ys_f + ys_b, 0, 1)
    mu = jnp.mean(y, axis=-1, keepdims=True)
    var = jnp.mean(jnp.square(y - mu), axis=-1, keepdims=True)
    yn = ((y - mu) * lax.rsqrt(var + GN_EPS) * p['rw_ln_w'].reshape(RW_HEADS, RW_HEAD).astype(F32)
          + p['rw_ln_b'].reshape(RW_HEADS, RW_HEAD).astype(F32))
    out = (yn + bonus).reshape(y.shape[0], y.shape[1], RW_WIDTH) * g
    return out.astype(dtype)


def rwkv7_mixer(z_ctx, z_lat, rows, p, need_ctx):
    st_c = rwkv_streams(z_ctx, shift_seq(z_ctx), p)
    st_l = rwkv_streams(z_lat, shift_grid(z_lat, rows), p)
    s0 = jnp.zeros((z_lat.shape[0], RW_HEADS, RW_HEAD, RW_HEAD), F32)
    ys_l, ys_c, bon_l, bon_c = [], [], [], []
    for d in range(2):
        xs_c, b_c = rwkv_direction(st_c, p, d)
        xs_l, b_l = rwkv_direction(st_l, p, d)
        s_ctx, y_c = rwkv_scan(xs_c, s0, d == 1)
        _, y_l = rwkv_scan(xs_l, s_ctx, d == 1)
        ys_l.append(y_l); bon_l.append(b_l); ys_c.append(y_c); bon_c.append(b_c)
    out_lat = rwkv_output(ys_l[0], ys_l[1], bon_l[0] + bon_l[1], st_l['g'], p, z_lat.dtype)
    out_ctx = rwkv_output(ys_c[0], ys_c[1], bon_c[0] + bon_c[1], st_c['g'], p, z_ctx.dtype) if need_ctx else None
    return out_lat, out_ctx


def peer_ffn(h, p):
    bn, length, dm = h.shape
    w_q, keys, u_tab, v_tab = p['peer_w_q'], p['peer_keys'], p['peer_u'], p['peer_v']

    def block(hb):
        q = (hb @ w_q).reshape(PEER_BLOCK, PEER_HEADS, 2, PEER_HALF)
        s = jnp.einsum('thcd,hcnd->thcn', q, keys)
        s1, i1 = lax.top_k(s[:, :, 0], PEER_TOPK)
        s2, i2 = lax.top_k(s[:, :, 1], PEER_TOPK)
        cand_s = (s1[..., :, None] + s2[..., None, :]).reshape(PEER_BLOCK, PEER_HEADS, PEER_TOPK * PEER_TOPK)
        cand_i = (i1[..., :, None] * PEER_NKEYS + i2[..., None, :]).reshape(PEER_BLOCK, PEER_HEADS, PEER_TOPK * PEER_TOPK)
        best_s, pos = lax.top_k(cand_s, PEER_TOPK)
        idx = jnp.take_along_axis(cand_i, pos, axis=-1)
        gate = jax.nn.softmax(best_s.astype(F32), axis=-1)
        u = jnp.take(u_tab, idx, axis=0)
        act = jax.nn.gelu(jnp.einsum('td,thkd->thk', hb, u).astype(F32), approximate=False)
        v = jnp.take(v_tab, idx, axis=0)
        return jnp.einsum('thk,thkd->td', (gate * act).astype(hb.dtype), v)

    out = lax.map(block, h.reshape(-1, PEER_BLOCK, dm))
    return out.reshape(bn, length, dm).astype(h.dtype)


def hybrid_layer(h, hc, c, c_ctx, p, rows, update_ctx):
    mod = jax.nn.silu(c) @ p['w_ada'] + p['b_ada']
    mod_c = jax.nn.silu(c_ctx) @ p['w_ada'] + p['b_ada']
    sh1, sc1, g1, sh2, sc2, g2 = jnp.split(mod[:, None, :], 6, axis=-1)
    csh1, csc1, cg1, csh2, csc2, cg2 = jnp.split(mod_c, 6, axis=-1)

    hn = modulate(rmsnorm(h, p['norm1_g']), sh1, sc1)
    hcn = modulate(rmsnorm(hc, p['norm1_g']), csh1, csc1)
    proj = hn @ p['w_in']
    proj_c = hcn @ p['w_in']
    s5_l, s5_c = s5_mixer(proj_c[..., :S5_WIDTH], proj[..., :S5_WIDTH], p, update_ctx)
    rw_l, rw_c = rwkv7_mixer(proj_c[..., S5_WIDTH:], proj[..., S5_WIDTH:], rows, p, update_ctx)
    h = h + g1 * (jnp.concatenate([s5_l, rw_l], axis=-1) @ p['w_out'])
    h = h + g2 * peer_ffn(modulate(rmsnorm(h, p['norm2_g']), sh2, sc2), p)
    if update_ctx:
        hc = hc + cg1 * (jnp.concatenate([s5_c, rw_c], axis=-1) @ p['w_out'])
        hc = hc + cg2 * peer_ffn(modulate(rmsnorm(hc, p['norm2_g']), csh2, csc2), p)
    return h, hc


def setup_inputs(seed: int = 0) -> dict:
    key = jax.random.key(seed)
    ks = jax.random.split(key, 40)
    n = lambda i, shape, s: jax.random.normal(ks[i], shape, F32) * s
    G, P, Hc = S5_GROUPS, S5_STATE, S5_GROUP
    a_im_base = jnp.pi * jnp.arange(P, dtype=F32)
    return {
        'x': n(0, (BATCH, SEQ, D_MODEL), 1.0),
        'c': n(1, (BATCH, D_MODEL), 1.0),
        'ctx': n(2, (BATCH, CTX_LEN, D_MODEL), 1.0),
        'c_ctx': n(3, (D_MODEL,), 1.0),
        'w_ada': n(4, (DEPTH, D_MODEL, 6 * D_MODEL), 0.5 * D_MODEL ** -0.5),
        'b_ada': n(5, (DEPTH, 6 * D_MODEL), 0.02),
        'norm1_g': 1.0 + n(6, (DEPTH, D_MODEL), 0.02),
        'norm2_g': 1.0 + n(7, (DEPTH, D_MODEL), 0.02),
        'w_in': n(8, (DEPTH, D_MODEL, IN_COLS), D_MODEL ** -0.5),
        's5_a_re': -0.5 + n(9, (DEPTH, 2, G, P), 0.01),
        's5_a_im': a_im_base + n(10, (DEPTH, 2, G, P), 0.01),
        's5_log_dt': jax.random.uniform(ks[11], (DEPTH, 2, G), F32, math.log(1e-3), math.log(1e-1)),
        's5_b_re': n(12, (DEPTH, 2, G, P, Hc), (2 * Hc) ** -0.5),
        's5_b_im': n(13, (DEPTH, 2, G, P, Hc), (2 * Hc) ** -0.5),
        's5_c_re': n(14, (DEPTH, 2, G, Hc, P), (2 * P) ** -0.5),
        's5_c_im': n(15, (DEPTH, 2, G, Hc, P), (2 * P) ** -0.5),
        's5_d': n(16, (DEPTH, S5_WIDTH), 1.0),
        's5_w_glu': n(17, (DEPTH, S5_WIDTH, S5_WIDTH), S5_WIDTH ** -0.5),
        's5_b_glu': n(18, (DEPTH, S5_WIDTH), 0.02),
        'rw_mu': jax.random.uniform(ks[19], (DEPTH, RW_COLS), F32, 0.0, 1.0),
        'rw_w0': jax.random.uniform(ks[20], (DEPTH, 2, RW_WIDTH), F32, -6.5, -1.5),
        'rw_w_w2': n(21, (DEPTH, 2, RW_DECAY_LORA, RW_WIDTH), 0.1 * RW_DECAY_LORA ** -0.5),
        'rw_a0': n(22, (DEPTH, 2, RW_WIDTH), 0.1),
        'rw_w_a2': n(23, (DEPTH, 2, RW_AAA_LORA, RW_WIDTH), 0.1 * RW_AAA_LORA ** -0.5),
        'rw_w_g2': n(24, (DEPTH, RW_GATE_LORA, RW_WIDTH), RW_GATE_LORA ** -0.5),
        'rw_k_k': 0.85 + n(25, (DEPTH, RW_WIDTH), 0.02),
        'rw_k_a': 1.0 + n(26, (DEPTH, RW_WIDTH), 0.02),
        'rw_r_k': n(27, (DEPTH, RW_HEADS, RW_HEAD), 0.1),
        'rw_ln_w': 1.0 + n(28, (DEPTH, RW_WIDTH), 0.02),
        'rw_ln_b': n(29, (DEPTH, RW_WIDTH), 0.02),
        'w_out': n(30, (DEPTH, D_MODEL, D_MODEL), D_MODEL ** -0.5),
        'peer_w_q': n(31, (DEPTH, D_MODEL, PEER_HEADS * PEER_QDIM), D_MODEL ** -0.5),
        'peer_keys': n(32, (DEPTH, PEER_HEADS, 2, PEER_NKEYS, PEER_HALF), PEER_HALF ** -0.5),
        'peer_u': n(33, (DEPTH, PEER_EXPERTS, D_MODEL), D_MODEL ** -0.5),
        'peer_v': n(34, (DEPTH, PEER_EXPERTS, D_MODEL), 0.5 * PEER_HEADS ** -0.5),
        'norm_f_g': 1.0 + n(35, (D_MODEL,), 0.02),
    }


def reference(x, c, ctx, c_ctx, w_ada, b_ada, norm1_g, norm2_g, w_in, s5_a_re, s5_a_im, s5_log_dt,
              s5_b_re, s5_b_im, s5_c_re, s5_c_im, s5_d, s5_w_glu, s5_b_glu, rw_mu, rw_w0, rw_w_w2,
              rw_a0, rw_w_a2, rw_w_g2, rw_k_k, rw_k_a, rw_r_k, rw_ln_w, rw_ln_b, w_out, peer_w_q,
              peer_keys, peer_u, peer_v, norm_f_g):
    rows = x.shape[1] // GRID_W
    h, hc = x, ctx
    for l in range(DEPTH):
        p = {
            'w_ada': w_ada[l], 'b_ada': b_ada[l], 'norm1_g': norm1_g[l], 'norm2_g': norm2_g[l],
            'w_in': w_in[l], 's5_a_re': s5_a_re[l], 's5_a_im': s5_a_im[l], 's5_log_dt': s5_log_dt[l],
            's5_b_re': s5_b_re[l], 's5_b_im': s5_b_im[l], 's5_c_re': s5_c_re[l], 's5_c_im': s5_c_im[l],
            's5_d': s5_d[l], 's5_w_glu': s5_w_glu[l], 's5_b_glu': s5_b_glu[l], 'rw_mu': rw_mu[l],
            'rw_w0': rw_w0[l], 'rw_w_w2': rw_w_w2[l], 'rw_a0': rw_a0[l], 'rw_w_a2': rw_w_a2[l],
            'rw_w_g2': rw_w_g2[l], 'rw_k_k': rw_k_k[l], 'rw_k_a': rw_k_a[l], 'rw_r_k': rw_r_k[l],
            'rw_ln_w': rw_ln_w[l], 'rw_ln_b': rw_ln_b[l], 'w_out': w_out[l], 'peer_w_q': peer_w_q[l],
            'peer_keys': peer_keys[l], 'peer_u': peer_u[l], 'peer_v': peer_v[l],
        }
        h, hc = hybrid_layer(h, hc, c, c_ctx, p, rows, l < DEPTH - 1)
    return rmsnorm(h, norm_f_g)
```

```cpp
#include <hip/hip_runtime.h>
#include <hip/hip_cooperative_groups.h>
#include <stdint.h>
#include <stdio.h>
namespace cg = cooperative_groups;

#ifndef MEGA
#define MEGA 0
#endif

typedef unsigned short u16;
using bf16x8 = __attribute__((ext_vector_type(8))) short;
using f32x4 = __attribute__((ext_vector_type(4))) float;
using u32x4 = __attribute__((ext_vector_type(4))) unsigned;

#define DM 1024
#define NLAT 65536
#define NCTX 8192
#define NTOK 73728
#define INC 2208
#define INCP 2304
#define NTHREADS 512
#define LDS_BYTES 131072

struct P {
  const float *x, *c, *ctx, *c_ctx, *w_ada, *b_ada, *norm1_g, *norm2_g, *w_in, *s5_a_re, *s5_a_im, *s5_log_dt,
      *s5_b_re, *s5_b_im, *s5_c_re, *s5_c_im, *s5_d, *s5_w_glu, *s5_b_glu, *rw_mu, *rw_w0, *rw_w_w2, *rw_a0, *rw_w_a2,
      *rw_w_g2, *rw_k_k, *rw_k_a, *rw_r_k, *rw_ln_w, *rw_ln_b, *w_out, *peer_w_q, *peer_keys, *peer_u, *peer_v, *norm_f_g;
  float* out;
  float* mod;
  u16 *win_t, *wout_t, *wq_t, *wglu_t, *wg2_t, *keys, *utab, *vtab;
  float *s5ab, *s5bb;
  u16* s5ct;
  u16 *hn, *proj, *ys5f, *ys5b, *yrwf, *yrwb;
  float* bsc;
  u16* sg;
  int* idx;
  float* gate;
};

__device__ __forceinline__ u16 f2bf(float f) {
  unsigned u = __float_as_uint(f);
  u += 0x7fffu + ((u >> 16) & 1u);
  return (u16)(u >> 16);
}
__device__ __forceinline__ float bf2f(u16 h) { return __uint_as_float(((unsigned)h) << 16); }
__device__ __forceinline__ unsigned pack2(float a, float b) { return (unsigned)f2bf(a) | ((unsigned)f2bf(b) << 16); }
__device__ __forceinline__ float bflo(unsigned u) { return __uint_as_float(u << 16); }
__device__ __forceinline__ float bfhi(unsigned u) { return __uint_as_float(u & 0xffff0000u); }
__device__ __forceinline__ float wave_sum(float v) {
#pragma unroll
  for (int m = 32; m >= 1; m >>= 1) v += __shfl_xor(v, m, 64);
  return v;
}
__device__ __forceinline__ float gelu_exact(float x) { return 0.5f * x * (1.f + erff(x * 0.70710678118654752f)); }
__device__ __forceinline__ float sigmoidf(float x) { return 1.f / (1.f + __expf(-x)); }

__device__ __forceinline__ void transpose_tiles(const float* __restrict__ src, int K, int N, u16* __restrict__ dst, int Kd, int Npad,
                                char* smem, int bid, int nb) {
  float* tile = (float*)smem;
  const int tid = threadIdx.x;
  const int nkt = Kd / 64, nnt = Npad / 64;
  for (int t = bid; t < nkt * nnt; t += nb) {
    int kt = t % nkt, nt = t / nkt;
    int k0 = kt * 64, n0 = nt * 64;
    __syncthreads();
#pragma unroll
    for (int it = 0; it < 8; ++it) {
      int i = (tid >> 6) + it * 8, j = tid & 63;
      int k = k0 + i, n = n0 + j;
      tile[i * 65 + j] = (k < K && n < N) ? src[(size_t)k * N + n] : 0.f;
    }
    __syncthreads();
    int n = tid >> 3, kc = (tid & 7) * 8;
    uint4 o;
    o.x = pack2(tile[(kc + 0) * 65 + n], tile[(kc + 1) * 65 + n]);
    o.y = pack2(tile[(kc + 2) * 65 + n], tile[(kc + 3) * 65 + n]);
    o.z = pack2(tile[(kc + 4) * 65 + n], tile[(kc + 5) * 65 + n]);
    o.w = pack2(tile[(kc + 6) * 65 + n], tile[(kc + 7) * 65 + n]);
    *(uint4*)(dst + (size_t)(n0 + n) * Kd + k0 + kc) = o;
  }
}

__device__ __forceinline__ void convert_bf16(const float* __restrict__ src, u16* __restrict__ dst, size_t n8, int bid, int nb) {
  for (size_t i = (size_t)bid * NTHREADS + threadIdx.x; i < n8; i += (size_t)nb * NTHREADS) {
    float4 a = *(const float4*)(src + i * 8), b = *(const float4*)(src + i * 8 + 4);
    uint4 o;
    o.x = pack2(a.x, a.y); o.y = pack2(a.z, a.w); o.z = pack2(b.x, b.y); o.w = pack2(b.z, b.w);
    *(uint4*)(dst + i * 8) = o;
  }
}

__device__ __forceinline__ void ph_prep(const P& p, char* smem, int bid, int nb) {
  const int tid = threadIdx.x;
  {
    float* sc = (float*)smem;
    float* red = (float*)(smem + 33 * 128 * 4);
    for (int item = bid; item < 96; item += nb) {
      const int j0 = item * 64, kg = tid >> 6, col = tid & 63;
      float acc[33];
#pragma unroll
      for (int b = 0; b < 33; ++b) acc[b] = 0.f;
      for (int ch = 0; ch < 8; ++ch) {
        __syncthreads();
        for (int e = tid; e < 33 * 128; e += NTHREADS) {
          int b = e >> 7, kk = e & 127;
          float cv = (b < 32) ? p.c[b * 1024 + ch * 128 + kk] : p.c_ctx[ch * 128 + kk];
          sc[e] = cv / (1.f + expf(-cv));
        }
        __syncthreads();
        for (int i = 0; i < 16; ++i) {
          int kk = kg * 16 + i;
          float w = p.w_ada[(size_t)(ch * 128 + kk) * 6144 + j0 + col];
#pragma unroll
          for (int b = 0; b < 33; ++b) acc[b] += sc[b * 128 + kk] * w;
        }
      }
#pragma unroll
      for (int b = 0; b < 33; ++b) red[(kg * 33 + b) * 64 + col] = acc[b];
      __syncthreads();
      for (int e = tid; e < 33 * 64; e += NTHREADS) {
        int b = e >> 6, cc = e & 63;
        float s = p.b_ada[j0 + cc];
#pragma unroll
        for (int k2 = 0; k2 < 8; ++k2) s += red[(k2 * 33 + b) * 64 + cc];
        p.mod[b * 6144 + j0 + cc] = s;
      }
      __syncthreads();
    }
  }
  transpose_tiles(p.w_in, 1024, INC, p.win_t, 1024, INCP, smem, bid, nb);
  transpose_tiles(p.w_out, 1024, 1024, p.wout_t, 1024, 1024, smem, bid, nb);
  transpose_tiles(p.peer_w_q, 1024, 2048, p.wq_t, 1024, 2048, smem, bid, nb);
  transpose_tiles(p.s5_w_glu, 512, 512, p.wglu_t, 512, 512, smem, bid, nb);
  transpose_tiles(p.rw_w_g2, 96, 512, p.wg2_t, 128, 512, smem, bid, nb);
  convert_bf16(p.peer_keys, p.keys, (size_t)8 * 2 * 128 * 128 / 8, bid, nb);
  convert_bf16(p.peer_u, p.utab, (size_t)16384 * 1024 / 8, bid, nb);
  convert_bf16(p.peer_v, p.vtab, (size_t)16384 * 1024 / 8, bid, nb);
  for (int it = bid * NTHREADS + tid; it < 4096; it += nb * NTHREADS) {
    int pp = it & 63, g = (it >> 6) & 31, d = it >> 11;
    float are = p.s5_a_re[it], aim = p.s5_a_im[it];
    float dt = expf(p.s5_log_dt[d * 32 + g]);
    float mag = expf(dt * are);
    float abr = mag * cosf(dt * aim), abi = mag * sinf(dt * aim);
    float nr = abr - 1.f, ni = abi;
    float den = are * are + aim * aim;
    float cfr = (nr * are + ni * aim) / den, cfi = (ni * are - nr * aim) / den;
    p.s5ab[it * 2] = abr;
    p.s5ab[it * 2 + 1] = abi;
    for (int h = 0; h < 16; ++h) {
      float br = p.s5_b_re[(size_t)it * 16 + h], bi = p.s5_b_im[(size_t)it * 16 + h];
      p.s5bb[(size_t)it * 32 + h] = cfr * br - cfi * bi;
      p.s5bb[(size_t)it * 32 + 16 + h] = cfr * bi + cfi * br;
    }
    for (int h = 0; h < 16; ++h) {
      size_t ci = ((size_t)(d * 32 + g) * 16 + h) * 64 + pp;
      p.s5ct[((size_t)(d * 32 + g) * 16 + h) * 128 + 2 * pp] = f2bf(p.s5_c_re[ci]);
      p.s5ct[((size_t)(d * 32 + g) * 16 + h) * 128 + 2 * pp + 1] = f2bf(-p.s5_c_im[ci]);
    }
  }
}

__device__ __forceinline__ void ph_norm(const P& p, int mode, int bid, int nb) {
  const int wid = threadIdx.x >> 6, lane = threadIdx.x & 63;
  const int nrows = mode == 0 ? NTOK : NLAT;
  const float* gvec = mode == 0 ? p.norm1_g : p.norm2_g;
  const int sh_off = mode == 0 ? 0 : 3 * 1024, sc_off = sh_off + 1024;
  for (int row = bid * 8 + wid; row < nrows; row += nb * 8) {
    const float* src;
    int b;
    if (mode == 0) {
      if (row < NLAT) { src = p.x + (size_t)row * 1024; b = row >> 11; }
      else { src = p.ctx + (size_t)(row - NLAT) * 1024; b = 32; }
    } else { src = p.out + (size_t)row * 1024; b = row >> 11; }
    float4 v[4];
    float ss = 0.f;
#pragma unroll
    for (int j = 0; j < 4; ++j) {
      v[j] = *(const float4*)(src + j * 256 + lane * 4);
      ss += v[j].x * v[j].x + v[j].y * v[j].y + v[j].z * v[j].z + v[j].w * v[j].w;
    }
    ss = wave_sum(ss);
    float rstd = rsqrtf(ss * (1.f / 1024.f) + 1e-6f);
    const float* mrow = p.mod + b * 6144;
#pragma unroll
    for (int j = 0; j < 4; ++j) {
      int col = j * 256 + lane * 4;
      float4 g = *(const float4*)(gvec + col);
      float4 sh = *(const float4*)(mrow + sh_off + col);
      float4 sc = *(const float4*)(mrow + sc_off + col);
      float y0 = v[j].x * rstd * g.x * (1.f + sc.x) + sh.x;
      float y1 = v[j].y * rstd * g.y * (1.f + sc.y) + sh.y;
      float y2 = v[j].z * rstd * g.z * (1.f + sc.z) + sh.z;
      float y3 = v[j].w * rstd * g.w * (1.f + sc.w) + sh.w;
      uint2 o;
      o.x = pack2(y0, y1); o.y = pack2(y2, y3);
      *(uint2*)(p.hn + (size_t)row * 1024 + col) = o;
    }
  }
}

#define G_BM 256
#define G_BN 128
#define G_BK 64
#define G_LD 72
template <class Epi>
__device__ __forceinline__ void gemm_phase(const u16* __restrict__ A, int lda, const u16* __restrict__ Bt, int ldb, int K, int M, int N,
                           char* smem, int bid, int nb, Epi epi) {
  u16* As = (u16*)smem;
  u16* Bs = (u16*)(smem + 2 * G_BM * G_LD * 2);
  const int tid = threadIdx.x, wid = tid >> 6, lane = tid & 63;
  const int wr = wid >> 1, wc = wid & 1, fr = lane & 15, fq = lane >> 4;
  const int ntn = N / G_BN, ntiles = (M / G_BM) * ntn, nk = K / G_BK;
  const int lrow = tid >> 3, lkc = (tid & 7) * 8;
  for (int tile = bid; tile < ntiles; tile += nb) {
    const int m0 = (tile / ntn) * G_BM, n0 = (tile % ntn) * G_BN;
    f32x4 acc[4][4];
#pragma unroll
    for (int i = 0; i < 4; ++i)
#pragma unroll
      for (int j = 0; j < 4; ++j) acc[i][j] = (f32x4){0.f, 0.f, 0.f, 0.f};
    u32x4 ra[4], rb[2];
    const u16* Ag = A + (size_t)(m0 + lrow) * lda + lkc;
    const u16* Bg = Bt + (size_t)(n0 + lrow) * ldb + lkc;
#pragma unroll
    for (int i = 0; i < 4; ++i) ra[i] = *(const u32x4*)(Ag + (size_t)(64 * i) * lda);
#pragma unroll
    for (int i = 0; i < 2; ++i) rb[i] = *(const u32x4*)(Bg + (size_t)(64 * i) * ldb);
    __syncthreads();
#pragma unroll
    for (int i = 0; i < 4; ++i) *(u32x4*)(As + (lrow + 64 * i) * G_LD + lkc) = ra[i];
#pragma unroll
    for (int i = 0; i < 2; ++i) *(u32x4*)(Bs + (lrow + 64 * i) * G_LD + lkc) = rb[i];
    __syncthreads();
    for (int kt = 0; kt < nk; ++kt) {
      const int buf = kt & 1;
      if (kt + 1 < nk) {
#pragma unroll
        for (int i = 0; i < 4; ++i) ra[i] = *(const u32x4*)(Ag + (size_t)(64 * i) * lda + (kt + 1) * G_BK);
#pragma unroll
        for (int i = 0; i < 2; ++i) rb[i] = *(const u32x4*)(Bg + (size_t)(64 * i) * ldb + (kt + 1) * G_BK);
      }
      const u16* as = As + buf * (G_BM * G_LD);
      const u16* bs = Bs + buf * (G_BN * G_LD);
#pragma unroll
      for (int ks = 0; ks < 2; ++ks) {
        bf16x8 af[4], bfr[4];
#pragma unroll
        for (int mi = 0; mi < 4; ++mi) af[mi] = *(const bf16x8*)(as + (wr * 64 + mi * 16 + fr) * G_LD + ks * 32 + fq * 8);
#pragma unroll
        for (int ni = 0; ni < 4; ++ni) bfr[ni] = *(const bf16x8*)(bs + (wc * 64 + ni * 16 + fr) * G_LD + ks * 32 + fq * 8);
#pragma unroll
        for (int mi = 0; mi < 4; ++mi)
#pragma unroll
          for (int ni = 0; ni < 4; ++ni)
            acc[mi][ni] = __builtin_amdgcn_mfma_f32_16x16x32_bf16(af[mi], bfr[ni], acc[mi][ni], 0, 0, 0);
      }
      if (kt + 1 < nk) {
        u16* as2 = As + (buf ^ 1) * (G_BM * G_LD);
        u16* bs2 = Bs + (buf ^ 1) * (G_BN * G_LD);
#pragma unroll
        for (int i = 0; i < 4; ++i) *(u32x4*)(as2 + (lrow + 64 * i) * G_LD + lkc) = ra[i];
#pragma unroll
        for (int i = 0; i < 2; ++i) *(u32x4*)(bs2 + (lrow + 64 * i) * G_LD + lkc) = rb[i];
      }
      __syncthreads();
    }
#pragma unroll
    for (int mi = 0; mi < 4; ++mi)
#pragma unroll
      for (int ni = 0; ni < 4; ++ni) epi(m0 + wr * 64 + mi * 16 + fq * 4, n0 + wc * 64 + ni * 16 + fr, acc[mi][ni]);
  }
}

struct EpiProj {
  u16* proj;
  __device__ __forceinline__ void operator()(int r, int c, f32x4 v) const {
    if (c < INC) {
#pragma unroll
      for (int j = 0; j < 4; ++j) proj[(size_t)(r + j) * INC + c] = f2bf(v[j]);
    }
  }
};
struct EpiGlu {
  const u16* y1; const float* bglu; u16* a2;
  __device__ __forceinline__ void operator()(int r, int c, f32x4 v) const {
    float bb = bglu[c];
#pragma unroll
    for (int j = 0; j < 4; ++j) {
      float y = bf2f(y1[(size_t)(r + j) * 512 + c]);
      a2[(size_t)(r + j) * 1024 + c] = f2bf(y * sigmoidf(v[j] + bb));
    }
  }
};
struct EpiGate {
  const u16* t1; u16* a2;
  __device__ __forceinline__ void operator()(int r, int c, f32x4 v) const {
#pragma unroll
    for (int j = 0; j < 4; ++j) {
      float t = bf2f(t1[(size_t)(r + j) * 512 + c]);
      a2[(size_t)(r + j) * 1024 + 512 + c] = f2bf(t * v[j]);
    }
  }
};
struct EpiWout {
  const float* x; const float* mod; float* h2;
  __device__ __forceinline__ void operator()(int r, int c, f32x4 v) const {
    float g1 = mod[(r >> 11) * 6144 + 2 * 1024 + c];
#pragma unroll
    for (int j = 0; j < 4; ++j) h2[(size_t)(r + j) * 1024 + c] = x[(size_t)(r + j) * 1024 + c] + g1 * v[j];
  }
};
struct EpiQ {
  u16* q;
  __device__ __forceinline__ void operator()(int r, int c, f32x4 v) const {
#pragma unroll
    for (int j = 0; j < 4; ++j) q[(size_t)(r + j) * 2048 + c] = f2bf(v[j]);
  }
};

__device__ __forceinline__ void ph_s5scan(const P& p, char* smem, int bid, int nb) {
  const int wid = threadIdx.x >> 6, lane = threadIdx.x & 63;
  float* U = (float*)(smem + wid * 8448);
  unsigned* H = (unsigned*)((char*)U + 4096);
  const int fr = lane & 15, fq = lane >> 4;
  for (int s = bid * 8 + wid; s < 2048; s += nb * 8) {
    const int g = s & 31, d = (s >> 5) & 1, b = s >> 6;
    const int ci = (d * 32 + g) * 64 + lane;
    const float abr = p.s5ab[ci * 2], abi = p.s5ab[ci * 2 + 1];
    float bbr[16], bbi[16];
#pragma unroll
    for (int q = 0; q < 4; ++q) {
      float4 t = *(const float4*)(p.s5bb + (size_t)ci * 32 + q * 4);
      bbr[q * 4] = t.x; bbr[q * 4 + 1] = t.y; bbr[q * 4 + 2] = t.z; bbr[q * 4 + 3] = t.w;
      float4 t2 = *(const float4*)(p.s5bb + (size_t)ci * 32 + 16 + q * 4);
      bbi[q * 4] = t2.x; bbi[q * 4 + 1] = t2.y; bbi[q * 4 + 2] = t2.z; bbi[q * 4 + 3] = t2.w;
    }
    bf16x8 cf[4];
#pragma unroll
    for (int kb = 0; kb < 4; ++kb)
      cf[kb] = *(const bf16x8*)(p.s5ct + ((size_t)(d * 32 + g) * 16 + fr) * 128 + kb * 32 + fq * 8);
    const float dcoef = p.s5_d[g * 16 + fr];
    u16* ydst = d ? p.ys5b : p.ys5f;
    float hr = 0.f, hi = 0.f;
    for (int seg = 0; seg < 2; ++seg) {
      const int L = seg ? 2048 : 256;
      const int rowbase = seg ? b * 2048 : NLAT + b * 256;
      for (int c0 = 0; c0 < L; c0 += 64) {
        {
          int pos = c0 + lane;
          int t = d ? (L - 1 - pos) : pos;
          const u16* src = p.proj + (size_t)(rowbase + t) * INC + g * 16;
          uint4 v0 = *(const uint4*)src, v1 = *(const uint4*)(src + 8);
          float4* ud = (float4*)(U + lane * 16);
          ud[0] = make_float4(bflo(v0.x), bfhi(v0.x), bflo(v0.y), bfhi(v0.y));
          ud[1] = make_float4(bflo(v0.z), bfhi(v0.z), bflo(v0.w), bfhi(v0.w));
          ud[2] = make_float4(bflo(v1.x), bfhi(v1.x), bflo(v1.y), bfhi(v1.y));
          ud[3] = make_float4(bflo(v1.z), bfhi(v1.z), bflo(v1.w), bfhi(v1.w));
        }
        for (int sub = 0; sub < 4; ++sub) {
#pragma unroll 4
          for (int i = 0; i < 16; ++i) {
            const float4* up = (const float4*)(U + (sub * 16 + i) * 16);
            float4 u0 = up[0], u1 = up[1], u2 = up[2], u3 = up[3];
            float ur[16] = {u0.x, u0.y, u0.z, u0.w, u1.x, u1.y, u1.z, u1.w, u2.x, u2.y, u2.z, u2.w, u3.x, u3.y, u3.z, u3.w};
            float br0 = 0.f, br1 = 0.f, bi0 = 0.f, bi1 = 0.f;
#pragma unroll
            for (int h = 0; h < 16; h += 2) {
              br0 += bbr[h] * ur[h]; br1 += bbr[h + 1] * ur[h + 1];
              bi0 += bbi[h] * ur[h]; bi1 += bbi[h + 1] * ur[h + 1];
            }
            float nr = abr * hr - abi * hi + (br0 + br1);
            float ni = abr * hi + abi * hr + (bi0 + bi1);
            hr = nr; hi = ni;
            if (seg) H[i * 68 + lane] = pack2(hr, hi);
          }
          if (seg) {
            f32x4 acc = (f32x4){0.f, 0.f, 0.f, 0.f};
#pragma unroll
            for (int kb = 0; kb < 4; ++kb) {
              bf16x8 a = *(const bf16x8*)((const u16*)H + fr * 136 + kb * 32 + fq * 8);
              acc = __builtin_amdgcn_mfma_f32_16x16x32_bf16(a, cf[kb], acc, 0, 0, 0);
            }
#pragma unroll
            for (int j = 0; j < 4; ++j) {
              int pi = sub * 16 + fq * 4 + j;
              int pos = c0 + pi;
              int t = d ? (L - 1 - pos) : pos;
              float y = acc[j];
              if (d == 0) y += dcoef * U[pi * 16 + fr];
              ydst[(size_t)(b * 2048 + t) * 512 + g * 16 + fr] = f2bf(y);
            }
          }
        }
      }
    }
  }
}

__device__ __forceinline__ float4 mix_load4(const u16* __restrict__ proj, size_t row, int col, const size_t* nrow,
                                            const bool* nval, float4 mu) {
  uint2 cz = *(const uint2*)(proj + row * INC + col);
  float z[4] = {bflo(cz.x), bfhi(cz.x), bflo(cz.y), bfhi(cz.y)};
  float o[4];
  float m[4] = {mu.x, mu.y, mu.z, mu.w};
#pragma unroll
  for (int j = 0; j < 4; ++j) {
    float nbv = 0.f;
    if (nval[j]) {
      u16 t = proj[nrow[j] * INC + col + j];
      nbv = bf2f(t);
    }
    o[j] = z[j] + (nbv - z[j]) * m[j];
  }
  return make_float4(o[0], o[1], o[2], o[3]);
}
__device__ __forceinline__ void neighbours(bool isctx, size_t row, int t, size_t* nrow, bool* nval) {
  if (isctx) {
    nrow[0] = row - 1; nval[0] = t > 0;
    nrow[1] = row + 1; nval[1] = t < 255;
    nrow[2] = row - 1; nval[2] = t > 0;
    nrow[3] = row + 1; nval[3] = t < 255;
  } else {
    int col = t & 63, gr = t >> 6;
    nrow[0] = row - 1; nval[0] = col > 0;
    nrow[1] = row + 1; nval[1] = col < 63;
    nrow[2] = row - 64; nval[2] = gr > 0;
    nrow[3] = row + 64; nval[3] = gr < 31;
  }
}

__device__ __forceinline__ void ph_rwscan(const P& p, char* smem, int bid, int nb) {
  const int tid = threadIdx.x, sl = tid >> 8, stid = tid & 255, wv = stid >> 6, lane = tid & 63;
  char* sb = smem + sl * 49152;
  float* OPS = (float*)sb;
  float* LW = (float*)(sb + 24576);
  float* LA = LW + 512;
  float* WW = (float*)(sb + 28672);
  float* WA = WW + 2048;
  float* YB = (float*)(sb + 45056);
  const int tt = stid >> 4, part = stid & 15;
  const int vrow = wv * 16 + (lane >> 2), kq = lane & 3;
  for (int sp = bid; sp < 256; sp += nb) {
    const int s = sp * 2 + sl;
    const int d = s & 1, h = (s >> 1) & 7, b = s >> 4;
    __syncthreads();
    for (int e = stid; e < 2048; e += 256) {
      int j = e >> 6, cc = e & 63;
      WW[e] = p.rw_w_w2[(size_t)(d * 32 + j) * 512 + h * 64 + cc];
      WA[e] = p.rw_w_a2[(size_t)(d * 32 + j) * 512 + h * 64 + cc];
    }
    const int hc = h * 64 + part * 4;
    const float4 w0v = *(const float4*)(p.rw_w0 + d * 512 + hc);
    const float4 a0v = *(const float4*)(p.rw_a0 + d * 512 + hc);
    const float4 kkv = *(const float4*)(p.rw_k_k + hc);
    const float4 kav = *(const float4*)(p.rw_k_a + hc);
    const float4 rkv = *(const float4*)(p.rw_r_k + hc);
    const float4 mur = *(const float4*)(p.rw_mu + hc);
    const float4 muk = *(const float4*)(p.rw_mu + 512 + hc);
    const float4 muv = *(const float4*)(p.rw_mu + 1024 + hc);
    const float4 mul = *(const float4*)(p.rw_mu + 1536 + part * 4);
    u16* ydst = d ? p.yrwb : p.yrwf;
    float S[16];
#pragma unroll
    for (int i = 0; i < 16; ++i) S[i] = 0.f;
    for (int seg = 0; seg < 2; ++seg) {
      const int L = seg ? 2048 : 256;
      const size_t rowbase = seg ? (size_t)b * 2048 : (size_t)NLAT + b * 256;
      for (int c0 = 0; c0 < L; c0 += 16) {
        const int pos = c0 + tt;
        const int t = d ? (L - 1 - pos) : pos;
        const size_t row = rowbase + t;
        size_t nrow[4];
        bool nval[4];
        neighbours(seg == 0, row, t, nrow, nval);
        float4 r4 = mix_load4(p.proj, row, 512 + hc, nrow, nval, mur);
        float4 k4 = mix_load4(p.proj, row, 512 + 512 + hc, nrow, nval, muk);
        float4 v4 = mix_load4(p.proj, row, 512 + 1024 + hc, nrow, nval, muv);
        float4 l4 = mix_load4(p.proj, row, 512 + 1536 + part * 4, nrow, nval, mul);
        if (part < 8) {
          *(float4*)(LW + tt * 32 + part * 4) = make_float4(tanhf(l4.x), tanhf(l4.y), tanhf(l4.z), tanhf(l4.w));
        } else {
          *(float4*)(LA + tt * 32 + (part - 8) * 4) = l4;
        }
        __syncthreads();
        float wp[4] = {w0v.x, w0v.y, w0v.z, w0v.w};
        float ap[4] = {a0v.x, a0v.y, a0v.z, a0v.w};
#pragma unroll 8
        for (int j = 0; j < 32; ++j) {
          float lw = LW[tt * 32 + j], la = LA[tt * 32 + j];
          float4 ww = *(const float4*)(WW + j * 64 + part * 4);
          float4 wa = *(const float4*)(WA + j * 64 + part * 4);
          wp[0] += lw * ww.x; wp[1] += lw * ww.y; wp[2] += lw * ww.z; wp[3] += lw * ww.w;
          ap[0] += la * wa.x; ap[1] += la * wa.y; ap[2] += la * wa.z; ap[3] += la * wa.w;
        }
        float rr[4] = {r4.x, r4.y, r4.z, r4.w}, kk4[4] = {k4.x, k4.y, k4.z, k4.w};
        float kkc[4] = {kkv.x, kkv.y, kkv.z, kkv.w}, kac[4] = {kav.x, kav.y, kav.z, kav.w}, rkc[4] = {rkv.x, rkv.y, rkv.z, rkv.w};
        float dec[4], aa[4], kd[4], kkr[4];
        float ss = 0.f, bon = 0.f;
#pragma unroll
        for (int i = 0; i < 4; ++i) {
          float xw = -wp[i];
          float sp_ = fmaxf(xw, 0.f) + log1pf(expf(-fabsf(xw)));
          float wl = -sp_ - 0.5f;
          dec[i] = expf(-expf(wl));
          aa[i] = 1.f / (1.f + expf(-ap[i]));
          kd[i] = kk4[i] * (1.f + (aa[i] - 1.f) * kac[i]);
          kkr[i] = kk4[i] * kkc[i];
          ss += kkr[i] * kkr[i];
          bon += rr[i] * kd[i] * rkc[i];
        }
#pragma unroll
        for (int m = 1; m < 16; m <<= 1) {
          ss += __shfl_xor(ss, m, 64);
          bon += __shfl_xor(bon, m, 64);
        }
        float inv = rsqrtf(ss + 1e-12f);
        float* o = OPS + tt * 384 + part * 4;
        *(float4*)(o + 0) = r4;
        *(float4*)(o + 64) = make_float4(dec[0], dec[1], dec[2], dec[3]);
        *(float4*)(o + 128) = make_float4(kd[0], kd[1], kd[2], kd[3]);
        *(float4*)(o + 192) = make_float4(-kkr[0] * inv, -kkr[1] * inv, -kkr[2] * inv, -kkr[3] * inv);
        *(float4*)(o + 256) = make_float4(kkr[0] * inv * aa[0], kkr[1] * inv * aa[1], kkr[2] * inv * aa[2], kkr[3] * inv * aa[3]);
        *(float4*)(o + 320) = v4;
        if (seg && part == 0) p.bsc[((size_t)d * NLAT + row) * 8 + h] = bon;
        __syncthreads();
        for (int i = 0; i < 16; ++i) {
          const float* oo = OPS + i * 384 + kq * 16;
          float kn[16], wv_[16], bv[16], kdv[16];
#pragma unroll
          for (int q = 0; q < 4; ++q) {
            float4 a = *(const float4*)(oo + 192 + q * 4);
            kn[q * 4] = a.x; kn[q * 4 + 1] = a.y; kn[q * 4 + 2] = a.z; kn[q * 4 + 3] = a.w;
            float4 w_ = *(const float4*)(oo + 64 + q * 4);
            wv_[q * 4] = w_.x; wv_[q * 4 + 1] = w_.y; wv_[q * 4 + 2] = w_.z; wv_[q * 4 + 3] = w_.w;
            float4 b_ = *(const float4*)(oo + 256 + q * 4);
            bv[q * 4] = b_.x; bv[q * 4 + 1] = b_.y; bv[q * 4 + 2] = b_.z; bv[q * 4 + 3] = b_.w;
            float4 k_ = *(const float4*)(oo + 128 + q * 4);
            kdv[q * 4] = k_.x; kdv[q * 4 + 1] = k_.y; kdv[q * 4 + 2] = k_.z; kdv[q * 4 + 3] = k_.w;
          }
          float vv = OPS[i * 384 + 320 + vrow];
          float s0 = 0.f, s1 = 0.f, s2 = 0.f, s3 = 0.f;
#pragma unroll
          for (int q = 0; q < 16; q += 4) {
            s0 += S[q] * kn[q]; s1 += S[q + 1] * kn[q + 1]; s2 += S[q + 2] * kn[q + 2]; s3 += S[q + 3] * kn[q + 3];
          }
          float sa = (s0 + s1) + (s2 + s3);
          sa += __shfl_xor(sa, 1, 64);
          sa += __shfl_xor(sa, 2, 64);
#pragma unroll
          for (int q = 0; q < 16; ++q) S[q] = S[q] * wv_[q] + sa * bv[q] + vv * kdv[q];
          if (seg) {
            float rv[16];
#pragma unroll
            for (int q = 0; q < 4; ++q) {
              float4 a = *(const float4*)(oo + q * 4);
              rv[q * 4] = a.x; rv[q * 4 + 1] = a.y; rv[q * 4 + 2] = a.z; rv[q * 4 + 3] = a.w;
            }
            float y0 = 0.f, y1 = 0.f, y2 = 0.f, y3 = 0.f;
#pragma unroll
            for (int q = 0; q < 16; q += 4) {
              y0 += S[q] * rv[q]; y1 += S[q + 1] * rv[q + 1]; y2 += S[q + 2] * rv[q + 2]; y3 += S[q + 3] * rv[q + 3];
            }
            float y = (y0 + y1) + (y2 + y3);
            y += __shfl_xor(y, 1, 64);
            y += __shfl_xor(y, 2, 64);
            if (kq == 0) YB[i * 64 + vrow] = y;
          }
        }
        __syncthreads();
        if (seg) {
          float4 yv = *(const float4*)(YB + tt * 64 + part * 4);
          uint2 o2;
          o2.x = pack2(yv.x, yv.y); o2.y = pack2(yv.z, yv.w);
          *(uint2*)(ydst + row * 512 + hc) = o2;
        }
      }
    }
  }
}

__device__ __forceinline__ void ph_mixprep(const P& p, int bid, int nb) {
  const int wid = threadIdx.x >> 6, lane = threadIdx.x & 63;
  const int c8 = lane * 8;
  for (int row = bid * 8 + wid; row < NLAT; row += nb * 8) {
    const int t = row & 2047;
    {
      uint4 a = *(const uint4*)(p.ys5f + (size_t)row * 512 + c8), b2 = *(const uint4*)(p.ys5b + (size_t)row * 512 + c8);
      unsigned au[4] = {a.x, a.y, a.z, a.w}, bu[4] = {b2.x, b2.y, b2.z, b2.w}, ou[4];
#pragma unroll
      for (int q = 0; q < 4; ++q) {
        float y0 = bflo(au[q]) + bflo(bu[q]), y1 = bfhi(au[q]) + bfhi(bu[q]);
        ou[q] = pack2(gelu_exact(y0), gelu_exact(y1));
      }
      *(uint4*)(p.ys5f + (size_t)row * 512 + c8) = make_uint4(ou[0], ou[1], ou[2], ou[3]);
    }
    float y[8];
    {
      uint4 a = *(const uint4*)(p.yrwf + (size_t)row * 512 + c8), b2 = *(const uint4*)(p.yrwb + (size_t)row * 512 + c8);
      unsigned au[4] = {a.x, a.y, a.z, a.w}, bu[4] = {b2.x, b2.y, b2.z, b2.w};
#pragma unroll
      for (int q = 0; q < 4; ++q) {
        y[2 * q] = bflo(au[q]) + bflo(bu[q]);
        y[2 * q + 1] = bfhi(au[q]) + bfhi(bu[q]);
      }
    }
    float sm = 0.f;
#pragma unroll
    for (int i = 0; i < 8; ++i) sm += y[i];
    sm += __shfl_xor(sm, 1, 64); sm += __shfl_xor(sm, 2, 64); sm += __shfl_xor(sm, 4, 64);
    float mu = sm * (1.f / 64.f);
    float sv = 0.f;
#pragma unroll
    for (int i = 0; i < 8; ++i) sv += (y[i] - mu) * (y[i] - mu);
    sv += __shfl_xor(sv, 1, 64); sv += __shfl_xor(sv, 2, 64); sv += __shfl_xor(sv, 4, 64);
    float rs = rsqrtf(sv * (1.f / 64.f) + 64e-5f);
    size_t nrow[4];
    bool nval[4];
    neighbours(false, (size_t)row, t, nrow, nval);
    float v[8];
    {
      int col = 512 + 1024 + c8;
      uint4 cz = *(const uint4*)(p.proj + (size_t)row * INC + col);
      unsigned cu[4] = {cz.x, cz.y, cz.z, cz.w};
      float4 m0 = *(const float4*)(p.rw_mu + 1024 + c8), m1 = *(const float4*)(p.rw_mu + 1024 + c8 + 4);
      float mm[8] = {m0.x, m0.y, m0.z, m0.w, m1.x, m1.y, m1.z, m1.w};
#pragma unroll
      for (int i = 0; i < 8; ++i) {
        float z = (i & 1) ? bfhi(cu[i >> 1]) : bflo(cu[i >> 1]);
        float nbv = 0.f;
        if (nval[i & 3]) nbv = bf2f(p.proj[nrow[i & 3] * INC + col + i]);
        v[i] = z + (nbv - z) * mm[i];
      }
    }
    const int head = lane >> 3;
    float bs = p.bsc[(size_t)row * 8 + head] + p.bsc[((size_t)NLAT + row) * 8 + head];
    {
      float4 w0 = *(const float4*)(p.rw_ln_w + c8), w1 = *(const float4*)(p.rw_ln_w + c8 + 4);
      float4 b0 = *(const float4*)(p.rw_ln_b + c8), b1 = *(const float4*)(p.rw_ln_b + c8 + 4);
      float lw[8] = {w0.x, w0.y, w0.z, w0.w, w1.x, w1.y, w1.z, w1.w};
      float lb[8] = {b0.x, b0.y, b0.z, b0.w, b1.x, b1.y, b1.z, b1.w};
      float o[8];
#pragma unroll
      for (int i = 0; i < 8; ++i) o[i] = (y[i] - mu) * rs * lw[i] + lb[i] + bs * v[i];
      *(uint4*)(p.yrwf + (size_t)row * 512 + c8) = make_uint4(pack2(o[0], o[1]), pack2(o[2], o[3]), pack2(o[4], o[5]), pack2(o[6], o[7]));
    }
    if (lane < 16) {
      unsigned ou[4] = {0u, 0u, 0u, 0u};
      if (lane < 12) {
        int col = 512 + 1600 + c8;
        uint4 cz = *(const uint4*)(p.proj + (size_t)row * INC + col);
        unsigned cu[4] = {cz.x, cz.y, cz.z, cz.w};
        float4 m0 = *(const float4*)(p.rw_mu + 1600 + c8), m1 = *(const float4*)(p.rw_mu + 1600 + c8 + 4);
        float mm[8] = {m0.x, m0.y, m0.z, m0.w, m1.x, m1.y, m1.z, m1.w};
        float gsig[8];
#pragma unroll
        for (int i = 0; i < 8; ++i) {
          float z = (i & 1) ? bfhi(cu[i >> 1]) : bflo(cu[i >> 1]);
          float nbv = 0.f;
          if (nval[i & 3]) nbv = bf2f(p.proj[nrow[i & 3] * INC + col + i]);
          float zm = z + (nbv - z) * mm[i];
          gsig[i] = 1.f / (1.f + expf(-zm));
        }
#pragma unroll
        for (int q = 0; q < 4; ++q) ou[q] = pack2(gsig[2 * q], gsig[2 * q + 1]);
      }
      *(uint4*)(p.sg + (size_t)row * 128 + c8) = make_uint4(ou[0], ou[1], ou[2], ou[3]);
    }
  }
}

__constant__ unsigned char CAND_I[52] = {0,0,0,0,0,0,0,0,0,0,0,0,0,0,0,0, 1,1,1,1,1,1,1,1, 2,2,2,2,2, 3,3,3,3, 4,4,4, 5,5, 6,6, 7,7, 8,9,10,11,12,13,14,15, 0,0};
__constant__ unsigned char CAND_J[52] = {0,1,2,3,4,5,6,7,8,9,10,11,12,13,14,15, 0,1,2,3,4,5,6,7, 0,1,2,3,4, 0,1,2,3, 0,1,2, 0,1, 0,1, 0,1, 0,0,0,0,0,0,0,0, 0,0};

#define SC_LD 132
__device__ __forceinline__ void ph_route(const P& p, char* smem, int bid, int nb) {
  float* SC = (float*)smem;
  float* TS = (float*)(smem + 2 * 64 * SC_LD * 4);
  int* TI = (int*)(TS + 2 * 64 * 16);
  const u16* Q = p.proj;
  const int tid = threadIdx.x, wid = tid >> 6, lane = tid & 63, fr = lane & 15, fq = lane >> 4;
  for (int item = bid; item < 1024 * 8; item += nb) {
    const int h = item & 7, row0 = (item >> 3) * 64;
    {
      const int c = wid >> 2, mrow = (wid & 3) * 16;
      f32x4 acc[8];
#pragma unroll
      for (int ni = 0; ni < 8; ++ni) acc[ni] = (f32x4){0.f, 0.f, 0.f, 0.f};
#pragma unroll
      for (int ks = 0; ks < 4; ++ks) {
        bf16x8 a = *(const bf16x8*)(Q + (size_t)(row0 + mrow + fr) * 2048 + h * 256 + c * 128 + ks * 32 + fq * 8);
#pragma unroll
        for (int ni = 0; ni < 8; ++ni) {
          bf16x8 bfr = *(const bf16x8*)(p.keys + ((size_t)(h * 2 + c) * 128 + ni * 16 + fr) * 128 + ks * 32 + fq * 8);
          acc[ni] = __builtin_amdgcn_mfma_f32_16x16x32_bf16(a, bfr, acc[ni], 0, 0, 0);
        }
      }
#pragma unroll
      for (int ni = 0; ni < 8; ++ni)
#pragma unroll
        for (int j = 0; j < 4; ++j) SC[(c * 64 + mrow + fq * 4 + j) * SC_LD + ni * 16 + fr] = acc[ni][j];
    }
    __syncthreads();
    {
      const int task = tid >> 2, q4 = tid & 3;
      const int c = task >> 6, t = task & 63;
      float val[32];
#pragma unroll
      for (int i = 0; i < 32; ++i) val[i] = SC[(c * 64 + t) * SC_LD + i * 4 + q4];
      for (int r = 0; r < 16; ++r) {
        float m = val[0];
#pragma unroll
        for (int i = 1; i < 32; ++i) m = fmaxf(m, val[i]);
        int li = 31;
#pragma unroll
        for (int i = 30; i >= 0; --i) li = (val[i] == m) ? i : li;
        int n = li * 4 + q4;
#pragma unroll
        for (int sh = 1; sh <= 2; sh <<= 1) {
          float om = __shfl_xor(m, sh, 64);
          int on = __shfl_xor(n, sh, 64);
          bool take = (om > m) || (om == m && on < n);
          m = take ? om : m;
          n = take ? on : n;
        }
        const int wi = n >> 2;
        const bool mine = (n & 3) == q4;
#pragma unroll
        for (int i = 0; i < 32; ++i) val[i] = (mine && i == wi) ? -INFINITY : val[i];
        if (q4 == (r & 3)) {
          TS[(c * 64 + t) * 16 + r] = m;
          TI[(c * 64 + t) * 16 + r] = n;
        }
      }
    }
    __syncthreads();
    if (tid < 256) {
      const int t = tid >> 2, q4 = tid & 3;
      float val[13];
      int cid[13];
#pragma unroll
      for (int e = 0; e < 13; ++e) {
        int ci = q4 + 4 * e;
        if (ci < 50) {
          int i = CAND_I[ci], j = CAND_J[ci];
          val[e] = TS[t * 16 + i] + TS[(64 + t) * 16 + j];
          cid[e] = i * 16 + j;
        } else { val[e] = -INFINITY; cid[e] = 1 << 20; }
      }
      float bs_[16];
      int bi_[16];
#pragma unroll
      for (int r = 0; r < 16; ++r) {
        float m = val[0]; int f = cid[0]; int le = 0;
#pragma unroll
        for (int e = 1; e < 13; ++e) {
          bool take = (val[e] > m) || (val[e] == m && cid[e] < f);
          m = take ? val[e] : m; f = take ? cid[e] : f; le = take ? e : le;
        }
        float wm = m; int wf = f;
#pragma unroll
        for (int sh = 1; sh <= 2; sh <<= 1) {
          float om = __shfl_xor(wm, sh, 64);
          int of = __shfl_xor(wf, sh, 64);
          bool take = (om > wm) || (om == wm && of < wf);
          wm = take ? om : wm; wf = take ? of : wf;
        }
        const bool mine = (wf == f) && (wm == m);
#pragma unroll
        for (int e = 0; e < 13; ++e) val[e] = (mine && e == le) ? -INFINITY : val[e];
        bs_[r] = wm; bi_[r] = wf;
      }
      float den = 0.f, ex[16];
#pragma unroll
      for (int r = 0; r < 16; ++r) { ex[r] = __expf(bs_[r] - bs_[0]); den += ex[r]; }
      float rden = 1.f / den;
      const size_t obase = ((size_t)(row0 + t) * 8 + h) * 16;
#pragma unroll
      for (int r = 0; r < 16; ++r) {
        if ((r & 3) == q4) {
          int i = bi_[r] >> 4, j = bi_[r] & 15;
          p.idx[obase + r] = TI[t * 16 + i] * 128 + TI[(64 + t) * 16 + j];
          p.gate[obase + r] = ex[r] * rden;
        }
      }
    }
    __syncthreads();
  }
}

__device__ __forceinline__ void ph_ffn(const P& p, int bid, int nb) {
  const int wid = threadIdx.x >> 6, lane = threadIdx.x & 63;
  const u16* H2N = p.hn;
  for (int row = bid * 8 + wid; row < NLAT; row += nb * 8) {
    float hx[16];
    {
      uint4 a = *(const uint4*)(H2N + (size_t)row * 1024 + lane * 8), b2 = *(const uint4*)(H2N + (size_t)row * 1024 + 512 + lane * 8);
      unsigned au[8] = {a.x, a.y, a.z, a.w, b2.x, b2.y, b2.z, b2.w};
#pragma unroll
      for (int q = 0; q < 8; ++q) { hx[2 * q] = bflo(au[q]); hx[2 * q + 1] = bfhi(au[q]); }
    }
    int id0 = p.idx[(size_t)row * 128 + lane], id1 = p.idx[(size_t)row * 128 + 64 + lane];
    float g0 = p.gate[(size_t)row * 128 + lane], g1 = p.gate[(size_t)row * 128 + 64 + lane];
    float oacc[16];
#pragma unroll
    for (int i = 0; i < 16; ++i) oacc[i] = 0.f;
    for (int e0 = 0; e0 < 128; e0 += 4) {
      uint4 ur[4][2], vr[4][2];
      float gt[4];
#pragma unroll
      for (int q = 0; q < 4; ++q) {
        int e = e0 + q;
        int id = __shfl((e < 64) ? id0 : id1, e & 63, 64);
        gt[q] = __shfl((e < 64) ? g0 : g1, e & 63, 64);
        const u16* up = p.utab + (size_t)id * 1024 + lane * 8;
        const u16* vp = p.vtab + (size_t)id * 1024 + lane * 8;
        ur[q][0] = *(const uint4*)up; ur[q][1] = *(const uint4*)(up + 512);
        vr[q][0] = *(const uint4*)vp; vr[q][1] = *(const uint4*)(vp + 512);
      }
      float dot[4];
#pragma unroll
      for (int q = 0; q < 4; ++q) {
        unsigned uu[8] = {ur[q][0].x, ur[q][0].y, ur[q][0].z, ur[q][0].w, ur[q][1].x, ur[q][1].y, ur[q][1].z, ur[q][1].w};
        float s0 = 0.f, s1 = 0.f;
#pragma unroll
        for (int k = 0; k < 8; ++k) { s0 += hx[2 * k] * bflo(uu[k]); s1 += hx[2 * k + 1] * bfhi(uu[k]); }
        dot[q] = s0 + s1;
      }
#pragma unroll
      for (int m = 32; m >= 1; m >>= 1) {
#pragma unroll
        for (int q = 0; q < 4; ++q) dot[q] += __shfl_xor(dot[q], m, 64);
      }
#pragma unroll
      for (int q = 0; q < 4; ++q) {
        float cf = gt[q] * gelu_exact(dot[q]);
        unsigned vv[8] = {vr[q][0].x, vr[q][0].y, vr[q][0].z, vr[q][0].w, vr[q][1].x, vr[q][1].y, vr[q][1].z, vr[q][1].w};
#pragma unroll
        for (int k = 0; k < 8; ++k) { oacc[2 * k] += cf * bflo(vv[k]); oacc[2 * k + 1] += cf * bfhi(vv[k]); }
      }
    }
    const int b = row >> 11;
    float h3[16];
    float ss = 0.f;
#pragma unroll
    for (int hf = 0; hf < 2; ++hf) {
      int col = hf * 512 + lane * 8;
      float4 a0 = *(const float4*)(p.out + (size_t)row * 1024 + col), a1 = *(const float4*)(p.out + (size_t)row * 1024 + col + 4);
      float4 q0 = *(const float4*)(p.mod + b * 6144 + 5 * 1024 + col), q1 = *(const float4*)(p.mod + b * 6144 + 5 * 1024 + col + 4);
      float hv[8] = {a0.x, a0.y, a0.z, a0.w, a1.x, a1.y, a1.z, a1.w};
      float gv[8] = {q0.x, q0.y, q0.z, q0.w, q1.x, q1.y, q1.z, q1.w};
#pragma unroll
      for (int i = 0; i < 8; ++i) {
        float v = hv[i] + gv[i] * oacc[hf * 8 + i];
        h3[hf * 8 + i] = v;
        ss += v * v;
      }
    }
    ss = wave_sum(ss);
    float rstd = rsqrtf(ss * (1.f / 1024.f) + 1e-6f);
#pragma unroll
    for (int hf = 0; hf < 2; ++hf) {
      int col = hf * 512 + lane * 8;
      float4 n0 = *(const float4*)(p.norm_f_g + col), n1 = *(const float4*)(p.norm_f_g + col + 4);
      float4 o0 = make_float4(h3[hf * 8 + 0] * rstd * n0.x, h3[hf * 8 + 1] * rstd * n0.y, h3[hf * 8 + 2] * rstd * n0.z, h3[hf * 8 + 3] * rstd * n0.w);
      float4 o1 = make_float4(h3[hf * 8 + 4] * rstd * n1.x, h3[hf * 8 + 5] * rstd * n1.y, h3[hf * 8 + 6] * rstd * n1.z, h3[hf * 8 + 7] * rstd * n1.w);
      *(float4*)(p.out + (size_t)row * 1024 + col) = o0;
      *(float4*)(p.out + (size_t)row * 1024 + col + 4) = o1;
    }
  }
}

#define NPHASES 11
template <int PH>
__device__ __forceinline__ void run_phase(const P& p, char* smem, int bid, int nb) {
  if (PH == 0) ph_prep(p, smem, bid, nb);
  if (PH == 1) ph_norm(p, 0, bid, nb);
  if (PH == 2) gemm_phase(p.hn, 1024, p.win_t, 1024, 1024, NTOK, INCP, smem, bid, nb, EpiProj{p.proj});
  if (PH == 3) { ph_s5scan(p, smem, bid, nb); ph_rwscan(p, smem, bid, nb); }
  if (PH == 4) ph_mixprep(p, bid, nb);
  if (PH == 5) {
    gemm_phase(p.ys5f, 512, p.wglu_t, 512, 512, NLAT, 512, smem, bid, nb, EpiGlu{p.ys5f, p.s5_b_glu, p.hn});
    gemm_phase(p.sg, 128, p.wg2_t, 128, 128, NLAT, 512, smem, bid, nb, EpiGate{p.yrwf, p.hn});
  }
  if (PH == 6) gemm_phase(p.hn, 1024, p.wout_t, 1024, 1024, NLAT, 1024, smem, bid, nb, EpiWout{p.x, p.mod, p.out});
  if (PH == 7) ph_norm(p, 1, bid, nb);
  if (PH == 8) gemm_phase(p.hn, 1024, p.wq_t, 1024, 1024, NLAT, 2048, smem, bid, nb, EpiQ{p.proj});
  if (PH == 9) ph_route(p, smem, bid, nb);
  if (PH == 10) ph_ffn(p, bid, nb);
}
#define PHASE(n) if (ph_lo <= n && n < ph_hi) { if (n > ph_lo) grid.sync(); run_phase<n>(p, smem, bid, nb); }
__global__ void __launch_bounds__(NTHREADS) mega(P p, int ph_lo, int ph_hi) {
  extern __shared__ __attribute__((aligned(16))) char smem[];
  cg::grid_group grid = cg::this_grid();
  const int bid = blockIdx.x, nb = gridDim.x;
  PHASE(0) PHASE(1) PHASE(2) PHASE(3) PHASE(4) PHASE(5) PHASE(6) PHASE(7) PHASE(8) PHASE(9) PHASE(10)
}

extern "C" void kernel_launch(void* const* d_in, const int* in_sizes, int n_in, void* d_out, int out_size, void* d_ws,
                              size_t ws_size, hipStream_t stream) {
  static int grid_blocks = 0;
  if (!grid_blocks) {
    int dev = 0, cus = 0, per_cu = 0;
    hipGetDevice(&dev);
    hipDeviceGetAttribute(&cus, hipDeviceAttributeMultiprocessorCount, dev);
    hipFuncSetAttribute((const void*)mega, hipFuncAttributeMaxDynamicSharedMemorySize, LDS_BYTES);
    hipOccupancyMaxActiveBlocksPerMultiprocessor(&per_cu, (const void*)mega, NTHREADS, LDS_BYTES);
    if (per_cu < 1) { fprintf(stderr, "occupancy query returned %d\n", per_cu); per_cu = 1; }
    grid_blocks = cus;
  }
  P p{};
  const float** fp = (const float**)&p;
  for (int i = 0; i < 36; ++i) fp[i] = (const float*)d_in[i];
  p.out = (float*)d_out;
  char* w = (char*)d_ws;
  size_t off = 0;
  auto take = [&](size_t bytes) { char* r = w + off; off += (bytes + 255) & ~(size_t)255; return r; };
  p.mod = (float*)take(33 * 6144 * 4);
  p.win_t = (u16*)take((size_t)INCP * 1024 * 2);
  p.wout_t = (u16*)take((size_t)1024 * 1024 * 2);
  p.wq_t = (u16*)take((size_t)2048 * 1024 * 2);
  p.wglu_t = (u16*)take((size_t)512 * 512 * 2);
  p.wg2_t = (u16*)take((size_t)512 * 128 * 2);
  p.keys = (u16*)take((size_t)8 * 2 * 128 * 128 * 2);
  p.utab = (u16*)take((size_t)16384 * 1024 * 2);
  p.vtab = (u16*)take((size_t)16384 * 1024 * 2);
  p.s5ab = (float*)take(4096 * 2 * 4);
  p.s5bb = (float*)take(4096 * 32 * 4);
  p.s5ct = (u16*)take(2 * 32 * 16 * 128 * 2);
  p.hn = (u16*)take((size_t)NTOK * 1024 * 2);
  p.proj = (u16*)take((size_t)NTOK * INC * 2);
  p.ys5f = (u16*)take((size_t)NLAT * 512 * 2);
  p.ys5b = (u16*)take((size_t)NLAT * 512 * 2);
  p.yrwf = (u16*)take((size_t)NLAT * 512 * 2);
  p.yrwb = (u16*)take((size_t)NLAT * 512 * 2);
  p.bsc = (float*)take((size_t)2 * NLAT * 8 * 4);
  p.sg = (u16*)take((size_t)NLAT * 128 * 2);
  p.idx = (int*)p.ys5b;
  p.gate = (float*)p.yrwb;
  if (off > ws_size) { fprintf(stderr, "workspace too small: need %zu have %zu\n", off, ws_size); return; }
#if MEGA
  int lo = 0, hi = NPHASES;
  void* args[] = {&p, &lo, &hi};
  hipError_t e = hipLaunchCooperativeKernel((const void*)mega, dim3(grid_blocks), dim3(NTHREADS), args, LDS_BYTES, stream);
  if (e != hipSuccess) fprintf(stderr, "cooperative launch failed: %s (grid %d)\n", hipGetErrorString(e), grid_blocks);
#else
  for (int ph = 0; ph < NPHASES; ++ph) {
    hipLaunchKernelGGL(mega, dim3(grid_blocks), dim3(NTHREADS), LDS_BYTES, stream, p, ph, ph + 1);
  }
#endif
}
```

```cpp
#include <hip/hip_runtime.h>
#include <hip/hip_cooperative_groups.h>
#include <stdint.h>
#include <stdio.h>
namespace cg = cooperative_groups;

#ifndef MEGA
#define MEGA 1
#endif

typedef unsigned short u16;
using bf16x8 = __attribute__((ext_vector_type(8))) short;
using f32x4 = __attribute__((ext_vector_type(4))) float;
using u32x4 = __attribute__((ext_vector_type(4))) unsigned;

#define DM 1024
#define NLAT 65536
#define NCTX 8192
#define NTOK 73728
#define INC 2208
#define INCP 2304
#define NTHREADS 512
#define LDS_BYTES 131072

struct P {
  const float *x, *c, *ctx, *c_ctx, *w_ada, *b_ada, *norm1_g, *norm2_g, *w_in, *s5_a_re, *s5_a_im, *s5_log_dt,
      *s5_b_re, *s5_b_im, *s5_c_re, *s5_c_im, *s5_d, *s5_w_glu, *s5_b_glu, *rw_mu, *rw_w0, *rw_w_w2, *rw_a0, *rw_w_a2,
      *rw_w_g2, *rw_k_k, *rw_k_a, *rw_r_k, *rw_ln_w, *rw_ln_b, *w_out, *peer_w_q, *peer_keys, *peer_u, *peer_v, *norm_f_g;
  float* out;
  float* mod;
  u16 *win_t, *wout_t, *wq_t, *wglu_t, *wg2_t, *keys, *utab, *vtab;
  float *s5ab, *s5bb;
  u16* s5ct;
  u16 *hn, *proj, *ys5f, *ys5b, *yrwf, *yrwb;
  float* bsc;
  u16* sg;
  int* idx;
  float* gate;
};

__device__ __forceinline__ u16 f2bf(float f) {
  unsigned u = __float_as_uint(f);
  u += 0x7fffu + ((u >> 16) & 1u);
  return (u16)(u >> 16);
}
__device__ __forceinline__ float bf2f(u16 h) { return __uint_as_float(((unsigned)h) << 16); }
__device__ __forceinline__ unsigned pack2(float a, float b) { return (unsigned)f2bf(a) | ((unsigned)f2bf(b) << 16); }
__device__ __forceinline__ float bflo(unsigned u) { return __uint_as_float(u << 16); }
__device__ __forceinline__ float bfhi(unsigned u) { return __uint_as_float(u & 0xffff0000u); }
__device__ __forceinline__ float wave_sum(float v) {
#pragma unroll
  for (int m = 32; m >= 1; m >>= 1) v += __shfl_xor(v, m, 64);
  return v;
}
__device__ __forceinline__ float gelu_exact(float x) { return 0.5f * x * (1.f + erff(x * 0.70710678118654752f)); }
__device__ __forceinline__ float sigmoidf(float x) { return 1.f / (1.f + __expf(-x)); }

__device__ __forceinline__ void transpose_tiles(const float* __restrict__ src, int K, int N, u16* __restrict__ dst, int Kd, int Npad,
                                char* smem, int bid, int nb) {
  float* tile = (float*)smem;
  const int tid = threadIdx.x;
  const int nkt = Kd / 64, nnt = Npad / 64;
  for (int t = bid; t < nkt * nnt; t += nb) {
    int kt = t % nkt, nt = t / nkt;
    int k0 = kt * 64, n0 = nt * 64;
    __syncthreads();
#pragma unroll
    for (int it = 0; it < 8; ++it) {
      int i = (tid >> 6) + it * 8, j = tid & 63;
      int k = k0 + i, n = n0 + j;
      tile[i * 65 + j] = (k < K && n < N) ? src[(size_t)k * N + n] : 0.f;
    }
    __syncthreads();
    int n = tid >> 3, kc = (tid & 7) * 8;
    uint4 o;
    o.x = pack2(tile[(kc + 0) * 65 + n], tile[(kc + 1) * 65 + n]);
    o.y = pack2(tile[(kc + 2) * 65 + n], tile[(kc + 3) * 65 + n]);
    o.z = pack2(tile[(kc + 4) * 65 + n], tile[(kc + 5) * 65 + n]);
    o.w = pack2(tile[(kc + 6) * 65 + n], tile[(kc + 7) * 65 + n]);
    *(uint4*)(dst + (size_t)(n0 + n) * Kd + k0 + kc) = o;
  }
}

__device__ __forceinline__ void convert_bf16(const float* __restrict__ src, u16* __restrict__ dst, size_t n8, int bid, int nb) {
  for (size_t i = (size_t)bid * NTHREADS + threadIdx.x; i < n8; i += (size_t)nb * NTHREADS) {
    float4 a = *(const float4*)(src + i * 8), b = *(const float4*)(src + i * 8 + 4);
    uint4 o;
    o.x = pack2(a.x, a.y); o.y = pack2(a.z, a.w); o.z = pack2(b.x, b.y); o.w = pack2(b.z, b.w);
    *(uint4*)(dst + i * 8) = o;
  }
}

__device__ __forceinline__ void ph_prep(const P& p, char* smem, int bid, int nb) {
  const int tid = threadIdx.x;
  {
    float* sc = (float*)smem;
    float* red = (float*)(smem + 33 * 128 * 4);
    for (int item = bid; item < 96; item += nb) {
      const int j0 = item * 64, kg = tid >> 6, col = tid & 63;
      float acc[33];
#pragma unroll
      for (int b = 0; b < 33; ++b) acc[b] = 0.f;
      for (int ch = 0; ch < 8; ++ch) {
        __syncthreads();
        for (int e = tid; e < 33 * 128; e += NTHREADS) {
          int b = e >> 7, kk = e & 127;
          float cv = (b < 32) ? p.c[b * 1024 + ch * 128 + kk] : p.c_ctx[ch * 128 + kk];
          sc[e] = cv / (1.f + expf(-cv));
        }
        __syncthreads();
        for (int i = 0; i < 16; ++i) {
          int kk = kg * 16 + i;
          float w = p.w_ada[(size_t)(ch * 128 + kk) * 6144 + j0 + col];
#pragma unroll
          for (int b = 0; b < 33; ++b) acc[b] += sc[b * 128 + kk] * w;
        }
      }
#pragma unroll
      for (int b = 0; b < 33; ++b) red[(kg * 33 + b) * 64 + col] = acc[b];
      __syncthreads();
      for (int e = tid; e < 33 * 64; e += NTHREADS) {
        int b = e >> 6, cc = e & 63;
        float s = p.b_ada[j0 + cc];
#pragma unroll
        for (int k2 = 0; k2 < 8; ++k2) s += red[(k2 * 33 + b) * 64 + cc];
        p.mod[b * 6144 + j0 + cc] = s;
      }
      __syncthreads();
    }
  }
  transpose_tiles(p.w_in, 1024, INC, p.win_t, 1024, INCP, smem, bid, nb);
  transpose_tiles(p.w_out, 1024, 1024, p.wout_t, 1024, 1024, smem, bid, nb);
  transpose_tiles(p.peer_w_q, 1024, 2048, p.wq_t, 1024, 2048, smem, bid, nb);
  transpose_tiles(p.s5_w_glu, 512, 512, p.wglu_t, 512, 512, smem, bid, nb);
  transpose_tiles(p.rw_w_g2, 96, 512, p.wg2_t, 128, 512, smem, bid, nb);
  convert_bf16(p.peer_keys, p.keys, (size_t)8 * 2 * 128 * 128 / 8, bid, nb);
  convert_bf16(p.peer_u, p.utab, (size_t)16384 * 1024 / 8, bid, nb);
  convert_bf16(p.peer_v, p.vtab, (size_t)16384 * 1024 / 8, bid, nb);
  for (int it = bid * NTHREADS + tid; it < 4096; it += nb * NTHREADS) {
    int pp = it & 63, g = (it >> 6) & 31, d = it >> 11;
    float are = p.s5_a_re[it], aim = p.s5_a_im[it];
    float dt = expf(p.s5_log_dt[d * 32 + g]);
    float mag = expf(dt * are);
    float abr = mag * cosf(dt * aim), abi = mag * sinf(dt * aim);
    float nr = abr - 1.f, ni = abi;
    float den = are * are + aim * aim;
    float cfr = (nr * are + ni * aim) / den, cfi = (ni * are - nr * aim) / den;
    p.s5ab[it * 2] = abr;
    p.s5ab[it * 2 + 1] = abi;
    for (int h = 0; h < 16; ++h) {
      float br = p.s5_b_re[(size_t)it * 16 + h], bi = p.s5_b_im[(size_t)it * 16 + h];
      p.s5bb[(size_t)it * 32 + h] = cfr * br - cfi * bi;
      p.s5bb[(size_t)it * 32 + 16 + h] = cfr * bi + cfi * br;
    }
    for (int h = 0; h < 16; ++h) {
      size_t ci = ((size_t)(d * 32 + g) * 16 + h) * 64 + pp;
      p.s5ct[((size_t)(d * 32 + g) * 16 + h) * 128 + 2 * pp] = f2bf(p.s5_c_re[ci]);
      p.s5ct[((size_t)(d * 32 + g) * 16 + h) * 128 + 2 * pp + 1] = f2bf(-p.s5_c_im[ci]);
    }
  }
}

__device__ __forceinline__ void ph_norm(const P& p, int mode, int bid, int nb) {
  const int wid = threadIdx.x >> 6, lane = threadIdx.x & 63;
  const int nrows = mode == 0 ? NTOK : NLAT;
  const float* gvec = mode == 0 ? p.norm1_g : p.norm2_g;
  const int sh_off = mode == 0 ? 0 : 3 * 1024, sc_off = sh_off + 1024;
  for (int row = bid * 8 + wid; row < nrows; row += nb * 8) {
    const float* src;
    int b;
    if (mode == 0) {
      if (row < NLAT) { src = p.x + (size_t)row * 1024; b = row >> 11; }
      else { src = p.ctx + (size_t)(row - NLAT) * 1024; b = 32; }
    } else { src = p.out + (size_t)row * 1024; b = row >> 11; }
    float4 v[4];
    float ss = 0.f;
#pragma unroll
    for (int j = 0; j < 4; ++j) {
      v[j] = *(const float4*)(src + j * 256 + lane * 4);
      ss += v[j].x * v[j].x + v[j].y * v[j].y + v[j].z * v[j].z + v[j].w * v[j].w;
    }
    ss = wave_sum(ss);
    float rstd = rsqrtf(ss * (1.f / 1024.f) + 1e-6f);
    const float* mrow = p.mod + b * 6144;
#pragma unroll
    for (int j = 0; j < 4; ++j) {
      int col = j * 256 + lane * 4;
      float4 g = *(const float4*)(gvec + col);
      float4 sh = *(const float4*)(mrow + sh_off + col);
      float4 sc = *(const float4*)(mrow + sc_off + col);
      float y0 = v[j].x * rstd * g.x * (1.f + sc.x) + sh.x;
      float y1 = v[j].y * rstd * g.y * (1.f + sc.y) + sh.y;
      float y2 = v[j].z * rstd * g.z * (1.f + sc.z) + sh.z;
      float y3 = v[j].w * rstd * g.w * (1.f + sc.w) + sh.w;
      uint2 o;
      o.x = pack2(y0, y1); o.y = pack2(y2, y3);
      *(uint2*)(p.hn + (size_t)row * 1024 + col) = o;
    }
  }
}

#define G_BM 256
#define G_BN 128
#define G_BK 64
#define G_LD 72
template <class Epi>
__device__ __forceinline__ void gemm_phase(const u16* __restrict__ A, int lda, const u16* __restrict__ Bt, int ldb, int K, int M, int N,
                           char* smem, int bid, int nb, Epi epi) {
  u16* As = (u16*)smem;
  u16* Bs = (u16*)(smem + 2 * G_BM * G_LD * 2);
  const int tid = threadIdx.x, wid = tid >> 6, lane = tid & 63;
  const int wr = wid >> 1, wc = wid & 1, fr = lane & 15, fq = lane >> 4;
  const int ntn = N / G_BN, ntiles = (M / G_BM) * ntn, nk = K / G_BK;
  const int lrow = tid >> 3, lkc = (tid & 7) * 8;
  for (int tile = bid; tile < ntiles; tile += nb) {
    const int m0 = (tile / ntn) * G_BM, n0 = (tile % ntn) * G_BN;
    f32x4 acc[4][4];
#pragma unroll
    for (int i = 0; i < 4; ++i)
#pragma unroll
      for (int j = 0; j < 4; ++j) acc[i][j] = (f32x4){0.f, 0.f, 0.f, 0.f};
    u32x4 ra[4], rb[2];
    const u16* Ag = A + (size_t)(m0 + lrow) * lda + lkc;
    const u16* Bg = Bt + (size_t)(n0 + lrow) * ldb + lkc;
#pragma unroll
    for (int i = 0; i < 4; ++i) ra[i] = *(const u32x4*)(Ag + (size_t)(64 * i) * lda);
#pragma unroll
    for (int i = 0; i < 2; ++i) rb[i] = *(const u32x4*)(Bg + (size_t)(64 * i) * ldb);
    __syncthreads();
#pragma unroll
    for (int i = 0; i < 4; ++i) *(u32x4*)(As + (lrow + 64 * i) * G_LD + lkc) = ra[i];
#pragma unroll
    for (int i = 0; i < 2; ++i) *(u32x4*)(Bs + (lrow + 64 * i) * G_LD + lkc) = rb[i];
    __syncthreads();
    for (int kt = 0; kt < nk; ++kt) {
      const int buf = kt & 1;
      if (kt + 1 < nk) {
#pragma unroll
        for (int i = 0; i < 4; ++i) ra[i] = *(const u32x4*)(Ag + (size_t)(64 * i) * lda + (kt + 1) * G_BK);
#pragma unroll
        for (int i = 0; i < 2; ++i) rb[i] = *(const u32x4*)(Bg + (size_t)(64 * i) * ldb + (kt + 1) * G_BK);
      }
      const u16* as = As + buf * (G_BM * G_LD);
      const u16* bs = Bs + buf * (G_BN * G_LD);
#pragma unroll
      for (int ks = 0; ks < 2; ++ks) {
        bf16x8 af[4], bfr[4];
#pragma unroll
        for (int mi = 0; mi < 4; ++mi) af[mi] = *(const bf16x8*)(as + (wr * 64 + mi * 16 + fr) * G_LD + ks * 32 + fq * 8);
#pragma unroll
        for (int ni = 0; ni < 4; ++ni) bfr[ni] = *(const bf16x8*)(bs + (wc * 64 + ni * 16 + fr) * G_LD + ks * 32 + fq * 8);
#pragma unroll
        for (int mi = 0; mi < 4; ++mi)
#pragma unroll
          for (int ni = 0; ni < 4; ++ni)
            acc[mi][ni] = __builtin_amdgcn_mfma_f32_16x16x32_bf16(af[mi], bfr[ni], acc[mi][ni], 0, 0, 0);
      }
      if (kt + 1 < nk) {
        u16* as2 = As + (buf ^ 1) * (G_BM * G_LD);
        u16* bs2 = Bs + (buf ^ 1) * (G_BN * G_LD);
#pragma unroll
        for (int i = 0; i < 4; ++i) *(u32x4*)(as2 + (lrow + 64 * i) * G_LD + lkc) = ra[i];
#pragma unroll
        for (int i = 0; i < 2; ++i) *(u32x4*)(bs2 + (lrow + 64 * i) * G_LD + lkc) = rb[i];
      }
      __syncthreads();
    }
#pragma unroll
    for (int mi = 0; mi < 4; ++mi)
#pragma unroll
      for (int ni = 0; ni < 4; ++ni) epi(m0 + wr * 64 + mi * 16 + fq * 4, n0 + wc * 64 + ni * 16 + fr, acc[mi][ni]);
  }
}

struct EpiProj {
  u16* proj;
  __device__ __forceinline__ void operator()(int r, int c, f32x4 v) const {
    if (c < INC) {
#pragma unroll
      for (int j = 0; j < 4; ++j) proj[(size_t)(r + j) * INC + c] = f2bf(v[j]);
    }
  }
};
struct EpiGlu {
  const u16* y1; const float* bglu; u16* a2;
  __device__ __forceinline__ void operator()(int r, int c, f32x4 v) const {
    float bb = bglu[c];
#pragma unroll
    for (int j = 0; j < 4; ++j) {
      float y = bf2f(y1[(size_t)(r + j) * 512 + c]);
      a2[(size_t)(r + j) * 1024 + c] = f2bf(y * sigmoidf(v[j] + bb));
    }
  }
};
struct EpiGate {
  const u16* t1; u16* a2;
  __device__ __forceinline__ void operator()(int r, int c, f32x4 v) const {
#pragma unroll
    for (int j = 0; j < 4; ++j) {
      float t = bf2f(t1[(size_t)(r + j) * 512 + c]);
      a2[(size_t)(r + j) * 1024 + 512 + c] = f2bf(t * v[j]);
    }
  }
};
struct EpiWout {
  const float* x; const float* mod; float* h2;
  __device__ __forceinline__ void operator()(int r, int c, f32x4 v) const {
    float g1 = mod[(r >> 11) * 6144 + 2 * 1024 + c];
#pragma unroll
    for (int j = 0; j < 4; ++j) h2[(size_t)(r + j) * 1024 + c] = x[(size_t)(r + j) * 1024 + c] + g1 * v[j];
  }
};
struct EpiQ {
  u16* q;
  __device__ __forceinline__ void operator()(int r, int c, f32x4 v) const {
#pragma unroll
    for (int j = 0; j < 4; ++j) q[(size_t)(r + j) * 2048 + c] = f2bf(v[j]);
  }
};

__device__ __forceinline__ void ph_s5scan(const P& p, char* smem, int bid, int nb) {
  const int wid = threadIdx.x >> 6, lane = threadIdx.x & 63;
  float* U = (float*)(smem + wid * 8448);
  unsigned* H = (unsigned*)((char*)U + 4096);
  const int fr = lane & 15, fq = lane >> 4;
  for (int s = bid * 8 + wid; s < 2048; s += nb * 8) {
    const int g = s & 31, d = (s >> 5) & 1, b = s >> 6;
    const int ci = (d * 32 + g) * 64 + lane;
    const float abr = p.s5ab[ci * 2], abi = p.s5ab[ci * 2 + 1];
    float bbr[16], bbi[16];
#pragma unroll
    for (int q = 0; q < 4; ++q) {
      float4 t = *(const float4*)(p.s5bb + (size_t)ci * 32 + q * 4);
      bbr[q * 4] = t.x; bbr[q * 4 + 1] = t.y; bbr[q * 4 + 2] = t.z; bbr[q * 4 + 3] = t.w;
      float4 t2 = *(const float4*)(p.s5bb + (size_t)ci * 32 + 16 + q * 4);
      bbi[q * 4] = t2.x; bbi[q * 4 + 1] = t2.y; bbi[q * 4 + 2] = t2.z; bbi[q * 4 + 3] = t2.w;
    }
    bf16x8 cf[4];
#pragma unroll
    for (int kb = 0; kb < 4; ++kb)
      cf[kb] = *(const bf16x8*)(p.s5ct + ((size_t)(d * 32 + g) * 16 + fr) * 128 + kb * 32 + fq * 8);
    const float dcoef = p.s5_d[g * 16 + fr];
    u16* ydst = d ? p.ys5b : p.ys5f;
    float hr = 0.f, hi = 0.f;
    for (int seg = 0; seg < 2; ++seg) {
      const int L = seg ? 2048 : 256;
      const int rowbase = seg ? b * 2048 : NLAT + b * 256;
      for (int c0 = 0; c0 < L; c0 += 64) {
        {
          int pos = c0 + lane;
          int t = d ? (L - 1 - pos) : pos;
          const u16* src = p.proj + (size_t)(rowbase + t) * INC + g * 16;
          uint4 v0 = *(const uint4*)src, v1 = *(const uint4*)(src + 8);
          float4* ud = (float4*)(U + lane * 16);
          ud[0] = make_float4(bflo(v0.x), bfhi(v0.x), bflo(v0.y), bfhi(v0.y));
          ud[1] = make_float4(bflo(v0.z), bfhi(v0.z), bflo(v0.w), bfhi(v0.w));
          ud[2] = make_float4(bflo(v1.x), bfhi(v1.x), bflo(v1.y), bfhi(v1.y));
          ud[3] = make_float4(bflo(v1.z), bfhi(v1.z), bflo(v1.w), bfhi(v1.w));
        }
        for (int sub = 0; sub < 4; ++sub) {
#pragma unroll 4
          for (int i = 0; i < 16; ++i) {
            const float4* up = (const float4*)(U + (sub * 16 + i) * 16);
            float4 u0 = up[0], u1 = up[1], u2 = up[2], u3 = up[3];
            float ur[16] = {u0.x, u0.y, u0.z, u0.w, u1.x, u1.y, u1.z, u1.w, u2.x, u2.y, u2.z, u2.w, u3.x, u3.y, u3.z, u3.w};
            float br0 = 0.f, br1 = 0.f, bi0 = 0.f, bi1 = 0.f;
#pragma unroll
            for (int h = 0; h < 16; h += 2) {
              br0 += bbr[h] * ur[h]; br1 += bbr[h + 1] * ur[h + 1];
              bi0 += bbi[h] * ur[h]; bi1 += bbi[h + 1] * ur[h + 1];
            }
            float nr = abr * hr - abi * hi + (br0 + br1);
            float ni = abr * hi + abi * hr + (bi0 + bi1);
            hr = nr; hi = ni;
            if (seg) H[i * 68 + lane] = pack2(hr, hi);
          }
          if (seg) {
            f32x4 acc = (f32x4){0.f, 0.f, 0.f, 0.f};
#pragma unroll
            for (int kb = 0; kb < 4; ++kb) {
              bf16x8 a = *(const bf16x8*)((const u16*)H + fr * 136 + kb * 32 + fq * 8);
              acc = __builtin_amdgcn_mfma_f32_16x16x32_bf16(a, cf[kb], acc, 0, 0, 0);
            }
#pragma unroll
            for (int j = 0; j < 4; ++j) {
              int pi = sub * 16 + fq * 4 + j;
              int pos = c0 + pi;
              int t = d ? (L - 1 - pos) : pos;
              float y = acc[j];
              if (d == 0) y += dcoef * U[pi * 16 + fr];
              ydst[(size_t)(b * 2048 + t) * 512 + g * 16 + fr] = f2bf(y);
            }
          }
        }
      }
    }
  }
}

__device__ __forceinline__ float4 mix_load4(const u16* __restrict__ proj, size_t row, int col, const size_t* nrow,
                                            const bool* nval, float4 mu) {
  uint2 cz = *(const uint2*)(proj + row * INC + col);
  float z[4] = {bflo(cz.x), bfhi(cz.x), bflo(cz.y), bfhi(cz.y)};
  float o[4];
  float m[4] = {mu.x, mu.y, mu.z, mu.w};
#pragma unroll
  for (int j = 0; j < 4; ++j) {
    float nbv = 0.f;
    if (nval[j]) {
      u16 t = proj[nrow[j] * INC + col + j];
      nbv = bf2f(t);
    }
    o[j] = z[j] + (nbv - z[j]) * m[j];
  }
  return make_float4(o[0], o[1], o[2], o[3]);
}
__device__ __forceinline__ void neighbours(bool isctx, size_t row, int t, size_t* nrow, bool* nval) {
  if (isctx) {
    nrow[0] = row - 1; nval[0] = t > 0;
    nrow[1] = row + 1; nval[1] = t < 255;
    nrow[2] = row - 1; nval[2] = t > 0;
    nrow[3] = row + 1; nval[3] = t < 255;
  } else {
    int col = t & 63, gr = t >> 6;
    nrow[0] = row - 1; nval[0] = col > 0;
    nrow[1] = row + 1; nval[1] = col < 63;
    nrow[2] = row - 64; nval[2] = gr > 0;
    nrow[3] = row + 64; nval[3] = gr < 31;
  }
}

__device__ __forceinline__ void ph_rwscan(const P& p, char* smem, int bid, int nb) {
  const int tid = threadIdx.x, sl = tid >> 8, stid = tid & 255, wv = stid >> 6, lane = tid & 63;
  char* sb = smem + sl * 49152;
  float* OPS = (float*)sb;
  float* LW = (float*)(sb + 24576);
  float* LA = LW + 512;
  float* WW = (float*)(sb + 28672);
  float* WA = WW + 2048;
  float* YB = (float*)(sb + 45056);
  const int tt = stid >> 4, part = stid & 15;
  const int vrow = wv * 16 + (lane >> 2), kq = lane & 3;
  for (int sp = bid; sp < 256; sp += nb) {
    const int s = sp * 2 + sl;
    const int d = s & 1, h = (s >> 1) & 7, b = s >> 4;
    __syncthreads();
    for (int e = stid; e < 2048; e += 256) {
      int j = e >> 6, cc = e & 63;
      WW[e] = p.rw_w_w2[(size_t)(d * 32 + j) * 512 + h * 64 + cc];
      WA[e] = p.rw_w_a2[(size_t)(d * 32 + j) * 512 + h * 64 + cc];
    }
    const int hc = h * 64 + part * 4;
    const float4 w0v = *(const float4*)(p.rw_w0 + d * 512 + hc);
    const float4 a0v = *(const float4*)(p.rw_a0 + d * 512 + hc);
    const float4 kkv = *(const float4*)(p.rw_k_k + hc);
    const float4 kav = *(const float4*)(p.rw_k_a + hc);
    const float4 rkv = *(const float4*)(p.rw_r_k + hc);
    const float4 mur = *(const float4*)(p.rw_mu + hc);
    const float4 muk = *(const float4*)(p.rw_mu + 512 + hc);
    const float4 muv = *(const float4*)(p.rw_mu + 1024 + hc);
    const float4 mul = *(const float4*)(p.rw_mu + 1536 + part * 4);
    u16* ydst = d ? p.yrwb : p.yrwf;
    float S[16];
#pragma unroll
    for (int i = 0; i < 16; ++i) S[i] = 0.f;
    for (int seg = 0; seg < 2; ++seg) {
      const int L = seg ? 2048 : 256;
      const size_t rowbase = seg ? (size_t)b * 2048 : (size_t)NLAT + b * 256;
      for (int c0 = 0; c0 < L; c0 += 16) {
        const int pos = c0 + tt;
        const int t = d ? (L - 1 - pos) : pos;
        const size_t row = rowbase + t;
        size_t nrow[4];
        bool nval[4];
        neighbours(seg == 0, row, t, nrow, nval);
        float4 r4 = mix_load4(p.proj, row, 512 + hc, nrow, nval, mur);
        float4 k4 = mix_load4(p.proj, row, 512 + 512 + hc, nrow, nval, muk);
        float4 v4 = mix_load4(p.proj, row, 512 + 1024 + hc, nrow, nval, muv);
        float4 l4 = mix_load4(p.proj, row, 512 + 1536 + part * 4, nrow, nval, mul);
        if (part < 8) {
          *(float4*)(LW + tt * 32 + part * 4) = make_float4(tanhf(l4.x), tanhf(l4.y), tanhf(l4.z), tanhf(l4.w));
        } else {
          *(float4*)(LA + tt * 32 + (part - 8) * 4) = l4;
        }
        __syncthreads();
        float wp[4] = {w0v.x, w0v.y, w0v.z, w0v.w};
        float ap[4] = {a0v.x, a0v.y, a0v.z, a0v.w};
#pragma unroll 8
        for (int j = 0; j < 32; ++j) {
          float lw = LW[tt * 32 + j], la = LA[tt * 32 + j];
          float4 ww = *(const float4*)(WW + j * 64 + part * 4);
          float4 wa = *(const float4*)(WA + j * 64 + part * 4);
          wp[0] += lw * ww.x; wp[1] += lw * ww.y; wp[2] += lw * ww.z; wp[3] += lw * ww.w;
          ap[0] += la * wa.x; ap[1] += la * wa.y; ap[2] += la * wa.z; ap[3] += la * wa.w;
        }
        float rr[4] = {r4.x, r4.y, r4.z, r4.w}, kk4[4] = {k4.x, k4.y, k4.z, k4.w};
        float kkc[4] = {kkv.x, kkv.y, kkv.z, kkv.w}, kac[4] = {kav.x, kav.y, kav.z, kav.w}, rkc[4] = {rkv.x, rkv.y, rkv.z, rkv.w};
        float dec[4], aa[4], kd[4], kkr[4];
        float ss = 0.f, bon = 0.f;
#pragma unroll
        for (int i = 0; i < 4; ++i) {
          float xw = -wp[i];
          float sp_ = fmaxf(xw, 0.f) + log1pf(expf(-fabsf(xw)));
          float wl = -sp_ - 0.5f;
          dec[i] = expf(-expf(wl));
          aa[i] = 1.f / (1.f + expf(-ap[i]));
          kd[i] = kk4[i] * (1.f + (aa[i] - 1.f) * kac[i]);
          kkr[i] = kk4[i] * kkc[i];
          ss += kkr[i] * kkr[i];
          bon += rr[i] * kd[i] * rkc[i];
        }
#pragma unroll
        for (int m = 1; m < 16; m <<= 1) {
          ss += __shfl_xor(ss, m, 64);
          bon += __shfl_xor(bon, m, 64);
        }
        float inv = rsqrtf(ss + 1e-12f);
        float* o = OPS + tt * 384 + part * 4;
        *(float4*)(o + 0) = r4;
        *(float4*)(o + 64) = make_float4(dec[0], dec[1], dec[2], dec[3]);
        *(float4*)(o + 128) = make_float4(kd[0], kd[1], kd[2], kd[3]);
        *(float4*)(o + 192) = make_float4(-kkr[0] * inv, -kkr[1] * inv, -kkr[2] * inv, -kkr[3] * inv);
        *(float4*)(o + 256) = make_float4(kkr[0] * inv * aa[0], kkr[1] * inv * aa[1], kkr[2] * inv * aa[2], kkr[3] * inv * aa[3]);
        *(float4*)(o + 320) = v4;
        if (seg && part == 0) p.bsc[((size_t)d * NLAT + row) * 8 + h] = bon;
        __syncthreads();
        for (int i = 0; i < 16; ++i) {
          const float* oo = OPS + i * 384 + kq * 16;
          float kn[16], wv_[16], bv[16], kdv[16];
#pragma unroll
          for (int q = 0; q < 4; ++q) {
            float4 a = *(const float4*)(oo + 192 + q * 4);
            kn[q * 4] = a.x; kn[q * 4 + 1] = a.y; kn[q * 4 + 2] = a.z; kn[q * 4 + 3] = a.w;
            float4 w_ = *(const float4*)(oo + 64 + q * 4);
            wv_[q * 4] = w_.x; wv_[q * 4 + 1] = w_.y; wv_[q * 4 + 2] = w_.z; wv_[q * 4 + 3] = w_.w;
            float4 b_ = *(const float4*)(oo + 256 + q * 4);
            bv[q * 4] = b_.x; bv[q * 4 + 1] = b_.y; bv[q * 4 + 2] = b_.z; bv[q * 4 + 3] = b_.w;
            float4 k_ = *(const float4*)(oo + 128 + q * 4);
            kdv[q * 4] = k_.x; kdv[q * 4 + 1] = k_.y; kdv[q * 4 + 2] = k_.z; kdv[q * 4 + 3] = k_.w;
          }
          float vv = OPS[i * 384 + 320 + vrow];
          float s0 = 0.f, s1 = 0.f, s2 = 0.f, s3 = 0.f;
#pragma unroll
          for (int q = 0; q < 16; q += 4) {
            s0 += S[q] * kn[q]; s1 += S[q + 1] * kn[q + 1]; s2 += S[q + 2] * kn[q + 2]; s3 += S[q + 3] * kn[q + 3];
          }
          float sa = (s0 + s1) + (s2 + s3);
          sa += __shfl_xor(sa, 1, 64);
          sa += __shfl_xor(sa, 2, 64);
#pragma unroll
          for (int q = 0; q < 16; ++q) S[q] = S[q] * wv_[q] + sa * bv[q] + vv * kdv[q];
          if (seg) {
            float rv[16];
#pragma unroll
            for (int q = 0; q < 4; ++q) {
              float4 a = *(const float4*)(oo + q * 4);
              rv[q * 4] = a.x; rv[q * 4 + 1] = a.y; rv[q * 4 + 2] = a.z; rv[q * 4 + 3] = a.w;
            }
            float y0 = 0.f, y1 = 0.f, y2 = 0.f, y3 = 0.f;
#pragma unroll
            for (int q = 0; q < 16; q += 4) {
              y0 += S[q] * rv[q]; y1 += S[q + 1] * rv[q + 1]; y2 += S[q + 2] * rv[q + 2]; y3 += S[q + 3] * rv[q + 3];
            }
            float y = (y0 + y1) + (y2 + y3);
            y += __shfl_xor(y, 1, 64);
            y += __shfl_xor(y, 2, 64);
            if (kq == 0) YB[i * 64 + vrow] = y;
          }
        }
        __syncthreads();
        if (seg) {
          float4 yv = *(const float4*)(YB + tt * 64 + part * 4);
          uint2 o2;
          o2.x = pack2(yv.x, yv.y); o2.y = pack2(yv.z, yv.w);
          *(uint2*)(ydst + row * 512 + hc) = o2;
        }
      }
    }
  }
}

__device__ __forceinline__ void ph_mixprep(const P& p, int bid, int nb) {
  const int wid = threadIdx.x >> 6, lane = threadIdx.x & 63;
  const int c8 = lane * 8;
  for (int row = bid * 8 + wid; row < NLAT; row += nb * 8) {
    const int t = row & 2047;
    {
      uint4 a = *(const uint4*)(p.ys5f + (size_t)row * 512 + c8), b2 = *(const uint4*)(p.ys5b + (size_t)row * 512 + c8);
      unsigned au[4] = {a.x, a.y, a.z, a.w}, bu[4] = {b2.x, b2.y, b2.z, b2.w}, ou[4];
#pragma unroll
      for (int q = 0; q < 4; ++q) {
        float y0 = bflo(au[q]) + bflo(bu[q]), y1 = bfhi(au[q]) + bfhi(bu[q]);
        ou[q] = pack2(gelu_exact(y0), gelu_exact(y1));
      }
      *(uint4*)(p.ys5f + (size_t)row * 512 + c8) = make_uint4(ou[0], ou[1], ou[2], ou[3]);
    }
    float y[8];
    {
      uint4 a = *(const uint4*)(p.yrwf + (size_t)row * 512 + c8), b2 = *(const uint4*)(p.yrwb + (size_t)row * 512 + c8);
      unsigned au[4] = {a.x, a.y, a.z, a.w}, bu[4] = {b2.x, b2.y, b2.z, b2.w};
#pragma unroll
      for (int q = 0; q < 4; ++q) {
        y[2 * q] = bflo(au[q]) + bflo(bu[q]);
        y[2 * q + 1] = bfhi(au[q]) + bfhi(bu[q]);
      }
    }
    float sm = 0.f;
#pragma unroll
    for (int i = 0; i < 8; ++i) sm += y[i];
    sm += __shfl_xor(sm, 1, 64); sm += __shfl_xor(sm, 2, 64); sm += __shfl_xor(sm, 4, 64);
    float mu = sm * (1.f / 64.f);
    float sv = 0.f;
#pragma unroll
    for (int i = 0; i < 8; ++i) sv += (y[i] - mu) * (y[i] - mu);
    sv += __shfl_xor(sv, 1, 64); sv += __shfl_xor(sv, 2, 64); sv += __shfl_xor(sv, 4, 64);
    float rs = rsqrtf(sv * (1.f / 64.f) + 64e-5f);
    size_t nrow[4];
    bool nval[4];
    neighbours(false, (size_t)row, t, nrow, nval);
    float v[8];
    {
      int col = 512 + 1024 + c8;
      uint4 cz = *(const uint4*)(p.proj + (size_t)row * INC + col);
      unsigned cu[4] = {cz.x, cz.y, cz.z, cz.w};
      float4 m0 = *(const float4*)(p.rw_mu + 1024 + c8), m1 = *(const float4*)(p.rw_mu + 1024 + c8 + 4);
      float mm[8] = {m0.x, m0.y, m0.z, m0.w, m1.x, m1.y, m1.z, m1.w};
#pragma unroll
      for (int i = 0; i < 8; ++i) {
        float z = (i & 1) ? bfhi(cu[i >> 1]) : bflo(cu[i >> 1]);
        float nbv = 0.f;
        if (nval[i & 3]) nbv = bf2f(p.proj[nrow[i & 3] * INC + col + i]);
        v[i] = z + (nbv - z) * mm[i];
      }
    }
    const int head = lane >> 3;
    float bs = p.bsc[(size_t)row * 8 + head] + p.bsc[((size_t)NLAT + row) * 8 + head];
    {
      float4 w0 = *(const float4*)(p.rw_ln_w + c8), w1 = *(const float4*)(p.rw_ln_w + c8 + 4);
      float4 b0 = *(const float4*)(p.rw_ln_b + c8), b1 = *(const float4*)(p.rw_ln_b + c8 + 4);
      float lw[8] = {w0.x, w0.y, w0.z, w0.w, w1.x, w1.y, w1.z, w1.w};
      float lb[8] = {b0.x, b0.y, b0.z, b0.w, b1.x, b1.y, b1.z, b1.w};
      float o[8];
#pragma unroll
      for (int i = 0; i < 8; ++i) o[i] = (y[i] - mu) * rs * lw[i] + lb[i] + bs * v[i];
      *(uint4*)(p.yrwf + (size_t)row * 512 + c8) = make_uint4(pack2(o[0], o[1]), pack2(o[2], o[3]), pack2(o[4], o[5]), pack2(o[6], o[7]));
    }
    if (lane < 16) {
      unsigned ou[4] = {0u, 0u, 0u, 0u};
      if (lane < 12) {
        int col = 512 + 1600 + c8;
        uint4 cz = *(const uint4*)(p.proj + (size_t)row * INC + col);
        unsigned cu[4] = {cz.x, cz.y, cz.z, cz.w};
        float4 m0 = *(const float4*)(p.rw_mu + 1600 + c8), m1 = *(const float4*)(p.rw_mu + 1600 + c8 + 4);
        float mm[8] = {m0.x, m0.y, m0.z, m0.w, m1.x, m1.y, m1.z, m1.w};
        float gsig[8];
#pragma unroll
        for (int i = 0; i < 8; ++i) {
          float z = (i & 1) ? bfhi(cu[i >> 1]) : bflo(cu[i >> 1]);
          float nbv = 0.f;
          if (nval[i & 3]) nbv = bf2f(p.proj[nrow[i & 3] * INC + col + i]);
          float zm = z + (nbv - z) * mm[i];
          gsig[i] = 1.f / (1.f + expf(-zm));
        }
#pragma unroll
        for (int q = 0; q < 4; ++q) ou[q] = pack2(gsig[2 * q], gsig[2 * q + 1]);
      }
      *(uint4*)(p.sg + (size_t)row * 128 + c8) = make_uint4(ou[0], ou[1], ou[2], ou[3]);
    }
  }
}

__constant__ unsigned char CAND_I[52] = {0,0,0,0,0,0,0,0,0,0,0,0,0,0,0,0, 1,1,1,1,1,1,1,1, 2,2,2,2,2, 3,3,3,3, 4,4,4, 5,5, 6,6, 7,7, 8,9,10,11,12,13,14,15, 0,0};
__constant__ unsigned char CAND_J[52] = {0,1,2,3,4,5,6,7,8,9,10,11,12,13,14,15, 0,1,2,3,4,5,6,7, 0,1,2,3,4, 0,1,2,3, 0,1,2, 0,1, 0,1, 0,1, 0,0,0,0,0,0,0,0, 0,0};

#define SC_LD 132
__device__ __forceinline__ void ph_route(const P& p, char* smem, int bid, int nb) {
  float* SC = (float*)smem;
  float* TS = (float*)(smem + 2 * 64 * SC_LD * 4);
  int* TI = (int*)(TS + 2 * 64 * 16);
  const u16* Q = p.proj;
  const int tid = threadIdx.x, wid = tid >> 6, lane = tid & 63, fr = lane & 15, fq = lane >> 4;
  for (int item = bid; item < 1024 * 8; item += nb) {
    const int h = item & 7, row0 = (item >> 3) * 64;
    {
      const int c = wid >> 2, mrow = (wid & 3) * 16;
      f32x4 acc[8];
#pragma unroll
      for (int ni = 0; ni < 8; ++ni) acc[ni] = (f32x4){0.f, 0.f, 0.f, 0.f};
#pragma unroll
      for (int ks = 0; ks < 4; ++ks) {
        bf16x8 a = *(const bf16x8*)(Q + (size_t)(row0 + mrow + fr) * 2048 + h * 256 + c * 128 + ks * 32 + fq * 8);
#pragma unroll
        for (int ni = 0; ni < 8; ++ni) {
          bf16x8 bfr = *(const bf16x8*)(p.keys + ((size_t)(h * 2 + c) * 128 + ni * 16 + fr) * 128 + ks * 32 + fq * 8);
          acc[ni] = __builtin_amdgcn_mfma_f32_16x16x32_bf16(a, bfr, acc[ni], 0, 0, 0);
        }
      }
#pragma unroll
      for (int ni = 0; ni < 8; ++ni)
#pragma unroll
        for (int j = 0; j < 4; ++j) SC[(c * 64 + mrow + fq * 4 + j) * SC_LD + ni * 16 + fr] = acc[ni][j];
    }
    __syncthreads();
    {
      const int task = tid >> 2, q4 = tid & 3;
      const int c = task >> 6, t = task & 63;
      float val[32];
#pragma unroll
      for (int i = 0; i < 32; ++i) val[i] = SC[(c * 64 + t) * SC_LD + i * 4 + q4];
      for (int r = 0; r < 16; ++r) {
        float m = val[0];
#pragma unroll
        for (int i = 1; i < 32; ++i) m = fmaxf(m, val[i]);
        int li = 31;
#pragma unroll
        for (int i = 30; i >= 0; --i) li = (val[i] == m) ? i : li;
        int n = li * 4 + q4;
#pragma unroll
        for (int sh = 1; sh <= 2; sh <<= 1) {
          float om = __shfl_xor(m, sh, 64);
          int on = __shfl_xor(n, sh, 64);
          bool take = (om > m) || (om == m && on < n);
          m = take ? om : m;
          n = take ? on : n;
        }
        const int wi = n >> 2;
        const bool mine = (n & 3) == q4;
#pragma unroll
        for (int i = 0; i < 32; ++i) val[i] = (mine && i == wi) ? -INFINITY : val[i];
        if (q4 == (r & 3)) {
          TS[(c * 64 + t) * 16 + r] = m;
          TI[(c * 64 + t) * 16 + r] = n;
        }
      }
    }
    __syncthreads();
    if (tid < 256) {
      const int t = tid >> 2, q4 = tid & 3;
      float val[13];
      int cid[13];
#pragma unroll
      for (int e = 0; e < 13; ++e) {
        int ci = q4 + 4 * e;
        if (ci < 50) {
          int i = CAND_I[ci], j = CAND_J[ci];
          val[e] = TS[t * 16 + i] + TS[(64 + t) * 16 + j];
          cid[e] = i * 16 + j;
        } else { val[e] = -INFINITY; cid[e] = 1 << 20; }
      }
      float bs_[16];
      int bi_[16];
#pragma unroll
      for (int r = 0; r < 16; ++r) {
        float m = val[0]; int f = cid[0]; int le = 0;
#pragma unroll
        for (int e = 1; e < 13; ++e) {
          bool take = (val[e] > m) || (val[e] == m && cid[e] < f);
          m = take ? val[e] : m; f = take ? cid[e] : f; le = take ? e : le;
        }
        float wm = m; int wf = f;
#pragma unroll
        for (int sh = 1; sh <= 2; sh <<= 1) {
          float om = __shfl_xor(wm, sh, 64);
          int of = __shfl_xor(wf, sh, 64);
          bool take = (om > wm) || (om == wm && of < wf);
          wm = take ? om : wm; wf = take ? of : wf;
        }
        const bool mine = (wf == f) && (wm == m);
#pragma unroll
        for (int e = 0; e < 13; ++e) val[e] = (mine && e == le) ? -INFINITY : val[e];
        bs_[r] = wm; bi_[r] = wf;
      }
      float den = 0.f, ex[16];
#pragma unroll
      for (int r = 0; r < 16; ++r) { ex[r] = __expf(bs_[r] - bs_[0]); den += ex[r]; }
      float rden = 1.f / den;
      const size_t obase = ((size_t)(row0 + t) * 8 + h) * 16;
#pragma unroll
      for (int r = 0; r < 16; ++r) {
        if ((r & 3) == q4) {
          int i = bi_[r] >> 4, j = bi_[r] & 15;
          p.idx[obase + r] = TI[t * 16 + i] * 128 + TI[(64 + t) * 16 + j];
          p.gate[obase + r] = ex[r] * rden;
        }
      }
    }
    __syncthreads();
  }
}

__device__ __forceinline__ void ph_ffn(const P& p, int bid, int nb) {
  const int wid = threadIdx.x >> 6, lane = threadIdx.x & 63;
  const u16* H2N = p.hn;
  for (int row = bid * 8 + wid; row < NLAT; row += nb * 8) {
    float hx[16];
    {
      uint4 a = *(const uint4*)(H2N + (size_t)row * 1024 + lane * 8), b2 = *(const uint4*)(H2N + (size_t)row * 1024 + 512 + lane * 8);
      unsigned au[8] = {a.x, a.y, a.z, a.w, b2.x, b2.y, b2.z, b2.w};
#pragma unroll
      for (int q = 0; q < 8; ++q) { hx[2 * q] = bflo(au[q]); hx[2 * q + 1] = bfhi(au[q]); }
    }
    int id0 = p.idx[(size_t)row * 128 + lane], id1 = p.idx[(size_t)row * 128 + 64 + lane];
    float g0 = p.gate[(size_t)row * 128 + lane], g1 = p.gate[(size_t)row * 128 + 64 + lane];
    float oacc[16];
#pragma unroll
    for (int i = 0; i < 16; ++i) oacc[i] = 0.f;
    for (int e0 = 0; e0 < 128; e0 += 4) {
      uint4 ur[4][2], vr[4][2];
      float gt[4];
#pragma unroll
      for (int q = 0; q < 4; ++q) {
        int e = e0 + q;
        int id = __shfl((e < 64) ? id0 : id1, e & 63, 64);
        gt[q] = __shfl((e < 64) ? g0 : g1, e & 63, 64);
        const u16* up = p.utab + (size_t)id * 1024 + lane * 8;
        const u16* vp = p.vtab + (size_t)id * 1024 + lane * 8;
        ur[q][0] = *(const uint4*)up; ur[q][1] = *(const uint4*)(up + 512);
        vr[q][0] = *(const uint4*)vp; vr[q][1] = *(const uint4*)(vp + 512);
      }
      float dot[4];
#pragma unroll
      for (int q = 0; q < 4; ++q) {
        unsigned uu[8] = {ur[q][0].x, ur[q][0].y, ur[q][0].z, ur[q][0].w, ur[q][1].x, ur[q][1].y, ur[q][1].z, ur[q][1].w};
        float s0 = 0.f, s1 = 0.f;
#pragma unroll
        for (int k = 0; k < 8; ++k) { s0 += hx[2 * k] * bflo(uu[k]); s1 += hx[2 * k + 1] * bfhi(uu[k]); }
        dot[q] = s0 + s1;
      }
#pragma unroll
      for (int m = 32; m >= 1; m >>= 1) {
#pragma unroll
        for (int q = 0; q < 4; ++q) dot[q] += __shfl_xor(dot[q], m, 64);
      }
#pragma unroll
      for (int q = 0; q < 4; ++q) {
        float cf = gt[q] * gelu_exact(dot[q]);
        unsigned vv[8] = {vr[q][0].x, vr[q][0].y, vr[q][0].z, vr[q][0].w, vr[q][1].x, vr[q][1].y, vr[q][1].z, vr[q][1].w};
#pragma unroll
        for (int k = 0; k < 8; ++k) { oacc[2 * k] += cf * bflo(vv[k]); oacc[2 * k + 1] += cf * bfhi(vv[k]); }
      }
    }
    const int b = row >> 11;
    float h3[16];
    float ss = 0.f;
#pragma unroll
    for (int hf = 0; hf < 2; ++hf) {
      int col = hf * 512 + lane * 8;
      float4 a0 = *(const float4*)(p.out + (size_t)row * 1024 + col), a1 = *(const float4*)(p.out + (size_t)row * 1024 + col + 4);
      float4 q0 = *(const float4*)(p.mod + b * 6144 + 5 * 1024 + col), q1 = *(const float4*)(p.mod + b * 6144 + 5 * 1024 + col + 4);
      float hv[8] = {a0.x, a0.y, a0.z, a0.w, a1.x, a1.y, a1.z, a1.w};
      float gv[8] = {q0.x, q0.y, q0.z, q0.w, q1.x, q1.y, q1.z, q1.w};
#pragma unroll
      for (int i = 0; i < 8; ++i) {
        float v = hv[i] + gv[i] * oacc[hf * 8 + i];
        h3[hf * 8 + i] = v;
        ss += v * v;
      }
    }
    ss = wave_sum(ss);
    float rstd = rsqrtf(ss * (1.f / 1024.f) + 1e-6f);
#pragma unroll
    for (int hf = 0; hf < 2; ++hf) {
      int col = hf * 512 + lane * 8;
      float4 n0 = *(const float4*)(p.norm_f_g + col), n1 = *(const float4*)(p.norm_f_g + col + 4);
      float4 o0 = make_float4(h3[hf * 8 + 0] * rstd * n0.x, h3[hf * 8 + 1] * rstd * n0.y, h3[hf * 8 + 2] * rstd * n0.z, h3[hf * 8 + 3] * rstd * n0.w);
      float4 o1 = make_float4(h3[hf * 8 + 4] * rstd * n1.x, h3[hf * 8 + 5] * rstd * n1.y, h3[hf * 8 + 6] * rstd * n1.z, h3[hf * 8 + 7] * rstd * n1.w);
      *(float4*)(p.out + (size_t)row * 1024 + col) = o0;
      *(float4*)(p.out + (size_t)row * 1024 + col + 4) = o1;
    }
  }
}

#define NPHASES 11
template <int PH>
__device__ __forceinline__ void run_phase(const P& p, char* smem, int bid, int nb) {
  if (PH == 0) ph_prep(p, smem, bid, nb);
  if (PH == 1) ph_norm(p, 0, bid, nb);
  if (PH == 2) gemm_phase(p.hn, 1024, p.win_t, 1024, 1024, NTOK, INCP, smem, bid, nb, EpiProj{p.proj});
  if (PH == 3) { ph_s5scan(p, smem, bid, nb); ph_rwscan(p, smem, bid, nb); }
  if (PH == 4) ph_mixprep(p, bid, nb);
  if (PH == 5) {
    gemm_phase(p.ys5f, 512, p.wglu_t, 512, 512, NLAT, 512, smem, bid, nb, EpiGlu{p.ys5f, p.s5_b_glu, p.hn});
    gemm_phase(p.sg, 128, p.wg2_t, 128, 128, NLAT, 512, smem, bid, nb, EpiGate{p.yrwf, p.hn});
  }
  if (PH == 6) gemm_phase(p.hn, 1024, p.wout_t, 1024, 1024, NLAT, 1024, smem, bid, nb, EpiWout{p.x, p.mod, p.out});
  if (PH == 7) ph_norm(p, 1, bid, nb);
  if (PH == 8) gemm_phase(p.hn, 1024, p.wq_t, 1024, 1024, NLAT, 2048, smem, bid, nb, EpiQ{p.proj});
  if (PH == 9) ph_route(p, smem, bid, nb);
  if (PH == 10) ph_ffn(p, bid, nb);
}
#define PHASE(n) if (ph_lo <= n && n < ph_hi) { if (n > ph_lo) grid.sync(); run_phase<n>(p, smem, bid, nb); }
__global__ void __launch_bounds__(NTHREADS) mega(P p, int ph_lo, int ph_hi) {
  extern __shared__ __attribute__((aligned(16))) char smem[];
  cg::grid_group grid = cg::this_grid();
  const int bid = blockIdx.x, nb = gridDim.x;
  PHASE(0) PHASE(1) PHASE(2) PHASE(3) PHASE(4) PHASE(5) PHASE(6) PHASE(7) PHASE(8) PHASE(9) PHASE(10)
}

extern "C" void kernel_launch(void* const* d_in, const int* in_sizes, int n_in, void* d_out, int out_size, void* d_ws,
                              size_t ws_size, hipStream_t stream) {
  static int grid_blocks = 0;
  if (!grid_blocks) {
    int dev = 0, cus = 0, per_cu = 0;
    hipGetDevice(&dev);
    hipDeviceGetAttribute(&cus, hipDeviceAttributeMultiprocessorCount, dev);
    hipFuncSetAttribute((const void*)mega, hipFuncAttributeMaxDynamicSharedMemorySize, LDS_BYTES);
    hipOccupancyMaxActiveBlocksPerMultiprocessor(&per_cu, (const void*)mega, NTHREADS, LDS_BYTES);
    if (per_cu < 1) { fprintf(stderr, "occupancy query returned %d\n", per_cu); per_cu = 1; }
    grid_blocks = cus;
  }
  P p{};
  const float** fp = (const float**)&p;
  for (int i = 0; i < 36; ++i) fp[i] = (const float*)d_in[i];
  p.out = (float*)d_out;
  char* w = (char*)d_ws;
  size_t off = 0;
  auto take = [&](size_t bytes) { char* r = w + off; off += (bytes + 255) & ~(size_t)255; return r; };
  p.mod = (float*)take(33 * 6144 * 4);
  p.win_t = (u16*)take((size_t)INCP * 1024 * 2);
  p.wout_t = (u16*)take((size_t)1024 * 1024 * 2);
  p.wq_t = (u16*)take((size_t)2048 * 1024 * 2);
  p.wglu_t = (u16*)take((size_t)512 * 512 * 2);
  p.wg2_t = (u16*)take((size_t)512 * 128 * 2);
  p.keys = (u16*)take((size_t)8 * 2 * 128 * 128 * 2);
  p.utab = (u16*)take((size_t)16384 * 1024 * 2);
  p.vtab = (u16*)take((size_t)16384 * 1024 * 2);
  p.s5ab = (float*)take(4096 * 2 * 4);
  p.s5bb = (float*)take(4096 * 32 * 4);
  p.s5ct = (u16*)take(2 * 32 * 16 * 128 * 2);
  p.hn = (u16*)take((size_t)NTOK * 1024 * 2);
  p.proj = (u16*)take((size_t)NTOK * INC * 2);
  p.ys5f = (u16*)take((size_t)NLAT * 512 * 2);
  p.ys5b = (u16*)take((size_t)NLAT * 512 * 2);
  p.yrwf = (u16*)take((size_t)NLAT * 512 * 2);
  p.yrwb = (u16*)take((size_t)NLAT * 512 * 2);
  p.bsc = (float*)take((size_t)2 * NLAT * 8 * 4);
  p.sg = (u16*)take((size_t)NLAT * 128 * 2);
  p.idx = (int*)p.ys5b;
  p.gate = (float*)p.yrwb;
  if (off > ws_size) { fprintf(stderr, "workspace too small: need %zu have %zu\n", off, ws_size); return; }
#if MEGA
  int lo = 0, hi = NPHASES;
  void* args[] = {&p, &lo, &hi};
  hipError_t e = hipLaunchCooperativeKernel((const void*)mega, dim3(grid_blocks), dim3(NTHREADS), args, LDS_BYTES, stream);
  if (e != hipSuccess) fprintf(stderr, "cooperative launch failed: %s (grid %d)\n", hipGetErrorString(e), grid_blocks);
#else
  for (int ph = 0; ph < NPHASES; ++ph) {
    hipLaunchKernelGGL(mega, dim3(grid_blocks), dim3(NTHREADS), LDS_BYTES, stream, p, ph, ph + 1);
  }
#endif
}
```

```cpp
#include <hip/hip_runtime.h>
#include <hip/hip_cooperative_groups.h>
#include <stdint.h>
#include <stdio.h>
namespace cg = cooperative_groups;

#ifndef MEGA
#define MEGA 1
#endif

typedef unsigned short u16;
using bf16x8 = __attribute__((ext_vector_type(8))) short;
using f32x4 = __attribute__((ext_vector_type(4))) float;
using u32x4 = __attribute__((ext_vector_type(4))) unsigned;

#define DM 1024
#define NLAT 65536
#define NCTX 8192
#define NTOK 73728
#define INC 2208
#define INCP 2304
#define NTHREADS 512
#define LDS_BYTES 131072

struct P {
  const float *x, *c, *ctx, *c_ctx, *w_ada, *b_ada, *norm1_g, *norm2_g, *w_in, *s5_a_re, *s5_a_im, *s5_log_dt,
      *s5_b_re, *s5_b_im, *s5_c_re, *s5_c_im, *s5_d, *s5_w_glu, *s5_b_glu, *rw_mu, *rw_w0, *rw_w_w2, *rw_a0, *rw_w_a2,
      *rw_w_g2, *rw_k_k, *rw_k_a, *rw_r_k, *rw_ln_w, *rw_ln_b, *w_out, *peer_w_q, *peer_keys, *peer_u, *peer_v, *norm_f_g;
  float* out;
  float* mod;
  u16 *win_t, *wout_t, *wq_t, *wglu_t, *wg2_t, *keys;
  unsigned char *utab, *vtab;
  float *usc, *vsc;
  float *s5ab, *s5bb;
  u16* s5ct;
  u16 *hn, *proj, *ys5f, *ys5b, *yrwf, *yrwb;
  float* bsc;
  u16* sg;
  int* idx;
  float* gate;
};

__device__ __forceinline__ u16 f2bf(float f) {
  unsigned u = __float_as_uint(f);
  u += 0x7fffu + ((u >> 16) & 1u);
  return (u16)(u >> 16);
}
__device__ __forceinline__ float bf2f(u16 h) { return __uint_as_float(((unsigned)h) << 16); }
__device__ __forceinline__ unsigned pack2(float a, float b) { return (unsigned)f2bf(a) | ((unsigned)f2bf(b) << 16); }
__device__ __forceinline__ float bflo(unsigned u) { return __uint_as_float(u << 16); }
__device__ __forceinline__ float bfhi(unsigned u) { return __uint_as_float(u & 0xffff0000u); }
__device__ __forceinline__ float wave_sum(float v) {
#pragma unroll
  for (int m = 32; m >= 1; m >>= 1) v += __shfl_xor(v, m, 64);
  return v;
}
__device__ __forceinline__ float gelu_exact(float x) { return 0.5f * x * (1.f + erff(x * 0.70710678118654752f)); }
__device__ __forceinline__ float sigmoidf(float x) { return 1.f / (1.f + __expf(-x)); }


typedef float v2f __attribute__((ext_vector_type(2)));
__device__ __forceinline__ float dpp_add(float v, const int ctrl, const int rmask) {
  int m;
  switch (ctrl) {
    case 0: m = __builtin_amdgcn_update_dpp(0, __float_as_int(v), 0xB1, 0xf, 0xf, true); break;
    case 1: m = __builtin_amdgcn_update_dpp(0, __float_as_int(v), 0x4E, 0xf, 0xf, true); break;
    case 2: m = __builtin_amdgcn_update_dpp(0, __float_as_int(v), 0x141, 0xf, 0xf, true); break;
    case 3: m = __builtin_amdgcn_update_dpp(0, __float_as_int(v), 0x140, 0xf, 0xf, true); break;
    case 4: m = __builtin_amdgcn_update_dpp(0, __float_as_int(v), 0x142, 0xa, 0xf, false); break;
    default: m = __builtin_amdgcn_update_dpp(0, __float_as_int(v), 0x143, 0xc, 0xf, false); break;
  }
  return v + __int_as_float(m);
}
__device__ __forceinline__ float wave_sum_u(float v) {
  v = dpp_add(v, 0, 0); v = dpp_add(v, 1, 0); v = dpp_add(v, 2, 0); v = dpp_add(v, 3, 0);
  v = dpp_add(v, 4, 0); v = dpp_add(v, 5, 0);
  return __int_as_float(__builtin_amdgcn_readlane(__float_as_int(v), 63));
}
__device__ __forceinline__ void convert_fp8_rows(const float* __restrict__ src, unsigned char* __restrict__ dst, float* __restrict__ sc,
                                                 int nrows, int bid, int nb) {
  const int wid = threadIdx.x >> 6, lane = threadIdx.x & 63;
  for (int row = bid * 8 + wid; row < nrows; row += nb * 8) {
    float4 v[4];
    float am = 0.f;
#pragma unroll
    for (int q = 0; q < 4; ++q) {
      v[q] = *(const float4*)(src + (size_t)row * 1024 + lane * 16 + q * 4);
      am = fmaxf(am, fmaxf(fmaxf(fabsf(v[q].x), fabsf(v[q].y)), fmaxf(fabsf(v[q].z), fabsf(v[q].w))));
    }
#pragma unroll
    for (int m = 32; m >= 1; m >>= 1) am = fmaxf(am, __shfl_xor(am, m, 64));
    float scl = am > 0.f ? 448.f / am : 1.f;
    unsigned o[4];
#pragma unroll
    for (int q = 0; q < 4; ++q) {
      int w = 0;
      w = __builtin_amdgcn_cvt_pk_fp8_f32(v[q].x * scl, v[q].y * scl, w, false);
      w = __builtin_amdgcn_cvt_pk_fp8_f32(v[q].z * scl, v[q].w * scl, w, true);
      o[q] = (unsigned)w;
    }
    *(uint4*)(dst + (size_t)row * 1024 + lane * 16) = make_uint4(o[0], o[1], o[2], o[3]);
    if (lane == 0) sc[row] = am > 0.f ? am / 448.f : 1.f;
  }
}

__device__ __forceinline__ void transpose_tiles(const float* __restrict__ src, int K, int N, u16* __restrict__ dst, int Kd, int Npad,
                                char* smem, int bid, int nb) {
  float* tile = (float*)smem;
  const int tid = threadIdx.x;
  const int nkt = Kd / 64, nnt = Npad / 64;
  for (int t = bid; t < nkt * nnt; t += nb) {
    int kt = t % nkt, nt = t / nkt;
    int k0 = kt * 64, n0 = nt * 64;
    __syncthreads();
#pragma unroll
    for (int it = 0; it < 8; ++it) {
      int i = (tid >> 6) + it * 8, j = tid & 63;
      int k = k0 + i, n = n0 + j;
      tile[i * 65 + j] = (k < K && n < N) ? src[(size_t)k * N + n] : 0.f;
    }
    __syncthreads();
    int n = tid >> 3, kc = (tid & 7) * 8;
    uint4 o;
    o.x = pack2(tile[(kc + 0) * 65 + n], tile[(kc + 1) * 65 + n]);
    o.y = pack2(tile[(kc + 2) * 65 + n], tile[(kc + 3) * 65 + n]);
    o.z = pack2(tile[(kc + 4) * 65 + n], tile[(kc + 5) * 65 + n]);
    o.w = pack2(tile[(kc + 6) * 65 + n], tile[(kc + 7) * 65 + n]);
    *(uint4*)(dst + (size_t)(n0 + n) * Kd + k0 + kc) = o;
  }
}

__device__ __forceinline__ void convert_bf16(const float* __restrict__ src, u16* __restrict__ dst, size_t n8, int bid, int nb) {
  for (size_t i = (size_t)bid * NTHREADS + threadIdx.x; i < n8; i += (size_t)nb * NTHREADS) {
    float4 a = *(const float4*)(src + i * 8), b = *(const float4*)(src + i * 8 + 4);
    uint4 o;
    o.x = pack2(a.x, a.y); o.y = pack2(a.z, a.w); o.z = pack2(b.x, b.y); o.w = pack2(b.z, b.w);
    *(uint4*)(dst + i * 8) = o;
  }
}

__device__ __forceinline__ void ph_prep(const P& p, char* smem, int bid, int nb) {
  const int tid = threadIdx.x;
  {
    float* sc = (float*)smem;
    float* red = (float*)(smem + 33 * 128 * 4);
    for (int item = bid; item < 96; item += nb) {
      const int j0 = item * 64, kg = tid >> 6, col = tid & 63;
      float acc[33];
#pragma unroll
      for (int b = 0; b < 33; ++b) acc[b] = 0.f;
      for (int ch = 0; ch < 8; ++ch) {
        __syncthreads();
        for (int e = tid; e < 33 * 128; e += NTHREADS) {
          int b = e >> 7, kk = e & 127;
          float cv = (b < 32) ? p.c[b * 1024 + ch * 128 + kk] : p.c_ctx[ch * 128 + kk];
          sc[e] = cv / (1.f + expf(-cv));
        }
        __syncthreads();
        for (int i = 0; i < 16; ++i) {
          int kk = kg * 16 + i;
          float w = p.w_ada[(size_t)(ch * 128 + kk) * 6144 + j0 + col];
#pragma unroll
          for (int b = 0; b < 33; ++b) acc[b] += sc[b * 128 + kk] * w;
        }
      }
#pragma unroll
      for (int b = 0; b < 33; ++b) red[(kg * 33 + b) * 64 + col] = acc[b];
      __syncthreads();
      for (int e = tid; e < 33 * 64; e += NTHREADS) {
        int b = e >> 6, cc = e & 63;
        float s = p.b_ada[j0 + cc];
#pragma unroll
        for (int k2 = 0; k2 < 8; ++k2) s += red[(k2 * 33 + b) * 64 + cc];
        p.mod[b * 6144 + j0 + cc] = s;
      }
      __syncthreads();
    }
  }
  transpose_tiles(p.w_in, 1024, INC, p.win_t, 1024, INCP, smem, bid, nb);
  transpose_tiles(p.w_out, 1024, 1024, p.wout_t, 1024, 1024, smem, bid, nb);
  transpose_tiles(p.peer_w_q, 1024, 2048, p.wq_t, 1024, 2048, smem, bid, nb);
  transpose_tiles(p.s5_w_glu, 512, 512, p.wglu_t, 512, 512, smem, bid, nb);
  transpose_tiles(p.rw_w_g2, 96, 512, p.wg2_t, 128, 512, smem, bid, nb);
  convert_bf16(p.peer_keys, p.keys, (size_t)8 * 2 * 128 * 128 / 8, bid, nb);
  convert_fp8_rows(p.peer_u, p.utab, p.usc, 16384, bid, nb);
  convert_fp8_rows(p.peer_v, p.vtab, p.vsc, 16384, bid, nb);
  for (int it = bid * NTHREADS + tid; it < 4096; it += nb * NTHREADS) {
    int pp = it & 63, g = (it >> 6) & 31, d = it >> 11;
    float are = p.s5_a_re[it], aim = p.s5_a_im[it];
    float dt = expf(p.s5_log_dt[d * 32 + g]);
    float mag = expf(dt * are);
    float abr = mag * cosf(dt * aim), abi = mag * sinf(dt * aim);
    float nr = abr - 1.f, ni = abi;
    float den = are * are + aim * aim;
    float cfr = (nr * are + ni * aim) / den, cfi = (ni * are - nr * aim) / den;
    p.s5ab[it * 2] = abr;
    p.s5ab[it * 2 + 1] = abi;
    for (int h = 0; h < 16; ++h) {
      float br = p.s5_b_re[(size_t)it * 16 + h], bi = p.s5_b_im[(size_t)it * 16 + h];
      p.s5bb[(size_t)it * 32 + h] = cfr * br - cfi * bi;
      p.s5bb[(size_t)it * 32 + 16 + h] = cfr * bi + cfi * br;
    }
    for (int h = 0; h < 16; ++h) {
      size_t ci = ((size_t)(d * 32 + g) * 16 + h) * 64 + pp;
      p.s5ct[((size_t)(d * 32 + g) * 16 + h) * 128 + 2 * pp] = f2bf(p.s5_c_re[ci]);
      p.s5ct[((size_t)(d * 32 + g) * 16 + h) * 128 + 2 * pp + 1] = f2bf(-p.s5_c_im[ci]);
    }
  }
}

__device__ __forceinline__ void ph_norm(const P& p, int mode, int bid, int nb) {
  const int wid = threadIdx.x >> 6, lane = threadIdx.x & 63;
  const int nrows = mode == 0 ? NTOK : NLAT;
  const float* gvec = mode == 0 ? p.norm1_g : p.norm2_g;
  const int sh_off = mode == 0 ? 0 : 3 * 1024, sc_off = sh_off + 1024;
  for (int row = bid * 8 + wid; row < nrows; row += nb * 8) {
    const float* src;
    int b;
    if (mode == 0) {
      if (row < NLAT) { src = p.x + (size_t)row * 1024; b = row >> 11; }
      else { src = p.ctx + (size_t)(row - NLAT) * 1024; b = 32; }
    } else { src = p.out + (size_t)row * 1024; b = row >> 11; }
    float4 v[4];
    float ss = 0.f;
#pragma unroll
    for (int j = 0; j < 4; ++j) {
      v[j] = *(const float4*)(src + j * 256 + lane * 4);
      ss += v[j].x * v[j].x + v[j].y * v[j].y + v[j].z * v[j].z + v[j].w * v[j].w;
    }
    ss = wave_sum(ss);
    float rstd = rsqrtf(ss * (1.f / 1024.f) + 1e-6f);
    const float* mrow = p.mod + b * 6144;
#pragma unroll
    for (int j = 0; j < 4; ++j) {
      int col = j * 256 + lane * 4;
      float4 g = *(const float4*)(gvec + col);
      float4 sh = *(const float4*)(mrow + sh_off + col);
      float4 sc = *(const float4*)(mrow + sc_off + col);
      float y0 = v[j].x * rstd * g.x * (1.f + sc.x) + sh.x;
      float y1 = v[j].y * rstd * g.y * (1.f + sc.y) + sh.y;
      float y2 = v[j].z * rstd * g.z * (1.f + sc.z) + sh.z;
      float y3 = v[j].w * rstd * g.w * (1.f + sc.w) + sh.w;
      uint2 o;
      o.x = pack2(y0, y1); o.y = pack2(y2, y3);
      *(uint2*)(p.hn + (size_t)row * 1024 + col) = o;
    }
  }
}

#define G_BM 256
#define G_BN 128
#define G_BK 64
#define G_LD 72
template <class Epi>
__device__ __forceinline__ void gemm_phase(const u16* __restrict__ A, int lda, const u16* __restrict__ Bt, int ldb, int K, int M, int N,
                           char* smem, int bid, int nb, Epi epi) {
  u16* As = (u16*)smem;
  u16* Bs = (u16*)(smem + 2 * G_BM * G_LD * 2);
  const int tid = threadIdx.x, wid = tid >> 6, lane = tid & 63;
  const int wr = wid >> 1, wc = wid & 1, fr = lane & 15, fq = lane >> 4;
  const int ntn = N / G_BN, ntiles = (M / G_BM) * ntn, nk = K / G_BK;
  const int lrow = tid >> 3, lkc = (tid & 7) * 8;
  for (int tile = bid; tile < ntiles; tile += nb) {
    const int m0 = (tile / ntn) * G_BM, n0 = (tile % ntn) * G_BN;
    f32x4 acc[4][4];
#pragma unroll
    for (int i = 0; i < 4; ++i)
#pragma unroll
      for (int j = 0; j < 4; ++j) acc[i][j] = (f32x4){0.f, 0.f, 0.f, 0.f};
    u32x4 ra[4], rb[2];
    const u16* Ag = A + (size_t)(m0 + lrow) * lda + lkc;
    const u16* Bg = Bt + (size_t)(n0 + lrow) * ldb + lkc;
#pragma unroll
    for (int i = 0; i < 4; ++i) ra[i] = *(const u32x4*)(Ag + (size_t)(64 * i) * lda);
#pragma unroll
    for (int i = 0; i < 2; ++i) rb[i] = *(const u32x4*)(Bg + (size_t)(64 * i) * ldb);
    __syncthreads();
#pragma unroll
    for (int i = 0; i < 4; ++i) *(u32x4*)(As + (lrow + 64 * i) * G_LD + lkc) = ra[i];
#pragma unroll
    for (int i = 0; i < 2; ++i) *(u32x4*)(Bs + (lrow + 64 * i) * G_LD + lkc) = rb[i];
    __syncthreads();
    for (int kt = 0; kt < nk; ++kt) {
      const int buf = kt & 1;
      if (kt + 1 < nk) {
#pragma unroll
        for (int i = 0; i < 4; ++i) ra[i] = *(const u32x4*)(Ag + (size_t)(64 * i) * lda + (kt + 1) * G_BK);
#pragma unroll
        for (int i = 0; i < 2; ++i) rb[i] = *(const u32x4*)(Bg + (size_t)(64 * i) * ldb + (kt + 1) * G_BK);
      }
      const u16* as = As + buf * (G_BM * G_LD);
      const u16* bs = Bs + buf * (G_BN * G_LD);
#pragma unroll
      for (int ks = 0; ks < 2; ++ks) {
        bf16x8 af[4], bfr[4];
#pragma unroll
        for (int mi = 0; mi < 4; ++mi) af[mi] = *(const bf16x8*)(as + (wr * 64 + mi * 16 + fr) * G_LD + ks * 32 + fq * 8);
#pragma unroll
        for (int ni = 0; ni < 4; ++ni) bfr[ni] = *(const bf16x8*)(bs + (wc * 64 + ni * 16 + fr) * G_LD + ks * 32 + fq * 8);
#pragma unroll
        for (int mi = 0; mi < 4; ++mi)
#pragma unroll
          for (int ni = 0; ni < 4; ++ni)
            acc[mi][ni] = __builtin_amdgcn_mfma_f32_16x16x32_bf16(af[mi], bfr[ni], acc[mi][ni], 0, 0, 0);
      }
      if (kt + 1 < nk) {
        u16* as2 = As + (buf ^ 1) * (G_BM * G_LD);
        u16* bs2 = Bs + (buf ^ 1) * (G_BN * G_LD);
#pragma unroll
        for (int i = 0; i < 4; ++i) *(u32x4*)(as2 + (lrow + 64 * i) * G_LD + lkc) = ra[i];
#pragma unroll
        for (int i = 0; i < 2; ++i) *(u32x4*)(bs2 + (lrow + 64 * i) * G_LD + lkc) = rb[i];
      }
      __syncthreads();
    }
#pragma unroll
    for (int mi = 0; mi < 4; ++mi)
#pragma unroll
      for (int ni = 0; ni < 4; ++ni) epi(m0 + wr * 64 + mi * 16 + fq * 4, n0 + wc * 64 + ni * 16 + fr, acc[mi][ni]);
  }
}

struct EpiProj {
  u16* proj;
  __device__ __forceinline__ void operator()(int r, int c, f32x4 v) const {
    if (c < INC) {
#pragma unroll
      for (int j = 0; j < 4; ++j) proj[(size_t)(r + j) * INC + c] = f2bf(v[j]);
    }
  }
};
struct EpiGlu {
  const u16* y1; const float* bglu; u16* a2;
  __device__ __forceinline__ void operator()(int r, int c, f32x4 v) const {
    float bb = bglu[c];
#pragma unroll
    for (int j = 0; j < 4; ++j) {
      float y = bf2f(y1[(size_t)(r + j) * 512 + c]);
      a2[(size_t)(r + j) * 1024 + c] = f2bf(y * sigmoidf(v[j] + bb));
    }
  }
};
struct EpiGate {
  const u16* t1; u16* a2;
  __device__ __forceinline__ void operator()(int r, int c, f32x4 v) const {
#pragma unroll
    for (int j = 0; j < 4; ++j) {
      float t = bf2f(t1[(size_t)(r + j) * 512 + c]);
      a2[(size_t)(r + j) * 1024 + 512 + c] = f2bf(t * v[j]);
    }
  }
};
struct EpiWout {
  const float* x; const float* mod; float* h2;
  __device__ __forceinline__ void operator()(int r, int c, f32x4 v) const {
    float g1 = mod[(r >> 11) * 6144 + 2 * 1024 + c];
#pragma unroll
    for (int j = 0; j < 4; ++j) h2[(size_t)(r + j) * 1024 + c] = x[(size_t)(r + j) * 1024 + c] + g1 * v[j];
  }
};
struct EpiQ {
  u16* q;
  __device__ __forceinline__ void operator()(int r, int c, f32x4 v) const {
#pragma unroll
    for (int j = 0; j < 4; ++j) q[(size_t)(r + j) * 2048 + c] = f2bf(v[j]);
  }
};

__device__ __forceinline__ void ph_s5scan(const P& p, char* smem, int bid, int nb) {
  const int wid = threadIdx.x >> 6, lane = threadIdx.x & 63;
  float* U = (float*)(smem + wid * 8448);
  unsigned* H = (unsigned*)((char*)U + 4096);
  const int fr = lane & 15, fq = lane >> 4;
  for (int s = bid * 8 + wid; s < 2048; s += nb * 8) {
    const int g = s & 31, d = (s >> 5) & 1, b = s >> 6;
    const int ci = (d * 32 + g) * 64 + lane;
    const float abr = p.s5ab[ci * 2], abi = p.s5ab[ci * 2 + 1];
    float bbr[16], bbi[16];
#pragma unroll
    for (int q = 0; q < 4; ++q) {
      float4 t = *(const float4*)(p.s5bb + (size_t)ci * 32 + q * 4);
      bbr[q * 4] = t.x; bbr[q * 4 + 1] = t.y; bbr[q * 4 + 2] = t.z; bbr[q * 4 + 3] = t.w;
      float4 t2 = *(const float4*)(p.s5bb + (size_t)ci * 32 + 16 + q * 4);
      bbi[q * 4] = t2.x; bbi[q * 4 + 1] = t2.y; bbi[q * 4 + 2] = t2.z; bbi[q * 4 + 3] = t2.w;
    }
    bf16x8 cf[4];
#pragma unroll
    for (int kb = 0; kb < 4; ++kb)
      cf[kb] = *(const bf16x8*)(p.s5ct + ((size_t)(d * 32 + g) * 16 + fr) * 128 + kb * 32 + fq * 8);
    const float dcoef = p.s5_d[g * 16 + fr];
    u16* ydst = d ? p.ys5b : p.ys5f;
    float hr = 0.f, hi = 0.f;
    for (int seg = 0; seg < 2; ++seg) {
      const int L = seg ? 2048 : 256;
      const int rowbase = seg ? b * 2048 : NLAT + b * 256;
      for (int c0 = 0; c0 < L; c0 += 64) {
        {
          int pos = c0 + lane;
          int t = d ? (L - 1 - pos) : pos;
          const u16* src = p.proj + (size_t)(rowbase + t) * INC + g * 16;
          uint4 v0 = *(const uint4*)src, v1 = *(const uint4*)(src + 8);
          float4* ud = (float4*)(U + lane * 16);
          ud[0] = make_float4(bflo(v0.x), bfhi(v0.x), bflo(v0.y), bfhi(v0.y));
          ud[1] = make_float4(bflo(v0.z), bfhi(v0.z), bflo(v0.w), bfhi(v0.w));
          ud[2] = make_float4(bflo(v1.x), bfhi(v1.x), bflo(v1.y), bfhi(v1.y));
          ud[3] = make_float4(bflo(v1.z), bfhi(v1.z), bflo(v1.w), bfhi(v1.w));
        }
        for (int sub = 0; sub < 4; ++sub) {
#pragma unroll 4
          for (int i = 0; i < 16; ++i) {
            const float4* up = (const float4*)(U + (sub * 16 + i) * 16);
            float4 u0 = up[0], u1 = up[1], u2 = up[2], u3 = up[3];
            float ur[16] = {u0.x, u0.y, u0.z, u0.w, u1.x, u1.y, u1.z, u1.w, u2.x, u2.y, u2.z, u2.w, u3.x, u3.y, u3.z, u3.w};
            float br0 = 0.f, br1 = 0.f, bi0 = 0.f, bi1 = 0.f;
#pragma unroll
            for (int h = 0; h < 16; h += 2) {
              br0 += bbr[h] * ur[h]; br1 += bbr[h + 1] * ur[h + 1];
              bi0 += bbi[h] * ur[h]; bi1 += bbi[h + 1] * ur[h + 1];
            }
            float nr = abr * hr - abi * hi + (br0 + br1);
            float ni = abr * hi + abi * hr + (bi0 + bi1);
            hr = nr; hi = ni;
            if (seg) H[i * 68 + lane] = pack2(hr, hi);
          }
          if (seg) {
            f32x4 acc = (f32x4){0.f, 0.f, 0.f, 0.f};
#pragma unroll
            for (int kb = 0; kb < 4; ++kb) {
              bf16x8 a = *(const bf16x8*)((const u16*)H + fr * 136 + kb * 32 + fq * 8);
              acc = __builtin_amdgcn_mfma_f32_16x16x32_bf16(a, cf[kb], acc, 0, 0, 0);
            }
#pragma unroll
            for (int j = 0; j < 4; ++j) {
              int pi = sub * 16 + fq * 4 + j;
              int pos = c0 + pi;
              int t = d ? (L - 1 - pos) : pos;
              float y = acc[j];
              if (d == 0) y += dcoef * U[pi * 16 + fr];
              ydst[(size_t)(b * 2048 + t) * 512 + g * 16 + fr] = f2bf(y);
            }
          }
        }
      }
    }
  }
}

__device__ __forceinline__ float4 mix_load4(const u16* __restrict__ proj, size_t row, int col, const size_t* nrow,
                                            const bool* nval, float4 mu) {
  uint2 cz = *(const uint2*)(proj + row * INC + col);
  float z[4] = {bflo(cz.x), bfhi(cz.x), bflo(cz.y), bfhi(cz.y)};
  float o[4];
  float m[4] = {mu.x, mu.y, mu.z, mu.w};
#pragma unroll
  for (int j = 0; j < 4; ++j) {
    float nbv = 0.f;
    if (nval[j]) {
      u16 t = proj[nrow[j] * INC + col + j];
      nbv = bf2f(t);
    }
    o[j] = z[j] + (nbv - z[j]) * m[j];
  }
  return make_float4(o[0], o[1], o[2], o[3]);
}
__device__ __forceinline__ void neighbours(bool isctx, size_t row, int t, size_t* nrow, bool* nval) {
  if (isctx) {
    nrow[0] = row - 1; nval[0] = t > 0;
    nrow[1] = row + 1; nval[1] = t < 255;
    nrow[2] = row - 1; nval[2] = t > 0;
    nrow[3] = row + 1; nval[3] = t < 255;
  } else {
    int col = t & 63, gr = t >> 6;
    nrow[0] = row - 1; nval[0] = col > 0;
    nrow[1] = row + 1; nval[1] = col < 63;
    nrow[2] = row - 64; nval[2] = gr > 0;
    nrow[3] = row + 64; nval[3] = gr < 31;
  }
}

__device__ __forceinline__ void ph_rwscan(const P& p, char* smem, int bid, int nb) {
  const int tid = threadIdx.x, sl = tid >> 8, stid = tid & 255, wv = stid >> 6, lane = tid & 63;
  char* sb = smem + sl * 49152;
  float* OPS = (float*)sb;
  float* LW = (float*)(sb + 24576);
  float* LA = LW + 512;
  float* WW = (float*)(sb + 28672);
  float* WA = WW + 2048;
  float* YB = (float*)(sb + 45056);
  const int tt = stid >> 4, part = stid & 15;
  const int vrow = wv * 16 + (lane >> 2), kq = lane & 3;
  for (int sp = bid; sp < 256; sp += nb) {
    const int s = sp * 2 + sl;
    const int d = s & 1, h = (s >> 1) & 7, b = s >> 4;
    __syncthreads();
    for (int e = stid; e < 2048; e += 256) {
      int j = e >> 6, cc = e & 63;
      WW[e] = p.rw_w_w2[(size_t)(d * 32 + j) * 512 + h * 64 + cc];
      WA[e] = p.rw_w_a2[(size_t)(d * 32 + j) * 512 + h * 64 + cc];
    }
    const int hc = h * 64 + part * 4;
    const float4 w0v = *(const float4*)(p.rw_w0 + d * 512 + hc);
    const float4 a0v = *(const float4*)(p.rw_a0 + d * 512 + hc);
    const float4 kkv = *(const float4*)(p.rw_k_k + hc);
    const float4 kav = *(const float4*)(p.rw_k_a + hc);
    const float4 rkv = *(const float4*)(p.rw_r_k + hc);
    const float4 mur = *(const float4*)(p.rw_mu + hc);
    const float4 muk = *(const float4*)(p.rw_mu + 512 + hc);
    const float4 muv = *(const float4*)(p.rw_mu + 1024 + hc);
    const float4 mul = *(const float4*)(p.rw_mu + 1536 + part * 4);
    u16* ydst = d ? p.yrwb : p.yrwf;
    float S[16];
#pragma unroll
    for (int i = 0; i < 16; ++i) S[i] = 0.f;
    for (int seg = 0; seg < 2; ++seg) {
      const int L = seg ? 2048 : 256;
      const size_t rowbase = seg ? (size_t)b * 2048 : (size_t)NLAT + b * 256;
      for (int c0 = 0; c0 < L; c0 += 16) {
        const int pos = c0 + tt;
        const int t = d ? (L - 1 - pos) : pos;
        const size_t row = rowbase + t;
        size_t nrow[4];
        bool nval[4];
        neighbours(seg == 0, row, t, nrow, nval);
        float4 r4 = mix_load4(p.proj, row, 512 + hc, nrow, nval, mur);
        float4 k4 = mix_load4(p.proj, row, 512 + 512 + hc, nrow, nval, muk);
        float4 v4 = mix_load4(p.proj, row, 512 + 1024 + hc, nrow, nval, muv);
        float4 l4 = mix_load4(p.proj, row, 512 + 1536 + part * 4, nrow, nval, mul);
        if (part < 8) {
          *(float4*)(LW + tt * 32 + part * 4) = make_float4(tanhf(l4.x), tanhf(l4.y), tanhf(l4.z), tanhf(l4.w));
        } else {
          *(float4*)(LA + tt * 32 + (part - 8) * 4) = l4;
        }
        __syncthreads();
        float wp[4] = {w0v.x, w0v.y, w0v.z, w0v.w};
        float ap[4] = {a0v.x, a0v.y, a0v.z, a0v.w};
#pragma unroll 8
        for (int j = 0; j < 32; ++j) {
          float lw = LW[tt * 32 + j], la = LA[tt * 32 + j];
          float4 ww = *(const float4*)(WW + j * 64 + part * 4);
          float4 wa = *(const float4*)(WA + j * 64 + part * 4);
          wp[0] += lw * ww.x; wp[1] += lw * ww.y; wp[2] += lw * ww.z; wp[3] += lw * ww.w;
          ap[0] += la * wa.x; ap[1] += la * wa.y; ap[2] += la * wa.z; ap[3] += la * wa.w;
        }
        float rr[4] = {r4.x, r4.y, r4.z, r4.w}, kk4[4] = {k4.x, k4.y, k4.z, k4.w};
        float kkc[4] = {kkv.x, kkv.y, kkv.z, kkv.w}, kac[4] = {kav.x, kav.y, kav.z, kav.w}, rkc[4] = {rkv.x, rkv.y, rkv.z, rkv.w};
        float dec[4], aa[4], kd[4], kkr[4];
        float ss = 0.f, bon = 0.f;
#pragma unroll
        for (int i = 0; i < 4; ++i) {
          float xw = -wp[i];
          float sp_ = fmaxf(xw, 0.f) + log1pf(expf(-fabsf(xw)));
          float wl = -sp_ - 0.5f;
          dec[i] = expf(-expf(wl));
          aa[i] = 1.f / (1.f + expf(-ap[i]));
          kd[i] = kk4[i] * (1.f + (aa[i] - 1.f) * kac[i]);
          kkr[i] = kk4[i] * kkc[i];
          ss += kkr[i] * kkr[i];
          bon += rr[i] * kd[i] * rkc[i];
        }
#pragma unroll
        for (int m = 1; m < 16; m <<= 1) {
          ss += __shfl_xor(ss, m, 64);
          bon += __shfl_xor(bon, m, 64);
        }
        float inv = rsqrtf(ss + 1e-12f);
        float* o = OPS + tt * 384 + part * 4;
        *(float4*)(o + 0) = r4;
        *(float4*)(o + 64) = make_float4(dec[0], dec[1], dec[2], dec[3]);
        *(float4*)(o + 128) = make_float4(kd[0], kd[1], kd[2], kd[3]);
        *(float4*)(o + 192) = make_float4(-kkr[0] * inv, -kkr[1] * inv, -kkr[2] * inv, -kkr[3] * inv);
        *(float4*)(o + 256) = make_float4(kkr[0] * inv * aa[0], kkr[1] * inv * aa[1], kkr[2] * inv * aa[2], kkr[3] * inv * aa[3]);
        *(float4*)(o + 320) = v4;
        if (seg && part == 0) p.bsc[((size_t)d * NLAT + row) * 8 + h] = bon;
        __syncthreads();
        for (int i = 0; i < 16; ++i) {
          const float* oo = OPS + i * 384 + kq * 16;
          float kn[16], wv_[16], bv[16], kdv[16];
#pragma unroll
          for (int q = 0; q < 4; ++q) {
            float4 a = *(const float4*)(oo + 192 + q * 4);
            kn[q * 4] = a.x; kn[q * 4 + 1] = a.y; kn[q * 4 + 2] = a.z; kn[q * 4 + 3] = a.w;
            float4 w_ = *(const float4*)(oo + 64 + q * 4);
            wv_[q * 4] = w_.x; wv_[q * 4 + 1] = w_.y; wv_[q * 4 + 2] = w_.z; wv_[q * 4 + 3] = w_.w;
            float4 b_ = *(const float4*)(oo + 256 + q * 4);
            bv[q * 4] = b_.x; bv[q * 4 + 1] = b_.y; bv[q * 4 + 2] = b_.z; bv[q * 4 + 3] = b_.w;
            float4 k_ = *(const float4*)(oo + 128 + q * 4);
            kdv[q * 4] = k_.x; kdv[q * 4 + 1] = k_.y; kdv[q * 4 + 2] = k_.z; kdv[q * 4 + 3] = k_.w;
          }
          float vv = OPS[i * 384 + 320 + vrow];
          float s0 = 0.f, s1 = 0.f, s2 = 0.f, s3 = 0.f;
#pragma unroll
          for (int q = 0; q < 16; q += 4) {
            s0 += S[q] * kn[q]; s1 += S[q + 1] * kn[q + 1]; s2 += S[q + 2] * kn[q + 2]; s3 += S[q + 3] * kn[q + 3];
          }
          float sa = (s0 + s1) + (s2 + s3);
          sa += __shfl_xor(sa, 1, 64);
          sa += __shfl_xor(sa, 2, 64);
#pragma unroll
          for (int q = 0; q < 16; ++q) S[q] = S[q] * wv_[q] + sa * bv[q] + vv * kdv[q];
          if (seg) {
            float rv[16];
#pragma unroll
            for (int q = 0; q < 4; ++q) {
              float4 a = *(const float4*)(oo + q * 4);
              rv[q * 4] = a.x; rv[q * 4 + 1] = a.y; rv[q * 4 + 2] = a.z; rv[q * 4 + 3] = a.w;
            }
            float y0 = 0.f, y1 = 0.f, y2 = 0.f, y3 = 0.f;
#pragma unroll
            for (int q = 0; q < 16; q += 4) {
              y0 += S[q] * rv[q]; y1 += S[q + 1] * rv[q + 1]; y2 += S[q + 2] * rv[q + 2]; y3 += S[q + 3] * rv[q + 3];
            }
            float y = (y0 + y1) + (y2 + y3);
            y += __shfl_xor(y, 1, 64);
            y += __shfl_xor(y, 2, 64);
            if (kq == 0) YB[i * 64 + vrow] = y;
          }
        }
        __syncthreads();
        if (seg) {
          float4 yv = *(const float4*)(YB + tt * 64 + part * 4);
          uint2 o2;
          o2.x = pack2(yv.x, yv.y); o2.y = pack2(yv.z, yv.w);
          *(uint2*)(ydst + row * 512 + hc) = o2;
        }
      }
    }
  }
}

__device__ __forceinline__ void ph_mixprep(const P& p, int bid, int nb) {
  const int wid = threadIdx.x >> 6, lane = threadIdx.x & 63;
  const int c8 = lane * 8;
  for (int row = bid * 8 + wid; row < NLAT; row += nb * 8) {
    const int t = row & 2047;
    {
      uint4 a = *(const uint4*)(p.ys5f + (size_t)row * 512 + c8), b2 = *(const uint4*)(p.ys5b + (size_t)row * 512 + c8);
      unsigned au[4] = {a.x, a.y, a.z, a.w}, bu[4] = {b2.x, b2.y, b2.z, b2.w}, ou[4];
#pragma unroll
      for (int q = 0; q < 4; ++q) {
        float y0 = bflo(au[q]) + bflo(bu[q]), y1 = bfhi(au[q]) + bfhi(bu[q]);
        ou[q] = pack2(gelu_exact(y0), gelu_exact(y1));
      }
      *(uint4*)(p.ys5f + (size_t)row * 512 + c8) = make_uint4(ou[0], ou[1], ou[2], ou[3]);
    }
    float y[8];
    {
      uint4 a = *(const uint4*)(p.yrwf + (size_t)row * 512 + c8), b2 = *(const uint4*)(p.yrwb + (size_t)row * 512 + c8);
      unsigned au[4] = {a.x, a.y, a.z, a.w}, bu[4] = {b2.x, b2.y, b2.z, b2.w};
#pragma unroll
      for (int q = 0; q < 4; ++q) {
        y[2 * q] = bflo(au[q]) + bflo(bu[q]);
        y[2 * q + 1] = bfhi(au[q]) + bfhi(bu[q]);
      }
    }
    float sm = 0.f;
#pragma unroll
    for (int i = 0; i < 8; ++i) sm += y[i];
    sm += __shfl_xor(sm, 1, 64); sm += __shfl_xor(sm, 2, 64); sm += __shfl_xor(sm, 4, 64);
    float mu = sm * (1.f / 64.f);
    float sv = 0.f;
#pragma unroll
    for (int i = 0; i < 8; ++i) sv += (y[i] - mu) * (y[i] - mu);
    sv += __shfl_xor(sv, 1, 64); sv += __shfl_xor(sv, 2, 64); sv += __shfl_xor(sv, 4, 64);
    float rs = rsqrtf(sv * (1.f / 64.f) + 64e-5f);
    size_t nrow[4];
    bool nval[4];
    neighbours(false, (size_t)row, t, nrow, nval);
    float v[8];
    {
      int col = 512 + 1024 + c8;
      uint4 cz = *(const uint4*)(p.proj + (size_t)row * INC + col);
      unsigned cu[4] = {cz.x, cz.y, cz.z, cz.w};
      float4 m0 = *(const float4*)(p.rw_mu + 1024 + c8), m1 = *(const float4*)(p.rw_mu + 1024 + c8 + 4);
      float mm[8] = {m0.x, m0.y, m0.z, m0.w, m1.x, m1.y, m1.z, m1.w};
#pragma unroll
      for (int i = 0; i < 8; ++i) {
        float z = (i & 1) ? bfhi(cu[i >> 1]) : bflo(cu[i >> 1]);
        float nbv = 0.f;
        if (nval[i & 3]) nbv = bf2f(p.proj[nrow[i & 3] * INC + col + i]);
        v[i] = z + (nbv - z) * mm[i];
      }
    }
    const int head = lane >> 3;
    float bs = p.bsc[(size_t)row * 8 + head] + p.bsc[((size_t)NLAT + row) * 8 + head];
    {
      float4 w0 = *(const float4*)(p.rw_ln_w + c8), w1 = *(const float4*)(p.rw_ln_w + c8 + 4);
      float4 b0 = *(const float4*)(p.rw_ln_b + c8), b1 = *(const float4*)(p.rw_ln_b + c8 + 4);
      float lw[8] = {w0.x, w0.y, w0.z, w0.w, w1.x, w1.y, w1.z, w1.w};
      float lb[8] = {b0.x, b0.y, b0.z, b0.w, b1.x, b1.y, b1.z, b1.w};
      float o[8];
#pragma unroll
      for (int i = 0; i < 8; ++i) o[i] = (y[i] - mu) * rs * lw[i] + lb[i] + bs * v[i];
      *(uint4*)(p.yrwf + (size_t)row * 512 + c8) = make_uint4(pack2(o[0], o[1]), pack2(o[2], o[3]), pack2(o[4], o[5]), pack2(o[6], o[7]));
    }
    if (lane < 16) {
      unsigned ou[4] = {0u, 0u, 0u, 0u};
      if (lane < 12) {
        int col = 512 + 1600 + c8;
        uint4 cz = *(const uint4*)(p.proj + (size_t)row * INC + col);
        unsigned cu[4] = {cz.x, cz.y, cz.z, cz.w};
        float4 m0 = *(const float4*)(p.rw_mu + 1600 + c8), m1 = *(const float4*)(p.rw_mu + 1600 + c8 + 4);
        float mm[8] = {m0.x, m0.y, m0.z, m0.w, m1.x, m1.y, m1.z, m1.w};
        float gsig[8];
#pragma unroll
        for (int i = 0; i < 8; ++i) {
          float z = (i & 1) ? bfhi(cu[i >> 1]) : bflo(cu[i >> 1]);
          float nbv = 0.f;
          if (nval[i & 3]) nbv = bf2f(p.proj[nrow[i & 3] * INC + col + i]);
          float zm = z + (nbv - z) * mm[i];
          gsig[i] = 1.f / (1.f + expf(-zm));
        }
#pragma unroll
        for (int q = 0; q < 4; ++q) ou[q] = pack2(gsig[2 * q], gsig[2 * q + 1]);
      }
      *(uint4*)(p.sg + (size_t)row * 128 + c8) = make_uint4(ou[0], ou[1], ou[2], ou[3]);
    }
  }
}

__constant__ unsigned char CAND_I[52] = {0,0,0,0,0,0,0,0,0,0,0,0,0,0,0,0, 1,1,1,1,1,1,1,1, 2,2,2,2,2, 3,3,3,3, 4,4,4, 5,5, 6,6, 7,7, 8,9,10,11,12,13,14,15, 0,0};
__constant__ unsigned char CAND_J[52] = {0,1,2,3,4,5,6,7,8,9,10,11,12,13,14,15, 0,1,2,3,4,5,6,7, 0,1,2,3,4, 0,1,2,3, 0,1,2, 0,1, 0,1, 0,1, 0,0,0,0,0,0,0,0, 0,0};

#define SC_LD 132
__device__ __forceinline__ void ph_route(const P& p, char* smem, int bid, int nb) {
  float* SC = (float*)smem;
  float* TS = (float*)(smem + 2 * 64 * SC_LD * 4);
  int* TI = (int*)(TS + 2 * 64 * 16);
  const u16* Q = p.proj;
  const int tid = threadIdx.x, wid = tid >> 6, lane = tid & 63, fr = lane & 15, fq = lane >> 4;
  for (int item = bid; item < 1024 * 8; item += nb) {
    const int h = item & 7, row0 = (item >> 3) * 64;
    {
      const int c = wid >> 2, mrow = (wid & 3) * 16;
      f32x4 acc[8];
#pragma unroll
      for (int ni = 0; ni < 8; ++ni) acc[ni] = (f32x4){0.f, 0.f, 0.f, 0.f};
#pragma unroll
      for (int ks = 0; ks < 4; ++ks) {
        bf16x8 a = *(const bf16x8*)(Q + (size_t)(row0 + mrow + fr) * 2048 + h * 256 + c * 128 + ks * 32 + fq * 8);
#pragma unroll
        for (int ni = 0; ni < 8; ++ni) {
          bf16x8 bfr = *(const bf16x8*)(p.keys + ((size_t)(h * 2 + c) * 128 + ni * 16 + fr) * 128 + ks * 32 + fq * 8);
          acc[ni] = __builtin_amdgcn_mfma_f32_16x16x32_bf16(a, bfr, acc[ni], 0, 0, 0);
        }
      }
#pragma unroll
      for (int ni = 0; ni < 8; ++ni)
#pragma unroll
        for (int j = 0; j < 4; ++j) SC[(c * 64 + mrow + fq * 4 + j) * SC_LD + ni * 16 + fr] = acc[ni][j];
    }
    __syncthreads();
    {
      const int task = tid >> 2, q4 = tid & 3;
      const int c = task >> 6, t = task & 63;
      float val[32];
#pragma unroll
      for (int i = 0; i < 32; ++i) val[i] = SC[(c * 64 + t) * SC_LD + i * 4 + q4];
      for (int r = 0; r < 16; ++r) {
        float m = val[0];
#pragma unroll
        for (int i = 1; i < 32; ++i) m = fmaxf(m, val[i]);
        int li = 31;
#pragma unroll
        for (int i = 30; i >= 0; --i) li = (val[i] == m) ? i : li;
        int n = li * 4 + q4;
#pragma unroll
        for (int sh = 1; sh <= 2; sh <<= 1) {
          float om = __shfl_xor(m, sh, 64);
          int on = __shfl_xor(n, sh, 64);
          bool take = (om > m) || (om == m && on < n);
          m = take ? om : m;
          n = take ? on : n;
        }
        const int wi = n >> 2;
        const bool mine = (n & 3) == q4;
#pragma unroll
        for (int i = 0; i < 32; ++i) val[i] = (mine && i == wi) ? -INFINITY : val[i];
        if (q4 == (r & 3)) {
          TS[(c * 64 + t) * 16 + r] = m;
          TI[(c * 64 + t) * 16 + r] = n;
        }
      }
    }
    __syncthreads();
    if (tid < 256) {
      const int t = tid >> 2, q4 = tid & 3;
      float val[13];
      int cid[13];
#pragma unroll
      for (int e = 0; e < 13; ++e) {
        int ci = q4 + 4 * e;
        if (ci < 50) {
          int i = CAND_I[ci], j = CAND_J[ci];
          val[e] = TS[t * 16 + i] + TS[(64 + t) * 16 + j];
          cid[e] = i * 16 + j;
        } else { val[e] = -INFINITY; cid[e] = 1 << 20; }
      }
      float bs_[16];
      int bi_[16];
#pragma unroll
      for (int r = 0; r < 16; ++r) {
        float m = val[0]; int f = cid[0]; int le = 0;
#pragma unroll
        for (int e = 1; e < 13; ++e) {
          bool take = (val[e] > m) || (val[e] == m && cid[e] < f);
          m = take ? val[e] : m; f = take ? cid[e] : f; le = take ? e : le;
        }
        float wm = m; int wf = f;
#pragma unroll
        for (int sh = 1; sh <= 2; sh <<= 1) {
          float om = __shfl_xor(wm, sh, 64);
          int of = __shfl_xor(wf, sh, 64);
          bool take = (om > wm) || (om == wm && of < wf);
          wm = take ? om : wm; wf = take ? of : wf;
        }
        const bool mine = (wf == f) && (wm == m);
#pragma unroll
        for (int e = 0; e < 13; ++e) val[e] = (mine && e == le) ? -INFINITY : val[e];
        bs_[r] = wm; bi_[r] = wf;
      }
      float den = 0.f, ex[16];
#pragma unroll
      for (int r = 0; r < 16; ++r) { ex[r] = __expf(bs_[r] - bs_[0]); den += ex[r]; }
      float rden = 1.f / den;
      const size_t obase = ((size_t)(row0 + t) * 8 + h) * 16;
#pragma unroll
      for (int r = 0; r < 16; ++r) {
        if ((r & 3) == q4) {
          int i = bi_[r] >> 4, j = bi_[r] & 15;
          p.idx[obase + r] = TI[t * 16 + i] * 128 + TI[(64 + t) * 16 + j];
          p.gate[obase + r] = ex[r] * rden;
        }
      }
    }
    __syncthreads();
  }
}

__device__ __forceinline__ void ph_ffn(const P& p, float* __restrict__ dst, int bid, int nb) {
  const int wid = threadIdx.x >> 6, lane = threadIdx.x & 63;
  const u16* H2N = p.hn;
  for (int row = bid * 8 + wid; row < NLAT; row += nb * 8) {
    float hx[16];
    {
      uint4 a = *(const uint4*)(H2N + (size_t)row * 1024 + lane * 16), b2 = *(const uint4*)(H2N + (size_t)row * 1024 + lane * 16 + 8);
      unsigned au[8] = {a.x, a.y, a.z, a.w, b2.x, b2.y, b2.z, b2.w};
#pragma unroll
      for (int q = 0; q < 8; ++q) { hx[2 * q] = bflo(au[q]); hx[2 * q + 1] = bfhi(au[q]); }
    }
    const int id0 = p.idx[(size_t)row * 128 + lane], id1 = p.idx[(size_t)row * 128 + 64 + lane];
    const float us0 = p.usc[id0], us1 = p.usc[id1];
    const float gv0 = p.gate[(size_t)row * 128 + lane] * p.vsc[id0], gv1 = p.gate[(size_t)row * 128 + 64 + lane] * p.vsc[id1];
    float oacc[16];
#pragma unroll
    for (int i = 0; i < 16; ++i) oacc[i] = 0.f;
#pragma unroll
    for (int hf = 0; hf < 2; ++hf) {
      const int idv = hf ? id1 : id0;
      const float usv = hf ? us1 : us0, gvv = hf ? gv1 : gv0;
#pragma unroll 1
      for (int e0 = 0; e0 < 64; e0 += 8) {
        uint4 ur[8], vr[8];
        float usq[8], gvq[8];
#pragma unroll
        for (int q = 0; q < 8; ++q) {
          const int id = __builtin_amdgcn_readlane(idv, e0 + q);
          usq[q] = __int_as_float(__builtin_amdgcn_readlane(__float_as_int(usv), e0 + q));
          gvq[q] = __int_as_float(__builtin_amdgcn_readlane(__float_as_int(gvv), e0 + q));
          ur[q] = *(const uint4*)(p.utab + (size_t)id * 1024 + lane * 16);
          vr[q] = *(const uint4*)(p.vtab + (size_t)id * 1024 + lane * 16);
        }
#pragma unroll
        for (int q = 0; q < 8; ++q) {
          const unsigned uu[4] = {ur[q].x, ur[q].y, ur[q].z, ur[q].w};
          float s0 = 0.f, s1 = 0.f;
#pragma unroll
          for (int k = 0; k < 4; ++k) {
            v2f lo = __builtin_amdgcn_cvt_pk_f32_fp8((int)uu[k], false), hi = __builtin_amdgcn_cvt_pk_f32_fp8((int)uu[k], true);
            s0 += hx[4 * k] * lo[0]; s1 += hx[4 * k + 1] * lo[1];
            s0 += hx[4 * k + 2] * hi[0]; s1 += hx[4 * k + 3] * hi[1];
          }
          const float dot = wave_sum_u(s0 + s1) * usq[q];
          const float cf = gvq[q] * gelu_exact(dot);
          const unsigned vv[4] = {vr[q].x, vr[q].y, vr[q].z, vr[q].w};
#pragma unroll
          for (int k = 0; k < 4; ++k) {
            v2f lo = __builtin_amdgcn_cvt_pk_f32_fp8((int)vv[k], false), hi = __builtin_amdgcn_cvt_pk_f32_fp8((int)vv[k], true);
            oacc[4 * k] += cf * lo[0]; oacc[4 * k + 1] += cf * lo[1];
            oacc[4 * k + 2] += cf * hi[0]; oacc[4 * k + 3] += cf * hi[1];
          }
        }
      }
    }
    const int b = row >> 11;
    float h3[16];
    float ss = 0.f;
#pragma unroll
    for (int q = 0; q < 4; ++q) {
      const int col = lane * 16 + q * 4;
      float4 a0 = *(const float4*)(p.out + (size_t)row * 1024 + col);
      float4 q0 = *(const float4*)(p.mod + b * 6144 + 5 * 1024 + col);
      h3[q * 4 + 0] = a0.x + q0.x * oacc[q * 4 + 0];
      h3[q * 4 + 1] = a0.y + q0.y * oacc[q * 4 + 1];
      h3[q * 4 + 2] = a0.z + q0.z * oacc[q * 4 + 2];
      h3[q * 4 + 3] = a0.w + q0.w * oacc[q * 4 + 3];
      ss += h3[q * 4] * h3[q * 4] + h3[q * 4 + 1] * h3[q * 4 + 1] + h3[q * 4 + 2] * h3[q * 4 + 2] + h3[q * 4 + 3] * h3[q * 4 + 3];
    }
    ss = wave_sum_u(ss);
    const float rstd = rsqrtf(ss * (1.f / 1024.f) + 1e-6f);
#pragma unroll
    for (int q = 0; q < 4; ++q) {
      const int col = lane * 16 + q * 4;
      float4 n0 = *(const float4*)(p.norm_f_g + col);
      *(float4*)(dst + (size_t)row * 1024 + col) =
          make_float4(h3[q * 4] * rstd * n0.x, h3[q * 4 + 1] * rstd * n0.y, h3[q * 4 + 2] * rstd * n0.z, h3[q * 4 + 3] * rstd * n0.w);
    }
  }
}

#define NPHASES 11
template <int PH>
__device__ __forceinline__ void run_phase(const P& p, char* smem, int bid, int nb, bool rep = false) {
  if (PH == 0) ph_prep(p, smem, bid, nb);
  if (PH == 1) ph_norm(p, 0, bid, nb);
  if (PH == 2) gemm_phase(p.hn, 1024, p.win_t, 1024, 1024, NTOK, INCP, smem, bid, nb, EpiProj{p.proj});
  if (PH == 3) { ph_s5scan(p, smem, bid, nb); ph_rwscan(p, smem, bid, nb); }
  if (PH == 4) ph_mixprep(p, bid, nb);
  if (PH == 5) {
    gemm_phase(p.ys5f, 512, p.wglu_t, 512, 512, NLAT, 512, smem, bid, nb, EpiGlu{p.ys5f, p.s5_b_glu, p.hn});
    gemm_phase(p.sg, 128, p.wg2_t, 128, 128, NLAT, 512, smem, bid, nb, EpiGate{p.yrwf, p.hn});
  }
  if (PH == 6) gemm_phase(p.hn, 1024, p.wout_t, 1024, 1024, NLAT, 1024, smem, bid, nb, EpiWout{p.x, p.mod, p.out});
  if (PH == 7) ph_norm(p, 1, bid, nb);
  if (PH == 8) gemm_phase(p.hn, 1024, p.wq_t, 1024, 1024, NLAT, 2048, smem, bid, nb, EpiQ{p.proj});
  if (PH == 9) ph_route(p, smem, bid, nb);
  if (PH == 10) ph_ffn(p, rep ? (float*)p.proj : p.out, bid, nb);
  if (PH == 11) ph_s5scan(p, smem, bid, nb);
  if (PH == 12) ph_rwscan(p, smem, bid, nb);
}
#ifndef REPMASK
#define REPMASK 0
#endif
#define REP(n) ((REPMASK >> (n)) & 1)
#define PHASE(n) if (ph_lo <= n && n < ph_hi) { if (n > ph_lo) grid.sync(); if (REP(n)) { run_phase<n>(p, smem, bid, nb, true); __syncthreads(); } if (n == 3 && REP(11)) { run_phase<11>(p, smem, bid, nb); __syncthreads(); } if (n == 3 && REP(12)) { run_phase<12>(p, smem, bid, nb); __syncthreads(); } run_phase<n>(p, smem, bid, nb); }
__global__ void __launch_bounds__(NTHREADS) mega(P p, int ph_lo, int ph_hi) {
  extern __shared__ __attribute__((aligned(16))) char smem[];
  cg::grid_group grid = cg::this_grid();
  const int bid = blockIdx.x, nb = gridDim.x;
  PHASE(0) PHASE(1) PHASE(2) PHASE(3) PHASE(4) PHASE(5) PHASE(6) PHASE(7) PHASE(8) PHASE(9) PHASE(10)
}

extern "C" void kernel_launch(void* const* d_in, const int* in_sizes, int n_in, void* d_out, int out_size, void* d_ws,
                              size_t ws_size, hipStream_t stream) {
  static int grid_blocks = 0;
  if (!grid_blocks) {
    int dev = 0, cus = 0, per_cu = 0;
    hipGetDevice(&dev);
    hipDeviceGetAttribute(&cus, hipDeviceAttributeMultiprocessorCount, dev);
    hipFuncSetAttribute((const void*)mega, hipFuncAttributeMaxDynamicSharedMemorySize, LDS_BYTES);
    hipOccupancyMaxActiveBlocksPerMultiprocessor(&per_cu, (const void*)mega, NTHREADS, LDS_BYTES);
    if (per_cu < 1) { fprintf(stderr, "occupancy query returned %d\n", per_cu); per_cu = 1; }
    grid_blocks = cus;
  }
  P p{};
  const float** fp = (const float**)&p;
  for (int i = 0; i < 36; ++i) fp[i] = (const float*)d_in[i];
  p.out = (float*)d_out;
  char* w = (char*)d_ws;
  size_t off = 0;
  auto take = [&](size_t bytes) { char* r = w + off; off += (bytes + 255) & ~(size_t)255; return r; };
  p.mod = (float*)take(33 * 6144 * 4);
  p.win_t = (u16*)take((size_t)INCP * 1024 * 2);
  p.wout_t = (u16*)take((size_t)1024 * 1024 * 2);
  p.wq_t = (u16*)take((size_t)2048 * 1024 * 2);
  p.wglu_t = (u16*)take((size_t)512 * 512 * 2);
  p.wg2_t = (u16*)take((size_t)512 * 128 * 2);
  p.keys = (u16*)take((size_t)8 * 2 * 128 * 128 * 2);
  p.utab = (unsigned char*)take((size_t)16384 * 1024);
  p.vtab = (unsigned char*)take((size_t)16384 * 1024);
  p.usc = (float*)take(16384 * 4);
  p.vsc = (float*)take(16384 * 4);
  p.s5ab = (float*)take(4096 * 2 * 4);
  p.s5bb = (float*)take(4096 * 32 * 4);
  p.s5ct = (u16*)take(2 * 32 * 16 * 128 * 2);
  p.hn = (u16*)take((size_t)NTOK * 1024 * 2);
  p.proj = (u16*)take((size_t)NTOK * INC * 2);
  p.ys5f = (u16*)take((size_t)NLAT * 512 * 2);
  p.ys5b = (u16*)take((size_t)NLAT * 512 * 2);
  p.yrwf = (u16*)take((size_t)NLAT * 512 * 2);
  p.yrwb = (u16*)take((size_t)NLAT * 512 * 2);
  p.bsc = (float*)take((size_t)2 * NLAT * 8 * 4);
  p.sg = (u16*)take((size_t)NLAT * 128 * 2);
  p.idx = (int*)p.ys5b;
  p.gate = (float*)p.yrwb;
  if (off > ws_size) { fprintf(stderr, "workspace too small: need %zu have %zu\n", off, ws_size); return; }
#if MEGA
  int lo = 0, hi = NPHASES;
  void* args[] = {&p, &lo, &hi};
  hipError_t e = hipLaunchCooperativeKernel((const void*)mega, dim3(grid_blocks), dim3(NTHREADS), args, LDS_BYTES, stream);
  if (e != hipSuccess) fprintf(stderr, "cooperative launch failed: %s (grid %d)\n", hipGetErrorString(e), grid_blocks);
#else
  for (int ph = 0; ph < NPHASES; ++ph) {
    hipLaunchKernelGGL(mega, dim3(grid_blocks), dim3(NTHREADS), LDS_BYTES, stream, p, ph, ph + 1);
  }
#endif
}
```

```cpp
#include <hip/hip_runtime.h>
#include <hip/hip_cooperative_groups.h>
#include <stdint.h>
#include <stdio.h>
namespace cg = cooperative_groups;

#ifndef MEGA
#define MEGA 1
#endif

typedef unsigned short u16;
using bf16x8 = __attribute__((ext_vector_type(8))) short;
using f32x4 = __attribute__((ext_vector_type(4))) float;
using u32x4 = __attribute__((ext_vector_type(4))) unsigned;

#define DM 1024
#define NLAT 65536
#define NCTX 8192
#define NTOK 73728
#define INC 2208
#define INCP 2304
#define NTHREADS 512
#define LDS_BYTES 163840

struct P {
  const float *x, *c, *ctx, *c_ctx, *w_ada, *b_ada, *norm1_g, *norm2_g, *w_in, *s5_a_re, *s5_a_im, *s5_log_dt,
      *s5_b_re, *s5_b_im, *s5_c_re, *s5_c_im, *s5_d, *s5_w_glu, *s5_b_glu, *rw_mu, *rw_w0, *rw_w_w2, *rw_a0, *rw_w_a2,
      *rw_w_g2, *rw_k_k, *rw_k_a, *rw_r_k, *rw_ln_w, *rw_ln_b, *w_out, *peer_w_q, *peer_keys, *peer_u, *peer_v, *norm_f_g;
  float* out;
  float* mod;
  u16 *win_t, *wout_t, *wq_t, *wglu_t, *wg2_t, *keys;
  unsigned char *utab, *vtab;
  float *usc, *vsc;
  float *s5ab, *s5bb;
  u16* s5ct;
  u16 *hn, *proj, *ys5f, *ys5b, *yrwf, *yrwb;
  float* bsc;
  u16* sg;
  int* idx;
  float* gate;
};

__device__ __forceinline__ u16 f2bf(float f) {
  unsigned u = __float_as_uint(f);
  u += 0x7fffu + ((u >> 16) & 1u);
  return (u16)(u >> 16);
}
__device__ __forceinline__ float bf2f(u16 h) { return __uint_as_float(((unsigned)h) << 16); }
__device__ __forceinline__ unsigned pack2(float a, float b) { return (unsigned)f2bf(a) | ((unsigned)f2bf(b) << 16); }
__device__ __forceinline__ float bflo(unsigned u) { return __uint_as_float(u << 16); }
__device__ __forceinline__ float bfhi(unsigned u) { return __uint_as_float(u & 0xffff0000u); }
__device__ __forceinline__ float wave_sum(float v) {
#pragma unroll
  for (int m = 32; m >= 1; m >>= 1) v += __shfl_xor(v, m, 64);
  return v;
}
__device__ __forceinline__ float gelu_exact(float x) { return 0.5f * x * (1.f + erff(x * 0.70710678118654752f)); }
__device__ __forceinline__ float sigmoidf(float x) { return 1.f / (1.f + __expf(-x)); }


typedef float v2f __attribute__((ext_vector_type(2)));
__device__ __forceinline__ float dpp_add(float v, const int ctrl, const int rmask) {
  int m;
  switch (ctrl) {
    case 0: m = __builtin_amdgcn_update_dpp(0, __float_as_int(v), 0xB1, 0xf, 0xf, true); break;
    case 1: m = __builtin_amdgcn_update_dpp(0, __float_as_int(v), 0x4E, 0xf, 0xf, true); break;
    case 2: m = __builtin_amdgcn_update_dpp(0, __float_as_int(v), 0x141, 0xf, 0xf, true); break;
    case 3: m = __builtin_amdgcn_update_dpp(0, __float_as_int(v), 0x140, 0xf, 0xf, true); break;
    case 4: m = __builtin_amdgcn_update_dpp(0, __float_as_int(v), 0x142, 0xa, 0xf, false); break;
    default: m = __builtin_amdgcn_update_dpp(0, __float_as_int(v), 0x143, 0xc, 0xf, false); break;
  }
  return v + __int_as_float(m);
}
__device__ __forceinline__ float wave_sum_u(float v) {
  v = dpp_add(v, 0, 0); v = dpp_add(v, 1, 0); v = dpp_add(v, 2, 0); v = dpp_add(v, 3, 0);
  v = dpp_add(v, 4, 0); v = dpp_add(v, 5, 0);
  return __int_as_float(__builtin_amdgcn_readlane(__float_as_int(v), 63));
}
__device__ __forceinline__ void convert_fp8_rows(const float* __restrict__ src, unsigned char* __restrict__ dst, float* __restrict__ sc,
                                                 int nrows, int bid, int nb) {
  const int wid = threadIdx.x >> 6, lane = threadIdx.x & 63;
  for (int row = bid * 8 + wid; row < nrows; row += nb * 8) {
    float4 v[4];
    float am = 0.f;
#pragma unroll
    for (int q = 0; q < 4; ++q) {
      v[q] = *(const float4*)(src + (size_t)row * 1024 + lane * 16 + q * 4);
      am = fmaxf(am, fmaxf(fmaxf(fabsf(v[q].x), fabsf(v[q].y)), fmaxf(fabsf(v[q].z), fabsf(v[q].w))));
    }
#pragma unroll
    for (int m = 32; m >= 1; m >>= 1) am = fmaxf(am, __shfl_xor(am, m, 64));
    float scl = am > 0.f ? 448.f / am : 1.f;
    unsigned o[4];
#pragma unroll
    for (int q = 0; q < 4; ++q) {
      int w = 0;
      w = __builtin_amdgcn_cvt_pk_fp8_f32(v[q].x * scl, v[q].y * scl, w, false);
      w = __builtin_amdgcn_cvt_pk_fp8_f32(v[q].z * scl, v[q].w * scl, w, true);
      o[q] = (unsigned)w;
    }
    *(uint4*)(dst + (size_t)row * 1024 + lane * 16) = make_uint4(o[0], o[1], o[2], o[3]);
    if (lane == 0) sc[row] = am > 0.f ? am / 448.f : 1.f;
  }
}

__device__ __forceinline__ void transpose_tiles(const float* __restrict__ src, int K, int N, u16* __restrict__ dst, int Kd, int Npad,
                                char* smem, int bid, int nb) {
  float* tile = (float*)smem;
  const int tid = threadIdx.x;
  const int nkt = Kd / 64, nnt = Npad / 64;
  for (int t = bid; t < nkt * nnt; t += nb) {
    int kt = t % nkt, nt = t / nkt;
    int k0 = kt * 64, n0 = nt * 64;
    __syncthreads();
#pragma unroll
    for (int it = 0; it < 8; ++it) {
      int i = (tid >> 6) + it * 8, j = tid & 63;
      int k = k0 + i, n = n0 + j;
      tile[i * 65 + j] = (k < K && n < N) ? src[(size_t)k * N + n] : 0.f;
    }
    __syncthreads();
    int n = tid >> 3, kc = (tid & 7) * 8;
    uint4 o;
    o.x = pack2(tile[(kc + 0) * 65 + n], tile[(kc + 1) * 65 + n]);
    o.y = pack2(tile[(kc + 2) * 65 + n], tile[(kc + 3) * 65 + n]);
    o.z = pack2(tile[(kc + 4) * 65 + n], tile[(kc + 5) * 65 + n]);
    o.w = pack2(tile[(kc + 6) * 65 + n], tile[(kc + 7) * 65 + n]);
    *(uint4*)(dst + (size_t)(n0 + n) * Kd + k0 + kc) = o;
  }
}

__device__ __forceinline__ void convert_bf16(const float* __restrict__ src, u16* __restrict__ dst, size_t n8, int bid, int nb) {
  for (size_t i = (size_t)bid * NTHREADS + threadIdx.x; i < n8; i += (size_t)nb * NTHREADS) {
    float4 a = *(const float4*)(src + i * 8), b = *(const float4*)(src + i * 8 + 4);
    uint4 o;
    o.x = pack2(a.x, a.y); o.y = pack2(a.z, a.w); o.z = pack2(b.x, b.y); o.w = pack2(b.z, b.w);
    *(uint4*)(dst + i * 8) = o;
  }
}

__device__ __forceinline__ void ph_prep(const P& p, char* smem, int bid, int nb) {
  const int tid = threadIdx.x;
  {
    float* sc = (float*)smem;
    float* red = (float*)(smem + 33 * 128 * 4);
    for (int item = bid; item < 96; item += nb) {
      const int j0 = item * 64, kg = tid >> 6, col = tid & 63;
      float acc[33];
#pragma unroll
      for (int b = 0; b < 33; ++b) acc[b] = 0.f;
      for (int ch = 0; ch < 8; ++ch) {
        __syncthreads();
        for (int e = tid; e < 33 * 128; e += NTHREADS) {
          int b = e >> 7, kk = e & 127;
          float cv = (b < 32) ? p.c[b * 1024 + ch * 128 + kk] : p.c_ctx[ch * 128 + kk];
          sc[e] = cv / (1.f + expf(-cv));
        }
        __syncthreads();
        for (int i = 0; i < 16; ++i) {
          int kk = kg * 16 + i;
          float w = p.w_ada[(size_t)(ch * 128 + kk) * 6144 + j0 + col];
#pragma unroll
          for (int b = 0; b < 33; ++b) acc[b] += sc[b * 128 + kk] * w;
        }
      }
#pragma unroll
      for (int b = 0; b < 33; ++b) red[(kg * 33 + b) * 64 + col] = acc[b];
      __syncthreads();
      for (int e = tid; e < 33 * 64; e += NTHREADS) {
        int b = e >> 6, cc = e & 63;
        float s = p.b_ada[j0 + cc];
#pragma unroll
        for (int k2 = 0; k2 < 8; ++k2) s += red[(k2 * 33 + b) * 64 + cc];
        p.mod[b * 6144 + j0 + cc] = s;
      }
      __syncthreads();
    }
  }
  transpose_tiles(p.w_in, 1024, INC, p.win_t, 1024, INCP, smem, bid, nb);
  transpose_tiles(p.w_out, 1024, 1024, p.wout_t, 1024, 1024, smem, bid, nb);
  transpose_tiles(p.peer_w_q, 1024, 2048, p.wq_t, 1024, 2048, smem, bid, nb);
  transpose_tiles(p.s5_w_glu, 512, 512, p.wglu_t, 512, 512, smem, bid, nb);
  transpose_tiles(p.rw_w_g2, 96, 512, p.wg2_t, 128, 512, smem, bid, nb);
  convert_bf16(p.peer_keys, p.keys, (size_t)8 * 2 * 128 * 128 / 8, bid, nb);
  convert_fp8_rows(p.peer_u, p.utab, p.usc, 16384, bid, nb);
  convert_fp8_rows(p.peer_v, p.vtab, p.vsc, 16384, bid, nb);
  for (int it = bid * NTHREADS + tid; it < 4096; it += nb * NTHREADS) {
    int pp = it & 63, g = (it >> 6) & 31, d = it >> 11;
    float are = p.s5_a_re[it], aim = p.s5_a_im[it];
    float dt = expf(p.s5_log_dt[d * 32 + g]);
    float mag = expf(dt * are);
    float abr = mag * cosf(dt * aim), abi = mag * sinf(dt * aim);
    float nr = abr - 1.f, ni = abi;
    float den = are * are + aim * aim;
    float cfr = (nr * are + ni * aim) / den, cfi = (ni * are - nr * aim) / den;
    p.s5ab[it * 2] = abr;
    p.s5ab[it * 2 + 1] = abi;
    for (int h = 0; h < 16; ++h) {
      float br = p.s5_b_re[(size_t)it * 16 + h], bi = p.s5_b_im[(size_t)it * 16 + h];
      p.s5bb[(size_t)it * 32 + h] = cfr * br - cfi * bi;
      p.s5bb[(size_t)it * 32 + 16 + h] = cfr * bi + cfi * br;
    }
    for (int h = 0; h < 16; ++h) {
      size_t ci = ((size_t)(d * 32 + g) * 16 + h) * 64 + pp;
      p.s5ct[((size_t)(d * 32 + g) * 16 + h) * 128 + 2 * pp] = f2bf(p.s5_c_re[ci]);
      p.s5ct[((size_t)(d * 32 + g) * 16 + h) * 128 + 2 * pp + 1] = f2bf(-p.s5_c_im[ci]);
    }
  }
}

__device__ __forceinline__ void ph_norm(const P& p, int mode, int bid, int nb) {
  const int wid = threadIdx.x >> 6, lane = threadIdx.x & 63;
  const int nrows = mode == 0 ? NTOK : NLAT;
  const float* gvec = mode == 0 ? p.norm1_g : p.norm2_g;
  const int sh_off = mode == 0 ? 0 : 3 * 1024, sc_off = sh_off + 1024;
  for (int row = bid * 8 + wid; row < nrows; row += nb * 8) {
    const float* src;
    int b;
    if (mode == 0) {
      if (row < NLAT) { src = p.x + (size_t)row * 1024; b = row >> 11; }
      else { src = p.ctx + (size_t)(row - NLAT) * 1024; b = 32; }
    } else { src = p.out + (size_t)row * 1024; b = row >> 11; }
    float4 v[4];
    float ss = 0.f;
#pragma unroll
    for (int j = 0; j < 4; ++j) {
      v[j] = *(const float4*)(src + j * 256 + lane * 4);
      ss += v[j].x * v[j].x + v[j].y * v[j].y + v[j].z * v[j].z + v[j].w * v[j].w;
    }
    ss = wave_sum(ss);
    float rstd = rsqrtf(ss * (1.f / 1024.f) + 1e-6f);
    const float* mrow = p.mod + b * 6144;
#pragma unroll
    for (int j = 0; j < 4; ++j) {
      int col = j * 256 + lane * 4;
      float4 g = *(const float4*)(gvec + col);
      float4 sh = *(const float4*)(mrow + sh_off + col);
      float4 sc = *(const float4*)(mrow + sc_off + col);
      float y0 = v[j].x * rstd * g.x * (1.f + sc.x) + sh.x;
      float y1 = v[j].y * rstd * g.y * (1.f + sc.y) + sh.y;
      float y2 = v[j].z * rstd * g.z * (1.f + sc.z) + sh.z;
      float y3 = v[j].w * rstd * g.w * (1.f + sc.w) + sh.w;
      uint2 o;
      o.x = pack2(y0, y1); o.y = pack2(y2, y3);
      *(uint2*)(p.hn + (size_t)row * 1024 + col) = o;
    }
  }
}

#define G_BM 256
#define G_BN 128
#define G_BK 64
#define G_LD 72
template <class Epi>
__device__ __forceinline__ void gemm_phase(const u16* __restrict__ A, int lda, const u16* __restrict__ Bt, int ldb, int K, int M, int N,
                           char* smem, int bid, int nb, Epi epi) {
  u16* As = (u16*)smem;
  u16* Bs = (u16*)(smem + 2 * G_BM * G_LD * 2);
  const int tid = threadIdx.x, wid = tid >> 6, lane = tid & 63;
  const int wr = wid >> 1, wc = wid & 1, fr = lane & 15, fq = lane >> 4;
  const int ntn = N / G_BN, ntiles = (M / G_BM) * ntn, nk = K / G_BK;
  const int lrow = tid >> 3, lkc = (tid & 7) * 8;
  for (int tile = bid; tile < ntiles; tile += nb) {
    const int m0 = (tile / ntn) * G_BM, n0 = (tile % ntn) * G_BN;
    f32x4 acc[4][4];
#pragma unroll
    for (int i = 0; i < 4; ++i)
#pragma unroll
      for (int j = 0; j < 4; ++j) acc[i][j] = (f32x4){0.f, 0.f, 0.f, 0.f};
    u32x4 ra[4], rb[2];
    const u16* Ag = A + (size_t)(m0 + lrow) * lda + lkc;
    const u16* Bg = Bt + (size_t)(n0 + lrow) * ldb + lkc;
#pragma unroll
    for (int i = 0; i < 4; ++i) ra[i] = *(const u32x4*)(Ag + (size_t)(64 * i) * lda);
#pragma unroll
    for (int i = 0; i < 2; ++i) rb[i] = *(const u32x4*)(Bg + (size_t)(64 * i) * ldb);
    __syncthreads();
#pragma unroll
    for (int i = 0; i < 4; ++i) *(u32x4*)(As + (lrow + 64 * i) * G_LD + lkc) = ra[i];
#pragma unroll
    for (int i = 0; i < 2; ++i) *(u32x4*)(Bs + (lrow + 64 * i) * G_LD + lkc) = rb[i];
    __syncthreads();
    for (int kt = 0; kt < nk; ++kt) {
      const int buf = kt & 1;
      if (kt + 1 < nk) {
#pragma unroll
        for (int i = 0; i < 4; ++i) ra[i] = *(const u32x4*)(Ag + (size_t)(64 * i) * lda + (kt + 1) * G_BK);
#pragma unroll
        for (int i = 0; i < 2; ++i) rb[i] = *(const u32x4*)(Bg + (size_t)(64 * i) * ldb + (kt + 1) * G_BK);
      }
      const u16* as = As + buf * (G_BM * G_LD);
      const u16* bs = Bs + buf * (G_BN * G_LD);
#pragma unroll
      for (int ks = 0; ks < 2; ++ks) {
        bf16x8 af[4], bfr[4];
#pragma unroll
        for (int mi = 0; mi < 4; ++mi) af[mi] = *(const bf16x8*)(as + (wr * 64 + mi * 16 + fr) * G_LD + ks * 32 + fq * 8);
#pragma unroll
        for (int ni = 0; ni < 4; ++ni) bfr[ni] = *(const bf16x8*)(bs + (wc * 64 + ni * 16 + fr) * G_LD + ks * 32 + fq * 8);
#pragma unroll
        for (int mi = 0; mi < 4; ++mi)
#pragma unroll
          for (int ni = 0; ni < 4; ++ni)
            acc[mi][ni] = __builtin_amdgcn_mfma_f32_16x16x32_bf16(af[mi], bfr[ni], acc[mi][ni], 0, 0, 0);
      }
      if (kt + 1 < nk) {
        u16* as2 = As + (buf ^ 1) * (G_BM * G_LD);
        u16* bs2 = Bs + (buf ^ 1) * (G_BN * G_LD);
#pragma unroll
        for (int i = 0; i < 4; ++i) *(u32x4*)(as2 + (lrow + 64 * i) * G_LD + lkc) = ra[i];
#pragma unroll
        for (int i = 0; i < 2; ++i) *(u32x4*)(bs2 + (lrow + 64 * i) * G_LD + lkc) = rb[i];
      }
      __syncthreads();
    }
#pragma unroll
    for (int mi = 0; mi < 4; ++mi)
#pragma unroll
      for (int ni = 0; ni < 4; ++ni) epi(m0 + wr * 64 + mi * 16 + fq * 4, n0 + wc * 64 + ni * 16 + fr, acc[mi][ni]);
  }
}

struct EpiProj {
  u16* proj;
  __device__ __forceinline__ void operator()(int r, int c, f32x4 v) const {
    if (c < INC) {
#pragma unroll
      for (int j = 0; j < 4; ++j) proj[(size_t)(r + j) * INC + c] = f2bf(v[j]);
    }
  }
};
struct EpiGlu {
  const u16* y1; const float* bglu; u16* a2;
  __device__ __forceinline__ void operator()(int r, int c, f32x4 v) const {
    float bb = bglu[c];
#pragma unroll
    for (int j = 0; j < 4; ++j) {
      float y = bf2f(y1[(size_t)(r + j) * 512 + c]);
      a2[(size_t)(r + j) * 1024 + c] = f2bf(y * sigmoidf(v[j] + bb));
    }
  }
};
struct EpiGate {
  const u16* t1; u16* a2;
  __device__ __forceinline__ void operator()(int r, int c, f32x4 v) const {
#pragma unroll
    for (int j = 0; j < 4; ++j) {
      float t = bf2f(t1[(size_t)(r + j) * 512 + c]);
      a2[(size_t)(r + j) * 1024 + 512 + c] = f2bf(t * v[j]);
    }
  }
};
struct EpiWout {
  const float* x; const float* mod; float* h2;
  __device__ __forceinline__ void operator()(int r, int c, f32x4 v) const {
    float g1 = mod[(r >> 11) * 6144 + 2 * 1024 + c];
#pragma unroll
    for (int j = 0; j < 4; ++j) h2[(size_t)(r + j) * 1024 + c] = x[(size_t)(r + j) * 1024 + c] + g1 * v[j];
  }
};
struct EpiQ {
  u16* q;
  __device__ __forceinline__ void operator()(int r, int c, f32x4 v) const {
#pragma unroll
    for (int j = 0; j < 4; ++j) q[(size_t)(r + j) * 2048 + c] = f2bf(v[j]);
  }
};

__device__ __forceinline__ void ph_s5scan(const P& p, char* smem, int bid, int nb) {
  const int wid = threadIdx.x >> 6, lane = threadIdx.x & 63;
  float* U = (float*)(smem + wid * 8448);
  unsigned* H = (unsigned*)((char*)U + 4096);
  const int fr = lane & 15, fq = lane >> 4;
  for (int s = bid * 8 + wid; s < 2048; s += nb * 8) {
    const int g = s & 31, d = (s >> 5) & 1, b = s >> 6;
    const int ci = (d * 32 + g) * 64 + lane;
    const float abr = p.s5ab[ci * 2], abi = p.s5ab[ci * 2 + 1];
    float bbr[16], bbi[16];
#pragma unroll
    for (int q = 0; q < 4; ++q) {
      float4 t = *(const float4*)(p.s5bb + (size_t)ci * 32 + q * 4);
      bbr[q * 4] = t.x; bbr[q * 4 + 1] = t.y; bbr[q * 4 + 2] = t.z; bbr[q * 4 + 3] = t.w;
      float4 t2 = *(const float4*)(p.s5bb + (size_t)ci * 32 + 16 + q * 4);
      bbi[q * 4] = t2.x; bbi[q * 4 + 1] = t2.y; bbi[q * 4 + 2] = t2.z; bbi[q * 4 + 3] = t2.w;
    }
    bf16x8 cf[4];
#pragma unroll
    for (int kb = 0; kb < 4; ++kb)
      cf[kb] = *(const bf16x8*)(p.s5ct + ((size_t)(d * 32 + g) * 16 + fr) * 128 + kb * 32 + fq * 8);
    const float dcoef = p.s5_d[g * 16 + fr];
    u16* ydst = d ? p.ys5b : p.ys5f;
    float hr = 0.f, hi = 0.f;
    for (int seg = 0; seg < 2; ++seg) {
      const int L = seg ? 2048 : 256;
      const int rowbase = seg ? b * 2048 : NLAT + b * 256;
      for (int c0 = 0; c0 < L; c0 += 64) {
        {
          int pos = c0 + lane;
          int t = d ? (L - 1 - pos) : pos;
          const u16* src = p.proj + (size_t)(rowbase + t) * INC + g * 16;
          uint4 v0 = *(const uint4*)src, v1 = *(const uint4*)(src + 8);
          float4* ud = (float4*)(U + lane * 16);
          ud[0] = make_float4(bflo(v0.x), bfhi(v0.x), bflo(v0.y), bfhi(v0.y));
          ud[1] = make_float4(bflo(v0.z), bfhi(v0.z), bflo(v0.w), bfhi(v0.w));
          ud[2] = make_float4(bflo(v1.x), bfhi(v1.x), bflo(v1.y), bfhi(v1.y));
          ud[3] = make_float4(bflo(v1.z), bfhi(v1.z), bflo(v1.w), bfhi(v1.w));
        }
        for (int sub = 0; sub < 4; ++sub) {
#pragma unroll 4
          for (int i = 0; i < 16; ++i) {
            const float4* up = (const float4*)(U + (sub * 16 + i) * 16);
            float4 u0 = up[0], u1 = up[1], u2 = up[2], u3 = up[3];
            float ur[16] = {u0.x, u0.y, u0.z, u0.w, u1.x, u1.y, u1.z, u1.w, u2.x, u2.y, u2.z, u2.w, u3.x, u3.y, u3.z, u3.w};
            float br0 = 0.f, br1 = 0.f, bi0 = 0.f, bi1 = 0.f;
#pragma unroll
            for (int h = 0; h < 16; h += 2) {
              br0 += bbr[h] * ur[h]; br1 += bbr[h + 1] * ur[h + 1];
              bi0 += bbi[h] * ur[h]; bi1 += bbi[h + 1] * ur[h + 1];
            }
            float nr = abr * hr - abi * hi + (br0 + br1);
            float ni = abr * hi + abi * hr + (bi0 + bi1);
            hr = nr; hi = ni;
            if (seg) H[i * 68 + lane] = pack2(hr, hi);
          }
          if (seg) {
            f32x4 acc = (f32x4){0.f, 0.f, 0.f, 0.f};
#pragma unroll
            for (int kb = 0; kb < 4; ++kb) {
              bf16x8 a = *(const bf16x8*)((const u16*)H + fr * 136 + kb * 32 + fq * 8);
              acc = __builtin_amdgcn_mfma_f32_16x16x32_bf16(a, cf[kb], acc, 0, 0, 0);
            }
#pragma unroll
            for (int j = 0; j < 4; ++j) {
              int pi = sub * 16 + fq * 4 + j;
              int pos = c0 + pi;
              int t = d ? (L - 1 - pos) : pos;
              float y = acc[j];
              if (d == 0) y += dcoef * U[pi * 16 + fr];
              ydst[(size_t)(b * 2048 + t) * 512 + g * 16 + fr] = f2bf(y);
            }
          }
        }
      }
    }
  }
}

__device__ __forceinline__ float4 mix_load4(const u16* __restrict__ proj, size_t row, int col, const size_t* nrow,
                                            const bool* nval, float4 mu) {
  uint2 cz = *(const uint2*)(proj + row * INC + col);
  float z[4] = {bflo(cz.x), bfhi(cz.x), bflo(cz.y), bfhi(cz.y)};
  float o[4];
  float m[4] = {mu.x, mu.y, mu.z, mu.w};
#pragma unroll
  for (int j = 0; j < 4; ++j) {
    float nbv = 0.f;
    if (nval[j]) {
      u16 t = proj[nrow[j] * INC + col + j];
      nbv = bf2f(t);
    }
    o[j] = z[j] + (nbv - z[j]) * m[j];
  }
  return make_float4(o[0], o[1], o[2], o[3]);
}
__device__ __forceinline__ void neighbours(bool isctx, size_t row, int t, size_t* nrow, bool* nval) {
  if (isctx) {
    nrow[0] = row - 1; nval[0] = t > 0;
    nrow[1] = row + 1; nval[1] = t < 255;
    nrow[2] = row - 1; nval[2] = t > 0;
    nrow[3] = row + 1; nval[3] = t < 255;
  } else {
    int col = t & 63, gr = t >> 6;
    nrow[0] = row - 1; nval[0] = col > 0;
    nrow[1] = row + 1; nval[1] = col < 63;
    nrow[2] = row - 64; nval[2] = gr > 0;
    nrow[3] = row + 64; nval[3] = gr < 31;
  }
}

__device__ __forceinline__ void ph_rwscan(const P& p, char* smem, int bid, int nb) {
  const int tid = threadIdx.x, sl = tid >> 8, stid = tid & 255, wv = stid >> 6, lane = tid & 63;
  char* sb = smem + sl * 49152;
  float* OPS = (float*)sb;
  float* LW = (float*)(sb + 24576);
  float* LA = LW + 512;
  float* WW = (float*)(sb + 28672);
  float* WA = WW + 2048;
  float* YB = (float*)(sb + 45056);
  const int tt = stid >> 4, part = stid & 15;
  const int vrow = wv * 16 + (lane >> 2), kq = lane & 3;
  for (int sp = bid; sp < 256; sp += nb) {
    const int s = sp * 2 + sl;
    const int d = s & 1, h = (s >> 1) & 7, b = s >> 4;
    __syncthreads();
    for (int e = stid; e < 2048; e += 256) {
      int j = e >> 6, cc = e & 63;
      WW[e] = p.rw_w_w2[(size_t)(d * 32 + j) * 512 + h * 64 + cc];
      WA[e] = p.rw_w_a2[(size_t)(d * 32 + j) * 512 + h * 64 + cc];
    }
    const int hc = h * 64 + part * 4;
    const float4 w0v = *(const float4*)(p.rw_w0 + d * 512 + hc);
    const float4 a0v = *(const float4*)(p.rw_a0 + d * 512 + hc);
    const float4 kkv = *(const float4*)(p.rw_k_k + hc);
    const float4 kav = *(const float4*)(p.rw_k_a + hc);
    const float4 rkv = *(const float4*)(p.rw_r_k + hc);
    const float4 mur = *(const float4*)(p.rw_mu + hc);
    const float4 muk = *(const float4*)(p.rw_mu + 512 + hc);
    const float4 muv = *(const float4*)(p.rw_mu + 1024 + hc);
    const float4 mul = *(const float4*)(p.rw_mu + 1536 + part * 4);
    u16* ydst = d ? p.yrwb : p.yrwf;
    float S[16];
#pragma unroll
    for (int i = 0; i < 16; ++i) S[i] = 0.f;
    for (int seg = 0; seg < 2; ++seg) {
      const int L = seg ? 2048 : 256;
      const size_t rowbase = seg ? (size_t)b * 2048 : (size_t)NLAT + b * 256;
      for (int c0 = 0; c0 < L; c0 += 16) {
        const int pos = c0 + tt;
        const int t = d ? (L - 1 - pos) : pos;
        const size_t row = rowbase + t;
        size_t nrow[4];
        bool nval[4];
        neighbours(seg == 0, row, t, nrow, nval);
        float4 r4 = mix_load4(p.proj, row, 512 + hc, nrow, nval, mur);
        float4 k4 = mix_load4(p.proj, row, 512 + 512 + hc, nrow, nval, muk);
        float4 v4 = mix_load4(p.proj, row, 512 + 1024 + hc, nrow, nval, muv);
        float4 l4 = mix_load4(p.proj, row, 512 + 1536 + part * 4, nrow, nval, mul);
        if (part < 8) {
          *(float4*)(LW + tt * 32 + part * 4) = make_float4(tanhf(l4.x), tanhf(l4.y), tanhf(l4.z), tanhf(l4.w));
        } else {
          *(float4*)(LA + tt * 32 + (part - 8) * 4) = l4;
        }
        __syncthreads();
        float wp[4] = {w0v.x, w0v.y, w0v.z, w0v.w};
        float ap[4] = {a0v.x, a0v.y, a0v.z, a0v.w};
#pragma unroll 8
        for (int j = 0; j < 32; ++j) {
          float lw = LW[tt * 32 + j], la = LA[tt * 32 + j];
          float4 ww = *(const float4*)(WW + j * 64 + part * 4);
          float4 wa = *(const float4*)(WA + j * 64 + part * 4);
          wp[0] += lw * ww.x; wp[1] += lw * ww.y; wp[2] += lw * ww.z; wp[3] += lw * ww.w;
          ap[0] += la * wa.x; ap[1] += la * wa.y; ap[2] += la * wa.z; ap[3] += la * wa.w;
        }
        float rr[4] = {r4.x, r4.y, r4.z, r4.w}, kk4[4] = {k4.x, k4.y, k4.z, k4.w};
        float kkc[4] = {kkv.x, kkv.y, kkv.z, kkv.w}, kac[4] = {kav.x, kav.y, kav.z, kav.w}, rkc[4] = {rkv.x, rkv.y, rkv.z, rkv.w};
        float dec[4], aa[4], kd[4], kkr[4];
        float ss = 0.f, bon = 0.f;
#pragma unroll
        for (int i = 0; i < 4; ++i) {
          float xw = -wp[i];
          float sp_ = fmaxf(xw, 0.f) + log1pf(expf(-fabsf(xw)));
          float wl = -sp_ - 0.5f;
          dec[i] = expf(-expf(wl));
          aa[i] = 1.f / (1.f + expf(-ap[i]));
          kd[i] = kk4[i] * (1.f + (aa[i] - 1.f) * kac[i]);
          kkr[i] = kk4[i] * kkc[i];
          ss += kkr[i] * kkr[i];
          bon += rr[i] * kd[i] * rkc[i];
        }
#pragma unroll
        for (int m = 0; m < 4; ++m) {
          ss = dpp_add(ss, m, 0);
          bon = dpp_add(bon, m, 0);
        }
        float inv = rsqrtf(ss + 1e-12f);
        float* o = OPS + tt * 384 + part * 4;
        *(float4*)(o + 0) = r4;
        *(float4*)(o + 64) = make_float4(dec[0], dec[1], dec[2], dec[3]);
        *(float4*)(o + 128) = make_float4(kd[0], kd[1], kd[2], kd[3]);
        *(float4*)(o + 192) = make_float4(-kkr[0] * inv, -kkr[1] * inv, -kkr[2] * inv, -kkr[3] * inv);
        *(float4*)(o + 256) = make_float4(kkr[0] * inv * aa[0], kkr[1] * inv * aa[1], kkr[2] * inv * aa[2], kkr[3] * inv * aa[3]);
        *(float4*)(o + 320) = v4;
        if (seg && part == 0) p.bsc[((size_t)d * NLAT + row) * 8 + h] = bon;
        __syncthreads();
        for (int i = 0; i < 16; ++i) {
          const float* oo = OPS + i * 384 + kq * 16;
          float kn[16], wv_[16], bv[16], kdv[16];
#pragma unroll
          for (int q = 0; q < 4; ++q) {
            float4 a = *(const float4*)(oo + 192 + q * 4);
            kn[q * 4] = a.x; kn[q * 4 + 1] = a.y; kn[q * 4 + 2] = a.z; kn[q * 4 + 3] = a.w;
            float4 w_ = *(const float4*)(oo + 64 + q * 4);
            wv_[q * 4] = w_.x; wv_[q * 4 + 1] = w_.y; wv_[q * 4 + 2] = w_.z; wv_[q * 4 + 3] = w_.w;
            float4 b_ = *(const float4*)(oo + 256 + q * 4);
            bv[q * 4] = b_.x; bv[q * 4 + 1] = b_.y; bv[q * 4 + 2] = b_.z; bv[q * 4 + 3] = b_.w;
            float4 k_ = *(const float4*)(oo + 128 + q * 4);
            kdv[q * 4] = k_.x; kdv[q * 4 + 1] = k_.y; kdv[q * 4 + 2] = k_.z; kdv[q * 4 + 3] = k_.w;
          }
          float vv = OPS[i * 384 + 320 + vrow];
          float s0 = 0.f, s1 = 0.f, s2 = 0.f, s3 = 0.f;
#pragma unroll
          for (int q = 0; q < 16; q += 4) {
            s0 += S[q] * kn[q]; s1 += S[q + 1] * kn[q + 1]; s2 += S[q + 2] * kn[q + 2]; s3 += S[q + 3] * kn[q + 3];
          }
          float sa = (s0 + s1) + (s2 + s3);
          sa = dpp_add(sa, 0, 0);
          sa = dpp_add(sa, 1, 0);
#pragma unroll
          for (int q = 0; q < 16; ++q) S[q] = S[q] * wv_[q] + sa * bv[q] + vv * kdv[q];
          if (seg) {
            float rv[16];
#pragma unroll
            for (int q = 0; q < 4; ++q) {
              float4 a = *(const float4*)(oo + q * 4);
              rv[q * 4] = a.x; rv[q * 4 + 1] = a.y; rv[q * 4 + 2] = a.z; rv[q * 4 + 3] = a.w;
            }
            float y0 = 0.f, y1 = 0.f, y2 = 0.f, y3 = 0.f;
#pragma unroll
            for (int q = 0; q < 16; q += 4) {
              y0 += S[q] * rv[q]; y1 += S[q + 1] * rv[q + 1]; y2 += S[q + 2] * rv[q + 2]; y3 += S[q + 3] * rv[q + 3];
            }
            float y = (y0 + y1) + (y2 + y3);
            y = dpp_add(y, 0, 0);
            y = dpp_add(y, 1, 0);
            if (kq == 0) YB[i * 64 + vrow] = y;
          }
        }
        __syncthreads();
        if (seg) {
          float4 yv = *(const float4*)(YB + tt * 64 + part * 4);
          uint2 o2;
          o2.x = pack2(yv.x, yv.y); o2.y = pack2(yv.z, yv.w);
          *(uint2*)(ydst + row * 512 + hc) = o2;
        }
      }
    }
  }
}

__device__ __forceinline__ void ph_mixprep(const P& p, int bid, int nb) {
  const int wid = threadIdx.x >> 6, lane = threadIdx.x & 63;
  const int c8 = lane * 8;
  for (int row = bid * 8 + wid; row < NLAT; row += nb * 8) {
    const int t = row & 2047;
    {
      uint4 a = *(const uint4*)(p.ys5f + (size_t)row * 512 + c8), b2 = *(const uint4*)(p.ys5b + (size_t)row * 512 + c8);
      unsigned au[4] = {a.x, a.y, a.z, a.w}, bu[4] = {b2.x, b2.y, b2.z, b2.w}, ou[4];
#pragma unroll
      for (int q = 0; q < 4; ++q) {
        float y0 = bflo(au[q]) + bflo(bu[q]), y1 = bfhi(au[q]) + bfhi(bu[q]);
        ou[q] = pack2(gelu_exact(y0), gelu_exact(y1));
      }
      *(uint4*)(p.ys5f + (size_t)row * 512 + c8) = make_uint4(ou[0], ou[1], ou[2], ou[3]);
    }
    float y[8];
    {
      uint4 a = *(const uint4*)(p.yrwf + (size_t)row * 512 + c8), b2 = *(const uint4*)(p.yrwb + (size_t)row * 512 + c8);
      unsigned au[4] = {a.x, a.y, a.z, a.w}, bu[4] = {b2.x, b2.y, b2.z, b2.w};
#pragma unroll
      for (int q = 0; q < 4; ++q) {
        y[2 * q] = bflo(au[q]) + bflo(bu[q]);
        y[2 * q + 1] = bfhi(au[q]) + bfhi(bu[q]);
      }
    }
    float sm = 0.f;
#pragma unroll
    for (int i = 0; i < 8; ++i) sm += y[i];
    sm += __shfl_xor(sm, 1, 64); sm += __shfl_xor(sm, 2, 64); sm += __shfl_xor(sm, 4, 64);
    float mu = sm * (1.f / 64.f);
    float sv = 0.f;
#pragma unroll
    for (int i = 0; i < 8; ++i) sv += (y[i] - mu) * (y[i] - mu);
    sv += __shfl_xor(sv, 1, 64); sv += __shfl_xor(sv, 2, 64); sv += __shfl_xor(sv, 4, 64);
    float rs = rsqrtf(sv * (1.f / 64.f) + 64e-5f);
    size_t nrow[4];
    bool nval[4];
    neighbours(false, (size_t)row, t, nrow, nval);
    float v[8];
    {
      int col = 512 + 1024 + c8;
      uint4 cz = *(const uint4*)(p.proj + (size_t)row * INC + col);
      unsigned cu[4] = {cz.x, cz.y, cz.z, cz.w};
      float4 m0 = *(const float4*)(p.rw_mu + 1024 + c8), m1 = *(const float4*)(p.rw_mu + 1024 + c8 + 4);
      float mm[8] = {m0.x, m0.y, m0.z, m0.w, m1.x, m1.y, m1.z, m1.w};
#pragma unroll
      for (int i = 0; i < 8; ++i) {
        float z = (i & 1) ? bfhi(cu[i >> 1]) : bflo(cu[i >> 1]);
        float nbv = 0.f;
        if (nval[i & 3]) nbv = bf2f(p.proj[nrow[i & 3] * INC + col + i]);
        v[i] = z + (nbv - z) * mm[i];
      }
    }
    const int head = lane >> 3;
    float bs = p.bsc[(size_t)row * 8 + head] + p.bsc[((size_t)NLAT + row) * 8 + head];
    {
      float4 w0 = *(const float4*)(p.rw_ln_w + c8), w1 = *(const float4*)(p.rw_ln_w + c8 + 4);
      float4 b0 = *(const float4*)(p.rw_ln_b + c8), b1 = *(const float4*)(p.rw_ln_b + c8 + 4);
      float lw[8] = {w0.x, w0.y, w0.z, w0.w, w1.x, w1.y, w1.z, w1.w};
      float lb[8] = {b0.x, b0.y, b0.z, b0.w, b1.x, b1.y, b1.z, b1.w};
      float o[8];
#pragma unroll
      for (int i = 0; i < 8; ++i) o[i] = (y[i] - mu) * rs * lw[i] + lb[i] + bs * v[i];
      *(uint4*)(p.yrwf + (size_t)row * 512 + c8) = make_uint4(pack2(o[0], o[1]), pack2(o[2], o[3]), pack2(o[4], o[5]), pack2(o[6], o[7]));
    }
    if (lane < 16) {
      unsigned ou[4] = {0u, 0u, 0u, 0u};
      if (lane < 12) {
        int col = 512 + 1600 + c8;
        uint4 cz = *(const uint4*)(p.proj + (size_t)row * INC + col);
        unsigned cu[4] = {cz.x, cz.y, cz.z, cz.w};
        float4 m0 = *(const float4*)(p.rw_mu + 1600 + c8), m1 = *(const float4*)(p.rw_mu + 1600 + c8 + 4);
        float mm[8] = {m0.x, m0.y, m0.z, m0.w, m1.x, m1.y, m1.z, m1.w};
        float gsig[8];
#pragma unroll
        for (int i = 0; i < 8; ++i) {
          float z = (i & 1) ? bfhi(cu[i >> 1]) : bflo(cu[i >> 1]);
          float nbv = 0.f;
          if (nval[i & 3]) nbv = bf2f(p.proj[nrow[i & 3] * INC + col + i]);
          float zm = z + (nbv - z) * mm[i];
          gsig[i] = 1.f / (1.f + expf(-zm));
        }
#pragma unroll
        for (int q = 0; q < 4; ++q) ou[q] = pack2(gsig[2 * q], gsig[2 * q + 1]);
      }
      *(uint4*)(p.sg + (size_t)row * 128 + c8) = make_uint4(ou[0], ou[1], ou[2], ou[3]);
    }
  }
}

__constant__ unsigned char CAND_I[52] = {0,0,0,0,0,0,0,0,0,0,0,0,0,0,0,0, 1,1,1,1,1,1,1,1, 2,2,2,2,2, 3,3,3,3, 4,4,4, 5,5, 6,6, 7,7, 8,9,10,11,12,13,14,15, 0,0};
__constant__ unsigned char CAND_J[52] = {0,1,2,3,4,5,6,7,8,9,10,11,12,13,14,15, 0,1,2,3,4,5,6,7, 0,1,2,3,4, 0,1,2,3, 0,1,2, 0,1, 0,1, 0,1, 0,0,0,0,0,0,0,0, 0,0};

#define SC_LD 144
#define KL_LD 136
__device__ __forceinline__ unsigned umax_quad(unsigned v) {
  unsigned o = (unsigned)__builtin_amdgcn_update_dpp(0, (int)v, 0xB1, 0xf, 0xf, true);
  v = v > o ? v : o;
  o = (unsigned)__builtin_amdgcn_update_dpp(0, (int)v, 0x4E, 0xf, 0xf, true);
  return v > o ? v : o;
}
__device__ __forceinline__ unsigned mono_key(float f) {
  unsigned u = __float_as_uint(f);
  return u ^ ((u >> 31) ? 0xFFFFFFFFu : 0x80000000u);
}
__device__ __forceinline__ float mono_inv(unsigned k) {
  unsigned u = (k >> 31) ? (k ^ 0x80000000u) : ~k;
  return __uint_as_float(u);
}
__device__ __forceinline__ unsigned umax3(unsigned a, unsigned b, unsigned c) {
  unsigned m = a > b ? a : b;
  return m > c ? m : c;
}
__device__ __forceinline__ void ph_route(const P& p, char* smem, int bid, int nb) {
  u16* KL = (u16*)smem;
  unsigned* SC = (unsigned*)(smem + 2 * 128 * KL_LD * 2);
  float* TS = (float*)(SC + 2 * 64 * SC_LD);
  int* TI = (int*)(TS + 2 * 64 * 16);
  const u16* Q = p.proj;
  const int tid = threadIdx.x, wid = tid >> 6, lane = tid & 63, fr = lane & 15, fq = lane >> 4;
  int cur_h = -1;
  for (int item = bid; item < 1024 * 8; item += nb) {
    const int h = item & 7, row0 = (item >> 3) * 64;
    if (h != cur_h) {
      __syncthreads();
      for (int e = tid; e < 2 * 128 * 16; e += NTHREADS) {
        int r = e >> 4, kc = (e & 15) * 8;
        *(uint4*)(KL + r * KL_LD + kc) = *(const uint4*)(p.keys + ((size_t)h * 256 + r) * 128 + kc);
      }
      cur_h = h;
      __syncthreads();
    }
    {
      const int c = wid >> 2, mrow = (wid & 3) * 16;
      f32x4 acc[8];
#pragma unroll
      for (int ni = 0; ni < 8; ++ni) acc[ni] = (f32x4){0.f, 0.f, 0.f, 0.f};
      bf16x8 a[4];
#pragma unroll
      for (int ks = 0; ks < 4; ++ks)
        a[ks] = *(const bf16x8*)(Q + (size_t)(row0 + mrow + fr) * 2048 + h * 256 + c * 128 + ks * 32 + fq * 8);
#pragma unroll
      for (int ks = 0; ks < 4; ++ks) {
#pragma unroll
        for (int ni = 0; ni < 8; ++ni) {
          bf16x8 bfr = *(const bf16x8*)(KL + (c * 128 + ni * 16 + fr) * KL_LD + ks * 32 + fq * 8);
          acc[ni] = __builtin_amdgcn_mfma_f32_16x16x32_bf16(a[ks], bfr, acc[ni], 0, 0, 0);
        }
      }
#pragma unroll
      for (int ni = 0; ni < 8; ++ni)
#pragma unroll
        for (int j = 0; j < 4; ++j) {
          const int n = ni * 16 + fr;
          SC[(c * 64 + mrow + fq * 4 + j) * SC_LD + n] = (mono_key(acc[ni][j]) & ~127u) | (unsigned)(127 - n);
        }
    }
    __syncthreads();
    {
      const int task = tid >> 2, q4 = tid & 3;
      unsigned* rowp = SC + task * SC_LD;
      for (int r = 0; r < 16; ++r) {
        unsigned m = 0;
#pragma unroll
        for (int j = 0; j < 8; ++j) {
          uint4 v = *(const uint4*)(rowp + 16 * j + 4 * q4);
          m = umax3(m, v.x, v.y);
          m = umax3(m, v.z, v.w);
        }
        m = umax_quad(m);
        const int n = 127 - (int)(m & 127u);
        if (((n >> 2) & 3) == q4) rowp[n] = 0u;
        if (q4 == (r & 3)) {
          TS[task * 16 + r] = mono_inv(m & ~127u);
          TI[task * 16 + r] = n;
        }
      }
    }
    __syncthreads();
    if (tid < 256) {
      const int t = tid >> 2, q4 = tid & 3;
      unsigned val[13];
#pragma unroll
      for (int e = 0; e < 13; ++e) {
        const int ci = q4 + 4 * e;
        const int i = CAND_I[ci], j = CAND_J[ci];
        const float sv = TS[t * 16 + i] + TS[(64 + t) * 16 + j];
        val[e] = (ci < 50) ? ((mono_key(sv) & ~255u) | (unsigned)(255 - (i * 16 + j))) : 0u;
      }
      unsigned mine[4] = {0u, 0u, 0u, 0u};
      unsigned first = 0u;
#pragma unroll
      for (int r = 0; r < 16; ++r) {
        unsigned m = umax3(val[0], val[1], val[2]);
        m = umax3(m, val[3], val[4]);
        m = umax3(m, val[5], val[6]);
        m = umax3(m, val[7], val[8]);
        m = umax3(m, val[9], val[10]);
        m = umax3(m, val[11], val[12]);
        m = umax_quad(m);
#pragma unroll
        for (int e = 0; e < 13; ++e) val[e] = (val[e] == m) ? 0u : val[e];
        if (r == 0) first = m;
        mine[r >> 2] = (q4 == (r & 3)) ? m : mine[r >> 2];
      }
      float smax;
      {
        const int cid = 255 - (int)(first & 255u);
        smax = TS[t * 16 + (cid >> 4)] + TS[(64 + t) * 16 + (cid & 15)];
      }
      float ex[4];
      int eid[4];
      float part = 0.f;
#pragma unroll
      for (int k = 0; k < 4; ++k) {
        const int cid = 255 - (int)(mine[k] & 255u);
        const int i = cid >> 4, j = cid & 15;
        const float sv = TS[t * 16 + i] + TS[(64 + t) * 16 + j];
        ex[k] = __expf(sv - smax);
        part += ex[k];
        eid[k] = TI[t * 16 + i] * 128 + TI[(64 + t) * 16 + j];
      }
      part = dpp_add(part, 0, 0);
      part = dpp_add(part, 1, 0);
      const float rden = 1.f / part;
      const size_t obase = ((size_t)(row0 + t) * 8 + h) * 16;
#pragma unroll
      for (int k = 0; k < 4; ++k) {
        p.idx[obase + 4 * k + q4] = eid[k];
        p.gate[obase + 4 * k + q4] = ex[k] * rden;
      }
    }
    __syncthreads();
  }
}

__device__ __forceinline__ void ph_ffn(const P& p, float* __restrict__ dst, int bid, int nb) {
  const int wid = threadIdx.x >> 6, lane = threadIdx.x & 63;
  const u16* H2N = p.hn;
  for (int row = bid * 8 + wid; row < NLAT; row += nb * 8) {
    float hx[16];
    {
      uint4 a = *(const uint4*)(H2N + (size_t)row * 1024 + lane * 16), b2 = *(const uint4*)(H2N + (size_t)row * 1024 + lane * 16 + 8);
      unsigned au[8] = {a.x, a.y, a.z, a.w, b2.x, b2.y, b2.z, b2.w};
#pragma unroll
      for (int q = 0; q < 8; ++q) { hx[2 * q] = bflo(au[q]); hx[2 * q + 1] = bfhi(au[q]); }
    }
    const int id0 = p.idx[(size_t)row * 128 + lane], id1 = p.idx[(size_t)row * 128 + 64 + lane];
    const float us0 = p.usc[id0], us1 = p.usc[id1];
    const float gv0 = p.gate[(size_t)row * 128 + lane] * p.vsc[id0], gv1 = p.gate[(size_t)row * 128 + 64 + lane] * p.vsc[id1];
    float oacc[16];
#pragma unroll
    for (int i = 0; i < 16; ++i) oacc[i] = 0.f;
#pragma unroll
    for (int hf = 0; hf < 2; ++hf) {
      const int idv = hf ? id1 : id0;
      const float usv = hf ? us1 : us0, gvv = hf ? gv1 : gv0;
#pragma unroll 1
      for (int e0 = 0; e0 < 64; e0 += 8) {
        uint4 ur[8], vr[8];
        float usq[8], gvq[8];
#pragma unroll
        for (int q = 0; q < 8; ++q) {
          const int id = __builtin_amdgcn_readlane(idv, e0 + q);
          usq[q] = __int_as_float(__builtin_amdgcn_readlane(__float_as_int(usv), e0 + q));
          gvq[q] = __int_as_float(__builtin_amdgcn_readlane(__float_as_int(gvv), e0 + q));
          ur[q] = *(const uint4*)(p.utab + (size_t)id * 1024 + lane * 16);
          vr[q] = *(const uint4*)(p.vtab + (size_t)id * 1024 + lane * 16);
        }
#pragma unroll
        for (int q = 0; q < 8; ++q) {
          const unsigned uu[4] = {ur[q].x, ur[q].y, ur[q].z, ur[q].w};
          float s0 = 0.f, s1 = 0.f;
#pragma unroll
          for (int k = 0; k < 4; ++k) {
            v2f lo = __builtin_amdgcn_cvt_pk_f32_fp8((int)uu[k], false), hi = __builtin_amdgcn_cvt_pk_f32_fp8((int)uu[k], true);
            s0 += hx[4 * k] * lo[0]; s1 += hx[4 * k + 1] * lo[1];
            s0 += hx[4 * k + 2] * hi[0]; s1 += hx[4 * k + 3] * hi[1];
          }
          const float dot = wave_sum_u(s0 + s1) * usq[q];
          const float cf = gvq[q] * gelu_exact(dot);
          const unsigned vv[4] = {vr[q].x, vr[q].y, vr[q].z, vr[q].w};
#pragma unroll
          for (int k = 0; k < 4; ++k) {
            v2f lo = __builtin_amdgcn_cvt_pk_f32_fp8((int)vv[k], false), hi = __builtin_amdgcn_cvt_pk_f32_fp8((int)vv[k], true);
            oacc[4 * k] += cf * lo[0]; oacc[4 * k + 1] += cf * lo[1];
            oacc[4 * k + 2] += cf * hi[0]; oacc[4 * k + 3] += cf * hi[1];
          }
        }
      }
    }
    const int b = row >> 11;
    float h3[16];
    float ss = 0.f;
#pragma unroll
    for (int q = 0; q < 4; ++q) {
      const int col = lane * 16 + q * 4;
      float4 a0 = *(const float4*)(p.out + (size_t)row * 1024 + col);
      float4 q0 = *(const float4*)(p.mod + b * 6144 + 5 * 1024 + col);
      h3[q * 4 + 0] = a0.x + q0.x * oacc[q * 4 + 0];
      h3[q * 4 + 1] = a0.y + q0.y * oacc[q * 4 + 1];
      h3[q * 4 + 2] = a0.z + q0.z * oacc[q * 4 + 2];
      h3[q * 4 + 3] = a0.w + q0.w * oacc[q * 4 + 3];
      ss += h3[q * 4] * h3[q * 4] + h3[q * 4 + 1] * h3[q * 4 + 1] + h3[q * 4 + 2] * h3[q * 4 + 2] + h3[q * 4 + 3] * h3[q * 4 + 3];
    }
    ss = wave_sum_u(ss);
    const float rstd = rsqrtf(ss * (1.f / 1024.f) + 1e-6f);
#pragma unroll
    for (int q = 0; q < 4; ++q) {
      const int col = lane * 16 + q * 4;
      float4 n0 = *(const float4*)(p.norm_f_g + col);
      *(float4*)(dst + (size_t)row * 1024 + col) =
          make_float4(h3[q * 4] * rstd * n0.x, h3[q * 4 + 1] * rstd * n0.y, h3[q * 4 + 2] * rstd * n0.z, h3[q * 4 + 3] * rstd * n0.w);
    }
  }
}

#define NPHASES 11
template <int PH>
__device__ __forceinline__ void run_phase(const P& p, char* smem, int bid, int nb, bool rep = false) {
  if (PH == 0) ph_prep(p, smem, bid, nb);
  if (PH == 1) ph_norm(p, 0, bid, nb);
  if (PH == 2) gemm_phase(p.hn, 1024, p.win_t, 1024, 1024, NTOK, INCP, smem, bid, nb, EpiProj{p.proj});
  if (PH == 3) { ph_s5scan(p, smem, bid, nb); ph_rwscan(p, smem, bid, nb); }
  if (PH == 4) ph_mixprep(p, bid, nb);
  if (PH == 5) {
    gemm_phase(p.ys5f, 512, p.wglu_t, 512, 512, NLAT, 512, smem, bid, nb, EpiGlu{p.ys5f, p.s5_b_glu, p.hn});
    gemm_phase(p.sg, 128, p.wg2_t, 128, 128, NLAT, 512, smem, bid, nb, EpiGate{p.yrwf, p.hn});
  }
  if (PH == 6) gemm_phase(p.hn, 1024, p.wout_t, 1024, 1024, NLAT, 1024, smem, bid, nb, EpiWout{p.x, p.mod, p.out});
  if (PH == 7) ph_norm(p, 1, bid, nb);
  if (PH == 8) gemm_phase(p.hn, 1024, p.wq_t, 1024, 1024, NLAT, 2048, smem, bid, nb, EpiQ{p.proj});
  if (PH == 9) ph_route(p, smem, bid, nb);
  if (PH == 10) ph_ffn(p, rep ? (float*)p.proj : p.out, bid, nb);
  if (PH == 11) ph_s5scan(p, smem, bid, nb);
  if (PH == 12) ph_rwscan(p, smem, bid, nb);
}
#ifndef REPMASK
#define REPMASK 0
#endif
#define REP(n) ((REPMASK >> (n)) & 1)
#define PHASE(n) if (ph_lo <= n && n < ph_hi) { if (n > ph_lo) grid.sync(); if (REP(n)) { run_phase<n>(p, smem, bid, nb, true); __syncthreads(); } if (n == 3 && REP(11)) { run_phase<11>(p, smem, bid, nb); __syncthreads(); } if (n == 3 && REP(12)) { run_phase<12>(p, smem, bid, nb); __syncthreads(); } run_phase<n>(p, smem, bid, nb); }
__global__ void __launch_bounds__(NTHREADS) mega(P p, int ph_lo, int ph_hi) {
  extern __shared__ __attribute__((aligned(16))) char smem[];
  cg::grid_group grid = cg::this_grid();
  const int bid = blockIdx.x, nb = gridDim.x;
  PHASE(0) PHASE(1) PHASE(2) PHASE(3) PHASE(4) PHASE(5) PHASE(6) PHASE(7) PHASE(8) PHASE(9) PHASE(10)
}

extern "C" void kernel_launch(void* const* d_in, const int* in_sizes, int n_in, void* d_out, int out_size, void* d_ws,
                              size_t ws_size, hipStream_t stream) {
  static int grid_blocks = 0;
  if (!grid_blocks) {
    int dev = 0, cus = 0, per_cu = 0;
    hipGetDevice(&dev);
    hipDeviceGetAttribute(&cus, hipDeviceAttributeMultiprocessorCount, dev);
    hipFuncSetAttribute((const void*)mega, hipFuncAttributeMaxDynamicSharedMemorySize, LDS_BYTES);
    hipOccupancyMaxActiveBlocksPerMultiprocessor(&per_cu, (const void*)mega, NTHREADS, LDS_BYTES);
    if (per_cu < 1) { fprintf(stderr, "occupancy query returned %d\n", per_cu); per_cu = 1; }
    grid_blocks = cus;
  }
  P p{};
  const float** fp = (const float**)&p;
  for (int i = 0; i < 36; ++i) fp[i] = (const float*)d_in[i];
  p.out = (float*)d_out;
  char* w = (char*)d_ws;
  size_t off = 0;
  auto take = [&](size_t bytes) { char* r = w + off; off += (bytes + 255) & ~(size_t)255; return r; };
  p.mod = (float*)take(33 * 6144 * 4);
  p.win_t = (u16*)take((size_t)INCP * 1024 * 2);
  p.wout_t = (u16*)take((size_t)1024 * 1024 * 2);
  p.wq_t = (u16*)take((size_t)2048 * 1024 * 2);
  p.wglu_t = (u16*)take((size_t)512 * 512 * 2);
  p.wg2_t = (u16*)take((size_t)512 * 128 * 2);
  p.keys = (u16*)take((size_t)8 * 2 * 128 * 128 * 2);
  p.utab = (unsigned char*)take((size_t)16384 * 1024);
  p.vtab = (unsigned char*)take((size_t)16384 * 1024);
  p.usc = (float*)take(16384 * 4);
  p.vsc = (float*)take(16384 * 4);
  p.s5ab = (float*)take(4096 * 2 * 4);
  p.s5bb = (float*)take(4096 * 32 * 4);
  p.s5ct = (u16*)take(2 * 32 * 16 * 128 * 2);
  p.hn = (u16*)take((size_t)NTOK * 1024 * 2);
  p.proj = (u16*)take((size_t)NTOK * INC * 2);
  p.ys5f = (u16*)take((size_t)NLAT * 512 * 2);
  p.ys5b = (u16*)take((size_t)NLAT * 512 * 2);
  p.yrwf = (u16*)take((size_t)NLAT * 512 * 2);
  p.yrwb = (u16*)take((size_t)NLAT * 512 * 2);
  p.bsc = (float*)take((size_t)2 * NLAT * 8 * 4);
  p.sg = (u16*)take((size_t)NLAT * 128 * 2);
  p.idx = (int*)p.ys5b;
  p.gate = (float*)p.yrwb;
  if (off > ws_size) { fprintf(stderr, "workspace too small: need %zu have %zu\n", off, ws_size); return; }
#if MEGA
  int lo = 0, hi = NPHASES;
  void* args[] = {&p, &lo, &hi};
  hipError_t e = hipLaunchCooperativeKernel((const void*)mega, dim3(grid_blocks), dim3(NTHREADS), args, LDS_BYTES, stream);
  if (e != hipSuccess) fprintf(stderr, "cooperative launch failed: %s (grid %d)\n", hipGetErrorString(e), grid_blocks);
#else
  for (int ph = 0; ph < NPHASES; ++ph) {
    hipLaunchKernelGGL(mega, dim3(grid_blocks), dim3(NTHREADS), LDS_BYTES, stream, p, ph, ph + 1);
  }
#endif
}
```

```cpp
#include <hip/hip_runtime.h>
#include <hip/hip_cooperative_groups.h>
#include <stdint.h>
#include <stdio.h>
namespace cg = cooperative_groups;

#ifndef MEGA
#define MEGA 1
#endif

typedef unsigned short u16;
using bf16x8 = __attribute__((ext_vector_type(8))) short;
using f32x4 = __attribute__((ext_vector_type(4))) float;
using u32x4 = __attribute__((ext_vector_type(4))) unsigned;
using f32x16 = __attribute__((ext_vector_type(16))) float;

#define DM 1024
#define NLAT 65536
#define NCTX 8192
#define NTOK 73728
#define INC 2208
#define INCP 2304
#define NTHREADS 512
#define LDS_BYTES 163840

#define INC_FWD 1
constexpr size_t ws_al(size_t x) { return (x + 255) & ~(size_t)255; }
constexpr size_t OFF_mod = 0;
constexpr size_t OFF_win_t = OFF_mod + ws_al(33 * 6144 * 4);
constexpr size_t OFF_wout_t = OFF_win_t + ws_al((size_t)2304 * 1024 * 2);
constexpr size_t OFF_wq_t = OFF_wout_t + ws_al((size_t)1024 * 1024 * 2);
constexpr size_t OFF_wglu_t = OFF_wq_t + ws_al((size_t)2048 * 1024 * 2);
constexpr size_t OFF_wg2_t = OFF_wglu_t + ws_al((size_t)512 * 512 * 2);
constexpr size_t OFF_keys = OFF_wg2_t + ws_al((size_t)512 * 256 * 2);
constexpr size_t OFF_utab = OFF_keys + ws_al((size_t)8 * 2 * 128 * 128 * 2);
constexpr size_t OFF_usc = OFF_utab + ws_al((size_t)16384 * 1024);
constexpr size_t OFF_vsc = OFF_usc + ws_al(16384 * 4);
constexpr size_t OFF_s5ab = OFF_vsc + ws_al(16384 * 4);
constexpr size_t OFF_s5bb = OFF_s5ab + ws_al(4096 * 2 * 4);
constexpr size_t OFF_s5ct = OFF_s5bb + ws_al(4096 * 32 * 4);
constexpr size_t OFF_hn = OFF_s5ct + ws_al(2 * 32 * 16 * 128 * 2);
constexpr size_t OFF_proj = OFF_hn + ws_al((size_t)73728 * 1024 * 2);
constexpr size_t OFF_ys5f = OFF_proj + ws_al((size_t)73728 * 2208 * 2);
constexpr size_t OFF_ys5b = OFF_ys5f + ws_al((size_t)65536 * 512 * 2);
constexpr size_t OFF_yrwf = OFF_ys5b + ws_al((size_t)65536 * 512 * 2);
constexpr size_t OFF_yrwb = OFF_yrwf + ws_al((size_t)65536 * 512 * 2);
constexpr size_t OFF_bsc = OFF_yrwb + ws_al((size_t)65536 * 512 * 2);
constexpr size_t OFF_sg = OFF_bsc + ws_al((size_t)2 * 65536 * 8 * 4);
constexpr size_t OFF_bar = OFF_sg + ws_al((size_t)65536 * 256 * 2);
constexpr size_t OFF_wlf = OFF_bar + ws_al(3456 * 4);
constexpr size_t WS_TOTAL = OFF_wlf + ws_al(2 * 4096 * 16);

extern __shared__ __attribute__((aligned(16))) char g_smem[];
#define WAVETAB_OFF (LDS_BYTES - 16 - 256)
__device__ __forceinline__ int hw_slot() { return (int)(__builtin_amdgcn_s_getreg((5 << 11) | 4) & 63u); }
__device__ __forceinline__ int tidx() {
  const int w = *(const int*)(g_smem + WAVETAB_OFF + 4 * hw_slot());
  return __builtin_amdgcn_readfirstlane(w) * 64 + (int)__builtin_amdgcn_mbcnt_hi(~0u, __builtin_amdgcn_mbcnt_lo(~0u, 0u));
}
struct P {
  const float *x, *c, *ctx, *c_ctx, *w_ada, *b_ada, *norm1_g, *norm2_g, *w_in, *s5_a_re, *s5_a_im, *s5_log_dt,
      *s5_b_re, *s5_b_im, *s5_c_re, *s5_c_im, *s5_d, *s5_w_glu, *s5_b_glu, *rw_mu, *rw_w0, *rw_w_w2, *rw_a0, *rw_w_a2,
      *rw_w_g2, *rw_k_k, *rw_k_a, *rw_r_k, *rw_ln_w, *rw_ln_b, *w_out, *peer_w_q, *peer_keys, *peer_u, *peer_v, *norm_f_g;
  float* out;
  char* ws;
  __device__ __forceinline__ float* mod() const { return (float*)(ws + OFF_mod); }
  __device__ __forceinline__ u16* win_t() const { return (u16*)(ws + OFF_win_t); }
  __device__ __forceinline__ u16* wout_t() const { return (u16*)(ws + OFF_wout_t); }
  __device__ __forceinline__ u16* wq_t() const { return (u16*)(ws + OFF_wq_t); }
  __device__ __forceinline__ u16* wglu_t() const { return (u16*)(ws + OFF_wglu_t); }
  __device__ __forceinline__ u16* wg2_t() const { return (u16*)(ws + OFF_wg2_t); }
  __device__ __forceinline__ u16* keys() const { return (u16*)(ws + OFF_keys); }
  __device__ __forceinline__ unsigned char* utab() const { return (unsigned char*)(ws + OFF_utab); }
  __device__ __forceinline__ float* usc() const { return (float*)(ws + OFF_usc); }
  __device__ __forceinline__ float* vsc() const { return (float*)(ws + OFF_vsc); }
  __device__ __forceinline__ float* s5ab() const { return (float*)(ws + OFF_s5ab); }
  __device__ __forceinline__ float* s5bb() const { return (float*)(ws + OFF_s5bb); }
  __device__ __forceinline__ u16* s5ct() const { return (u16*)(ws + OFF_s5ct); }
  __device__ __forceinline__ u16* hn() const { return (u16*)(ws + OFF_hn); }
  __device__ __forceinline__ u16* proj() const { return (u16*)(ws + OFF_proj); }
  __device__ __forceinline__ u16* ys5f() const { return (u16*)(ws + OFF_ys5f); }
  __device__ __forceinline__ u16* ys5b() const { return (u16*)(ws + OFF_ys5b); }
  __device__ __forceinline__ u16* yrwf() const { return (u16*)(ws + OFF_yrwf); }
  __device__ __forceinline__ u16* yrwb() const { return (u16*)(ws + OFF_yrwb); }
  __device__ __forceinline__ float* bsc() const { return (float*)(ws + OFF_bsc); }
  __device__ __forceinline__ u16* sg() const { return (u16*)(ws + OFF_sg); }
  __device__ __forceinline__ unsigned* bar() const { return (unsigned*)(ws + OFF_bar); }
  __device__ __forceinline__ u16* wlf() const { return (u16*)(ws + OFF_wlf); }
  __device__ __forceinline__ unsigned char* vtab() const { return utab() + 512; }
  __device__ __forceinline__ int* idx() const { return (int*)ys5b(); }
  __device__ __forceinline__ float* gate() const { return (float*)yrwb(); }
};

typedef float f32x2_t __attribute__((ext_vector_type(2)));
typedef __bf16 bf16x2_t __attribute__((ext_vector_type(2)));
__device__ __forceinline__ unsigned pack2(float a, float b) {
  f32x2_t v = {a, b};
  return __builtin_bit_cast(unsigned, __builtin_convertvector(v, bf16x2_t));
}
__device__ __forceinline__ u16 f2bf(float f) { return __builtin_bit_cast(u16, (__bf16)f); }
__device__ __forceinline__ float bf2f(u16 h) { return __uint_as_float(((unsigned)h) << 16); }
__device__ __forceinline__ float bflo(unsigned u) { return __uint_as_float(u << 16); }
__device__ __forceinline__ float bfhi(unsigned u) { return __uint_as_float(u & 0xffff0000u); }
__device__ __forceinline__ float wave_sum(float v) {
#pragma unroll
  for (int m = 32; m >= 1; m >>= 1) v += __shfl_xor(v, m, 64);
  return v;
}
__device__ __forceinline__ float gelu_exact(float x) { return 0.5f * x * (1.f + erff(x * 0.70710678118654752f)); }
__device__ __forceinline__ float gelu_as(float v) {
  const float av = fabsf(v), t = __builtin_amdgcn_rcpf(av * 0.2316418882f + 1.0f);
  float q = t * 0.5307027145f + (-0.7265760135f);
  q = q * t + 0.7107068705f; q = q * t + (-0.142248368f); q = q * t + 0.127414796f; q = q * t;
  const float e = __builtin_amdgcn_exp2f((v * v) * (-0.72134752044f));
  const float m = v * (q * e);
  return v < 0.f ? m : v - m;
}
__device__ __forceinline__ float sigmoidf(float x) { return 1.f / (1.f + __expf(-x)); }


typedef float v2f __attribute__((ext_vector_type(2)));
__device__ __forceinline__ float dpp_add(float v, const int ctrl, const int rmask) {
  int m;
  switch (ctrl) {
    case 0: m = __builtin_amdgcn_update_dpp(0, __float_as_int(v), 0xB1, 0xf, 0xf, true); break;
    case 1: m = __builtin_amdgcn_update_dpp(0, __float_as_int(v), 0x4E, 0xf, 0xf, true); break;
    case 2: m = __builtin_amdgcn_update_dpp(0, __float_as_int(v), 0x141, 0xf, 0xf, true); break;
    case 3: m = __builtin_amdgcn_update_dpp(0, __float_as_int(v), 0x140, 0xf, 0xf, true); break;
    case 4: m = __builtin_amdgcn_update_dpp(0, __float_as_int(v), 0x142, 0xa, 0xf, false); break;
    default: m = __builtin_amdgcn_update_dpp(0, __float_as_int(v), 0x143, 0xc, 0xf, false); break;
  }
  return v + __int_as_float(m);
}
__device__ __forceinline__ float wave_sum_u(float v) {
  v = dpp_add(v, 0, 0); v = dpp_add(v, 1, 0); v = dpp_add(v, 2, 0); v = dpp_add(v, 3, 0);
  v = dpp_add(v, 4, 0); v = dpp_add(v, 5, 0);
  return __int_as_float(__builtin_amdgcn_readlane(__float_as_int(v), 63));
}
__device__ __forceinline__ void convert_fp4_rows(const float* __restrict__ src, unsigned char* __restrict__ dst, float* __restrict__ sc,
                                                 int nrows, int bid, int nb) {
  const int wid = tidx() >> 6, lane = tidx() & 63;
  const int stride = nb * 8;
  for (int row0 = bid * 8 + wid; row0 < nrows; row0 += 4 * stride) {
    float4 v[4][4];
#pragma unroll
    for (int u = 0; u < 4; ++u) {
      int row = row0 + u * stride;
      if (row >= nrows) row = row0;
#pragma unroll
      for (int q = 0; q < 4; ++q) v[u][q] = *(const float4*)(src + (size_t)row * 1024 + lane * 16 + q * 4);
    }
#pragma unroll
    for (int u = 0; u < 4; ++u) {
      const int row = row0 + u * stride;
      if (row >= nrows) continue;
      float am = 0.f;
#pragma unroll
      for (int q = 0; q < 4; ++q)
        am = fmaxf(am, fmaxf(fmaxf(fabsf(v[u][q].x), fabsf(v[u][q].y)), fmaxf(fabsf(v[u][q].z), fabsf(v[u][q].w))));
#pragma unroll
      for (int m = 32; m >= 1; m >>= 1) am = fmaxf(am, __shfl_xor(am, m, 64));
      const float scl = am > 0.f ? 6.f / am : 1.f;
      unsigned w0 = 0u, w1 = 0u;
      w0 = __builtin_amdgcn_cvt_scalef32_pk_fp4_f32(w0, v[u][0].x * scl, v[u][0].y * scl, 1.0f, 0);
      w0 = __builtin_amdgcn_cvt_scalef32_pk_fp4_f32(w0, v[u][0].z * scl, v[u][0].w * scl, 1.0f, 1);
      w0 = __builtin_amdgcn_cvt_scalef32_pk_fp4_f32(w0, v[u][1].x * scl, v[u][1].y * scl, 1.0f, 2);
      w0 = __builtin_amdgcn_cvt_scalef32_pk_fp4_f32(w0, v[u][1].z * scl, v[u][1].w * scl, 1.0f, 3);
      w1 = __builtin_amdgcn_cvt_scalef32_pk_fp4_f32(w1, v[u][2].x * scl, v[u][2].y * scl, 1.0f, 0);
      w1 = __builtin_amdgcn_cvt_scalef32_pk_fp4_f32(w1, v[u][2].z * scl, v[u][2].w * scl, 1.0f, 1);
      w1 = __builtin_amdgcn_cvt_scalef32_pk_fp4_f32(w1, v[u][3].x * scl, v[u][3].y * scl, 1.0f, 2);
      w1 = __builtin_amdgcn_cvt_scalef32_pk_fp4_f32(w1, v[u][3].z * scl, v[u][3].w * scl, 1.0f, 3);
      *(uint2*)(dst + (size_t)row * 1024 + lane * 8) = make_uint2(w0, w1);
      if (lane == 0) sc[row] = am > 0.f ? am / 6.f : 1.f;
    }
  }
}

__device__ __forceinline__ void transpose_tiles(const float* __restrict__ src, int K, int N, u16* __restrict__ dst, int Kd, int Npad,
                                char* smem, int bid, int nb) {
  float* tile = (float*)smem;
  const int tid = tidx();
  const int nkt = Kd / 64, nnt = Npad / 64;
  for (int t = bid; t < nkt * nnt; t += nb) {
    int kt = t % nkt, nt = t / nkt;
    int k0 = kt * 64, n0 = nt * 64;
    __syncthreads();
#pragma unroll
    for (int it = 0; it < 8; ++it) {
      int i = (tid >> 6) + it * 8, j = tid & 63;
      int k = k0 + i, n = n0 + j;
      tile[i * 65 + j] = (k < K && n < N) ? src[(size_t)k * N + n] : 0.f;
    }
    __syncthreads();
    int n = tid >> 3, kc = (tid & 7) * 8;
    uint4 o;
    o.x = pack2(tile[(kc + 0) * 65 + n], tile[(kc + 1) * 65 + n]);
    o.y = pack2(tile[(kc + 2) * 65 + n], tile[(kc + 3) * 65 + n]);
    o.z = pack2(tile[(kc + 4) * 65 + n], tile[(kc + 5) * 65 + n]);
    o.w = pack2(tile[(kc + 6) * 65 + n], tile[(kc + 7) * 65 + n]);
    *(uint4*)(dst + (size_t)(n0 + n) * Kd + k0 + kc) = o;
  }
}

__device__ __forceinline__ void convert_bf16(const float* __restrict__ src, u16* __restrict__ dst, size_t n8, int bid, int nb) {
  for (size_t i = (size_t)bid * NTHREADS + tidx(); i < n8; i += (size_t)nb * NTHREADS) {
    float4 a = *(const float4*)(src + i * 8), b = *(const float4*)(src + i * 8 + 4);
    uint4 o;
    o.x = pack2(a.x, a.y); o.y = pack2(a.z, a.w); o.z = pack2(b.x, b.y); o.w = pack2(b.z, b.w);
    *(uint4*)(dst + i * 8) = o;
  }
}

__device__ __forceinline__ void ph_prep(const P& p, char* smem, int bid, int nb) {
  const int tid = tidx();
  {
    float* sc = (float*)smem;
    float* red = (float*)(smem + 33 * 256 * 4);
    for (int item = bid; item < 192; item += nb) {
      const int j0 = item * 32, kg = tid >> 5, col = tid & 31;
      float acc[33];
#pragma unroll
      for (int b = 0; b < 33; ++b) acc[b] = 0.f;
      for (int ch = 0; ch < 4; ++ch) {
        __syncthreads();
        for (int e = tid; e < 33 * 256; e += NTHREADS) {
          int b = e >> 8, kk = e & 255;
          float cv = (b < 32) ? p.c[b * 1024 + ch * 256 + kk] : p.c_ctx[ch * 256 + kk];
          sc[e] = cv / (1.f + expf(-cv));
        }
        float w[16];
#pragma unroll
        for (int i = 0; i < 16; ++i) w[i] = p.w_ada[(size_t)(ch * 256 + kg * 16 + i) * 6144 + j0 + col];
        __syncthreads();
#pragma unroll
        for (int i = 0; i < 16; ++i) {
          const int kk = kg * 16 + i;
#pragma unroll
          for (int b = 0; b < 33; ++b) acc[b] += sc[b * 256 + kk] * w[i];
        }
      }
#pragma unroll
      for (int b = 0; b < 33; ++b) red[(kg * 33 + b) * 32 + col] = acc[b];
      __syncthreads();
      for (int e = tid; e < 33 * 32; e += NTHREADS) {
        int b = e >> 5, cc = e & 31;
        float sv = p.b_ada[j0 + cc];
#pragma unroll
        for (int k2 = 0; k2 < 16; ++k2) sv += red[(k2 * 33 + b) * 32 + cc];
        p.mod()[b * 6144 + j0 + cc] = sv;
      }
      __syncthreads();
    }
  }
  transpose_tiles(p.w_in, 1024, INC, p.win_t(), 1024, INCP, smem, bid, nb);
  transpose_tiles(p.w_out, 1024, 1024, p.wout_t(), 1024, 1024, smem, bid, nb);
  transpose_tiles(p.peer_w_q, 1024, 2048, p.wq_t(), 1024, 2048, smem, bid, nb);
  transpose_tiles(p.s5_w_glu, 512, 512, p.wglu_t(), 512, 512, smem, bid, nb);
  transpose_tiles(p.rw_w_g2, 96, 512, p.wg2_t(), 256, 512, smem, bid, nb);
  convert_bf16(p.peer_keys, p.keys(), (size_t)8 * 2 * 128 * 128 / 8, bid, nb);
  convert_fp4_rows(p.peer_u, p.utab(), p.usc(), 16384, bid, nb);
  convert_fp4_rows(p.peer_v, p.vtab(), p.vsc(), 16384, bid, nb);
  for (int it = bid * NTHREADS + tid; it < 2 * 4096; it += nb * NTHREADS) {
    const int ln = it & 63, mt = (it >> 6) & 3, hh_ = (it >> 8) & 7, dd = (it >> 11) & 1, mm = it >> 12;
    const int tt = ln & 15, kq_ = ln >> 4;
    const float* W = mm ? p.rw_w_a2 : p.rw_w_w2;
    unsigned o[4];
#pragma unroll
    for (int q = 0; q < 4; ++q) {
      const size_t o0 = (size_t)(dd * 32 + 8 * kq_ + 2 * q) * 512 + hh_ * 64 + 16 * mt + tt;
      o[q] = pack2(W[o0], W[o0 + 512]);
    }
    *(uint4*)(p.wlf() + (size_t)it * 8) = make_uint4(o[0], o[1], o[2], o[3]);
  }
  for (int it = bid * NTHREADS + tid; it < 4096; it += nb * NTHREADS) {
    int pp = it & 63, g = (it >> 6) & 31, d = it >> 11;
    float are = p.s5_a_re[it], aim = p.s5_a_im[it];
    float dt = expf(p.s5_log_dt[d * 32 + g]);
    float mag = expf(dt * are);
    float abr = mag * cosf(dt * aim), abi = mag * sinf(dt * aim);
    float nr = abr - 1.f, ni = abi;
    float den = are * are + aim * aim;
    float cfr = (nr * are + ni * aim) / den, cfi = (ni * are - nr * aim) / den;
    p.s5ab()[it * 2] = abr;
    p.s5ab()[it * 2 + 1] = abi;
    for (int h = 0; h < 16; ++h) {
      float br = p.s5_b_re[(size_t)it * 16 + h], bi = p.s5_b_im[(size_t)it * 16 + h];
      p.s5bb()[(size_t)it * 32 + h] = cfr * br - cfi * bi;
      p.s5bb()[(size_t)it * 32 + 16 + h] = cfr * bi + cfi * br;
    }
    for (int h = 0; h < 16; ++h) {
      size_t ci = ((size_t)(d * 32 + g) * 16 + h) * 64 + pp;
      p.s5ct()[((size_t)(d * 32 + g) * 16 + h) * 128 + 2 * pp] = f2bf(p.s5_c_re[ci]);
      p.s5ct()[((size_t)(d * 32 + g) * 16 + h) * 128 + 2 * pp + 1] = f2bf(-p.s5_c_im[ci]);
    }
  }
}

__device__ __forceinline__ void ph_norm(const P& p, int mode, int bid, int nb) {
  const int wid = tidx() >> 6, lane = tidx() & 63;
  const int nrows = mode == 0 ? NTOK : NLAT;
  const float* gvec = mode == 0 ? p.norm1_g : p.norm2_g;
  const int sh_off = mode == 0 ? 0 : 3 * 1024, sc_off = sh_off + 1024;
  const int stride = nb * 8;
  for (int row0 = bid * 8 + wid; row0 < nrows; row0 += 4 * stride) {
    float4 v[4][4];
    int bs[4];
#pragma unroll
    for (int u = 0; u < 4; ++u) {
      int row = row0 + u * stride;
      if (row >= nrows) row = row0;
      const float* src;
      if (mode == 0) {
        if (row < NLAT) { src = p.x + (size_t)row * 1024; bs[u] = row >> 11; }
        else { src = p.ctx + (size_t)(row - NLAT) * 1024; bs[u] = 32; }
      } else { src = p.out + (size_t)row * 1024; bs[u] = row >> 11; }
#pragma unroll
      for (int j = 0; j < 2; ++j) {
        v[u][2 * j] = *(const float4*)(src + j * 512 + lane * 8);
        v[u][2 * j + 1] = *(const float4*)(src + j * 512 + lane * 8 + 4);
      }
    }
#pragma unroll
    for (int u = 0; u < 4; ++u) {
      const int row = row0 + u * stride;
      if (row >= nrows) continue;
      float ss = 0.f;
#pragma unroll
      for (int j = 0; j < 4; ++j) ss += v[u][j].x * v[u][j].x + v[u][j].y * v[u][j].y + v[u][j].z * v[u][j].z + v[u][j].w * v[u][j].w;
      ss = wave_sum_u(ss);
      const float rstd = rsqrtf(ss * (1.f / 1024.f) + 1e-6f);
      const float* mrow = p.mod() + bs[u] * 6144;
#pragma unroll
      for (int j = 0; j < 2; ++j) {
        const int col = j * 512 + lane * 8;
        unsigned o[4];
#pragma unroll
        for (int hq = 0; hq < 2; ++hq) {
          const float4 x = v[u][2 * j + hq];
          const float4 g = *(const float4*)(gvec + col + 4 * hq);
          const float4 sh = *(const float4*)(mrow + sh_off + col + 4 * hq);
          const float4 sc = *(const float4*)(mrow + sc_off + col + 4 * hq);
          o[2 * hq] = pack2(x.x * rstd * g.x * (1.f + sc.x) + sh.x, x.y * rstd * g.y * (1.f + sc.y) + sh.y);
          o[2 * hq + 1] = pack2(x.z * rstd * g.z * (1.f + sc.z) + sh.z, x.w * rstd * g.w * (1.f + sc.w) + sh.w);
        }
        *(uint4*)(p.hn() + (size_t)row * 1024 + col) = make_uint4(o[0], o[1], o[2], o[3]);
      }
    }
  }
}

#define G_BM 256
#define G_BN 128
#define G_BK 64
#define G_LD 72
template <class Epi>
__device__ __forceinline__ void gemm_simple(const u16* __restrict__ A, int lda, const u16* __restrict__ Bt, int ldb, int K, int M, int N,
                           char* smem, int bid, int nb, Epi epi) {
  u16* As = (u16*)smem;
  u16* Bs = (u16*)(smem + 2 * G_BM * G_LD * 2);
  const int tid = tidx(), wid = tid >> 6, lane = tid & 63;
  const int wr = wid >> 1, wc = wid & 1, fr = lane & 15, fq = lane >> 4;
  const int ntn = N / G_BN, ntiles = (M / G_BM) * ntn, nk = K / G_BK;
  const int lrow = tid >> 3, lkc = (tid & 7) * 8;
  for (int tile = bid; tile < ntiles; tile += nb) {
    const int m0 = (tile / ntn) * G_BM, n0 = (tile % ntn) * G_BN;
    f32x4 acc[4][4];
#pragma unroll
    for (int i = 0; i < 4; ++i)
#pragma unroll
      for (int j = 0; j < 4; ++j) acc[i][j] = (f32x4){0.f, 0.f, 0.f, 0.f};
    u32x4 ra[4], rb[2];
    const u16* Ag = A + (size_t)(m0 + lrow) * lda + lkc;
    const u16* Bg = Bt + (size_t)(n0 + lrow) * ldb + lkc;
#pragma unroll
    for (int i = 0; i < 4; ++i) ra[i] = *(const u32x4*)(Ag + (size_t)(64 * i) * lda);
#pragma unroll
    for (int i = 0; i < 2; ++i) rb[i] = *(const u32x4*)(Bg + (size_t)(64 * i) * ldb);
    __syncthreads();
#pragma unroll
    for (int i = 0; i < 4; ++i) *(u32x4*)(As + (lrow + 64 * i) * G_LD + lkc) = ra[i];
#pragma unroll
    for (int i = 0; i < 2; ++i) *(u32x4*)(Bs + (lrow + 64 * i) * G_LD + lkc) = rb[i];
    __syncthreads();
    for (int kt = 0; kt < nk; ++kt) {
      const int buf = kt & 1;
      if (kt + 1 < nk) {
#pragma unroll
        for (int i = 0; i < 4; ++i) ra[i] = *(const u32x4*)(Ag + (size_t)(64 * i) * lda + (kt + 1) * G_BK);
#pragma unroll
        for (int i = 0; i < 2; ++i) rb[i] = *(const u32x4*)(Bg + (size_t)(64 * i) * ldb + (kt + 1) * G_BK);
      }
      const u16* as = As + buf * (G_BM * G_LD);
      const u16* bs = Bs + buf * (G_BN * G_LD);
#pragma unroll
      for (int ks = 0; ks < 2; ++ks) {
        bf16x8 af[4], bfr[4];
#pragma unroll
        for (int mi = 0; mi < 4; ++mi) af[mi] = *(const bf16x8*)(as + (wr * 64 + mi * 16 + fr) * G_LD + ks * 32 + fq * 8);
#pragma unroll
        for (int ni = 0; ni < 4; ++ni) bfr[ni] = *(const bf16x8*)(bs + (wc * 64 + ni * 16 + fr) * G_LD + ks * 32 + fq * 8);
#pragma unroll
        for (int mi = 0; mi < 4; ++mi)
#pragma unroll
          for (int ni = 0; ni < 4; ++ni)
            acc[mi][ni] = __builtin_amdgcn_mfma_f32_16x16x32_bf16(af[mi], bfr[ni], acc[mi][ni], 0, 0, 0);
      }
      if (kt + 1 < nk) {
        u16* as2 = As + (buf ^ 1) * (G_BM * G_LD);
        u16* bs2 = Bs + (buf ^ 1) * (G_BN * G_LD);
#pragma unroll
        for (int i = 0; i < 4; ++i) *(u32x4*)(as2 + (lrow + 64 * i) * G_LD + lkc) = ra[i];
#pragma unroll
        for (int i = 0; i < 2; ++i) *(u32x4*)(bs2 + (lrow + 64 * i) * G_LD + lkc) = rb[i];
      }
      __syncthreads();
    }
#pragma unroll
    for (int mi = 0; mi < 4; ++mi)
#pragma unroll
      for (int ni = 0; ni < 4; ++ni) epi(m0 + wr * 64 + mi * 16 + fq * 4, n0 + wc * 64 + ni * 16 + fr, acc[mi][ni]);
  }
}

namespace pg8 {
#define PG8_LAS __attribute__((address_space(3)))
typedef unsigned short bf16_t;
typedef short bf16x8 __attribute__((ext_vector_type(8)));
typedef float f32x4 __attribute__((ext_vector_type(4)));
typedef unsigned u32x4 __attribute__((ext_vector_type(4)));
constexpr int BM = 256, BK = 64, HALF = 128, HTB = HALF * BK * 2  , STAGE_BYTES = 8 * HTB, NXCD = 8, WGM = 8;

__host__ __device__ __forceinline__ int lds_byte(int r, int c) { const int st = (r >> 4) * 2 + (c >> 5), rr = r & 15, cc = c & 31, ob = rr * 64 + cc * 2; return st * 1024 + (ob ^ (((ob >> 9) & 1) << 5)); }
__host__ __device__ __forceinline__ void stage_rc(int b, int& R, int& C) { const int st = b / 1024, sb = b % 1024, swz = sb ^ (((sb >> 9) & 1) << 5); R = (st >> 1) * 16 + swz / 64; C = (st & 1) * 32 + (swz % 64) / 2; }
__host__ __device__ __forceinline__ int perm32(int rho) { const int n = rho >> 4, i = rho & 15; return 8 * (i >> 2) + 4 * n + (i & 3); }

struct Unit { int pm, pn; };
struct Gemm { const bf16_t* A; const bf16_t* Bt; int M, N, K; };

struct StaticOrder {
    int nM, nN, nwg, G, c;
    __host__ __device__ void init(int M, int N, int G_, int c_) { nM = M / BM; nN = N / BM; nwg = nM * nN; G = G_; c = c_; }
    __host__ __device__ bool next(int i, Unit& u) const {
        const long L = (long)i * G + c; if (L >= nwg) return false;
        int wgid = (int)L; { const int q = nwg / NXCD, r = nwg % NXCD, xcd = wgid % NXCD, off = wgid / NXCD; wgid = (xcd < r ? xcd * (q + 1) : r * (q + 1) + (xcd - r) * q) + off; }
        const int nig = WGM * nN, gid = wgid / nig, fm = gid * WGM, gsz = (nM - fm) < WGM ? (nM - fm) : WGM;
        u.pm = fm + ((wgid % nig) % gsz); u.pn = (wgid % nig) / gsz; return true;
    }
    __device__ __forceinline__ void a_ready(const Unit&) const {}
    __device__ __forceinline__ void done(const Unit&) const {}
};
__device__ __forceinline__ unsigned cvt_pk_bf16(float lo, float hi) { return ::pack2(lo, hi); }
typedef float f32x2 __attribute__((ext_vector_type(2)));
template <class Epi, class Sched, bool STAMP = false>
__device__ __forceinline__ void gemm_phase(PG8_LAS unsigned char* lds, const Gemm g, const Sched& S, const Epi& E, unsigned long long* stamps) {
    const int tid = tidx(), wid = __builtin_amdgcn_readfirstlane(tid >> 6), lane = tid & 63, wr = wid >> 2, wc = wid & 3, fr = lane & 15, fq = lane >> 4;
    const int K = g.K, nt = K / BK;
    int ts_lo = 0, ts_hi = 0, nts = 0; const unsigned long long rt_entry = STAMP ? (unsigned long long)wall_clock64() : 0ull;
#define PG8_STAMP() do { if (STAMP && wid == 0 && nts < 64) { const unsigned long long _c = (unsigned long long)clock64(); \
        ts_lo = (lane == nts) ? (int)(unsigned)_c : ts_lo; ts_hi = (lane == nts) ? (int)(unsigned)(_c >> 32) : ts_hi; ++nts; } } while (0)
    PG8_STAMP();
    unsigned voffA[2], voffB[2];
#pragma unroll
    for (int i = 0; i < 2; ++i) { int R, C; stage_rc(tid * 16 + i * 8192, R, C); const int Rb = Epi::PERM ? ((R & ~31) + perm32(R & 31)) : R;
        voffA[i] = (unsigned)(R * K + C) * 2u; voffB[i] = (unsigned)(Rb * K + C) * 2u; }
    const size_t kstep = (size_t)(BK * 2);
    const size_t hstep = (size_t)HALF * K * 2;
    const size_t tstep = 2 * hstep;
    const unsigned ldsw = (unsigned)wid * 1024u;
    const int aoff = lds_byte(wr * 64 + fr, fq * 8), boff = lds_byte(wc * 32 + fr, fq * 8);
#define PG8_SA(b, h) (((b) * 2 + (h)) * HTB)
#define PG8_SB(b, h) ((4 + (b) * 2 + (h)) * HTB)
#define PG8_STAGE(bufoff, gbase, voff) do { _Pragma("unroll") for (int _i = 0; _i < 2; ++_i) \
        __builtin_amdgcn_global_load_lds((const unsigned*)((const char*)(gbase) + (voff)[_i]), (PG8_LAS unsigned*)(lds + (bufoff) + ldsw + _i * 8192), 16, 0, 0); } while (0)
#define PG8_LDA(dst, b, h) do { _Pragma("unroll") for (int m = 0; m < 4; ++m) _Pragma("unroll") for (int k = 0; k < 2; ++k) dst[m][k] = *(const PG8_LAS bf16x8*)(lds + PG8_SA(b, h) + aoff + m * 2048 + k * 1024); } while (0)
#define PG8_LDB(dst, b, h) do { _Pragma("unroll") for (int n = 0; n < 2; ++n) _Pragma("unroll") for (int k = 0; k < 2; ++k) dst[n][k] = *(const PG8_LAS bf16x8*)(lds + PG8_SB(b, h) + boff + n * 2048 + k * 1024); } while (0)
#define PG8_MMA(ai, bj, At, Bt) do { __builtin_amdgcn_s_setprio(1); _Pragma("unroll") for (int m = 0; m < 4; ++m) _Pragma("unroll") for (int n = 0; n < 2; ++n) _Pragma("unroll") for (int k = 0; k < 2; ++k) \
        acc[ai][bj][m][n] = __builtin_amdgcn_mfma_f32_16x16x32_bf16(Bt[n][k], At[m][k], acc[ai][bj][m][n], 0, 0, 0); __builtin_amdgcn_s_setprio(0); } while (0)
#define PG8_WAIT_V(n) asm volatile("s_waitcnt vmcnt(" #n ")" ::: "memory")
#define PG8_WAIT_L(n) asm volatile("s_waitcnt lgkmcnt(" #n ")" ::: "memory")
#define PG8_BAR __builtin_amdgcn_s_barrier()
#define PG8_SCHED __builtin_amdgcn_sched_barrier(0)
    Unit cur, nxt; int ui = 0;
    if (!S.next(0, cur)) return;
    f32x4 acc[2][2][4][2];
#pragma unroll
    for (int a = 0; a < 2; ++a)
#pragma unroll
        for (int b = 0; b < 2; ++b)
#pragma unroll
            for (int m = 0; m < 4; ++m)
#pragma unroll
                for (int n = 0; n < 2; ++n) acc[a][b][m][n] = (f32x4){0.f, 0.f, 0.f, 0.f};
    bf16x8 At[4][2], B0[2][2], B1[2][2];
    const char* cA = (const char*)g.A + (size_t)cur.pm * tstep; const char* cB = (const char*)g.Bt + (size_t)cur.pn * tstep;
    S.a_ready(cur);
    PG8_STAGE(PG8_SB(0, 0), cB, voffB); PG8_STAGE(PG8_SA(0, 0), cA, voffA); PG8_STAGE(PG8_SB(0, 1), cB + hstep, voffB); PG8_STAGE(PG8_SA(0, 1), cA + hstep, voffA);
    if (wr == 1) PG8_BAR;
    PG8_WAIT_V(4); PG8_BAR;
    PG8_STAGE(PG8_SB(1, 0), cB + kstep, voffB); PG8_STAGE(PG8_SA(1, 0), cA + kstep, voffA); PG8_STAGE(PG8_SB(1, 1), cB + hstep + kstep, voffB);
    PG8_WAIT_V(6); PG8_BAR;
    PG8_STAMP();
    for (;;) {
        const bool has_next = S.next(ui + 1, nxt);
        const char* nA = has_next ? (const char*)g.A + (size_t)nxt.pm * tstep : cA; const char* nB = has_next ? (const char*)g.Bt + (size_t)nxt.pn * tstep : cB;
        for (int t = 0; t < nt; t += 2) {
            const bool last = (t == nt - 2);
            const char* a1 = cA + (size_t)(t + 1) * kstep;
            const char* a2 = last ? nA : cA + (size_t)(t + 2) * kstep; const char* b2 = last ? nB : cB + (size_t)(t + 2) * kstep;
            const char* a3 = a2 + kstep; const char* b3 = b2 + kstep;
            if (last && has_next) S.a_ready(nxt);
            PG8_LDB(B0, 0, 0); PG8_SCHED; PG8_LDA(At, 0, 0); PG8_STAGE(PG8_SA(1, 1), a1 + hstep, voffA);
            PG8_WAIT_L(8); PG8_BAR; PG8_WAIT_L(0); PG8_MMA(0, 0, At, B0); PG8_BAR; PG8_SCHED;
            PG8_LDB(B1, 0, 1); PG8_STAGE(PG8_SB(0, 0), b2, voffB);
            PG8_BAR; PG8_WAIT_L(0); PG8_MMA(0, 1, At, B1); PG8_BAR;
            PG8_LDA(At, 0, 1); PG8_STAGE(PG8_SA(0, 0), a2, voffA);
            PG8_BAR; PG8_WAIT_L(0); PG8_MMA(1, 0, At, B0); PG8_BAR; PG8_SCHED;
            PG8_STAGE(PG8_SB(0, 1), b2 + hstep, voffB);
            PG8_WAIT_V(6); PG8_BAR; PG8_MMA(1, 1, At, B1); PG8_BAR;
            PG8_LDB(B0, 1, 0); PG8_SCHED; PG8_LDA(At, 1, 0); PG8_STAGE(PG8_SA(0, 1), a2 + hstep, voffA);
            PG8_WAIT_L(8); PG8_BAR; PG8_WAIT_L(0); PG8_MMA(0, 0, At, B0); PG8_BAR; PG8_SCHED;
            PG8_LDB(B1, 1, 1); PG8_STAGE(PG8_SB(1, 0), b3, voffB);
            PG8_BAR; PG8_WAIT_L(0); PG8_MMA(0, 1, At, B1); PG8_BAR;
            PG8_LDA(At, 1, 1); PG8_STAGE(PG8_SA(1, 0), a3, voffA);
            PG8_BAR; PG8_WAIT_L(0); PG8_MMA(1, 0, At, B0); PG8_BAR; PG8_SCHED;
            PG8_STAGE(PG8_SB(1, 1), b3 + hstep, voffB);
            PG8_WAIT_V(6); PG8_BAR; PG8_MMA(1, 1, At, B1); PG8_BAR;
        }
        PG8_STAMP();
        if constexpr (!Epi::AFTER_DRAIN) { E(acc, cur, wr, wc, fr, fq); S.done(cur); }
        PG8_STAMP();
        if (!has_next) break;
#pragma unroll
        for (int a = 0; a < 2; ++a)
#pragma unroll
            for (int b = 0; b < 2; ++b)
#pragma unroll
                for (int m = 0; m < 4; ++m)
#pragma unroll
                    for (int n = 0; n < 2; ++n) acc[a][b][m][n] = (f32x4){0.f, 0.f, 0.f, 0.f};
        cur = nxt; cA = nA; cB = nB; ++ui;
    }
    PG8_WAIT_V(0);
    if (wr == 0) PG8_BAR;
    PG8_BAR;
    if constexpr (Epi::AFTER_DRAIN) { E.fused(acc, cur, wr, wc, fr, fq, lds, wid, lane); S.done(cur); }
    PG8_STAMP();
    if (STAMP && wid == 0) { stamps[lane] = lane < nts ? (((unsigned long long)(unsigned)ts_hi << 32) | (unsigned)ts_lo) : 0ull;
        if (lane == 62) stamps[62] = rt_entry; if (lane == 63) stamps[63] = (unsigned long long)wall_clock64(); }
#undef PG8_STAMP
#undef PG8_SA
#undef PG8_SB
#undef PG8_STAGE
#undef PG8_LDA
#undef PG8_LDB
#undef PG8_MMA
#undef PG8_WAIT_V
#undef PG8_WAIT_L
#undef PG8_BAR
#undef PG8_SCHED
}
}

namespace pg8 {
struct EpiProjT {
  static constexpr bool PERM = true, AFTER_DRAIN = false;
  bf16_t* O; int ldc; int ncols;
  __device__ __forceinline__ void operator()(const f32x4 (&acc)[2][2][4][2], const Unit& u, int wr, int wc, int fr, int fq) const {
    const int row0 = u.pm * BM + wr * 64 + fr, col0 = u.pn * BM + wc * 32 + 8 * fq;
#pragma unroll
    for (int ai = 0; ai < 2; ++ai)
#pragma unroll
      for (int m = 0; m < 4; ++m) {
        bf16_t* rowp = O + (size_t)(row0 + ai * HALF + m * 16) * ldc + col0;
#pragma unroll
        for (int bj = 0; bj < 2; ++bj) {
          if (col0 + bj * HALF < ncols) {
            const f32x4 v0 = acc[ai][bj][m][0], v1 = acc[ai][bj][m][1];
            u32x4 w; w.x = cvt_pk_bf16(v0[0], v0[1]); w.y = cvt_pk_bf16(v0[2], v0[3]); w.z = cvt_pk_bf16(v1[0], v1[1]); w.w = cvt_pk_bf16(v1[2], v1[3]);
            *(u32x4*)(rowp + bj * HALF) = w;
          }
        }
      }
  }
};
struct EpiGluT {
  static constexpr bool PERM = true, AFTER_DRAIN = false;
  const bf16_t* Y1; const float* bglu; bf16_t* O;
  __device__ __forceinline__ void operator()(const f32x4 (&acc)[2][2][4][2], const Unit& u, int wr, int wc, int fr, int fq) const {
    const int row0 = u.pm * BM + wr * 64 + fr, col0 = u.pn * BM + wc * 32 + 8 * fq;
    f32x4 bv[2][2];
#pragma unroll
    for (int bj = 0; bj < 2; ++bj)
#pragma unroll
      for (int n = 0; n < 2; ++n) bv[bj][n] = *(const f32x4*)(bglu + col0 + bj * HALF + 4 * n);
#pragma unroll
    for (int ai = 0; ai < 2; ++ai)
#pragma unroll
      for (int m = 0; m < 4; ++m) {
        const size_t r = (size_t)(row0 + ai * HALF + m * 16);
#pragma unroll
        for (int bj = 0; bj < 2; ++bj) {
          const u32x4 yv = *(const u32x4*)(Y1 + r * 512 + col0 + bj * HALF);
          const f32x4 v0 = acc[ai][bj][m][0] + bv[bj][0], v1 = acc[ai][bj][m][1] + bv[bj][1];
          float o[8];
#pragma unroll
          for (int q = 0; q < 4; ++q) {
            const float ylo = __uint_as_float(yv[q] << 16), yhi = __uint_as_float(yv[q] & 0xffff0000u);
            const float a0 = q < 2 ? v0[2 * q] : v1[2 * q - 4], a1 = q < 2 ? v0[2 * q + 1] : v1[2 * q - 3];
            o[2 * q] = ylo / (1.f + __expf(-a0));
            o[2 * q + 1] = yhi / (1.f + __expf(-a1));
          }
          u32x4 w; w.x = cvt_pk_bf16(o[0], o[1]); w.y = cvt_pk_bf16(o[2], o[3]); w.z = cvt_pk_bf16(o[4], o[5]); w.w = cvt_pk_bf16(o[6], o[7]);
          *(u32x4*)(O + r * 1024 + col0 + bj * HALF) = w;
        }
      }
  }
};
struct EpiGateT {
  static constexpr bool PERM = true, AFTER_DRAIN = false;
  const bf16_t* T1; bf16_t* O;
  __device__ __forceinline__ void operator()(const f32x4 (&acc)[2][2][4][2], const Unit& u, int wr, int wc, int fr, int fq) const {
    const int row0 = u.pm * BM + wr * 64 + fr, col0 = u.pn * BM + wc * 32 + 8 * fq;
#pragma unroll
    for (int ai = 0; ai < 2; ++ai)
#pragma unroll
      for (int m = 0; m < 4; ++m) {
        const size_t r = (size_t)(row0 + ai * HALF + m * 16);
#pragma unroll
        for (int bj = 0; bj < 2; ++bj) {
          const u32x4 tv = *(const u32x4*)(T1 + r * 512 + col0 + bj * HALF);
          const f32x4 v0 = acc[ai][bj][m][0], v1 = acc[ai][bj][m][1];
          u32x4 w;
          w.x = cvt_pk_bf16(__uint_as_float(tv[0] << 16) * v0[0], __uint_as_float(tv[0] & 0xffff0000u) * v0[1]);
          w.y = cvt_pk_bf16(__uint_as_float(tv[1] << 16) * v0[2], __uint_as_float(tv[1] & 0xffff0000u) * v0[3]);
          w.z = cvt_pk_bf16(__uint_as_float(tv[2] << 16) * v1[0], __uint_as_float(tv[2] & 0xffff0000u) * v1[1]);
          w.w = cvt_pk_bf16(__uint_as_float(tv[3] << 16) * v1[2], __uint_as_float(tv[3] & 0xffff0000u) * v1[3]);
          *(u32x4*)(O + r * 1024 + 512 + col0 + bj * HALF) = w;
        }
      }
  }
};
struct EpiWoutT {
  static constexpr bool PERM = false, AFTER_DRAIN = false;
  const float* X; const float* mod; float* H2;
  __device__ __forceinline__ void operator()(const f32x4 (&acc)[2][2][4][2], const Unit& u, int wr, int wc, int fr, int fq) const {
    const int row0 = u.pm * BM + wr * 64 + fr, col0 = u.pn * BM + wc * 32 + 4 * fq;
    const float* g1p = mod + ((u.pm * BM) >> 11) * 6144 + 2 * 1024 + col0;
    f32x4 gv[2][2];
#pragma unroll
    for (int bj = 0; bj < 2; ++bj)
#pragma unroll
      for (int n = 0; n < 2; ++n) gv[bj][n] = *(const f32x4*)(g1p + bj * HALF + n * 16);
#pragma unroll
    for (int ai = 0; ai < 2; ++ai)
#pragma unroll
      for (int m = 0; m < 4; ++m) {
        const size_t off = (size_t)(row0 + ai * HALF + m * 16) * 1024 + col0;
#pragma unroll
        for (int bj = 0; bj < 2; ++bj)
#pragma unroll
          for (int n = 0; n < 2; ++n) {
            const f32x4 xv = *(const f32x4*)(X + off + bj * HALF + n * 16);
            *(f32x4*)(H2 + off + bj * HALF + n * 16) = xv + gv[bj][n] * acc[ai][bj][m][n];
          }
      }
  }
};
}

struct EpiProj {
  u16* proj;
  __device__ __forceinline__ void operator()(int r, int c, f32x4 v) const {
    if (c < INC) {
#pragma unroll
      for (int j = 0; j < 4; ++j) proj[(size_t)(r + j) * INC + c] = f2bf(v[j]);
    }
  }
};
struct EpiGlu {
  const u16* y1; const float* bglu; u16* a2;
  __device__ __forceinline__ void operator()(int r, int c, f32x4 v) const {
    float bb = bglu[c];
#pragma unroll
    for (int j = 0; j < 4; ++j) {
      float y = bf2f(y1[(size_t)(r + j) * 512 + c]);
      a2[(size_t)(r + j) * 1024 + c] = f2bf(y * sigmoidf(v[j] + bb));
    }
  }
};
struct EpiGate {
  const u16* t1; u16* a2;
  __device__ __forceinline__ void operator()(int r, int c, f32x4 v) const {
#pragma unroll
    for (int j = 0; j < 4; ++j) {
      float t = bf2f(t1[(size_t)(r + j) * 512 + c]);
      a2[(size_t)(r + j) * 1024 + 512 + c] = f2bf(t * v[j]);
    }
  }
};
struct EpiWout {
  const float* x; const float* mod; float* h2;
  __device__ __forceinline__ void operator()(int r, int c, f32x4 v) const {
    float g1 = mod[(r >> 11) * 6144 + 2 * 1024 + c];
#pragma unroll
    for (int j = 0; j < 4; ++j) h2[(size_t)(r + j) * 1024 + c] = x[(size_t)(r + j) * 1024 + c] + g1 * v[j];
  }
};
struct EpiQ {
  u16* q;
  __device__ __forceinline__ void operator()(int r, int c, f32x4 v) const {
#pragma unroll
    for (int j = 0; j < 4; ++j) q[(size_t)(r + j) * 2048 + c] = f2bf(v[j]);
  }
};

__device__ __forceinline__ void ph_s5scan(const P& p, char* smem, int bid, int nb) {
  const int wid = tidx() >> 6, lane = tidx() & 63;
  float* U = (float*)(smem + wid * 8448);
  unsigned* H = (unsigned*)((char*)U + 4096);
  const int fr = lane & 15, fq = lane >> 4;
  for (int s = bid * 8 + wid; s < 2048; s += nb * 8) {
    const int g = s & 31, d = (s >> 5) & 1, b = s >> 6;
    const int ci = (d * 32 + g) * 64 + lane;
    const float abr = p.s5ab()[ci * 2], abi = p.s5ab()[ci * 2 + 1];
    float bbr[16], bbi[16];
#pragma unroll
    for (int q = 0; q < 4; ++q) {
      float4 t = *(const float4*)(p.s5bb() + (size_t)ci * 32 + q * 4);
      bbr[q * 4] = t.x; bbr[q * 4 + 1] = t.y; bbr[q * 4 + 2] = t.z; bbr[q * 4 + 3] = t.w;
      float4 t2 = *(const float4*)(p.s5bb() + (size_t)ci * 32 + 16 + q * 4);
      bbi[q * 4] = t2.x; bbi[q * 4 + 1] = t2.y; bbi[q * 4 + 2] = t2.z; bbi[q * 4 + 3] = t2.w;
    }
    bf16x8 cf[4];
#pragma unroll
    for (int kb = 0; kb < 4; ++kb)
      cf[kb] = *(const bf16x8*)(p.s5ct() + ((size_t)(d * 32 + g) * 16 + fr) * 128 + kb * 32 + fq * 8);
    const float dcoef = p.s5_d[g * 16 + fr];
    u16* ydst = d ? p.ys5b() : p.ys5f();
    float hr = 0.f, hi = 0.f;
    for (int seg = 0; seg < 2; ++seg) {
      const int L = seg ? 2048 : 256;
      const int rowbase = seg ? b * 2048 : NLAT + b * 256;
      for (int c0 = 0; c0 < L; c0 += 64) {
        {
          int pos = c0 + lane;
          int t = d ? (L - 1 - pos) : pos;
          const u16* src = p.proj() + (size_t)(rowbase + t) * INC + g * 16;
          uint4 v0 = *(const uint4*)src, v1 = *(const uint4*)(src + 8);
          float4* ud = (float4*)(U + lane * 16);
          ud[0] = make_float4(bflo(v0.x), bfhi(v0.x), bflo(v0.y), bfhi(v0.y));
          ud[1] = make_float4(bflo(v0.z), bfhi(v0.z), bflo(v0.w), bfhi(v0.w));
          ud[2] = make_float4(bflo(v1.x), bfhi(v1.x), bflo(v1.y), bfhi(v1.y));
          ud[3] = make_float4(bflo(v1.z), bfhi(v1.z), bflo(v1.w), bfhi(v1.w));
        }
        for (int sub = 0; sub < 4; ++sub) {
#pragma unroll 4
          for (int i = 0; i < 16; ++i) {
            const float4* up = (const float4*)(U + (sub * 16 + i) * 16);
            float4 u0 = up[0], u1 = up[1], u2 = up[2], u3 = up[3];
            float ur[16] = {u0.x, u0.y, u0.z, u0.w, u1.x, u1.y, u1.z, u1.w, u2.x, u2.y, u2.z, u2.w, u3.x, u3.y, u3.z, u3.w};
            float br0 = 0.f, br1 = 0.f, bi0 = 0.f, bi1 = 0.f;
#pragma unroll
            for (int h = 0; h < 16; h += 2) {
              br0 += bbr[h] * ur[h]; br1 += bbr[h + 1] * ur[h + 1];
              bi0 += bbi[h] * ur[h]; bi1 += bbi[h + 1] * ur[h + 1];
            }
            float nr = abr * hr - abi * hi + (br0 + br1);
            float ni = abr * hi + abi * hr + (bi0 + bi1);
            hr = nr; hi = ni;
            if (seg) H[i * 68 + lane] = pack2(hr, hi);
          }
          if (seg) {
            f32x4 acc = (f32x4){0.f, 0.f, 0.f, 0.f};
#pragma unroll
            for (int kb = 0; kb < 4; ++kb) {
              bf16x8 a = *(const bf16x8*)((const u16*)H + fr * 136 + kb * 32 + fq * 8);
              acc = __builtin_amdgcn_mfma_f32_16x16x32_bf16(a, cf[kb], acc, 0, 0, 0);
            }
#pragma unroll
            for (int j = 0; j < 4; ++j) {
              int pi = sub * 16 + fq * 4 + j;
              int pos = c0 + pi;
              int t = d ? (L - 1 - pos) : pos;
              float y = acc[j];
              if (d == 0) y += dcoef * U[pi * 16 + fr];
              ydst[(size_t)(b * 2048 + t) * 512 + g * 16 + fr] = f2bf(y);
            }
          }
        }
      }
    }
  }
}

#define S5_LD 168
__device__ __forceinline__ void ph_s5scan2(const P& p, char* smem, int bid, int nb) {
  const int wid = tidx() >> 6, lane = tidx() & 63;
  u16* H = (u16*)(smem + wid * (32 * S5_LD * 2));
  const int n = lane & 31, hh = lane >> 5, fr = lane & 15, fq = lane >> 4;
  for (int r = lane; r < 32; r += 64) {
    *(uint4*)(H + r * S5_LD + 144) = make_uint4(0u, 0u, 0u, 0u);
    *(uint4*)(H + r * S5_LD + 152) = make_uint4(0u, 0u, 0u, 0u);
    *(uint4*)(H + r * S5_LD + 160) = make_uint4(0u, 0u, 0u, 0u);
  }
  for (int s = bid * 8 + wid; s < 2048; s += nb * 8) {
    const int g = s & 31, d = (s >> 5) & 1, b = s >> 6;
    float ar[2][4], ai[2][4], a8r[2], a8i[2];
#pragma unroll
    for (int st = 0; st < 2; ++st) {
      const int ci = (d * 32 + g) * 64 + st * 32 + n;
      const float xr = p.s5ab()[ci * 2], xi = p.s5ab()[ci * 2 + 1];
      ar[st][0] = xr; ai[st][0] = xi;
#pragma unroll
      for (int k = 1; k < 4; ++k) {
        ar[st][k] = ar[st][k - 1] * xr - ai[st][k - 1] * xi;
        ai[st][k] = ar[st][k - 1] * xi + ai[st][k - 1] * xr;
      }
      a8r[st] = ar[st][3] * ar[st][3] - ai[st][3] * ai[st][3];
      a8i[st] = 2.f * ar[st][3] * ai[st][3];
    }
    bf16x8 bfr[4];
#pragma unroll
    for (int nt = 0; nt < 4; ++nt) {
      const int ci = (d * 32 + g) * 64 + (nt & 1) * 32 + n;
      const float4 t0 = *(const float4*)(p.s5bb() + (size_t)ci * 32 + (nt >> 1) * 16 + 8 * hh);
      const float4 t1 = *(const float4*)(p.s5bb() + (size_t)ci * 32 + (nt >> 1) * 16 + 8 * hh + 4);
      union { unsigned u[4]; bf16x8 v; } t;
      t.u[0] = pack2(t0.x, t0.y); t.u[1] = pack2(t0.z, t0.w); t.u[2] = pack2(t1.x, t1.y); t.u[3] = pack2(t1.z, t1.w);
      bfr[nt] = t.v;
    }
    bf16x8 cf[5];
#pragma unroll
    for (int kb = 0; kb < 4; ++kb)
      cf[kb] = *(const bf16x8*)(p.s5ct() + ((size_t)(d * 32 + g) * 16 + fr) * 128 + kb * 32 + fq * 8);
    {
      const float dv = (d == 0) ? p.s5_d[g * 16 + fr] : 0.f;
      union { u16 h[8]; bf16x8 v; } t;
#pragma unroll
      for (int j = 0; j < 8; ++j) t.h[j] = (8 * fq + j == fr) ? f2bf(dv) : (u16)0;
      cf[4] = t.v;
    }
    u16* ydst = d ? p.ys5b() : p.ys5f();
    float hcr[2] = {0.f, 0.f}, hci[2] = {0.f, 0.f};
    for (int seg = 0; seg < 2; ++seg) {
      const int L = seg ? 2048 : 256;
      const int rowbase = seg ? b * 2048 : NLAT + b * 256;
      uint4 anext;
      {
        const int pos = n;
        const int t = d ? (L - 1 - pos) : pos;
        anext = *(const uint4*)(p.proj() + (size_t)(rowbase + t) * INC + g * 16 + 8 * hh);
      }
      for (int c0 = 0; c0 < L; c0 += 32) {
        const uint4 acur = anext;
        if (c0 + 32 < L) {
          const int pos = c0 + 32 + n;
          const int t = d ? (L - 1 - pos) : pos;
          anext = *(const uint4*)(p.proj() + (size_t)(rowbase + t) * INC + g * 16 + 8 * hh);
        }
        union { uint4 q; bf16x8 v; } af;
        af.q = acur;
        f32x16 acc[4];
#pragma unroll
        for (int nt = 0; nt < 4; ++nt) {
          f32x16 z;
#pragma unroll
          for (int r = 0; r < 16; ++r) z[r] = 0.f;
          acc[nt] = __builtin_amdgcn_mfma_f32_32x32x16_bf16(af.v, bfr[nt], z, 0, 0, 0);
        }
#pragma unroll
        for (int st = 0; st < 2; ++st)
#pragma unroll
          for (int gg = 0; gg < 4; ++gg)
#pragma unroll
            for (int j = 1; j < 4; ++j) {
              const float pr = acc[st][4 * gg + j - 1], pi = acc[2 + st][4 * gg + j - 1];
              acc[st][4 * gg + j] += ar[st][0] * pr - ai[st][0] * pi;
              acc[2 + st][4 * gg + j] += ar[st][0] * pi + ai[st][0] * pr;
            }
        float sr[2][4], si[2][4];
        {
          float e0r[2][4], e0i[2][4], qpr[2][4], qpi[2][4], s1r[2][4], s1i[2][4];
#pragma unroll
          for (int st = 0; st < 2; ++st)
#pragma unroll
            for (int gg = 0; gg < 4; ++gg) {
              e0r[st][gg] = __shfl_xor(acc[st][4 * gg + 3], 32, 64);
              e0i[st][gg] = __shfl_xor(acc[2 + st][4 * gg + 3], 32, 64);
            }
#pragma unroll
          for (int st = 0; st < 2; ++st) {
            float qr = hcr[st], qi = hci[st];
#pragma unroll
            for (int gg = 0; gg < 4; ++gg) {
              const float er = acc[st][4 * gg + 3], ei = acc[2 + st][4 * gg + 3];
              qpr[st][gg] = qr; qpi[st][gg] = qi;
              s1r[st][gg] = ar[st][3] * qr - ai[st][3] * qi + e0r[st][gg];
              s1i[st][gg] = ar[st][3] * qi + ai[st][3] * qr + e0i[st][gg];
              const float nqr = ar[st][3] * s1r[st][gg] - ai[st][3] * s1i[st][gg] + er;
              const float nqi = ar[st][3] * s1i[st][gg] + ai[st][3] * s1r[st][gg] + ei;
              qr = nqr; qi = nqi;
            }
            hcr[st] = qr; hci[st] = qi;
          }
#pragma unroll
          for (int st = 0; st < 2; ++st)
#pragma unroll
            for (int gg = 0; gg < 4; ++gg) {
              const float s0r = __shfl_xor(qpr[st][gg], 32, 64), s0i = __shfl_xor(qpi[st][gg], 32, 64);
              sr[st][gg] = hh ? s1r[st][gg] : s0r;
              si[st][gg] = hh ? s1i[st][gg] : s0i;
            }
        }
        if (seg) {
#pragma unroll
          for (int st = 0; st < 2; ++st)
#pragma unroll
            for (int gg = 0; gg < 4; ++gg)
#pragma unroll
              for (int j = 0; j < 4; ++j) {
                const float hr_ = acc[st][4 * gg + j] + ar[st][j] * sr[st][gg] - ai[st][j] * si[st][gg];
                const float hi_ = acc[2 + st][4 * gg + j] + ar[st][j] * si[st][gg] + ai[st][j] * sr[st][gg];
                const int tok = 8 * gg + 4 * hh + j;
                *(unsigned*)(H + tok * S5_LD + 2 * (st * 32 + n)) = pack2(hr_, hi_);
              }
          *(uint4*)(H + n * S5_LD + 128 + 8 * hh) = acur;
#pragma unroll
          for (int mt = 0; mt < 2; ++mt) {
            f32x4 y = (f32x4){0.f, 0.f, 0.f, 0.f};
#pragma unroll
            for (int kb = 0; kb < 5; ++kb) {
              const bf16x8 a = *(const bf16x8*)(H + (16 * mt + fr) * S5_LD + kb * 32 + fq * 8);
              y = __builtin_amdgcn_mfma_f32_16x16x32_bf16(a, cf[kb], y, 0, 0, 0);
            }
#pragma unroll
            for (int j = 0; j < 4; ++j) {
              const int pos = c0 + 16 * mt + 4 * fq + j;
              const int t = d ? (L - 1 - pos) : pos;
              ydst[(size_t)(b * 2048 + t) * 512 + g * 16 + fr] = f2bf(y[j]);
            }
          }
        }
      }
    }
  }
}

__device__ __forceinline__ float4 mix_load4(const u16* __restrict__ proj, size_t row, int col, const size_t* nrow,
                                            const bool* nval, float4 mu) {
  uint2 cz = *(const uint2*)(proj + row * INC + col);
  float z[4] = {bflo(cz.x), bfhi(cz.x), bflo(cz.y), bfhi(cz.y)};
  float o[4];
  float m[4] = {mu.x, mu.y, mu.z, mu.w};
#pragma unroll
  for (int j = 0; j < 4; ++j) {
    float nbv = 0.f;
    if (nval[j]) {
      u16 t = proj[nrow[j] * INC + col + j];
      nbv = bf2f(t);
    }
    o[j] = z[j] + (nbv - z[j]) * m[j];
  }
  return make_float4(o[0], o[1], o[2], o[3]);
}
__device__ __forceinline__ void neighbours(bool isctx, size_t row, int t, size_t* nrow, bool* nval) {
  if (isctx) {
    nrow[0] = row - 1; nval[0] = t > 0;
    nrow[1] = row + 1; nval[1] = t < 255;
    nrow[2] = row - 1; nval[2] = t > 0;
    nrow[3] = row + 1; nval[3] = t < 255;
  } else {
    int col = t & 63, gr = t >> 6;
    nrow[0] = row - 1; nval[0] = col > 0;
    nrow[1] = row + 1; nval[1] = col < 63;
    nrow[2] = row - 64; nval[2] = gr > 0;
    nrow[3] = row + 64; nval[3] = gr < 31;
  }
}

__device__ __forceinline__ void ph_rwscan(const P& p, char* smem, int bid, int nb) {
  const int tid = tidx(), sl = tid >> 8, stid = tid & 255, wv = stid >> 6, lane = tid & 63;
  char* sb = smem + sl * 49152;
  float* OPS = (float*)sb;
  float* LW = (float*)(sb + 24576);
  float* LA = LW + 512;
  float* WW = (float*)(sb + 28672);
  float* WA = WW + 2048;
  float* YB = (float*)(sb + 45056);
  const int tt = stid >> 4, part = stid & 15;
  const int vrow = wv * 16 + (lane >> 2), kq = lane & 3;
  for (int sp = bid; sp < 256; sp += nb) {
    const int s = sp * 2 + sl;
    const int d = s & 1, h = (s >> 1) & 7, b = s >> 4;
    __syncthreads();
    for (int e = stid; e < 2048; e += 256) {
      int j = e >> 6, cc = e & 63;
      WW[e] = p.rw_w_w2[(size_t)(d * 32 + j) * 512 + h * 64 + cc];
      WA[e] = p.rw_w_a2[(size_t)(d * 32 + j) * 512 + h * 64 + cc];
    }
    const int hc = h * 64 + part * 4;
    const float4 w0v = *(const float4*)(p.rw_w0 + d * 512 + hc);
    const float4 a0v = *(const float4*)(p.rw_a0 + d * 512 + hc);
    const float4 kkv = *(const float4*)(p.rw_k_k + hc);
    const float4 kav = *(const float4*)(p.rw_k_a + hc);
    const float4 rkv = *(const float4*)(p.rw_r_k + hc);
    const float4 mur = *(const float4*)(p.rw_mu + hc);
    const float4 muk = *(const float4*)(p.rw_mu + 512 + hc);
    const float4 muv = *(const float4*)(p.rw_mu + 1024 + hc);
    const float4 mul = *(const float4*)(p.rw_mu + 1536 + part * 4);
    u16* ydst = d ? p.yrwb() : p.yrwf();
    float S[16];
#pragma unroll
    for (int i = 0; i < 16; ++i) S[i] = 0.f;
    for (int seg = 0; seg < 2; ++seg) {
      const int L = seg ? 2048 : 256;
      const size_t rowbase = seg ? (size_t)b * 2048 : (size_t)NLAT + b * 256;
      for (int c0 = 0; c0 < L; c0 += 16) {
        const int pos = c0 + tt;
        const int t = d ? (L - 1 - pos) : pos;
        const size_t row = rowbase + t;
        size_t nrow[4];
        bool nval[4];
        neighbours(seg == 0, row, t, nrow, nval);
        float4 r4 = mix_load4(p.proj(), row, 512 + hc, nrow, nval, mur);
        float4 k4 = mix_load4(p.proj(), row, 512 + 512 + hc, nrow, nval, muk);
        float4 v4 = mix_load4(p.proj(), row, 512 + 1024 + hc, nrow, nval, muv);
        float4 l4 = mix_load4(p.proj(), row, 512 + 1536 + part * 4, nrow, nval, mul);
        if (part < 8) {
          *(float4*)(LW + tt * 32 + part * 4) = make_float4(tanhf(l4.x), tanhf(l4.y), tanhf(l4.z), tanhf(l4.w));
        } else {
          *(float4*)(LA + tt * 32 + (part - 8) * 4) = l4;
        }
        __syncthreads();
        float wp[4] = {w0v.x, w0v.y, w0v.z, w0v.w};
        float ap[4] = {a0v.x, a0v.y, a0v.z, a0v.w};
#pragma unroll 8
        for (int j = 0; j < 32; ++j) {
          float lw = LW[tt * 32 + j], la = LA[tt * 32 + j];
          float4 ww = *(const float4*)(WW + j * 64 + part * 4);
          float4 wa = *(const float4*)(WA + j * 64 + part * 4);
          wp[0] += lw * ww.x; wp[1] += lw * ww.y; wp[2] += lw * ww.z; wp[3] += lw * ww.w;
          ap[0] += la * wa.x; ap[1] += la * wa.y; ap[2] += la * wa.z; ap[3] += la * wa.w;
        }
        float rr[4] = {r4.x, r4.y, r4.z, r4.w}, kk4[4] = {k4.x, k4.y, k4.z, k4.w};
        float kkc[4] = {kkv.x, kkv.y, kkv.z, kkv.w}, kac[4] = {kav.x, kav.y, kav.z, kav.w}, rkc[4] = {rkv.x, rkv.y, rkv.z, rkv.w};
        float dec[4], aa[4], kd[4], kkr[4];
        float ss = 0.f, bon = 0.f;
#pragma unroll
        for (int i = 0; i < 4; ++i) {
          float xw = -wp[i];
          float sp_ = fmaxf(xw, 0.f) + log1pf(expf(-fabsf(xw)));
          float wl = -sp_ - 0.5f;
          dec[i] = expf(-expf(wl));
          aa[i] = 1.f / (1.f + expf(-ap[i]));
          kd[i] = kk4[i] * (1.f + (aa[i] - 1.f) * kac[i]);
          kkr[i] = kk4[i] * kkc[i];
          ss += kkr[i] * kkr[i];
          bon += rr[i] * kd[i] * rkc[i];
        }
#pragma unroll
        for (int m = 0; m < 4; ++m) {
          ss = dpp_add(ss, m, 0);
          bon = dpp_add(bon, m, 0);
        }
        float inv = rsqrtf(ss + 1e-12f);
        float* o = OPS + tt * 384 + part * 4;
        *(float4*)(o + 0) = r4;
        *(float4*)(o + 64) = make_float4(dec[0], dec[1], dec[2], dec[3]);
        *(float4*)(o + 128) = make_float4(kd[0], kd[1], kd[2], kd[3]);
        *(float4*)(o + 192) = make_float4(-kkr[0] * inv, -kkr[1] * inv, -kkr[2] * inv, -kkr[3] * inv);
        *(float4*)(o + 256) = make_float4(kkr[0] * inv * aa[0], kkr[1] * inv * aa[1], kkr[2] * inv * aa[2], kkr[3] * inv * aa[3]);
        *(float4*)(o + 320) = v4;
        if (seg && part == 0) p.bsc()[((size_t)d * NLAT + row) * 8 + h] = bon;
        __syncthreads();
        for (int i = 0; i < 16; ++i) {
          const float* oo = OPS + i * 384 + kq * 16;
          float kn[16], wv_[16], bv[16], kdv[16];
#pragma unroll
          for (int q = 0; q < 4; ++q) {
            float4 a = *(const float4*)(oo + 192 + q * 4);
            kn[q * 4] = a.x; kn[q * 4 + 1] = a.y; kn[q * 4 + 2] = a.z; kn[q * 4 + 3] = a.w;
            float4 w_ = *(const float4*)(oo + 64 + q * 4);
            wv_[q * 4] = w_.x; wv_[q * 4 + 1] = w_.y; wv_[q * 4 + 2] = w_.z; wv_[q * 4 + 3] = w_.w;
            float4 b_ = *(const float4*)(oo + 256 + q * 4);
            bv[q * 4] = b_.x; bv[q * 4 + 1] = b_.y; bv[q * 4 + 2] = b_.z; bv[q * 4 + 3] = b_.w;
            float4 k_ = *(const float4*)(oo + 128 + q * 4);
            kdv[q * 4] = k_.x; kdv[q * 4 + 1] = k_.y; kdv[q * 4 + 2] = k_.z; kdv[q * 4 + 3] = k_.w;
          }
          float vv = OPS[i * 384 + 320 + vrow];
          float s0 = 0.f, s1 = 0.f, s2 = 0.f, s3 = 0.f;
#pragma unroll
          for (int q = 0; q < 16; q += 4) {
            s0 += S[q] * kn[q]; s1 += S[q + 1] * kn[q + 1]; s2 += S[q + 2] * kn[q + 2]; s3 += S[q + 3] * kn[q + 3];
          }
          float sa = (s0 + s1) + (s2 + s3);
          sa = dpp_add(sa, 0, 0);
          sa = dpp_add(sa, 1, 0);
#pragma unroll
          for (int q = 0; q < 16; ++q) S[q] = S[q] * wv_[q] + sa * bv[q] + vv * kdv[q];
          if (seg) {
            float rv[16];
#pragma unroll
            for (int q = 0; q < 4; ++q) {
              float4 a = *(const float4*)(oo + q * 4);
              rv[q * 4] = a.x; rv[q * 4 + 1] = a.y; rv[q * 4 + 2] = a.z; rv[q * 4 + 3] = a.w;
            }
            float y0 = 0.f, y1 = 0.f, y2 = 0.f, y3 = 0.f;
#pragma unroll
            for (int q = 0; q < 16; q += 4) {
              y0 += S[q] * rv[q]; y1 += S[q + 1] * rv[q + 1]; y2 += S[q + 2] * rv[q + 2]; y3 += S[q + 3] * rv[q + 3];
            }
            float y = (y0 + y1) + (y2 + y3);
            y = dpp_add(y, 0, 0);
            y = dpp_add(y, 1, 0);
            if (kq == 0) YB[i * 64 + vrow] = y;
          }
        }
        __syncthreads();
        if (seg) {
          float4 yv = *(const float4*)(YB + tt * 64 + part * 4);
          uint2 o2;
          o2.x = pack2(yv.x, yv.y); o2.y = pack2(yv.z, yv.w);
          *(uint2*)(ydst + row * 512 + hc) = o2;
        }
      }
    }
  }
}

#define RW_AR_LD 68
#define RW_RM_LD 72
#define RW_SLOT_BYTES 11776
#define RW_SCR_BYTES 9216
#define RW_STREAM_BYTES (4 * RW_SLOT_BYTES + 3 * RW_SCR_BYTES + 2304)
__device__ __forceinline__ unsigned cvtpk(float lo, float hi) { return pack2(lo, hi); }
__device__ __forceinline__ float dpp_shr_add(float v, const int n) {
  int m;
  switch (n) {
    case 1: m = __builtin_amdgcn_update_dpp(0, __float_as_int(v), 0x111, 0xf, 0xf, true); break;
    case 2: m = __builtin_amdgcn_update_dpp(0, __float_as_int(v), 0x112, 0xf, 0xf, true); break;
    case 4: m = __builtin_amdgcn_update_dpp(0, __float_as_int(v), 0x114, 0xf, 0xf, true); break;
    default: m = __builtin_amdgcn_update_dpp(0, __float_as_int(v), 0x118, 0xf, 0xf, true); break;
  }
  return v + __int_as_float(m);
}
__device__ __forceinline__ int opaque(int x) { asm volatile("" : "+v"(x)); return x; }
__device__ __forceinline__ float fsig(float x) { return __builtin_amdgcn_rcpf(1.f + __expf(-x)); }

__device__ __forceinline__ void ph_rwscan2(const P& p, char* smem, int bid, int nb) {
  const int tid = tidx(), wid = tid >> 6, lane = tid & 63, sl = wid >> 2, wv = wid & 3;
  char* sb = smem + sl * RW_STREAM_BYTES;
  float* CST = (float*)(sb + 4 * RW_SLOT_BYTES + 3 * RW_SCR_BYTES);
  const int NCH = 144;
  for (int sp = bid; sp < 256; sp += nb) {
    const int s = sp * 2 + sl;
    const int d = s & 1, h = (s >> 1) & 7, b = s >> 4;
    __syncthreads();
    if (wv == 0) {
      const int cc = lane;
      CST[0 * 64 + cc] = p.rw_w0[d * 512 + h * 64 + cc];
      CST[1 * 64 + cc] = p.rw_a0[d * 512 + h * 64 + cc];
      CST[2 * 64 + cc] = p.rw_k_k[h * 64 + cc];
      CST[3 * 64 + cc] = p.rw_k_a[h * 64 + cc];
      CST[4 * 64 + cc] = p.rw_r_k[h * 64 + cc];
      CST[5 * 64 + cc] = p.rw_mu[h * 64 + cc];
      CST[6 * 64 + cc] = p.rw_mu[512 + h * 64 + cc];
      CST[7 * 64 + cc] = p.rw_mu[1024 + h * 64 + cc];
      CST[8 * 64 + cc] = p.rw_mu[1536 + cc];
    }
    __syncthreads();
    if (wv == 0) {
      const int v32 = lane & 31, hh = lane >> 5;
      u16* ydst = d ? p.yrwb() : p.yrwf();
      f32x16 X[2][2];
#pragma unroll
      for (int mt = 0; mt < 2; ++mt)
#pragma unroll
        for (int vt = 0; vt < 2; ++vt)
#pragma unroll
          for (int r = 0; r < 16; ++r) X[mt][vt][r] = 0.f;
      for (int tick = 0; tick < NCH + 4; ++tick) {
        if (tick >= 3 + sl && tick - 3 - sl < NCH) {
          const int c = tick - 3 - sl;
          const char* slot = sb + (c & 3) * RW_SLOT_BYTES;
          const u16* AR = (const u16*)slot;
          const u16* MG = (const u16*)(slot + 4352);
          const u16* BT = (const u16*)(slot + 5376);
          const u16* KT = (const u16*)(slot + 7424);
          const u16* VT = (const u16*)(slot + 9472);
          const float* WC = (const float*)(slot + 11520);
          {
            const char* scr = sb + 4 * RW_SLOT_BYTES + (c % 3) * RW_SCR_BYTES;
            const u16* RHs = (const u16*)scr + 16 * RW_RM_LD;
            const float* AAv = (const float*)((const u16*)scr + 32 * RW_RM_LD);
            const float* Arb = AAv + 512;
            const float* Ark = AAv + 768;
            u16* ARw = (u16*)slot;
            u16* MGw = (u16*)(slot + 4352);
            const int ol = opaque(lane), oj = opaque(lane & 15);
            float ah[16], m2[16];
#pragma unroll
            for (int tt = 0; tt < 16; ++tt) {
              const int m0 = 8 * (tt >> 2) + (tt & 3);
              ah[tt] = bf2f(ARw[ol + m0 * RW_AR_LD]);
              m2[tt] = bf2f(MGw[oj + m0 * 16]);
            }
#pragma unroll
            for (int tt = 0; tt < 16; ++tt) {
              float acc = bf2f(RHs[ol + tt * RW_RM_LD]);
              float accg = Ark[oj + tt * 16];
#pragma unroll
              for (int i4 = 0; i4 < (tt + 4) / 4; ++i4) {
                const float4 s4 = *(const float4*)(Arb + tt * 16 + 4 * i4);
                const float sv[4] = {s4.x, s4.y, s4.z, s4.w};
#pragma unroll
                for (int q = 0; q < 4; ++q) {
                  const int i = 4 * i4 + q;
                  if (i <= tt) { acc += sv[q] * ah[i]; accg += sv[q] * m2[i]; }
                }
              }
              const int m0 = 8 * (tt >> 2) + (tt & 3);
              ARw[ol + (m0 + 4) * RW_AR_LD] = f2bf(acc);
              if (lane < 16) MGw[oj + (m0 + 4) * 16] = f2bf(accg);
            }
          }
          bf16x8 vtf[2];
#pragma unroll
          for (int vt = 0; vt < 2; ++vt) vtf[vt] = *(const bf16x8*)(VT + (32 * vt + v32) * 16 + 8 * hh);
          f32x16 UY[2];
#pragma unroll
          for (int vt = 0; vt < 2; ++vt)
#pragma unroll
            for (int r = 0; r < 16; ++r) UY[vt][r] = 0.f;
          {
            const bf16x8 mgf = *(const bf16x8*)(MG + v32 * 16 + 8 * hh);
#pragma unroll
            for (int vt = 0; vt < 2; ++vt) UY[vt] = __builtin_amdgcn_mfma_f32_32x32x16_bf16(mgf, vtf[vt], UY[vt], 0, 0, 0);
          }
#pragma unroll
          for (int mt = 0; mt < 2; ++mt)
#pragma unroll
            for (int ks = 0; ks < 2; ++ks) {
              const int base = 32 * mt + 16 * ks + 4 * hh;
              const uint2 a0 = *(const uint2*)(AR + v32 * RW_AR_LD + base);
              const uint2 a1 = *(const uint2*)(AR + v32 * RW_AR_LD + base + 8);
              union { unsigned u[4]; bf16x8 v; } af;
              af.u[0] = a0.x; af.u[1] = a0.y; af.u[2] = a1.x; af.u[3] = a1.y;
#pragma unroll
              for (int vt = 0; vt < 2; ++vt) {
                union { unsigned u[4]; bf16x8 v; } xf;
#pragma unroll
                for (int q = 0; q < 4; ++q) xf.u[q] = cvtpk(X[mt][vt][8 * ks + 2 * q], X[mt][vt][8 * ks + 2 * q + 1]);
                UY[vt] = __builtin_amdgcn_mfma_f32_32x32x16_bf16(af.v, xf.v, UY[vt], 0, 0, 0);
              }
            }
          if (c >= 16 && hh == 1) {
#pragma unroll
            for (int r = 0; r < 16; ++r) {
              const int pos = (c - 16) * 16 + r;
              const int tok = d ? (2047 - pos) : pos;
              u16* yp = ydst + ((size_t)b * 2048 + tok) * 512 + h * 64 + v32;
              yp[0] = f2bf(UY[0][r]);
              yp[32] = f2bf(UY[1][r]);
            }
          }
          bf16x8 uyf[2][2];
#pragma unroll
          for (int vt = 0; vt < 2; ++vt)
#pragma unroll
            for (int ks = 0; ks < 2; ++ks) {
              union { unsigned u[4]; bf16x8 v; } t_;
#pragma unroll
              for (int q = 0; q < 4; ++q) t_.u[q] = cvtpk(UY[vt][8 * ks + 2 * q], UY[vt][8 * ks + 2 * q + 1]);
              uyf[vt][ks] = t_.v;
            }
#pragma unroll
          for (int mt = 0; mt < 2; ++mt) {
            const int krow = 32 * mt + v32;
            const bf16x8 ktf = *(const bf16x8*)(KT + krow * 16 + 8 * hh);
            bf16x8 btf[2];
#pragma unroll
            for (int ks = 0; ks < 2; ++ks) {
              btf[ks] = *(const bf16x8*)(BT + krow * 16 + 8 * ks);
              if (hh) btf[ks] = (bf16x8){0, 0, 0, 0, 0, 0, 0, 0};
            }
#pragma unroll
            for (int vt = 0; vt < 2; ++vt) {
              X[mt][vt] = __builtin_amdgcn_mfma_f32_32x32x16_bf16(ktf, vtf[vt], X[mt][vt], 0, 0, 0);
#pragma unroll
              for (int ks = 0; ks < 2; ++ks) X[mt][vt] = __builtin_amdgcn_mfma_f32_32x32x16_bf16(btf[ks], uyf[vt][ks], X[mt][vt], 0, 0, 0);
            }
#pragma unroll
            for (int g = 0; g < 4; ++g) {
              const float4 w4 = *(const float4*)(WC + 32 * mt + 8 * g + 4 * hh);
#pragma unroll
              for (int vt = 0; vt < 2; ++vt) {
                X[mt][vt][4 * g + 0] *= w4.x; X[mt][vt][4 * g + 1] *= w4.y;
                X[mt][vt][4 * g + 2] *= w4.z; X[mt][vt][4 * g + 3] *= w4.w;
              }
            }
          }
        }
        __syncthreads();
      }
    } else {
      const int pw = wv - 1;
      const int t = lane & 15, kq = lane >> 4;
      char* scr = sb + 4 * RW_SLOT_BYTES + pw * RW_SCR_BYTES;
      u16* AL = (u16*)scr;
      u16* RH = AL + 16 * RW_RM_LD;
      u16* BE = RH + 16 * RW_RM_LD;
      u16* KA = BE + 16 * RW_RM_LD;
      float* AAs = (float*)BE;
      const int o_kq4 = opaque(4 * kq);
      const int o_tr = opaque(64 * kq + t);
      const int o_rm = opaque(t * RW_RM_LD + 4 * kq);
      const int o_l = opaque(lane);
      const int o_j = opaque(lane & 15);
      const float* cstl = CST + o_kq4;
      bf16x8 wwf[4], waf[4];
      {
        const int o_wl = (((d * 8 + h) * 4) * 64 + lane) * 8;
#pragma unroll
        for (int mt = 0; mt < 4; ++mt) {
          wwf[mt] = *(const bf16x8*)(p.wlf() + o_wl + mt * 512);
          waf[mt] = *(const bf16x8*)(p.wlf() + o_wl + 32768 + mt * 512);
        }
      }
      for (int i = 0; i < pw + sl; ++i) __syncthreads();
      for (int c = pw; c < NCH; c += 3) {
        char* slot = sb + (c & 3) * RW_SLOT_BYTES;
        u16* AR = (u16*)slot;
        u16* MG = (u16*)(slot + 4352);
        u16* BT = (u16*)(slot + 5376);
        u16* KT = (u16*)(slot + 7424);
        u16* VT = (u16*)(slot + 9472);
        float* WC = (float*)(slot + 11520);
        const bool lat = c >= 16;
        const int L = lat ? 2048 : 256;
        const int pos = (lat ? (c - 16) : c) * 16 + t;
        const int tok = d ? (L - 1 - pos) : pos;
        const size_t row = (lat ? (size_t)b * 2048 : (size_t)NLAT + (size_t)b * 256) + tok;
        const u16* cbase = p.proj() + row * INC + 512;
        const u16* nbase[4];
        float nmask[4];
        {
          size_t nrow[4];
          bool nval[4];
          neighbours(!lat, row, tok, nrow, nval);
#pragma unroll
          for (int j = 0; j < 4; ++j) {
            nbase[j] = p.proj() + (nval[j] ? nrow[j] : row) * INC + 512 + j;
            nmask[j] = nval[j] ? 1.f : 0.f;
          }
        }
        bf16x8 lwf, laf;
        {
          const int colw = 1536 + 8 * kq, cola = 1568 + 8 * kq;
          const uint4 cw = *(const uint4*)(cbase + colw), ca = *(const uint4*)(cbase + cola);
          const unsigned cwu[4] = {cw.x, cw.y, cw.z, cw.w}, cau[4] = {ca.x, ca.y, ca.z, ca.w};
          float lw[8], la[8];
          const float4 ml0 = *(const float4*)(cstl + o_kq4 + 8 * 64), ml1 = *(const float4*)(cstl + o_kq4 + 8 * 64 + 4);
          const float4 ma0 = *(const float4*)(cstl + o_kq4 + 8 * 64 + 32), ma1 = *(const float4*)(cstl + o_kq4 + 8 * 64 + 32 + 4);
          const float mul_[8] = {ml0.x, ml0.y, ml0.z, ml0.w, ml1.x, ml1.y, ml1.z, ml1.w};
          const float mua_[8] = {ma0.x, ma0.y, ma0.z, ma0.w, ma1.x, ma1.y, ma1.z, ma1.w};
#pragma unroll
          for (int q = 0; q < 8; ++q) {
            const float zw = (q & 1) ? bfhi(cwu[q >> 1]) : bflo(cwu[q >> 1]);
            const float za = (q & 1) ? bfhi(cau[q >> 1]) : bflo(cau[q >> 1]);
            const float nw = bf2f(nbase[q & 3][colw + (q & 4)]) * nmask[q & 3];
            const float na = bf2f(nbase[q & 3][cola + (q & 4)]) * nmask[q & 3];
            lw[q] = 1.f - 2.f * __builtin_amdgcn_rcpf(1.f + __expf(2.f * (zw + (nw - zw) * mul_[q])));
            la[q] = za + (na - za) * mua_[q];
          }
          union { unsigned u[4]; bf16x8 v; } tw, ta;
#pragma unroll
          for (int q = 0; q < 4; ++q) { tw.u[q] = pack2(lw[2 * q], lw[2 * q + 1]); ta.u[q] = pack2(la[2 * q], la[2 * q + 1]); }
          lwf = tw.v; laf = ta.v;
        }
        float ee[16];
        unsigned rrp[8], aap[8], kxp[8];
        {
          const u16* cb2 = cbase + h * 64 + 4 * kq;
          const u16* nb2[4] = {nbase[0] + h * 64 + 4 * kq, nbase[1] + h * 64 + 4 * kq, nbase[2] + h * 64 + 4 * kq, nbase[3] + h * 64 + 4 * kq};
#pragma unroll
          for (int mt = 0; mt < 4; ++mt) {
            const float4 mr = *(const float4*)(cstl + 5 * 64 + 16 * mt), mk = *(const float4*)(cstl + 6 * 64 + 16 * mt), mv = *(const float4*)(cstl + 7 * 64 + 16 * mt);
            const float mrv[4] = {mr.x, mr.y, mr.z, mr.w}, mkv[4] = {mk.x, mk.y, mk.z, mk.w}, mvv[4] = {mv.x, mv.y, mv.z, mv.w};
            const uint2 cr = *(const uint2*)(cb2 + 16 * mt), ck = *(const uint2*)(cb2 + 512 + 16 * mt), cv = *(const uint2*)(cb2 + 1024 + 16 * mt);
            const float zr[4] = {bflo(cr.x), bfhi(cr.x), bflo(cr.y), bfhi(cr.y)};
            const float zk[4] = {bflo(ck.x), bfhi(ck.x), bflo(ck.y), bfhi(ck.y)};
            const float zv[4] = {bflo(cv.x), bfhi(cv.x), bflo(cv.y), bfhi(cv.y)};
            float kxv[4], rrv[4], aav[4];
#pragma unroll
            for (int j = 0; j < 4; ++j) {
              const float nr = bf2f(nb2[j][16 * mt]) * nmask[j];
              const float nk = bf2f(nb2[j][512 + 16 * mt]) * nmask[j];
              const float nv = bf2f(nb2[j][1024 + 16 * mt]) * nmask[j];
              rrv[j] = zr[j] + (nr - zr[j]) * mrv[j];
              kxv[j] = zk[j] + (nk - zk[j]) * mkv[j];
              VT[o_tr + (16 * mt + j) * 16] = f2bf(zv[j] + (nv - zv[j]) * mvv[j]);
            }
            const f32x4 z4 = (f32x4){0.f, 0.f, 0.f, 0.f};
            const f32x4 aw = __builtin_amdgcn_mfma_f32_16x16x32_bf16(wwf[mt], lwf, z4, 0, 0, 0);
            const f32x4 a2 = __builtin_amdgcn_mfma_f32_16x16x32_bf16(waf[mt], laf, z4, 0, 0, 0);
            const float4 w0 = *(const float4*)(cstl + 0 * 64 + 16 * mt), a0 = *(const float4*)(cstl + 1 * 64 + 16 * mt);
            ee[4 * mt] = 0.60653066f * fsig(w0.x + aw[0]); ee[4 * mt + 1] = 0.60653066f * fsig(w0.y + aw[1]);
            ee[4 * mt + 2] = 0.60653066f * fsig(w0.z + aw[2]); ee[4 * mt + 3] = 0.60653066f * fsig(w0.w + aw[3]);
            aav[0] = fsig(a0.x + a2[0]); aav[1] = fsig(a0.y + a2[1]);
            aav[2] = fsig(a0.z + a2[2]); aav[3] = fsig(a0.w + a2[3]);
            rrp[2 * mt] = pack2(rrv[0], rrv[1]); rrp[2 * mt + 1] = pack2(rrv[2], rrv[3]);
            aap[2 * mt] = pack2(aav[0], aav[1]); aap[2 * mt + 1] = pack2(aav[2], aav[3]);
            kxp[2 * mt] = pack2(kxv[0], kxv[1]); kxp[2 * mt + 1] = pack2(kxv[2], kxv[3]);
          }
        }
        __syncthreads();
        float kdf[16], kkf[16];
        float inv;
        {
          float ss = 0.f, bon = 0.f;
#pragma unroll
          for (int mt = 0; mt < 4; ++mt) {
            const float4 c2 = *(const float4*)(cstl + 2 * 64 + 16 * mt), c3 = *(const float4*)(cstl + 3 * 64 + 16 * mt), c4 = *(const float4*)(cstl + 4 * 64 + 16 * mt);
            const float kkc[4] = {c2.x, c2.y, c2.z, c2.w}, kac[4] = {c3.x, c3.y, c3.z, c3.w}, rkc[4] = {c4.x, c4.y, c4.z, c4.w};
#pragma unroll
            for (int j = 0; j < 4; ++j) {
              const int e = 4 * mt + j;
              const float kx = (e & 1) ? bfhi(kxp[e >> 1]) : bflo(kxp[e >> 1]);
              const float av = (e & 1) ? bfhi(aap[e >> 1]) : bflo(aap[e >> 1]);
              const float rv = (e & 1) ? bfhi(rrp[e >> 1]) : bflo(rrp[e >> 1]);
              kdf[e] = kx * (1.f + (av - 1.f) * kac[j]);
              kkf[e] = kx * kkc[j];
              ss += kkf[e] * kkf[e];
              bon += rv * kdf[e] * rkc[j];
            }
          }
          ss += __shfl_xor(ss, 16, 64); ss += __shfl_xor(ss, 32, 64);
          bon += __shfl_xor(bon, 16, 64); bon += __shfl_xor(bon, 32, 64);
          inv = rsqrtf(ss + 1e-12f);
          if (lat && kq == 0) p.bsc()[((size_t)d * NLAT + row) * 8 + h] = bon;
        }
#pragma unroll
        for (int mt = 0; mt < 4; ++mt) {
          float al4[4], rh4[4], be4[4], ka4[4];
#pragma unroll
          for (int j = 0; j < 4; ++j) {
            const int e = 4 * mt + j;
            float cs = ee[e];
            cs = dpp_shr_add(cs, 1); cs = dpp_shr_add(cs, 2); cs = dpp_shr_add(cs, 4); cs = dpp_shr_add(cs, 8);
            const float Ep = __expf(cs), Em = __builtin_amdgcn_rcpf(Ep), Ex = __expf(ee[e] - cs);
            const float kkn = kkf[e] * inv;
            al4[j] = -kkn * Ex;
            be4[j] = kkn * ((e & 1) ? bfhi(aap[e >> 1]) : bflo(aap[e >> 1])) * Ep;
            ka4[j] = kdf[e] * Ep;
            rh4[j] = ((e & 1) ? bfhi(rrp[e >> 1]) : bflo(rrp[e >> 1])) * Em;
            BT[o_tr + (16 * mt + j) * 16] = f2bf(be4[j]);
            KT[o_tr + (16 * mt + j) * 16] = f2bf(ka4[j]);
            if (t == 15) WC[o_kq4 + 16 * mt + j] = Em;
          }
          const int ko = o_rm + 16 * mt;
          *(uint2*)(AL + ko) = make_uint2(pack2(al4[0], al4[1]), pack2(al4[2], al4[3]));
          *(uint2*)(RH + ko) = make_uint2(pack2(rh4[0], rh4[1]), pack2(rh4[2], rh4[3]));
          *(uint2*)(BE + ko) = make_uint2(pack2(be4[0], be4[1]), pack2(be4[2], be4[3]));
          *(uint2*)(KA + ko) = make_uint2(pack2(ka4[0], ka4[1]), pack2(ka4[2], ka4[3]));
        }
        {
          const int m = lane & 31, hh = lane >> 5;
          const int typ = (m >> 2) & 1, tt = 4 * (m >> 3) + (m & 3);
          const u16* arow = (typ ? RH : AL) + tt * RW_RM_LD + 8 * hh;
          const u16* brow = ((m >> 4) ? KA : BE) + (m & 15) * RW_RM_LD + 8 * hh;
          f32x16 aa;
#pragma unroll
          for (int r = 0; r < 16; ++r) aa[r] = 0.f;
#pragma unroll
          for (int ks = 0; ks < 4; ++ks) {
            const bf16x8 af = *(const bf16x8*)(arow + 16 * ks);
            const bf16x8 bf_ = *(const bf16x8*)(brow + 16 * ks);
            aa = __builtin_amdgcn_mfma_f32_32x32x16_bf16(af, bf_, aa, 0, 0, 0);
          }
          const int i = m & 15;
          const int o_aa = opaque((hh * 2 + (m >> 4)) * 256 + i);
#pragma unroll
          for (int r = 0; r < 16; ++r) {
            const bool keep = hh ? (i <= r) : (i < r);
            AAs[o_aa + r * 16] = keep ? aa[r] : 0.f;
          }
        }
        __syncthreads();
        {
          const float* Aab = AAs;
          const float* Aak = AAs + 256;
          const float* Arb = AAs + 512;
          const float* Ark = AAs + 768;
          float ah[16], m2[16];
#pragma unroll
          for (int tt = 0; tt < 16; ++tt) {
            float acc = bf2f(AL[o_l + tt * RW_RM_LD]);
            float accm = Aak[o_j + tt * 16];
#pragma unroll
            for (int i4 = 0; i4 < (tt + 3) / 4; ++i4) {
              const float4 s4 = *(const float4*)(Aab + tt * 16 + 4 * i4);
              const float sv[4] = {s4.x, s4.y, s4.z, s4.w};
#pragma unroll
              for (int q = 0; q < 4; ++q) {
                const int i = 4 * i4 + q;
                if (i < tt) { acc += sv[q] * ah[i]; accm += sv[q] * m2[i]; }
              }
            }
            ah[tt] = acc; m2[tt] = accm;
          }
#pragma unroll
          for (int tt = 0; tt < 16; ++tt) {
            const int m0 = 8 * (tt >> 2) + (tt & 3);
            AR[o_l + m0 * RW_AR_LD] = f2bf(ah[tt]);
            if (lane < 16) MG[o_j + m0 * 16] = f2bf(m2[tt]);
          }
        }
        __syncthreads();
      }
      for (int i = 0; i < 4 - pw - sl; ++i) __syncthreads();
    }
  }
}

struct MixLd {
  uint4 s5f, s5b, rwf, rwb, vc, gc;
  u16 vn[8], gn[8];
  float bs0, bs1;
};
__device__ __forceinline__ void mix_load(const P& p, int row, int lane, MixLd& L, float (&nmask)[4]) {
  const int c8 = lane * 8, t = row & 2047;
  L.s5f = *(const uint4*)(p.ys5f() + (size_t)row * 512 + c8);
  L.s5b = *(const uint4*)(p.ys5b() + (size_t)row * 512 + c8);
  L.rwf = *(const uint4*)(p.yrwf() + (size_t)row * 512 + c8);
  L.rwb = *(const uint4*)(p.yrwb() + (size_t)row * 512 + c8);
  size_t nrow[4];
  bool nval[4];
  neighbours(false, (size_t)row, t, nrow, nval);
  const u16* nb_[4];
#pragma unroll
  for (int j = 0; j < 4; ++j) { nb_[j] = p.proj() + (nval[j] ? nrow[j] : (size_t)row) * INC + 512 + j; nmask[j] = nval[j] ? 1.f : 0.f; }
  const u16* cb = p.proj() + (size_t)row * INC + 512;
  L.vc = *(const uint4*)(cb + 1024 + c8);
#pragma unroll
  for (int i = 0; i < 8; ++i) L.vn[i] = nb_[i & 3][1024 + c8 + (i & 4)];
  const int g8 = (lane < 12) ? c8 : 0;
  L.gc = *(const uint4*)(cb + 1600 + g8);
#pragma unroll
  for (int i = 0; i < 8; ++i) L.gn[i] = nb_[i & 3][1600 + g8 + (i & 4)];
  const int head = lane >> 3;
  L.bs0 = p.bsc()[(size_t)row * 8 + head];
  L.bs1 = p.bsc()[((size_t)NLAT + row) * 8 + head];
}
__device__ __forceinline__ void mix_compute(const P& p, int row, int lane, const MixLd& L, const float (&nmask)[4], u16* y1dst, u16* t1dst) {
  const int c8 = lane * 8;
  {
    const unsigned au[4] = {L.s5f.x, L.s5f.y, L.s5f.z, L.s5f.w}, bu[4] = {L.s5b.x, L.s5b.y, L.s5b.z, L.s5b.w};
    unsigned ou[4];
#pragma unroll
    for (int q = 0; q < 4; ++q) ou[q] = pack2(gelu_as(bflo(au[q]) + bflo(bu[q])), gelu_as(bfhi(au[q]) + bfhi(bu[q])));
    *(uint4*)(y1dst + (size_t)row * 512 + c8) = make_uint4(ou[0], ou[1], ou[2], ou[3]);
  }
  float y[8];
  {
    const unsigned au[4] = {L.rwf.x, L.rwf.y, L.rwf.z, L.rwf.w}, bu[4] = {L.rwb.x, L.rwb.y, L.rwb.z, L.rwb.w};
#pragma unroll
    for (int q = 0; q < 4; ++q) { y[2 * q] = bflo(au[q]) + bflo(bu[q]); y[2 * q + 1] = bfhi(au[q]) + bfhi(bu[q]); }
  }
  float sm = 0.f;
#pragma unroll
  for (int i = 0; i < 8; ++i) sm += y[i];
  sm = dpp_add(sm, 0, 0); sm = dpp_add(sm, 1, 0); sm = dpp_add(sm, 2, 0);
  const float mu = sm * (1.f / 64.f);
  float sv = 0.f;
#pragma unroll
  for (int i = 0; i < 8; ++i) sv += (y[i] - mu) * (y[i] - mu);
  sv = dpp_add(sv, 0, 0); sv = dpp_add(sv, 1, 0); sv = dpp_add(sv, 2, 0);
  const float rs = rsqrtf(sv * (1.f / 64.f) + 64e-5f);
  float v[8];
  {
    const unsigned cu[4] = {L.vc.x, L.vc.y, L.vc.z, L.vc.w};
    const float4 m0 = *(const float4*)(p.rw_mu + 1024 + c8), m1 = *(const float4*)(p.rw_mu + 1024 + c8 + 4);
    const float mm[8] = {m0.x, m0.y, m0.z, m0.w, m1.x, m1.y, m1.z, m1.w};
#pragma unroll
    for (int i = 0; i < 8; ++i) {
      const float z = (i & 1) ? bfhi(cu[i >> 1]) : bflo(cu[i >> 1]);
      const float nbv = bf2f(L.vn[i]) * nmask[i & 3];
      v[i] = z + (nbv - z) * mm[i];
    }
  }
  const float bs = L.bs0 + L.bs1;
  {
    const float4 w0 = *(const float4*)(p.rw_ln_w + c8), w1 = *(const float4*)(p.rw_ln_w + c8 + 4);
    const float4 b0 = *(const float4*)(p.rw_ln_b + c8), b1 = *(const float4*)(p.rw_ln_b + c8 + 4);
    const float lw[8] = {w0.x, w0.y, w0.z, w0.w, w1.x, w1.y, w1.z, w1.w};
    const float lb[8] = {b0.x, b0.y, b0.z, b0.w, b1.x, b1.y, b1.z, b1.w};
    float o[8];
#pragma unroll
    for (int i = 0; i < 8; ++i) o[i] = (y[i] - mu) * rs * lw[i] + lb[i] + bs * v[i];
    *(uint4*)(t1dst + (size_t)row * 512 + c8) = make_uint4(pack2(o[0], o[1]), pack2(o[2], o[3]), pack2(o[4], o[5]), pack2(o[6], o[7]));
  }
  if (lane < 32) {
    unsigned ou[4] = {0u, 0u, 0u, 0u};
    if (lane < 12) {
      const unsigned cu[4] = {L.gc.x, L.gc.y, L.gc.z, L.gc.w};
      const float4 m0 = *(const float4*)(p.rw_mu + 1600 + c8), m1 = *(const float4*)(p.rw_mu + 1600 + c8 + 4);
      const float mm[8] = {m0.x, m0.y, m0.z, m0.w, m1.x, m1.y, m1.z, m1.w};
      float gsig[8];
#pragma unroll
      for (int i = 0; i < 8; ++i) {
        const float z = (i & 1) ? bfhi(cu[i >> 1]) : bflo(cu[i >> 1]);
        const float nbv = bf2f(L.gn[i]) * nmask[i & 3];
        gsig[i] = fsig(z + (nbv - z) * mm[i]);
      }
#pragma unroll
      for (int q = 0; q < 4; ++q) ou[q] = pack2(gsig[2 * q], gsig[2 * q + 1]);
    }
    *(uint4*)(p.sg() + (size_t)row * 256 + c8) = make_uint4(ou[0], ou[1], ou[2], ou[3]);
  }
}
__device__ __forceinline__ void ph_mixprep(const P& p, int bid, int nb, u16* y1dst, u16* t1dst) {
  const int wid = tidx() >> 6, lane = tidx() & 63;
  const int stride = nb * 8;
  for (int row = bid * 8 + wid; row < NLAT; row += 2 * stride) {
    const int rowB = row + stride;
    const bool hasB = rowB < NLAT;
    MixLd LA, LB;
    float mA[4], mB[4];
    mix_load(p, row, lane, LA, mA);
    mix_load(p, hasB ? rowB : row, lane, LB, mB);
    mix_compute(p, row, lane, LA, mA, y1dst, t1dst);
    if (hasB) mix_compute(p, rowB, lane, LB, mB, y1dst, t1dst);
  }
}

__constant__ unsigned char CAND_I[52] = {0,0,0,0,0,0,0,0,0,0,0,0,0,0,0,0, 1,1,1,1,1,1,1,1, 2,2,2,2,2, 3,3,3,3, 4,4,4, 5,5, 6,6, 7,7, 8,9,10,11,12,13,14,15, 0,0};
__constant__ unsigned char CAND_J[52] = {0,1,2,3,4,5,6,7,8,9,10,11,12,13,14,15, 0,1,2,3,4,5,6,7, 0,1,2,3,4, 0,1,2,3, 0,1,2, 0,1, 0,1, 0,1, 0,0,0,0,0,0,0,0, 0,0};

#define SC_LD 144
#define KL_LD 136
__device__ __forceinline__ unsigned umax_quad(unsigned v) {
  unsigned o = (unsigned)__builtin_amdgcn_update_dpp(0, (int)v, 0xB1, 0xf, 0xf, true);
  v = v > o ? v : o;
  o = (unsigned)__builtin_amdgcn_update_dpp(0, (int)v, 0x4E, 0xf, 0xf, true);
  return v > o ? v : o;
}
__device__ __forceinline__ unsigned mono_key(float f) {
  unsigned u = __float_as_uint(f);
  return u ^ ((u >> 31) ? 0xFFFFFFFFu : 0x80000000u);
}
__device__ __forceinline__ float mono_inv(unsigned k) {
  unsigned u = (k >> 31) ? (k ^ 0x80000000u) : ~k;
  return __uint_as_float(u);
}
__device__ __forceinline__ unsigned umax3(unsigned a, unsigned b, unsigned c) {
  unsigned m = a > b ? a : b;
  return m > c ? m : c;
}
__device__ __forceinline__ void ph_route(const P& p, char* smem, int bid, int nb) {
  u16* KL = (u16*)smem;
  unsigned* SC = (unsigned*)(smem + 2 * 128 * KL_LD * 2);
  float* TS = (float*)(SC + 2 * 64 * SC_LD);
  int* TI = (int*)(TS + 2 * 64 * 16);
  const u16* Q = p.proj();
  const int tid = tidx(), wid = tid >> 6, lane = tid & 63, fr = lane & 15, fq = lane >> 4;
  int cur_h = -1;
  bf16x8 an[4];
  {
    const int h0 = bid & 7, r0 = (bid >> 3) * 64, c0 = wid >> 2, m0 = (wid & 3) * 16;
#pragma unroll
    for (int ks = 0; ks < 4; ++ks)
      an[ks] = *(const bf16x8*)(Q + (size_t)(r0 + m0 + fr) * 2048 + h0 * 256 + c0 * 128 + ks * 32 + fq * 8);
  }
  for (int item = bid; item < 1024 * 8; item += nb) {
    const int h = item & 7, row0 = (item >> 3) * 64;
    if (h != cur_h) {
      __syncthreads();
      for (int e = tid; e < 2 * 128 * 16; e += NTHREADS) {
        int r = e >> 4, kc = (e & 15) * 8;
        *(uint4*)(KL + r * KL_LD + kc) = *(const uint4*)(p.keys() + ((size_t)h * 256 + r) * 128 + kc);
      }
      cur_h = h;
      __syncthreads();
    }
    {
      const int c = wid >> 2, mrow = (wid & 3) * 16;
      f32x4 acc[8];
#pragma unroll
      for (int ni = 0; ni < 8; ++ni) acc[ni] = (f32x4){0.f, 0.f, 0.f, 0.f};
      bf16x8 a[4];
#pragma unroll
      for (int ks = 0; ks < 4; ++ks) a[ks] = an[ks];
      {
        const int nit = (item + nb < 1024 * 8) ? item + nb : item;
        const int nh = nit & 7, nr0 = (nit >> 3) * 64;
#pragma unroll
        for (int ks = 0; ks < 4; ++ks)
          an[ks] = *(const bf16x8*)(Q + (size_t)(nr0 + mrow + fr) * 2048 + nh * 256 + c * 128 + ks * 32 + fq * 8);
      }
#pragma unroll
      for (int ks = 0; ks < 4; ++ks) {
#pragma unroll
        for (int ni = 0; ni < 8; ++ni) {
          bf16x8 bfr = *(const bf16x8*)(KL + (c * 128 + ni * 16 + fr) * KL_LD + ks * 32 + fq * 8);
          acc[ni] = __builtin_amdgcn_mfma_f32_16x16x32_bf16(a[ks], bfr, acc[ni], 0, 0, 0);
        }
      }
#pragma unroll
      for (int ni = 0; ni < 8; ++ni)
#pragma unroll
        for (int j = 0; j < 4; ++j) {
          const int n = ni * 16 + fr;
          SC[(c * 64 + mrow + fq * 4 + j) * SC_LD + n] = (mono_key(acc[ni][j]) & ~127u) | (unsigned)(127 - n);
        }
    }
    __syncthreads();
    {
      const int task = tid >> 2, q4 = tid & 3;
      unsigned* rowp = SC + task * SC_LD;
      for (int r = 0; r < 16; ++r) {
        unsigned m = 0;
#pragma unroll
        for (int j = 0; j < 8; ++j) {
          uint4 v = *(const uint4*)(rowp + 16 * j + 4 * q4);
          m = umax3(m, v.x, v.y);
          m = umax3(m, v.z, v.w);
        }
        m = umax_quad(m);
        const int n = 127 - (int)(m & 127u);
        if (((n >> 2) & 3) == q4) rowp[n] = 0u;
        if (q4 == (r & 3)) {
          TS[task * 16 + r] = mono_inv(m & ~127u);
          TI[task * 16 + r] = n;
        }
      }
    }
    __syncthreads();
    if (tid < 256) {
      const int t = tid >> 2, q4 = tid & 3;
      unsigned val[13];
#pragma unroll
      for (int e = 0; e < 13; ++e) {
        const int ci = q4 + 4 * e;
        const int i = CAND_I[ci], j = CAND_J[ci];
        const float sv = TS[t * 16 + i] + TS[(64 + t) * 16 + j];
        val[e] = (ci < 50) ? ((mono_key(sv) & ~255u) | (unsigned)(255 - (i * 16 + j))) : 0u;
      }
      unsigned mine[4] = {0u, 0u, 0u, 0u};
      unsigned first = 0u;
#pragma unroll
      for (int r = 0; r < 16; ++r) {
        unsigned m = umax3(val[0], val[1], val[2]);
        m = umax3(m, val[3], val[4]);
        m = umax3(m, val[5], val[6]);
        m = umax3(m, val[7], val[8]);
        m = umax3(m, val[9], val[10]);
        m = umax3(m, val[11], val[12]);
        m = umax_quad(m);
#pragma unroll
        for (int e = 0; e < 13; ++e) val[e] = (val[e] == m) ? 0u : val[e];
        if (r == 0) first = m;
        mine[r >> 2] = (q4 == (r & 3)) ? m : mine[r >> 2];
      }
      float smax;
      {
        const int cid = 255 - (int)(first & 255u);
        smax = TS[t * 16 + (cid >> 4)] + TS[(64 + t) * 16 + (cid & 15)];
      }
      float ex[4];
      int eid[4];
      float part = 0.f;
#pragma unroll
      for (int k = 0; k < 4; ++k) {
        const int cid = 255 - (int)(mine[k] & 255u);
        const int i = cid >> 4, j = cid & 15;
        const float sv = TS[t * 16 + i] + TS[(64 + t) * 16 + j];
        ex[k] = __expf(sv - smax);
        part += ex[k];
        eid[k] = TI[t * 16 + i] * 128 + TI[(64 + t) * 16 + j];
      }
      part = dpp_add(part, 0, 0);
      part = dpp_add(part, 1, 0);
      const float rden = 1.f / part;
      const size_t obase = ((size_t)(row0 + t) * 8 + h) * 16;
#pragma unroll
      for (int k = 0; k < 4; ++k) {
        p.idx()[obase + 4 * k + q4] = eid[k];
        p.gate()[obase + 4 * k + q4] = ex[k] * rden;
      }
    }
    __syncthreads();
  }
}

typedef int v8i_t __attribute__((ext_vector_type(8)));
__device__ __forceinline__ void ph_ffn(const P& p, float* __restrict__ dst, char* smem, int bid, int nb) {
  const int wid = tidx() >> 6, lane = tidx() & 63;
  const int hh = lane >> 5, li = lane & 31, m16 = lane & 15, kg = lane >> 4;
  unsigned char* h8 = (unsigned char*)smem + wid * 1024;
  const u16* H2N = p.hn();
  for (int row = bid * 8 + wid; row < NLAT; row += nb * 8) {
    float hinv;
    {
      const uint4 a = *(const uint4*)(H2N + (size_t)row * 1024 + lane * 16), b2 = *(const uint4*)(H2N + (size_t)row * 1024 + lane * 16 + 8);
      const unsigned au[8] = {a.x, a.y, a.z, a.w, b2.x, b2.y, b2.z, b2.w};
      float hv[16];
      float am = 0.f;
#pragma unroll
      for (int q = 0; q < 8; ++q) { hv[2 * q] = bflo(au[q]); hv[2 * q + 1] = bfhi(au[q]); am = fmaxf(am, fmaxf(fabsf(hv[2 * q]), fabsf(hv[2 * q + 1]))); }
#pragma unroll
      for (int m = 32; m >= 1; m >>= 1) am = fmaxf(am, __shfl_xor(am, m, 64));
      const float scl = am > 0.f ? 448.f / am : 1.f;
      hinv = am > 0.f ? am * (1.f / 448.f) : 1.f;
      unsigned o[4];
#pragma unroll
      for (int q = 0; q < 4; ++q) {
        int w = 0;
        w = __builtin_amdgcn_cvt_pk_fp8_f32(hv[4 * q] * scl, hv[4 * q + 1] * scl, w, false);
        w = __builtin_amdgcn_cvt_pk_fp8_f32(hv[4 * q + 2] * scl, hv[4 * q + 3] * scl, w, true);
        o[q] = (unsigned)w;
      }
      *(uint4*)(h8 + lane * 16) = make_uint4(o[0], o[1], o[2], o[3]);
    }
    v8i_t hb[8];
#pragma unroll
    for (int s2 = 0; s2 < 8; ++s2) {
      const uint4 x0 = *(const uint4*)(h8 + 128 * s2 + 16 * kg), x1 = *(const uint4*)(h8 + 128 * s2 + 64 + 16 * kg);
      hb[s2] = (v8i_t){(int)x0.x, (int)x0.y, (int)x0.z, (int)x0.w, (int)x1.x, (int)x1.y, (int)x1.z, (int)x1.w};
    }
    const int id0 = p.idx()[(size_t)row * 128 + lane], id1 = p.idx()[(size_t)row * 128 + 64 + lane];
    const float us0 = p.usc()[id0] * hinv, us1 = p.usc()[id1] * hinv;
    const float gv0 = p.gate()[(size_t)row * 128 + lane] * p.vsc()[id0], gv1 = p.gate()[(size_t)row * 128 + 64 + lane] * p.vsc()[id1];
    float oacc[32];
#pragma unroll
    for (int i = 0; i < 32; ++i) oacc[i] = 0.f;
#pragma unroll 1
    for (int bb = 0; bb < 8; ++bb) {
      const bool hf = bb >= 4;
      const int e0 = (bb & 3) * 16;
      const int idv = hf ? id1 : id0;
      const float usv = hf ? us1 : us0, gvv = hf ? gv1 : gv0;
      const int idm = __shfl(idv, e0 + m16, 64);
      uint4 ua[8];
#pragma unroll
      for (int s2 = 0; s2 < 8; ++s2) ua[s2] = *(const uint4*)(p.utab() + (size_t)idm * 1024 + 64 * s2 + 16 * kg);
      uint4 vr[8];
#pragma unroll
      for (int q = 0; q < 8; ++q) {
        const int ia = __builtin_amdgcn_readlane(idv, e0 + 2 * q), ib = __builtin_amdgcn_readlane(idv, e0 + 2 * q + 1);
        const int id = hh ? ib : ia;
        vr[q] = *(const uint4*)(p.utab() + (size_t)id * 1024 + 512 + li * 16);
      }
      f32x4 D = (f32x4){0.f, 0.f, 0.f, 0.f};
#pragma unroll
      for (int s2 = 0; s2 < 8; ++s2) {
        const v8i_t av = (v8i_t){(int)ua[s2].x, (int)ua[s2].y, (int)ua[s2].z, (int)ua[s2].w, 0, 0, 0, 0};
        D = __builtin_amdgcn_mfma_scale_f32_16x16x128_f8f6f4(av, hb[s2], D, 4  , 0  , 0, 0x7f7f7f7f, 0, 0x7f7f7f7f);
      }
      const int nn = m16 & 3;
      const float dotv = nn == 0 ? D[0] : (nn == 1 ? D[1] : (nn == 2 ? D[2] : D[3]));
      const int esrc = e0 + 4 * kg + nn;
      const float usx = __shfl(usv, esrc, 64), gvx = __shfl(gvv, esrc, 64);
      const float cfl = gvx * gelu_as(dotv * usx);
#pragma unroll
      for (int q = 0; q < 8; ++q) {
        int one_s;
        asm volatile("s_mov_b32 %0, 1" : "=s"(one_s));
        if (one_s == 0) continue;
        const int ma = 2 * q, mb = 2 * q + 1;
        const float cfa = __int_as_float(__builtin_amdgcn_readlane(__float_as_int(cfl), 16 * (ma >> 2) + (ma & 3)));
        const float cfb = __int_as_float(__builtin_amdgcn_readlane(__float_as_int(cfl), 16 * (mb >> 2) + (mb & 3)));
        const float cf = hh ? cfb : cfa;
        const unsigned vv[4] = {vr[q].x, vr[q].y, vr[q].z, vr[q].w};
#pragma unroll
        for (int k = 0; k < 4; ++k) {
          v2f p0 = __builtin_amdgcn_cvt_scalef32_pk_f32_fp4(vv[k], 1.0f, 0), p1 = __builtin_amdgcn_cvt_scalef32_pk_f32_fp4(vv[k], 1.0f, 1);
          v2f p2 = __builtin_amdgcn_cvt_scalef32_pk_f32_fp4(vv[k], 1.0f, 2), p3 = __builtin_amdgcn_cvt_scalef32_pk_f32_fp4(vv[k], 1.0f, 3);
          oacc[8 * k] += cf * p0[0]; oacc[8 * k + 1] += cf * p0[1];
          oacc[8 * k + 2] += cf * p1[0]; oacc[8 * k + 3] += cf * p1[1];
          oacc[8 * k + 4] += cf * p2[0]; oacc[8 * k + 5] += cf * p2[1];
          oacc[8 * k + 6] += cf * p3[0]; oacc[8 * k + 7] += cf * p3[1];
        }
      }
    }
    float mine[16];
#pragma unroll
    for (int i = 0; i < 16; ++i) {
      const float give = hh ? oacc[i] : oacc[16 + i];
      const float got = __shfl_xor(give, 32, 64);
      mine[i] = (hh ? oacc[16 + i] : oacc[i]) + got;
    }
    const int b = row >> 11;
    const int colb = li * 32 + hh * 16;
    float h3[16];
    float ss = 0.f;
#pragma unroll
    for (int q = 0; q < 4; ++q) {
      const int col = colb + q * 4;
      float4 a0 = *(const float4*)(p.out + (size_t)row * 1024 + col);
      float4 q0 = *(const float4*)(p.mod() + b * 6144 + 5 * 1024 + col);
      h3[q * 4 + 0] = a0.x + q0.x * mine[q * 4 + 0];
      h3[q * 4 + 1] = a0.y + q0.y * mine[q * 4 + 1];
      h3[q * 4 + 2] = a0.z + q0.z * mine[q * 4 + 2];
      h3[q * 4 + 3] = a0.w + q0.w * mine[q * 4 + 3];
      ss += h3[q * 4] * h3[q * 4] + h3[q * 4 + 1] * h3[q * 4 + 1] + h3[q * 4 + 2] * h3[q * 4 + 2] + h3[q * 4 + 3] * h3[q * 4 + 3];
    }
    ss = wave_sum_u(ss);
    const float rstd = rsqrtf(ss * (1.f / 1024.f) + 1e-6f);
#pragma unroll
    for (int q = 0; q < 4; ++q) {
      const int col = colb + q * 4;
      float4 n0 = *(const float4*)(p.norm_f_g + col);
      *(float4*)(dst + (size_t)row * 1024 + col) =
          make_float4(h3[q * 4] * rstd * n0.x, h3[q * 4 + 1] * rstd * n0.y, h3[q * 4 + 2] * rstd * n0.z, h3[q * 4 + 3] * rstd * n0.w);
    }
  }
}

#define XB_TMO      128
#define XB_XCNT(j)  (256  + 64 * (j))
#define XB_XSUB(j)  (1280 + 64 * (j))
#define XB_XGEN(j)  (2304 + 64 * (j))
#define XB_TOP      3328
#define XB_TOPGEN   3392
#define XCD_BAR_WORDS 3456
#define XB_SPIN_CAP (1u << 18)
#define LAS __attribute__((address_space(3)))

__device__ __forceinline__ unsigned xb_ld(unsigned* p)              { return __hip_atomic_load(p, __ATOMIC_RELAXED, __HIP_MEMORY_SCOPE_AGENT); }
__device__ __forceinline__ unsigned xb_add(unsigned* p, unsigned v) { return __hip_atomic_fetch_add(p, v, __ATOMIC_RELAXED, __HIP_MEMORY_SCOPE_AGENT); }
__device__ __forceinline__ unsigned xb_xcc_id() { return (unsigned)__builtin_amdgcn_s_getreg((3 << 11) | 20) & 0xFu; }
#define XB_SPIN(cond, bar) do { unsigned _sp = 0; while (cond) { __builtin_amdgcn_s_sleep(1); \
    if ((++_sp & 255u) == 0u) { if (xb_ld(&(bar)[XB_TMO])) break; if (_sp > XB_SPIN_CAP) { atomicAdd(&(bar)[XB_TMO], 1u); break; } } } } while (0)

struct XcdBarrier {
    unsigned* bar; unsigned x;
    volatile LAS unsigned* st;
};

__device__ __forceinline__ XcdBarrier xcd_barrier_post(unsigned* bar, volatile LAS unsigned* st) {
    XcdBarrier b; b.bar = bar; b.x = xb_xcc_id(); b.st = st;
    if (tidx() == 0) (void)xb_add(&bar[XB_XCNT(b.x)], 1u);
    return b;
}
__device__ __forceinline__ void xcd_barrier_complete(unsigned* bar, unsigned x, unsigned& nloc, unsigned& nx) {
    const unsigned G = gridDim.x * gridDim.y * gridDim.z;
    unsigned sum, cnt, mine, sp = 0u;
    for (;;) {
        sum = 0u; cnt = 0u; mine = 0u;
#pragma unroll
        for (unsigned j = 0; j < 16; ++j) { const unsigned c = xb_ld(&bar[XB_XCNT(j)]); sum += c; cnt += (c > 0u) ? 1u : 0u; mine = (j == x) ? c : mine; }
        if (sum == G) break;
        __builtin_amdgcn_s_sleep(1);
        if ((++sp & 255u) == 0u) { if (xb_ld(&bar[XB_TMO])) break; if (sp > XB_SPIN_CAP) { atomicAdd(&bar[XB_TMO], 1u); break; } }
    }
    nloc = mine > 0u ? mine : 1u; nx = cnt > 0u ? cnt : 1u;
}

__device__ __forceinline__ void xcd_barrier(const XcdBarrier& b) {
    asm volatile("s_waitcnt vmcnt(0)" ::: "memory");
    __syncthreads();
    if (tidx() == 0) {
        unsigned* bar = b.bar;
        __builtin_amdgcn_s_waitcnt(0);
        unsigned nloc = b.st[0], nx = b.st[1];
        if (nloc == 0u) { xcd_barrier_complete(bar, b.x, nloc, nx); b.st[0] = nloc; b.st[1] = nx; }
        const unsigned old = xb_add(&bar[XB_XSUB(b.x)], 1u);
        const unsigned gen = old / nloc;
        if (old + 1u == (gen + 1u) * nloc) {
            __builtin_amdgcn_fence(__ATOMIC_RELEASE, "agent");
            asm volatile("s_waitcnt vmcnt(0)" ::: "memory");
            const unsigned og = xb_add(&bar[XB_TOP], 1u);
            const unsigned tg = og / nx;
            if (og + 1u == (tg + 1u) * nx) xb_add(&bar[XB_TOPGEN], 1u);
            else XB_SPIN(xb_ld(&bar[XB_TOPGEN]) == tg, bar);
            __builtin_amdgcn_fence(__ATOMIC_ACQUIRE, "agent");
            xb_add(&bar[XB_XGEN(b.x)], 1u);
            asm volatile("s_waitcnt vmcnt(0)" ::: "memory");
        } else {
            XB_SPIN(xb_ld(&bar[XB_XGEN(b.x)]) == gen, bar);
            __builtin_amdgcn_fence(__ATOMIC_ACQUIRE, "agent");
            asm volatile("s_waitcnt vmcnt(0)" ::: "memory");
        }
    }
    __syncthreads();
}

typedef const __attribute__((address_space(4))) P* kargP_t;
__device__ __forceinline__ P load_params() {
  kargP_t q = (kargP_t)__builtin_amdgcn_kernarg_segment_ptr();
  asm volatile("" : "+s"(q));
  P r;
  r.x = q->x;
  r.c = q->c;
  r.ctx = q->ctx;
  r.c_ctx = q->c_ctx;
  r.w_ada = q->w_ada;
  r.b_ada = q->b_ada;
  r.norm1_g = q->norm1_g;
  r.norm2_g = q->norm2_g;
  r.w_in = q->w_in;
  r.s5_a_re = q->s5_a_re;
  r.s5_a_im = q->s5_a_im;
  r.s5_log_dt = q->s5_log_dt;
  r.s5_b_re = q->s5_b_re;
  r.s5_b_im = q->s5_b_im;
  r.s5_c_re = q->s5_c_re;
  r.s5_c_im = q->s5_c_im;
  r.s5_d = q->s5_d;
  r.s5_w_glu = q->s5_w_glu;
  r.s5_b_glu = q->s5_b_glu;
  r.rw_mu = q->rw_mu;
  r.rw_w0 = q->rw_w0;
  r.rw_w_w2 = q->rw_w_w2;
  r.rw_a0 = q->rw_a0;
  r.rw_w_a2 = q->rw_w_a2;
  r.rw_w_g2 = q->rw_w_g2;
  r.rw_k_k = q->rw_k_k;
  r.rw_k_a = q->rw_k_a;
  r.rw_r_k = q->rw_r_k;
  r.rw_ln_w = q->rw_ln_w;
  r.rw_ln_b = q->rw_ln_b;
  r.w_out = q->w_out;
  r.peer_w_q = q->peer_w_q;
  r.peer_keys = q->peer_keys;
  r.peer_u = q->peer_u;
  r.peer_v = q->peer_v;
  r.norm_f_g = q->norm_f_g;
  r.out = q->out;
  r.ws = q->ws;
  return r;
}
#define NPHASES 11
template <int PH>
__device__ __forceinline__ void run_phase(const P& p, char* smem, int bid, int nb, bool rep = false) {
  if (PH == 0) ph_prep(p, smem, bid, nb);
  if (PH == 1) ph_norm(p, 0, bid, nb);
  if (PH == 2) {
    pg8::StaticOrder S; S.init(NTOK, INCP, nb, bid);
    pg8::gemm_phase<pg8::EpiProjT, pg8::StaticOrder, false>((PG8_LAS unsigned char*)smem, pg8::Gemm{p.hn(), p.win_t(), NTOK, INCP, 1024}, S, pg8::EpiProjT{p.proj(), INC, INC}, nullptr);
  }
  if (PH == 3) { ph_s5scan2(p, smem, bid, nb); ph_rwscan2(p, smem, bid, nb); }
  if (PH == 4) ph_mixprep(p, bid, nb, rep ? p.hn() : p.ys5f(), rep ? p.hn() + (size_t)NLAT * 512 : p.yrwf());
  if (PH == 5) {
    {
      pg8::StaticOrder S; S.init(NLAT, 512, nb, bid);
      pg8::gemm_phase<pg8::EpiGluT, pg8::StaticOrder, false>((PG8_LAS unsigned char*)smem, pg8::Gemm{p.ys5f(), p.wglu_t(), NLAT, 512, 512}, S, pg8::EpiGluT{p.ys5f(), p.s5_b_glu, p.hn()}, nullptr);
    }
    {
      pg8::StaticOrder S; S.init(NLAT, 512, nb, bid);
      pg8::gemm_phase<pg8::EpiGateT, pg8::StaticOrder, false>((PG8_LAS unsigned char*)smem, pg8::Gemm{p.sg(), p.wg2_t(), NLAT, 512, 256}, S, pg8::EpiGateT{p.yrwf(), p.hn()}, nullptr);
    }
  }
  if (PH == 6) {
    pg8::StaticOrder S; S.init(NLAT, 1024, nb, bid);
    pg8::gemm_phase<pg8::EpiWoutT, pg8::StaticOrder, false>((PG8_LAS unsigned char*)smem, pg8::Gemm{p.hn(), p.wout_t(), NLAT, 1024, 1024}, S, pg8::EpiWoutT{p.x, p.mod(), p.out}, nullptr);
  }
  if (PH == 7) ph_norm(p, 1, bid, nb);
  if (PH == 8) {
    pg8::StaticOrder S; S.init(NLAT, 2048, nb, bid);
    pg8::gemm_phase<pg8::EpiProjT, pg8::StaticOrder, false>((PG8_LAS unsigned char*)smem, pg8::Gemm{p.hn(), p.wq_t(), NLAT, 2048, 1024}, S, pg8::EpiProjT{p.proj(), 2048, 2048}, nullptr);
  }
  if (PH == 9) ph_route(p, smem, bid, nb);
  if (PH == 10) ph_ffn(p, rep ? (float*)p.proj() : p.out, smem, bid, nb);
  if (PH == 11) ph_s5scan2(p, smem, bid, nb);
  if (PH == 12) ph_rwscan2(p, smem, bid, nb);
}
#ifndef REPMASK
#define REPMASK 0
#endif
#define REP(n) ((REPMASK >> (n)) & 1)
#define PHASE(n) if (ph_lo <= n && n < ph_hi) { if (n > ph_lo) { if (n == 1) grid.sync(); else xcd_barrier(xb); } if (REP(n)) { { const P lp_ = load_params(); run_phase<n>(lp_, smem, bid, nb, true); } __syncthreads(); } if (n == 3 && REP(11)) { run_phase<11>(p, smem, bid, nb); __syncthreads(); } if (n == 3 && REP(12)) { run_phase<12>(p, smem, bid, nb); __syncthreads(); } { const P lp_ = load_params(); run_phase<n>(lp_, smem, bid, nb); } }
__global__ void __launch_bounds__(NTHREADS) mega(P p, int ph_lo, int ph_hi) {
  char* smem = g_smem;
  if ((threadIdx.x & 63) == 0) *(int*)(g_smem + WAVETAB_OFF + 4 * hw_slot()) = (int)(threadIdx.x >> 6);
  cg::grid_group grid = cg::this_grid();
  const int bid = blockIdx.x, nb = gridDim.x;
  volatile LAS unsigned* xst = (volatile LAS unsigned*)(smem + LDS_BYTES - 16);
  if (threadIdx.x == 0) { xst[0] = 0u; xst[1] = 0u; }
  __syncthreads();
  XcdBarrier xb;
  {
    const P lp0 = load_params();
    xb.bar = lp0.bar(); xb.x = 0; xb.st = xst;
    if (ph_hi - ph_lo > 1) xb = xcd_barrier_post(lp0.bar(), xst);
  }
  PHASE(0) PHASE(1) PHASE(2) PHASE(3) PHASE(4) PHASE(5) PHASE(6) PHASE(7) PHASE(8) PHASE(9) PHASE(10)
}

extern "C" void kernel_launch(void* const* d_in, const int* in_sizes, int n_in, void* d_out, int out_size, void* d_ws,
                              size_t ws_size, hipStream_t stream) {
  static int grid_blocks = 0;
  if (!grid_blocks) {
    int dev = 0, cus = 0, per_cu = 0;
    hipGetDevice(&dev);
    hipDeviceGetAttribute(&cus, hipDeviceAttributeMultiprocessorCount, dev);
    hipFuncSetAttribute((const void*)mega, hipFuncAttributeMaxDynamicSharedMemorySize, LDS_BYTES);
    hipOccupancyMaxActiveBlocksPerMultiprocessor(&per_cu, (const void*)mega, NTHREADS, LDS_BYTES);
    if (per_cu < 1) { fprintf(stderr, "occupancy query returned %d\n", per_cu); per_cu = 1; }
    grid_blocks = cus;
  }
  P p{};
  const float** fp = (const float**)&p;
  for (int i = 0; i < 36; ++i) fp[i] = (const float*)d_in[i];
  p.out = (float*)d_out;
  p.ws = (char*)d_ws;
  if (WS_TOTAL > ws_size) { fprintf(stderr, "workspace too small: need %zu have %zu\n", (size_t)WS_TOTAL, ws_size); return; }
#if MEGA
  if (hipMemsetAsync((char*)d_ws + OFF_bar, 0, XCD_BAR_WORDS * 4, stream) != hipSuccess) fprintf(stderr, "memset of barrier words failed\n");
  int lo = 0, hi = NPHASES;
  void* args[] = {&p, &lo, &hi};
  hipError_t e = hipLaunchCooperativeKernel((const void*)mega, dim3(grid_blocks), dim3(NTHREADS), args, LDS_BYTES, stream);
  if (e != hipSuccess) fprintf(stderr, "cooperative launch failed: %s (grid %d)\n", hipGetErrorString(e), grid_blocks);
#else
  for (int ph = 0; ph < NPHASES; ++ph) {
    hipLaunchKernelGGL(mega, dim3(grid_blocks), dim3(NTHREADS), LDS_BYTES, stream, p, ph, ph + 1);
  }
#endif
}
```

```cpp
#include <hip/hip_runtime.h>
#include <hip/hip_cooperative_groups.h>
#include <stdint.h>
#include <stdio.h>
namespace cg = cooperative_groups;

#ifndef MEGA
#define MEGA 1
#endif

typedef unsigned short u16;
using bf16x8 = __attribute__((ext_vector_type(8))) short;
using f32x4 = __attribute__((ext_vector_type(4))) float;
using u32x4 = __attribute__((ext_vector_type(4))) unsigned;
using f32x16 = __attribute__((ext_vector_type(16))) float;

#define DM 1024
#define NLAT 65536
#define NCTX 8192
#define NTOK 73728
#define INC 2208
#define INCP 2304
#define NTHREADS 512
#define LDS_BYTES 163840

#define INC_FWD 1
constexpr size_t ws_al(size_t x) { return (x + 255) & ~(size_t)255; }
constexpr size_t OFF_mod = 0;
constexpr size_t OFF_win_t = OFF_mod + ws_al(33 * 6144 * 4);
constexpr size_t OFF_wout_t = OFF_win_t + ws_al((size_t)2304 * 1024 * 2);
constexpr size_t OFF_wq_t = OFF_wout_t + ws_al((size_t)1024 * 1024 * 2);
constexpr size_t OFF_wglu_t = OFF_wq_t + ws_al((size_t)2048 * 1024 * 2);
constexpr size_t OFF_wg2_t = OFF_wglu_t + ws_al((size_t)512 * 512 * 2);
constexpr size_t OFF_keys = OFF_wg2_t + ws_al((size_t)512 * 256 * 2);
constexpr size_t OFF_utab = OFF_keys + ws_al((size_t)8 * 2 * 128 * 128 * 2);
constexpr size_t OFF_usc = OFF_utab + ws_al((size_t)16384 * 1024);
constexpr size_t OFF_vsc = OFF_usc + ws_al(16384 * 4);
constexpr size_t OFF_s5ab = OFF_vsc + ws_al(16384 * 4);
constexpr size_t OFF_s5bb = OFF_s5ab + ws_al(4096 * 2 * 4);
constexpr size_t OFF_s5ct = OFF_s5bb + ws_al(4096 * 32 * 4);
constexpr size_t OFF_hn = OFF_s5ct + ws_al(2 * 32 * 16 * 128 * 2);
constexpr size_t OFF_proj = OFF_hn + ws_al((size_t)73728 * 1024 * 2);
constexpr size_t OFF_ys5f = OFF_proj + ws_al((size_t)73728 * 2208 * 2);
constexpr size_t OFF_ys5b = OFF_ys5f + ws_al((size_t)65536 * 512 * 2);
constexpr size_t OFF_yrwf = OFF_ys5b + ws_al((size_t)65536 * 512 * 2);
constexpr size_t OFF_yrwb = OFF_yrwf + ws_al((size_t)65536 * 512 * 2);
constexpr size_t OFF_bsc = OFF_yrwb + ws_al((size_t)65536 * 512 * 2);
constexpr size_t OFF_sg = OFF_bsc + ws_al((size_t)2 * 65536 * 8 * 4);
constexpr size_t OFF_bar = OFF_sg + ws_al((size_t)65536 * 256 * 2);
constexpr size_t OFF_wlf = OFF_bar + ws_al(3456 * 4);
constexpr size_t WS_TOTAL = OFF_wlf + ws_al(2 * 4096 * 16);

extern __shared__ __attribute__((aligned(16))) char g_smem[];
#define WAVETAB_OFF (LDS_BYTES - 16 - 256)
__device__ __forceinline__ int hw_slot() { return (int)(__builtin_amdgcn_s_getreg((5 << 11) | 4) & 63u); }
__device__ __forceinline__ int tidx() {
  const int w = *(const int*)(g_smem + WAVETAB_OFF + 4 * hw_slot());
  return __builtin_amdgcn_readfirstlane(w) * 64 + (int)__builtin_amdgcn_mbcnt_hi(~0u, __builtin_amdgcn_mbcnt_lo(~0u, 0u));
}
struct P {
  const float *x, *c, *ctx, *c_ctx, *w_ada, *b_ada, *norm1_g, *norm2_g, *w_in, *s5_a_re, *s5_a_im, *s5_log_dt,
      *s5_b_re, *s5_b_im, *s5_c_re, *s5_c_im, *s5_d, *s5_w_glu, *s5_b_glu, *rw_mu, *rw_w0, *rw_w_w2, *rw_a0, *rw_w_a2,
      *rw_w_g2, *rw_k_k, *rw_k_a, *rw_r_k, *rw_ln_w, *rw_ln_b, *w_out, *peer_w_q, *peer_keys, *peer_u, *peer_v, *norm_f_g;
  float* out;
  char* ws;
  __device__ __forceinline__ float* mod() const { return (float*)(ws + OFF_mod); }
  __device__ __forceinline__ u16* win_t() const { return (u16*)(ws + OFF_win_t); }
  __device__ __forceinline__ u16* wout_t() const { return (u16*)(ws + OFF_wout_t); }
  __device__ __forceinline__ u16* wq_t() const { return (u16*)(ws + OFF_wq_t); }
  __device__ __forceinline__ u16* wglu_t() const { return (u16*)(ws + OFF_wglu_t); }
  __device__ __forceinline__ u16* wg2_t() const { return (u16*)(ws + OFF_wg2_t); }
  __device__ __forceinline__ u16* keys() const { return (u16*)(ws + OFF_keys); }
  __device__ __forceinline__ unsigned char* utab() const { return (unsigned char*)(ws + OFF_utab); }
  __device__ __forceinline__ float* usc() const { return (float*)(ws + OFF_usc); }
  __device__ __forceinline__ float* vsc() const { return (float*)(ws + OFF_vsc); }
  __device__ __forceinline__ float* s5ab() const { return (float*)(ws + OFF_s5ab); }
  __device__ __forceinline__ float* s5bb() const { return (float*)(ws + OFF_s5bb); }
  __device__ __forceinline__ u16* s5ct() const { return (u16*)(ws + OFF_s5ct); }
  __device__ __forceinline__ u16* hn() const { return (u16*)(ws + OFF_hn); }
  __device__ __forceinline__ u16* proj() const { return (u16*)(ws + OFF_proj); }
  __device__ __forceinline__ u16* ys5f() const { return (u16*)(ws + OFF_ys5f); }
  __device__ __forceinline__ u16* ys5b() const { return (u16*)(ws + OFF_ys5b); }
  __device__ __forceinline__ u16* yrwf() const { return (u16*)(ws + OFF_yrwf); }
  __device__ __forceinline__ u16* yrwb() const { return (u16*)(ws + OFF_yrwb); }
  __device__ __forceinline__ float* bsc() const { return (float*)(ws + OFF_bsc); }
  __device__ __forceinline__ u16* sg() const { return (u16*)(ws + OFF_sg); }
  __device__ __forceinline__ unsigned* bar() const { return (unsigned*)(ws + OFF_bar); }
  __device__ __forceinline__ u16* wlf() const { return (u16*)(ws + OFF_wlf); }
  __device__ __forceinline__ unsigned char* vtab() const { return utab() + 512; }
  __device__ __forceinline__ int* idx() const { return (int*)ys5b(); }
  __device__ __forceinline__ float* gate() const { return (float*)yrwb(); }
};

typedef float f32x2_t __attribute__((ext_vector_type(2)));
typedef __bf16 bf16x2_t __attribute__((ext_vector_type(2)));
__device__ __forceinline__ unsigned pack2(float a, float b) {
  f32x2_t v = {a, b};
  return __builtin_bit_cast(unsigned, __builtin_convertvector(v, bf16x2_t));
}
__device__ __forceinline__ u16 f2bf(float f) { return __builtin_bit_cast(u16, (__bf16)f); }
__device__ __forceinline__ float bf2f(u16 h) { return __uint_as_float(((unsigned)h) << 16); }
__device__ __forceinline__ float bflo(unsigned u) { return __uint_as_float(u << 16); }
__device__ __forceinline__ float bfhi(unsigned u) { return __uint_as_float(u & 0xffff0000u); }
__device__ __forceinline__ float wave_sum(float v) {
#pragma unroll
  for (int m = 32; m >= 1; m >>= 1) v += __shfl_xor(v, m, 64);
  return v;
}
__device__ __forceinline__ float gelu_exact(float x) { return 0.5f * x * (1.f + erff(x * 0.70710678118654752f)); }
__device__ __forceinline__ float gelu_as(float v) {
  const float av = fabsf(v), t = __builtin_amdgcn_rcpf(av * 0.2316418882f + 1.0f);
  float q = t * 0.5307027145f + (-0.7265760135f);
  q = q * t + 0.7107068705f; q = q * t + (-0.142248368f); q = q * t + 0.127414796f; q = q * t;
  const float e = __builtin_amdgcn_exp2f((v * v) * (-0.72134752044f));
  const float m = v * (q * e);
  return v < 0.f ? m : v - m;
}
__device__ __forceinline__ float sigmoidf(float x) { return 1.f / (1.f + __expf(-x)); }


typedef float v2f __attribute__((ext_vector_type(2)));
__device__ __forceinline__ float dpp_add(float v, const int ctrl, const int rmask) {
  int m;
  switch (ctrl) {
    case 0: m = __builtin_amdgcn_update_dpp(0, __float_as_int(v), 0xB1, 0xf, 0xf, true); break;
    case 1: m = __builtin_amdgcn_update_dpp(0, __float_as_int(v), 0x4E, 0xf, 0xf, true); break;
    case 2: m = __builtin_amdgcn_update_dpp(0, __float_as_int(v), 0x141, 0xf, 0xf, true); break;
    case 3: m = __builtin_amdgcn_update_dpp(0, __float_as_int(v), 0x140, 0xf, 0xf, true); break;
    case 4: m = __builtin_amdgcn_update_dpp(0, __float_as_int(v), 0x142, 0xa, 0xf, false); break;
    default: m = __builtin_amdgcn_update_dpp(0, __float_as_int(v), 0x143, 0xc, 0xf, false); break;
  }
  return v + __int_as_float(m);
}
__device__ __forceinline__ float wave_sum_u(float v) {
  v = dpp_add(v, 0, 0); v = dpp_add(v, 1, 0); v = dpp_add(v, 2, 0); v = dpp_add(v, 3, 0);
  v = dpp_add(v, 4, 0); v = dpp_add(v, 5, 0);
  return __int_as_float(__builtin_amdgcn_readlane(__float_as_int(v), 63));
}
__device__ __forceinline__ void convert_fp4_rows(const float* __restrict__ src, unsigned char* __restrict__ dst, float* __restrict__ sc,
                                                 int nrows, int bid, int nb) {
  const int wid = tidx() >> 6, lane = tidx() & 63;
  const int stride = nb * 8;
  for (int row0 = bid * 8 + wid; row0 < nrows; row0 += 4 * stride) {
    float4 v[4][4];
#pragma unroll
    for (int u = 0; u < 4; ++u) {
      int row = row0 + u * stride;
      if (row >= nrows) row = row0;
#pragma unroll
      for (int q = 0; q < 4; ++q) v[u][q] = *(const float4*)(src + (size_t)row * 1024 + lane * 16 + q * 4);
    }
#pragma unroll
    for (int u = 0; u < 4; ++u) {
      const int row = row0 + u * stride;
      if (row >= nrows) continue;
      float am = 0.f;
#pragma unroll
      for (int q = 0; q < 4; ++q)
        am = fmaxf(am, fmaxf(fmaxf(fabsf(v[u][q].x), fabsf(v[u][q].y)), fmaxf(fabsf(v[u][q].z), fabsf(v[u][q].w))));
#pragma unroll
      for (int m = 32; m >= 1; m >>= 1) am = fmaxf(am, __shfl_xor(am, m, 64));
      const float scl = am > 0.f ? 6.f / am : 1.f;
      unsigned w0 = 0u, w1 = 0u;
      w0 = __builtin_amdgcn_cvt_scalef32_pk_fp4_f32(w0, v[u][0].x * scl, v[u][0].y * scl, 1.0f, 0);
      w0 = __builtin_amdgcn_cvt_scalef32_pk_fp4_f32(w0, v[u][0].z * scl, v[u][0].w * scl, 1.0f, 1);
      w0 = __builtin_amdgcn_cvt_scalef32_pk_fp4_f32(w0, v[u][1].x * scl, v[u][1].y * scl, 1.0f, 2);
      w0 = __builtin_amdgcn_cvt_scalef32_pk_fp4_f32(w0, v[u][1].z * scl, v[u][1].w * scl, 1.0f, 3);
      w1 = __builtin_amdgcn_cvt_scalef32_pk_fp4_f32(w1, v[u][2].x * scl, v[u][2].y * scl, 1.0f, 0);
      w1 = __builtin_amdgcn_cvt_scalef32_pk_fp4_f32(w1, v[u][2].z * scl, v[u][2].w * scl, 1.0f, 1);
      w1 = __builtin_amdgcn_cvt_scalef32_pk_fp4_f32(w1, v[u][3].x * scl, v[u][3].y * scl, 1.0f, 2);
      w1 = __builtin_amdgcn_cvt_scalef32_pk_fp4_f32(w1, v[u][3].z * scl, v[u][3].w * scl, 1.0f, 3);
      *(uint2*)(dst + (size_t)row * 1024 + lane * 8) = make_uint2(w0, w1);
      if (lane == 0) sc[row] = am > 0.f ? am / 6.f : 1.f;
    }
  }
}

__device__ __forceinline__ void transpose_tiles(const float* __restrict__ src, int K, int N, u16* __restrict__ dst, int Kd, int Npad,
                                char* smem, int bid, int nb) {
  float* tile = (float*)smem;
  const int tid = tidx();
  const int nkt = Kd / 64, nnt = Npad / 64;
  for (int t = bid; t < nkt * nnt; t += nb) {
    int kt = t % nkt, nt = t / nkt;
    int k0 = kt * 64, n0 = nt * 64;
    __syncthreads();
#pragma unroll
    for (int it = 0; it < 8; ++it) {
      int i = (tid >> 6) + it * 8, j = tid & 63;
      int k = k0 + i, n = n0 + j;
      tile[i * 65 + j] = (k < K && n < N) ? src[(size_t)k * N + n] : 0.f;
    }
    __syncthreads();
    int n = tid >> 3, kc = (tid & 7) * 8;
    uint4 o;
    o.x = pack2(tile[(kc + 0) * 65 + n], tile[(kc + 1) * 65 + n]);
    o.y = pack2(tile[(kc + 2) * 65 + n], tile[(kc + 3) * 65 + n]);
    o.z = pack2(tile[(kc + 4) * 65 + n], tile[(kc + 5) * 65 + n]);
    o.w = pack2(tile[(kc + 6) * 65 + n], tile[(kc + 7) * 65 + n]);
    *(uint4*)(dst + (size_t)(n0 + n) * Kd + k0 + kc) = o;
  }
}

__device__ __forceinline__ void convert_bf16(const float* __restrict__ src, u16* __restrict__ dst, size_t n8, int bid, int nb) {
  for (size_t i = (size_t)bid * NTHREADS + tidx(); i < n8; i += (size_t)nb * NTHREADS) {
    float4 a = *(const float4*)(src + i * 8), b = *(const float4*)(src + i * 8 + 4);
    uint4 o;
    o.x = pack2(a.x, a.y); o.y = pack2(a.z, a.w); o.z = pack2(b.x, b.y); o.w = pack2(b.z, b.w);
    *(uint4*)(dst + i * 8) = o;
  }
}

__device__ __forceinline__ void ph_prep(const P& p, char* smem, int bid, int nb) {
  const int tid = tidx();
  {
    float* sc = (float*)smem;
    float* red = (float*)(smem + 33 * 256 * 4);
    for (int item = bid; item < 192; item += nb) {
      const int j0 = item * 32, kg = tid >> 5, col = tid & 31;
      float acc[33];
#pragma unroll
      for (int b = 0; b < 33; ++b) acc[b] = 0.f;
      for (int ch = 0; ch < 4; ++ch) {
        __syncthreads();
        for (int e = tid; e < 33 * 256; e += NTHREADS) {
          int b = e >> 8, kk = e & 255;
          float cv = (b < 32) ? p.c[b * 1024 + ch * 256 + kk] : p.c_ctx[ch * 256 + kk];
          sc[e] = cv / (1.f + expf(-cv));
        }
        float w[16];
#pragma unroll
        for (int i = 0; i < 16; ++i) w[i] = p.w_ada[(size_t)(ch * 256 + kg * 16 + i) * 6144 + j0 + col];
        __syncthreads();
#pragma unroll
        for (int i = 0; i < 16; ++i) {
          const int kk = kg * 16 + i;
#pragma unroll
          for (int b = 0; b < 33; ++b) acc[b] += sc[b * 256 + kk] * w[i];
        }
      }
#pragma unroll
      for (int b = 0; b < 33; ++b) red[(kg * 33 + b) * 32 + col] = acc[b];
      __syncthreads();
      for (int e = tid; e < 33 * 32; e += NTHREADS) {
        int b = e >> 5, cc = e & 31;
        float sv = p.b_ada[j0 + cc];
#pragma unroll
        for (int k2 = 0; k2 < 16; ++k2) sv += red[(k2 * 33 + b) * 32 + cc];
        p.mod()[b * 6144 + j0 + cc] = sv;
      }
      __syncthreads();
    }
  }
  transpose_tiles(p.w_in, 1024, INC, p.win_t(), 1024, INCP, smem, bid, nb);
  transpose_tiles(p.w_out, 1024, 1024, p.wout_t(), 1024, 1024, smem, bid, nb);
  transpose_tiles(p.peer_w_q, 1024, 2048, p.wq_t(), 1024, 2048, smem, bid, nb);
  transpose_tiles(p.s5_w_glu, 512, 512, p.wglu_t(), 512, 512, smem, bid, nb);
  transpose_tiles(p.rw_w_g2, 96, 512, p.wg2_t(), 256, 512, smem, bid, nb);
  convert_bf16(p.peer_keys, p.keys(), (size_t)8 * 2 * 128 * 128 / 8, bid, nb);
  convert_fp4_rows(p.peer_u, p.utab(), p.usc(), 16384, bid, nb);
  convert_fp4_rows(p.peer_v, p.vtab(), p.vsc(), 16384, bid, nb);
  for (int it = bid * NTHREADS + tid; it < 2 * 4096; it += nb * NTHREADS) {
    const int ln = it & 63, mt = (it >> 6) & 3, hh_ = (it >> 8) & 7, dd = (it >> 11) & 1, mm = it >> 12;
    const int tt = ln & 15, kq_ = ln >> 4;
    const float* W = mm ? p.rw_w_a2 : p.rw_w_w2;
    unsigned o[4];
#pragma unroll
    for (int q = 0; q < 4; ++q) {
      const size_t o0 = (size_t)(dd * 32 + 8 * kq_ + 2 * q) * 512 + hh_ * 64 + 16 * mt + tt;
      o[q] = pack2(W[o0], W[o0 + 512]);
    }
    *(uint4*)(p.wlf() + (size_t)it * 8) = make_uint4(o[0], o[1], o[2], o[3]);
  }
  for (int it = bid * NTHREADS + tid; it < 4096; it += nb * NTHREADS) {
    int pp = it & 63, g = (it >> 6) & 31, d = it >> 11;
    float are = p.s5_a_re[it], aim = p.s5_a_im[it];
    float dt = expf(p.s5_log_dt[d * 32 + g]);
    float mag = expf(dt * are);
    float abr = mag * cosf(dt * aim), abi = mag * sinf(dt * aim);
    float nr = abr - 1.f, ni = abi;
    float den = are * are + aim * aim;
    float cfr = (nr * are + ni * aim) / den, cfi = (ni * are - nr * aim) / den;
    p.s5ab()[it * 2] = abr;
    p.s5ab()[it * 2 + 1] = abi;
    for (int h = 0; h < 16; ++h) {
      float br = p.s5_b_re[(size_t)it * 16 + h], bi = p.s5_b_im[(size_t)it * 16 + h];
      p.s5bb()[(size_t)it * 32 + h] = cfr * br - cfi * bi;
      p.s5bb()[(size_t)it * 32 + 16 + h] = cfr * bi + cfi * br;
    }
    for (int h = 0; h < 16; ++h) {
      size_t ci = ((size_t)(d * 32 + g) * 16 + h) * 64 + pp;
      p.s5ct()[((size_t)(d * 32 + g) * 16 + h) * 128 + 2 * pp] = f2bf(p.s5_c_re[ci]);
      p.s5ct()[((size_t)(d * 32 + g) * 16 + h) * 128 + 2 * pp + 1] = f2bf(-p.s5_c_im[ci]);
    }
  }
}

__device__ __forceinline__ void ph_norm(const P& p, int mode, int bid, int nb) {
  const int wid = tidx() >> 6, lane = tidx() & 63;
  const int nrows = mode == 0 ? NTOK : NLAT;
  const float* gvec = mode == 0 ? p.norm1_g : p.norm2_g;
  const int sh_off = mode == 0 ? 0 : 3 * 1024, sc_off = sh_off + 1024;
  const int stride = nb * 8;
  for (int row0 = bid * 8 + wid; row0 < nrows; row0 += 4 * stride) {
    float4 v[4][4];
    int bs[4];
#pragma unroll
    for (int u = 0; u < 4; ++u) {
      int row = row0 + u * stride;
      if (row >= nrows) row = row0;
      const float* src;
      if (mode == 0) {
        if (row < NLAT) { src = p.x + (size_t)row * 1024; bs[u] = row >> 11; }
        else { src = p.ctx + (size_t)(row - NLAT) * 1024; bs[u] = 32; }
      } else { src = p.out + (size_t)row * 1024; bs[u] = row >> 11; }
#pragma unroll
      for (int j = 0; j < 2; ++j) {
        v[u][2 * j] = *(const float4*)(src + j * 512 + lane * 8);
        v[u][2 * j + 1] = *(const float4*)(src + j * 512 + lane * 8 + 4);
      }
    }
#pragma unroll
    for (int u = 0; u < 4; ++u) {
      const int row = row0 + u * stride;
      if (row >= nrows) continue;
      float ss = 0.f;
#pragma unroll
      for (int j = 0; j < 4; ++j) ss += v[u][j].x * v[u][j].x + v[u][j].y * v[u][j].y + v[u][j].z * v[u][j].z + v[u][j].w * v[u][j].w;
      ss = wave_sum_u(ss);
      const float rstd = rsqrtf(ss * (1.f / 1024.f) + 1e-6f);
      const float* mrow = p.mod() + bs[u] * 6144;
#pragma unroll
      for (int j = 0; j < 2; ++j) {
        const int col = j * 512 + lane * 8;
        unsigned o[4];
#pragma unroll
        for (int hq = 0; hq < 2; ++hq) {
          const float4 x = v[u][2 * j + hq];
          const float4 g = *(const float4*)(gvec + col + 4 * hq);
          const float4 sh = *(const float4*)(mrow + sh_off + col + 4 * hq);
          const float4 sc = *(const float4*)(mrow + sc_off + col + 4 * hq);
          o[2 * hq] = pack2(x.x * rstd * g.x * (1.f + sc.x) + sh.x, x.y * rstd * g.y * (1.f + sc.y) + sh.y);
          o[2 * hq + 1] = pack2(x.z * rstd * g.z * (1.f + sc.z) + sh.z, x.w * rstd * g.w * (1.f + sc.w) + sh.w);
        }
        *(uint4*)(p.hn() + (size_t)row * 1024 + col) = make_uint4(o[0], o[1], o[2], o[3]);
      }
    }
  }
}

#define G_BM 256
#define G_BN 128
#define G_BK 64
#define G_LD 72
template <class Epi>
__device__ __forceinline__ void gemm_simple(const u16* __restrict__ A, int lda, const u16* __restrict__ Bt, int ldb, int K, int M, int N,
                           char* smem, int bid, int nb, Epi epi) {
  u16* As = (u16*)smem;
  u16* Bs = (u16*)(smem + 2 * G_BM * G_LD * 2);
  const int tid = tidx(), wid = tid >> 6, lane = tid & 63;
  const int wr = wid >> 1, wc = wid & 1, fr = lane & 15, fq = lane >> 4;
  const int ntn = N / G_BN, ntiles = (M / G_BM) * ntn, nk = K / G_BK;
  const int lrow = tid >> 3, lkc = (tid & 7) * 8;
  for (int tile = bid; tile < ntiles; tile += nb) {
    const int m0 = (tile / ntn) * G_BM, n0 = (tile % ntn) * G_BN;
    f32x4 acc[4][4];
#pragma unroll
    for (int i = 0; i < 4; ++i)
#pragma unroll
      for (int j = 0; j < 4; ++j) acc[i][j] = (f32x4){0.f, 0.f, 0.f, 0.f};
    u32x4 ra[4], rb[2];
    const u16* Ag = A + (size_t)(m0 + lrow) * lda + lkc;
    const u16* Bg = Bt + (size_t)(n0 + lrow) * ldb + lkc;
#pragma unroll
    for (int i = 0; i < 4; ++i) ra[i] = *(const u32x4*)(Ag + (size_t)(64 * i) * lda);
#pragma unroll
    for (int i = 0; i < 2; ++i) rb[i] = *(const u32x4*)(Bg + (size_t)(64 * i) * ldb);
    __syncthreads();
#pragma unroll
    for (int i = 0; i < 4; ++i) *(u32x4*)(As + (lrow + 64 * i) * G_LD + lkc) = ra[i];
#pragma unroll
    for (int i = 0; i < 2; ++i) *(u32x4*)(Bs + (lrow + 64 * i) * G_LD + lkc) = rb[i];
    __syncthreads();
    for (int kt = 0; kt < nk; ++kt) {
      const int buf = kt & 1;
      if (kt + 1 < nk) {
#pragma unroll
        for (int i = 0; i < 4; ++i) ra[i] = *(const u32x4*)(Ag + (size_t)(64 * i) * lda + (kt + 1) * G_BK);
#pragma unroll
        for (int i = 0; i < 2; ++i) rb[i] = *(const u32x4*)(Bg + (size_t)(64 * i) * ldb + (kt + 1) * G_BK);
      }
      const u16* as = As + buf * (G_BM * G_LD);
      const u16* bs = Bs + buf * (G_BN * G_LD);
#pragma unroll
      for (int ks = 0; ks < 2; ++ks) {
        bf16x8 af[4], bfr[4];
#pragma unroll
        for (int mi = 0; mi < 4; ++mi) af[mi] = *(const bf16x8*)(as + (wr * 64 + mi * 16 + fr) * G_LD + ks * 32 + fq * 8);
#pragma unroll
        for (int ni = 0; ni < 4; ++ni) bfr[ni] = *(const bf16x8*)(bs + (wc * 64 + ni * 16 + fr) * G_LD + ks * 32 + fq * 8);
#pragma unroll
        for (int mi = 0; mi < 4; ++mi)
#pragma unroll
          for (int ni = 0; ni < 4; ++ni)
            acc[mi][ni] = __builtin_amdgcn_mfma_f32_16x16x32_bf16(af[mi], bfr[ni], acc[mi][ni], 0, 0, 0);
      }
      if (kt + 1 < nk) {
        u16* as2 = As + (buf ^ 1) * (G_BM * G_LD);
        u16* bs2 = Bs + (buf ^ 1) * (G_BN * G_LD);
#pragma unroll
        for (int i = 0; i < 4; ++i) *(u32x4*)(as2 + (lrow + 64 * i) * G_LD + lkc) = ra[i];
#pragma unroll
        for (int i = 0; i < 2; ++i) *(u32x4*)(bs2 + (lrow + 64 * i) * G_LD + lkc) = rb[i];
      }
      __syncthreads();
    }
#pragma unroll
    for (int mi = 0; mi < 4; ++mi)
#pragma unroll
      for (int ni = 0; ni < 4; ++ni) epi(m0 + wr * 64 + mi * 16 + fq * 4, n0 + wc * 64 + ni * 16 + fr, acc[mi][ni]);
  }
}

namespace pg8 {
#define PG8_LAS __attribute__((address_space(3)))
typedef unsigned short bf16_t;
typedef short bf16x8 __attribute__((ext_vector_type(8)));
typedef float f32x4 __attribute__((ext_vector_type(4)));
typedef unsigned u32x4 __attribute__((ext_vector_type(4)));
constexpr int BM = 256, BK = 64, HALF = 128, HTB = HALF * BK * 2  , STAGE_BYTES = 8 * HTB, NXCD = 8, WGM = 8;

__host__ __device__ __forceinline__ int lds_byte(int r, int c) { const int st = (r >> 4) * 2 + (c >> 5), rr = r & 15, cc = c & 31, ob = rr * 64 + cc * 2; return st * 1024 + (ob ^ (((ob >> 9) & 1) << 5)); }
__host__ __device__ __forceinline__ void stage_rc(int b, int& R, int& C) { const int st = b / 1024, sb = b % 1024, swz = sb ^ (((sb >> 9) & 1) << 5); R = (st >> 1) * 16 + swz / 64; C = (st & 1) * 32 + (swz % 64) / 2; }
__host__ __device__ __forceinline__ int perm32(int rho) { const int n = rho >> 4, i = rho & 15; return 8 * (i >> 2) + 4 * n + (i & 3); }

struct Unit { int pm, pn; };
struct Gemm { const bf16_t* A; const bf16_t* Bt; int M, N, K; };

struct StaticOrder {
    int nM, nN, nwg, G, c;
    __host__ __device__ void init(int M, int N, int G_, int c_) { nM = M / BM; nN = N / BM; nwg = nM * nN; G = G_; c = c_; }
    __host__ __device__ bool next(int i, Unit& u) const {
        const long L = (long)i * G + c; if (L >= nwg) return false;
        int wgid = (int)L; { const int q = nwg / NXCD, r = nwg % NXCD, xcd = wgid % NXCD, off = wgid / NXCD; wgid = (xcd < r ? xcd * (q + 1) : r * (q + 1) + (xcd - r) * q) + off; }
        const int nig = WGM * nN, gid = wgid / nig, fm = gid * WGM, gsz = (nM - fm) < WGM ? (nM - fm) : WGM;
        u.pm = fm + ((wgid % nig) % gsz); u.pn = (wgid % nig) / gsz; return true;
    }
    __device__ __forceinline__ void a_ready(const Unit&) const {}
    __device__ __forceinline__ void done(const Unit&) const {}
};
__device__ __forceinline__ unsigned cvt_pk_bf16(float lo, float hi) { return ::pack2(lo, hi); }
typedef float f32x2 __attribute__((ext_vector_type(2)));
template <class Epi, class Sched, bool STAMP = false>
__device__ __forceinline__ void gemm_phase(PG8_LAS unsigned char* lds, const Gemm g, const Sched& S, const Epi& E, unsigned long long* stamps) {
    const int tid = tidx(), wid = __builtin_amdgcn_readfirstlane(tid >> 6), lane = tid & 63, wr = wid >> 2, wc = wid & 3, fr = lane & 15, fq = lane >> 4;
    const int K = g.K, nt = K / BK;
    int ts_lo = 0, ts_hi = 0, nts = 0; const unsigned long long rt_entry = STAMP ? (unsigned long long)wall_clock64() : 0ull;
#define PG8_STAMP() do { if (STAMP && wid == 0 && nts < 64) { const unsigned long long _c = (unsigned long long)clock64(); \
        ts_lo = (lane == nts) ? (int)(unsigned)_c : ts_lo; ts_hi = (lane == nts) ? (int)(unsigned)(_c >> 32) : ts_hi; ++nts; } } while (0)
    PG8_STAMP();
    unsigned voffA[2], voffB[2];
#pragma unroll
    for (int i = 0; i < 2; ++i) { int R, C; stage_rc(tid * 16 + i * 8192, R, C); const int Rb = Epi::PERM ? ((R & ~31) + perm32(R & 31)) : R;
        voffA[i] = (unsigned)(R * K + C) * 2u; voffB[i] = (unsigned)(Rb * K + C) * 2u; }
    const size_t kstep = (size_t)(BK * 2);
    const size_t hstep = (size_t)HALF * K * 2;
    const size_t tstep = 2 * hstep;
    const unsigned ldsw = (unsigned)wid * 1024u;
    const int aoff = lds_byte(wr * 64 + fr, fq * 8), boff = lds_byte(wc * 32 + fr, fq * 8);
#define PG8_SA(b, h) (((b) * 2 + (h)) * HTB)
#define PG8_SB(b, h) ((4 + (b) * 2 + (h)) * HTB)
#define PG8_STAGE(bufoff, gbase, voff) do { _Pragma("unroll") for (int _i = 0; _i < 2; ++_i) \
        __builtin_amdgcn_global_load_lds((const unsigned*)((const char*)(gbase) + (voff)[_i]), (PG8_LAS unsigned*)(lds + (bufoff) + ldsw + _i * 8192), 16, 0, 0); } while (0)
#define PG8_LDA(dst, b, h) do { _Pragma("unroll") for (int m = 0; m < 4; ++m) _Pragma("unroll") for (int k = 0; k < 2; ++k) dst[m][k] = *(const PG8_LAS bf16x8*)(lds + PG8_SA(b, h) + aoff + m * 2048 + k * 1024); } while (0)
#define PG8_LDB(dst, b, h) do { _Pragma("unroll") for (int n = 0; n < 2; ++n) _Pragma("unroll") for (int k = 0; k < 2; ++k) dst[n][k] = *(const PG8_LAS bf16x8*)(lds + PG8_SB(b, h) + boff + n * 2048 + k * 1024); } while (0)
#define PG8_MMA(ai, bj, At, Bt) do { __builtin_amdgcn_s_setprio(1); _Pragma("unroll") for (int m = 0; m < 4; ++m) _Pragma("unroll") for (int n = 0; n < 2; ++n) _Pragma("unroll") for (int k = 0; k < 2; ++k) \
        acc[ai][bj][m][n] = __builtin_amdgcn_mfma_f32_16x16x32_bf16(Bt[n][k], At[m][k], acc[ai][bj][m][n], 0, 0, 0); __builtin_amdgcn_s_setprio(0); } while (0)
#define PG8_WAIT_V(n) asm volatile("s_waitcnt vmcnt(" #n ")" ::: "memory")
#define PG8_WAIT_L(n) asm volatile("s_waitcnt lgkmcnt(" #n ")" ::: "memory")
#define PG8_BAR __builtin_amdgcn_s_barrier()
#define PG8_SCHED __builtin_amdgcn_sched_barrier(0)
    Unit cur, nxt; int ui = 0;
    if (!S.next(0, cur)) return;
    f32x4 acc[2][2][4][2];
#pragma unroll
    for (int a = 0; a < 2; ++a)
#pragma unroll
        for (int b = 0; b < 2; ++b)
#pragma unroll
            for (int m = 0; m < 4; ++m)
#pragma unroll
                for (int n = 0; n < 2; ++n) acc[a][b][m][n] = (f32x4){0.f, 0.f, 0.f, 0.f};
    bf16x8 At[4][2], B0[2][2], B1[2][2];
    const char* cA = (const char*)g.A + (size_t)cur.pm * tstep; const char* cB = (const char*)g.Bt + (size_t)cur.pn * tstep;
    S.a_ready(cur);
    PG8_STAGE(PG8_SB(0, 0), cB, voffB); PG8_STAGE(PG8_SA(0, 0), cA, voffA); PG8_STAGE(PG8_SB(0, 1), cB + hstep, voffB); PG8_STAGE(PG8_SA(0, 1), cA + hstep, voffA);
    if (wr == 1) PG8_BAR;
    PG8_WAIT_V(4); PG8_BAR;
    PG8_STAGE(PG8_SB(1, 0), cB + kstep, voffB); PG8_STAGE(PG8_SA(1, 0), cA + kstep, voffA); PG8_STAGE(PG8_SB(1, 1), cB + hstep + kstep, voffB);
    PG8_WAIT_V(6); PG8_BAR;
    PG8_STAMP();
    for (;;) {
        const bool has_next = S.next(ui + 1, nxt);
        const char* nA = has_next ? (const char*)g.A + (size_t)nxt.pm * tstep : cA; const char* nB = has_next ? (const char*)g.Bt + (size_t)nxt.pn * tstep : cB;
        for (int t = 0; t < nt; t += 2) {
            const bool last = (t == nt - 2);
            const char* a1 = cA + (size_t)(t + 1) * kstep;
            const char* a2 = last ? nA : cA + (size_t)(t + 2) * kstep; const char* b2 = last ? nB : cB + (size_t)(t + 2) * kstep;
            const char* a3 = a2 + kstep; const char* b3 = b2 + kstep;
            if (last && has_next) S.a_ready(nxt);
            PG8_LDB(B0, 0, 0); PG8_SCHED; PG8_LDA(At, 0, 0); PG8_STAGE(PG8_SA(1, 1), a1 + hstep, voffA);
            PG8_WAIT_L(8); PG8_BAR; PG8_WAIT_L(0); PG8_MMA(0, 0, At, B0); PG8_BAR; PG8_SCHED;
            PG8_LDB(B1, 0, 1); PG8_STAGE(PG8_SB(0, 0), b2, voffB);
            PG8_BAR; PG8_WAIT_L(0); PG8_MMA(0, 1, At, B1); PG8_BAR;
            PG8_LDA(At, 0, 1); PG8_STAGE(PG8_SA(0, 0), a2, voffA);
            PG8_BAR; PG8_WAIT_L(0); PG8_MMA(1, 0, At, B0); PG8_BAR; PG8_SCHED;
            PG8_STAGE(PG8_SB(0, 1), b2 + hstep, voffB);
            PG8_WAIT_V(6); PG8_BAR; PG8_MMA(1, 1, At, B1); PG8_BAR;
            PG8_LDB(B0, 1, 0); PG8_SCHED; PG8_LDA(At, 1, 0); PG8_STAGE(PG8_SA(0, 1), a2 + hstep, voffA);
            PG8_WAIT_L(8); PG8_BAR; PG8_WAIT_L(0); PG8_MMA(0, 0, At, B0); PG8_BAR; PG8_SCHED;
            PG8_LDB(B1, 1, 1); PG8_STAGE(PG8_SB(1, 0), b3, voffB);
            PG8_BAR; PG8_WAIT_L(0); PG8_MMA(0, 1, At, B1); PG8_BAR;
            PG8_LDA(At, 1, 1); PG8_STAGE(PG8_SA(1, 0), a3, voffA);
            PG8_BAR; PG8_WAIT_L(0); PG8_MMA(1, 0, At, B0); PG8_BAR; PG8_SCHED;
            PG8_STAGE(PG8_SB(1, 1), b3 + hstep, voffB);
            PG8_WAIT_V(6); PG8_BAR; PG8_MMA(1, 1, At, B1); PG8_BAR;
        }
        PG8_STAMP();
        if constexpr (!Epi::AFTER_DRAIN) { E(acc, cur, wr, wc, fr, fq); S.done(cur); }
        PG8_STAMP();
        if (!has_next) break;
#pragma unroll
        for (int a = 0; a < 2; ++a)
#pragma unroll
            for (int b = 0; b < 2; ++b)
#pragma unroll
                for (int m = 0; m < 4; ++m)
#pragma unroll
                    for (int n = 0; n < 2; ++n) acc[a][b][m][n] = (f32x4){0.f, 0.f, 0.f, 0.f};
        cur = nxt; cA = nA; cB = nB; ++ui;
    }
    PG8_WAIT_V(0);
    if (wr == 0) PG8_BAR;
    PG8_BAR;
    if constexpr (Epi::AFTER_DRAIN) { E.fused(acc, cur, wr, wc, fr, fq, lds, wid, lane); S.done(cur); }
    PG8_STAMP();
    if (STAMP && wid == 0) { stamps[lane] = lane < nts ? (((unsigned long long)(unsigned)ts_hi << 32) | (unsigned)ts_lo) : 0ull;
        if (lane == 62) stamps[62] = rt_entry; if (lane == 63) stamps[63] = (unsigned long long)wall_clock64(); }
#undef PG8_STAMP
#undef PG8_SA
#undef PG8_SB
#undef PG8_STAGE
#undef PG8_LDA
#undef PG8_LDB
#undef PG8_MMA
#undef PG8_WAIT_V
#undef PG8_WAIT_L
#undef PG8_BAR
#undef PG8_SCHED
}
}

namespace pg8 {
struct EpiProjT {
  static constexpr bool PERM = true, AFTER_DRAIN = false;
  bf16_t* O; int ldc; int ncols;
  __device__ __forceinline__ void operator()(const f32x4 (&acc)[2][2][4][2], const Unit& u, int wr, int wc, int fr, int fq) const {
    const int row0 = u.pm * BM + wr * 64 + fr, col0 = u.pn * BM + wc * 32 + 8 * fq;
#pragma unroll
    for (int ai = 0; ai < 2; ++ai)
#pragma unroll
      for (int m = 0; m < 4; ++m) {
        bf16_t* rowp = O + (size_t)(row0 + ai * HALF + m * 16) * ldc + col0;
#pragma unroll
        for (int bj = 0; bj < 2; ++bj) {
          if (col0 + bj * HALF < ncols) {
            const f32x4 v0 = acc[ai][bj][m][0], v1 = acc[ai][bj][m][1];
            u32x4 w; w.x = cvt_pk_bf16(v0[0], v0[1]); w.y = cvt_pk_bf16(v0[2], v0[3]); w.z = cvt_pk_bf16(v1[0], v1[1]); w.w = cvt_pk_bf16(v1[2], v1[3]);
            *(u32x4*)(rowp + bj * HALF) = w;
          }
        }
      }
  }
};
struct EpiGluT {
  static constexpr bool PERM = true, AFTER_DRAIN = false;
  const bf16_t* Y1; const float* bglu; bf16_t* O;
  __device__ __forceinline__ void operator()(const f32x4 (&acc)[2][2][4][2], const Unit& u, int wr, int wc, int fr, int fq) const {
    const int row0 = u.pm * BM + wr * 64 + fr, col0 = u.pn * BM + wc * 32 + 8 * fq;
    f32x4 bv[2][2];
#pragma unroll
    for (int bj = 0; bj < 2; ++bj)
#pragma unroll
      for (int n = 0; n < 2; ++n) bv[bj][n] = *(const f32x4*)(bglu + col0 + bj * HALF + 4 * n);
#pragma unroll
    for (int ai = 0; ai < 2; ++ai)
#pragma unroll
      for (int m = 0; m < 4; ++m) {
        const size_t r = (size_t)(row0 + ai * HALF + m * 16);
#pragma unroll
        for (int bj = 0; bj < 2; ++bj) {
          const u32x4 yv = *(const u32x4*)(Y1 + r * 512 + col0 + bj * HALF);
          const f32x4 v0 = acc[ai][bj][m][0] + bv[bj][0], v1 = acc[ai][bj][m][1] + bv[bj][1];
          float o[8];
#pragma unroll
          for (int q = 0; q < 4; ++q) {
            const float ylo = __uint_as_float(yv[q] << 16), yhi = __uint_as_float(yv[q] & 0xffff0000u);
            const float a0 = q < 2 ? v0[2 * q] : v1[2 * q - 4], a1 = q < 2 ? v0[2 * q + 1] : v1[2 * q - 3];
            o[2 * q] = ylo / (1.f + __expf(-a0));
            o[2 * q + 1] = yhi / (1.f + __expf(-a1));
          }
          u32x4 w; w.x = cvt_pk_bf16(o[0], o[1]); w.y = cvt_pk_bf16(o[2], o[3]); w.z = cvt_pk_bf16(o[4], o[5]); w.w = cvt_pk_bf16(o[6], o[7]);
          *(u32x4*)(O + r * 1024 + col0 + bj * HALF) = w;
        }
      }
  }
};
struct EpiGateT {
  static constexpr bool PERM = true, AFTER_DRAIN = false;
  const bf16_t* T1; bf16_t* O;
  __device__ __forceinline__ void operator()(const f32x4 (&acc)[2][2][4][2], const Unit& u, int wr, int wc, int fr, int fq) const {
    const int row0 = u.pm * BM + wr * 64 + fr, col0 = u.pn * BM + wc * 32 + 8 * fq;
#pragma unroll
    for (int ai = 0; ai < 2; ++ai)
#pragma unroll
      for (int m = 0; m < 4; ++m) {
        const size_t r = (size_t)(row0 + ai * HALF + m * 16);
#pragma unroll
        for (int bj = 0; bj < 2; ++bj) {
          const u32x4 tv = *(const u32x4*)(T1 + r * 512 + col0 + bj * HALF);
          const f32x4 v0 = acc[ai][bj][m][0], v1 = acc[ai][bj][m][1];
          u32x4 w;
          w.x = cvt_pk_bf16(__uint_as_float(tv[0] << 16) * v0[0], __uint_as_float(tv[0] & 0xffff0000u) * v0[1]);
          w.y = cvt_pk_bf16(__uint_as_float(tv[1] << 16) * v0[2], __uint_as_float(tv[1] & 0xffff0000u) * v0[3]);
          w.z = cvt_pk_bf16(__uint_as_float(tv[2] << 16) * v1[0], __uint_as_float(tv[2] & 0xffff0000u) * v1[1]);
          w.w = cvt_pk_bf16(__uint_as_float(tv[3] << 16) * v1[2], __uint_as_float(tv[3] & 0xffff0000u) * v1[3]);
          *(u32x4*)(O + r * 1024 + 512 + col0 + bj * HALF) = w;
        }
      }
  }
};
struct EpiWoutT {
  static constexpr bool PERM = false, AFTER_DRAIN = false;
  const float* X; const float* mod; float* H2;
  __device__ __forceinline__ void operator()(const f32x4 (&acc)[2][2][4][2], const Unit& u, int wr, int wc, int fr, int fq) const {
    const int row0 = u.pm * BM + wr * 64 + fr, col0 = u.pn * BM + wc * 32 + 4 * fq;
    const float* g1p = mod + ((u.pm * BM) >> 11) * 6144 + 2 * 1024 + col0;
    f32x4 gv[2][2];
#pragma unroll
    for (int bj = 0; bj < 2; ++bj)
#pragma unroll
      for (int n = 0; n < 2; ++n) gv[bj][n] = *(const f32x4*)(g1p + bj * HALF + n * 16);
#pragma unroll
    for (int ai = 0; ai < 2; ++ai)
#pragma unroll
      for (int m = 0; m < 4; ++m) {
        const size_t off = (size_t)(row0 + ai * HALF + m * 16) * 1024 + col0;
#pragma unroll
        for (int bj = 0; bj < 2; ++bj)
#pragma unroll
          for (int n = 0; n < 2; ++n) {
            const f32x4 xv = *(const f32x4*)(X + off + bj * HALF + n * 16);
            *(f32x4*)(H2 + off + bj * HALF + n * 16) = xv + gv[bj][n] * acc[ai][bj][m][n];
          }
      }
  }
};
}

struct EpiProj {
  u16* proj;
  __device__ __forceinline__ void operator()(int r, int c, f32x4 v) const {
    if (c < INC) {
#pragma unroll
      for (int j = 0; j < 4; ++j) proj[(size_t)(r + j) * INC + c] = f2bf(v[j]);
    }
  }
};
struct EpiGlu {
  const u16* y1; const float* bglu; u16* a2;
  __device__ __forceinline__ void operator()(int r, int c, f32x4 v) const {
    float bb = bglu[c];
#pragma unroll
    for (int j = 0; j < 4; ++j) {
      float y = bf2f(y1[(size_t)(r + j) * 512 + c]);
      a2[(size_t)(r + j) * 1024 + c] = f2bf(y * sigmoidf(v[j] + bb));
    }
  }
};
struct EpiGate {
  const u16* t1; u16* a2;
  __device__ __forceinline__ void operator()(int r, int c, f32x4 v) const {
#pragma unroll
    for (int j = 0; j < 4; ++j) {
      float t = bf2f(t1[(size_t)(r + j) * 512 + c]);
      a2[(size_t)(r + j) * 1024 + 512 + c] = f2bf(t * v[j]);
    }
  }
};
struct EpiWout {
  const float* x; const float* mod; float* h2;
  __device__ __forceinline__ void operator()(int r, int c, f32x4 v) const {
    float g1 = mod[(r >> 11) * 6144 + 2 * 1024 + c];
#pragma unroll
    for (int j = 0; j < 4; ++j) h2[(size_t)(r + j) * 1024 + c] = x[(size_t)(r + j) * 1024 + c] + g1 * v[j];
  }
};
struct EpiQ {
  u16* q;
  __device__ __forceinline__ void operator()(int r, int c, f32x4 v) const {
#pragma unroll
    for (int j = 0; j < 4; ++j) q[(size_t)(r + j) * 2048 + c] = f2bf(v[j]);
  }
};

__device__ __forceinline__ void ph_s5scan(const P& p, char* smem, int bid, int nb) {
  const int wid = tidx() >> 6, lane = tidx() & 63;
  float* U = (float*)(smem + wid * 8448);
  unsigned* H = (unsigned*)((char*)U + 4096);
  const int fr = lane & 15, fq = lane >> 4;
  for (int s = bid * 8 + wid; s < 2048; s += nb * 8) {
    const int g = s & 31, d = (s >> 5) & 1, b = s >> 6;
    const int ci = (d * 32 + g) * 64 + lane;
    const float abr = p.s5ab()[ci * 2], abi = p.s5ab()[ci * 2 + 1];
    float bbr[16], bbi[16];
#pragma unroll
    for (int q = 0; q < 4; ++q) {
      float4 t = *(const float4*)(p.s5bb() + (size_t)ci * 32 + q * 4);
      bbr[q * 4] = t.x; bbr[q * 4 + 1] = t.y; bbr[q * 4 + 2] = t.z; bbr[q * 4 + 3] = t.w;
      float4 t2 = *(const float4*)(p.s5bb() + (size_t)ci * 32 + 16 + q * 4);
      bbi[q * 4] = t2.x; bbi[q * 4 + 1] = t2.y; bbi[q * 4 + 2] = t2.z; bbi[q * 4 + 3] = t2.w;
    }
    bf16x8 cf[4];
#pragma unroll
    for (int kb = 0; kb < 4; ++kb)
      cf[kb] = *(const bf16x8*)(p.s5ct() + ((size_t)(d * 32 + g) * 16 + fr) * 128 + kb * 32 + fq * 8);
    const float dcoef = p.s5_d[g * 16 + fr];
    u16* ydst = d ? p.ys5b() : p.ys5f();
    float hr = 0.f, hi = 0.f;
    for (int seg = 0; seg < 2; ++seg) {
      const int L = seg ? 2048 : 256;
      const int rowbase = seg ? b * 2048 : NLAT + b * 256;
      for (int c0 = 0; c0 < L; c0 += 64) {
        {
          int pos = c0 + lane;
          int t = d ? (L - 1 - pos) : pos;
          const u16* src = p.proj() + (size_t)(rowbase + t) * INC + g * 16;
          uint4 v0 = *(const uint4*)src, v1 = *(const uint4*)(src + 8);
          float4* ud = (float4*)(U + lane * 16);
          ud[0] = make_float4(bflo(v0.x), bfhi(v0.x), bflo(v0.y), bfhi(v0.y));
          ud[1] = make_float4(bflo(v0.z), bfhi(v0.z), bflo(v0.w), bfhi(v0.w));
          ud[2] = make_float4(bflo(v1.x), bfhi(v1.x), bflo(v1.y), bfhi(v1.y));
          ud[3] = make_float4(bflo(v1.z), bfhi(v1.z), bflo(v1.w), bfhi(v1.w));
        }
        for (int sub = 0; sub < 4; ++sub) {
#pragma unroll 4
          for (int i = 0; i < 16; ++i) {
            const float4* up = (const float4*)(U + (sub * 16 + i) * 16);
            float4 u0 = up[0], u1 = up[1], u2 = up[2], u3 = up[3];
            float ur[16] = {u0.x, u0.y, u0.z, u0.w, u1.x, u1.y, u1.z, u1.w, u2.x, u2.y, u2.z, u2.w, u3.x, u3.y, u3.z, u3.w};
            float br0 = 0.f, br1 = 0.f, bi0 = 0.f, bi1 = 0.f;
#pragma unroll
            for (int h = 0; h < 16; h += 2) {
              br0 += bbr[h] * ur[h]; br1 += bbr[h + 1] * ur[h + 1];
              bi0 += bbi[h] * ur[h]; bi1 += bbi[h + 1] * ur[h + 1];
            }
            float nr = abr * hr - abi * hi + (br0 + br1);
            float ni = abr * hi + abi * hr + (bi0 + bi1);
            hr = nr; hi = ni;
            if (seg) H[i * 68 + lane] = pack2(hr, hi);
          }
          if (seg) {
            f32x4 acc = (f32x4){0.f, 0.f, 0.f, 0.f};
#pragma unroll
            for (int kb = 0; kb < 4; ++kb) {
              bf16x8 a = *(const bf16x8*)((const u16*)H + fr * 136 + kb * 32 + fq * 8);
              acc = __builtin_amdgcn_mfma_f32_16x16x32_bf16(a, cf[kb], acc, 0, 0, 0);
            }
#pragma unroll
            for (int j = 0; j < 4; ++j) {
              int pi = sub * 16 + fq * 4 + j;
              int pos = c0 + pi;
              int t = d ? (L - 1 - pos) : pos;
              float y = acc[j];
              if (d == 0) y += dcoef * U[pi * 16 + fr];
              ydst[(size_t)(b * 2048 + t) * 512 + g * 16 + fr] = f2bf(y);
            }
          }
        }
      }
    }
  }
}

#define S5_LD 168
__device__ __forceinline__ void ph_s5scan2(const P& p, char* smem, int bid, int nb) {
  const int wid = tidx() >> 6, lane = tidx() & 63;
  u16* H = (u16*)(smem + wid * (32 * S5_LD * 2));
  const int n = lane & 31, hh = lane >> 5, fr = lane & 15, fq = lane >> 4;
  for (int r = lane; r < 32; r += 64) {
    *(uint4*)(H + r * S5_LD + 144) = make_uint4(0u, 0u, 0u, 0u);
    *(uint4*)(H + r * S5_LD + 152) = make_uint4(0u, 0u, 0u, 0u);
    *(uint4*)(H + r * S5_LD + 160) = make_uint4(0u, 0u, 0u, 0u);
  }
  for (int s = bid * 8 + wid; s < 2048; s += nb * 8) {
    const int g = s & 31, d = (s >> 5) & 1, b = s >> 6;
    float ar[2][4], ai[2][4], a8r[2], a8i[2];
#pragma unroll
    for (int st = 0; st < 2; ++st) {
      const int ci = (d * 32 + g) * 64 + st * 32 + n;
      const float xr = p.s5ab()[ci * 2], xi = p.s5ab()[ci * 2 + 1];
      ar[st][0] = xr; ai[st][0] = xi;
#pragma unroll
      for (int k = 1; k < 4; ++k) {
        ar[st][k] = ar[st][k - 1] * xr - ai[st][k - 1] * xi;
        ai[st][k] = ar[st][k - 1] * xi + ai[st][k - 1] * xr;
      }
      a8r[st] = ar[st][3] * ar[st][3] - ai[st][3] * ai[st][3];
      a8i[st] = 2.f * ar[st][3] * ai[st][3];
    }
    bf16x8 bfr[4];
#pragma unroll
    for (int nt = 0; nt < 4; ++nt) {
      const int ci = (d * 32 + g) * 64 + (nt & 1) * 32 + n;
      const float4 t0 = *(const float4*)(p.s5bb() + (size_t)ci * 32 + (nt >> 1) * 16 + 8 * hh);
      const float4 t1 = *(const float4*)(p.s5bb() + (size_t)ci * 32 + (nt >> 1) * 16 + 8 * hh + 4);
      union { unsigned u[4]; bf16x8 v; } t;
      t.u[0] = pack2(t0.x, t0.y); t.u[1] = pack2(t0.z, t0.w); t.u[2] = pack2(t1.x, t1.y); t.u[3] = pack2(t1.z, t1.w);
      bfr[nt] = t.v;
    }
    bf16x8 cf[5];
#pragma unroll
    for (int kb = 0; kb < 4; ++kb)
      cf[kb] = *(const bf16x8*)(p.s5ct() + ((size_t)(d * 32 + g) * 16 + fr) * 128 + kb * 32 + fq * 8);
    {
      const float dv = (d == 0) ? p.s5_d[g * 16 + fr] : 0.f;
      union { u16 h[8]; bf16x8 v; } t;
#pragma unroll
      for (int j = 0; j < 8; ++j) t.h[j] = (8 * fq + j == fr) ? f2bf(dv) : (u16)0;
      cf[4] = t.v;
    }
    u16* ydst = d ? p.ys5b() : p.ys5f();
    float hcr[2] = {0.f, 0.f}, hci[2] = {0.f, 0.f};
    for (int seg = 0; seg < 2; ++seg) {
      const int L = seg ? 2048 : 256;
      const int rowbase = seg ? b * 2048 : NLAT + b * 256;
      uint4 anext;
      {
        const int pos = n;
        const int t = d ? (L - 1 - pos) : pos;
        anext = *(const uint4*)(p.proj() + (size_t)(rowbase + t) * INC + g * 16 + 8 * hh);
      }
      for (int c0 = 0; c0 < L; c0 += 32) {
        const uint4 acur = anext;
        if (c0 + 32 < L) {
          const int pos = c0 + 32 + n;
          const int t = d ? (L - 1 - pos) : pos;
          anext = *(const uint4*)(p.proj() + (size_t)(rowbase + t) * INC + g * 16 + 8 * hh);
        }
        union { uint4 q; bf16x8 v; } af;
        af.q = acur;
        f32x16 acc[4];
#pragma unroll
        for (int nt = 0; nt < 4; ++nt) {
          f32x16 z;
#pragma unroll
          for (int r = 0; r < 16; ++r) z[r] = 0.f;
          acc[nt] = __builtin_amdgcn_mfma_f32_32x32x16_bf16(af.v, bfr[nt], z, 0, 0, 0);
        }
#pragma unroll
        for (int st = 0; st < 2; ++st)
#pragma unroll
          for (int gg = 0; gg < 4; ++gg)
#pragma unroll
            for (int j = 1; j < 4; ++j) {
              const float pr = acc[st][4 * gg + j - 1], pi = acc[2 + st][4 * gg + j - 1];
              acc[st][4 * gg + j] += ar[st][0] * pr - ai[st][0] * pi;
              acc[2 + st][4 * gg + j] += ar[st][0] * pi + ai[st][0] * pr;
            }
        float sr[2][4], si[2][4];
        {
          float e0r[2][4], e0i[2][4], qpr[2][4], qpi[2][4], s1r[2][4], s1i[2][4];
#pragma unroll
          for (int st = 0; st < 2; ++st)
#pragma unroll
            for (int gg = 0; gg < 4; ++gg) {
              e0r[st][gg] = __shfl_xor(acc[st][4 * gg + 3], 32, 64);
              e0i[st][gg] = __shfl_xor(acc[2 + st][4 * gg + 3], 32, 64);
            }
#pragma unroll
          for (int st = 0; st < 2; ++st) {
            float qr = hcr[st], qi = hci[st];
#pragma unroll
            for (int gg = 0; gg < 4; ++gg) {
              const float er = acc[st][4 * gg + 3], ei = acc[2 + st][4 * gg + 3];
              qpr[st][gg] = qr; qpi[st][gg] = qi;
              s1r[st][gg] = ar[st][3] * qr - ai[st][3] * qi + e0r[st][gg];
              s1i[st][gg] = ar[st][3] * qi + ai[st][3] * qr + e0i[st][gg];
              const float nqr = ar[st][3] * s1r[st][gg] - ai[st][3] * s1i[st][gg] + er;
              const float nqi = ar[st][3] * s1i[st][gg] + ai[st][3] * s1r[st][gg] + ei;
              qr = nqr; qi = nqi;
            }
            hcr[st] = qr; hci[st] = qi;
          }
#pragma unroll
          for (int st = 0; st < 2; ++st)
#pragma unroll
            for (int gg = 0; gg < 4; ++gg) {
              const float s0r = __shfl_xor(qpr[st][gg], 32, 64), s0i = __shfl_xor(qpi[st][gg], 32, 64);
              sr[st][gg] = hh ? s1r[st][gg] : s0r;
              si[st][gg] = hh ? s1i[st][gg] : s0i;
            }
        }
        if (seg) {
#pragma unroll
          for (int st = 0; st < 2; ++st)
#pragma unroll
            for (int gg = 0; gg < 4; ++gg)
#pragma unroll
              for (int j = 0; j < 4; ++j) {
                const float hr_ = acc[st][4 * gg + j] + ar[st][j] * sr[st][gg] - ai[st][j] * si[st][gg];
                const float hi_ = acc[2 + st][4 * gg + j] + ar[st][j] * si[st][gg] + ai[st][j] * sr[st][gg];
                const int tok = 8 * gg + 4 * hh + j;
                *(unsigned*)(H + tok * S5_LD + 2 * (st * 32 + n)) = pack2(hr_, hi_);
              }
          *(uint4*)(H + n * S5_LD + 128 + 8 * hh) = acur;
#pragma unroll
          for (int mt = 0; mt < 2; ++mt) {
            f32x4 y = (f32x4){0.f, 0.f, 0.f, 0.f};
#pragma unroll
            for (int kb = 0; kb < 5; ++kb) {
              const bf16x8 a = *(const bf16x8*)(H + (16 * mt + fr) * S5_LD + kb * 32 + fq * 8);
              y = __builtin_amdgcn_mfma_f32_16x16x32_bf16(a, cf[kb], y, 0, 0, 0);
            }
#pragma unroll
            for (int j = 0; j < 4; ++j) {
              const int pos = c0 + 16 * mt + 4 * fq + j;
              const int t = d ? (L - 1 - pos) : pos;
              ydst[(size_t)(b * 2048 + t) * 512 + g * 16 + fr] = f2bf(y[j]);
            }
          }
        }
      }
    }
  }
}

__device__ __forceinline__ float4 mix_load4(const u16* __restrict__ proj, size_t row, int col, const size_t* nrow,
                                            const bool* nval, float4 mu) {
  uint2 cz = *(const uint2*)(proj + row * INC + col);
  float z[4] = {bflo(cz.x), bfhi(cz.x), bflo(cz.y), bfhi(cz.y)};
  float o[4];
  float m[4] = {mu.x, mu.y, mu.z, mu.w};
#pragma unroll
  for (int j = 0; j < 4; ++j) {
    float nbv = 0.f;
    if (nval[j]) {
      u16 t = proj[nrow[j] * INC + col + j];
      nbv = bf2f(t);
    }
    o[j] = z[j] + (nbv - z[j]) * m[j];
  }
  return make_float4(o[0], o[1], o[2], o[3]);
}
__device__ __forceinline__ void neighbours(bool isctx, size_t row, int t, size_t* nrow, bool* nval) {
  if (isctx) {
    nrow[0] = row - 1; nval[0] = t > 0;
    nrow[1] = row + 1; nval[1] = t < 255;
    nrow[2] = row - 1; nval[2] = t > 0;
    nrow[3] = row + 1; nval[3] = t < 255;
  } else {
    int col = t & 63, gr = t >> 6;
    nrow[0] = row - 1; nval[0] = col > 0;
    nrow[1] = row + 1; nval[1] = col < 63;
    nrow[2] = row - 64; nval[2] = gr > 0;
    nrow[3] = row + 64; nval[3] = gr < 31;
  }
}

__device__ __forceinline__ void ph_rwscan(const P& p, char* smem, int bid, int nb) {
  const int tid = tidx(), sl = tid >> 8, stid = tid & 255, wv = stid >> 6, lane = tid & 63;
  char* sb = smem + sl * 49152;
  float* OPS = (float*)sb;
  float* LW = (float*)(sb + 24576);
  float* LA = LW + 512;
  float* WW = (float*)(sb + 28672);
  float* WA = WW + 2048;
  float* YB = (float*)(sb + 45056);
  const int tt = stid >> 4, part = stid & 15;
  const int vrow = wv * 16 + (lane >> 2), kq = lane & 3;
  for (int sp = bid; sp < 256; sp += nb) {
    const int s = sp * 2 + sl;
    const int d = s & 1, h = (s >> 1) & 7, b = s >> 4;
    __syncthreads();
    for (int e = stid; e < 2048; e += 256) {
      int j = e >> 6, cc = e & 63;
      WW[e] = p.rw_w_w2[(size_t)(d * 32 + j) * 512 + h * 64 + cc];
      WA[e] = p.rw_w_a2[(size_t)(d * 32 + j) * 512 + h * 64 + cc];
    }
    const int hc = h * 64 + part * 4;
    const float4 w0v = *(const float4*)(p.rw_w0 + d * 512 + hc);
    const float4 a0v = *(const float4*)(p.rw_a0 + d * 512 + hc);
    const float4 kkv = *(const float4*)(p.rw_k_k + hc);
    const float4 kav = *(const float4*)(p.rw_k_a + hc);
    const float4 rkv = *(const float4*)(p.rw_r_k + hc);
    const float4 mur = *(const float4*)(p.rw_mu + hc);
    const float4 muk = *(const float4*)(p.rw_mu + 512 + hc);
    const float4 muv = *(const float4*)(p.rw_mu + 1024 + hc);
    const float4 mul = *(const float4*)(p.rw_mu + 1536 + part * 4);
    u16* ydst = d ? p.yrwb() : p.yrwf();
    float S[16];
#pragma unroll
    for (int i = 0; i < 16; ++i) S[i] = 0.f;
    for (int seg = 0; seg < 2; ++seg) {
      const int L = seg ? 2048 : 256;
      const size_t rowbase = seg ? (size_t)b * 2048 : (size_t)NLAT + b * 256;
      for (int c0 = 0; c0 < L; c0 += 16) {
        const int pos = c0 + tt;
        const int t = d ? (L - 1 - pos) : pos;
        const size_t row = rowbase + t;
        size_t nrow[4];
        bool nval[4];
        neighbours(seg == 0, row, t, nrow, nval);
        float4 r4 = mix_load4(p.proj(), row, 512 + hc, nrow, nval, mur);
        float4 k4 = mix_load4(p.proj(), row, 512 + 512 + hc, nrow, nval, muk);
        float4 v4 = mix_load4(p.proj(), row, 512 + 1024 + hc, nrow, nval, muv);
        float4 l4 = mix_load4(p.proj(), row, 512 + 1536 + part * 4, nrow, nval, mul);
        if (part < 8) {
          *(float4*)(LW + tt * 32 + part * 4) = make_float4(tanhf(l4.x), tanhf(l4.y), tanhf(l4.z), tanhf(l4.w));
        } else {
          *(float4*)(LA + tt * 32 + (part - 8) * 4) = l4;
        }
        __syncthreads();
        float wp[4] = {w0v.x, w0v.y, w0v.z, w0v.w};
        float ap[4] = {a0v.x, a0v.y, a0v.z, a0v.w};
#pragma unroll 8
        for (int j = 0; j < 32; ++j) {
          float lw = LW[tt * 32 + j], la = LA[tt * 32 + j];
          float4 ww = *(const float4*)(WW + j * 64 + part * 4);
          float4 wa = *(const float4*)(WA + j * 64 + part * 4);
          wp[0] += lw * ww.x; wp[1] += lw * ww.y; wp[2] += lw * ww.z; wp[3] += lw * ww.w;
          ap[0] += la * wa.x; ap[1] += la * wa.y; ap[2] += la * wa.z; ap[3] += la * wa.w;
        }
        float rr[4] = {r4.x, r4.y, r4.z, r4.w}, kk4[4] = {k4.x, k4.y, k4.z, k4.w};
        float kkc[4] = {kkv.x, kkv.y, kkv.z, kkv.w}, kac[4] = {kav.x, kav.y, kav.z, kav.w}, rkc[4] = {rkv.x, rkv.y, rkv.z, rkv.w};
        float dec[4], aa[4], kd[4], kkr[4];
        float ss = 0.f, bon = 0.f;
#pragma unroll
        for (int i = 0; i < 4; ++i) {
          float xw = -wp[i];
          float sp_ = fmaxf(xw, 0.f) + log1pf(expf(-fabsf(xw)));
          float wl = -sp_ - 0.5f;
          dec[i] = expf(-expf(wl));
          aa[i] = 1.f / (1.f + expf(-ap[i]));
          kd[i] = kk4[i] * (1.f + (aa[i] - 1.f) * kac[i]);
          kkr[i] = kk4[i] * kkc[i];
          ss += kkr[i] * kkr[i];
          bon += rr[i] * kd[i] * rkc[i];
        }
#pragma unroll
        for (int m = 0; m < 4; ++m) {
          ss = dpp_add(ss, m, 0);
          bon = dpp_add(bon, m, 0);
        }
        float inv = rsqrtf(ss + 1e-12f);
        float* o = OPS + tt * 384 + part * 4;
        *(float4*)(o + 0) = r4;
        *(float4*)(o + 64) = make_float4(dec[0], dec[1], dec[2], dec[3]);
        *(float4*)(o + 128) = make_float4(kd[0], kd[1], kd[2], kd[3]);
        *(float4*)(o + 192) = make_float4(-kkr[0] * inv, -kkr[1] * inv, -kkr[2] * inv, -kkr[3] * inv);
        *(float4*)(o + 256) = make_float4(kkr[0] * inv * aa[0], kkr[1] * inv * aa[1], kkr[2] * inv * aa[2], kkr[3] * inv * aa[3]);
        *(float4*)(o + 320) = v4;
        if (seg && part == 0) p.bsc()[((size_t)d * NLAT + row) * 8 + h] = bon;
        __syncthreads();
        for (int i = 0; i < 16; ++i) {
          const float* oo = OPS + i * 384 + kq * 16;
          float kn[16], wv_[16], bv[16], kdv[16];
#pragma unroll
          for (int q = 0; q < 4; ++q) {
            float4 a = *(const float4*)(oo + 192 + q * 4);
            kn[q * 4] = a.x; kn[q * 4 + 1] = a.y; kn[q * 4 + 2] = a.z; kn[q * 4 + 3] = a.w;
            float4 w_ = *(const float4*)(oo + 64 + q * 4);
            wv_[q * 4] = w_.x; wv_[q * 4 + 1] = w_.y; wv_[q * 4 + 2] = w_.z; wv_[q * 4 + 3] = w_.w;
            float4 b_ = *(const float4*)(oo + 256 + q * 4);
            bv[q * 4] = b_.x; bv[q * 4 + 1] = b_.y; bv[q * 4 + 2] = b_.z; bv[q * 4 + 3] = b_.w;
            float4 k_ = *(const float4*)(oo + 128 + q * 4);
            kdv[q * 4] = k_.x; kdv[q * 4 + 1] = k_.y; kdv[q * 4 + 2] = k_.z; kdv[q * 4 + 3] = k_.w;
          }
          float vv = OPS[i * 384 + 320 + vrow];
          float s0 = 0.f, s1 = 0.f, s2 = 0.f, s3 = 0.f;
#pragma unroll
          for (int q = 0; q < 16; q += 4) {
            s0 += S[q] * kn[q]; s1 += S[q + 1] * kn[q + 1]; s2 += S[q + 2] * kn[q + 2]; s3 += S[q + 3] * kn[q + 3];
          }
          float sa = (s0 + s1) + (s2 + s3);
          sa = dpp_add(sa, 0, 0);
          sa = dpp_add(sa, 1, 0);
#pragma unroll
          for (int q = 0; q < 16; ++q) S[q] = S[q] * wv_[q] + sa * bv[q] + vv * kdv[q];
          if (seg) {
            float rv[16];
#pragma unroll
            for (int q = 0; q < 4; ++q) {
              float4 a = *(const float4*)(oo + q * 4);
              rv[q * 4] = a.x; rv[q * 4 + 1] = a.y; rv[q * 4 + 2] = a.z; rv[q * 4 + 3] = a.w;
            }
            float y0 = 0.f, y1 = 0.f, y2 = 0.f, y3 = 0.f;
#pragma unroll
            for (int q = 0; q < 16; q += 4) {
              y0 += S[q] * rv[q]; y1 += S[q + 1] * rv[q + 1]; y2 += S[q + 2] * rv[q + 2]; y3 += S[q + 3] * rv[q + 3];
            }
            float y = (y0 + y1) + (y2 + y3);
            y = dpp_add(y, 0, 0);
            y = dpp_add(y, 1, 0);
            if (kq == 0) YB[i * 64 + vrow] = y;
          }
        }
        __syncthreads();
        if (seg) {
          float4 yv = *(const float4*)(YB + tt * 64 + part * 4);
          uint2 o2;
          o2.x = pack2(yv.x, yv.y); o2.y = pack2(yv.z, yv.w);
          *(uint2*)(ydst + row * 512 + hc) = o2;
        }
      }
    }
  }
}

#define RW_AR_LD 68
#define RW_RM_LD 72
#define RW_SLOT_BYTES 11776
#define RW_SCR_BYTES 9216
#define RW_STREAM_BYTES (4 * RW_SLOT_BYTES + 3 * RW_SCR_BYTES + 2304)
__device__ __forceinline__ unsigned cvtpk(float lo, float hi) { return pack2(lo, hi); }
__device__ __forceinline__ float dpp_shr_add(float v, const int n) {
  int m;
  switch (n) {
    case 1: m = __builtin_amdgcn_update_dpp(0, __float_as_int(v), 0x111, 0xf, 0xf, true); break;
    case 2: m = __builtin_amdgcn_update_dpp(0, __float_as_int(v), 0x112, 0xf, 0xf, true); break;
    case 4: m = __builtin_amdgcn_update_dpp(0, __float_as_int(v), 0x114, 0xf, 0xf, true); break;
    default: m = __builtin_amdgcn_update_dpp(0, __float_as_int(v), 0x118, 0xf, 0xf, true); break;
  }
  return v + __int_as_float(m);
}
__device__ __forceinline__ int opaque(int x) { asm volatile("" : "+v"(x)); return x; }
__device__ __forceinline__ float fsig(float x) { return __builtin_amdgcn_rcpf(1.f + __expf(-x)); }

__device__ __forceinline__ void ph_rwscan2(const P& p, char* smem, int bid, int nb) {
  const int tid = tidx(), wid = tid >> 6, lane = tid & 63, sl = wid >> 2, wv = wid & 3;
  char* sb = smem + sl * RW_STREAM_BYTES;
  float* CST = (float*)(sb + 4 * RW_SLOT_BYTES + 3 * RW_SCR_BYTES);
  const int NCH = 144;
  for (int sp = bid; sp < 256; sp += nb) {
    const int s = sp * 2 + sl;
    const int d = s & 1, h = (s >> 1) & 7, b = s >> 4;
    __syncthreads();
    if (wv == 0) {
      const int cc = lane;
      CST[0 * 64 + cc] = p.rw_w0[d * 512 + h * 64 + cc];
      CST[1 * 64 + cc] = p.rw_a0[d * 512 + h * 64 + cc];
      CST[2 * 64 + cc] = p.rw_k_k[h * 64 + cc];
      CST[3 * 64 + cc] = p.rw_k_a[h * 64 + cc];
      CST[4 * 64 + cc] = p.rw_r_k[h * 64 + cc];
      CST[5 * 64 + cc] = p.rw_mu[h * 64 + cc];
      CST[6 * 64 + cc] = p.rw_mu[512 + h * 64 + cc];
      CST[7 * 64 + cc] = p.rw_mu[1024 + h * 64 + cc];
      CST[8 * 64 + cc] = p.rw_mu[1536 + cc];
    }
    __syncthreads();
    if (wv == 0) {
      const int v32 = lane & 31, hh = lane >> 5;
      u16* ydst = d ? p.yrwb() : p.yrwf();
      f32x16 X[2][2];
#pragma unroll
      for (int mt = 0; mt < 2; ++mt)
#pragma unroll
        for (int vt = 0; vt < 2; ++vt)
#pragma unroll
          for (int r = 0; r < 16; ++r) X[mt][vt][r] = 0.f;
      for (int tick = 0; tick < NCH + 4; ++tick) {
        if (tick >= 3 + sl && tick - 3 - sl < NCH) {
          const int c = tick - 3 - sl;
          const char* slot = sb + (c & 3) * RW_SLOT_BYTES;
          const u16* AR = (const u16*)slot;
          const u16* MG = (const u16*)(slot + 4352);
          const u16* BT = (const u16*)(slot + 5376);
          const u16* KT = (const u16*)(slot + 7424);
          const u16* VT = (const u16*)(slot + 9472);
          const float* WC = (const float*)(slot + 11520);
          {
            const char* scr = sb + 4 * RW_SLOT_BYTES + (c % 3) * RW_SCR_BYTES;
            const u16* RHs = (const u16*)scr + 16 * RW_RM_LD;
            const float* AAv = (const float*)((const u16*)scr + 32 * RW_RM_LD);
            const float* Arb = AAv + 512;
            const float* Ark = AAv + 768;
            u16* ARw = (u16*)slot;
            u16* MGw = (u16*)(slot + 4352);
            const int ol = opaque(lane), oj = opaque(lane & 15);
            v2f am[16];
#pragma unroll
            for (int tt = 0; tt < 16; ++tt) {
              const int m0 = 8 * (tt >> 2) + (tt & 3);
              am[tt] = (v2f){bf2f(ARw[ol + m0 * RW_AR_LD]), bf2f(MGw[oj + m0 * 16])};
            }
#pragma unroll
            for (int tt = 0; tt < 16; ++tt) {
              v2f acc = (v2f){bf2f(RHs[ol + tt * RW_RM_LD]), Ark[oj + tt * 16]};
#pragma unroll
              for (int i4 = 0; i4 < (tt + 4) / 4; ++i4) {
                const float4 s4 = *(const float4*)(Arb + tt * 16 + 4 * i4);
                const float sv[4] = {s4.x, s4.y, s4.z, s4.w};
#pragma unroll
                for (int q = 0; q < 4; ++q) {
                  const int i = 4 * i4 + q;
                  if (i <= tt) acc += sv[q] * am[i];
                }
              }
              const int m0 = 8 * (tt >> 2) + (tt & 3);
              ARw[ol + (m0 + 4) * RW_AR_LD] = f2bf(acc[0]);
              if (lane < 16) MGw[oj + (m0 + 4) * 16] = f2bf(acc[1]);
            }
          }
          bf16x8 vtf[2];
#pragma unroll
          for (int vt = 0; vt < 2; ++vt) vtf[vt] = *(const bf16x8*)(VT + (32 * vt + v32) * 16 + 8 * hh);
          f32x16 UY[2];
#pragma unroll
          for (int vt = 0; vt < 2; ++vt)
#pragma unroll
            for (int r = 0; r < 16; ++r) UY[vt][r] = 0.f;
          {
            const bf16x8 mgf = *(const bf16x8*)(MG + v32 * 16 + 8 * hh);
#pragma unroll
            for (int vt = 0; vt < 2; ++vt) UY[vt] = __builtin_amdgcn_mfma_f32_32x32x16_bf16(mgf, vtf[vt], UY[vt], 0, 0, 0);
          }
#pragma unroll
          for (int mt = 0; mt < 2; ++mt)
#pragma unroll
            for (int ks = 0; ks < 2; ++ks) {
              const int base = 32 * mt + 16 * ks + 4 * hh;
              const uint2 a0 = *(const uint2*)(AR + v32 * RW_AR_LD + base);
              const uint2 a1 = *(const uint2*)(AR + v32 * RW_AR_LD + base + 8);
              union { unsigned u[4]; bf16x8 v; } af;
              af.u[0] = a0.x; af.u[1] = a0.y; af.u[2] = a1.x; af.u[3] = a1.y;
#pragma unroll
              for (int vt = 0; vt < 2; ++vt) {
                union { unsigned u[4]; bf16x8 v; } xf;
#pragma unroll
                for (int q = 0; q < 4; ++q) xf.u[q] = cvtpk(X[mt][vt][8 * ks + 2 * q], X[mt][vt][8 * ks + 2 * q + 1]);
                UY[vt] = __builtin_amdgcn_mfma_f32_32x32x16_bf16(af.v, xf.v, UY[vt], 0, 0, 0);
              }
            }
          if (c >= 16 && hh == 1) {
#pragma unroll
            for (int r = 0; r < 16; ++r) {
              const int pos = (c - 16) * 16 + r;
              const int tok = d ? (2047 - pos) : pos;
              u16* yp = ydst + ((size_t)b * 2048 + tok) * 512 + h * 64 + v32;
              yp[0] = f2bf(UY[0][r]);
              yp[32] = f2bf(UY[1][r]);
            }
          }
          bf16x8 uyf[2][2];
#pragma unroll
          for (int vt = 0; vt < 2; ++vt)
#pragma unroll
            for (int ks = 0; ks < 2; ++ks) {
              union { unsigned u[4]; bf16x8 v; } t_;
#pragma unroll
              for (int q = 0; q < 4; ++q) t_.u[q] = cvtpk(UY[vt][8 * ks + 2 * q], UY[vt][8 * ks + 2 * q + 1]);
              uyf[vt][ks] = t_.v;
            }
#pragma unroll
          for (int mt = 0; mt < 2; ++mt) {
            const int krow = 32 * mt + v32;
            const bf16x8 ktf = *(const bf16x8*)(KT + krow * 16 + 8 * hh);
            bf16x8 btf[2];
#pragma unroll
            for (int ks = 0; ks < 2; ++ks) {
              btf[ks] = *(const bf16x8*)(BT + krow * 16 + 8 * ks);
              if (hh) btf[ks] = (bf16x8){0, 0, 0, 0, 0, 0, 0, 0};
            }
#pragma unroll
            for (int vt = 0; vt < 2; ++vt) {
              X[mt][vt] = __builtin_amdgcn_mfma_f32_32x32x16_bf16(ktf, vtf[vt], X[mt][vt], 0, 0, 0);
#pragma unroll
              for (int ks = 0; ks < 2; ++ks) X[mt][vt] = __builtin_amdgcn_mfma_f32_32x32x16_bf16(btf[ks], uyf[vt][ks], X[mt][vt], 0, 0, 0);
            }
#pragma unroll
            for (int g = 0; g < 4; ++g) {
              const float4 w4 = *(const float4*)(WC + 32 * mt + 8 * g + 4 * hh);
#pragma unroll
              for (int vt = 0; vt < 2; ++vt) {
                X[mt][vt][4 * g + 0] *= w4.x; X[mt][vt][4 * g + 1] *= w4.y;
                X[mt][vt][4 * g + 2] *= w4.z; X[mt][vt][4 * g + 3] *= w4.w;
              }
            }
          }
        }
        __syncthreads();
      }
    } else {
      const int pw = wv - 1;
      const int t = lane & 15, kq = lane >> 4;
      char* scr = sb + 4 * RW_SLOT_BYTES + pw * RW_SCR_BYTES;
      u16* AL = (u16*)scr;
      u16* RH = AL + 16 * RW_RM_LD;
      u16* BE = RH + 16 * RW_RM_LD;
      u16* KA = BE + 16 * RW_RM_LD;
      float* AAs = (float*)BE;
      const int o_kq4 = opaque(4 * kq);
      const int o_tr = opaque(64 * kq + t);
      const int o_rm = opaque(t * RW_RM_LD + 4 * kq);
      const int o_l = opaque(lane);
      const int o_j = opaque(lane & 15);
      const float* cstl = CST + o_kq4;
      bf16x8 wwf[4], waf[4];
      {
        const int o_wl = (((d * 8 + h) * 4) * 64 + lane) * 8;
#pragma unroll
        for (int mt = 0; mt < 4; ++mt) {
          wwf[mt] = *(const bf16x8*)(p.wlf() + o_wl + mt * 512);
          waf[mt] = *(const bf16x8*)(p.wlf() + o_wl + 32768 + mt * 512);
        }
      }
      for (int i = 0; i < pw + sl; ++i) __syncthreads();
      for (int c = pw; c < NCH; c += 3) {
        char* slot = sb + (c & 3) * RW_SLOT_BYTES;
        u16* AR = (u16*)slot;
        u16* MG = (u16*)(slot + 4352);
        u16* BT = (u16*)(slot + 5376);
        u16* KT = (u16*)(slot + 7424);
        u16* VT = (u16*)(slot + 9472);
        float* WC = (float*)(slot + 11520);
        const bool lat = c >= 16;
        const int L = lat ? 2048 : 256;
        const int pos = (lat ? (c - 16) : c) * 16 + t;
        const int tok = d ? (L - 1 - pos) : pos;
        const size_t row = (lat ? (size_t)b * 2048 : (size_t)NLAT + (size_t)b * 256) + tok;
        const u16* cbase = p.proj() + row * INC + 512;
        const u16* nbase[4];
        float nmask[4];
        {
          size_t nrow[4];
          bool nval[4];
          neighbours(!lat, row, tok, nrow, nval);
#pragma unroll
          for (int j = 0; j < 4; ++j) {
            nbase[j] = p.proj() + (nval[j] ? nrow[j] : row) * INC + 512 + j;
            nmask[j] = nval[j] ? 1.f : 0.f;
          }
        }
        bf16x8 lwf, laf;
        {
          const int colw = 1536 + 8 * kq, cola = 1568 + 8 * kq;
          const uint4 cw = *(const uint4*)(cbase + colw), ca = *(const uint4*)(cbase + cola);
          const unsigned cwu[4] = {cw.x, cw.y, cw.z, cw.w}, cau[4] = {ca.x, ca.y, ca.z, ca.w};
          float lw[8], la[8];
          const float4 ml0 = *(const float4*)(cstl + o_kq4 + 8 * 64), ml1 = *(const float4*)(cstl + o_kq4 + 8 * 64 + 4);
          const float4 ma0 = *(const float4*)(cstl + o_kq4 + 8 * 64 + 32), ma1 = *(const float4*)(cstl + o_kq4 + 8 * 64 + 32 + 4);
          const float mul_[8] = {ml0.x, ml0.y, ml0.z, ml0.w, ml1.x, ml1.y, ml1.z, ml1.w};
          const float mua_[8] = {ma0.x, ma0.y, ma0.z, ma0.w, ma1.x, ma1.y, ma1.z, ma1.w};
#pragma unroll
          for (int q = 0; q < 8; ++q) {
            const float zw = (q & 1) ? bfhi(cwu[q >> 1]) : bflo(cwu[q >> 1]);
            const float za = (q & 1) ? bfhi(cau[q >> 1]) : bflo(cau[q >> 1]);
            const float nw = bf2f(nbase[q & 3][colw + (q & 4)]) * nmask[q & 3];
            const float na = bf2f(nbase[q & 3][cola + (q & 4)]) * nmask[q & 3];
            lw[q] = 1.f - 2.f * __builtin_amdgcn_rcpf(1.f + __expf(2.f * (zw + (nw - zw) * mul_[q])));
            la[q] = za + (na - za) * mua_[q];
          }
          union { unsigned u[4]; bf16x8 v; } tw, ta;
#pragma unroll
          for (int q = 0; q < 4; ++q) { tw.u[q] = pack2(lw[2 * q], lw[2 * q + 1]); ta.u[q] = pack2(la[2 * q], la[2 * q + 1]); }
          lwf = tw.v; laf = ta.v;
        }
        float ee[16];
        unsigned rrp[8], aap[8], kxp[8];
        {
          const u16* cb2 = cbase + h * 64 + 4 * kq;
          const u16* nb2[4] = {nbase[0] + h * 64 + 4 * kq, nbase[1] + h * 64 + 4 * kq, nbase[2] + h * 64 + 4 * kq, nbase[3] + h * 64 + 4 * kq};
#pragma unroll
          for (int mt = 0; mt < 4; ++mt) {
            const float4 mr = *(const float4*)(cstl + 5 * 64 + 16 * mt), mk = *(const float4*)(cstl + 6 * 64 + 16 * mt), mv = *(const float4*)(cstl + 7 * 64 + 16 * mt);
            const float mrv[4] = {mr.x, mr.y, mr.z, mr.w}, mkv[4] = {mk.x, mk.y, mk.z, mk.w}, mvv[4] = {mv.x, mv.y, mv.z, mv.w};
            const uint2 cr = *(const uint2*)(cb2 + 16 * mt), ck = *(const uint2*)(cb2 + 512 + 16 * mt), cv = *(const uint2*)(cb2 + 1024 + 16 * mt);
            const float zr[4] = {bflo(cr.x), bfhi(cr.x), bflo(cr.y), bfhi(cr.y)};
            const float zk[4] = {bflo(ck.x), bfhi(ck.x), bflo(ck.y), bfhi(ck.y)};
            const float zv[4] = {bflo(cv.x), bfhi(cv.x), bflo(cv.y), bfhi(cv.y)};
            float kxv[4], rrv[4], aav[4];
#pragma unroll
            for (int j = 0; j < 4; ++j) {
              const float nr = bf2f(nb2[j][16 * mt]) * nmask[j];
              const float nk = bf2f(nb2[j][512 + 16 * mt]) * nmask[j];
              const float nv = bf2f(nb2[j][1024 + 16 * mt]) * nmask[j];
              rrv[j] = zr[j] + (nr - zr[j]) * mrv[j];
              kxv[j] = zk[j] + (nk - zk[j]) * mkv[j];
              VT[o_tr + (16 * mt + j) * 16] = f2bf(zv[j] + (nv - zv[j]) * mvv[j]);
            }
            const f32x4 z4 = (f32x4){0.f, 0.f, 0.f, 0.f};
            const f32x4 aw = __builtin_amdgcn_mfma_f32_16x16x32_bf16(wwf[mt], lwf, z4, 0, 0, 0);
            const f32x4 a2 = __builtin_amdgcn_mfma_f32_16x16x32_bf16(waf[mt], laf, z4, 0, 0, 0);
            const float4 w0 = *(const float4*)(cstl + 0 * 64 + 16 * mt), a0 = *(const float4*)(cstl + 1 * 64 + 16 * mt);
            ee[4 * mt] = 0.60653066f * fsig(w0.x + aw[0]); ee[4 * mt + 1] = 0.60653066f * fsig(w0.y + aw[1]);
            ee[4 * mt + 2] = 0.60653066f * fsig(w0.z + aw[2]); ee[4 * mt + 3] = 0.60653066f * fsig(w0.w + aw[3]);
            aav[0] = fsig(a0.x + a2[0]); aav[1] = fsig(a0.y + a2[1]);
            aav[2] = fsig(a0.z + a2[2]); aav[3] = fsig(a0.w + a2[3]);
            rrp[2 * mt] = pack2(rrv[0], rrv[1]); rrp[2 * mt + 1] = pack2(rrv[2], rrv[3]);
            aap[2 * mt] = pack2(aav[0], aav[1]); aap[2 * mt + 1] = pack2(aav[2], aav[3]);
            kxp[2 * mt] = pack2(kxv[0], kxv[1]); kxp[2 * mt + 1] = pack2(kxv[2], kxv[3]);
          }
        }
        __syncthreads();
        float kdf[16], kkf[16];
        float inv;
        {
          float ss = 0.f, bon = 0.f;
#pragma unroll
          for (int mt = 0; mt < 4; ++mt) {
            const float4 c2 = *(const float4*)(cstl + 2 * 64 + 16 * mt), c3 = *(const float4*)(cstl + 3 * 64 + 16 * mt), c4 = *(const float4*)(cstl + 4 * 64 + 16 * mt);
            const float kkc[4] = {c2.x, c2.y, c2.z, c2.w}, kac[4] = {c3.x, c3.y, c3.z, c3.w}, rkc[4] = {c4.x, c4.y, c4.z, c4.w};
#pragma unroll
            for (int j = 0; j < 4; ++j) {
              const int e = 4 * mt + j;
              const float kx = (e & 1) ? bfhi(kxp[e >> 1]) : bflo(kxp[e >> 1]);
              const float av = (e & 1) ? bfhi(aap[e >> 1]) : bflo(aap[e >> 1]);
              const float rv = (e & 1) ? bfhi(rrp[e >> 1]) : bflo(rrp[e >> 1]);
              kdf[e] = kx * (1.f + (av - 1.f) * kac[j]);
              kkf[e] = kx * kkc[j];
              ss += kkf[e] * kkf[e];
              bon += rv * kdf[e] * rkc[j];
            }
          }
          ss += __shfl_xor(ss, 16, 64); ss += __shfl_xor(ss, 32, 64);
          bon += __shfl_xor(bon, 16, 64); bon += __shfl_xor(bon, 32, 64);
          inv = rsqrtf(ss + 1e-12f);
          if (lat && kq == 0) p.bsc()[((size_t)d * NLAT + row) * 8 + h] = bon;
        }
#pragma unroll
        for (int mt = 0; mt < 4; ++mt) {
          float al4[4], rh4[4], be4[4], ka4[4];
#pragma unroll
          for (int j = 0; j < 4; ++j) {
            const int e = 4 * mt + j;
            float cs = ee[e];
            cs = dpp_shr_add(cs, 1); cs = dpp_shr_add(cs, 2); cs = dpp_shr_add(cs, 4); cs = dpp_shr_add(cs, 8);
            const float Ep = __expf(cs), Em = __builtin_amdgcn_rcpf(Ep), Ex = __expf(ee[e] - cs);
            const float kkn = kkf[e] * inv;
            al4[j] = -kkn * Ex;
            be4[j] = kkn * ((e & 1) ? bfhi(aap[e >> 1]) : bflo(aap[e >> 1])) * Ep;
            ka4[j] = kdf[e] * Ep;
            rh4[j] = ((e & 1) ? bfhi(rrp[e >> 1]) : bflo(rrp[e >> 1])) * Em;
            BT[o_tr + (16 * mt + j) * 16] = f2bf(be4[j]);
            KT[o_tr + (16 * mt + j) * 16] = f2bf(ka4[j]);
            if (t == 15) WC[o_kq4 + 16 * mt + j] = Em;
          }
          const int ko = o_rm + 16 * mt;
          *(uint2*)(AL + ko) = make_uint2(pack2(al4[0], al4[1]), pack2(al4[2], al4[3]));
          *(uint2*)(RH + ko) = make_uint2(pack2(rh4[0], rh4[1]), pack2(rh4[2], rh4[3]));
          *(uint2*)(BE + ko) = make_uint2(pack2(be4[0], be4[1]), pack2(be4[2], be4[3]));
          *(uint2*)(KA + ko) = make_uint2(pack2(ka4[0], ka4[1]), pack2(ka4[2], ka4[3]));
        }
        {
          const int m = lane & 31, hh = lane >> 5;
          const int typ = (m >> 2) & 1, tt = 4 * (m >> 3) + (m & 3);
          const u16* arow = (typ ? RH : AL) + tt * RW_RM_LD + 8 * hh;
          const u16* brow = ((m >> 4) ? KA : BE) + (m & 15) * RW_RM_LD + 8 * hh;
          f32x16 aa;
#pragma unroll
          for (int r = 0; r < 16; ++r) aa[r] = 0.f;
#pragma unroll
          for (int ks = 0; ks < 4; ++ks) {
            const bf16x8 af = *(const bf16x8*)(arow + 16 * ks);
            const bf16x8 bf_ = *(const bf16x8*)(brow + 16 * ks);
            aa = __builtin_amdgcn_mfma_f32_32x32x16_bf16(af, bf_, aa, 0, 0, 0);
          }
          const int i = m & 15;
          const int o_aa = opaque((hh * 2 + (m >> 4)) * 256 + i);
#pragma unroll
          for (int r = 0; r < 16; ++r) {
            const bool keep = hh ? (i <= r) : (i < r);
            AAs[o_aa + r * 16] = keep ? aa[r] : 0.f;
          }
        }
        __syncthreads();
        {
          const float* Aab = AAs;
          const float* Aak = AAs + 256;
          const float* Arb = AAs + 512;
          const float* Ark = AAs + 768;
          v2f am[16];
#pragma unroll
          for (int tt = 0; tt < 16; ++tt) {
            v2f acc = (v2f){bf2f(AL[o_l + tt * RW_RM_LD]), Aak[o_j + tt * 16]};
#pragma unroll
            for (int i4 = 0; i4 < (tt + 3) / 4; ++i4) {
              const float4 s4 = *(const float4*)(Aab + tt * 16 + 4 * i4);
              const float sv[4] = {s4.x, s4.y, s4.z, s4.w};
#pragma unroll
              for (int q = 0; q < 4; ++q) {
                const int i = 4 * i4 + q;
                if (i < tt) acc += sv[q] * am[i];
              }
            }
            am[tt] = acc;
          }
#pragma unroll
          for (int tt = 0; tt < 16; ++tt) {
            const int m0 = 8 * (tt >> 2) + (tt & 3);
            AR[o_l + m0 * RW_AR_LD] = f2bf(am[tt][0]);
            if (lane < 16) MG[o_j + m0 * 16] = f2bf(am[tt][1]);
          }
        }
        __syncthreads();
      }
      for (int i = 0; i < 4 - pw - sl; ++i) __syncthreads();
    }
  }
}

struct MixLd {
  uint4 s5f, s5b, rwf, rwb, vc, gc;
  u16 vn[8], gn[8];
  float bs0, bs1;
};
__device__ __forceinline__ void mix_load(const P& p, int row, int lane, MixLd& L, float (&nmask)[4]) {
  const int c8 = lane * 8, t = row & 2047;
  L.s5f = *(const uint4*)(p.ys5f() + (size_t)row * 512 + c8);
  L.s5b = *(const uint4*)(p.ys5b() + (size_t)row * 512 + c8);
  L.rwf = *(const uint4*)(p.yrwf() + (size_t)row * 512 + c8);
  L.rwb = *(const uint4*)(p.yrwb() + (size_t)row * 512 + c8);
  size_t nrow[4];
  bool nval[4];
  neighbours(false, (size_t)row, t, nrow, nval);
  const u16* nb_[4];
#pragma unroll
  for (int j = 0; j < 4; ++j) { nb_[j] = p.proj() + (nval[j] ? nrow[j] : (size_t)row) * INC + 512 + j; nmask[j] = nval[j] ? 1.f : 0.f; }
  const u16* cb = p.proj() + (size_t)row * INC + 512;
  L.vc = *(const uint4*)(cb + 1024 + c8);
#pragma unroll
  for (int i = 0; i < 8; ++i) L.vn[i] = nb_[i & 3][1024 + c8 + (i & 4)];
  const int g8 = (lane < 12) ? c8 : 0;
  L.gc = *(const uint4*)(cb + 1600 + g8);
#pragma unroll
  for (int i = 0; i < 8; ++i) L.gn[i] = nb_[i & 3][1600 + g8 + (i & 4)];
  const int head = lane >> 3;
  L.bs0 = p.bsc()[(size_t)row * 8 + head];
  L.bs1 = p.bsc()[((size_t)NLAT + row) * 8 + head];
}
__device__ __forceinline__ void mix_compute(const P& p, int row, int lane, const MixLd& L, const float (&nmask)[4], u16* y1dst, u16* t1dst) {
  const int c8 = lane * 8;
  {
    const unsigned au[4] = {L.s5f.x, L.s5f.y, L.s5f.z, L.s5f.w}, bu[4] = {L.s5b.x, L.s5b.y, L.s5b.z, L.s5b.w};
    unsigned ou[4];
#pragma unroll
    for (int q = 0; q < 4; ++q) ou[q] = pack2(gelu_as(bflo(au[q]) + bflo(bu[q])), gelu_as(bfhi(au[q]) + bfhi(bu[q])));
    *(uint4*)(y1dst + (size_t)row * 512 + c8) = make_uint4(ou[0], ou[1], ou[2], ou[3]);
  }
  float y[8];
  {
    const unsigned au[4] = {L.rwf.x, L.rwf.y, L.rwf.z, L.rwf.w}, bu[4] = {L.rwb.x, L.rwb.y, L.rwb.z, L.rwb.w};
#pragma unroll
    for (int q = 0; q < 4; ++q) { y[2 * q] = bflo(au[q]) + bflo(bu[q]); y[2 * q + 1] = bfhi(au[q]) + bfhi(bu[q]); }
  }
  float sm = 0.f;
#pragma unroll
  for (int i = 0; i < 8; ++i) sm += y[i];
  sm = dpp_add(sm, 0, 0); sm = dpp_add(sm, 1, 0); sm = dpp_add(sm, 2, 0);
  const float mu = sm * (1.f / 64.f);
  float sv = 0.f;
#pragma unroll
  for (int i = 0; i < 8; ++i) sv += (y[i] - mu) * (y[i] - mu);
  sv = dpp_add(sv, 0, 0); sv = dpp_add(sv, 1, 0); sv = dpp_add(sv, 2, 0);
  const float rs = rsqrtf(sv * (1.f / 64.f) + 64e-5f);
  float v[8];
  {
    const unsigned cu[4] = {L.vc.x, L.vc.y, L.vc.z, L.vc.w};
    const float4 m0 = *(const float4*)(p.rw_mu + 1024 + c8), m1 = *(const float4*)(p.rw_mu + 1024 + c8 + 4);
    const float mm[8] = {m0.x, m0.y, m0.z, m0.w, m1.x, m1.y, m1.z, m1.w};
#pragma unroll
    for (int i = 0; i < 8; ++i) {
      const float z = (i & 1) ? bfhi(cu[i >> 1]) : bflo(cu[i >> 1]);
      const float nbv = bf2f(L.vn[i]) * nmask[i & 3];
      v[i] = z + (nbv - z) * mm[i];
    }
  }
  const float bs = L.bs0 + L.bs1;
  {
    const float4 w0 = *(const float4*)(p.rw_ln_w + c8), w1 = *(const float4*)(p.rw_ln_w + c8 + 4);
    const float4 b0 = *(const float4*)(p.rw_ln_b + c8), b1 = *(const float4*)(p.rw_ln_b + c8 + 4);
    const float lw[8] = {w0.x, w0.y, w0.z, w0.w, w1.x, w1.y, w1.z, w1.w};
    const float lb[8] = {b0.x, b0.y, b0.z, b0.w, b1.x, b1.y, b1.z, b1.w};
    float o[8];
#pragma unroll
    for (int i = 0; i < 8; ++i) o[i] = (y[i] - mu) * rs * lw[i] + lb[i] + bs * v[i];
    *(uint4*)(t1dst + (size_t)row * 512 + c8) = make_uint4(pack2(o[0], o[1]), pack2(o[2], o[3]), pack2(o[4], o[5]), pack2(o[6], o[7]));
  }
  if (lane < 32) {
    unsigned ou[4] = {0u, 0u, 0u, 0u};
    if (lane < 12) {
      const unsigned cu[4] = {L.gc.x, L.gc.y, L.gc.z, L.gc.w};
      const float4 m0 = *(const float4*)(p.rw_mu + 1600 + c8), m1 = *(const float4*)(p.rw_mu + 1600 + c8 + 4);
      const float mm[8] = {m0.x, m0.y, m0.z, m0.w, m1.x, m1.y, m1.z, m1.w};
      float gsig[8];
#pragma unroll
      for (int i = 0; i < 8; ++i) {
        const float z = (i & 1) ? bfhi(cu[i >> 1]) : bflo(cu[i >> 1]);
        const float nbv = bf2f(L.gn[i]) * nmask[i & 3];
        gsig[i] = fsig(z + (nbv - z) * mm[i]);
      }
#pragma unroll
      for (int q = 0; q < 4; ++q) ou[q] = pack2(gsig[2 * q], gsig[2 * q + 1]);
    }
    *(uint4*)(p.sg() + (size_t)row * 256 + c8) = make_uint4(ou[0], ou[1], ou[2], ou[3]);
  }
}
__device__ __forceinline__ void ph_mixprep(const P& p, int bid, int nb, u16* y1dst, u16* t1dst) {
  const int wid = tidx() >> 6, lane = tidx() & 63;
  const int stride = nb * 8;
  for (int row = bid * 8 + wid; row < NLAT; row += 2 * stride) {
    const int rowB = row + stride;
    const bool hasB = rowB < NLAT;
    MixLd LA, LB;
    float mA[4], mB[4];
    mix_load(p, row, lane, LA, mA);
    mix_load(p, hasB ? rowB : row, lane, LB, mB);
    mix_compute(p, row, lane, LA, mA, y1dst, t1dst);
    if (hasB) mix_compute(p, rowB, lane, LB, mB, y1dst, t1dst);
  }
}

__constant__ unsigned char CAND_I[52] = {0,0,0,0,0,0,0,0,0,0,0,0,0,0,0,0, 1,1,1,1,1,1,1,1, 2,2,2,2,2, 3,3,3,3, 4,4,4, 5,5, 6,6, 7,7, 8,9,10,11,12,13,14,15, 0,0};
__constant__ unsigned char CAND_J[52] = {0,1,2,3,4,5,6,7,8,9,10,11,12,13,14,15, 0,1,2,3,4,5,6,7, 0,1,2,3,4, 0,1,2,3, 0,1,2, 0,1, 0,1, 0,1, 0,0,0,0,0,0,0,0, 0,0};

#define SC_LD 144
#define KL_LD 136
__device__ __forceinline__ unsigned umax_quad(unsigned v) {
  unsigned o = (unsigned)__builtin_amdgcn_update_dpp(0, (int)v, 0xB1, 0xf, 0xf, true);
  v = v > o ? v : o;
  o = (unsigned)__builtin_amdgcn_update_dpp(0, (int)v, 0x4E, 0xf, 0xf, true);
  return v > o ? v : o;
}
__device__ __forceinline__ unsigned mono_key(float f) {
  unsigned u = __float_as_uint(f);
  return u ^ ((u >> 31) ? 0xFFFFFFFFu : 0x80000000u);
}
__device__ __forceinline__ float mono_inv(unsigned k) {
  unsigned u = (k >> 31) ? (k ^ 0x80000000u) : ~k;
  return __uint_as_float(u);
}
__device__ __forceinline__ unsigned umax3(unsigned a, unsigned b, unsigned c) {
  unsigned m = a > b ? a : b;
  return m > c ? m : c;
}
__device__ __forceinline__ void ph_route(const P& p, char* smem, int bid, int nb) {
  u16* KL = (u16*)smem;
  unsigned* SC = (unsigned*)(smem + 2 * 128 * KL_LD * 2);
  float* TS = (float*)(SC + 2 * 64 * SC_LD);
  int* TI = (int*)(TS + 2 * 64 * 16);
  const u16* Q = p.proj();
  const int tid = tidx(), wid = tid >> 6, lane = tid & 63, fr = lane & 15, fq = lane >> 4;
  int cur_h = -1;
  bf16x8 an[4];
  {
    const int h0 = bid & 7, r0 = (bid >> 3) * 64, c0 = wid >> 2, m0 = (wid & 3) * 16;
#pragma unroll
    for (int ks = 0; ks < 4; ++ks)
      an[ks] = *(const bf16x8*)(Q + (size_t)(r0 + m0 + fr) * 2048 + h0 * 256 + c0 * 128 + ks * 32 + fq * 8);
  }
  for (int item = bid; item < 1024 * 8; item += nb) {
    const int h = item & 7, row0 = (item >> 3) * 64;
    if (h != cur_h) {
      __syncthreads();
      for (int e = tid; e < 2 * 128 * 16; e += NTHREADS) {
        int r = e >> 4, kc = (e & 15) * 8;
        *(uint4*)(KL + r * KL_LD + kc) = *(const uint4*)(p.keys() + ((size_t)h * 256 + r) * 128 + kc);
      }
      cur_h = h;
      __syncthreads();
    }
    {
      const int c = wid >> 2, mrow = (wid & 3) * 16;
      f32x4 acc[8];
#pragma unroll
      for (int ni = 0; ni < 8; ++ni) acc[ni] = (f32x4){0.f, 0.f, 0.f, 0.f};
      bf16x8 a[4];
#pragma unroll
      for (int ks = 0; ks < 4; ++ks) a[ks] = an[ks];
      {
        const int nit = (item + nb < 1024 * 8) ? item + nb : item;
        const int nh = nit & 7, nr0 = (nit >> 3) * 64;
#pragma unroll
        for (int ks = 0; ks < 4; ++ks)
          an[ks] = *(const bf16x8*)(Q + (size_t)(nr0 + mrow + fr) * 2048 + nh * 256 + c * 128 + ks * 32 + fq * 8);
      }
#pragma unroll
      for (int ks = 0; ks < 4; ++ks) {
#pragma unroll
        for (int ni = 0; ni < 8; ++ni) {
          bf16x8 bfr = *(const bf16x8*)(KL + (c * 128 + ni * 16 + fr) * KL_LD + ks * 32 + fq * 8);
          acc[ni] = __builtin_amdgcn_mfma_f32_16x16x32_bf16(a[ks], bfr, acc[ni], 0, 0, 0);
        }
      }
#pragma unroll
      for (int ni = 0; ni < 8; ++ni)
#pragma unroll
        for (int j = 0; j < 4; ++j) {
          const int n = ni * 16 + fr;
          SC[(c * 64 + mrow + fq * 4 + j) * SC_LD + n] = (mono_key(acc[ni][j]) & ~127u) | (unsigned)(127 - n);
        }
    }
    __syncthreads();
    {
      const int task = tid >> 2, q4 = tid & 3;
      unsigned* rowp = SC + task * SC_LD;
      for (int r = 0; r < 16; ++r) {
        unsigned m = 0;
#pragma unroll
        for (int j = 0; j < 8; ++j) {
          uint4 v = *(const uint4*)(rowp + 16 * j + 4 * q4);
          m = umax3(m, v.x, v.y);
          m = umax3(m, v.z, v.w);
        }
        m = umax_quad(m);
        const int n = 127 - (int)(m & 127u);
        if (((n >> 2) & 3) == q4) rowp[n] = 0u;
        if (q4 == (r & 3)) {
          TS[task * 16 + r] = mono_inv(m & ~127u);
          TI[task * 16 + r] = n;
        }
      }
    }
    __syncthreads();
    if (tid < 256) {
      const int t = tid >> 2, q4 = tid & 3;
      unsigned val[13];
#pragma unroll
      for (int e = 0; e < 13; ++e) {
        const int ci = q4 + 4 * e;
        const int i = CAND_I[ci], j = CAND_J[ci];
        const float sv = TS[t * 16 + i] + TS[(64 + t) * 16 + j];
        val[e] = (ci < 50) ? ((mono_key(sv) & ~255u) | (unsigned)(255 - (i * 16 + j))) : 0u;
      }
      unsigned mine[4] = {0u, 0u, 0u, 0u};
      unsigned first = 0u;
#pragma unroll
      for (int r = 0; r < 16; ++r) {
        unsigned m = umax3(val[0], val[1], val[2]);
        m = umax3(m, val[3], val[4]);
        m = umax3(m, val[5], val[6]);
        m = umax3(m, val[7], val[8]);
        m = umax3(m, val[9], val[10]);
        m = umax3(m, val[11], val[12]);
        m = umax_quad(m);
#pragma unroll
        for (int e = 0; e < 13; ++e) val[e] = (val[e] == m) ? 0u : val[e];
        if (r == 0) first = m;
        mine[r >> 2] = (q4 == (r & 3)) ? m : mine[r >> 2];
      }
      float smax;
      {
        const int cid = 255 - (int)(first & 255u);
        smax = TS[t * 16 + (cid >> 4)] + TS[(64 + t) * 16 + (cid & 15)];
      }
      float ex[4];
      int eid[4];
      float part = 0.f;
#pragma unroll
      for (int k = 0; k < 4; ++k) {
        const int cid = 255 - (int)(mine[k] & 255u);
        const int i = cid >> 4, j = cid & 15;
        const float sv = TS[t * 16 + i] + TS[(64 + t) * 16 + j];
        ex[k] = __expf(sv - smax);
        part += ex[k];
        eid[k] = TI[t * 16 + i] * 128 + TI[(64 + t) * 16 + j];
      }
      part = dpp_add(part, 0, 0);
      part = dpp_add(part, 1, 0);
      const float rden = 1.f / part;
      const size_t obase = ((size_t)(row0 + t) * 8 + h) * 16;
#pragma unroll
      for (int k = 0; k < 4; ++k) {
        p.idx()[obase + 4 * k + q4] = eid[k];
        p.gate()[obase + 4 * k + q4] = ex[k] * rden;
      }
    }
    __syncthreads();
  }
}

typedef int v8i_t __attribute__((ext_vector_type(8)));
__device__ __forceinline__ void ph_ffn(const P& p, float* __restrict__ dst, char* smem, int bid, int nb) {
  const int wid = tidx() >> 6, lane = tidx() & 63;
  const int hh = lane >> 5, li = lane & 31, m16 = lane & 15, kg = lane >> 4;
  unsigned char* h8 = (unsigned char*)smem + wid * 1024;
  const u16* H2N = p.hn();
  for (int row = bid * 8 + wid; row < NLAT; row += nb * 8) {
    float hinv;
    {
      const uint4 a = *(const uint4*)(H2N + (size_t)row * 1024 + lane * 16), b2 = *(const uint4*)(H2N + (size_t)row * 1024 + lane * 16 + 8);
      const unsigned au[8] = {a.x, a.y, a.z, a.w, b2.x, b2.y, b2.z, b2.w};
      float hv[16];
      float am = 0.f;
#pragma unroll
      for (int q = 0; q < 8; ++q) { hv[2 * q] = bflo(au[q]); hv[2 * q + 1] = bfhi(au[q]); am = fmaxf(am, fmaxf(fabsf(hv[2 * q]), fabsf(hv[2 * q + 1]))); }
#pragma unroll
      for (int m = 32; m >= 1; m >>= 1) am = fmaxf(am, __shfl_xor(am, m, 64));
      const float scl = am > 0.f ? 448.f / am : 1.f;
      hinv = am > 0.f ? am * (1.f / 448.f) : 1.f;
      unsigned o[4];
#pragma unroll
      for (int q = 0; q < 4; ++q) {
        int w = 0;
        w = __builtin_amdgcn_cvt_pk_fp8_f32(hv[4 * q] * scl, hv[4 * q + 1] * scl, w, false);
        w = __builtin_amdgcn_cvt_pk_fp8_f32(hv[4 * q + 2] * scl, hv[4 * q + 3] * scl, w, true);
        o[q] = (unsigned)w;
      }
      *(uint4*)(h8 + lane * 16) = make_uint4(o[0], o[1], o[2], o[3]);
    }
    v8i_t hb[8];
#pragma unroll
    for (int s2 = 0; s2 < 8; ++s2) {
      const uint4 x0 = *(const uint4*)(h8 + 128 * s2 + 16 * kg), x1 = *(const uint4*)(h8 + 128 * s2 + 64 + 16 * kg);
      hb[s2] = (v8i_t){(int)x0.x, (int)x0.y, (int)x0.z, (int)x0.w, (int)x1.x, (int)x1.y, (int)x1.z, (int)x1.w};
    }
    const int id0 = p.idx()[(size_t)row * 128 + lane], id1 = p.idx()[(size_t)row * 128 + 64 + lane];
    const float us0 = p.usc()[id0] * hinv, us1 = p.usc()[id1] * hinv;
    const float gv0 = p.gate()[(size_t)row * 128 + lane] * p.vsc()[id0], gv1 = p.gate()[(size_t)row * 128 + 64 + lane] * p.vsc()[id1];
    float oacc[32];
#pragma unroll
    for (int i = 0; i < 32; ++i) oacc[i] = 0.f;
#pragma unroll 1
    for (int bb = 0; bb < 8; ++bb) {
      const bool hf = bb >= 4;
      const int e0 = (bb & 3) * 16;
      const int idv = hf ? id1 : id0;
      const float usv = hf ? us1 : us0, gvv = hf ? gv1 : gv0;
      const int idm = __shfl(idv, e0 + m16, 64);
      uint4 ua[8];
#pragma unroll
      for (int s2 = 0; s2 < 8; ++s2) ua[s2] = *(const uint4*)(p.utab() + (size_t)idm * 1024 + 64 * s2 + 16 * kg);
      uint4 vr[8];
#pragma unroll
      for (int q = 0; q < 8; ++q) {
        const int ia = __builtin_amdgcn_readlane(idv, e0 + 2 * q), ib = __builtin_amdgcn_readlane(idv, e0 + 2 * q + 1);
        const int id = hh ? ib : ia;
        vr[q] = *(const uint4*)(p.utab() + (size_t)id * 1024 + 512 + li * 16);
      }
      f32x4 D = (f32x4){0.f, 0.f, 0.f, 0.f};
#pragma unroll
      for (int s2 = 0; s2 < 8; ++s2) {
        const v8i_t av = (v8i_t){(int)ua[s2].x, (int)ua[s2].y, (int)ua[s2].z, (int)ua[s2].w, 0, 0, 0, 0};
        D = __builtin_amdgcn_mfma_scale_f32_16x16x128_f8f6f4(av, hb[s2], D, 4  , 0  , 0, 0x7f7f7f7f, 0, 0x7f7f7f7f);
      }
      const int nn = m16 & 3;
      const float dotv = nn == 0 ? D[0] : (nn == 1 ? D[1] : (nn == 2 ? D[2] : D[3]));
      const int esrc = e0 + 4 * kg + nn;
      const float usx = __shfl(usv, esrc, 64), gvx = __shfl(gvv, esrc, 64);
      const float cfl = gvx * gelu_as(dotv * usx);
#pragma unroll
      for (int q = 0; q < 8; ++q) {
        int one_s;
        asm volatile("s_mov_b32 %0, 1" : "=s"(one_s));
        if (one_s == 0) continue;
        const int ma = 2 * q, mb = 2 * q + 1;
        const float cfa = __int_as_float(__builtin_amdgcn_readlane(__float_as_int(cfl), 16 * (ma >> 2) + (ma & 3)));
        const float cfb = __int_as_float(__builtin_amdgcn_readlane(__float_as_int(cfl), 16 * (mb >> 2) + (mb & 3)));
        const float cf = hh ? cfb : cfa;
        const unsigned vv[4] = {vr[q].x, vr[q].y, vr[q].z, vr[q].w};
#pragma unroll
        for (int k = 0; k < 4; ++k) {
          v2f p0 = __builtin_amdgcn_cvt_scalef32_pk_f32_fp4(vv[k], 1.0f, 0), p1 = __builtin_amdgcn_cvt_scalef32_pk_f32_fp4(vv[k], 1.0f, 1);
          v2f p2 = __builtin_amdgcn_cvt_scalef32_pk_f32_fp4(vv[k], 1.0f, 2), p3 = __builtin_amdgcn_cvt_scalef32_pk_f32_fp4(vv[k], 1.0f, 3);
          oacc[8 * k] += cf * p0[0]; oacc[8 * k + 1] += cf * p0[1];
          oacc[8 * k + 2] += cf * p1[0]; oacc[8 * k + 3] += cf * p1[1];
          oacc[8 * k + 4] += cf * p2[0]; oacc[8 * k + 5] += cf * p2[1];
          oacc[8 * k + 6] += cf * p3[0]; oacc[8 * k + 7] += cf * p3[1];
        }
      }
    }
    float mine[16];
#pragma unroll
    for (int i = 0; i < 16; ++i) {
      const float give = hh ? oacc[i] : oacc[16 + i];
      const float got = __shfl_xor(give, 32, 64);
      mine[i] = (hh ? oacc[16 + i] : oacc[i]) + got;
    }
    const int b = row >> 11;
    const int colb = li * 32 + hh * 16;
    float h3[16];
    float ss = 0.f;
#pragma unroll
    for (int q = 0; q < 4; ++q) {
      const int col = colb + q * 4;
      float4 a0 = *(const float4*)(p.out + (size_t)row * 1024 + col);
      float4 q0 = *(const float4*)(p.mod() + b * 6144 + 5 * 1024 + col);
      h3[q * 4 + 0] = a0.x + q0.x * mine[q * 4 + 0];
      h3[q * 4 + 1] = a0.y + q0.y * mine[q * 4 + 1];
      h3[q * 4 + 2] = a0.z + q0.z * mine[q * 4 + 2];
      h3[q * 4 + 3] = a0.w + q0.w * mine[q * 4 + 3];
      ss += h3[q * 4] * h3[q * 4] + h3[q * 4 + 1] * h3[q * 4 + 1] + h3[q * 4 + 2] * h3[q * 4 + 2] + h3[q * 4 + 3] * h3[q * 4 + 3];
    }
    ss = wave_sum_u(ss);
    const float rstd = rsqrtf(ss * (1.f / 1024.f) + 1e-6f);
#pragma unroll
    for (int q = 0; q < 4; ++q) {
      const int col = colb + q * 4;
      float4 n0 = *(const float4*)(p.norm_f_g + col);
      *(float4*)(dst + (size_t)row * 1024 + col) =
          make_float4(h3[q * 4] * rstd * n0.x, h3[q * 4 + 1] * rstd * n0.y, h3[q * 4 + 2] * rstd * n0.z, h3[q * 4 + 3] * rstd * n0.w);
    }
  }
}

#define XB_TMO      128
#define XB_XCNT(j)  (256  + 64 * (j))
#define XB_XSUB(j)  (1280 + 64 * (j))
#define XB_XGEN(j)  (2304 + 64 * (j))
#define XB_TOP      3328
#define XB_TOPGEN   3392
#define XCD_BAR_WORDS 3456
#define XB_SPIN_CAP (1u << 18)
#define LAS __attribute__((address_space(3)))

__device__ __forceinline__ unsigned xb_ld(unsigned* p)              { return __hip_atomic_load(p, __ATOMIC_RELAXED, __HIP_MEMORY_SCOPE_AGENT); }
__device__ __forceinline__ unsigned xb_add(unsigned* p, unsigned v) { return __hip_atomic_fetch_add(p, v, __ATOMIC_RELAXED, __HIP_MEMORY_SCOPE_AGENT); }
__device__ __forceinline__ unsigned xb_xcc_id() { return (unsigned)__builtin_amdgcn_s_getreg((3 << 11) | 20) & 0xFu; }
#define XB_SPIN(cond, bar) do { unsigned _sp = 0; while (cond) { __builtin_amdgcn_s_sleep(1); \
    if ((++_sp & 255u) == 0u) { if (xb_ld(&(bar)[XB_TMO])) break; if (_sp > XB_SPIN_CAP) { atomicAdd(&(bar)[XB_TMO], 1u); break; } } } } while (0)

struct XcdBarrier {
    unsigned* bar; unsigned x;
    volatile LAS unsigned* st;
};

__device__ __forceinline__ XcdBarrier xcd_barrier_post(unsigned* bar, volatile LAS unsigned* st) {
    XcdBarrier b; b.bar = bar; b.x = xb_xcc_id(); b.st = st;
    if (tidx() == 0) (void)xb_add(&bar[XB_XCNT(b.x)], 1u);
    return b;
}
__device__ __forceinline__ void xcd_barrier_complete(unsigned* bar, unsigned x, unsigned& nloc, unsigned& nx) {
    const unsigned G = gridDim.x * gridDim.y * gridDim.z;
    unsigned sum, cnt, mine, sp = 0u;
    for (;;) {
        sum = 0u; cnt = 0u; mine = 0u;
#pragma unroll
        for (unsigned j = 0; j < 16; ++j) { const unsigned c = xb_ld(&bar[XB_XCNT(j)]); sum += c; cnt += (c > 0u) ? 1u : 0u; mine = (j == x) ? c : mine; }
        if (sum == G) break;
        __builtin_amdgcn_s_sleep(1);
        if ((++sp & 255u) == 0u) { if (xb_ld(&bar[XB_TMO])) break; if (sp > XB_SPIN_CAP) { atomicAdd(&bar[XB_TMO], 1u); break; } }
    }
    nloc = mine > 0u ? mine : 1u; nx = cnt > 0u ? cnt : 1u;
}

__device__ __forceinline__ void xcd_barrier(const XcdBarrier& b) {
    asm volatile("s_waitcnt vmcnt(0)" ::: "memory");
    __syncthreads();
    if (tidx() == 0) {
        unsigned* bar = b.bar;
        __builtin_amdgcn_s_waitcnt(0);
        unsigned nloc = b.st[0], nx = b.st[1];
        if (nloc == 0u) { xcd_barrier_complete(bar, b.x, nloc, nx); b.st[0] = nloc; b.st[1] = nx; }
        const unsigned old = xb_add(&bar[XB_XSUB(b.x)], 1u);
        const unsigned gen = old / nloc;
        if (old + 1u == (gen + 1u) * nloc) {
            __builtin_amdgcn_fence(__ATOMIC_RELEASE, "agent");
            asm volatile("s_waitcnt vmcnt(0)" ::: "memory");
            const unsigned og = xb_add(&bar[XB_TOP], 1u);
            const unsigned tg = og / nx;
            if (og + 1u == (tg + 1u) * nx) xb_add(&bar[XB_TOPGEN], 1u);
            else XB_SPIN(xb_ld(&bar[XB_TOPGEN]) == tg, bar);
            __builtin_amdgcn_fence(__ATOMIC_ACQUIRE, "agent");
            xb_add(&bar[XB_XGEN(b.x)], 1u);
            asm volatile("s_waitcnt vmcnt(0)" ::: "memory");
        } else {
            XB_SPIN(xb_ld(&bar[XB_XGEN(b.x)]) == gen, bar);
            __builtin_amdgcn_fence(__ATOMIC_ACQUIRE, "agent");
            asm volatile("s_waitcnt vmcnt(0)" ::: "memory");
        }
    }
    __syncthreads();
}

typedef const __attribute__((address_space(4))) P* kargP_t;
__device__ __forceinline__ P load_params() {
  kargP_t q = (kargP_t)__builtin_amdgcn_kernarg_segment_ptr();
  asm volatile("" : "+s"(q));
  P r;
  r.x = q->x;
  r.c = q->c;
  r.ctx = q->ctx;
  r.c_ctx = q->c_ctx;
  r.w_ada = q->w_ada;
  r.b_ada = q->b_ada;
  r.norm1_g = q->norm1_g;
  r.norm2_g = q->norm2_g;
  r.w_in = q->w_in;
  r.s5_a_re = q->s5_a_re;
  r.s5_a_im = q->s5_a_im;
  r.s5_log_dt = q->s5_log_dt;
  r.s5_b_re = q->s5_b_re;
  r.s5_b_im = q->s5_b_im;
  r.s5_c_re = q->s5_c_re;
  r.s5_c_im = q->s5_c_im;
  r.s5_d = q->s5_d;
  r.s5_w_glu = q->s5_w_glu;
  r.s5_b_glu = q->s5_b_glu;
  r.rw_mu = q->rw_mu;
  r.rw_w0 = q->rw_w0;
  r.rw_w_w2 = q->rw_w_w2;
  r.rw_a0 = q->rw_a0;
  r.rw_w_a2 = q->rw_w_a2;
  r.rw_w_g2 = q->rw_w_g2;
  r.rw_k_k = q->rw_k_k;
  r.rw_k_a = q->rw_k_a;
  r.rw_r_k = q->rw_r_k;
  r.rw_ln_w = q->rw_ln_w;
  r.rw_ln_b = q->rw_ln_b;
  r.w_out = q->w_out;
  r.peer_w_q = q->peer_w_q;
  r.peer_keys = q->peer_keys;
  r.peer_u = q->peer_u;
  r.peer_v = q->peer_v;
  r.norm_f_g = q->norm_f_g;
  r.out = q->out;
  r.ws = q->ws;
  return r;
}
#define NPHASES 11
template <int PH>
__device__ __forceinline__ void run_phase(const P& p, char* smem, int bid, int nb, bool rep = false) {
  if (PH == 0) ph_prep(p, smem, bid, nb);
  if (PH == 1) ph_norm(p, 0, bid, nb);
  if (PH == 2) {
    pg8::StaticOrder S; S.init(NTOK, INCP, nb, bid);
    pg8::gemm_phase<pg8::EpiProjT, pg8::StaticOrder, false>((PG8_LAS unsigned char*)smem, pg8::Gemm{p.hn(), p.win_t(), NTOK, INCP, 1024}, S, pg8::EpiProjT{p.proj(), INC, INC}, nullptr);
  }
  if (PH == 3) { ph_s5scan2(p, smem, bid, nb); ph_rwscan2(p, smem, bid, nb); }
  if (PH == 4) ph_mixprep(p, bid, nb, rep ? p.hn() : p.ys5f(), rep ? p.hn() + (size_t)NLAT * 512 : p.yrwf());
  if (PH == 5) {
    {
      pg8::StaticOrder S; S.init(NLAT, 512, nb, bid);
      pg8::gemm_phase<pg8::EpiGluT, pg8::StaticOrder, false>((PG8_LAS unsigned char*)smem, pg8::Gemm{p.ys5f(), p.wglu_t(), NLAT, 512, 512}, S, pg8::EpiGluT{p.ys5f(), p.s5_b_glu, p.hn()}, nullptr);
    }
    {
      pg8::StaticOrder S; S.init(NLAT, 512, nb, bid);
      pg8::gemm_phase<pg8::EpiGateT, pg8::StaticOrder, false>((PG8_LAS unsigned char*)smem, pg8::Gemm{p.sg(), p.wg2_t(), NLAT, 512, 256}, S, pg8::EpiGateT{p.yrwf(), p.hn()}, nullptr);
    }
  }
  if (PH == 6) {
    pg8::StaticOrder S; S.init(NLAT, 1024, nb, bid);
    pg8::gemm_phase<pg8::EpiWoutT, pg8::StaticOrder, false>((PG8_LAS unsigned char*)smem, pg8::Gemm{p.hn(), p.wout_t(), NLAT, 1024, 1024}, S, pg8::EpiWoutT{p.x, p.mod(), p.out}, nullptr);
  }
  if (PH == 7) ph_norm(p, 1, bid, nb);
  if (PH == 8) {
    pg8::StaticOrder S; S.init(NLAT, 2048, nb, bid);
    pg8::gemm_phase<pg8::EpiProjT, pg8::StaticOrder, false>((PG8_LAS unsigned char*)smem, pg8::Gemm{p.hn(), p.wq_t(), NLAT, 2048, 1024}, S, pg8::EpiProjT{p.proj(), 2048, 2048}, nullptr);
  }
  if (PH == 9) ph_route(p, smem, bid, nb);
  if (PH == 10) ph_ffn(p, rep ? (float*)p.proj() : p.out, smem, bid, nb);
  if (PH == 11) ph_s5scan2(p, smem, bid, nb);
  if (PH == 12) ph_rwscan2(p, smem, bid, nb);
}
#ifndef REPMASK
#define REPMASK 0
#endif
#define REP(n) ((REPMASK >> (n)) & 1)
#define PHASE(n) if (ph_lo <= n && n < ph_hi) { if (n > ph_lo) { if (n == 1) grid.sync(); else xcd_barrier(xb); } if (REP(n)) { { const P lp_ = load_params(); run_phase<n>(lp_, smem, bid, nb, true); } __syncthreads(); } if (n == 3 && REP(11)) { run_phase<11>(p, smem, bid, nb); __syncthreads(); } if (n == 3 && REP(12)) { run_phase<12>(p, smem, bid, nb); __syncthreads(); } { const P lp_ = load_params(); run_phase<n>(lp_, smem, bid, nb); } }
__global__ void __launch_bounds__(NTHREADS) mega(P p, int ph_lo, int ph_hi) {
  char* smem = g_smem;
  if ((threadIdx.x & 63) == 0) *(int*)(g_smem + WAVETAB_OFF + 4 * hw_slot()) = (int)(threadIdx.x >> 6);
  cg::grid_group grid = cg::this_grid();
  const int bid = blockIdx.x, nb = gridDim.x;
  volatile LAS unsigned* xst = (volatile LAS unsigned*)(smem + LDS_BYTES - 16);
  if (threadIdx.x == 0) { xst[0] = 0u; xst[1] = 0u; }
  __syncthreads();
  XcdBarrier xb;
  {
    const P lp0 = load_params();
    xb.bar = lp0.bar(); xb.x = 0; xb.st = xst;
    if (ph_hi - ph_lo > 1) xb = xcd_barrier_post(lp0.bar(), xst);
  }
  PHASE(0) PHASE(1) PHASE(2) PHASE(3) PHASE(4) PHASE(5) PHASE(6) PHASE(7) PHASE(8) PHASE(9) PHASE(10)
}

extern "C" void kernel_launch(void* const* d_in, const int* in_sizes, int n_in, void* d_out, int out_size, void* d_ws,
                              size_t ws_size, hipStream_t stream) {
  static int grid_blocks = 0;
  if (!grid_blocks) {
    int dev = 0, cus = 0, per_cu = 0;
    hipGetDevice(&dev);
    hipDeviceGetAttribute(&cus, hipDeviceAttributeMultiprocessorCount, dev);
    hipFuncSetAttribute((const void*)mega, hipFuncAttributeMaxDynamicSharedMemorySize, LDS_BYTES);
    hipOccupancyMaxActiveBlocksPerMultiprocessor(&per_cu, (const void*)mega, NTHREADS, LDS_BYTES);
    if (per_cu < 1) { fprintf(stderr, "occupancy query returned %d\n", per_cu); per_cu = 1; }
    grid_blocks = cus;
  }
  P p{};
  const float** fp = (const float**)&p;
  for (int i = 0; i < 36; ++i) fp[i] = (const float*)d_in[i];
  p.out = (float*)d_out;
  p.ws = (char*)d_ws;
  if (WS_TOTAL > ws_size) { fprintf(stderr, "workspace too small: need %zu have %zu\n", (size_t)WS_TOTAL, ws_size); return; }
#if MEGA
  if (hipMemsetAsync((char*)d_ws + OFF_bar, 0, XCD_BAR_WORDS * 4, stream) != hipSuccess) fprintf(stderr, "memset of barrier words failed\n");
  int lo = 0, hi = NPHASES;
  void* args[] = {&p, &lo, &hi};
  hipError_t e = hipLaunchCooperativeKernel((const void*)mega, dim3(grid_blocks), dim3(NTHREADS), args, LDS_BYTES, stream);
  if (e != hipSuccess) fprintf(stderr, "cooperative launch failed: %s (grid %d)\n", hipGetErrorString(e), grid_blocks);
#else
  for (int ph = 0; ph < NPHASES; ++ph) {
    hipLaunchKernelGGL(mega, dim3(grid_blocks), dim3(NTHREADS), LDS_BYTES, stream, p, ph, ph + 1);
  }
#endif
}
```

```cpp
#include <hip/hip_runtime.h>
#include <hip/hip_cooperative_groups.h>
#include <stdint.h>
#include <stdio.h>
namespace cg = cooperative_groups;

#ifndef MEGA
#define MEGA 1
#endif

typedef unsigned short u16;
using bf16x8 = __attribute__((ext_vector_type(8))) short;
using f32x4 = __attribute__((ext_vector_type(4))) float;
using u32x4 = __attribute__((ext_vector_type(4))) unsigned;
using f32x16 = __attribute__((ext_vector_type(16))) float;

#define DM 1024
#define NLAT 65536
#define NCTX 8192
#define NTOK 73728
#define INC 2208
#define INCP 2304
#define NTHREADS 512
#define LDS_BYTES 163840

#define INC_FWD 1
constexpr size_t ws_al(size_t x) { return (x + 255) & ~(size_t)255; }
constexpr size_t OFF_mod = 0;
constexpr size_t OFF_win_t = OFF_mod + ws_al(33 * 6144 * 4);
constexpr size_t OFF_wout_t = OFF_win_t + ws_al((size_t)2304 * 1024 * 2);
constexpr size_t OFF_wq_t = OFF_wout_t + ws_al((size_t)1024 * 1024 * 2);
constexpr size_t OFF_wglu_t = OFF_wq_t + ws_al((size_t)2048 * 1024 * 2);
constexpr size_t OFF_wg2_t = OFF_wglu_t + ws_al((size_t)512 * 512 * 2);
constexpr size_t OFF_keys = OFF_wg2_t + ws_al((size_t)512 * 256 * 2);
constexpr size_t OFF_utab = OFF_keys + ws_al((size_t)8 * 2 * 128 * 128 * 2);
constexpr size_t OFF_usc = OFF_utab + ws_al((size_t)16384 * 1024);
constexpr size_t OFF_vsc = OFF_usc + ws_al(16384 * 4);
constexpr size_t OFF_s5ab = OFF_vsc + ws_al(16384 * 4);
constexpr size_t OFF_s5bb = OFF_s5ab + ws_al(4096 * 2 * 4);
constexpr size_t OFF_s5ct = OFF_s5bb + ws_al(4096 * 32 * 4);
constexpr size_t OFF_hn = OFF_s5ct + ws_al(2 * 32 * 16 * 128 * 2);
constexpr size_t OFF_proj = OFF_hn + ws_al((size_t)73728 * 1024 * 2);
constexpr size_t OFF_ys5f = OFF_proj + ws_al((size_t)73728 * 2208 * 2);
constexpr size_t OFF_ys5b = OFF_ys5f + ws_al((size_t)65536 * 512 * 2);
constexpr size_t OFF_yrwf = OFF_ys5b + ws_al((size_t)65536 * 512 * 2);
constexpr size_t OFF_yrwb = OFF_yrwf + ws_al((size_t)65536 * 512 * 2);
constexpr size_t OFF_bsc = OFF_yrwb + ws_al((size_t)65536 * 512 * 2);
constexpr size_t OFF_sg = OFF_bsc + ws_al((size_t)2 * 65536 * 8 * 4);
constexpr size_t OFF_bar = OFF_sg + ws_al((size_t)65536 * 256 * 2);
constexpr size_t OFF_wlf = OFF_bar + ws_al(3456 * 4);
constexpr size_t WS_TOTAL = OFF_wlf + ws_al(2 * 4096 * 16);

extern __shared__ __attribute__((aligned(16))) char g_smem[];
#define WAVETAB_OFF (LDS_BYTES - 16 - 256)
__device__ __forceinline__ int hw_slot() { return (int)(__builtin_amdgcn_s_getreg((5 << 11) | 4) & 63u); }
__device__ __forceinline__ int tidx() {
  const int w = *(const int*)(g_smem + WAVETAB_OFF + 4 * hw_slot());
  return __builtin_amdgcn_readfirstlane(w) * 64 + (int)__builtin_amdgcn_mbcnt_hi(~0u, __builtin_amdgcn_mbcnt_lo(~0u, 0u));
}
struct P {
  const float *x, *c, *ctx, *c_ctx, *w_ada, *b_ada, *norm1_g, *norm2_g, *w_in, *s5_a_re, *s5_a_im, *s5_log_dt,
      *s5_b_re, *s5_b_im, *s5_c_re, *s5_c_im, *s5_d, *s5_w_glu, *s5_b_glu, *rw_mu, *rw_w0, *rw_w_w2, *rw_a0, *rw_w_a2,
      *rw_w_g2, *rw_k_k, *rw_k_a, *rw_r_k, *rw_ln_w, *rw_ln_b, *w_out, *peer_w_q, *peer_keys, *peer_u, *peer_v, *norm_f_g;
  float* out;
  char* ws;
  __device__ __forceinline__ float* mod() const { return (float*)(ws + OFF_mod); }
  __device__ __forceinline__ u16* win_t() const { return (u16*)(ws + OFF_win_t); }
  __device__ __forceinline__ u16* wout_t() const { return (u16*)(ws + OFF_wout_t); }
  __device__ __forceinline__ u16* wq_t() const { return (u16*)(ws + OFF_wq_t); }
  __device__ __forceinline__ u16* wglu_t() const { return (u16*)(ws + OFF_wglu_t); }
  __device__ __forceinline__ u16* wg2_t() const { return (u16*)(ws + OFF_wg2_t); }
  __device__ __forceinline__ u16* keys() const { return (u16*)(ws + OFF_keys); }
  __device__ __forceinline__ unsigned char* utab() const { return (unsigned char*)(ws + OFF_utab); }
  __device__ __forceinline__ float* usc() const { return (float*)(ws + OFF_usc); }
  __device__ __forceinline__ float* vsc() const { return (float*)(ws + OFF_vsc); }
  __device__ __forceinline__ float* s5ab() const { return (float*)(ws + OFF_s5ab); }
  __device__ __forceinline__ float* s5bb() const { return (float*)(ws + OFF_s5bb); }
  __device__ __forceinline__ u16* s5ct() const { return (u16*)(ws + OFF_s5ct); }
  __device__ __forceinline__ u16* hn() const { return (u16*)(ws + OFF_hn); }
  __device__ __forceinline__ u16* proj() const { return (u16*)(ws + OFF_proj); }
  __device__ __forceinline__ u16* ys5f() const { return (u16*)(ws + OFF_ys5f); }
  __device__ __forceinline__ u16* ys5b() const { return (u16*)(ws + OFF_ys5b); }
  __device__ __forceinline__ u16* yrwf() const { return (u16*)(ws + OFF_yrwf); }
  __device__ __forceinline__ u16* yrwb() const { return (u16*)(ws + OFF_yrwb); }
  __device__ __forceinline__ float* bsc() const { return (float*)(ws + OFF_bsc); }
  __device__ __forceinline__ u16* sg() const { return (u16*)(ws + OFF_sg); }
  __device__ __forceinline__ unsigned* bar() const { return (unsigned*)(ws + OFF_bar); }
  __device__ __forceinline__ u16* wlf() const { return (u16*)(ws + OFF_wlf); }
  __device__ __forceinline__ unsigned char* vtab() const { return utab() + 512; }
  __device__ __forceinline__ int* idx() const { return (int*)ys5b(); }
  __device__ __forceinline__ float* gate() const { return (float*)yrwb(); }
};

typedef float f32x2_t __attribute__((ext_vector_type(2)));
typedef __bf16 bf16x2_t __attribute__((ext_vector_type(2)));
__device__ __forceinline__ unsigned pack2(float a, float b) {
  f32x2_t v = {a, b};
  return __builtin_bit_cast(unsigned, __builtin_convertvector(v, bf16x2_t));
}
__device__ __forceinline__ u16 f2bf(float f) { return __builtin_bit_cast(u16, (__bf16)f); }
__device__ __forceinline__ float bf2f(u16 h) { return __uint_as_float(((unsigned)h) << 16); }
__device__ __forceinline__ float bflo(unsigned u) { return __uint_as_float(u << 16); }
__device__ __forceinline__ float bfhi(unsigned u) { return __uint_as_float(u & 0xffff0000u); }
__device__ __forceinline__ float wave_sum(float v) {
#pragma unroll
  for (int m = 32; m >= 1; m >>= 1) v += __shfl_xor(v, m, 64);
  return v;
}
__device__ __forceinline__ float gelu_exact(float x) { return 0.5f * x * (1.f + erff(x * 0.70710678118654752f)); }
__device__ __forceinline__ float gelu_as(float v) {
  const float av = fabsf(v), t = __builtin_amdgcn_rcpf(av * 0.2316418882f + 1.0f);
  float q = t * 0.5307027145f + (-0.7265760135f);
  q = q * t + 0.7107068705f; q = q * t + (-0.142248368f); q = q * t + 0.127414796f; q = q * t;
  const float e = __builtin_amdgcn_exp2f((v * v) * (-0.72134752044f));
  const float m = v * (q * e);
  return v < 0.f ? m : v - m;
}
__device__ __forceinline__ float sigmoidf(float x) { return 1.f / (1.f + __expf(-x)); }


typedef float v2f __attribute__((ext_vector_type(2)));
__device__ __forceinline__ float dpp_add(float v, const int ctrl, const int rmask) {
  int m;
  switch (ctrl) {
    case 0: m = __builtin_amdgcn_update_dpp(0, __float_as_int(v), 0xB1, 0xf, 0xf, true); break;
    case 1: m = __builtin_amdgcn_update_dpp(0, __float_as_int(v), 0x4E, 0xf, 0xf, true); break;
    case 2: m = __builtin_amdgcn_update_dpp(0, __float_as_int(v), 0x141, 0xf, 0xf, true); break;
    case 3: m = __builtin_amdgcn_update_dpp(0, __float_as_int(v), 0x140, 0xf, 0xf, true); break;
    case 4: m = __builtin_amdgcn_update_dpp(0, __float_as_int(v), 0x142, 0xa, 0xf, false); break;
    default: m = __builtin_amdgcn_update_dpp(0, __float_as_int(v), 0x143, 0xc, 0xf, false); break;
  }
  return v + __int_as_float(m);
}
__device__ __forceinline__ float wave_sum_u(float v) {
  v = dpp_add(v, 0, 0); v = dpp_add(v, 1, 0); v = dpp_add(v, 2, 0); v = dpp_add(v, 3, 0);
  v = dpp_add(v, 4, 0); v = dpp_add(v, 5, 0);
  return __int_as_float(__builtin_amdgcn_readlane(__float_as_int(v), 63));
}
__device__ __forceinline__ void convert_fp4_rows(const float* __restrict__ src, unsigned char* __restrict__ dst, float* __restrict__ sc,
                                                 int nrows, int bid, int nb) {
  const int wid = tidx() >> 6, lane = tidx() & 63;
  const int stride = nb * 8;
  for (int row0 = bid * 8 + wid; row0 < nrows; row0 += 4 * stride) {
    float4 v[4][4];
#pragma unroll
    for (int u = 0; u < 4; ++u) {
      int row = row0 + u * stride;
      if (row >= nrows) row = row0;
#pragma unroll
      for (int q = 0; q < 4; ++q) v[u][q] = *(const float4*)(src + (size_t)row * 1024 + lane * 16 + q * 4);
    }
#pragma unroll
    for (int u = 0; u < 4; ++u) {
      const int row = row0 + u * stride;
      if (row >= nrows) continue;
      float am = 0.f;
#pragma unroll
      for (int q = 0; q < 4; ++q)
        am = fmaxf(am, fmaxf(fmaxf(fabsf(v[u][q].x), fabsf(v[u][q].y)), fmaxf(fabsf(v[u][q].z), fabsf(v[u][q].w))));
#pragma unroll
      for (int m = 32; m >= 1; m >>= 1) am = fmaxf(am, __shfl_xor(am, m, 64));
      const float scl = am > 0.f ? 6.f / am : 1.f;
      unsigned w0 = 0u, w1 = 0u;
      w0 = __builtin_amdgcn_cvt_scalef32_pk_fp4_f32(w0, v[u][0].x * scl, v[u][0].y * scl, 1.0f, 0);
      w0 = __builtin_amdgcn_cvt_scalef32_pk_fp4_f32(w0, v[u][0].z * scl, v[u][0].w * scl, 1.0f, 1);
      w0 = __builtin_amdgcn_cvt_scalef32_pk_fp4_f32(w0, v[u][1].x * scl, v[u][1].y * scl, 1.0f, 2);
      w0 = __builtin_amdgcn_cvt_scalef32_pk_fp4_f32(w0, v[u][1].z * scl, v[u][1].w * scl, 1.0f, 3);
      w1 = __builtin_amdgcn_cvt_scalef32_pk_fp4_f32(w1, v[u][2].x * scl, v[u][2].y * scl, 1.0f, 0);
      w1 = __builtin_amdgcn_cvt_scalef32_pk_fp4_f32(w1, v[u][2].z * scl, v[u][2].w * scl, 1.0f, 1);
      w1 = __builtin_amdgcn_cvt_scalef32_pk_fp4_f32(w1, v[u][3].x * scl, v[u][3].y * scl, 1.0f, 2);
      w1 = __builtin_amdgcn_cvt_scalef32_pk_fp4_f32(w1, v[u][3].z * scl, v[u][3].w * scl, 1.0f, 3);
      *(uint2*)(dst + (size_t)row * 1024 + lane * 8) = make_uint2(w0, w1);
      if (lane == 0) sc[row] = am > 0.f ? am / 6.f : 1.f;
    }
  }
}

__device__ __forceinline__ void transpose_tiles(const float* __restrict__ src, int K, int N, u16* __restrict__ dst, int Kd, int Npad,
                                char* smem, int bid, int nb) {
  float* tile = (float*)smem;
  const int tid = tidx();
  const int nkt = Kd / 64, nnt = Npad / 64;
  for (int t = bid; t < nkt * nnt; t += nb) {
    int kt = t % nkt, nt = t / nkt;
    int k0 = kt * 64, n0 = nt * 64;
    __syncthreads();
#pragma unroll
    for (int it = 0; it < 8; ++it) {
      int i = (tid >> 6) + it * 8, j = tid & 63;
      int k = k0 + i, n = n0 + j;
      tile[i * 65 + j] = (k < K && n < N) ? src[(size_t)k * N + n] : 0.f;
    }
    __syncthreads();
    int n = tid >> 3, kc = (tid & 7) * 8;
    uint4 o;
    o.x = pack2(tile[(kc + 0) * 65 + n], tile[(kc + 1) * 65 + n]);
    o.y = pack2(tile[(kc + 2) * 65 + n], tile[(kc + 3) * 65 + n]);
    o.z = pack2(tile[(kc + 4) * 65 + n], tile[(kc + 5) * 65 + n]);
    o.w = pack2(tile[(kc + 6) * 65 + n], tile[(kc + 7) * 65 + n]);
    *(uint4*)(dst + (size_t)(n0 + n) * Kd + k0 + kc) = o;
  }
}

__device__ __forceinline__ void convert_bf16(const float* __restrict__ src, u16* __restrict__ dst, size_t n8, int bid, int nb) {
  for (size_t i = (size_t)bid * NTHREADS + tidx(); i < n8; i += (size_t)nb * NTHREADS) {
    float4 a = *(const float4*)(src + i * 8), b = *(const float4*)(src + i * 8 + 4);
    uint4 o;
    o.x = pack2(a.x, a.y); o.y = pack2(a.z, a.w); o.z = pack2(b.x, b.y); o.w = pack2(b.z, b.w);
    *(uint4*)(dst + i * 8) = o;
  }
}

__device__ __forceinline__ void ph_prep(const P& p, char* smem, int bid, int nb) {
  const int tid = tidx();
  {
    float* sc = (float*)smem;
    float* red = (float*)(smem + 33 * 256 * 4);
    for (int item = bid; item < 192; item += nb) {
      const int j0 = item * 32, kg = tid >> 5, col = tid & 31;
      float acc[33];
#pragma unroll
      for (int b = 0; b < 33; ++b) acc[b] = 0.f;
      for (int ch = 0; ch < 4; ++ch) {
        __syncthreads();
        for (int e = tid; e < 33 * 256; e += NTHREADS) {
          int b = e >> 8, kk = e & 255;
          float cv = (b < 32) ? p.c[b * 1024 + ch * 256 + kk] : p.c_ctx[ch * 256 + kk];
          sc[e] = cv / (1.f + expf(-cv));
        }
        float w[16];
#pragma unroll
        for (int i = 0; i < 16; ++i) w[i] = p.w_ada[(size_t)(ch * 256 + kg * 16 + i) * 6144 + j0 + col];
        __syncthreads();
#pragma unroll
        for (int i = 0; i < 16; ++i) {
          const int kk = kg * 16 + i;
#pragma unroll
          for (int b = 0; b < 33; ++b) acc[b] += sc[b * 256 + kk] * w[i];
        }
      }
#pragma unroll
      for (int b = 0; b < 33; ++b) red[(kg * 33 + b) * 32 + col] = acc[b];
      __syncthreads();
      for (int e = tid; e < 33 * 32; e += NTHREADS) {
        int b = e >> 5, cc = e & 31;
        float sv = p.b_ada[j0 + cc];
#pragma unroll
        for (int k2 = 0; k2 < 16; ++k2) sv += red[(k2 * 33 + b) * 32 + cc];
        p.mod()[b * 6144 + j0 + cc] = sv;
      }
      __syncthreads();
    }
  }
  transpose_tiles(p.w_in, 1024, INC, p.win_t(), 1024, INCP, smem, bid, nb);
  transpose_tiles(p.w_out, 1024, 1024, p.wout_t(), 1024, 1024, smem, bid, nb);
  transpose_tiles(p.peer_w_q, 1024, 2048, p.wq_t(), 1024, 2048, smem, bid, nb);
  transpose_tiles(p.s5_w_glu, 512, 512, p.wglu_t(), 512, 512, smem, bid, nb);
  transpose_tiles(p.rw_w_g2, 96, 512, p.wg2_t(), 256, 512, smem, bid, nb);
  convert_bf16(p.peer_keys, p.keys(), (size_t)8 * 2 * 128 * 128 / 8, bid, nb);
  convert_fp4_rows(p.peer_u, p.utab(), p.usc(), 16384, bid, nb);
  convert_fp4_rows(p.peer_v, p.vtab(), p.vsc(), 16384, bid, nb);
  for (int it = bid * NTHREADS + tid; it < 2 * 4096; it += nb * NTHREADS) {
    const int ln = it & 63, mt = (it >> 6) & 3, hh_ = (it >> 8) & 7, dd = (it >> 11) & 1, mm = it >> 12;
    const int tt = ln & 15, kq_ = ln >> 4;
    const float* W = mm ? p.rw_w_a2 : p.rw_w_w2;
    unsigned o[4];
#pragma unroll
    for (int q = 0; q < 4; ++q) {
      const size_t o0 = (size_t)(dd * 32 + 8 * kq_ + 2 * q) * 512 + hh_ * 64 + 16 * mt + tt;
      o[q] = pack2(W[o0], W[o0 + 512]);
    }
    *(uint4*)(p.wlf() + (size_t)it * 8) = make_uint4(o[0], o[1], o[2], o[3]);
  }
  for (int it = bid * NTHREADS + tid; it < 4096; it += nb * NTHREADS) {
    int pp = it & 63, g = (it >> 6) & 31, d = it >> 11;
    float are = p.s5_a_re[it], aim = p.s5_a_im[it];
    float dt = expf(p.s5_log_dt[d * 32 + g]);
    float mag = expf(dt * are);
    float abr = mag * cosf(dt * aim), abi = mag * sinf(dt * aim);
    float nr = abr - 1.f, ni = abi;
    float den = are * are + aim * aim;
    float cfr = (nr * are + ni * aim) / den, cfi = (ni * are - nr * aim) / den;
    p.s5ab()[it * 2] = abr;
    p.s5ab()[it * 2 + 1] = abi;
    for (int h = 0; h < 16; ++h) {
      float br = p.s5_b_re[(size_t)it * 16 + h], bi = p.s5_b_im[(size_t)it * 16 + h];
      p.s5bb()[(size_t)it * 32 + h] = cfr * br - cfi * bi;
      p.s5bb()[(size_t)it * 32 + 16 + h] = cfr * bi + cfi * br;
    }
    for (int h = 0; h < 16; ++h) {
      size_t ci = ((size_t)(d * 32 + g) * 16 + h) * 64 + pp;
      p.s5ct()[((size_t)(d * 32 + g) * 16 + h) * 128 + 2 * pp] = f2bf(p.s5_c_re[ci]);
      p.s5ct()[((size_t)(d * 32 + g) * 16 + h) * 128 + 2 * pp + 1] = f2bf(-p.s5_c_im[ci]);
    }
  }
}

__device__ __forceinline__ void ph_norm(const P& p, int mode, int bid, int nb) {
  const int wid = tidx() >> 6, lane = tidx() & 63;
  const int nrows = mode == 0 ? NTOK : NLAT;
  const float* gvec = mode == 0 ? p.norm1_g : p.norm2_g;
  const int sh_off = mode == 0 ? 0 : 3 * 1024, sc_off = sh_off + 1024;
  const int stride = nb * 8;
  for (int row0 = bid * 8 + wid; row0 < nrows; row0 += 4 * stride) {
    float4 v[4][4];
    int bs[4];
#pragma unroll
    for (int u = 0; u < 4; ++u) {
      int row = row0 + u * stride;
      if (row >= nrows) row = row0;
      const float* src;
      if (mode == 0) {
        if (row < NLAT) { src = p.x + (size_t)row * 1024; bs[u] = row >> 11; }
        else { src = p.ctx + (size_t)(row - NLAT) * 1024; bs[u] = 32; }
      } else { src = p.out + (size_t)row * 1024; bs[u] = row >> 11; }
#pragma unroll
      for (int j = 0; j < 2; ++j) {
        v[u][2 * j] = *(const float4*)(src + j * 512 + lane * 8);
        v[u][2 * j + 1] = *(const float4*)(src + j * 512 + lane * 8 + 4);
      }
    }
#pragma unroll
    for (int u = 0; u < 4; ++u) {
      const int row = row0 + u * stride;
      if (row >= nrows) continue;
      float ss = 0.f;
#pragma unroll
      for (int j = 0; j < 4; ++j) ss += v[u][j].x * v[u][j].x + v[u][j].y * v[u][j].y + v[u][j].z * v[u][j].z + v[u][j].w * v[u][j].w;
      ss = wave_sum_u(ss);
      const float rstd = rsqrtf(ss * (1.f / 1024.f) + 1e-6f);
      const float* mrow = p.mod() + bs[u] * 6144;
#pragma unroll
      for (int j = 0; j < 2; ++j) {
        const int col = j * 512 + lane * 8;
        unsigned o[4];
#pragma unroll
        for (int hq = 0; hq < 2; ++hq) {
          const float4 x = v[u][2 * j + hq];
          const float4 g = *(const float4*)(gvec + col + 4 * hq);
          const float4 sh = *(const float4*)(mrow + sh_off + col + 4 * hq);
          const float4 sc = *(const float4*)(mrow + sc_off + col + 4 * hq);
          o[2 * hq] = pack2(x.x * rstd * g.x * (1.f + sc.x) + sh.x, x.y * rstd * g.y * (1.f + sc.y) + sh.y);
          o[2 * hq + 1] = pack2(x.z * rstd * g.z * (1.f + sc.z) + sh.z, x.w * rstd * g.w * (1.f + sc.w) + sh.w);
        }
        *(uint4*)(p.hn() + (size_t)row * 1024 + col) = make_uint4(o[0], o[1], o[2], o[3]);
      }
    }
  }
}

#define G_BM 256
#define G_BN 128
#define G_BK 64
#define G_LD 72
template <class Epi>
__device__ __forceinline__ void gemm_simple(const u16* __restrict__ A, int lda, const u16* __restrict__ Bt, int ldb, int K, int M, int N,
                           char* smem, int bid, int nb, Epi epi) {
  u16* As = (u16*)smem;
  u16* Bs = (u16*)(smem + 2 * G_BM * G_LD * 2);
  const int tid = tidx(), wid = tid >> 6, lane = tid & 63;
  const int wr = wid >> 1, wc = wid & 1, fr = lane & 15, fq = lane >> 4;
  const int ntn = N / G_BN, ntiles = (M / G_BM) * ntn, nk = K / G_BK;
  const int lrow = tid >> 3, lkc = (tid & 7) * 8;
  for (int tile = bid; tile < ntiles; tile += nb) {
    const int m0 = (tile / ntn) * G_BM, n0 = (tile % ntn) * G_BN;
    f32x4 acc[4][4];
#pragma unroll
    for (int i = 0; i < 4; ++i)
#pragma unroll
      for (int j = 0; j < 4; ++j) acc[i][j] = (f32x4){0.f, 0.f, 0.f, 0.f};
    u32x4 ra[4], rb[2];
    const u16* Ag = A + (size_t)(m0 + lrow) * lda + lkc;
    const u16* Bg = Bt + (size_t)(n0 + lrow) * ldb + lkc;
#pragma unroll
    for (int i = 0; i < 4; ++i) ra[i] = *(const u32x4*)(Ag + (size_t)(64 * i) * lda);
#pragma unroll
    for (int i = 0; i < 2; ++i) rb[i] = *(const u32x4*)(Bg + (size_t)(64 * i) * ldb);
    __syncthreads();
#pragma unroll
    for (int i = 0; i < 4; ++i) *(u32x4*)(As + (lrow + 64 * i) * G_LD + lkc) = ra[i];
#pragma unroll
    for (int i = 0; i < 2; ++i) *(u32x4*)(Bs + (lrow + 64 * i) * G_LD + lkc) = rb[i];
    __syncthreads();
    for (int kt = 0; kt < nk; ++kt) {
      const int buf = kt & 1;
      if (kt + 1 < nk) {
#pragma unroll
        for (int i = 0; i < 4; ++i) ra[i] = *(const u32x4*)(Ag + (size_t)(64 * i) * lda + (kt + 1) * G_BK);
#pragma unroll
        for (int i = 0; i < 2; ++i) rb[i] = *(const u32x4*)(Bg + (size_t)(64 * i) * ldb + (kt + 1) * G_BK);
      }
      const u16* as = As + buf * (G_BM * G_LD);
      const u16* bs = Bs + buf * (G_BN * G_LD);
#pragma unroll
      for (int ks = 0; ks < 2; ++ks) {
        bf16x8 af[4], bfr[4];
#pragma unroll
        for (int mi = 0; mi < 4; ++mi) af[mi] = *(const bf16x8*)(as + (wr * 64 + mi * 16 + fr) * G_LD + ks * 32 + fq * 8);
#pragma unroll
        for (int ni = 0; ni < 4; ++ni) bfr[ni] = *(const bf16x8*)(bs + (wc * 64 + ni * 16 + fr) * G_LD + ks * 32 + fq * 8);
#pragma unroll
        for (int mi = 0; mi < 4; ++mi)
#pragma unroll
          for (int ni = 0; ni < 4; ++ni)
            acc[mi][ni] = __builtin_amdgcn_mfma_f32_16x16x32_bf16(af[mi], bfr[ni], acc[mi][ni], 0, 0, 0);
      }
      if (kt + 1 < nk) {
        u16* as2 = As + (buf ^ 1) * (G_BM * G_LD);
        u16* bs2 = Bs + (buf ^ 1) * (G_BN * G_LD);
#pragma unroll
        for (int i = 0; i < 4; ++i) *(u32x4*)(as2 + (lrow + 64 * i) * G_LD + lkc) = ra[i];
#pragma unroll
        for (int i = 0; i < 2; ++i) *(u32x4*)(bs2 + (lrow + 64 * i) * G_LD + lkc) = rb[i];
      }
      __syncthreads();
    }
#pragma unroll
    for (int mi = 0; mi < 4; ++mi)
#pragma unroll
      for (int ni = 0; ni < 4; ++ni) epi(m0 + wr * 64 + mi * 16 + fq * 4, n0 + wc * 64 + ni * 16 + fr, acc[mi][ni]);
  }
}

namespace pg8 {
#define PG8_LAS __attribute__((address_space(3)))
typedef unsigned short bf16_t;
typedef short bf16x8 __attribute__((ext_vector_type(8)));
typedef float f32x4 __attribute__((ext_vector_type(4)));
typedef unsigned u32x4 __attribute__((ext_vector_type(4)));
constexpr int BM = 256, BK = 64, HALF = 128, HTB = HALF * BK * 2  , STAGE_BYTES = 8 * HTB, NXCD = 8, WGM = 8;

__host__ __device__ __forceinline__ int lds_byte(int r, int c) { const int st = (r >> 4) * 2 + (c >> 5), rr = r & 15, cc = c & 31, ob = rr * 64 + cc * 2; return st * 1024 + (ob ^ (((ob >> 9) & 1) << 5)); }
__host__ __device__ __forceinline__ void stage_rc(int b, int& R, int& C) { const int st = b / 1024, sb = b % 1024, swz = sb ^ (((sb >> 9) & 1) << 5); R = (st >> 1) * 16 + swz / 64; C = (st & 1) * 32 + (swz % 64) / 2; }
__host__ __device__ __forceinline__ int perm32(int rho) { const int n = rho >> 4, i = rho & 15; return 8 * (i >> 2) + 4 * n + (i & 3); }

struct Unit { int pm, pn; };
struct Gemm { const bf16_t* A; const bf16_t* Bt; int M, N, K; };

struct StaticOrder {
    int nM, nN, nwg, G, c;
    __host__ __device__ void init(int M, int N, int G_, int c_) { nM = M / BM; nN = N / BM; nwg = nM * nN; G = G_; c = c_; }
    __host__ __device__ bool next(int i, Unit& u) const {
        const long L = (long)i * G + c; if (L >= nwg) return false;
        int wgid = (int)L; { const int q = nwg / NXCD, r = nwg % NXCD, xcd = wgid % NXCD, off = wgid / NXCD; wgid = (xcd < r ? xcd * (q + 1) : r * (q + 1) + (xcd - r) * q) + off; }
        const int nig = WGM * nN, gid = wgid / nig, fm = gid * WGM, gsz = (nM - fm) < WGM ? (nM - fm) : WGM;
        u.pm = fm + ((wgid % nig) % gsz); u.pn = (wgid % nig) / gsz; return true;
    }
    __device__ __forceinline__ void a_ready(const Unit&) const {}
    __device__ __forceinline__ void done(const Unit&) const {}
};
__device__ __forceinline__ unsigned cvt_pk_bf16(float lo, float hi) { return ::pack2(lo, hi); }
typedef float f32x2 __attribute__((ext_vector_type(2)));
template <class Epi, class Sched, bool STAMP = false>
__device__ __forceinline__ void gemm_phase(PG8_LAS unsigned char* lds, const Gemm g, const Sched& S, const Epi& E, unsigned long long* stamps) {
    const int tid = tidx(), wid = __builtin_amdgcn_readfirstlane(tid >> 6), lane = tid & 63, wr = wid >> 2, wc = wid & 3, fr = lane & 15, fq = lane >> 4;
    const int K = g.K, nt = K / BK;
    int ts_lo = 0, ts_hi = 0, nts = 0; const unsigned long long rt_entry = STAMP ? (unsigned long long)wall_clock64() : 0ull;
#define PG8_STAMP() do { if (STAMP && wid == 0 && nts < 64) { const unsigned long long _c = (unsigned long long)clock64(); \
        ts_lo = (lane == nts) ? (int)(unsigned)_c : ts_lo; ts_hi = (lane == nts) ? (int)(unsigned)(_c >> 32) : ts_hi; ++nts; } } while (0)
    PG8_STAMP();
    unsigned voffA[2], voffB[2];
#pragma unroll
    for (int i = 0; i < 2; ++i) { int R, C; stage_rc(tid * 16 + i * 8192, R, C); const int Rb = Epi::PERM ? ((R & ~31) + perm32(R & 31)) : R;
        voffA[i] = (unsigned)(R * K + C) * 2u; voffB[i] = (unsigned)(Rb * K + C) * 2u; }
    const size_t kstep = (size_t)(BK * 2);
    const size_t hstep = (size_t)HALF * K * 2;
    const size_t tstep = 2 * hstep;
    const unsigned ldsw = (unsigned)wid * 1024u;
    const int aoff = lds_byte(wr * 64 + fr, fq * 8), boff = lds_byte(wc * 32 + fr, fq * 8);
#define PG8_SA(b, h) (((b) * 2 + (h)) * HTB)
#define PG8_SB(b, h) ((4 + (b) * 2 + (h)) * HTB)
#define PG8_STAGE(bufoff, gbase, voff) do { _Pragma("unroll") for (int _i = 0; _i < 2; ++_i) \
        __builtin_amdgcn_global_load_lds((const unsigned*)((const char*)(gbase) + (voff)[_i]), (PG8_LAS unsigned*)(lds + (bufoff) + ldsw + _i * 8192), 16, 0, 0); } while (0)
#define PG8_LDA(dst, b, h) do { _Pragma("unroll") for (int m = 0; m < 4; ++m) _Pragma("unroll") for (int k = 0; k < 2; ++k) dst[m][k] = *(const PG8_LAS bf16x8*)(lds + PG8_SA(b, h) + aoff + m * 2048 + k * 1024); } while (0)
#define PG8_LDB(dst, b, h) do { _Pragma("unroll") for (int n = 0; n < 2; ++n) _Pragma("unroll") for (int k = 0; k < 2; ++k) dst[n][k] = *(const PG8_LAS bf16x8*)(lds + PG8_SB(b, h) + boff + n * 2048 + k * 1024); } while (0)
#define PG8_MMA(ai, bj, At, Bt) do { __builtin_amdgcn_s_setprio(1); _Pragma("unroll") for (int m = 0; m < 4; ++m) _Pragma("unroll") for (int n = 0; n < 2; ++n) _Pragma("unroll") for (int k = 0; k < 2; ++k) \
        acc[ai][bj][m][n] = __builtin_amdgcn_mfma_f32_16x16x32_bf16(Bt[n][k], At[m][k], acc[ai][bj][m][n], 0, 0, 0); __builtin_amdgcn_s_setprio(0); } while (0)
#define PG8_WAIT_V(n) asm volatile("s_waitcnt vmcnt(" #n ")" ::: "memory")
#define PG8_WAIT_L(n) asm volatile("s_waitcnt lgkmcnt(" #n ")" ::: "memory")
#define PG8_BAR __builtin_amdgcn_s_barrier()
#define PG8_SCHED __builtin_amdgcn_sched_barrier(0)
    Unit cur, nxt; int ui = 0;
    if (!S.next(0, cur)) return;
    f32x4 acc[2][2][4][2];
#pragma unroll
    for (int a = 0; a < 2; ++a)
#pragma unroll
        for (int b = 0; b < 2; ++b)
#pragma unroll
            for (int m = 0; m < 4; ++m)
#pragma unroll
                for (int n = 0; n < 2; ++n) acc[a][b][m][n] = (f32x4){0.f, 0.f, 0.f, 0.f};
    bf16x8 At[4][2], B0[2][2], B1[2][2];
    const char* cA = (const char*)g.A + (size_t)cur.pm * tstep; const char* cB = (const char*)g.Bt + (size_t)cur.pn * tstep;
    S.a_ready(cur);
    PG8_STAGE(PG8_SB(0, 0), cB, voffB); PG8_STAGE(PG8_SA(0, 0), cA, voffA); PG8_STAGE(PG8_SB(0, 1), cB + hstep, voffB); PG8_STAGE(PG8_SA(0, 1), cA + hstep, voffA);
    if (wr == 1) PG8_BAR;
    PG8_WAIT_V(4); PG8_BAR;
    PG8_STAGE(PG8_SB(1, 0), cB + kstep, voffB); PG8_STAGE(PG8_SA(1, 0), cA + kstep, voffA); PG8_STAGE(PG8_SB(1, 1), cB + hstep + kstep, voffB);
    PG8_WAIT_V(6); PG8_BAR;
    PG8_STAMP();
    for (;;) {
        const bool has_next = S.next(ui + 1, nxt);
        const char* nA = has_next ? (const char*)g.A + (size_t)nxt.pm * tstep : cA; const char* nB = has_next ? (const char*)g.Bt + (size_t)nxt.pn * tstep : cB;
        for (int t = 0; t < nt; t += 2) {
            const bool last = (t == nt - 2);
            const char* a1 = cA + (size_t)(t + 1) * kstep;
            const char* a2 = last ? nA : cA + (size_t)(t + 2) * kstep; const char* b2 = last ? nB : cB + (size_t)(t + 2) * kstep;
            const char* a3 = a2 + kstep; const char* b3 = b2 + kstep;
            if (last && has_next) S.a_ready(nxt);
            PG8_LDB(B0, 0, 0); PG8_SCHED; PG8_LDA(At, 0, 0); PG8_STAGE(PG8_SA(1, 1), a1 + hstep, voffA);
            PG8_WAIT_L(8); PG8_BAR; PG8_WAIT_L(0); PG8_MMA(0, 0, At, B0); PG8_BAR; PG8_SCHED;
            PG8_LDB(B1, 0, 1); PG8_STAGE(PG8_SB(0, 0), b2, voffB);
            PG8_BAR; PG8_WAIT_L(0); PG8_MMA(0, 1, At, B1); PG8_BAR;
            PG8_LDA(At, 0, 1); PG8_STAGE(PG8_SA(0, 0), a2, voffA);
            PG8_BAR; PG8_WAIT_L(0); PG8_MMA(1, 0, At, B0); PG8_BAR; PG8_SCHED;
            PG8_STAGE(PG8_SB(0, 1), b2 + hstep, voffB);
            PG8_WAIT_V(6); PG8_BAR; PG8_MMA(1, 1, At, B1); PG8_BAR;
            PG8_LDB(B0, 1, 0); PG8_SCHED; PG8_LDA(At, 1, 0); PG8_STAGE(PG8_SA(0, 1), a2 + hstep, voffA);
            PG8_WAIT_L(8); PG8_BAR; PG8_WAIT_L(0); PG8_MMA(0, 0, At, B0); PG8_BAR; PG8_SCHED;
            PG8_LDB(B1, 1, 1); PG8_STAGE(PG8_SB(1, 0), b3, voffB);
            PG8_BAR; PG8_WAIT_L(0); PG8_MMA(0, 1, At, B1); PG8_BAR;
            PG8_LDA(At, 1, 1); PG8_STAGE(PG8_SA(1, 0), a3, voffA);
            PG8_BAR; PG8_WAIT_L(0); PG8_MMA(1, 0, At, B0); PG8_BAR; PG8_SCHED;
            PG8_STAGE(PG8_SB(1, 1), b3 + hstep, voffB);
            PG8_WAIT_V(6); PG8_BAR; PG8_MMA(1, 1, At, B1); PG8_BAR;
        }
        PG8_STAMP();
        if constexpr (!Epi::AFTER_DRAIN) { E(acc, cur, wr, wc, fr, fq); S.done(cur); }
        PG8_STAMP();
        if (!has_next) break;
#pragma unroll
        for (int a = 0; a < 2; ++a)
#pragma unroll
            for (int b = 0; b < 2; ++b)
#pragma unroll
                for (int m = 0; m < 4; ++m)
#pragma unroll
                    for (int n = 0; n < 2; ++n) acc[a][b][m][n] = (f32x4){0.f, 0.f, 0.f, 0.f};
        cur = nxt; cA = nA; cB = nB; ++ui;
    }
    PG8_WAIT_V(0);
    if (wr == 0) PG8_BAR;
    PG8_BAR;
    if constexpr (Epi::AFTER_DRAIN) { E.fused(acc, cur, wr, wc, fr, fq, lds, wid, lane); S.done(cur); }
    PG8_STAMP();
    if (STAMP && wid == 0) { stamps[lane] = lane < nts ? (((unsigned long long)(unsigned)ts_hi << 32) | (unsigned)ts_lo) : 0ull;
        if (lane == 62) stamps[62] = rt_entry; if (lane == 63) stamps[63] = (unsigned long long)wall_clock64(); }
#undef PG8_STAMP
#undef PG8_SA
#undef PG8_SB
#undef PG8_STAGE
#undef PG8_LDA
#undef PG8_LDB
#undef PG8_MMA
#undef PG8_WAIT_V
#undef PG8_WAIT_L
#undef PG8_BAR
#undef PG8_SCHED
}
}

namespace pg8 {
struct EpiProjT {
  static constexpr bool PERM = true, AFTER_DRAIN = false;
  bf16_t* O; int ldc; int ncols;
  __device__ __forceinline__ void operator()(const f32x4 (&acc)[2][2][4][2], const Unit& u, int wr, int wc, int fr, int fq) const {
    const int row0 = u.pm * BM + wr * 64 + fr, col0 = u.pn * BM + wc * 32 + 8 * fq;
#pragma unroll
    for (int ai = 0; ai < 2; ++ai)
#pragma unroll
      for (int m = 0; m < 4; ++m) {
        bf16_t* rowp = O + (size_t)(row0 + ai * HALF + m * 16) * ldc + col0;
#pragma unroll
        for (int bj = 0; bj < 2; ++bj) {
          if (col0 + bj * HALF < ncols) {
            const f32x4 v0 = acc[ai][bj][m][0], v1 = acc[ai][bj][m][1];
            u32x4 w; w.x = cvt_pk_bf16(v0[0], v0[1]); w.y = cvt_pk_bf16(v0[2], v0[3]); w.z = cvt_pk_bf16(v1[0], v1[1]); w.w = cvt_pk_bf16(v1[2], v1[3]);
            *(u32x4*)(rowp + bj * HALF) = w;
          }
        }
      }
  }
};
struct EpiGluT {
  static constexpr bool PERM = true, AFTER_DRAIN = false;
  const bf16_t* Y1; const float* bglu; bf16_t* O;
  __device__ __forceinline__ void operator()(const f32x4 (&acc)[2][2][4][2], const Unit& u, int wr, int wc, int fr, int fq) const {
    const int row0 = u.pm * BM + wr * 64 + fr, col0 = u.pn * BM + wc * 32 + 8 * fq;
    f32x4 bv[2][2];
#pragma unroll
    for (int bj = 0; bj < 2; ++bj)
#pragma unroll
      for (int n = 0; n < 2; ++n) bv[bj][n] = *(const f32x4*)(bglu + col0 + bj * HALF + 4 * n);
#pragma unroll
    for (int ai = 0; ai < 2; ++ai)
#pragma unroll
      for (int m = 0; m < 4; ++m) {
        const size_t r = (size_t)(row0 + ai * HALF + m * 16);
#pragma unroll
        for (int bj = 0; bj < 2; ++bj) {
          const u32x4 yv = *(const u32x4*)(Y1 + r * 512 + col0 + bj * HALF);
          const f32x4 v0 = acc[ai][bj][m][0] + bv[bj][0], v1 = acc[ai][bj][m][1] + bv[bj][1];
          float o[8];
#pragma unroll
          for (int q = 0; q < 4; ++q) {
            const float ylo = __uint_as_float(yv[q] << 16), yhi = __uint_as_float(yv[q] & 0xffff0000u);
            const float a0 = q < 2 ? v0[2 * q] : v1[2 * q - 4], a1 = q < 2 ? v0[2 * q + 1] : v1[2 * q - 3];
            o[2 * q] = ylo / (1.f + __expf(-a0));
            o[2 * q + 1] = yhi / (1.f + __expf(-a1));
          }
          u32x4 w; w.x = cvt_pk_bf16(o[0], o[1]); w.y = cvt_pk_bf16(o[2], o[3]); w.z = cvt_pk_bf16(o[4], o[5]); w.w = cvt_pk_bf16(o[6], o[7]);
          *(u32x4*)(O + r * 1024 + col0 + bj * HALF) = w;
        }
      }
  }
};
struct EpiGateT {
  static constexpr bool PERM = true, AFTER_DRAIN = false;
  const bf16_t* T1; bf16_t* O;
  __device__ __forceinline__ void operator()(const f32x4 (&acc)[2][2][4][2], const Unit& u, int wr, int wc, int fr, int fq) const {
    const int row0 = u.pm * BM + wr * 64 + fr, col0 = u.pn * BM + wc * 32 + 8 * fq;
#pragma unroll
    for (int ai = 0; ai < 2; ++ai)
#pragma unroll
      for (int m = 0; m < 4; ++m) {
        const size_t r = (size_t)(row0 + ai * HALF + m * 16);
#pragma unroll
        for (int bj = 0; bj < 2; ++bj) {
          const u32x4 tv = *(const u32x4*)(T1 + r * 512 + col0 + bj * HALF);
          const f32x4 v0 = acc[ai][bj][m][0], v1 = acc[ai][bj][m][1];
          u32x4 w;
          w.x = cvt_pk_bf16(__uint_as_float(tv[0] << 16) * v0[0], __uint_as_float(tv[0] & 0xffff0000u) * v0[1]);
          w.y = cvt_pk_bf16(__uint_as_float(tv[1] << 16) * v0[2], __uint_as_float(tv[1] & 0xffff0000u) * v0[3]);
          w.z = cvt_pk_bf16(__uint_as_float(tv[2] << 16) * v1[0], __uint_as_float(tv[2] & 0xffff0000u) * v1[1]);
          w.w = cvt_pk_bf16(__uint_as_float(tv[3] << 16) * v1[2], __uint_as_float(tv[3] & 0xffff0000u) * v1[3]);
          *(u32x4*)(O + r * 1024 + 512 + col0 + bj * HALF) = w;
        }
      }
  }
};
struct EpiWoutT {
  static constexpr bool PERM = false, AFTER_DRAIN = false;
  const float* X; const float* mod; float* H2;
  __device__ __forceinline__ void operator()(const f32x4 (&acc)[2][2][4][2], const Unit& u, int wr, int wc, int fr, int fq) const {
    const int row0 = u.pm * BM + wr * 64 + fr, col0 = u.pn * BM + wc * 32 + 4 * fq;
    const float* g1p = mod + ((u.pm * BM) >> 11) * 6144 + 2 * 1024 + col0;
    f32x4 gv[2][2];
#pragma unroll
    for (int bj = 0; bj < 2; ++bj)
#pragma unroll
      for (int n = 0; n < 2; ++n) gv[bj][n] = *(const f32x4*)(g1p + bj * HALF + n * 16);
#pragma unroll
    for (int ai = 0; ai < 2; ++ai)
#pragma unroll
      for (int m = 0; m < 4; ++m) {
        const size_t off = (size_t)(row0 + ai * HALF + m * 16) * 1024 + col0;
#pragma unroll
        for (int bj = 0; bj < 2; ++bj)
#pragma unroll
          for (int n = 0; n < 2; ++n) {
            const f32x4 xv = *(const f32x4*)(X + off + bj * HALF + n * 16);
            *(f32x4*)(H2 + off + bj * HALF + n * 16) = xv + gv[bj][n] * acc[ai][bj][m][n];
          }
      }
  }
};
}

struct EpiProj {
  u16* proj;
  __device__ __forceinline__ void operator()(int r, int c, f32x4 v) const {
    if (c < INC) {
#pragma unroll
      for (int j = 0; j < 4; ++j) proj[(size_t)(r + j) * INC + c] = f2bf(v[j]);
    }
  }
};
struct EpiGlu {
  const u16* y1; const float* bglu; u16* a2;
  __device__ __forceinline__ void operator()(int r, int c, f32x4 v) const {
    float bb = bglu[c];
#pragma unroll
    for (int j = 0; j < 4; ++j) {
      float y = bf2f(y1[(size_t)(r + j) * 512 + c]);
      a2[(size_t)(r + j) * 1024 + c] = f2bf(y * sigmoidf(v[j] + bb));
    }
  }
};
struct EpiGate {
  const u16* t1; u16* a2;
  __device__ __forceinline__ void operator()(int r, int c, f32x4 v) const {
#pragma unroll
    for (int j = 0; j < 4; ++j) {
      float t = bf2f(t1[(size_t)(r + j) * 512 + c]);
      a2[(size_t)(r + j) * 1024 + 512 + c] = f2bf(t * v[j]);
    }
  }
};
struct EpiWout {
  const float* x; const float* mod; float* h2;
  __device__ __forceinline__ void operator()(int r, int c, f32x4 v) const {
    float g1 = mod[(r >> 11) * 6144 + 2 * 1024 + c];
#pragma unroll
    for (int j = 0; j < 4; ++j) h2[(size_t)(r + j) * 1024 + c] = x[(size_t)(r + j) * 1024 + c] + g1 * v[j];
  }
};
struct EpiQ {
  u16* q;
  __device__ __forceinline__ void operator()(int r, int c, f32x4 v) const {
#pragma unroll
    for (int j = 0; j < 4; ++j) q[(size_t)(r + j) * 2048 + c] = f2bf(v[j]);
  }
};

__device__ __forceinline__ void ph_s5scan(const P& p, char* smem, int bid, int nb) {
  const int wid = tidx() >> 6, lane = tidx() & 63;
  float* U = (float*)(smem + wid * 8448);
  unsigned* H = (unsigned*)((char*)U + 4096);
  const int fr = lane & 15, fq = lane >> 4;
  for (int s = bid * 8 + wid; s < 2048; s += nb * 8) {
    const int g = s & 31, d = (s >> 5) & 1, b = s >> 6;
    const int ci = (d * 32 + g) * 64 + lane;
    const float abr = p.s5ab()[ci * 2], abi = p.s5ab()[ci * 2 + 1];
    float bbr[16], bbi[16];
#pragma unroll
    for (int q = 0; q < 4; ++q) {
      float4 t = *(const float4*)(p.s5bb() + (size_t)ci * 32 + q * 4);
      bbr[q * 4] = t.x; bbr[q * 4 + 1] = t.y; bbr[q * 4 + 2] = t.z; bbr[q * 4 + 3] = t.w;
      float4 t2 = *(const float4*)(p.s5bb() + (size_t)ci * 32 + 16 + q * 4);
      bbi[q * 4] = t2.x; bbi[q * 4 + 1] = t2.y; bbi[q * 4 + 2] = t2.z; bbi[q * 4 + 3] = t2.w;
    }
    bf16x8 cf[4];
#pragma unroll
    for (int kb = 0; kb < 4; ++kb)
      cf[kb] = *(const bf16x8*)(p.s5ct() + ((size_t)(d * 32 + g) * 16 + fr) * 128 + kb * 32 + fq * 8);
    const float dcoef = p.s5_d[g * 16 + fr];
    u16* ydst = d ? p.ys5b() : p.ys5f();
    float hr = 0.f, hi = 0.f;
    for (int seg = 0; seg < 2; ++seg) {
      const int L = seg ? 2048 : 256;
      const int rowbase = seg ? b * 2048 : NLAT + b * 256;
      for (int c0 = 0; c0 < L; c0 += 64) {
        {
          int pos = c0 + lane;
          int t = d ? (L - 1 - pos) : pos;
          const u16* src = p.proj() + (size_t)(rowbase + t) * INC + g * 16;
          uint4 v0 = *(const uint4*)src, v1 = *(const uint4*)(src + 8);
          float4* ud = (float4*)(U + lane * 16);
          ud[0] = make_float4(bflo(v0.x), bfhi(v0.x), bflo(v0.y), bfhi(v0.y));
          ud[1] = make_float4(bflo(v0.z), bfhi(v0.z), bflo(v0.w), bfhi(v0.w));
          ud[2] = make_float4(bflo(v1.x), bfhi(v1.x), bflo(v1.y), bfhi(v1.y));
          ud[3] = make_float4(bflo(v1.z), bfhi(v1.z), bflo(v1.w), bfhi(v1.w));
        }
        for (int sub = 0; sub < 4; ++sub) {
#pragma unroll 4
          for (int i = 0; i < 16; ++i) {
            const float4* up = (const float4*)(U + (sub * 16 + i) * 16);
            float4 u0 = up[0], u1 = up[1], u2 = up[2], u3 = up[3];
            float ur[16] = {u0.x, u0.y, u0.z, u0.w, u1.x, u1.y, u1.z, u1.w, u2.x, u2.y, u2.z, u2.w, u3.x, u3.y, u3.z, u3.w};
            float br0 = 0.f, br1 = 0.f, bi0 = 0.f, bi1 = 0.f;
#pragma unroll
            for (int h = 0; h < 16; h += 2) {
              br0 += bbr[h] * ur[h]; br1 += bbr[h + 1] * ur[h + 1];
              bi0 += bbi[h] * ur[h]; bi1 += bbi[h + 1] * ur[h + 1];
            }
            float nr = abr * hr - abi * hi + (br0 + br1);
            float ni = abr * hi + abi * hr + (bi0 + bi1);
            hr = nr; hi = ni;
            if (seg) H[i * 68 + lane] = pack2(hr, hi);
          }
          if (seg) {
            f32x4 acc = (f32x4){0.f, 0.f, 0.f, 0.f};
#pragma unroll
            for (int kb = 0; kb < 4; ++kb) {
              bf16x8 a = *(const bf16x8*)((const u16*)H + fr * 136 + kb * 32 + fq * 8);
              acc = __builtin_amdgcn_mfma_f32_16x16x32_bf16(a, cf[kb], acc, 0, 0, 0);
            }
#pragma unroll
            for (int j = 0; j < 4; ++j) {
              int pi = sub * 16 + fq * 4 + j;
              int pos = c0 + pi;
              int t = d ? (L - 1 - pos) : pos;
              float y = acc[j];
              if (d == 0) y += dcoef * U[pi * 16 + fr];
              ydst[(size_t)(b * 2048 + t) * 512 + g * 16 + fr] = f2bf(y);
            }
          }
        }
      }
    }
  }
}

#define S5_LD 168
__device__ __forceinline__ void ph_s5scan2(const P& p, char* smem, int bid, int nb) {
  const int wid = tidx() >> 6, lane = tidx() & 63;
  u16* H = (u16*)(smem + wid * (32 * S5_LD * 2));
  const int n = lane & 31, hh = lane >> 5, fr = lane & 15, fq = lane >> 4;
  for (int r = lane; r < 32; r += 64) {
    *(uint4*)(H + r * S5_LD + 144) = make_uint4(0u, 0u, 0u, 0u);
    *(uint4*)(H + r * S5_LD + 152) = make_uint4(0u, 0u, 0u, 0u);
    *(uint4*)(H + r * S5_LD + 160) = make_uint4(0u, 0u, 0u, 0u);
  }
  for (int s = bid * 8 + wid; s < 2048; s += nb * 8) {
    const int g = s & 31, d = (s >> 5) & 1, b = s >> 6;
    float ar[2][4], ai[2][4], a8r[2], a8i[2];
#pragma unroll
    for (int st = 0; st < 2; ++st) {
      const int ci = (d * 32 + g) * 64 + st * 32 + n;
      const float xr = p.s5ab()[ci * 2], xi = p.s5ab()[ci * 2 + 1];
      ar[st][0] = xr; ai[st][0] = xi;
#pragma unroll
      for (int k = 1; k < 4; ++k) {
        ar[st][k] = ar[st][k - 1] * xr - ai[st][k - 1] * xi;
        ai[st][k] = ar[st][k - 1] * xi + ai[st][k - 1] * xr;
      }
      a8r[st] = ar[st][3] * ar[st][3] - ai[st][3] * ai[st][3];
      a8i[st] = 2.f * ar[st][3] * ai[st][3];
    }
    bf16x8 bfr[4];
#pragma unroll
    for (int nt = 0; nt < 4; ++nt) {
      const int ci = (d * 32 + g) * 64 + (nt & 1) * 32 + n;
      const float4 t0 = *(const float4*)(p.s5bb() + (size_t)ci * 32 + (nt >> 1) * 16 + 8 * hh);
      const float4 t1 = *(const float4*)(p.s5bb() + (size_t)ci * 32 + (nt >> 1) * 16 + 8 * hh + 4);
      union { unsigned u[4]; bf16x8 v; } t;
      t.u[0] = pack2(t0.x, t0.y); t.u[1] = pack2(t0.z, t0.w); t.u[2] = pack2(t1.x, t1.y); t.u[3] = pack2(t1.z, t1.w);
      bfr[nt] = t.v;
    }
    bf16x8 cf[5];
#pragma unroll
    for (int kb = 0; kb < 4; ++kb)
      cf[kb] = *(const bf16x8*)(p.s5ct() + ((size_t)(d * 32 + g) * 16 + fr) * 128 + kb * 32 + fq * 8);
    {
      const float dv = (d == 0) ? p.s5_d[g * 16 + fr] : 0.f;
      union { u16 h[8]; bf16x8 v; } t;
#pragma unroll
      for (int j = 0; j < 8; ++j) t.h[j] = (8 * fq + j == fr) ? f2bf(dv) : (u16)0;
      cf[4] = t.v;
    }
    u16* ydst = d ? p.ys5b() : p.ys5f();
    float hcr[2] = {0.f, 0.f}, hci[2] = {0.f, 0.f};
    for (int seg = 0; seg < 2; ++seg) {
      const int L = seg ? 2048 : 256;
      const int rowbase = seg ? b * 2048 : NLAT + b * 256;
      uint4 anext;
      {
        const int pos = n;
        const int t = d ? (L - 1 - pos) : pos;
        anext = *(const uint4*)(p.proj() + (size_t)(rowbase + t) * INC + g * 16 + 8 * hh);
      }
      for (int c0 = 0; c0 < L; c0 += 32) {
        const uint4 acur = anext;
        if (c0 + 32 < L) {
          const int pos = c0 + 32 + n;
          const int t = d ? (L - 1 - pos) : pos;
          anext = *(const uint4*)(p.proj() + (size_t)(rowbase + t) * INC + g * 16 + 8 * hh);
        }
        union { uint4 q; bf16x8 v; } af;
        af.q = acur;
        f32x16 acc[4];
#pragma unroll
        for (int nt = 0; nt < 4; ++nt) {
          f32x16 z;
#pragma unroll
          for (int r = 0; r < 16; ++r) z[r] = 0.f;
          acc[nt] = __builtin_amdgcn_mfma_f32_32x32x16_bf16(af.v, bfr[nt], z, 0, 0, 0);
        }
#pragma unroll
        for (int st = 0; st < 2; ++st)
#pragma unroll
          for (int gg = 0; gg < 4; ++gg)
#pragma unroll
            for (int j = 1; j < 4; ++j) {
              const float pr = acc[st][4 * gg + j - 1], pi = acc[2 + st][4 * gg + j - 1];
              acc[st][4 * gg + j] += ar[st][0] * pr - ai[st][0] * pi;
              acc[2 + st][4 * gg + j] += ar[st][0] * pi + ai[st][0] * pr;
            }
        float sr[2][4], si[2][4];
        {
          float e0r[2][4], e0i[2][4], qpr[2][4], qpi[2][4], s1r[2][4], s1i[2][4];
#pragma unroll
          for (int st = 0; st < 2; ++st)
#pragma unroll
            for (int gg = 0; gg < 4; ++gg) {
              e0r[st][gg] = __shfl_xor(acc[st][4 * gg + 3], 32, 64);
              e0i[st][gg] = __shfl_xor(acc[2 + st][4 * gg + 3], 32, 64);
            }
#pragma unroll
          for (int st = 0; st < 2; ++st) {
            float qr = hcr[st], qi = hci[st];
#pragma unroll
            for (int gg = 0; gg < 4; ++gg) {
              const float er = acc[st][4 * gg + 3], ei = acc[2 + st][4 * gg + 3];
              qpr[st][gg] = qr; qpi[st][gg] = qi;
              s1r[st][gg] = ar[st][3] * qr - ai[st][3] * qi + e0r[st][gg];
              s1i[st][gg] = ar[st][3] * qi + ai[st][3] * qr + e0i[st][gg];
              const float nqr = ar[st][3] * s1r[st][gg] - ai[st][3] * s1i[st][gg] + er;
              const float nqi = ar[st][3] * s1i[st][gg] + ai[st][3] * s1r[st][gg] + ei;
              qr = nqr; qi = nqi;
            }
            hcr[st] = qr; hci[st] = qi;
          }
#pragma unroll
          for (int st = 0; st < 2; ++st)
#pragma unroll
            for (int gg = 0; gg < 4; ++gg) {
              const float s0r = __shfl_xor(qpr[st][gg], 32, 64), s0i = __shfl_xor(qpi[st][gg], 32, 64);
              sr[st][gg] = hh ? s1r[st][gg] : s0r;
              si[st][gg] = hh ? s1i[st][gg] : s0i;
            }
        }
        if (seg) {
#pragma unroll
          for (int st = 0; st < 2; ++st)
#pragma unroll
            for (int gg = 0; gg < 4; ++gg)
#pragma unroll
              for (int j = 0; j < 4; ++j) {
                const float hr_ = acc[st][4 * gg + j] + ar[st][j] * sr[st][gg] - ai[st][j] * si[st][gg];
                const float hi_ = acc[2 + st][4 * gg + j] + ar[st][j] * si[st][gg] + ai[st][j] * sr[st][gg];
                const int tok = 8 * gg + 4 * hh + j;
                *(unsigned*)(H + tok * S5_LD + 2 * (st * 32 + n)) = pack2(hr_, hi_);
              }
          *(uint4*)(H + n * S5_LD + 128 + 8 * hh) = acur;
#pragma unroll
          for (int mt = 0; mt < 2; ++mt) {
            f32x4 y = (f32x4){0.f, 0.f, 0.f, 0.f};
#pragma unroll
            for (int kb = 0; kb < 5; ++kb) {
              const bf16x8 a = *(const bf16x8*)(H + (16 * mt + fr) * S5_LD + kb * 32 + fq * 8);
              y = __builtin_amdgcn_mfma_f32_16x16x32_bf16(a, cf[kb], y, 0, 0, 0);
            }
#pragma unroll
            for (int j = 0; j < 4; ++j) {
              const int pos = c0 + 16 * mt + 4 * fq + j;
              const int t = d ? (L - 1 - pos) : pos;
              ydst[(size_t)(b * 2048 + t) * 512 + g * 16 + fr] = f2bf(y[j]);
            }
          }
        }
      }
    }
  }
}

__device__ __forceinline__ float4 mix_load4(const u16* __restrict__ proj, size_t row, int col, const size_t* nrow,
                                            const bool* nval, float4 mu) {
  uint2 cz = *(const uint2*)(proj + row * INC + col);
  float z[4] = {bflo(cz.x), bfhi(cz.x), bflo(cz.y), bfhi(cz.y)};
  float o[4];
  float m[4] = {mu.x, mu.y, mu.z, mu.w};
#pragma unroll
  for (int j = 0; j < 4; ++j) {
    float nbv = 0.f;
    if (nval[j]) {
      u16 t = proj[nrow[j] * INC + col + j];
      nbv = bf2f(t);
    }
    o[j] = z[j] + (nbv - z[j]) * m[j];
  }
  return make_float4(o[0], o[1], o[2], o[3]);
}
__device__ __forceinline__ void neighbours(bool isctx, size_t row, int t, size_t* nrow, bool* nval) {
  if (isctx) {
    nrow[0] = row - 1; nval[0] = t > 0;
    nrow[1] = row + 1; nval[1] = t < 255;
    nrow[2] = row - 1; nval[2] = t > 0;
    nrow[3] = row + 1; nval[3] = t < 255;
  } else {
    int col = t & 63, gr = t >> 6;
    nrow[0] = row - 1; nval[0] = col > 0;
    nrow[1] = row + 1; nval[1] = col < 63;
    nrow[2] = row - 64; nval[2] = gr > 0;
    nrow[3] = row + 64; nval[3] = gr < 31;
  }
}

__device__ __forceinline__ void ph_rwscan(const P& p, char* smem, int bid, int nb) {
  const int tid = tidx(), sl = tid >> 8, stid = tid & 255, wv = stid >> 6, lane = tid & 63;
  char* sb = smem + sl * 49152;
  float* OPS = (float*)sb;
  float* LW = (float*)(sb + 24576);
  float* LA = LW + 512;
  float* WW = (float*)(sb + 28672);
  float* WA = WW + 2048;
  float* YB = (float*)(sb + 45056);
  const int tt = stid >> 4, part = stid & 15;
  const int vrow = wv * 16 + (lane >> 2), kq = lane & 3;
  for (int sp = bid; sp < 256; sp += nb) {
    const int s = sp * 2 + sl;
    const int d = s & 1, h = (s >> 1) & 7, b = s >> 4;
    __syncthreads();
    for (int e = stid; e < 2048; e += 256) {
      int j = e >> 6, cc = e & 63;
      WW[e] = p.rw_w_w2[(size_t)(d * 32 + j) * 512 + h * 64 + cc];
      WA[e] = p.rw_w_a2[(size_t)(d * 32 + j) * 512 + h * 64 + cc];
    }
    const int hc = h * 64 + part * 4;
    const float4 w0v = *(const float4*)(p.rw_w0 + d * 512 + hc);
    const float4 a0v = *(const float4*)(p.rw_a0 + d * 512 + hc);
    const float4 kkv = *(const float4*)(p.rw_k_k + hc);
    const float4 kav = *(const float4*)(p.rw_k_a + hc);
    const float4 rkv = *(const float4*)(p.rw_r_k + hc);
    const float4 mur = *(const float4*)(p.rw_mu + hc);
    const float4 muk = *(const float4*)(p.rw_mu + 512 + hc);
    const float4 muv = *(const float4*)(p.rw_mu + 1024 + hc);
    const float4 mul = *(const float4*)(p.rw_mu + 1536 + part * 4);
    u16* ydst = d ? p.yrwb() : p.yrwf();
    float S[16];
#pragma unroll
    for (int i = 0; i < 16; ++i) S[i] = 0.f;
    for (int seg = 0; seg < 2; ++seg) {
      const int L = seg ? 2048 : 256;
      const size_t rowbase = seg ? (size_t)b * 2048 : (size_t)NLAT + b * 256;
      for (int c0 = 0; c0 < L; c0 += 16) {
        const int pos = c0 + tt;
        const int t = d ? (L - 1 - pos) : pos;
        const size_t row = rowbase + t;
        size_t nrow[4];
        bool nval[4];
        neighbours(seg == 0, row, t, nrow, nval);
        float4 r4 = mix_load4(p.proj(), row, 512 + hc, nrow, nval, mur);
        float4 k4 = mix_load4(p.proj(), row, 512 + 512 + hc, nrow, nval, muk);
        float4 v4 = mix_load4(p.proj(), row, 512 + 1024 + hc, nrow, nval, muv);
        float4 l4 = mix_load4(p.proj(), row, 512 + 1536 + part * 4, nrow, nval, mul);
        if (part < 8) {
          *(float4*)(LW + tt * 32 + part * 4) = make_float4(tanhf(l4.x), tanhf(l4.y), tanhf(l4.z), tanhf(l4.w));
        } else {
          *(float4*)(LA + tt * 32 + (part - 8) * 4) = l4;
        }
        __syncthreads();
        float wp[4] = {w0v.x, w0v.y, w0v.z, w0v.w};
        float ap[4] = {a0v.x, a0v.y, a0v.z, a0v.w};
#pragma unroll 8
        for (int j = 0; j < 32; ++j) {
          float lw = LW[tt * 32 + j], la = LA[tt * 32 + j];
          float4 ww = *(const float4*)(WW + j * 64 + part * 4);
          float4 wa = *(const float4*)(WA + j * 64 + part * 4);
          wp[0] += lw * ww.x; wp[1] += lw * ww.y; wp[2] += lw * ww.z; wp[3] += lw * ww.w;
          ap[0] += la * wa.x; ap[1] += la * wa.y; ap[2] += la * wa.z; ap[3] += la * wa.w;
        }
        float rr[4] = {r4.x, r4.y, r4.z, r4.w}, kk4[4] = {k4.x, k4.y, k4.z, k4.w};
        float kkc[4] = {kkv.x, kkv.y, kkv.z, kkv.w}, kac[4] = {kav.x, kav.y, kav.z, kav.w}, rkc[4] = {rkv.x, rkv.y, rkv.z, rkv.w};
        float dec[4], aa[4], kd[4], kkr[4];
        float ss = 0.f, bon = 0.f;
#pragma unroll
        for (int i = 0; i < 4; ++i) {
          float xw = -wp[i];
          float sp_ = fmaxf(xw, 0.f) + log1pf(expf(-fabsf(xw)));
          float wl = -sp_ - 0.5f;
          dec[i] = expf(-expf(wl));
          aa[i] = 1.f / (1.f + expf(-ap[i]));
          kd[i] = kk4[i] * (1.f + (aa[i] - 1.f) * kac[i]);
          kkr[i] = kk4[i] * kkc[i];
          ss += kkr[i] * kkr[i];
          bon += rr[i] * kd[i] * rkc[i];
        }
#pragma unroll
        for (int m = 0; m < 4; ++m) {
          ss = dpp_add(ss, m, 0);
          bon = dpp_add(bon, m, 0);
        }
        float inv = rsqrtf(ss + 1e-12f);
        float* o = OPS + tt * 384 + part * 4;
        *(float4*)(o + 0) = r4;
        *(float4*)(o + 64) = make_float4(dec[0], dec[1], dec[2], dec[3]);
        *(float4*)(o + 128) = make_float4(kd[0], kd[1], kd[2], kd[3]);
        *(float4*)(o + 192) = make_float4(-kkr[0] * inv, -kkr[1] * inv, -kkr[2] * inv, -kkr[3] * inv);
        *(float4*)(o + 256) = make_float4(kkr[0] * inv * aa[0], kkr[1] * inv * aa[1], kkr[2] * inv * aa[2], kkr[3] * inv * aa[3]);
        *(float4*)(o + 320) = v4;
        if (seg && part == 0) p.bsc()[((size_t)d * NLAT + row) * 8 + h] = bon;
        __syncthreads();
        for (int i = 0; i < 16; ++i) {
          const float* oo = OPS + i * 384 + kq * 16;
          float kn[16], wv_[16], bv[16], kdv[16];
#pragma unroll
          for (int q = 0; q < 4; ++q) {
            float4 a = *(const float4*)(oo + 192 + q * 4);
            kn[q * 4] = a.x; kn[q * 4 + 1] = a.y; kn[q * 4 + 2] = a.z; kn[q * 4 + 3] = a.w;
            float4 w_ = *(const float4*)(oo + 64 + q * 4);
            wv_[q * 4] = w_.x; wv_[q * 4 + 1] = w_.y; wv_[q * 4 + 2] = w_.z; wv_[q * 4 + 3] = w_.w;
            float4 b_ = *(const float4*)(oo + 256 + q * 4);
            bv[q * 4] = b_.x; bv[q * 4 + 1] = b_.y; bv[q * 4 + 2] = b_.z; bv[q * 4 + 3] = b_.w;
            float4 k_ = *(const float4*)(oo + 128 + q * 4);
            kdv[q * 4] = k_.x; kdv[q * 4 + 1] = k_.y; kdv[q * 4 + 2] = k_.z; kdv[q * 4 + 3] = k_.w;
          }
          float vv = OPS[i * 384 + 320 + vrow];
          float s0 = 0.f, s1 = 0.f, s2 = 0.f, s3 = 0.f;
#pragma unroll
          for (int q = 0; q < 16; q += 4) {
            s0 += S[q] * kn[q]; s1 += S[q + 1] * kn[q + 1]; s2 += S[q + 2] * kn[q + 2]; s3 += S[q + 3] * kn[q + 3];
          }
          float sa = (s0 + s1) + (s2 + s3);
          sa = dpp_add(sa, 0, 0);
          sa = dpp_add(sa, 1, 0);
#pragma unroll
          for (int q = 0; q < 16; ++q) S[q] = S[q] * wv_[q] + sa * bv[q] + vv * kdv[q];
          if (seg) {
            float rv[16];
#pragma unroll
            for (int q = 0; q < 4; ++q) {
              float4 a = *(const float4*)(oo + q * 4);
              rv[q * 4] = a.x; rv[q * 4 + 1] = a.y; rv[q * 4 + 2] = a.z; rv[q * 4 + 3] = a.w;
            }
            float y0 = 0.f, y1 = 0.f, y2 = 0.f, y3 = 0.f;
#pragma unroll
            for (int q = 0; q < 16; q += 4) {
              y0 += S[q] * rv[q]; y1 += S[q + 1] * rv[q + 1]; y2 += S[q + 2] * rv[q + 2]; y3 += S[q + 3] * rv[q + 3];
            }
            float y = (y0 + y1) + (y2 + y3);
            y = dpp_add(y, 0, 0);
            y = dpp_add(y, 1, 0);
            if (kq == 0) YB[i * 64 + vrow] = y;
          }
        }
        __syncthreads();
        if (seg) {
          float4 yv = *(const float4*)(YB + tt * 64 + part * 4);
          uint2 o2;
          o2.x = pack2(yv.x, yv.y); o2.y = pack2(yv.z, yv.w);
          *(uint2*)(ydst + row * 512 + hc) = o2;
        }
      }
    }
  }
}

#define LAS __attribute__((address_space(3)))
#define RW_AR_LD 68
#define RW_RM_LD 72
#define RW_SLOT_BYTES 13824
#define RW_SCR_BYTES 6912
#define RW_STREAM_BYTES (4 * RW_SLOT_BYTES + 3 * RW_SCR_BYTES + 2304 + 64)
__device__ __forceinline__ unsigned cvtpk(float lo, float hi) { return pack2(lo, hi); }
__device__ __forceinline__ float dpp_shr_add(float v, const int n) {
  int m;
  switch (n) {
    case 1: m = __builtin_amdgcn_update_dpp(0, __float_as_int(v), 0x111, 0xf, 0xf, true); break;
    case 2: m = __builtin_amdgcn_update_dpp(0, __float_as_int(v), 0x112, 0xf, 0xf, true); break;
    case 4: m = __builtin_amdgcn_update_dpp(0, __float_as_int(v), 0x114, 0xf, 0xf, true); break;
    default: m = __builtin_amdgcn_update_dpp(0, __float_as_int(v), 0x118, 0xf, 0xf, true); break;
  }
  return v + __int_as_float(m);
}
__device__ __forceinline__ int opaque(int x) { asm volatile("" : "+v"(x)); return x; }
__device__ __forceinline__ float fsig(float x) { return __builtin_amdgcn_rcpf(1.f + __expf(-x)); }

__device__ __forceinline__ void ph_rwscan2(const P& p, char* smem, int bid, int nb) {
  const int tid = tidx(), wid = tid >> 6, lane = tid & 63, sl = wid >> 2, wv = wid & 3;
  char* sb = smem + sl * RW_STREAM_BYTES;
  float* CST = (float*)(sb + 4 * RW_SLOT_BYTES + 3 * RW_SCR_BYTES);
  volatile LAS int* FL = (volatile LAS int*)(sb + 4 * RW_SLOT_BYTES + 3 * RW_SCR_BYTES + 2304);
  const int NCH = 144;
  for (int sp = bid; sp < 256; sp += nb) {
    const int s = sp * 2 + sl;
    const int d = s & 1, h = (s >> 1) & 7, b = s >> 4;
    __syncthreads();
    if (wv == 0) {
      const int cc = lane;
      CST[0 * 64 + cc] = p.rw_w0[d * 512 + h * 64 + cc];
      CST[1 * 64 + cc] = p.rw_a0[d * 512 + h * 64 + cc];
      CST[2 * 64 + cc] = p.rw_k_k[h * 64 + cc];
      CST[3 * 64 + cc] = p.rw_k_a[h * 64 + cc];
      CST[4 * 64 + cc] = p.rw_r_k[h * 64 + cc];
      CST[5 * 64 + cc] = p.rw_mu[h * 64 + cc];
      CST[6 * 64 + cc] = p.rw_mu[512 + h * 64 + cc];
      CST[7 * 64 + cc] = p.rw_mu[1024 + h * 64 + cc];
      CST[8 * 64 + cc] = p.rw_mu[1536 + cc];
      if (lane < 4) FL[lane] = 0;
    }
    __syncthreads();
    if (wv == 0) {
      const int v32 = lane & 31, hh = lane >> 5;
      u16* ydst = d ? p.yrwb() : p.yrwf();
      f32x16 X[2][2];
#pragma unroll
      for (int mt = 0; mt < 2; ++mt)
#pragma unroll
        for (int vt = 0; vt < 2; ++vt)
#pragma unroll
          for (int r = 0; r < 16; ++r) X[mt][vt][r] = 0.f;
      int c3 = 0, need = 1;
      for (int c = 0; c < NCH; ++c) {
        {
          while (FL[c3] < need) __builtin_amdgcn_s_sleep(1);
          asm volatile("" ::: "memory");
          const char* slot = sb + (c & 3) * RW_SLOT_BYTES;
          const u16* AR = (const u16*)slot;
          const u16* MG = (const u16*)(slot + 4352);
          const u16* BT = (const u16*)(slot + 5376);
          const u16* KT = (const u16*)(slot + 7424);
          const u16* VT = (const u16*)(slot + 9472);
          const float* WC = (const float*)(slot + 11520);
          {
            const float* Arb = (const float*)(slot + 11776);
            const float* Ark = Arb + 256;
            u16* ARw = (u16*)slot;
            u16* MGw = (u16*)(slot + 4352);
            const int ol = opaque(lane), oj = opaque(lane & 15);
            v2f am[16];
#pragma unroll
            for (int tt = 0; tt < 16; ++tt) {
              const int m0 = 8 * (tt >> 2) + (tt & 3);
              am[tt] = (v2f){bf2f(ARw[ol + m0 * RW_AR_LD]), bf2f(MGw[oj + m0 * 16])};
            }
#pragma unroll
            for (int tt = 0; tt < 16; ++tt) {
              const int m0 = 8 * (tt >> 2) + (tt & 3);
              v2f acc = (v2f){bf2f(ARw[ol + (m0 + 4) * RW_AR_LD]), Ark[oj + tt * 16]};
#pragma unroll
              for (int i4 = 0; i4 < (tt + 4) / 4; ++i4) {
                const float4 s4 = *(const float4*)(Arb + tt * 16 + 4 * i4);
                const float sv[4] = {s4.x, s4.y, s4.z, s4.w};
#pragma unroll
                for (int q = 0; q < 4; ++q) {
                  const int i = 4 * i4 + q;
                  if (i <= tt) acc += sv[q] * am[i];
                }
              }
              ARw[ol + (m0 + 4) * RW_AR_LD] = f2bf(acc[0]);
              if (lane < 16) MGw[oj + (m0 + 4) * 16] = f2bf(acc[1]);
            }
          }
          bf16x8 vtf[2];
#pragma unroll
          for (int vt = 0; vt < 2; ++vt) vtf[vt] = *(const bf16x8*)(VT + (32 * vt + v32) * 16 + 8 * hh);
          f32x16 UY[2];
#pragma unroll
          for (int vt = 0; vt < 2; ++vt)
#pragma unroll
            for (int r = 0; r < 16; ++r) UY[vt][r] = 0.f;
          {
            const bf16x8 mgf = *(const bf16x8*)(MG + v32 * 16 + 8 * hh);
#pragma unroll
            for (int vt = 0; vt < 2; ++vt) UY[vt] = __builtin_amdgcn_mfma_f32_32x32x16_bf16(mgf, vtf[vt], UY[vt], 0, 0, 0);
          }
#pragma unroll
          for (int mt = 0; mt < 2; ++mt)
#pragma unroll
            for (int ks = 0; ks < 2; ++ks) {
              const int base = 32 * mt + 16 * ks + 4 * hh;
              const uint2 a0 = *(const uint2*)(AR + v32 * RW_AR_LD + base);
              const uint2 a1 = *(const uint2*)(AR + v32 * RW_AR_LD + base + 8);
              union { unsigned u[4]; bf16x8 v; } af;
              af.u[0] = a0.x; af.u[1] = a0.y; af.u[2] = a1.x; af.u[3] = a1.y;
#pragma unroll
              for (int vt = 0; vt < 2; ++vt) {
                union { unsigned u[4]; bf16x8 v; } xf;
#pragma unroll
                for (int q = 0; q < 4; ++q) xf.u[q] = cvtpk(X[mt][vt][8 * ks + 2 * q], X[mt][vt][8 * ks + 2 * q + 1]);
                UY[vt] = __builtin_amdgcn_mfma_f32_32x32x16_bf16(af.v, xf.v, UY[vt], 0, 0, 0);
              }
            }
          if (c >= 16 && hh == 1) {
#pragma unroll
            for (int r = 0; r < 16; ++r) {
              const int pos = (c - 16) * 16 + r;
              const int tok = d ? (2047 - pos) : pos;
              u16* yp = ydst + ((size_t)b * 2048 + tok) * 512 + h * 64 + v32;
              yp[0] = f2bf(UY[0][r]);
              yp[32] = f2bf(UY[1][r]);
            }
          }
          bf16x8 uyf[2][2];
#pragma unroll
          for (int vt = 0; vt < 2; ++vt)
#pragma unroll
            for (int ks = 0; ks < 2; ++ks) {
              union { unsigned u[4]; bf16x8 v; } t_;
#pragma unroll
              for (int q = 0; q < 4; ++q) t_.u[q] = cvtpk(UY[vt][8 * ks + 2 * q], UY[vt][8 * ks + 2 * q + 1]);
              uyf[vt][ks] = t_.v;
            }
#pragma unroll
          for (int mt = 0; mt < 2; ++mt) {
            const int krow = 32 * mt + v32;
            const bf16x8 ktf = *(const bf16x8*)(KT + krow * 16 + 8 * hh);
            bf16x8 btf[2];
#pragma unroll
            for (int ks = 0; ks < 2; ++ks) {
              btf[ks] = *(const bf16x8*)(BT + krow * 16 + 8 * ks);
              if (hh) btf[ks] = (bf16x8){0, 0, 0, 0, 0, 0, 0, 0};
            }
#pragma unroll
            for (int vt = 0; vt < 2; ++vt) {
              X[mt][vt] = __builtin_amdgcn_mfma_f32_32x32x16_bf16(ktf, vtf[vt], X[mt][vt], 0, 0, 0);
#pragma unroll
              for (int ks = 0; ks < 2; ++ks) X[mt][vt] = __builtin_amdgcn_mfma_f32_32x32x16_bf16(btf[ks], uyf[vt][ks], X[mt][vt], 0, 0, 0);
            }
#pragma unroll
            for (int g = 0; g < 4; ++g) {
              const float4 w4 = *(const float4*)(WC + 32 * mt + 8 * g + 4 * hh);
#pragma unroll
              for (int vt = 0; vt < 2; ++vt) {
                X[mt][vt][4 * g + 0] *= w4.x; X[mt][vt][4 * g + 1] *= w4.y;
                X[mt][vt][4 * g + 2] *= w4.z; X[mt][vt][4 * g + 3] *= w4.w;
              }
            }
          }
        }
        asm volatile("s_waitcnt lgkmcnt(0)" ::: "memory");
        if (lane == 0) FL[3] = c + 1;
        if (++c3 == 3) { c3 = 0; ++need; }
      }
    } else {
      const int pw = wv - 1;
      const int t = lane & 15, kq = lane >> 4;
      char* scr = sb + 4 * RW_SLOT_BYTES + pw * RW_SCR_BYTES;
      u16* AL = (u16*)scr;
      u16* BE = AL + 16 * RW_RM_LD;
      u16* KA = BE + 16 * RW_RM_LD;
      float* AAs = (float*)BE;
      const int o_kq4 = opaque(4 * kq);
      const int o_tr = opaque(64 * kq + t);
      const int o_rm = opaque(t * RW_RM_LD + 4 * kq);
      const int o_ar = opaque((8 * (t >> 2) + (t & 3) + 4) * RW_AR_LD + 4 * kq);
      const int o_l = opaque(lane);
      const int o_j = opaque(lane & 15);
      const float* cstl = CST + o_kq4;
      bf16x8 wwf[4], waf[4];
      {
        const int o_wl = (((d * 8 + h) * 4) * 64 + lane) * 8;
#pragma unroll
        for (int mt = 0; mt < 4; ++mt) {
          wwf[mt] = *(const bf16x8*)(p.wlf() + o_wl + mt * 512);
          waf[mt] = *(const bf16x8*)(p.wlf() + o_wl + 32768 + mt * 512);
        }
      }
      int ndone = 0;
      for (int c = pw; c < NCH; c += 3) {
        while (FL[3] < c - 3) __builtin_amdgcn_s_sleep(1);
        asm volatile("" ::: "memory");
        char* slot = sb + (c & 3) * RW_SLOT_BYTES;
        u16* AR = (u16*)slot;
        u16* MG = (u16*)(slot + 4352);
        u16* BT = (u16*)(slot + 5376);
        u16* KT = (u16*)(slot + 7424);
        u16* VT = (u16*)(slot + 9472);
        float* WC = (float*)(slot + 11520);
        const bool lat = c >= 16;
        const int L = lat ? 2048 : 256;
        const int pos = (lat ? (c - 16) : c) * 16 + t;
        const int tok = d ? (L - 1 - pos) : pos;
        const size_t row = (lat ? (size_t)b * 2048 : (size_t)NLAT + (size_t)b * 256) + tok;
        const u16* cbase = p.proj() + row * INC + 512;
        const u16* nbase[4];
        float nmask[4];
        {
          size_t nrow[4];
          bool nval[4];
          neighbours(!lat, row, tok, nrow, nval);
#pragma unroll
          for (int j = 0; j < 4; ++j) {
            nbase[j] = p.proj() + (nval[j] ? nrow[j] : row) * INC + 512 + j;
            nmask[j] = nval[j] ? 1.f : 0.f;
          }
        }
        bf16x8 lwf, laf;
        {
          const int colw = 1536 + 8 * kq, cola = 1568 + 8 * kq;
          const uint4 cw = *(const uint4*)(cbase + colw), ca = *(const uint4*)(cbase + cola);
          const unsigned cwu[4] = {cw.x, cw.y, cw.z, cw.w}, cau[4] = {ca.x, ca.y, ca.z, ca.w};
          float lw[8], la[8];
          const float4 ml0 = *(const float4*)(cstl + o_kq4 + 8 * 64), ml1 = *(const float4*)(cstl + o_kq4 + 8 * 64 + 4);
          const float4 ma0 = *(const float4*)(cstl + o_kq4 + 8 * 64 + 32), ma1 = *(const float4*)(cstl + o_kq4 + 8 * 64 + 32 + 4);
          const float mul_[8] = {ml0.x, ml0.y, ml0.z, ml0.w, ml1.x, ml1.y, ml1.z, ml1.w};
          const float mua_[8] = {ma0.x, ma0.y, ma0.z, ma0.w, ma1.x, ma1.y, ma1.z, ma1.w};
#pragma unroll
          for (int q = 0; q < 8; ++q) {
            const float zw = (q & 1) ? bfhi(cwu[q >> 1]) : bflo(cwu[q >> 1]);
            const float za = (q & 1) ? bfhi(cau[q >> 1]) : bflo(cau[q >> 1]);
            const float nw = bf2f(nbase[q & 3][colw + (q & 4)]) * nmask[q & 3];
            const float na = bf2f(nbase[q & 3][cola + (q & 4)]) * nmask[q & 3];
            lw[q] = 1.f - 2.f * __builtin_amdgcn_rcpf(1.f + __expf(2.f * (zw + (nw - zw) * mul_[q])));
            la[q] = za + (na - za) * mua_[q];
          }
          union { unsigned u[4]; bf16x8 v; } tw, ta;
#pragma unroll
          for (int q = 0; q < 4; ++q) { tw.u[q] = pack2(lw[2 * q], lw[2 * q + 1]); ta.u[q] = pack2(la[2 * q], la[2 * q + 1]); }
          lwf = tw.v; laf = ta.v;
        }
        float ee[16];
        unsigned rrp[8], aap[8], kxp[8];
        {
          const u16* cb2 = cbase + h * 64 + 4 * kq;
          const u16* nb2[4] = {nbase[0] + h * 64 + 4 * kq, nbase[1] + h * 64 + 4 * kq, nbase[2] + h * 64 + 4 * kq, nbase[3] + h * 64 + 4 * kq};
#pragma unroll
          for (int mt = 0; mt < 4; ++mt) {
            const float4 mr = *(const float4*)(cstl + 5 * 64 + 16 * mt), mk = *(const float4*)(cstl + 6 * 64 + 16 * mt), mv = *(const float4*)(cstl + 7 * 64 + 16 * mt);
            const float mrv[4] = {mr.x, mr.y, mr.z, mr.w}, mkv[4] = {mk.x, mk.y, mk.z, mk.w}, mvv[4] = {mv.x, mv.y, mv.z, mv.w};
            const uint2 cr = *(const uint2*)(cb2 + 16 * mt), ck = *(const uint2*)(cb2 + 512 + 16 * mt), cv = *(const uint2*)(cb2 + 1024 + 16 * mt);
            const float zr[4] = {bflo(cr.x), bfhi(cr.x), bflo(cr.y), bfhi(cr.y)};
            const float zk[4] = {bflo(ck.x), bfhi(ck.x), bflo(ck.y), bfhi(ck.y)};
            const float zv[4] = {bflo(cv.x), bfhi(cv.x), bflo(cv.y), bfhi(cv.y)};
            float kxv[4], rrv[4], aav[4];
#pragma unroll
            for (int j = 0; j < 4; ++j) {
              const float nr = bf2f(nb2[j][16 * mt]) * nmask[j];
              const float nk = bf2f(nb2[j][512 + 16 * mt]) * nmask[j];
              const float nv = bf2f(nb2[j][1024 + 16 * mt]) * nmask[j];
              rrv[j] = zr[j] + (nr - zr[j]) * mrv[j];
              kxv[j] = zk[j] + (nk - zk[j]) * mkv[j];
              VT[o_tr + (16 * mt + j) * 16] = f2bf(zv[j] + (nv - zv[j]) * mvv[j]);
            }
            const f32x4 z4 = (f32x4){0.f, 0.f, 0.f, 0.f};
            const f32x4 aw = __builtin_amdgcn_mfma_f32_16x16x32_bf16(wwf[mt], lwf, z4, 0, 0, 0);
            const f32x4 a2 = __builtin_amdgcn_mfma_f32_16x16x32_bf16(waf[mt], laf, z4, 0, 0, 0);
            const float4 w0 = *(const float4*)(cstl + 0 * 64 + 16 * mt), a0 = *(const float4*)(cstl + 1 * 64 + 16 * mt);
            ee[4 * mt] = 0.60653066f * fsig(w0.x + aw[0]); ee[4 * mt + 1] = 0.60653066f * fsig(w0.y + aw[1]);
            ee[4 * mt + 2] = 0.60653066f * fsig(w0.z + aw[2]); ee[4 * mt + 3] = 0.60653066f * fsig(w0.w + aw[3]);
            aav[0] = fsig(a0.x + a2[0]); aav[1] = fsig(a0.y + a2[1]);
            aav[2] = fsig(a0.z + a2[2]); aav[3] = fsig(a0.w + a2[3]);
            rrp[2 * mt] = pack2(rrv[0], rrv[1]); rrp[2 * mt + 1] = pack2(rrv[2], rrv[3]);
            aap[2 * mt] = pack2(aav[0], aav[1]); aap[2 * mt + 1] = pack2(aav[2], aav[3]);
            kxp[2 * mt] = pack2(kxv[0], kxv[1]); kxp[2 * mt + 1] = pack2(kxv[2], kxv[3]);
          }
        }
        float kdf[16], kkf[16];
        float inv;
        {
          float ss = 0.f, bon = 0.f;
#pragma unroll
          for (int mt = 0; mt < 4; ++mt) {
            const float4 c2 = *(const float4*)(cstl + 2 * 64 + 16 * mt), c3 = *(const float4*)(cstl + 3 * 64 + 16 * mt), c4 = *(const float4*)(cstl + 4 * 64 + 16 * mt);
            const float kkc[4] = {c2.x, c2.y, c2.z, c2.w}, kac[4] = {c3.x, c3.y, c3.z, c3.w}, rkc[4] = {c4.x, c4.y, c4.z, c4.w};
#pragma unroll
            for (int j = 0; j < 4; ++j) {
              const int e = 4 * mt + j;
              const float kx = (e & 1) ? bfhi(kxp[e >> 1]) : bflo(kxp[e >> 1]);
              const float av = (e & 1) ? bfhi(aap[e >> 1]) : bflo(aap[e >> 1]);
              const float rv = (e & 1) ? bfhi(rrp[e >> 1]) : bflo(rrp[e >> 1]);
              kdf[e] = kx * (1.f + (av - 1.f) * kac[j]);
              kkf[e] = kx * kkc[j];
              ss += kkf[e] * kkf[e];
              bon += rv * kdf[e] * rkc[j];
            }
          }
          ss += __shfl_xor(ss, 16, 64); ss += __shfl_xor(ss, 32, 64);
          bon += __shfl_xor(bon, 16, 64); bon += __shfl_xor(bon, 32, 64);
          inv = rsqrtf(ss + 1e-12f);
          if (lat && kq == 0) p.bsc()[((size_t)d * NLAT + row) * 8 + h] = bon;
        }
#pragma unroll
        for (int mt = 0; mt < 4; ++mt) {
          float al4[4], rh4[4], be4[4], ka4[4];
#pragma unroll
          for (int j = 0; j < 4; ++j) {
            const int e = 4 * mt + j;
            float cs = ee[e];
            cs = dpp_shr_add(cs, 1); cs = dpp_shr_add(cs, 2); cs = dpp_shr_add(cs, 4); cs = dpp_shr_add(cs, 8);
            const float Ep = __expf(cs), Em = __builtin_amdgcn_rcpf(Ep), Ex = __expf(ee[e] - cs);
            const float kkn = kkf[e] * inv;
            al4[j] = -kkn * Ex;
            be4[j] = kkn * ((e & 1) ? bfhi(aap[e >> 1]) : bflo(aap[e >> 1])) * Ep;
            ka4[j] = kdf[e] * Ep;
            rh4[j] = ((e & 1) ? bfhi(rrp[e >> 1]) : bflo(rrp[e >> 1])) * Em;
            BT[o_tr + (16 * mt + j) * 16] = f2bf(be4[j]);
            KT[o_tr + (16 * mt + j) * 16] = f2bf(ka4[j]);
            if (t == 15) WC[o_kq4 + 16 * mt + j] = Em;
          }
          const int ko = o_rm + 16 * mt;
          *(uint2*)(AL + ko) = make_uint2(pack2(al4[0], al4[1]), pack2(al4[2], al4[3]));
          *(uint2*)(AR + o_ar + 16 * mt) = make_uint2(pack2(rh4[0], rh4[1]), pack2(rh4[2], rh4[3]));
          *(uint2*)(BE + ko) = make_uint2(pack2(be4[0], be4[1]), pack2(be4[2], be4[3]));
          *(uint2*)(KA + ko) = make_uint2(pack2(ka4[0], ka4[1]), pack2(ka4[2], ka4[3]));
        }
        {
          const int m = lane & 31, hh = lane >> 5;
          const int typ = (m >> 2) & 1, tt = 4 * (m >> 3) + (m & 3);
          const u16* arow = (typ ? AR + m * RW_AR_LD : AL + tt * RW_RM_LD) + 8 * hh;
          const u16* brow = ((m >> 4) ? KA : BE) + (m & 15) * RW_RM_LD + 8 * hh;
          f32x16 aa;
#pragma unroll
          for (int r = 0; r < 16; ++r) aa[r] = 0.f;
#pragma unroll
          for (int ks = 0; ks < 4; ++ks) {
            const uint2 a0 = *(const uint2*)(arow + 16 * ks), a1 = *(const uint2*)(arow + 16 * ks + 4);
            union { unsigned u[4]; bf16x8 v; } af;
            af.u[0] = a0.x; af.u[1] = a0.y; af.u[2] = a1.x; af.u[3] = a1.y;
            const bf16x8 bf_ = *(const bf16x8*)(brow + 16 * ks);
            aa = __builtin_amdgcn_mfma_f32_32x32x16_bf16(af.v, bf_, aa, 0, 0, 0);
          }
          const int i = m & 15;
          float* aad = (hh ? (float*)(slot + 11776) : AAs) + opaque((m >> 4) * 256 + i);
#pragma unroll
          for (int r = 0; r < 16; ++r) {
            const bool keep = hh ? (i <= r) : (i < r);
            aad[r * 16] = keep ? aa[r] : 0.f;
          }
        }
        asm volatile("" ::: "memory");
        {
          const float* Aab = AAs;
          const float* Aak = AAs + 256;
          v2f am[16];
#pragma unroll
          for (int tt = 0; tt < 16; ++tt) {
            v2f acc = (v2f){bf2f(AL[o_l + tt * RW_RM_LD]), Aak[o_j + tt * 16]};
#pragma unroll
            for (int i4 = 0; i4 < (tt + 3) / 4; ++i4) {
              const float4 s4 = *(const float4*)(Aab + tt * 16 + 4 * i4);
              const float sv[4] = {s4.x, s4.y, s4.z, s4.w};
#pragma unroll
              for (int q = 0; q < 4; ++q) {
                const int i = 4 * i4 + q;
                if (i < tt) acc += sv[q] * am[i];
              }
            }
            am[tt] = acc;
          }
#pragma unroll
          for (int tt = 0; tt < 16; ++tt) {
            const int m0 = 8 * (tt >> 2) + (tt & 3);
            AR[o_l + m0 * RW_AR_LD] = f2bf(am[tt][0]);
            if (lane < 16) MG[o_j + m0 * 16] = f2bf(am[tt][1]);
          }
        }
        asm volatile("s_waitcnt lgkmcnt(0)" ::: "memory");
        ++ndone;
        if (lane == 0) FL[pw] = ndone;
      }
    }
  }
}

struct MixLd {
  uint4 s5f, s5b, rwf, rwb, vc, gc;
  u16 vn[8], gn[8];
  float bs0, bs1;
};
__device__ __forceinline__ void mix_load(const P& p, int row, int lane, MixLd& L, float (&nmask)[4]) {
  const int c8 = lane * 8, t = row & 2047;
  L.s5f = *(const uint4*)(p.ys5f() + (size_t)row * 512 + c8);
  L.s5b = *(const uint4*)(p.ys5b() + (size_t)row * 512 + c8);
  L.rwf = *(const uint4*)(p.yrwf() + (size_t)row * 512 + c8);
  L.rwb = *(const uint4*)(p.yrwb() + (size_t)row * 512 + c8);
  size_t nrow[4];
  bool nval[4];
  neighbours(false, (size_t)row, t, nrow, nval);
  const u16* nb_[4];
#pragma unroll
  for (int j = 0; j < 4; ++j) { nb_[j] = p.proj() + (nval[j] ? nrow[j] : (size_t)row) * INC + 512 + j; nmask[j] = nval[j] ? 1.f : 0.f; }
  const u16* cb = p.proj() + (size_t)row * INC + 512;
  L.vc = *(const uint4*)(cb + 1024 + c8);
#pragma unroll
  for (int i = 0; i < 8; ++i) L.vn[i] = nb_[i & 3][1024 + c8 + (i & 4)];
  const int g8 = (lane < 12) ? c8 : 0;
  L.gc = *(const uint4*)(cb + 1600 + g8);
#pragma unroll
  for (int i = 0; i < 8; ++i) L.gn[i] = nb_[i & 3][1600 + g8 + (i & 4)];
  const int head = lane >> 3;
  L.bs0 = p.bsc()[(size_t)row * 8 + head];
  L.bs1 = p.bsc()[((size_t)NLAT + row) * 8 + head];
}
__device__ __forceinline__ void mix_compute(const P& p, int row, int lane, const MixLd& L, const float (&nmask)[4], u16* y1dst, u16* t1dst) {
  const int c8 = lane * 8;
  {
    const unsigned au[4] = {L.s5f.x, L.s5f.y, L.s5f.z, L.s5f.w}, bu[4] = {L.s5b.x, L.s5b.y, L.s5b.z, L.s5b.w};
    unsigned ou[4];
#pragma unroll
    for (int q = 0; q < 4; ++q) ou[q] = pack2(gelu_as(bflo(au[q]) + bflo(bu[q])), gelu_as(bfhi(au[q]) + bfhi(bu[q])));
    *(uint4*)(y1dst + (size_t)row * 512 + c8) = make_uint4(ou[0], ou[1], ou[2], ou[3]);
  }
  float y[8];
  {
    const unsigned au[4] = {L.rwf.x, L.rwf.y, L.rwf.z, L.rwf.w}, bu[4] = {L.rwb.x, L.rwb.y, L.rwb.z, L.rwb.w};
#pragma unroll
    for (int q = 0; q < 4; ++q) { y[2 * q] = bflo(au[q]) + bflo(bu[q]); y[2 * q + 1] = bfhi(au[q]) + bfhi(bu[q]); }
  }
  float sm = 0.f;
#pragma unroll
  for (int i = 0; i < 8; ++i) sm += y[i];
  sm = dpp_add(sm, 0, 0); sm = dpp_add(sm, 1, 0); sm = dpp_add(sm, 2, 0);
  const float mu = sm * (1.f / 64.f);
  float sv = 0.f;
#pragma unroll
  for (int i = 0; i < 8; ++i) sv += (y[i] - mu) * (y[i] - mu);
  sv = dpp_add(sv, 0, 0); sv = dpp_add(sv, 1, 0); sv = dpp_add(sv, 2, 0);
  const float rs = rsqrtf(sv * (1.f / 64.f) + 64e-5f);
  float v[8];
  {
    const unsigned cu[4] = {L.vc.x, L.vc.y, L.vc.z, L.vc.w};
    const float4 m0 = *(const float4*)(p.rw_mu + 1024 + c8), m1 = *(const float4*)(p.rw_mu + 1024 + c8 + 4);
    const float mm[8] = {m0.x, m0.y, m0.z, m0.w, m1.x, m1.y, m1.z, m1.w};
#pragma unroll
    for (int i = 0; i < 8; ++i) {
      const float z = (i & 1) ? bfhi(cu[i >> 1]) : bflo(cu[i >> 1]);
      const float nbv = bf2f(L.vn[i]) * nmask[i & 3];
      v[i] = z + (nbv - z) * mm[i];
    }
  }
  const float bs = L.bs0 + L.bs1;
  {
    const float4 w0 = *(const float4*)(p.rw_ln_w + c8), w1 = *(const float4*)(p.rw_ln_w + c8 + 4);
    const float4 b0 = *(const float4*)(p.rw_ln_b + c8), b1 = *(const float4*)(p.rw_ln_b + c8 + 4);
    const float lw[8] = {w0.x, w0.y, w0.z, w0.w, w1.x, w1.y, w1.z, w1.w};
    const float lb[8] = {b0.x, b0.y, b0.z, b0.w, b1.x, b1.y, b1.z, b1.w};
    float o[8];
#pragma unroll
    for (int i = 0; i < 8; ++i) o[i] = (y[i] - mu) * rs * lw[i] + lb[i] + bs * v[i];
    *(uint4*)(t1dst + (size_t)row * 512 + c8) = make_uint4(pack2(o[0], o[1]), pack2(o[2], o[3]), pack2(o[4], o[5]), pack2(o[6], o[7]));
  }
  if (lane < 32) {
    unsigned ou[4] = {0u, 0u, 0u, 0u};
    if (lane < 12) {
      const unsigned cu[4] = {L.gc.x, L.gc.y, L.gc.z, L.gc.w};
      const float4 m0 = *(const float4*)(p.rw_mu + 1600 + c8), m1 = *(const float4*)(p.rw_mu + 1600 + c8 + 4);
      const float mm[8] = {m0.x, m0.y, m0.z, m0.w, m1.x, m1.y, m1.z, m1.w};
      float gsig[8];
#pragma unroll
      for (int i = 0; i < 8; ++i) {
        const float z = (i & 1) ? bfhi(cu[i >> 1]) : bflo(cu[i >> 1]);
        const float nbv = bf2f(L.gn[i]) * nmask[i & 3];
        gsig[i] = fsig(z + (nbv - z) * mm[i]);
      }
#pragma unroll
      for (int q = 0; q < 4; ++q) ou[q] = pack2(gsig[2 * q], gsig[2 * q + 1]);
    }
    *(uint4*)(p.sg() + (size_t)row * 256 + c8) = make_uint4(ou[0], ou[1], ou[2], ou[3]);
  }
}
__device__ __forceinline__ void ph_mixprep(const P& p, int bid, int nb, u16* y1dst, u16* t1dst) {
  const int wid = tidx() >> 6, lane = tidx() & 63;
  const int stride = nb * 8;
  for (int row = bid * 8 + wid; row < NLAT; row += 2 * stride) {
    const int rowB = row + stride;
    const bool hasB = rowB < NLAT;
    MixLd LA, LB;
    float mA[4], mB[4];
    mix_load(p, row, lane, LA, mA);
    mix_load(p, hasB ? rowB : row, lane, LB, mB);
    mix_compute(p, row, lane, LA, mA, y1dst, t1dst);
    if (hasB) mix_compute(p, rowB, lane, LB, mB, y1dst, t1dst);
  }
}

__constant__ unsigned char CAND_I[52] = {0,0,0,0,0,0,0,0,0,0,0,0,0,0,0,0, 1,1,1,1,1,1,1,1, 2,2,2,2,2, 3,3,3,3, 4,4,4, 5,5, 6,6, 7,7, 8,9,10,11,12,13,14,15, 0,0};
__constant__ unsigned char CAND_J[52] = {0,1,2,3,4,5,6,7,8,9,10,11,12,13,14,15, 0,1,2,3,4,5,6,7, 0,1,2,3,4, 0,1,2,3, 0,1,2, 0,1, 0,1, 0,1, 0,0,0,0,0,0,0,0, 0,0};

#define SC_LD 144
#define KL_LD 136
__device__ __forceinline__ unsigned umax_quad(unsigned v) {
  unsigned o = (unsigned)__builtin_amdgcn_update_dpp(0, (int)v, 0xB1, 0xf, 0xf, true);
  v = v > o ? v : o;
  o = (unsigned)__builtin_amdgcn_update_dpp(0, (int)v, 0x4E, 0xf, 0xf, true);
  return v > o ? v : o;
}
__device__ __forceinline__ unsigned mono_key(float f) {
  unsigned u = __float_as_uint(f);
  return u ^ ((u >> 31) ? 0xFFFFFFFFu : 0x80000000u);
}
__device__ __forceinline__ float mono_inv(unsigned k) {
  unsigned u = (k >> 31) ? (k ^ 0x80000000u) : ~k;
  return __uint_as_float(u);
}
__device__ __forceinline__ unsigned umax3(unsigned a, unsigned b, unsigned c) {
  unsigned m = a > b ? a : b;
  return m > c ? m : c;
}
__device__ __forceinline__ void ph_route(const P& p, char* smem, int bid, int nb) {
  u16* KL = (u16*)smem;
  unsigned* SC = (unsigned*)(smem + 2 * 128 * KL_LD * 2);
  float* TS = (float*)(SC + 2 * 64 * SC_LD);
  int* TI = (int*)(TS + 2 * 64 * 16);
  const u16* Q = p.proj();
  const int tid = tidx(), wid = tid >> 6, lane = tid & 63, fr = lane & 15, fq = lane >> 4;
  int cur_h = -1;
  bf16x8 an[4];
  {
    const int h0 = bid & 7, r0 = (bid >> 3) * 64, c0 = wid >> 2, m0 = (wid & 3) * 16;
#pragma unroll
    for (int ks = 0; ks < 4; ++ks)
      an[ks] = *(const bf16x8*)(Q + (size_t)(r0 + m0 + fr) * 2048 + h0 * 256 + c0 * 128 + ks * 32 + fq * 8);
  }
  for (int item = bid; item < 1024 * 8; item += nb) {
    const int h = item & 7, row0 = (item >> 3) * 64;
    if (h != cur_h) {
      __syncthreads();
      for (int e = tid; e < 2 * 128 * 16; e += NTHREADS) {
        int r = e >> 4, kc = (e & 15) * 8;
        *(uint4*)(KL + r * KL_LD + kc) = *(const uint4*)(p.keys() + ((size_t)h * 256 + r) * 128 + kc);
      }
      cur_h = h;
      __syncthreads();
    }
    {
      const int c = wid >> 2, mrow = (wid & 3) * 16;
      f32x4 acc[8];
#pragma unroll
      for (int ni = 0; ni < 8; ++ni) acc[ni] = (f32x4){0.f, 0.f, 0.f, 0.f};
      bf16x8 a[4];
#pragma unroll
      for (int ks = 0; ks < 4; ++ks) a[ks] = an[ks];
      {
        const int nit = (item + nb < 1024 * 8) ? item + nb : item;
        const int nh = nit & 7, nr0 = (nit >> 3) * 64;
#pragma unroll
        for (int ks = 0; ks < 4; ++ks)
          an[ks] = *(const bf16x8*)(Q + (size_t)(nr0 + mrow + fr) * 2048 + nh * 256 + c * 128 + ks * 32 + fq * 8);
      }
#pragma unroll
      for (int ks = 0; ks < 4; ++ks) {
#pragma unroll
        for (int ni = 0; ni < 8; ++ni) {
          bf16x8 bfr = *(const bf16x8*)(KL + (c * 128 + ni * 16 + fr) * KL_LD + ks * 32 + fq * 8);
          acc[ni] = __builtin_amdgcn_mfma_f32_16x16x32_bf16(a[ks], bfr, acc[ni], 0, 0, 0);
        }
      }
#pragma unroll
      for (int ni = 0; ni < 8; ++ni)
#pragma unroll
        for (int j = 0; j < 4; ++j) {
          const int n = ni * 16 + fr;
          SC[(c * 64 + mrow + fq * 4 + j) * SC_LD + n] = (mono_key(acc[ni][j]) & ~127u) | (unsigned)(127 - n);
        }
    }
    __syncthreads();
    {
      const int task = tid >> 2, q4 = tid & 3;
      unsigned* rowp = SC + task * SC_LD;
      for (int r = 0; r < 16; ++r) {
        unsigned m = 0;
#pragma unroll
        for (int j = 0; j < 8; ++j) {
          uint4 v = *(const uint4*)(rowp + 16 * j + 4 * q4);
          m = umax3(m, v.x, v.y);
          m = umax3(m, v.z, v.w);
        }
        m = umax_quad(m);
        const int n = 127 - (int)(m & 127u);
        if (((n >> 2) & 3) == q4) rowp[n] = 0u;
        if (q4 == (r & 3)) {
          TS[task * 16 + r] = mono_inv(m & ~127u);
          TI[task * 16 + r] = n;
        }
      }
    }
    __syncthreads();
    if (tid < 256) {
      const int t = tid >> 2, q4 = tid & 3;
      unsigned val[13];
#pragma unroll
      for (int e = 0; e < 13; ++e) {
        const int ci = q4 + 4 * e;
        const int i = CAND_I[ci], j = CAND_J[ci];
        const float sv = TS[t * 16 + i] + TS[(64 + t) * 16 + j];
        val[e] = (ci < 50) ? ((mono_key(sv) & ~255u) | (unsigned)(255 - (i * 16 + j))) : 0u;
      }
      unsigned mine[4] = {0u, 0u, 0u, 0u};
      unsigned first = 0u;
#pragma unroll
      for (int r = 0; r < 16; ++r) {
        unsigned m = umax3(val[0], val[1], val[2]);
        m = umax3(m, val[3], val[4]);
        m = umax3(m, val[5], val[6]);
        m = umax3(m, val[7], val[8]);
        m = umax3(m, val[9], val[10]);
        m = umax3(m, val[11], val[12]);
        m = umax_quad(m);
#pragma unroll
        for (int e = 0; e < 13; ++e) val[e] = (val[e] == m) ? 0u : val[e];
        if (r == 0) first = m;
        mine[r >> 2] = (q4 == (r & 3)) ? m : mine[r >> 2];
      }
      float smax;
      {
        const int cid = 255 - (int)(first & 255u);
        smax = TS[t * 16 + (cid >> 4)] + TS[(64 + t) * 16 + (cid & 15)];
      }
      float ex[4];
      int eid[4];
      float part = 0.f;
#pragma unroll
      for (int k = 0; k < 4; ++k) {
        const int cid = 255 - (int)(mine[k] & 255u);
        const int i = cid >> 4, j = cid & 15;
        const float sv = TS[t * 16 + i] + TS[(64 + t) * 16 + j];
        ex[k] = __expf(sv - smax);
        part += ex[k];
        eid[k] = TI[t * 16 + i] * 128 + TI[(64 + t) * 16 + j];
      }
      part = dpp_add(part, 0, 0);
      part = dpp_add(part, 1, 0);
      const float rden = 1.f / part;
      const size_t obase = ((size_t)(row0 + t) * 8 + h) * 16;
#pragma unroll
      for (int k = 0; k < 4; ++k) {
        p.idx()[obase + 4 * k + q4] = eid[k];
        p.gate()[obase + 4 * k + q4] = ex[k] * rden;
      }
    }
    __syncthreads();
  }
}

typedef int v8i_t __attribute__((ext_vector_type(8)));
__device__ __forceinline__ void ph_ffn(const P& p, float* __restrict__ dst, char* smem, int bid, int nb) {
  const int wid = tidx() >> 6, lane = tidx() & 63;
  const int hh = lane >> 5, li = lane & 31, m16 = lane & 15, kg = lane >> 4;
  unsigned char* h8 = (unsigned char*)smem + wid * 1024;
  const u16* H2N = p.hn();
  for (int row = bid * 8 + wid; row < NLAT; row += nb * 8) {
    float hinv;
    {
      const uint4 a = *(const uint4*)(H2N + (size_t)row * 1024 + lane * 16), b2 = *(const uint4*)(H2N + (size_t)row * 1024 + lane * 16 + 8);
      const unsigned au[8] = {a.x, a.y, a.z, a.w, b2.x, b2.y, b2.z, b2.w};
      float hv[16];
      float am = 0.f;
#pragma unroll
      for (int q = 0; q < 8; ++q) { hv[2 * q] = bflo(au[q]); hv[2 * q + 1] = bfhi(au[q]); am = fmaxf(am, fmaxf(fabsf(hv[2 * q]), fabsf(hv[2 * q + 1]))); }
#pragma unroll
      for (int m = 32; m >= 1; m >>= 1) am = fmaxf(am, __shfl_xor(am, m, 64));
      const float scl = am > 0.f ? 448.f / am : 1.f;
      hinv = am > 0.f ? am * (1.f / 448.f) : 1.f;
      unsigned o[4];
#pragma unroll
      for (int q = 0; q < 4; ++q) {
        int w = 0;
        w = __builtin_amdgcn_cvt_pk_fp8_f32(hv[4 * q] * scl, hv[4 * q + 1] * scl, w, false);
        w = __builtin_amdgcn_cvt_pk_fp8_f32(hv[4 * q + 2] * scl, hv[4 * q + 3] * scl, w, true);
        o[q] = (unsigned)w;
      }
      *(uint4*)(h8 + lane * 16) = make_uint4(o[0], o[1], o[2], o[3]);
    }
    v8i_t hb[8];
#pragma unroll
    for (int s2 = 0; s2 < 8; ++s2) {
      const uint4 x0 = *(const uint4*)(h8 + 128 * s2 + 16 * kg), x1 = *(const uint4*)(h8 + 128 * s2 + 64 + 16 * kg);
      hb[s2] = (v8i_t){(int)x0.x, (int)x0.y, (int)x0.z, (int)x0.w, (int)x1.x, (int)x1.y, (int)x1.z, (int)x1.w};
    }
    const int id0 = p.idx()[(size_t)row * 128 + lane], id1 = p.idx()[(size_t)row * 128 + 64 + lane];
    const float us0 = p.usc()[id0] * hinv, us1 = p.usc()[id1] * hinv;
    const float gv0 = p.gate()[(size_t)row * 128 + lane] * p.vsc()[id0], gv1 = p.gate()[(size_t)row * 128 + 64 + lane] * p.vsc()[id1];
    float oacc[32];
#pragma unroll
    for (int i = 0; i < 32; ++i) oacc[i] = 0.f;
#pragma unroll 1
    for (int bb = 0; bb < 8; ++bb) {
      const bool hf = bb >= 4;
      const int e0 = (bb & 3) * 16;
      const int idv = hf ? id1 : id0;
      const float usv = hf ? us1 : us0, gvv = hf ? gv1 : gv0;
      const int idm = __shfl(idv, e0 + m16, 64);
      uint4 ua[8];
#pragma unroll
      for (int s2 = 0; s2 < 8; ++s2) ua[s2] = *(const uint4*)(p.utab() + (size_t)idm * 1024 + 64 * s2 + 16 * kg);
      uint4 vr[8];
#pragma unroll
      for (int q = 0; q < 8; ++q) {
        const int ia = __builtin_amdgcn_readlane(idv, e0 + 2 * q), ib = __builtin_amdgcn_readlane(idv, e0 + 2 * q + 1);
        const int id = hh ? ib : ia;
        vr[q] = *(const uint4*)(p.utab() + (size_t)id * 1024 + 512 + li * 16);
      }
      f32x4 D = (f32x4){0.f, 0.f, 0.f, 0.f};
#pragma unroll
      for (int s2 = 0; s2 < 8; ++s2) {
        const v8i_t av = (v8i_t){(int)ua[s2].x, (int)ua[s2].y, (int)ua[s2].z, (int)ua[s2].w, 0, 0, 0, 0};
        D = __builtin_amdgcn_mfma_scale_f32_16x16x128_f8f6f4(av, hb[s2], D, 4  , 0  , 0, 0x7f7f7f7f, 0, 0x7f7f7f7f);
      }
      const int nn = m16 & 3;
      const float dotv = nn == 0 ? D[0] : (nn == 1 ? D[1] : (nn == 2 ? D[2] : D[3]));
      const int esrc = e0 + 4 * kg + nn;
      const float usx = __shfl(usv, esrc, 64), gvx = __shfl(gvv, esrc, 64);
      const float cfl = gvx * gelu_as(dotv * usx);
#pragma unroll
      for (int q = 0; q < 8; ++q) {
        int one_s;
        asm volatile("s_mov_b32 %0, 1" : "=s"(one_s));
        if (one_s == 0) continue;
        const int ma = 2 * q, mb = 2 * q + 1;
        const float cfa = __int_as_float(__builtin_amdgcn_readlane(__float_as_int(cfl), 16 * (ma >> 2) + (ma & 3)));
        const float cfb = __int_as_float(__builtin_amdgcn_readlane(__float_as_int(cfl), 16 * (mb >> 2) + (mb & 3)));
        const float cf = hh ? cfb : cfa;
        const unsigned vv[4] = {vr[q].x, vr[q].y, vr[q].z, vr[q].w};
#pragma unroll
        for (int k = 0; k < 4; ++k) {
          v2f p0 = __builtin_amdgcn_cvt_scalef32_pk_f32_fp4(vv[k], 1.0f, 0), p1 = __builtin_amdgcn_cvt_scalef32_pk_f32_fp4(vv[k], 1.0f, 1);
          v2f p2 = __builtin_amdgcn_cvt_scalef32_pk_f32_fp4(vv[k], 1.0f, 2), p3 = __builtin_amdgcn_cvt_scalef32_pk_f32_fp4(vv[k], 1.0f, 3);
          oacc[8 * k] += cf * p0[0]; oacc[8 * k + 1] += cf * p0[1];
          oacc[8 * k + 2] += cf * p1[0]; oacc[8 * k + 3] += cf * p1[1];
          oacc[8 * k + 4] += cf * p2[0]; oacc[8 * k + 5] += cf * p2[1];
          oacc[8 * k + 6] += cf * p3[0]; oacc[8 * k + 7] += cf * p3[1];
        }
      }
    }
    float mine[16];
#pragma unroll
    for (int i = 0; i < 16; ++i) {
      const float give = hh ? oacc[i] : oacc[16 + i];
      const float got = __shfl_xor(give, 32, 64);
      mine[i] = (hh ? oacc[16 + i] : oacc[i]) + got;
    }
    const int b = row >> 11;
    const int colb = li * 32 + hh * 16;
    float h3[16];
    float ss = 0.f;
#pragma unroll
    for (int q = 0; q < 4; ++q) {
      const int col = colb + q * 4;
      float4 a0 = *(const float4*)(p.out + (size_t)row * 1024 + col);
      float4 q0 = *(const float4*)(p.mod() + b * 6144 + 5 * 1024 + col);
      h3[q * 4 + 0] = a0.x + q0.x * mine[q * 4 + 0];
      h3[q * 4 + 1] = a0.y + q0.y * mine[q * 4 + 1];
      h3[q * 4 + 2] = a0.z + q0.z * mine[q * 4 + 2];
      h3[q * 4 + 3] = a0.w + q0.w * mine[q * 4 + 3];
      ss += h3[q * 4] * h3[q * 4] + h3[q * 4 + 1] * h3[q * 4 + 1] + h3[q * 4 + 2] * h3[q * 4 + 2] + h3[q * 4 + 3] * h3[q * 4 + 3];
    }
    ss = wave_sum_u(ss);
    const float rstd = rsqrtf(ss * (1.f / 1024.f) + 1e-6f);
#pragma unroll
    for (int q = 0; q < 4; ++q) {
      const int col = colb + q * 4;
      float4 n0 = *(const float4*)(p.norm_f_g + col);
      *(float4*)(dst + (size_t)row * 1024 + col) =
          make_float4(h3[q * 4] * rstd * n0.x, h3[q * 4 + 1] * rstd * n0.y, h3[q * 4 + 2] * rstd * n0.z, h3[q * 4 + 3] * rstd * n0.w);
    }
  }
}

#define XB_TMO      128
#define XB_XCNT(j)  (256  + 64 * (j))
#define XB_XSUB(j)  (1280 + 64 * (j))
#define XB_XGEN(j)  (2304 + 64 * (j))
#define XB_TOP      3328
#define XB_TOPGEN   3392
#define XCD_BAR_WORDS 3456
#define XB_SPIN_CAP (1u << 18)
#define LAS __attribute__((address_space(3)))

__device__ __forceinline__ unsigned xb_ld(unsigned* p)              { return __hip_atomic_load(p, __ATOMIC_RELAXED, __HIP_MEMORY_SCOPE_AGENT); }
__device__ __forceinline__ unsigned xb_add(unsigned* p, unsigned v) { return __hip_atomic_fetch_add(p, v, __ATOMIC_RELAXED, __HIP_MEMORY_SCOPE_AGENT); }
__device__ __forceinline__ unsigned xb_xcc_id() { return (unsigned)__builtin_amdgcn_s_getreg((3 << 11) | 20) & 0xFu; }
#define XB_SPIN(cond, bar) do { unsigned _sp = 0; while (cond) { __builtin_amdgcn_s_sleep(1); \
    if ((++_sp & 255u) == 0u) { if (xb_ld(&(bar)[XB_TMO])) break; if (_sp > XB_SPIN_CAP) { atomicAdd(&(bar)[XB_TMO], 1u); break; } } } } while (0)

struct XcdBarrier {
    unsigned* bar; unsigned x;
    volatile LAS unsigned* st;
};

__device__ __forceinline__ XcdBarrier xcd_barrier_post(unsigned* bar, volatile LAS unsigned* st) {
    XcdBarrier b; b.bar = bar; b.x = xb_xcc_id(); b.st = st;
    if (tidx() == 0) (void)xb_add(&bar[XB_XCNT(b.x)], 1u);
    return b;
}
__device__ __forceinline__ void xcd_barrier_complete(unsigned* bar, unsigned x, unsigned& nloc, unsigned& nx) {
    const unsigned G = gridDim.x * gridDim.y * gridDim.z;
    unsigned sum, cnt, mine, sp = 0u;
    for (;;) {
        sum = 0u; cnt = 0u; mine = 0u;
#pragma unroll
        for (unsigned j = 0; j < 16; ++j) { const unsigned c = xb_ld(&bar[XB_XCNT(j)]); sum += c; cnt += (c > 0u) ? 1u : 0u; mine = (j == x) ? c : mine; }
        if (sum == G) break;
        __builtin_amdgcn_s_sleep(1);
        if ((++sp & 255u) == 0u) { if (xb_ld(&bar[XB_TMO])) break; if (sp > XB_SPIN_CAP) { atomicAdd(&bar[XB_TMO], 1u); break; } }
    }
    nloc = mine > 0u ? mine : 1u; nx = cnt > 0u ? cnt : 1u;
}

__device__ __forceinline__ void xcd_barrier(const XcdBarrier& b) {
    asm volatile("s_waitcnt vmcnt(0)" ::: "memory");
    __syncthreads();
    if (tidx() == 0) {
        unsigned* bar = b.bar;
        __builtin_amdgcn_s_waitcnt(0);
        unsigned nloc = b.st[0], nx = b.st[1];
        if (nloc == 0u) { xcd_barrier_complete(bar, b.x, nloc, nx); b.st[0] = nloc; b.st[1] = nx; }
        const unsigned old = xb_add(&bar[XB_XSUB(b.x)], 1u);
        const unsigned gen = old / nloc;
        if (old + 1u == (gen + 1u) * nloc) {
            __builtin_amdgcn_fence(__ATOMIC_RELEASE, "agent");
            asm volatile("s_waitcnt vmcnt(0)" ::: "memory");
            const unsigned og = xb_add(&bar[XB_TOP], 1u);
            const unsigned tg = og / nx;
            if (og + 1u == (tg + 1u) * nx) xb_add(&bar[XB_TOPGEN], 1u);
            else XB_SPIN(xb_ld(&bar[XB_TOPGEN]) == tg, bar);
            __builtin_amdgcn_fence(__ATOMIC_ACQUIRE, "agent");
            xb_add(&bar[XB_XGEN(b.x)], 1u);
            asm volatile("s_waitcnt vmcnt(0)" ::: "memory");
        } else {
            XB_SPIN(xb_ld(&bar[XB_XGEN(b.x)]) == gen, bar);
            __builtin_amdgcn_fence(__ATOMIC_ACQUIRE, "agent");
            asm volatile("s_waitcnt vmcnt(0)" ::: "memory");
        }
    }
    __syncthreads();
}

typedef const __attribute__((address_space(4))) P* kargP_t;
__device__ __forceinline__ P load_params() {
  kargP_t q = (kargP_t)__builtin_amdgcn_kernarg_segment_ptr();
  asm volatile("" : "+s"(q));
  P r;
  r.x = q->x;
  r.c = q->c;
  r.ctx = q->ctx;
  r.c_ctx = q->c_ctx;
  r.w_ada = q->w_ada;
  r.b_ada = q->b_ada;
  r.norm1_g = q->norm1_g;
  r.norm2_g = q->norm2_g;
  r.w_in = q->w_in;
  r.s5_a_re = q->s5_a_re;
  r.s5_a_im = q->s5_a_im;
  r.s5_log_dt = q->s5_log_dt;
  r.s5_b_re = q->s5_b_re;
  r.s5_b_im = q->s5_b_im;
  r.s5_c_re = q->s5_c_re;
  r.s5_c_im = q->s5_c_im;
  r.s5_d = q->s5_d;
  r.s5_w_glu = q->s5_w_glu;
  r.s5_b_glu = q->s5_b_glu;
  r.rw_mu = q->rw_mu;
  r.rw_w0 = q->rw_w0;
  r.rw_w_w2 = q->rw_w_w2;
  r.rw_a0 = q->rw_a0;
  r.rw_w_a2 = q->rw_w_a2;
  r.rw_w_g2 = q->rw_w_g2;
  r.rw_k_k = q->rw_k_k;
  r.rw_k_a = q->rw_k_a;
  r.rw_r_k = q->rw_r_k;
  r.rw_ln_w = q->rw_ln_w;
  r.rw_ln_b = q->rw_ln_b;
  r.w_out = q->w_out;
  r.peer_w_q = q->peer_w_q;
  r.peer_keys = q->peer_keys;
  r.peer_u = q->peer_u;
  r.peer_v = q->peer_v;
  r.norm_f_g = q->norm_f_g;
  r.out = q->out;
  r.ws = q->ws;
  return r;
}
#define NPHASES 11
template <int PH>
__device__ __forceinline__ void run_phase(const P& p, char* smem, int bid, int nb, bool rep = false) {
  if (PH == 0) ph_prep(p, smem, bid, nb);
  if (PH == 1) ph_norm(p, 0, bid, nb);
  if (PH == 2) {
    pg8::StaticOrder S; S.init(NTOK, INCP, nb, bid);
    pg8::gemm_phase<pg8::EpiProjT, pg8::StaticOrder, false>((PG8_LAS unsigned char*)smem, pg8::Gemm{p.hn(), p.win_t(), NTOK, INCP, 1024}, S, pg8::EpiProjT{p.proj(), INC, INC}, nullptr);
  }
  if (PH == 3) { ph_s5scan2(p, smem, bid, nb); ph_rwscan2(p, smem, bid, nb); }
  if (PH == 4) ph_mixprep(p, bid, nb, rep ? p.hn() : p.ys5f(), rep ? p.hn() + (size_t)NLAT * 512 : p.yrwf());
  if (PH == 5) {
    {
      pg8::StaticOrder S; S.init(NLAT, 512, nb, bid);
      pg8::gemm_phase<pg8::EpiGluT, pg8::StaticOrder, false>((PG8_LAS unsigned char*)smem, pg8::Gemm{p.ys5f(), p.wglu_t(), NLAT, 512, 512}, S, pg8::EpiGluT{p.ys5f(), p.s5_b_glu, p.hn()}, nullptr);
    }
    {
      pg8::StaticOrder S; S.init(NLAT, 512, nb, bid);
      pg8::gemm_phase<pg8::EpiGateT, pg8::StaticOrder, false>((PG8_LAS unsigned char*)smem, pg8::Gemm{p.sg(), p.wg2_t(), NLAT, 512, 256}, S, pg8::EpiGateT{p.yrwf(), p.hn()}, nullptr);
    }
  }
  if (PH == 6) {
    pg8::StaticOrder S; S.init(NLAT, 1024, nb, bid);
    pg8::gemm_phase<pg8::EpiWoutT, pg8::StaticOrder, false>((PG8_LAS unsigned char*)smem, pg8::Gemm{p.hn(), p.wout_t(), NLAT, 1024, 1024}, S, pg8::EpiWoutT{p.x, p.mod(), p.out}, nullptr);
  }
  if (PH == 7) ph_norm(p, 1, bid, nb);
  if (PH == 8) {
    pg8::StaticOrder S; S.init(NLAT, 2048, nb, bid);
    pg8::gemm_phase<pg8::EpiProjT, pg8::StaticOrder, false>((PG8_LAS unsigned char*)smem, pg8::Gemm{p.hn(), p.wq_t(), NLAT, 2048, 1024}, S, pg8::EpiProjT{p.proj(), 2048, 2048}, nullptr);
  }
  if (PH == 9) ph_route(p, smem, bid, nb);
  if (PH == 10) ph_ffn(p, rep ? (float*)p.proj() : p.out, smem, bid, nb);
  if (PH == 11) ph_s5scan2(p, smem, bid, nb);
  if (PH == 12) ph_rwscan2(p, smem, bid, nb);
}
#ifndef REPMASK
#define REPMASK 0
#endif
#define REP(n) ((REPMASK >> (n)) & 1)
#define PHASE(n) if (ph_lo <= n && n < ph_hi) { if (n > ph_lo) { if (n == 1) grid.sync(); else xcd_barrier(xb); } if (REP(n)) { { const P lp_ = load_params(); run_phase<n>(lp_, smem, bid, nb, true); } __syncthreads(); } if (n == 3 && REP(11)) { run_phase<11>(p, smem, bid, nb); __syncthreads(); } if (n == 3 && REP(12)) { run_phase<12>(p, smem, bid, nb); __syncthreads(); } { const P lp_ = load_params(); run_phase<n>(lp_, smem, bid, nb); } }
__global__ void __launch_bounds__(NTHREADS) mega(P p, int ph_lo, int ph_hi) {
  char* smem = g_smem;
  if ((threadIdx.x & 63) == 0) *(int*)(g_smem + WAVETAB_OFF + 4 * hw_slot()) = (int)(threadIdx.x >> 6);
  cg::grid_group grid = cg::this_grid();
  const int bid = blockIdx.x, nb = gridDim.x;
  volatile LAS unsigned* xst = (volatile LAS unsigned*)(smem + LDS_BYTES - 16);
  if (threadIdx.x == 0) { xst[0] = 0u; xst[1] = 0u; }
  __syncthreads();
  XcdBarrier xb;
  {
    const P lp0 = load_params();
    xb.bar = lp0.bar(); xb.x = 0; xb.st = xst;
    if (ph_hi - ph_lo > 1) xb = xcd_barrier_post(lp0.bar(), xst);
  }
  PHASE(0) PHASE(1) PHASE(2) PHASE(3) PHASE(4) PHASE(5) PHASE(6) PHASE(7) PHASE(8) PHASE(9) PHASE(10)
}

extern "C" void kernel_launch(void* const* d_in, const int* in_sizes, int n_in, void* d_out, int out_size, void* d_ws,
                              size_t ws_size, hipStream_t stream) {
  static int grid_blocks = 0;
  if (!grid_blocks) {
    int dev = 0, cus = 0, per_cu = 0;
    hipGetDevice(&dev);
    hipDeviceGetAttribute(&cus, hipDeviceAttributeMultiprocessorCount, dev);
    hipFuncSetAttribute((const void*)mega, hipFuncAttributeMaxDynamicSharedMemorySize, LDS_BYTES);
    hipOccupancyMaxActiveBlocksPerMultiprocessor(&per_cu, (const void*)mega, NTHREADS, LDS_BYTES);
    if (per_cu < 1) { fprintf(stderr, "occupancy query returned %d\n", per_cu); per_cu = 1; }
    grid_blocks = cus;
  }
  P p{};
  const float** fp = (const float**)&p;
  for (int i = 0; i < 36; ++i) fp[i] = (const float*)d_in[i];
  p.out = (float*)d_out;
  p.ws = (char*)d_ws;
  if (WS_TOTAL > ws_size) { fprintf(stderr, "workspace too small: need %zu have %zu\n", (size_t)WS_TOTAL, ws_size); return; }
#if MEGA
  if (hipMemsetAsync((char*)d_ws + OFF_bar, 0, XCD_BAR_WORDS * 4, stream) != hipSuccess) fprintf(stderr, "memset of barrier words failed\n");
  int lo = 0, hi = NPHASES;
  void* args[] = {&p, &lo, &hi};
  hipError_t e = hipLaunchCooperativeKernel((const void*)mega, dim3(grid_blocks), dim3(NTHREADS), args, LDS_BYTES, stream);
  if (e != hipSuccess) fprintf(stderr, "cooperative launch failed: %s (grid %d)\n", hipGetErrorString(e), grid_blocks);
#else
  for (int ph = 0; ph < NPHASES; ++ph) {
    hipLaunchKernelGGL(mega, dim3(grid_blocks), dim3(NTHREADS), LDS_BYTES, stream, p, ph, ph + 1);
  }
#endif
}
```

```cpp
#include <hip/hip_runtime.h>
#include <hip/hip_cooperative_groups.h>
#include <stdint.h>
#include <stdio.h>
namespace cg = cooperative_groups;

#ifndef MEGA
#define MEGA 1
#endif

typedef unsigned short u16;
using bf16x8 = __attribute__((ext_vector_type(8))) short;
using f32x4 = __attribute__((ext_vector_type(4))) float;
using u32x4 = __attribute__((ext_vector_type(4))) unsigned;
using f32x16 = __attribute__((ext_vector_type(16))) float;

#define DM 1024
#define NLAT 65536
#define NCTX 8192
#define NTOK 73728
#define INC 2208
#define INCP 2304
#define NTHREADS 512
#define LDS_BYTES 163840

#define INC_FWD 1
constexpr size_t ws_al(size_t x) { return (x + 255) & ~(size_t)255; }
constexpr size_t OFF_mod = 0;
constexpr size_t OFF_win_t = OFF_mod + ws_al(33 * 6144 * 4);
constexpr size_t OFF_wout_t = OFF_win_t + ws_al((size_t)2304 * 1024 * 2);
constexpr size_t OFF_wq_t = OFF_wout_t + ws_al((size_t)1024 * 1024 * 2);
constexpr size_t OFF_wglu_t = OFF_wq_t + ws_al((size_t)2048 * 1024 * 2);
constexpr size_t OFF_wg2_t = OFF_wglu_t + ws_al((size_t)512 * 512 * 2);
constexpr size_t OFF_keys = OFF_wg2_t + ws_al((size_t)512 * 256 * 2);
constexpr size_t OFF_utab = OFF_keys + ws_al((size_t)8 * 2 * 128 * 128 * 2);
constexpr size_t OFF_usc = OFF_utab + ws_al((size_t)16384 * 1024);
constexpr size_t OFF_vsc = OFF_usc + ws_al(16384 * 4);
constexpr size_t OFF_s5ab = OFF_vsc + ws_al(16384 * 4);
constexpr size_t OFF_s5bb = OFF_s5ab + ws_al(4096 * 2 * 4);
constexpr size_t OFF_s5ct = OFF_s5bb + ws_al(4096 * 32 * 4);
constexpr size_t OFF_hn = OFF_s5ct + ws_al(2 * 32 * 16 * 128 * 2);
constexpr size_t OFF_proj = OFF_hn + ws_al((size_t)73728 * 1024 * 2);
constexpr size_t OFF_ys5f = OFF_proj + ws_al((size_t)73728 * 2208 * 2);
constexpr size_t OFF_ys5b = OFF_ys5f + ws_al((size_t)65536 * 512 * 2);
constexpr size_t OFF_yrwf = OFF_ys5b + ws_al((size_t)65536 * 512 * 2);
constexpr size_t OFF_yrwb = OFF_yrwf + ws_al((size_t)65536 * 512 * 2);
constexpr size_t OFF_bsc = OFF_yrwb + ws_al((size_t)65536 * 512 * 2);
constexpr size_t OFF_sg = OFF_bsc + ws_al((size_t)2 * 65536 * 8 * 4);
constexpr size_t OFF_bar = OFF_sg + ws_al((size_t)65536 * 256 * 2);
constexpr size_t OFF_wlf = OFF_bar + ws_al(3456 * 4);
constexpr size_t WS_TOTAL = OFF_wlf + ws_al(2 * 4096 * 16);

extern __shared__ __attribute__((aligned(16))) char g_smem[];
#define WAVETAB_OFF (LDS_BYTES - 16 - 256)
__device__ __forceinline__ int hw_slot() { return (int)(__builtin_amdgcn_s_getreg((5 << 11) | 4) & 63u); }
__device__ __forceinline__ int tidx() {
  const int w = *(const int*)(g_smem + WAVETAB_OFF + 4 * hw_slot());
  return __builtin_amdgcn_readfirstlane(w) * 64 + (int)__builtin_amdgcn_mbcnt_hi(~0u, __builtin_amdgcn_mbcnt_lo(~0u, 0u));
}
struct P {
  const float *x, *c, *ctx, *c_ctx, *w_ada, *b_ada, *norm1_g, *norm2_g, *w_in, *s5_a_re, *s5_a_im, *s5_log_dt,
      *s5_b_re, *s5_b_im, *s5_c_re, *s5_c_im, *s5_d, *s5_w_glu, *s5_b_glu, *rw_mu, *rw_w0, *rw_w_w2, *rw_a0, *rw_w_a2,
      *rw_w_g2, *rw_k_k, *rw_k_a, *rw_r_k, *rw_ln_w, *rw_ln_b, *w_out, *peer_w_q, *peer_keys, *peer_u, *peer_v, *norm_f_g;
  float* out;
  char* ws;
  __device__ __forceinline__ float* mod() const { return (float*)(ws + OFF_mod); }
  __device__ __forceinline__ u16* win_t() const { return (u16*)(ws + OFF_win_t); }
  __device__ __forceinline__ u16* wout_t() const { return (u16*)(ws + OFF_wout_t); }
  __device__ __forceinline__ u16* wq_t() const { return (u16*)(ws + OFF_wq_t); }
  __device__ __forceinline__ u16* wglu_t() const { return (u16*)(ws + OFF_wglu_t); }
  __device__ __forceinline__ u16* wg2_t() const { return (u16*)(ws + OFF_wg2_t); }
  __device__ __forceinline__ u16* keys() const { return (u16*)(ws + OFF_keys); }
  __device__ __forceinline__ unsigned char* utab() const { return (unsigned char*)(ws + OFF_utab); }
  __device__ __forceinline__ float* usc() const { return (float*)(ws + OFF_usc); }
  __device__ __forceinline__ float* vsc() const { return (float*)(ws + OFF_vsc); }
  __device__ __forceinline__ float* s5ab() const { return (float*)(ws + OFF_s5ab); }
  __device__ __forceinline__ float* s5bb() const { return (float*)(ws + OFF_s5bb); }
  __device__ __forceinline__ u16* s5ct() const { return (u16*)(ws + OFF_s5ct); }
  __device__ __forceinline__ u16* hn() const { return (u16*)(ws + OFF_hn); }
  __device__ __forceinline__ u16* proj() const { return (u16*)(ws + OFF_proj); }
  __device__ __forceinline__ u16* ys5f() const { return (u16*)(ws + OFF_ys5f); }
  __device__ __forceinline__ u16* ys5b() const { return (u16*)(ws + OFF_ys5b); }
  __device__ __forceinline__ u16* yrwf() const { return (u16*)(ws + OFF_yrwf); }
  __device__ __forceinline__ u16* yrwb() const { return (u16*)(ws + OFF_yrwb); }
  __device__ __forceinline__ float* bsc() const { return (float*)(ws + OFF_bsc); }
  __device__ __forceinline__ u16* sg() const { return (u16*)(ws + OFF_sg); }
  __device__ __forceinline__ unsigned* bar() const { return (unsigned*)(ws + OFF_bar); }
  __device__ __forceinline__ u16* wlf() const { return (u16*)(ws + OFF_wlf); }
  __device__ __forceinline__ unsigned char* vtab() const { return utab() + 512; }
  __device__ __forceinline__ int* idx() const { return (int*)ys5b(); }
  __device__ __forceinline__ float* gate() const { return (float*)yrwb(); }
};

typedef float f32x2_t __attribute__((ext_vector_type(2)));
typedef __bf16 bf16x2_t __attribute__((ext_vector_type(2)));
__device__ __forceinline__ unsigned pack2(float a, float b) {
  f32x2_t v = {a, b};
  return __builtin_bit_cast(unsigned, __builtin_convertvector(v, bf16x2_t));
}
__device__ __forceinline__ u16 f2bf(float f) { return __builtin_bit_cast(u16, (__bf16)f); }
__device__ __forceinline__ float bf2f(u16 h) { return __uint_as_float(((unsigned)h) << 16); }
__device__ __forceinline__ float bflo(unsigned u) { return __uint_as_float(u << 16); }
__device__ __forceinline__ float bfhi(unsigned u) { return __uint_as_float(u & 0xffff0000u); }
__device__ __forceinline__ float wave_sum(float v) {
#pragma unroll
  for (int m = 32; m >= 1; m >>= 1) v += __shfl_xor(v, m, 64);
  return v;
}
__device__ __forceinline__ float gelu_exact(float x) { return 0.5f * x * (1.f + erff(x * 0.70710678118654752f)); }
__device__ __forceinline__ float gelu_as(float v) {
  const float av = fabsf(v), t = __builtin_amdgcn_rcpf(av * 0.2316418882f + 1.0f);
  float q = t * 0.5307027145f + (-0.7265760135f);
  q = q * t + 0.7107068705f; q = q * t + (-0.142248368f); q = q * t + 0.127414796f; q = q * t;
  const float e = __builtin_amdgcn_exp2f((v * v) * (-0.72134752044f));
  const float m = v * (q * e);
  return v < 0.f ? m : v - m;
}
__device__ __forceinline__ float sigmoidf(float x) { return 1.f / (1.f + __expf(-x)); }


typedef float v2f __attribute__((ext_vector_type(2)));
__device__ __forceinline__ float dpp_add(float v, const int ctrl, const int rmask) {
  int m;
  switch (ctrl) {
    case 0: m = __builtin_amdgcn_update_dpp(0, __float_as_int(v), 0xB1, 0xf, 0xf, true); break;
    case 1: m = __builtin_amdgcn_update_dpp(0, __float_as_int(v), 0x4E, 0xf, 0xf, true); break;
    case 2: m = __builtin_amdgcn_update_dpp(0, __float_as_int(v), 0x141, 0xf, 0xf, true); break;
    case 3: m = __builtin_amdgcn_update_dpp(0, __float_as_int(v), 0x140, 0xf, 0xf, true); break;
    case 4: m = __builtin_amdgcn_update_dpp(0, __float_as_int(v), 0x142, 0xa, 0xf, false); break;
    default: m = __builtin_amdgcn_update_dpp(0, __float_as_int(v), 0x143, 0xc, 0xf, false); break;
  }
  return v + __int_as_float(m);
}
__device__ __forceinline__ float wave_sum_u(float v) {
  v = dpp_add(v, 0, 0); v = dpp_add(v, 1, 0); v = dpp_add(v, 2, 0); v = dpp_add(v, 3, 0);
  v = dpp_add(v, 4, 0); v = dpp_add(v, 5, 0);
  return __int_as_float(__builtin_amdgcn_readlane(__float_as_int(v), 63));
}
__device__ __forceinline__ void convert_fp4_rows(const float* __restrict__ src, unsigned char* __restrict__ dst, float* __restrict__ sc,
                                                 int nrows, int bid, int nb) {
  const int wid = tidx() >> 6, lane = tidx() & 63;
  const int stride = nb * 8;
  for (int row0 = bid * 8 + wid; row0 < nrows; row0 += 4 * stride) {
    float4 v[4][4];
#pragma unroll
    for (int u = 0; u < 4; ++u) {
      int row = row0 + u * stride;
      if (row >= nrows) row = row0;
#pragma unroll
      for (int q = 0; q < 4; ++q) v[u][q] = *(const float4*)(src + (size_t)row * 1024 + lane * 16 + q * 4);
    }
#pragma unroll
    for (int u = 0; u < 4; ++u) {
      const int row = row0 + u * stride;
      if (row >= nrows) continue;
      float am = 0.f;
#pragma unroll
      for (int q = 0; q < 4; ++q)
        am = fmaxf(am, fmaxf(fmaxf(fabsf(v[u][q].x), fabsf(v[u][q].y)), fmaxf(fabsf(v[u][q].z), fabsf(v[u][q].w))));
#pragma unroll
      for (int m = 32; m >= 1; m >>= 1) am = fmaxf(am, __shfl_xor(am, m, 64));
      const float scl = am > 0.f ? 6.f / am : 1.f;
      unsigned w0 = 0u, w1 = 0u;
      w0 = __builtin_amdgcn_cvt_scalef32_pk_fp4_f32(w0, v[u][0].x * scl, v[u][0].y * scl, 1.0f, 0);
      w0 = __builtin_amdgcn_cvt_scalef32_pk_fp4_f32(w0, v[u][0].z * scl, v[u][0].w * scl, 1.0f, 1);
      w0 = __builtin_amdgcn_cvt_scalef32_pk_fp4_f32(w0, v[u][1].x * scl, v[u][1].y * scl, 1.0f, 2);
      w0 = __builtin_amdgcn_cvt_scalef32_pk_fp4_f32(w0, v[u][1].z * scl, v[u][1].w * scl, 1.0f, 3);
      w1 = __builtin_amdgcn_cvt_scalef32_pk_fp4_f32(w1, v[u][2].x * scl, v[u][2].y * scl, 1.0f, 0);
      w1 = __builtin_amdgcn_cvt_scalef32_pk_fp4_f32(w1, v[u][2].z * scl, v[u][2].w * scl, 1.0f, 1);
      w1 = __builtin_amdgcn_cvt_scalef32_pk_fp4_f32(w1, v[u][3].x * scl, v[u][3].y * scl, 1.0f, 2);
      w1 = __builtin_amdgcn_cvt_scalef32_pk_fp4_f32(w1, v[u][3].z * scl, v[u][3].w * scl, 1.0f, 3);
      *(uint2*)(dst + (size_t)row * 1024 + lane * 8) = make_uint2(w0, w1);
      if (lane == 0) sc[row] = am > 0.f ? am / 6.f : 1.f;
    }
  }
}

__device__ __forceinline__ void transpose_tiles(const float* __restrict__ src, int K, int N, u16* __restrict__ dst, int Kd, int Npad,
                                char* smem, int bid, int nb) {
  float* tile = (float*)smem;
  const int tid = tidx();
  const int nkt = Kd / 64, nnt = Npad / 64;
  for (int t = bid; t < nkt * nnt; t += nb) {
    int kt = t % nkt, nt = t / nkt;
    int k0 = kt * 64, n0 = nt * 64;
    __syncthreads();
#pragma unroll
    for (int it = 0; it < 8; ++it) {
      int i = (tid >> 6) + it * 8, j = tid & 63;
      int k = k0 + i, n = n0 + j;
      tile[i * 65 + j] = (k < K && n < N) ? src[(size_t)k * N + n] : 0.f;
    }
    __syncthreads();
    int n = tid >> 3, kc = (tid & 7) * 8;
    uint4 o;
    o.x = pack2(tile[(kc + 0) * 65 + n], tile[(kc + 1) * 65 + n]);
    o.y = pack2(tile[(kc + 2) * 65 + n], tile[(kc + 3) * 65 + n]);
    o.z = pack2(tile[(kc + 4) * 65 + n], tile[(kc + 5) * 65 + n]);
    o.w = pack2(tile[(kc + 6) * 65 + n], tile[(kc + 7) * 65 + n]);
    *(uint4*)(dst + (size_t)(n0 + n) * Kd + k0 + kc) = o;
  }
}

__device__ __forceinline__ void convert_bf16(const float* __restrict__ src, u16* __restrict__ dst, size_t n8, int bid, int nb) {
  for (size_t i = (size_t)bid * NTHREADS + tidx(); i < n8; i += (size_t)nb * NTHREADS) {
    float4 a = *(const float4*)(src + i * 8), b = *(const float4*)(src + i * 8 + 4);
    uint4 o;
    o.x = pack2(a.x, a.y); o.y = pack2(a.z, a.w); o.z = pack2(b.x, b.y); o.w = pack2(b.z, b.w);
    *(uint4*)(dst + i * 8) = o;
  }
}

__device__ __forceinline__ void ph_prep(const P& p, char* smem, int bid, int nb) {
  const int tid = tidx();
  {
    float* sc = (float*)smem;
    float* red = (float*)(smem + 33 * 256 * 4);
    for (int item = bid; item < 192; item += nb) {
      const int j0 = item * 32, kg = tid >> 5, col = tid & 31;
      float acc[33];
#pragma unroll
      for (int b = 0; b < 33; ++b) acc[b] = 0.f;
      for (int ch = 0; ch < 4; ++ch) {
        __syncthreads();
        for (int e = tid; e < 33 * 256; e += NTHREADS) {
          int b = e >> 8, kk = e & 255;
          float cv = (b < 32) ? p.c[b * 1024 + ch * 256 + kk] : p.c_ctx[ch * 256 + kk];
          sc[e] = cv / (1.f + expf(-cv));
        }
        float w[16];
#pragma unroll
        for (int i = 0; i < 16; ++i) w[i] = p.w_ada[(size_t)(ch * 256 + kg * 16 + i) * 6144 + j0 + col];
        __syncthreads();
#pragma unroll
        for (int i = 0; i < 16; ++i) {
          const int kk = kg * 16 + i;
#pragma unroll
          for (int b = 0; b < 33; ++b) acc[b] += sc[b * 256 + kk] * w[i];
        }
      }
#pragma unroll
      for (int b = 0; b < 33; ++b) red[(kg * 33 + b) * 32 + col] = acc[b];
      __syncthreads();
      for (int e = tid; e < 33 * 32; e += NTHREADS) {
        int b = e >> 5, cc = e & 31;
        float sv = p.b_ada[j0 + cc];
#pragma unroll
        for (int k2 = 0; k2 < 16; ++k2) sv += red[(k2 * 33 + b) * 32 + cc];
        p.mod()[b * 6144 + j0 + cc] = sv;
      }
      __syncthreads();
    }
  }
  transpose_tiles(p.w_in, 1024, INC, p.win_t(), 1024, INCP, smem, bid, nb);
  transpose_tiles(p.w_out, 1024, 1024, p.wout_t(), 1024, 1024, smem, bid, nb);
  transpose_tiles(p.peer_w_q, 1024, 2048, p.wq_t(), 1024, 2048, smem, bid, nb);
  transpose_tiles(p.s5_w_glu, 512, 512, p.wglu_t(), 512, 512, smem, bid, nb);
  transpose_tiles(p.rw_w_g2, 96, 512, p.wg2_t(), 256, 512, smem, bid, nb);
  convert_bf16(p.peer_keys, p.keys(), (size_t)8 * 2 * 128 * 128 / 8, bid, nb);
  convert_fp4_rows(p.peer_u, p.utab(), p.usc(), 16384, bid, nb);
  convert_fp4_rows(p.peer_v, p.vtab(), p.vsc(), 16384, bid, nb);
  for (int it = bid * NTHREADS + tid; it < 2 * 4096; it += nb * NTHREADS) {
    const int ln = it & 63, mt = (it >> 6) & 3, hh_ = (it >> 8) & 7, dd = (it >> 11) & 1, mm = it >> 12;
    const int tt = ln & 15, kq_ = ln >> 4;
    const float* W = mm ? p.rw_w_a2 : p.rw_w_w2;
    unsigned o[4];
#pragma unroll
    for (int q = 0; q < 4; ++q) {
      const size_t o0 = (size_t)(dd * 32 + 8 * kq_ + 2 * q) * 512 + hh_ * 64 + 16 * (tt >> 2) + 4 * mt + (tt & 3);
      o[q] = pack2(W[o0], W[o0 + 512]);
    }
    *(uint4*)(p.wlf() + (size_t)it * 8) = make_uint4(o[0], o[1], o[2], o[3]);
  }
  for (int it = bid * NTHREADS + tid; it < 4096; it += nb * NTHREADS) {
    int pp = it & 63, g = (it >> 6) & 31, d = it >> 11;
    float are = p.s5_a_re[it], aim = p.s5_a_im[it];
    float dt = expf(p.s5_log_dt[d * 32 + g]);
    float mag = expf(dt * are);
    float abr = mag * cosf(dt * aim), abi = mag * sinf(dt * aim);
    float nr = abr - 1.f, ni = abi;
    float den = are * are + aim * aim;
    float cfr = (nr * are + ni * aim) / den, cfi = (ni * are - nr * aim) / den;
    p.s5ab()[it * 2] = abr;
    p.s5ab()[it * 2 + 1] = abi;
    for (int h = 0; h < 16; ++h) {
      float br = p.s5_b_re[(size_t)it * 16 + h], bi = p.s5_b_im[(size_t)it * 16 + h];
      p.s5bb()[(size_t)it * 32 + h] = cfr * br - cfi * bi;
      p.s5bb()[(size_t)it * 32 + 16 + h] = cfr * bi + cfi * br;
    }
    for (int h = 0; h < 16; ++h) {
      size_t ci = ((size_t)(d * 32 + g) * 16 + h) * 64 + pp;
      p.s5ct()[((size_t)(d * 32 + g) * 16 + h) * 128 + 2 * pp] = f2bf(p.s5_c_re[ci]);
      p.s5ct()[((size_t)(d * 32 + g) * 16 + h) * 128 + 2 * pp + 1] = f2bf(-p.s5_c_im[ci]);
    }
  }
}

__device__ __forceinline__ void ph_norm(const P& p, int mode, int bid, int nb) {
  const int wid = tidx() >> 6, lane = tidx() & 63;
  const int nrows = mode == 0 ? NTOK : NLAT;
  const float* gvec = mode == 0 ? p.norm1_g : p.norm2_g;
  const int sh_off = mode == 0 ? 0 : 3 * 1024, sc_off = sh_off + 1024;
  const int stride = nb * 8;
  for (int row0 = bid * 8 + wid; row0 < nrows; row0 += 4 * stride) {
    float4 v[4][4];
    int bs[4];
#pragma unroll
    for (int u = 0; u < 4; ++u) {
      int row = row0 + u * stride;
      if (row >= nrows) row = row0;
      const float* src;
      if (mode == 0) {
        if (row < NLAT) { src = p.x + (size_t)row * 1024; bs[u] = row >> 11; }
        else { src = p.ctx + (size_t)(row - NLAT) * 1024; bs[u] = 32; }
      } else { src = p.out + (size_t)row * 1024; bs[u] = row >> 11; }
#pragma unroll
      for (int j = 0; j < 2; ++j) {
        v[u][2 * j] = *(const float4*)(src + j * 512 + lane * 8);
        v[u][2 * j + 1] = *(const float4*)(src + j * 512 + lane * 8 + 4);
      }
    }
#pragma unroll
    for (int u = 0; u < 4; ++u) {
      const int row = row0 + u * stride;
      if (row >= nrows) continue;
      float ss = 0.f;
#pragma unroll
      for (int j = 0; j < 4; ++j) ss += v[u][j].x * v[u][j].x + v[u][j].y * v[u][j].y + v[u][j].z * v[u][j].z + v[u][j].w * v[u][j].w;
      ss = wave_sum_u(ss);
      const float rstd = rsqrtf(ss * (1.f / 1024.f) + 1e-6f);
      const float* mrow = p.mod() + bs[u] * 6144;
#pragma unroll
      for (int j = 0; j < 2; ++j) {
        const int col = j * 512 + lane * 8;
        unsigned o[4];
#pragma unroll
        for (int hq = 0; hq < 2; ++hq) {
          const float4 x = v[u][2 * j + hq];
          const float4 g = *(const float4*)(gvec + col + 4 * hq);
          const float4 sh = *(const float4*)(mrow + sh_off + col + 4 * hq);
          const float4 sc = *(const float4*)(mrow + sc_off + col + 4 * hq);
          o[2 * hq] = pack2(x.x * rstd * g.x * (1.f + sc.x) + sh.x, x.y * rstd * g.y * (1.f + sc.y) + sh.y);
          o[2 * hq + 1] = pack2(x.z * rstd * g.z * (1.f + sc.z) + sh.z, x.w * rstd * g.w * (1.f + sc.w) + sh.w);
        }
        *(uint4*)(p.hn() + (size_t)row * 1024 + col) = make_uint4(o[0], o[1], o[2], o[3]);
      }
    }
  }
}

#define G_BM 256
#define G_BN 128
#define G_BK 64
#define G_LD 72
template <class Epi>
__device__ __forceinline__ void gemm_simple(const u16* __restrict__ A, int lda, const u16* __restrict__ Bt, int ldb, int K, int M, int N,
                           char* smem, int bid, int nb, Epi epi) {
  u16* As = (u16*)smem;
  u16* Bs = (u16*)(smem + 2 * G_BM * G_LD * 2);
  const int tid = tidx(), wid = tid >> 6, lane = tid & 63;
  const int wr = wid >> 1, wc = wid & 1, fr = lane & 15, fq = lane >> 4;
  const int ntn = N / G_BN, ntiles = (M / G_BM) * ntn, nk = K / G_BK;
  const int lrow = tid >> 3, lkc = (tid & 7) * 8;
  for (int tile = bid; tile < ntiles; tile += nb) {
    const int m0 = (tile / ntn) * G_BM, n0 = (tile % ntn) * G_BN;
    f32x4 acc[4][4];
#pragma unroll
    for (int i = 0; i < 4; ++i)
#pragma unroll
      for (int j = 0; j < 4; ++j) acc[i][j] = (f32x4){0.f, 0.f, 0.f, 0.f};
    u32x4 ra[4], rb[2];
    const u16* Ag = A + (size_t)(m0 + lrow) * lda + lkc;
    const u16* Bg = Bt + (size_t)(n0 + lrow) * ldb + lkc;
#pragma unroll
    for (int i = 0; i < 4; ++i) ra[i] = *(const u32x4*)(Ag + (size_t)(64 * i) * lda);
#pragma unroll
    for (int i = 0; i < 2; ++i) rb[i] = *(const u32x4*)(Bg + (size_t)(64 * i) * ldb);
    __syncthreads();
#pragma unroll
    for (int i = 0; i < 4; ++i) *(u32x4*)(As + (lrow + 64 * i) * G_LD + lkc) = ra[i];
#pragma unroll
    for (int i = 0; i < 2; ++i) *(u32x4*)(Bs + (lrow + 64 * i) * G_LD + lkc) = rb[i];
    __syncthreads();
    for (int kt = 0; kt < nk; ++kt) {
      const int buf = kt & 1;
      if (kt + 1 < nk) {
#pragma unroll
        for (int i = 0; i < 4; ++i) ra[i] = *(const u32x4*)(Ag + (size_t)(64 * i) * lda + (kt + 1) * G_BK);
#pragma unroll
        for (int i = 0; i < 2; ++i) rb[i] = *(const u32x4*)(Bg + (size_t)(64 * i) * ldb + (kt + 1) * G_BK);
      }
      const u16* as = As + buf * (G_BM * G_LD);
      const u16* bs = Bs + buf * (G_BN * G_LD);
#pragma unroll
      for (int ks = 0; ks < 2; ++ks) {
        bf16x8 af[4], bfr[4];
#pragma unroll
        for (int mi = 0; mi < 4; ++mi) af[mi] = *(const bf16x8*)(as + (wr * 64 + mi * 16 + fr) * G_LD + ks * 32 + fq * 8);
#pragma unroll
        for (int ni = 0; ni < 4; ++ni) bfr[ni] = *(const bf16x8*)(bs + (wc * 64 + ni * 16 + fr) * G_LD + ks * 32 + fq * 8);
#pragma unroll
        for (int mi = 0; mi < 4; ++mi)
#pragma unroll
          for (int ni = 0; ni < 4; ++ni)
            acc[mi][ni] = __builtin_amdgcn_mfma_f32_16x16x32_bf16(af[mi], bfr[ni], acc[mi][ni], 0, 0, 0);
      }
      if (kt + 1 < nk) {
        u16* as2 = As + (buf ^ 1) * (G_BM * G_LD);
        u16* bs2 = Bs + (buf ^ 1) * (G_BN * G_LD);
#pragma unroll
        for (int i = 0; i < 4; ++i) *(u32x4*)(as2 + (lrow + 64 * i) * G_LD + lkc) = ra[i];
#pragma unroll
        for (int i = 0; i < 2; ++i) *(u32x4*)(bs2 + (lrow + 64 * i) * G_LD + lkc) = rb[i];
      }
      __syncthreads();
    }
#pragma unroll
    for (int mi = 0; mi < 4; ++mi)
#pragma unroll
      for (int ni = 0; ni < 4; ++ni) epi(m0 + wr * 64 + mi * 16 + fq * 4, n0 + wc * 64 + ni * 16 + fr, acc[mi][ni]);
  }
}

namespace pg8 {
#define PG8_LAS __attribute__((address_space(3)))
typedef unsigned short bf16_t;
typedef short bf16x8 __attribute__((ext_vector_type(8)));
typedef float f32x4 __attribute__((ext_vector_type(4)));
typedef unsigned u32x4 __attribute__((ext_vector_type(4)));
constexpr int BM = 256, BK = 64, HALF = 128, HTB = HALF * BK * 2  , STAGE_BYTES = 8 * HTB, NXCD = 8, WGM = 8;

__host__ __device__ __forceinline__ int lds_byte(int r, int c) { const int st = (r >> 4) * 2 + (c >> 5), rr = r & 15, cc = c & 31, ob = rr * 64 + cc * 2; return st * 1024 + (ob ^ (((ob >> 9) & 1) << 5)); }
__host__ __device__ __forceinline__ void stage_rc(int b, int& R, int& C) { const int st = b / 1024, sb = b % 1024, swz = sb ^ (((sb >> 9) & 1) << 5); R = (st >> 1) * 16 + swz / 64; C = (st & 1) * 32 + (swz % 64) / 2; }
__host__ __device__ __forceinline__ int perm32(int rho) { const int n = rho >> 4, i = rho & 15; return 8 * (i >> 2) + 4 * n + (i & 3); }

struct Unit { int pm, pn; };
struct Gemm { const bf16_t* A; const bf16_t* Bt; int M, N, K; };

struct StaticOrder {
    int nM, nN, nwg, G, c;
    __host__ __device__ void init(int M, int N, int G_, int c_) { nM = M / BM; nN = N / BM; nwg = nM * nN; G = G_; c = c_; }
    __host__ __device__ bool next(int i, Unit& u) const {
        const long L = (long)i * G + c; if (L >= nwg) return false;
        int wgid = (int)L; { const int q = nwg / NXCD, r = nwg % NXCD, xcd = wgid % NXCD, off = wgid / NXCD; wgid = (xcd < r ? xcd * (q + 1) : r * (q + 1) + (xcd - r) * q) + off; }
        const int nig = WGM * nN, gid = wgid / nig, fm = gid * WGM, gsz = (nM - fm) < WGM ? (nM - fm) : WGM;
        u.pm = fm + ((wgid % nig) % gsz); u.pn = (wgid % nig) / gsz; return true;
    }
    __device__ __forceinline__ void a_ready(const Unit&) const {}
    __device__ __forceinline__ void done(const Unit&) const {}
};
__device__ __forceinline__ unsigned cvt_pk_bf16(float lo, float hi) { return ::pack2(lo, hi); }
typedef float f32x2 __attribute__((ext_vector_type(2)));
template <class Epi, class Sched, bool STAMP = false>
__device__ __forceinline__ void gemm_phase(PG8_LAS unsigned char* lds, const Gemm g, const Sched& S, const Epi& E, unsigned long long* stamps) {
    const int tid = tidx(), wid = __builtin_amdgcn_readfirstlane(tid >> 6), lane = tid & 63, wr = wid >> 2, wc = wid & 3, fr = lane & 15, fq = lane >> 4;
    const int K = g.K, nt = K / BK;
    int ts_lo = 0, ts_hi = 0, nts = 0; const unsigned long long rt_entry = STAMP ? (unsigned long long)wall_clock64() : 0ull;
#define PG8_STAMP() do { if (STAMP && wid == 0 && nts < 64) { const unsigned long long _c = (unsigned long long)clock64(); \
        ts_lo = (lane == nts) ? (int)(unsigned)_c : ts_lo; ts_hi = (lane == nts) ? (int)(unsigned)(_c >> 32) : ts_hi; ++nts; } } while (0)
    PG8_STAMP();
    unsigned voffA[2], voffB[2];
#pragma unroll
    for (int i = 0; i < 2; ++i) { int R, C; stage_rc(tid * 16 + i * 8192, R, C); const int Rb = Epi::PERM ? ((R & ~31) + perm32(R & 31)) : R;
        voffA[i] = (unsigned)(R * K + C) * 2u; voffB[i] = (unsigned)(Rb * K + C) * 2u; }
    const size_t kstep = (size_t)(BK * 2);
    const size_t hstep = (size_t)HALF * K * 2;
    const size_t tstep = 2 * hstep;
    const unsigned ldsw = (unsigned)wid * 1024u;
    const int aoff = lds_byte(wr * 64 + fr, fq * 8), boff = lds_byte(wc * 32 + fr, fq * 8);
#define PG8_SA(b, h) (((b) * 2 + (h)) * HTB)
#define PG8_SB(b, h) ((4 + (b) * 2 + (h)) * HTB)
#define PG8_STAGE(bufoff, gbase, voff) do { _Pragma("unroll") for (int _i = 0; _i < 2; ++_i) \
        __builtin_amdgcn_global_load_lds((const unsigned*)((const char*)(gbase) + (voff)[_i]), (PG8_LAS unsigned*)(lds + (bufoff) + ldsw + _i * 8192), 16, 0, 0); } while (0)
#define PG8_LDA(dst, b, h) do { _Pragma("unroll") for (int m = 0; m < 4; ++m) _Pragma("unroll") for (int k = 0; k < 2; ++k) dst[m][k] = *(const PG8_LAS bf16x8*)(lds + PG8_SA(b, h) + aoff + m * 2048 + k * 1024); } while (0)
#define PG8_LDB(dst, b, h) do { _Pragma("unroll") for (int n = 0; n < 2; ++n) _Pragma("unroll") for (int k = 0; k < 2; ++k) dst[n][k] = *(const PG8_LAS bf16x8*)(lds + PG8_SB(b, h) + boff + n * 2048 + k * 1024); } while (0)
#define PG8_MMA(ai, bj, At, Bt) do { __builtin_amdgcn_s_setprio(1); _Pragma("unroll") for (int m = 0; m < 4; ++m) _Pragma("unroll") for (int n = 0; n < 2; ++n) _Pragma("unroll") for (int k = 0; k < 2; ++k) \
        acc[ai][bj][m][n] = __builtin_amdgcn_mfma_f32_16x16x32_bf16(Bt[n][k], At[m][k], acc[ai][bj][m][n], 0, 0, 0); __builtin_amdgcn_s_setprio(0); } while (0)
#define PG8_WAIT_V(n) asm volatile("s_waitcnt vmcnt(" #n ")" ::: "memory")
#define PG8_WAIT_L(n) asm volatile("s_waitcnt lgkmcnt(" #n ")" ::: "memory")
#define PG8_BAR __builtin_amdgcn_s_barrier()
#define PG8_SCHED __builtin_amdgcn_sched_barrier(0)
    Unit cur, nxt; int ui = 0;
    if (!S.next(0, cur)) return;
    f32x4 acc[2][2][4][2];
#pragma unroll
    for (int a = 0; a < 2; ++a)
#pragma unroll
        for (int b = 0; b < 2; ++b)
#pragma unroll
            for (int m = 0; m < 4; ++m)
#pragma unroll
                for (int n = 0; n < 2; ++n) acc[a][b][m][n] = (f32x4){0.f, 0.f, 0.f, 0.f};
    bf16x8 At[4][2], B0[2][2], B1[2][2];
    const char* cA = (const char*)g.A + (size_t)cur.pm * tstep; const char* cB = (const char*)g.Bt + (size_t)cur.pn * tstep;
    S.a_ready(cur);
    PG8_STAGE(PG8_SB(0, 0), cB, voffB); PG8_STAGE(PG8_SA(0, 0), cA, voffA); PG8_STAGE(PG8_SB(0, 1), cB + hstep, voffB); PG8_STAGE(PG8_SA(0, 1), cA + hstep, voffA);
    if (wr == 1) PG8_BAR;
    PG8_WAIT_V(4); PG8_BAR;
    PG8_STAGE(PG8_SB(1, 0), cB + kstep, voffB); PG8_STAGE(PG8_SA(1, 0), cA + kstep, voffA); PG8_STAGE(PG8_SB(1, 1), cB + hstep + kstep, voffB);
    PG8_WAIT_V(6); PG8_BAR;
    PG8_STAMP();
    for (;;) {
        const bool has_next = S.next(ui + 1, nxt);
        const char* nA = has_next ? (const char*)g.A + (size_t)nxt.pm * tstep : cA; const char* nB = has_next ? (const char*)g.Bt + (size_t)nxt.pn * tstep : cB;
        for (int t = 0; t < nt; t += 2) {
            const bool last = (t == nt - 2);
            const char* a1 = cA + (size_t)(t + 1) * kstep;
            const char* a2 = last ? nA : cA + (size_t)(t + 2) * kstep; const char* b2 = last ? nB : cB + (size_t)(t + 2) * kstep;
            const char* a3 = a2 + kstep; const char* b3 = b2 + kstep;
            if (last && has_next) S.a_ready(nxt);
            PG8_LDB(B0, 0, 0); PG8_SCHED; PG8_LDA(At, 0, 0); PG8_STAGE(PG8_SA(1, 1), a1 + hstep, voffA);
            PG8_WAIT_L(8); PG8_BAR; PG8_WAIT_L(0); PG8_MMA(0, 0, At, B0); PG8_BAR; PG8_SCHED;
            PG8_LDB(B1, 0, 1); PG8_STAGE(PG8_SB(0, 0), b2, voffB);
            PG8_BAR; PG8_WAIT_L(0); PG8_MMA(0, 1, At, B1); PG8_BAR;
            PG8_LDA(At, 0, 1); PG8_STAGE(PG8_SA(0, 0), a2, voffA);
            PG8_BAR; PG8_WAIT_L(0); PG8_MMA(1, 0, At, B0); PG8_BAR; PG8_SCHED;
            PG8_STAGE(PG8_SB(0, 1), b2 + hstep, voffB);
            PG8_WAIT_V(6); PG8_BAR; PG8_MMA(1, 1, At, B1); PG8_BAR;
            PG8_LDB(B0, 1, 0); PG8_SCHED; PG8_LDA(At, 1, 0); PG8_STAGE(PG8_SA(0, 1), a2 + hstep, voffA);
            PG8_WAIT_L(8); PG8_BAR; PG8_WAIT_L(0); PG8_MMA(0, 0, At, B0); PG8_BAR; PG8_SCHED;
            PG8_LDB(B1, 1, 1); PG8_STAGE(PG8_SB(1, 0), b3, voffB);
            PG8_BAR; PG8_WAIT_L(0); PG8_MMA(0, 1, At, B1); PG8_BAR;
            PG8_LDA(At, 1, 1); PG8_STAGE(PG8_SA(1, 0), a3, voffA);
            PG8_BAR; PG8_WAIT_L(0); PG8_MMA(1, 0, At, B0); PG8_BAR; PG8_SCHED;
            PG8_STAGE(PG8_SB(1, 1), b3 + hstep, voffB);
            PG8_WAIT_V(6); PG8_BAR; PG8_MMA(1, 1, At, B1); PG8_BAR;
        }
        PG8_STAMP();
        if constexpr (!Epi::AFTER_DRAIN) { E(acc, cur, wr, wc, fr, fq); S.done(cur); }
        PG8_STAMP();
        if (!has_next) break;
#pragma unroll
        for (int a = 0; a < 2; ++a)
#pragma unroll
            for (int b = 0; b < 2; ++b)
#pragma unroll
                for (int m = 0; m < 4; ++m)
#pragma unroll
                    for (int n = 0; n < 2; ++n) acc[a][b][m][n] = (f32x4){0.f, 0.f, 0.f, 0.f};
        cur = nxt; cA = nA; cB = nB; ++ui;
    }
    PG8_WAIT_V(0);
    if (wr == 0) PG8_BAR;
    PG8_BAR;
    if constexpr (Epi::AFTER_DRAIN) { E.fused(acc, cur, wr, wc, fr, fq, lds, wid, lane); S.done(cur); }
    PG8_STAMP();
    if (STAMP && wid == 0) { stamps[lane] = lane < nts ? (((unsigned long long)(unsigned)ts_hi << 32) | (unsigned)ts_lo) : 0ull;
        if (lane == 62) stamps[62] = rt_entry; if (lane == 63) stamps[63] = (unsigned long long)wall_clock64(); }
#undef PG8_STAMP
#undef PG8_SA
#undef PG8_SB
#undef PG8_STAGE
#undef PG8_LDA
#undef PG8_LDB
#undef PG8_MMA
#undef PG8_WAIT_V
#undef PG8_WAIT_L
#undef PG8_BAR
#undef PG8_SCHED
}
}

namespace pg8 {
struct EpiProjT {
  static constexpr bool PERM = true, AFTER_DRAIN = false;
  bf16_t* O; int ldc; int ncols;
  __device__ __forceinline__ void operator()(const f32x4 (&acc)[2][2][4][2], const Unit& u, int wr, int wc, int fr, int fq) const {
    const int row0 = u.pm * BM + wr * 64 + fr, col0 = u.pn * BM + wc * 32 + 8 * fq;
#pragma unroll
    for (int ai = 0; ai < 2; ++ai)
#pragma unroll
      for (int m = 0; m < 4; ++m) {
        bf16_t* rowp = O + (size_t)(row0 + ai * HALF + m * 16) * ldc + col0;
#pragma unroll
        for (int bj = 0; bj < 2; ++bj) {
          if (col0 + bj * HALF < ncols) {
            const f32x4 v0 = acc[ai][bj][m][0], v1 = acc[ai][bj][m][1];
            u32x4 w; w.x = cvt_pk_bf16(v0[0], v0[1]); w.y = cvt_pk_bf16(v0[2], v0[3]); w.z = cvt_pk_bf16(v1[0], v1[1]); w.w = cvt_pk_bf16(v1[2], v1[3]);
            *(u32x4*)(rowp + bj * HALF) = w;
          }
        }
      }
  }
};
struct EpiGluT {
  static constexpr bool PERM = true, AFTER_DRAIN = false;
  const bf16_t* Y1; const float* bglu; bf16_t* O;
  __device__ __forceinline__ void operator()(const f32x4 (&acc)[2][2][4][2], const Unit& u, int wr, int wc, int fr, int fq) const {
    const int row0 = u.pm * BM + wr * 64 + fr, col0 = u.pn * BM + wc * 32 + 8 * fq;
    f32x4 bv[2][2];
#pragma unroll
    for (int bj = 0; bj < 2; ++bj)
#pragma unroll
      for (int n = 0; n < 2; ++n) bv[bj][n] = *(const f32x4*)(bglu + col0 + bj * HALF + 4 * n);
#pragma unroll
    for (int ai = 0; ai < 2; ++ai)
#pragma unroll
      for (int m = 0; m < 4; ++m) {
        const size_t r = (size_t)(row0 + ai * HALF + m * 16);
#pragma unroll
        for (int bj = 0; bj < 2; ++bj) {
          const u32x4 yv = *(const u32x4*)(Y1 + r * 512 + col0 + bj * HALF);
          const f32x4 v0 = acc[ai][bj][m][0] + bv[bj][0], v1 = acc[ai][bj][m][1] + bv[bj][1];
          float o[8];
#pragma unroll
          for (int q = 0; q < 4; ++q) {
            const float ylo = __uint_as_float(yv[q] << 16), yhi = __uint_as_float(yv[q] & 0xffff0000u);
            const float a0 = q < 2 ? v0[2 * q] : v1[2 * q - 4], a1 = q < 2 ? v0[2 * q + 1] : v1[2 * q - 3];
            o[2 * q] = ylo / (1.f + __expf(-a0));
            o[2 * q + 1] = yhi / (1.f + __expf(-a1));
          }
          u32x4 w; w.x = cvt_pk_bf16(o[0], o[1]); w.y = cvt_pk_bf16(o[2], o[3]); w.z = cvt_pk_bf16(o[4], o[5]); w.w = cvt_pk_bf16(o[6], o[7]);
          *(u32x4*)(O + r * 1024 + col0 + bj * HALF) = w;
        }
      }
  }
};
struct EpiGateT {
  static constexpr bool PERM = true, AFTER_DRAIN = false;
  const bf16_t* T1; bf16_t* O;
  __device__ __forceinline__ void operator()(const f32x4 (&acc)[2][2][4][2], const Unit& u, int wr, int wc, int fr, int fq) const {
    const int row0 = u.pm * BM + wr * 64 + fr, col0 = u.pn * BM + wc * 32 + 8 * fq;
#pragma unroll
    for (int ai = 0; ai < 2; ++ai)
#pragma unroll
      for (int m = 0; m < 4; ++m) {
        const size_t r = (size_t)(row0 + ai * HALF + m * 16);
#pragma unroll
        for (int bj = 0; bj < 2; ++bj) {
          const u32x4 tv = *(const u32x4*)(T1 + r * 512 + col0 + bj * HALF);
          const f32x4 v0 = acc[ai][bj][m][0], v1 = acc[ai][bj][m][1];
          u32x4 w;
          w.x = cvt_pk_bf16(__uint_as_float(tv[0] << 16) * v0[0], __uint_as_float(tv[0] & 0xffff0000u) * v0[1]);
          w.y = cvt_pk_bf16(__uint_as_float(tv[1] << 16) * v0[2], __uint_as_float(tv[1] & 0xffff0000u) * v0[3]);
          w.z = cvt_pk_bf16(__uint_as_float(tv[2] << 16) * v1[0], __uint_as_float(tv[2] & 0xffff0000u) * v1[1]);
          w.w = cvt_pk_bf16(__uint_as_float(tv[3] << 16) * v1[2], __uint_as_float(tv[3] & 0xffff0000u) * v1[3]);
          *(u32x4*)(O + r * 1024 + 512 + col0 + bj * HALF) = w;
        }
      }
  }
};
struct EpiWoutT {
  static constexpr bool PERM = false, AFTER_DRAIN = false;
  const float* X; const float* mod; float* H2;
  __device__ __forceinline__ void operator()(const f32x4 (&acc)[2][2][4][2], const Unit& u, int wr, int wc, int fr, int fq) const {
    const int row0 = u.pm * BM + wr * 64 + fr, col0 = u.pn * BM + wc * 32 + 4 * fq;
    const float* g1p = mod + ((u.pm * BM) >> 11) * 6144 + 2 * 1024 + col0;
    f32x4 gv[2][2];
#pragma unroll
    for (int bj = 0; bj < 2; ++bj)
#pragma unroll
      for (int n = 0; n < 2; ++n) gv[bj][n] = *(const f32x4*)(g1p + bj * HALF + n * 16);
#pragma unroll
    for (int ai = 0; ai < 2; ++ai)
#pragma unroll
      for (int m = 0; m < 4; ++m) {
        const size_t off = (size_t)(row0 + ai * HALF + m * 16) * 1024 + col0;
#pragma unroll
        for (int bj = 0; bj < 2; ++bj)
#pragma unroll
          for (int n = 0; n < 2; ++n) {
            const f32x4 xv = *(const f32x4*)(X + off + bj * HALF + n * 16);
            *(f32x4*)(H2 + off + bj * HALF + n * 16) = xv + gv[bj][n] * acc[ai][bj][m][n];
          }
      }
  }
};
}

struct EpiProj {
  u16* proj;
  __device__ __forceinline__ void operator()(int r, int c, f32x4 v) const {
    if (c < INC) {
#pragma unroll
      for (int j = 0; j < 4; ++j) proj[(size_t)(r + j) * INC + c] = f2bf(v[j]);
    }
  }
};
struct EpiGlu {
  const u16* y1; const float* bglu; u16* a2;
  __device__ __forceinline__ void operator()(int r, int c, f32x4 v) const {
    float bb = bglu[c];
#pragma unroll
    for (int j = 0; j < 4; ++j) {
      float y = bf2f(y1[(size_t)(r + j) * 512 + c]);
      a2[(size_t)(r + j) * 1024 + c] = f2bf(y * sigmoidf(v[j] + bb));
    }
  }
};
struct EpiGate {
  const u16* t1; u16* a2;
  __device__ __forceinline__ void operator()(int r, int c, f32x4 v) const {
#pragma unroll
    for (int j = 0; j < 4; ++j) {
      float t = bf2f(t1[(size_t)(r + j) * 512 + c]);
      a2[(size_t)(r + j) * 1024 + 512 + c] = f2bf(t * v[j]);
    }
  }
};
struct EpiWout {
  const float* x; const float* mod; float* h2;
  __device__ __forceinline__ void operator()(int r, int c, f32x4 v) const {
    float g1 = mod[(r >> 11) * 6144 + 2 * 1024 + c];
#pragma unroll
    for (int j = 0; j < 4; ++j) h2[(size_t)(r + j) * 1024 + c] = x[(size_t)(r + j) * 1024 + c] + g1 * v[j];
  }
};
struct EpiQ {
  u16* q;
  __device__ __forceinline__ void operator()(int r, int c, f32x4 v) const {
#pragma unroll
    for (int j = 0; j < 4; ++j) q[(size_t)(r + j) * 2048 + c] = f2bf(v[j]);
  }
};

__device__ __forceinline__ void ph_s5scan(const P& p, char* smem, int bid, int nb) {
  const int wid = tidx() >> 6, lane = tidx() & 63;
  float* U = (float*)(smem + wid * 8448);
  unsigned* H = (unsigned*)((char*)U + 4096);
  const int fr = lane & 15, fq = lane >> 4;
  for (int s = bid * 8 + wid; s < 2048; s += nb * 8) {
    const int g = s & 31, d = (s >> 5) & 1, b = s >> 6;
    const int ci = (d * 32 + g) * 64 + lane;
    const float abr = p.s5ab()[ci * 2], abi = p.s5ab()[ci * 2 + 1];
    float bbr[16], bbi[16];
#pragma unroll
    for (int q = 0; q < 4; ++q) {
      float4 t = *(const float4*)(p.s5bb() + (size_t)ci * 32 + q * 4);
      bbr[q * 4] = t.x; bbr[q * 4 + 1] = t.y; bbr[q * 4 + 2] = t.z; bbr[q * 4 + 3] = t.w;
      float4 t2 = *(const float4*)(p.s5bb() + (size_t)ci * 32 + 16 + q * 4);
      bbi[q * 4] = t2.x; bbi[q * 4 + 1] = t2.y; bbi[q * 4 + 2] = t2.z; bbi[q * 4 + 3] = t2.w;
    }
    bf16x8 cf[4];
#pragma unroll
    for (int kb = 0; kb < 4; ++kb)
      cf[kb] = *(const bf16x8*)(p.s5ct() + ((size_t)(d * 32 + g) * 16 + fr) * 128 + kb * 32 + fq * 8);
    const float dcoef = p.s5_d[g * 16 + fr];
    u16* ydst = d ? p.ys5b() : p.ys5f();
    float hr = 0.f, hi = 0.f;
    for (int seg = 0; seg < 2; ++seg) {
      const int L = seg ? 2048 : 256;
      const int rowbase = seg ? b * 2048 : NLAT + b * 256;
      for (int c0 = 0; c0 < L; c0 += 64) {
        {
          int pos = c0 + lane;
          int t = d ? (L - 1 - pos) : pos;
          const u16* src = p.proj() + (size_t)(rowbase + t) * INC + g * 16;
          uint4 v0 = *(const uint4*)src, v1 = *(const uint4*)(src + 8);
          float4* ud = (float4*)(U + lane * 16);
          ud[0] = make_float4(bflo(v0.x), bfhi(v0.x), bflo(v0.y), bfhi(v0.y));
          ud[1] = make_float4(bflo(v0.z), bfhi(v0.z), bflo(v0.w), bfhi(v0.w));
          ud[2] = make_float4(bflo(v1.x), bfhi(v1.x), bflo(v1.y), bfhi(v1.y));
          ud[3] = make_float4(bflo(v1.z), bfhi(v1.z), bflo(v1.w), bfhi(v1.w));
        }
        for (int sub = 0; sub < 4; ++sub) {
#pragma unroll 4
          for (int i = 0; i < 16; ++i) {
            const float4* up = (const float4*)(U + (sub * 16 + i) * 16);
            float4 u0 = up[0], u1 = up[1], u2 = up[2], u3 = up[3];
            float ur[16] = {u0.x, u0.y, u0.z, u0.w, u1.x, u1.y, u1.z, u1.w, u2.x, u2.y, u2.z, u2.w, u3.x, u3.y, u3.z, u3.w};
            float br0 = 0.f, br1 = 0.f, bi0 = 0.f, bi1 = 0.f;
#pragma unroll
            for (int h = 0; h < 16; h += 2) {
              br0 += bbr[h] * ur[h]; br1 += bbr[h + 1] * ur[h + 1];
              bi0 += bbi[h] * ur[h]; bi1 += bbi[h + 1] * ur[h + 1];
            }
            float nr = abr * hr - abi * hi + (br0 + br1);
            float ni = abr * hi + abi * hr + (bi0 + bi1);
            hr = nr; hi = ni;
            if (seg) H[i * 68 + lane] = pack2(hr, hi);
          }
          if (seg) {
            f32x4 acc = (f32x4){0.f, 0.f, 0.f, 0.f};
#pragma unroll
            for (int kb = 0; kb < 4; ++kb) {
              bf16x8 a = *(const bf16x8*)((const u16*)H + fr * 136 + kb * 32 + fq * 8);
              acc = __builtin_amdgcn_mfma_f32_16x16x32_bf16(a, cf[kb], acc, 0, 0, 0);
            }
#pragma unroll
            for (int j = 0; j < 4; ++j) {
              int pi = sub * 16 + fq * 4 + j;
              int pos = c0 + pi;
              int t = d ? (L - 1 - pos) : pos;
              float y = acc[j];
              if (d == 0) y += dcoef * U[pi * 16 + fr];
              ydst[(size_t)(b * 2048 + t) * 512 + g * 16 + fr] = f2bf(y);
            }
          }
        }
      }
    }
  }
}

#define S5_LD 168
__device__ __forceinline__ void ph_s5scan2(const P& p, char* smem, int bid, int nb) {
  const int wid = tidx() >> 6, lane = tidx() & 63;
  u16* H = (u16*)(smem + wid * (32 * S5_LD * 2));
  const int n = lane & 31, hh = lane >> 5, fr = lane & 15, fq = lane >> 4;
  for (int r = lane; r < 32; r += 64) {
    *(uint4*)(H + r * S5_LD + 144) = make_uint4(0u, 0u, 0u, 0u);
    *(uint4*)(H + r * S5_LD + 152) = make_uint4(0u, 0u, 0u, 0u);
    *(uint4*)(H + r * S5_LD + 160) = make_uint4(0u, 0u, 0u, 0u);
  }
  for (int s = bid * 8 + wid; s < 2048; s += nb * 8) {
    const int g = s & 31, d = (s >> 5) & 1, b = s >> 6;
    float ar[2][4], ai[2][4], a8r[2], a8i[2];
#pragma unroll
    for (int st = 0; st < 2; ++st) {
      const int ci = (d * 32 + g) * 64 + st * 32 + n;
      const float xr = p.s5ab()[ci * 2], xi = p.s5ab()[ci * 2 + 1];
      ar[st][0] = xr; ai[st][0] = xi;
#pragma unroll
      for (int k = 1; k < 4; ++k) {
        ar[st][k] = ar[st][k - 1] * xr - ai[st][k - 1] * xi;
        ai[st][k] = ar[st][k - 1] * xi + ai[st][k - 1] * xr;
      }
      a8r[st] = ar[st][3] * ar[st][3] - ai[st][3] * ai[st][3];
      a8i[st] = 2.f * ar[st][3] * ai[st][3];
    }
    bf16x8 bfr[4];
#pragma unroll
    for (int nt = 0; nt < 4; ++nt) {
      const int ci = (d * 32 + g) * 64 + (nt & 1) * 32 + n;
      const float4 t0 = *(const float4*)(p.s5bb() + (size_t)ci * 32 + (nt >> 1) * 16 + 8 * hh);
      const float4 t1 = *(const float4*)(p.s5bb() + (size_t)ci * 32 + (nt >> 1) * 16 + 8 * hh + 4);
      union { unsigned u[4]; bf16x8 v; } t;
      t.u[0] = pack2(t0.x, t0.y); t.u[1] = pack2(t0.z, t0.w); t.u[2] = pack2(t1.x, t1.y); t.u[3] = pack2(t1.z, t1.w);
      bfr[nt] = t.v;
    }
    bf16x8 cf[5];
#pragma unroll
    for (int kb = 0; kb < 4; ++kb)
      cf[kb] = *(const bf16x8*)(p.s5ct() + ((size_t)(d * 32 + g) * 16 + fr) * 128 + kb * 32 + fq * 8);
    {
      const float dv = (d == 0) ? p.s5_d[g * 16 + fr] : 0.f;
      union { u16 h[8]; bf16x8 v; } t;
#pragma unroll
      for (int j = 0; j < 8; ++j) t.h[j] = (8 * fq + j == fr) ? f2bf(dv) : (u16)0;
      cf[4] = t.v;
    }
    u16* ydst = d ? p.ys5b() : p.ys5f();
    float hcr[2] = {0.f, 0.f}, hci[2] = {0.f, 0.f};
    for (int seg = 0; seg < 2; ++seg) {
      const int L = seg ? 2048 : 256;
      const int rowbase = seg ? b * 2048 : NLAT + b * 256;
      uint4 anext;
      {
        const int pos = n;
        const int t = d ? (L - 1 - pos) : pos;
        anext = *(const uint4*)(p.proj() + (size_t)(rowbase + t) * INC + g * 16 + 8 * hh);
      }
      for (int c0 = 0; c0 < L; c0 += 32) {
        const uint4 acur = anext;
        if (c0 + 32 < L) {
          const int pos = c0 + 32 + n;
          const int t = d ? (L - 1 - pos) : pos;
          anext = *(const uint4*)(p.proj() + (size_t)(rowbase + t) * INC + g * 16 + 8 * hh);
        }
        union { uint4 q; bf16x8 v; } af;
        af.q = acur;
        f32x16 acc[4];
#pragma unroll
        for (int nt = 0; nt < 4; ++nt) {
          f32x16 z;
#pragma unroll
          for (int r = 0; r < 16; ++r) z[r] = 0.f;
          acc[nt] = __builtin_amdgcn_mfma_f32_32x32x16_bf16(af.v, bfr[nt], z, 0, 0, 0);
        }
#pragma unroll
        for (int st = 0; st < 2; ++st)
#pragma unroll
          for (int gg = 0; gg < 4; ++gg)
#pragma unroll
            for (int j = 1; j < 4; ++j) {
              const float pr = acc[st][4 * gg + j - 1], pi = acc[2 + st][4 * gg + j - 1];
              acc[st][4 * gg + j] += ar[st][0] * pr - ai[st][0] * pi;
              acc[2 + st][4 * gg + j] += ar[st][0] * pi + ai[st][0] * pr;
            }
        float sr[2][4], si[2][4];
        {
          float e0r[2][4], e0i[2][4], qpr[2][4], qpi[2][4], s1r[2][4], s1i[2][4];
#pragma unroll
          for (int st = 0; st < 2; ++st)
#pragma unroll
            for (int gg = 0; gg < 4; ++gg) {
              e0r[st][gg] = __shfl_xor(acc[st][4 * gg + 3], 32, 64);
              e0i[st][gg] = __shfl_xor(acc[2 + st][4 * gg + 3], 32, 64);
            }
#pragma unroll
          for (int st = 0; st < 2; ++st) {
            float qr = hcr[st], qi = hci[st];
#pragma unroll
            for (int gg = 0; gg < 4; ++gg) {
              const float er = acc[st][4 * gg + 3], ei = acc[2 + st][4 * gg + 3];
              qpr[st][gg] = qr; qpi[st][gg] = qi;
              s1r[st][gg] = ar[st][3] * qr - ai[st][3] * qi + e0r[st][gg];
              s1i[st][gg] = ar[st][3] * qi + ai[st][3] * qr + e0i[st][gg];
              const float nqr = ar[st][3] * s1r[st][gg] - ai[st][3] * s1i[st][gg] + er;
              const float nqi = ar[st][3] * s1i[st][gg] + ai[st][3] * s1r[st][gg] + ei;
              qr = nqr; qi = nqi;
            }
            hcr[st] = qr; hci[st] = qi;
          }
#pragma unroll
          for (int st = 0; st < 2; ++st)
#pragma unroll
            for (int gg = 0; gg < 4; ++gg) {
              const float s0r = __shfl_xor(qpr[st][gg], 32, 64), s0i = __shfl_xor(qpi[st][gg], 32, 64);
              sr[st][gg] = hh ? s1r[st][gg] : s0r;
              si[st][gg] = hh ? s1i[st][gg] : s0i;
            }
        }
        if (seg) {
#pragma unroll
          for (int st = 0; st < 2; ++st)
#pragma unroll
            for (int gg = 0; gg < 4; ++gg)
#pragma unroll
              for (int j = 0; j < 4; ++j) {
                const float hr_ = acc[st][4 * gg + j] + ar[st][j] * sr[st][gg] - ai[st][j] * si[st][gg];
                const float hi_ = acc[2 + st][4 * gg + j] + ar[st][j] * si[st][gg] + ai[st][j] * sr[st][gg];
                const int tok = 8 * gg + 4 * hh + j;
                *(unsigned*)(H + tok * S5_LD + 2 * (st * 32 + n)) = pack2(hr_, hi_);
              }
          *(uint4*)(H + n * S5_LD + 128 + 8 * hh) = acur;
#pragma unroll
          for (int mt = 0; mt < 2; ++mt) {
            f32x4 y = (f32x4){0.f, 0.f, 0.f, 0.f};
#pragma unroll
            for (int kb = 0; kb < 5; ++kb) {
              const bf16x8 a = *(const bf16x8*)(H + (16 * mt + fr) * S5_LD + kb * 32 + fq * 8);
              y = __builtin_amdgcn_mfma_f32_16x16x32_bf16(a, cf[kb], y, 0, 0, 0);
            }
#pragma unroll
            for (int j = 0; j < 4; ++j) {
              const int pos = c0 + 16 * mt + 4 * fq + j;
              const int t = d ? (L - 1 - pos) : pos;
              ydst[(size_t)(b * 2048 + t) * 512 + g * 16 + fr] = f2bf(y[j]);
            }
          }
        }
      }
    }
  }
}

__device__ __forceinline__ float4 mix_load4(const u16* __restrict__ proj, size_t row, int col, const size_t* nrow,
                                            const bool* nval, float4 mu) {
  uint2 cz = *(const uint2*)(proj + row * INC + col);
  float z[4] = {bflo(cz.x), bfhi(cz.x), bflo(cz.y), bfhi(cz.y)};
  float o[4];
  float m[4] = {mu.x, mu.y, mu.z, mu.w};
#pragma unroll
  for (int j = 0; j < 4; ++j) {
    float nbv = 0.f;
    if (nval[j]) {
      u16 t = proj[nrow[j] * INC + col + j];
      nbv = bf2f(t);
    }
    o[j] = z[j] + (nbv - z[j]) * m[j];
  }
  return make_float4(o[0], o[1], o[2], o[3]);
}
__device__ __forceinline__ void neighbours(bool isctx, size_t row, int t, size_t* nrow, bool* nval) {
  if (isctx) {
    nrow[0] = row - 1; nval[0] = t > 0;
    nrow[1] = row + 1; nval[1] = t < 255;
    nrow[2] = row - 1; nval[2] = t > 0;
    nrow[3] = row + 1; nval[3] = t < 255;
  } else {
    int col = t & 63, gr = t >> 6;
    nrow[0] = row - 1; nval[0] = col > 0;
    nrow[1] = row + 1; nval[1] = col < 63;
    nrow[2] = row - 64; nval[2] = gr > 0;
    nrow[3] = row + 64; nval[3] = gr < 31;
  }
}

__device__ __forceinline__ void ph_rwscan(const P& p, char* smem, int bid, int nb) {
  const int tid = tidx(), sl = tid >> 8, stid = tid & 255, wv = stid >> 6, lane = tid & 63;
  char* sb = smem + sl * 49152;
  float* OPS = (float*)sb;
  float* LW = (float*)(sb + 24576);
  float* LA = LW + 512;
  float* WW = (float*)(sb + 28672);
  float* WA = WW + 2048;
  float* YB = (float*)(sb + 45056);
  const int tt = stid >> 4, part = stid & 15;
  const int vrow = wv * 16 + (lane >> 2), kq = lane & 3;
  for (int sp = bid; sp < 256; sp += nb) {
    const int s = sp * 2 + sl;
    const int d = s & 1, h = (s >> 1) & 7, b = s >> 4;
    __syncthreads();
    for (int e = stid; e < 2048; e += 256) {
      int j = e >> 6, cc = e & 63;
      WW[e] = p.rw_w_w2[(size_t)(d * 32 + j) * 512 + h * 64 + cc];
      WA[e] = p.rw_w_a2[(size_t)(d * 32 + j) * 512 + h * 64 + cc];
    }
    const int hc = h * 64 + part * 4;
    const float4 w0v = *(const float4*)(p.rw_w0 + d * 512 + hc);
    const float4 a0v = *(const float4*)(p.rw_a0 + d * 512 + hc);
    const float4 kkv = *(const float4*)(p.rw_k_k + hc);
    const float4 kav = *(const float4*)(p.rw_k_a + hc);
    const float4 rkv = *(const float4*)(p.rw_r_k + hc);
    const float4 mur = *(const float4*)(p.rw_mu + hc);
    const float4 muk = *(const float4*)(p.rw_mu + 512 + hc);
    const float4 muv = *(const float4*)(p.rw_mu + 1024 + hc);
    const float4 mul = *(const float4*)(p.rw_mu + 1536 + part * 4);
    u16* ydst = d ? p.yrwb() : p.yrwf();
    float S[16];
#pragma unroll
    for (int i = 0; i < 16; ++i) S[i] = 0.f;
    for (int seg = 0; seg < 2; ++seg) {
      const int L = seg ? 2048 : 256;
      const size_t rowbase = seg ? (size_t)b * 2048 : (size_t)NLAT + b * 256;
      for (int c0 = 0; c0 < L; c0 += 16) {
        const int pos = c0 + tt;
        const int t = d ? (L - 1 - pos) : pos;
        const size_t row = rowbase + t;
        size_t nrow[4];
        bool nval[4];
        neighbours(seg == 0, row, t, nrow, nval);
        float4 r4 = mix_load4(p.proj(), row, 512 + hc, nrow, nval, mur);
        float4 k4 = mix_load4(p.proj(), row, 512 + 512 + hc, nrow, nval, muk);
        float4 v4 = mix_load4(p.proj(), row, 512 + 1024 + hc, nrow, nval, muv);
        float4 l4 = mix_load4(p.proj(), row, 512 + 1536 + part * 4, nrow, nval, mul);
        if (part < 8) {
          *(float4*)(LW + tt * 32 + part * 4) = make_float4(tanhf(l4.x), tanhf(l4.y), tanhf(l4.z), tanhf(l4.w));
        } else {
          *(float4*)(LA + tt * 32 + (part - 8) * 4) = l4;
        }
        __syncthreads();
        float wp[4] = {w0v.x, w0v.y, w0v.z, w0v.w};
        float ap[4] = {a0v.x, a0v.y, a0v.z, a0v.w};
#pragma unroll 8
        for (int j = 0; j < 32; ++j) {
          float lw = LW[tt * 32 + j], la = LA[tt * 32 + j];
          float4 ww = *(const float4*)(WW + j * 64 + part * 4);
          float4 wa = *(const float4*)(WA + j * 64 + part * 4);
          wp[0] += lw * ww.x; wp[1] += lw * ww.y; wp[2] += lw * ww.z; wp[3] += lw * ww.w;
          ap[0] += la * wa.x; ap[1] += la * wa.y; ap[2] += la * wa.z; ap[3] += la * wa.w;
        }
        float rr[4] = {r4.x, r4.y, r4.z, r4.w}, kk4[4] = {k4.x, k4.y, k4.z, k4.w};
        float kkc[4] = {kkv.x, kkv.y, kkv.z, kkv.w}, kac[4] = {kav.x, kav.y, kav.z, kav.w}, rkc[4] = {rkv.x, rkv.y, rkv.z, rkv.w};
        float dec[4], aa[4], kd[4], kkr[4];
        float ss = 0.f, bon = 0.f;
#pragma unroll
        for (int i = 0; i < 4; ++i) {
          float xw = -wp[i];
          float sp_ = fmaxf(xw, 0.f) + log1pf(expf(-fabsf(xw)));
          float wl = -sp_ - 0.5f;
          dec[i] = expf(-expf(wl));
          aa[i] = 1.f / (1.f + expf(-ap[i]));
          kd[i] = kk4[i] * (1.f + (aa[i] - 1.f) * kac[i]);
          kkr[i] = kk4[i] * kkc[i];
          ss += kkr[i] * kkr[i];
          bon += rr[i] * kd[i] * rkc[i];
        }
#pragma unroll
        for (int m = 0; m < 4; ++m) {
          ss = dpp_add(ss, m, 0);
          bon = dpp_add(bon, m, 0);
        }
        float inv = rsqrtf(ss + 1e-12f);
        float* o = OPS + tt * 384 + part * 4;
        *(float4*)(o + 0) = r4;
        *(float4*)(o + 64) = make_float4(dec[0], dec[1], dec[2], dec[3]);
        *(float4*)(o + 128) = make_float4(kd[0], kd[1], kd[2], kd[3]);
        *(float4*)(o + 192) = make_float4(-kkr[0] * inv, -kkr[1] * inv, -kkr[2] * inv, -kkr[3] * inv);
        *(float4*)(o + 256) = make_float4(kkr[0] * inv * aa[0], kkr[1] * inv * aa[1], kkr[2] * inv * aa[2], kkr[3] * inv * aa[3]);
        *(float4*)(o + 320) = v4;
        if (seg && part == 0) p.bsc()[((size_t)d * NLAT + row) * 8 + h] = bon;
        __syncthreads();
        for (int i = 0; i < 16; ++i) {
          const float* oo = OPS + i * 384 + kq * 16;
          float kn[16], wv_[16], bv[16], kdv[16];
#pragma unroll
          for (int q = 0; q < 4; ++q) {
            float4 a = *(const float4*)(oo + 192 + q * 4);
            kn[q * 4] = a.x; kn[q * 4 + 1] = a.y; kn[q * 4 + 2] = a.z; kn[q * 4 + 3] = a.w;
            float4 w_ = *(const float4*)(oo + 64 + q * 4);
            wv_[q * 4] = w_.x; wv_[q * 4 + 1] = w_.y; wv_[q * 4 + 2] = w_.z; wv_[q * 4 + 3] = w_.w;
            float4 b_ = *(const float4*)(oo + 256 + q * 4);
            bv[q * 4] = b_.x; bv[q * 4 + 1] = b_.y; bv[q * 4 + 2] = b_.z; bv[q * 4 + 3] = b_.w;
            float4 k_ = *(const float4*)(oo + 128 + q * 4);
            kdv[q * 4] = k_.x; kdv[q * 4 + 1] = k_.y; kdv[q * 4 + 2] = k_.z; kdv[q * 4 + 3] = k_.w;
          }
          float vv = OPS[i * 384 + 320 + vrow];
          float s0 = 0.f, s1 = 0.f, s2 = 0.f, s3 = 0.f;
#pragma unroll
          for (int q = 0; q < 16; q += 4) {
            s0 += S[q] * kn[q]; s1 += S[q + 1] * kn[q + 1]; s2 += S[q + 2] * kn[q + 2]; s3 += S[q + 3] * kn[q + 3];
          }
          float sa = (s0 + s1) + (s2 + s3);
          sa = dpp_add(sa, 0, 0);
          sa = dpp_add(sa, 1, 0);
#pragma unroll
          for (int q = 0; q < 16; ++q) S[q] = S[q] * wv_[q] + sa * bv[q] + vv * kdv[q];
          if (seg) {
            float rv[16];
#pragma unroll
            for (int q = 0; q < 4; ++q) {
              float4 a = *(const float4*)(oo + q * 4);
              rv[q * 4] = a.x; rv[q * 4 + 1] = a.y; rv[q * 4 + 2] = a.z; rv[q * 4 + 3] = a.w;
            }
            float y0 = 0.f, y1 = 0.f, y2 = 0.f, y3 = 0.f;
#pragma unroll
            for (int q = 0; q < 16; q += 4) {
              y0 += S[q] * rv[q]; y1 += S[q + 1] * rv[q + 1]; y2 += S[q + 2] * rv[q + 2]; y3 += S[q + 3] * rv[q + 3];
            }
            float y = (y0 + y1) + (y2 + y3);
            y = dpp_add(y, 0, 0);
            y = dpp_add(y, 1, 0);
            if (kq == 0) YB[i * 64 + vrow] = y;
          }
        }
        __syncthreads();
        if (seg) {
          float4 yv = *(const float4*)(YB + tt * 64 + part * 4);
          uint2 o2;
          o2.x = pack2(yv.x, yv.y); o2.y = pack2(yv.z, yv.w);
          *(uint2*)(ydst + row * 512 + hc) = o2;
        }
      }
    }
  }
}

#define LAS __attribute__((address_space(3)))
#define RW_AR_LD 68
#define RW_RM_LD 72
#define RW_SLOT_BYTES 13824
#define RW_SCR_BYTES 6912
#define RW_STREAM_BYTES (4 * RW_SLOT_BYTES + 3 * RW_SCR_BYTES + 2304 + 64)
__device__ __forceinline__ unsigned cvtpk(float lo, float hi) { return pack2(lo, hi); }
__device__ __forceinline__ float dpp_shr_add(float v, const int n) {
  int m;
  switch (n) {
    case 1: m = __builtin_amdgcn_update_dpp(0, __float_as_int(v), 0x111, 0xf, 0xf, true); break;
    case 2: m = __builtin_amdgcn_update_dpp(0, __float_as_int(v), 0x112, 0xf, 0xf, true); break;
    case 4: m = __builtin_amdgcn_update_dpp(0, __float_as_int(v), 0x114, 0xf, 0xf, true); break;
    default: m = __builtin_amdgcn_update_dpp(0, __float_as_int(v), 0x118, 0xf, 0xf, true); break;
  }
  return v + __int_as_float(m);
}
__device__ __forceinline__ unsigned dpp_row_shr1(unsigned old, unsigned v) { return (unsigned)__builtin_amdgcn_update_dpp((int)old, (int)v, 0x111, 0xf, 0xf, false); }
__device__ __forceinline__ unsigned dpp_row_shl1(unsigned old, unsigned v) { return (unsigned)__builtin_amdgcn_update_dpp((int)old, (int)v, 0x101, 0xf, 0xf, false); }
__device__ __forceinline__ void shift_src(unsigned c01, unsigned be01, unsigned up23, unsigned dn23, unsigned m01, unsigned& n01, unsigned& n23) {
  const unsigned S = dpp_row_shr1(be01, c01), H = dpp_row_shl1(be01, c01);
  n01 = (S & m01) | (H & ~m01);
  n23 = (up23 & 0xffffu) | (dn23 & 0xffff0000u);
}
__device__ __forceinline__ int opaque(int x) { asm volatile("" : "+v"(x)); return x; }
__device__ __forceinline__ float fsig(float x) { return __builtin_amdgcn_rcpf(1.f + __expf(-x)); }

__device__ __forceinline__ void ph_rwscan2(const P& p, char* smem, int bid, int nb) {
  const int tid = tidx(), wid = tid >> 6, lane = tid & 63, sl = wid >> 2, wv = wid & 3;
  char* sb = smem + sl * RW_STREAM_BYTES;
  float* CST = (float*)(sb + 4 * RW_SLOT_BYTES + 3 * RW_SCR_BYTES);
  volatile LAS int* FL = (volatile LAS int*)(sb + 4 * RW_SLOT_BYTES + 3 * RW_SCR_BYTES + 2304);
  const int NCH = 144;
  for (int sp = bid; sp < 256; sp += nb) {
    const int s = sp * 2 + sl;
    const int d = s & 1, h = (s >> 1) & 7, b = s >> 4;
    __syncthreads();
    if (wv == 0) {
      const int cc = lane;
      CST[0 * 64 + cc] = p.rw_w0[d * 512 + h * 64 + cc];
      CST[1 * 64 + cc] = p.rw_a0[d * 512 + h * 64 + cc];
      CST[2 * 64 + cc] = p.rw_k_k[h * 64 + cc];
      CST[3 * 64 + cc] = p.rw_k_a[h * 64 + cc];
      CST[4 * 64 + cc] = p.rw_r_k[h * 64 + cc];
      CST[5 * 64 + cc] = p.rw_mu[h * 64 + cc];
      CST[6 * 64 + cc] = p.rw_mu[512 + h * 64 + cc];
      CST[7 * 64 + cc] = p.rw_mu[1024 + h * 64 + cc];
      CST[8 * 64 + cc] = p.rw_mu[1536 + cc];
      if (lane < 4) FL[lane] = 0;
    }
    __syncthreads();
    if (wv == 0) {
      const int v32 = lane & 31, hh = lane >> 5;
      u16* ydst = d ? p.yrwb() : p.yrwf();
      f32x16 X[2][2];
#pragma unroll
      for (int mt = 0; mt < 2; ++mt)
#pragma unroll
        for (int vt = 0; vt < 2; ++vt)
#pragma unroll
          for (int r = 0; r < 16; ++r) X[mt][vt][r] = 0.f;
      int c3 = 0, need = 1;
      for (int c = 0; c < NCH; ++c) {
        {
          while (FL[c3] < need) __builtin_amdgcn_s_sleep(1);
          asm volatile("" ::: "memory");
          const char* slot = sb + (c & 3) * RW_SLOT_BYTES;
          const u16* AR = (const u16*)slot;
          const u16* MG = (const u16*)(slot + 4352);
          const u16* BT = (const u16*)(slot + 5376);
          const u16* KT = (const u16*)(slot + 7424);
          const u16* VT = (const u16*)(slot + 9472);
          const float* WC = (const float*)(slot + 11520);
          {
            const float* Arb = (const float*)(slot + 11776);
            const float* Ark = Arb + 256;
            u16* ARw = (u16*)slot;
            u16* MGw = (u16*)(slot + 4352);
            const int ol = opaque(lane), oj = opaque(lane & 15);
            v2f am[16];
#pragma unroll
            for (int tt = 0; tt < 16; ++tt) {
              const int m0 = 8 * (tt >> 2) + (tt & 3);
              am[tt] = (v2f){bf2f(ARw[ol + m0 * RW_AR_LD]), bf2f(MGw[oj + m0 * 16])};
            }
#pragma unroll
            for (int tt = 0; tt < 16; ++tt) {
              const int m0 = 8 * (tt >> 2) + (tt & 3);
              v2f acc = (v2f){bf2f(ARw[ol + (m0 + 4) * RW_AR_LD]), Ark[oj + tt * 16]};
#pragma unroll
              for (int i4 = 0; i4 < (tt + 4) / 4; ++i4) {
                const float4 s4 = *(const float4*)(Arb + tt * 16 + 4 * i4);
                const float sv[4] = {s4.x, s4.y, s4.z, s4.w};
#pragma unroll
                for (int q = 0; q < 4; ++q) {
                  const int i = 4 * i4 + q;
                  if (i <= tt) acc += sv[q] * am[i];
                }
              }
              ARw[ol + (m0 + 4) * RW_AR_LD] = f2bf(acc[0]);
              if (lane < 16) MGw[oj + (m0 + 4) * 16] = f2bf(acc[1]);
            }
          }
          bf16x8 vtf[2];
#pragma unroll
          for (int vt = 0; vt < 2; ++vt) vtf[vt] = *(const bf16x8*)(VT + (32 * vt + v32) * 16 + 8 * hh);
          f32x16 UY[2];
#pragma unroll
          for (int vt = 0; vt < 2; ++vt)
#pragma unroll
            for (int r = 0; r < 16; ++r) UY[vt][r] = 0.f;
          {
            const bf16x8 mgf = *(const bf16x8*)(MG + v32 * 16 + 8 * hh);
#pragma unroll
            for (int vt = 0; vt < 2; ++vt) UY[vt] = __builtin_amdgcn_mfma_f32_32x32x16_bf16(mgf, vtf[vt], UY[vt], 0, 0, 0);
          }
#pragma unroll
          for (int mt = 0; mt < 2; ++mt)
#pragma unroll
            for (int ks = 0; ks < 2; ++ks) {
              const int base = 32 * mt + 16 * ks + 4 * hh;
              const uint2 a0 = *(const uint2*)(AR + v32 * RW_AR_LD + base);
              const uint2 a1 = *(const uint2*)(AR + v32 * RW_AR_LD + base + 8);
              union { unsigned u[4]; bf16x8 v; } af;
              af.u[0] = a0.x; af.u[1] = a0.y; af.u[2] = a1.x; af.u[3] = a1.y;
#pragma unroll
              for (int vt = 0; vt < 2; ++vt) {
                union { unsigned u[4]; bf16x8 v; } xf;
#pragma unroll
                for (int q = 0; q < 4; ++q) xf.u[q] = cvtpk(X[mt][vt][8 * ks + 2 * q], X[mt][vt][8 * ks + 2 * q + 1]);
                UY[vt] = __builtin_amdgcn_mfma_f32_32x32x16_bf16(af.v, xf.v, UY[vt], 0, 0, 0);
              }
            }
          if (c >= 16 && hh == 1) {
#pragma unroll
            for (int r = 0; r < 16; ++r) {
              const int pos = (c - 16) * 16 + r;
              const int tok = d ? (2047 - pos) : pos;
              u16* yp = ydst + ((size_t)b * 2048 + tok) * 512 + h * 64 + v32;
              yp[0] = f2bf(UY[0][r]);
              yp[32] = f2bf(UY[1][r]);
            }
          }
          bf16x8 uyf[2][2];
#pragma unroll
          for (int vt = 0; vt < 2; ++vt)
#pragma unroll
            for (int ks = 0; ks < 2; ++ks) {
              union { unsigned u[4]; bf16x8 v; } t_;
#pragma unroll
              for (int q = 0; q < 4; ++q) t_.u[q] = cvtpk(UY[vt][8 * ks + 2 * q], UY[vt][8 * ks + 2 * q + 1]);
              uyf[vt][ks] = t_.v;
            }
#pragma unroll
          for (int mt = 0; mt < 2; ++mt) {
            const int krow = 32 * mt + v32;
            const bf16x8 ktf = *(const bf16x8*)(KT + krow * 16 + 8 * hh);
            bf16x8 btf[2];
#pragma unroll
            for (int ks = 0; ks < 2; ++ks) {
              btf[ks] = *(const bf16x8*)(BT + krow * 16 + 8 * ks);
              if (hh) btf[ks] = (bf16x8){0, 0, 0, 0, 0, 0, 0, 0};
            }
#pragma unroll
            for (int vt = 0; vt < 2; ++vt) {
              X[mt][vt] = __builtin_amdgcn_mfma_f32_32x32x16_bf16(ktf, vtf[vt], X[mt][vt], 0, 0, 0);
#pragma unroll
              for (int ks = 0; ks < 2; ++ks) X[mt][vt] = __builtin_amdgcn_mfma_f32_32x32x16_bf16(btf[ks], uyf[vt][ks], X[mt][vt], 0, 0, 0);
            }
#pragma unroll
            for (int g = 0; g < 4; ++g) {
              const float4 w4 = *(const float4*)(WC + 32 * mt + 8 * g + 4 * hh);
#pragma unroll
              for (int vt = 0; vt < 2; ++vt) {
                X[mt][vt][4 * g + 0] *= w4.x; X[mt][vt][4 * g + 1] *= w4.y;
                X[mt][vt][4 * g + 2] *= w4.z; X[mt][vt][4 * g + 3] *= w4.w;
              }
            }
          }
        }
        asm volatile("s_waitcnt lgkmcnt(0)" ::: "memory");
        if (lane == 0) FL[3] = c + 1;
        if (++c3 == 3) { c3 = 0; ++need; }
      }
    } else {
      const int pw = wv - 1;
      const int t = lane & 15, kq = lane >> 4;
      char* scr = sb + 4 * RW_SLOT_BYTES + pw * RW_SCR_BYTES;
      u16* AL = (u16*)scr;
      u16* BE = AL + 16 * RW_RM_LD;
      u16* KA = BE + 16 * RW_RM_LD;
      float* AAs = (float*)BE;
      const int o_kq16 = opaque(16 * kq);
      const int o_tr = opaque(256 * kq + t);
      const int o_rm = opaque(t * RW_RM_LD + 16 * kq);
      const int o_ar = opaque((8 * (t >> 2) + (t & 3) + 4) * RW_AR_LD + 16 * kq);
      const int o_l = opaque(lane);
      const int o_j = opaque(lane & 15);
      const float* cstl = CST + o_kq16;
      const float* cstw = CST + 8 * 64 + opaque(8 * kq);
      const unsigned m01 = d ? 0xffff0000u : 0x0000ffffu;
      bf16x8 wwf[4], waf[4];
      {
        const int o_wl = (((d * 8 + h) * 4) * 64 + lane) * 8;
#pragma unroll
        for (int mt = 0; mt < 4; ++mt) {
          wwf[mt] = *(const bf16x8*)(p.wlf() + o_wl + mt * 512);
          waf[mt] = *(const bf16x8*)(p.wlf() + o_wl + 32768 + mt * 512);
        }
      }
      int ndone = 0;
      for (int c = pw; c < NCH; c += 3) {
        while (FL[3] < c - 3) __builtin_amdgcn_s_sleep(1);
        asm volatile("" ::: "memory");
        char* slot = sb + (c & 3) * RW_SLOT_BYTES;
        u16* AR = (u16*)slot;
        u16* MG = (u16*)(slot + 4352);
        u16* BT = (u16*)(slot + 5376);
        u16* KT = (u16*)(slot + 7424);
        u16* VT = (u16*)(slot + 9472);
        float* WC = (float*)(slot + 11520);
        const bool lat = c >= 16;
        const int L = lat ? 2048 : 256;
        const int pos = (lat ? (c - 16) : c) * 16 + t;
        const int tok = d ? (L - 1 - pos) : pos;
        const size_t row = (lat ? (size_t)b * 2048 : (size_t)NLAT + (size_t)b * 256) + tok;
        const u16* cbase = p.proj() + row * INC + 512;
        const u16 *ubase, *dbase, *ebase;
        float nmask[4];
        {
          size_t nrow[4];
          bool nval[4];
          neighbours(!lat, row, tok, nrow, nval);
#pragma unroll
          for (int j = 0; j < 4; ++j) nmask[j] = nval[j] ? 1.f : 0.f;
          ubase = p.proj() + (nval[2] ? nrow[2] : row) * INC + 512;
          dbase = p.proj() + (nval[3] ? nrow[3] : row) * INC + 512;
          const bool useup = (t == 0) != (d != 0);
          const size_t erow = useup ? (nval[0] ? nrow[0] : row) : (nval[1] ? nrow[1] : row);
          ebase = p.proj() + erow * INC + 512;
        }
        const int cl = 1536 + 8 * kq, cx = h * 64 + 16 * kq;
        u32x4 Cl[2], Ul[2], Dl[2], El[2];
        u32x4 Cx[3][2], Ux[3][2], Dx[3][2], Ex[3][2];
#pragma unroll
        for (int a = 0; a < 2; ++a) {
          Cl[a] = *(const u32x4*)(cbase + cl + 32 * a);
          Ul[a] = *(const u32x4*)(ubase + cl + 32 * a);
          Dl[a] = *(const u32x4*)(dbase + cl + 32 * a);
          El[a] = (u32x4){0u, 0u, 0u, 0u};
        }
#pragma unroll
        for (int a = 0; a < 3; ++a)
#pragma unroll
          for (int hf = 0; hf < 2; ++hf) {
            Cx[a][hf] = *(const u32x4*)(cbase + cx + 512 * a + 8 * hf);
            Ux[a][hf] = *(const u32x4*)(ubase + cx + 512 * a + 8 * hf);
            Dx[a][hf] = *(const u32x4*)(dbase + cx + 512 * a + 8 * hf);
            Ex[a][hf] = (u32x4){0u, 0u, 0u, 0u};
          }
        if (t == 0 || t == 15) {
#pragma unroll
          for (int a = 0; a < 2; ++a) El[a] = *(const u32x4*)(ebase + cl + 32 * a);
#pragma unroll
          for (int a = 0; a < 3; ++a)
#pragma unroll
            for (int hf = 0; hf < 2; ++hf) Ex[a][hf] = *(const u32x4*)(ebase + cx + 512 * a + 8 * hf);
        }
        bf16x8 lwf, laf;
        {
          float lw[8], la[8];
          const float4 ml0 = *(const float4*)(cstw), ml1 = *(const float4*)(cstw + 4);
          const float4 ma0 = *(const float4*)(cstw + 32), ma1 = *(const float4*)(cstw + 32 + 4);
          const float mul_[8] = {ml0.x, ml0.y, ml0.z, ml0.w, ml1.x, ml1.y, ml1.z, ml1.w};
          const float mua_[8] = {ma0.x, ma0.y, ma0.z, ma0.w, ma1.x, ma1.y, ma1.z, ma1.w};
#pragma unroll
          for (int g = 0; g < 2; ++g) {
            unsigned nw01, nw23, na01, na23;
            shift_src(Cl[0][2 * g], El[0][2 * g], Ul[0][2 * g + 1], Dl[0][2 * g + 1], m01, nw01, nw23);
            shift_src(Cl[1][2 * g], El[1][2 * g], Ul[1][2 * g + 1], Dl[1][2 * g + 1], m01, na01, na23);
            const float zw[4] = {bflo(Cl[0][2 * g]), bfhi(Cl[0][2 * g]), bflo(Cl[0][2 * g + 1]), bfhi(Cl[0][2 * g + 1])};
            const float za[4] = {bflo(Cl[1][2 * g]), bfhi(Cl[1][2 * g]), bflo(Cl[1][2 * g + 1]), bfhi(Cl[1][2 * g + 1])};
            const float nw[4] = {bflo(nw01), bfhi(nw01), bflo(nw23), bfhi(nw23)};
            const float na[4] = {bflo(na01), bfhi(na01), bflo(na23), bfhi(na23)};
#pragma unroll
            for (int j = 0; j < 4; ++j) {
              const int q = 4 * g + j;
              lw[q] = 1.f - 2.f * __builtin_amdgcn_rcpf(1.f + __expf(2.f * (zw[j] + (nw[j] * nmask[j] - zw[j]) * mul_[q])));
              la[q] = za[j] + (na[j] * nmask[j] - za[j]) * mua_[q];
            }
          }
          union { unsigned u[4]; bf16x8 v; } tw, ta;
#pragma unroll
          for (int q = 0; q < 4; ++q) { tw.u[q] = pack2(lw[2 * q], lw[2 * q + 1]); ta.u[q] = pack2(la[2 * q], la[2 * q + 1]); }
          lwf = tw.v; laf = ta.v;
        }
        float ee[16];
        unsigned rrp[8], aap[8], kxp[8];
        {
#pragma unroll
          for (int mt = 0; mt < 4; ++mt) {
            const float4 mr = *(const float4*)(cstl + 5 * 64 + 4 * mt), mk = *(const float4*)(cstl + 6 * 64 + 4 * mt), mv = *(const float4*)(cstl + 7 * 64 + 4 * mt);
            const float mrv[4] = {mr.x, mr.y, mr.z, mr.w}, mkv[4] = {mk.x, mk.y, mk.z, mk.w}, mvv[4] = {mv.x, mv.y, mv.z, mv.w};
            const int hf = mt >> 1, r0 = 2 * (mt & 1);
            float mix[3][4];
#pragma unroll
            for (int a = 0; a < 3; ++a) {
              unsigned n01, n23;
              shift_src(Cx[a][hf][r0], Ex[a][hf][r0], Ux[a][hf][r0 + 1], Dx[a][hf][r0 + 1], m01, n01, n23);
              const float z[4] = {bflo(Cx[a][hf][r0]), bfhi(Cx[a][hf][r0]), bflo(Cx[a][hf][r0 + 1]), bfhi(Cx[a][hf][r0 + 1])};
              const float n[4] = {bflo(n01), bfhi(n01), bflo(n23), bfhi(n23)};
              const float* mm = a == 0 ? mrv : (a == 1 ? mkv : mvv);
#pragma unroll
              for (int j = 0; j < 4; ++j) mix[a][j] = z[j] + (n[j] * nmask[j] - z[j]) * mm[j];
            }
#pragma unroll
            for (int j = 0; j < 4; ++j) VT[o_tr + (4 * mt + j) * 16] = f2bf(mix[2][j]);
            const f32x4 z4 = (f32x4){0.f, 0.f, 0.f, 0.f};
            const f32x4 aw = __builtin_amdgcn_mfma_f32_16x16x32_bf16(wwf[mt], lwf, z4, 0, 0, 0);
            const f32x4 a2 = __builtin_amdgcn_mfma_f32_16x16x32_bf16(waf[mt], laf, z4, 0, 0, 0);
            const float4 w0 = *(const float4*)(cstl + 0 * 64 + 4 * mt), a0 = *(const float4*)(cstl + 1 * 64 + 4 * mt);
            ee[4 * mt] = 0.60653066f * fsig(w0.x + aw[0]); ee[4 * mt + 1] = 0.60653066f * fsig(w0.y + aw[1]);
            ee[4 * mt + 2] = 0.60653066f * fsig(w0.z + aw[2]); ee[4 * mt + 3] = 0.60653066f * fsig(w0.w + aw[3]);
            float aav[4];
            aav[0] = fsig(a0.x + a2[0]); aav[1] = fsig(a0.y + a2[1]);
            aav[2] = fsig(a0.z + a2[2]); aav[3] = fsig(a0.w + a2[3]);
            rrp[2 * mt] = pack2(mix[0][0], mix[0][1]); rrp[2 * mt + 1] = pack2(mix[0][2], mix[0][3]);
            aap[2 * mt] = pack2(aav[0], aav[1]); aap[2 * mt + 1] = pack2(aav[2], aav[3]);
            kxp[2 * mt] = pack2(mix[1][0], mix[1][1]); kxp[2 * mt + 1] = pack2(mix[1][2], mix[1][3]);
          }
        }
        float kdf[16], kkf[16];
        float inv;
        {
          float ss = 0.f, bon = 0.f;
#pragma unroll
          for (int mt = 0; mt < 4; ++mt) {
            const float4 c2 = *(const float4*)(cstl + 2 * 64 + 4 * mt), c3 = *(const float4*)(cstl + 3 * 64 + 4 * mt), c4 = *(const float4*)(cstl + 4 * 64 + 4 * mt);
            const float kkc[4] = {c2.x, c2.y, c2.z, c2.w}, kac[4] = {c3.x, c3.y, c3.z, c3.w}, rkc[4] = {c4.x, c4.y, c4.z, c4.w};
#pragma unroll
            for (int j = 0; j < 4; ++j) {
              const int e = 4 * mt + j;
              const float kx = (e & 1) ? bfhi(kxp[e >> 1]) : bflo(kxp[e >> 1]);
              const float av = (e & 1) ? bfhi(aap[e >> 1]) : bflo(aap[e >> 1]);
              const float rv = (e & 1) ? bfhi(rrp[e >> 1]) : bflo(rrp[e >> 1]);
              kdf[e] = kx * (1.f + (av - 1.f) * kac[j]);
              kkf[e] = kx * kkc[j];
              ss += kkf[e] * kkf[e];
              bon += rv * kdf[e] * rkc[j];
            }
          }
          ss += __shfl_xor(ss, 16, 64); ss += __shfl_xor(ss, 32, 64);
          bon += __shfl_xor(bon, 16, 64); bon += __shfl_xor(bon, 32, 64);
          inv = rsqrtf(ss + 1e-12f);
          if (lat && kq == 0) p.bsc()[((size_t)d * NLAT + row) * 8 + h] = bon;
        }
#pragma unroll
        for (int mt = 0; mt < 4; ++mt) {
          float al4[4], rh4[4], be4[4], ka4[4];
#pragma unroll
          for (int j = 0; j < 4; ++j) {
            const int e = 4 * mt + j;
            float cs = ee[e];
            cs = dpp_shr_add(cs, 1); cs = dpp_shr_add(cs, 2); cs = dpp_shr_add(cs, 4); cs = dpp_shr_add(cs, 8);
            const float Ep = __expf(cs), Em = __builtin_amdgcn_rcpf(Ep), Ex = __expf(ee[e] - cs);
            const float kkn = kkf[e] * inv;
            al4[j] = -kkn * Ex;
            be4[j] = kkn * ((e & 1) ? bfhi(aap[e >> 1]) : bflo(aap[e >> 1])) * Ep;
            ka4[j] = kdf[e] * Ep;
            rh4[j] = ((e & 1) ? bfhi(rrp[e >> 1]) : bflo(rrp[e >> 1])) * Em;
            BT[o_tr + (4 * mt + j) * 16] = f2bf(be4[j]);
            KT[o_tr + (4 * mt + j) * 16] = f2bf(ka4[j]);
            if (t == 15) WC[o_kq16 + 4 * mt + j] = Em;
          }
          const int ko = o_rm + 4 * mt;
          *(uint2*)(AL + ko) = make_uint2(pack2(al4[0], al4[1]), pack2(al4[2], al4[3]));
          *(uint2*)(AR + o_ar + 4 * mt) = make_uint2(pack2(rh4[0], rh4[1]), pack2(rh4[2], rh4[3]));
          *(uint2*)(BE + ko) = make_uint2(pack2(be4[0], be4[1]), pack2(be4[2], be4[3]));
          *(uint2*)(KA + ko) = make_uint2(pack2(ka4[0], ka4[1]), pack2(ka4[2], ka4[3]));
        }
        {
          const int m = lane & 31, hh = lane >> 5;
          const int typ = (m >> 2) & 1, tt = 4 * (m >> 3) + (m & 3);
          const u16* arow = (typ ? AR + m * RW_AR_LD : AL + tt * RW_RM_LD) + 8 * hh;
          const u16* brow = ((m >> 4) ? KA : BE) + (m & 15) * RW_RM_LD + 8 * hh;
          f32x16 aa;
#pragma unroll
          for (int r = 0; r < 16; ++r) aa[r] = 0.f;
#pragma unroll
          for (int ks = 0; ks < 4; ++ks) {
            const uint2 a0 = *(const uint2*)(arow + 16 * ks), a1 = *(const uint2*)(arow + 16 * ks + 4);
            union { unsigned u[4]; bf16x8 v; } af;
            af.u[0] = a0.x; af.u[1] = a0.y; af.u[2] = a1.x; af.u[3] = a1.y;
            const bf16x8 bf_ = *(const bf16x8*)(brow + 16 * ks);
            aa = __builtin_amdgcn_mfma_f32_32x32x16_bf16(af.v, bf_, aa, 0, 0, 0);
          }
          const int i = m & 15;
          float* aad = (hh ? (float*)(slot + 11776) : AAs) + opaque((m >> 4) * 256 + i);
#pragma unroll
          for (int r = 0; r < 16; ++r) {
            const bool keep = hh ? (i <= r) : (i < r);
            aad[r * 16] = keep ? aa[r] : 0.f;
          }
        }
        asm volatile("" ::: "memory");
        {
          const float* Aab = AAs;
          const float* Aak = AAs + 256;
          v2f am[16];
#pragma unroll
          for (int tt = 0; tt < 16; ++tt) {
            v2f acc = (v2f){bf2f(AL[o_l + tt * RW_RM_LD]), Aak[o_j + tt * 16]};
#pragma unroll
            for (int i4 = 0; i4 < (tt + 3) / 4; ++i4) {
              const float4 s4 = *(const float4*)(Aab + tt * 16 + 4 * i4);
              const float sv[4] = {s4.x, s4.y, s4.z, s4.w};
#pragma unroll
              for (int q = 0; q < 4; ++q) {
                const int i = 4 * i4 + q;
                if (i < tt) acc += sv[q] * am[i];
              }
            }
            am[tt] = acc;
          }
#pragma unroll
          for (int tt = 0; tt < 16; ++tt) {
            const int m0 = 8 * (tt >> 2) + (tt & 3);
            AR[o_l + m0 * RW_AR_LD] = f2bf(am[tt][0]);
            if (lane < 16) MG[o_j + m0 * 16] = f2bf(am[tt][1]);
          }
        }
        asm volatile("s_waitcnt lgkmcnt(0)" ::: "memory");
        ++ndone;
        if (lane == 0) FL[pw] = ndone;
      }
    }
  }
}

struct MixLd {
  uint4 s5f, s5b, rwf, rwb, vc, gc;
  u16 vn[8], gn[8];
  float bs0, bs1;
};
__device__ __forceinline__ void mix_load(const P& p, int row, int lane, MixLd& L, float (&nmask)[4]) {
  const int c8 = lane * 8, t = row & 2047;
  L.s5f = *(const uint4*)(p.ys5f() + (size_t)row * 512 + c8);
  L.s5b = *(const uint4*)(p.ys5b() + (size_t)row * 512 + c8);
  L.rwf = *(const uint4*)(p.yrwf() + (size_t)row * 512 + c8);
  L.rwb = *(const uint4*)(p.yrwb() + (size_t)row * 512 + c8);
  size_t nrow[4];
  bool nval[4];
  neighbours(false, (size_t)row, t, nrow, nval);
  const u16* nb_[4];
#pragma unroll
  for (int j = 0; j < 4; ++j) { nb_[j] = p.proj() + (nval[j] ? nrow[j] : (size_t)row) * INC + 512 + j; nmask[j] = nval[j] ? 1.f : 0.f; }
  const u16* cb = p.proj() + (size_t)row * INC + 512;
  L.vc = *(const uint4*)(cb + 1024 + c8);
#pragma unroll
  for (int i = 0; i < 8; ++i) L.vn[i] = nb_[i & 3][1024 + c8 + (i & 4)];
  const int g8 = (lane < 12) ? c8 : 0;
  L.gc = *(const uint4*)(cb + 1600 + g8);
#pragma unroll
  for (int i = 0; i < 8; ++i) L.gn[i] = nb_[i & 3][1600 + g8 + (i & 4)];
  const int head = lane >> 3;
  L.bs0 = p.bsc()[(size_t)row * 8 + head];
  L.bs1 = p.bsc()[((size_t)NLAT + row) * 8 + head];
}
__device__ __forceinline__ void mix_compute(const P& p, int row, int lane, const MixLd& L, const float (&nmask)[4], u16* y1dst, u16* t1dst) {
  const int c8 = lane * 8;
  {
    const unsigned au[4] = {L.s5f.x, L.s5f.y, L.s5f.z, L.s5f.w}, bu[4] = {L.s5b.x, L.s5b.y, L.s5b.z, L.s5b.w};
    unsigned ou[4];
#pragma unroll
    for (int q = 0; q < 4; ++q) ou[q] = pack2(gelu_as(bflo(au[q]) + bflo(bu[q])), gelu_as(bfhi(au[q]) + bfhi(bu[q])));
    *(uint4*)(y1dst + (size_t)row * 512 + c8) = make_uint4(ou[0], ou[1], ou[2], ou[3]);
  }
  float y[8];
  {
    const unsigned au[4] = {L.rwf.x, L.rwf.y, L.rwf.z, L.rwf.w}, bu[4] = {L.rwb.x, L.rwb.y, L.rwb.z, L.rwb.w};
#pragma unroll
    for (int q = 0; q < 4; ++q) { y[2 * q] = bflo(au[q]) + bflo(bu[q]); y[2 * q + 1] = bfhi(au[q]) + bfhi(bu[q]); }
  }
  float sm = 0.f;
#pragma unroll
  for (int i = 0; i < 8; ++i) sm += y[i];
  sm = dpp_add(sm, 0, 0); sm = dpp_add(sm, 1, 0); sm = dpp_add(sm, 2, 0);
  const float mu = sm * (1.f / 64.f);
  float sv = 0.f;
#pragma unroll
  for (int i = 0; i < 8; ++i) sv += (y[i] - mu) * (y[i] - mu);
  sv = dpp_add(sv, 0, 0); sv = dpp_add(sv, 1, 0); sv = dpp_add(sv, 2, 0);
  const float rs = rsqrtf(sv * (1.f / 64.f) + 64e-5f);
  float v[8];
  {
    const unsigned cu[4] = {L.vc.x, L.vc.y, L.vc.z, L.vc.w};
    const float4 m0 = *(const float4*)(p.rw_mu + 1024 + c8), m1 = *(const float4*)(p.rw_mu + 1024 + c8 + 4);
    const float mm[8] = {m0.x, m0.y, m0.z, m0.w, m1.x, m1.y, m1.z, m1.w};
#pragma unroll
    for (int i = 0; i < 8; ++i) {
      const float z = (i & 1) ? bfhi(cu[i >> 1]) : bflo(cu[i >> 1]);
      const float nbv = bf2f(L.vn[i]) * nmask[i & 3];
      v[i] = z + (nbv - z) * mm[i];
    }
  }
  const float bs = L.bs0 + L.bs1;
  {
    const float4 w0 = *(const float4*)(p.rw_ln_w + c8), w1 = *(const float4*)(p.rw_ln_w + c8 + 4);
    const float4 b0 = *(const float4*)(p.rw_ln_b + c8), b1 = *(const float4*)(p.rw_ln_b + c8 + 4);
    const float lw[8] = {w0.x, w0.y, w0.z, w0.w, w1.x, w1.y, w1.z, w1.w};
    const float lb[8] = {b0.x, b0.y, b0.z, b0.w, b1.x, b1.y, b1.z, b1.w};
    float o[8];
#pragma unroll
    for (int i = 0; i < 8; ++i) o[i] = (y[i] - mu) * rs * lw[i] + lb[i] + bs * v[i];
    *(uint4*)(t1dst + (size_t)row * 512 + c8) = make_uint4(pack2(o[0], o[1]), pack2(o[2], o[3]), pack2(o[4], o[5]), pack2(o[6], o[7]));
  }
  if (lane < 32) {
    unsigned ou[4] = {0u, 0u, 0u, 0u};
    if (lane < 12) {
      const unsigned cu[4] = {L.gc.x, L.gc.y, L.gc.z, L.gc.w};
      const float4 m0 = *(const float4*)(p.rw_mu + 1600 + c8), m1 = *(const float4*)(p.rw_mu + 1600 + c8 + 4);
      const float mm[8] = {m0.x, m0.y, m0.z, m0.w, m1.x, m1.y, m1.z, m1.w};
      float gsig[8];
#pragma unroll
      for (int i = 0; i < 8; ++i) {
        const float z = (i & 1) ? bfhi(cu[i >> 1]) : bflo(cu[i >> 1]);
        const float nbv = bf2f(L.gn[i]) * nmask[i & 3];
        gsig[i] = fsig(z + (nbv - z) * mm[i]);
      }
#pragma unroll
      for (int q = 0; q < 4; ++q) ou[q] = pack2(gsig[2 * q], gsig[2 * q + 1]);
    }
    *(uint4*)(p.sg() + (size_t)row * 256 + c8) = make_uint4(ou[0], ou[1], ou[2], ou[3]);
  }
}
__device__ __forceinline__ void ph_mixprep(const P& p, int bid, int nb, u16* y1dst, u16* t1dst) {
  const int wid = tidx() >> 6, lane = tidx() & 63;
  const int stride = nb * 8;
  for (int row = bid * 8 + wid; row < NLAT; row += 2 * stride) {
    const int rowB = row + stride;
    const bool hasB = rowB < NLAT;
    MixLd LA, LB;
    float mA[4], mB[4];
    mix_load(p, row, lane, LA, mA);
    mix_load(p, hasB ? rowB : row, lane, LB, mB);
    mix_compute(p, row, lane, LA, mA, y1dst, t1dst);
    if (hasB) mix_compute(p, rowB, lane, LB, mB, y1dst, t1dst);
  }
}

__constant__ unsigned char CAND_I[52] = {0,0,0,0,0,0,0,0,0,0,0,0,0,0,0,0, 1,1,1,1,1,1,1,1, 2,2,2,2,2, 3,3,3,3, 4,4,4, 5,5, 6,6, 7,7, 8,9,10,11,12,13,14,15, 0,0};
__constant__ unsigned char CAND_J[52] = {0,1,2,3,4,5,6,7,8,9,10,11,12,13,14,15, 0,1,2,3,4,5,6,7, 0,1,2,3,4, 0,1,2,3, 0,1,2, 0,1, 0,1, 0,1, 0,0,0,0,0,0,0,0, 0,0};

#define SC_LD 144
#define KL_LD 136
__device__ __forceinline__ unsigned umax_quad(unsigned v) {
  unsigned o = (unsigned)__builtin_amdgcn_update_dpp(0, (int)v, 0xB1, 0xf, 0xf, true);
  v = v > o ? v : o;
  o = (unsigned)__builtin_amdgcn_update_dpp(0, (int)v, 0x4E, 0xf, 0xf, true);
  return v > o ? v : o;
}
__device__ __forceinline__ unsigned mono_key(float f) {
  unsigned u = __float_as_uint(f);
  return u ^ ((u >> 31) ? 0xFFFFFFFFu : 0x80000000u);
}
__device__ __forceinline__ float mono_inv(unsigned k) {
  unsigned u = (k >> 31) ? (k ^ 0x80000000u) : ~k;
  return __uint_as_float(u);
}
__device__ __forceinline__ unsigned umax3(unsigned a, unsigned b, unsigned c) {
  unsigned m = a > b ? a : b;
  return m > c ? m : c;
}
__device__ __forceinline__ void ph_route(const P& p, char* smem, int bid, int nb) {
  u16* KL = (u16*)smem;
  unsigned* SC = (unsigned*)(smem + 2 * 128 * KL_LD * 2);
  float* TS = (float*)(SC + 2 * 64 * SC_LD);
  int* TI = (int*)(TS + 2 * 64 * 16);
  const u16* Q = p.proj();
  const int tid = tidx(), wid = tid >> 6, lane = tid & 63, fr = lane & 15, fq = lane >> 4;
  int cur_h = -1;
  bf16x8 an[4];
  {
    const int h0 = bid & 7, r0 = (bid >> 3) * 64, c0 = wid >> 2, m0 = (wid & 3) * 16;
#pragma unroll
    for (int ks = 0; ks < 4; ++ks)
      an[ks] = *(const bf16x8*)(Q + (size_t)(r0 + m0 + fr) * 2048 + h0 * 256 + c0 * 128 + ks * 32 + fq * 8);
  }
  for (int item = bid; item < 1024 * 8; item += nb) {
    const int h = item & 7, row0 = (item >> 3) * 64;
    if (h != cur_h) {
      __syncthreads();
      for (int e = tid; e < 2 * 128 * 16; e += NTHREADS) {
        int r = e >> 4, kc = (e & 15) * 8;
        *(uint4*)(KL + r * KL_LD + kc) = *(const uint4*)(p.keys() + ((size_t)h * 256 + r) * 128 + kc);
      }
      cur_h = h;
      __syncthreads();
    }
    {
      const int c = wid >> 2, mrow = (wid & 3) * 16;
      f32x4 acc[8];
#pragma unroll
      for (int ni = 0; ni < 8; ++ni) acc[ni] = (f32x4){0.f, 0.f, 0.f, 0.f};
      bf16x8 a[4];
#pragma unroll
      for (int ks = 0; ks < 4; ++ks) a[ks] = an[ks];
      {
        const int nit = (item + nb < 1024 * 8) ? item + nb : item;
        const int nh = nit & 7, nr0 = (nit >> 3) * 64;
#pragma unroll
        for (int ks = 0; ks < 4; ++ks)
          an[ks] = *(const bf16x8*)(Q + (size_t)(nr0 + mrow + fr) * 2048 + nh * 256 + c * 128 + ks * 32 + fq * 8);
      }
#pragma unroll
      for (int ks = 0; ks < 4; ++ks) {
#pragma unroll
        for (int ni = 0; ni < 8; ++ni) {
          bf16x8 bfr = *(const bf16x8*)(KL + (c * 128 + ni * 16 + fr) * KL_LD + ks * 32 + fq * 8);
          acc[ni] = __builtin_amdgcn_mfma_f32_16x16x32_bf16(a[ks], bfr, acc[ni], 0, 0, 0);
        }
      }
#pragma unroll
      for (int ni = 0; ni < 8; ++ni)
#pragma unroll
        for (int j = 0; j < 4; ++j) {
          const int n = ni * 16 + fr;
          SC[(c * 64 + mrow + fq * 4 + j) * SC_LD + n] = (mono_key(acc[ni][j]) & ~127u) | (unsigned)(127 - n);
        }
    }
    __syncthreads();
    {
      const int task = tid >> 2, q4 = tid & 3;
      unsigned* rowp = SC + task * SC_LD;
      for (int r = 0; r < 16; ++r) {
        unsigned m = 0;
#pragma unroll
        for (int j = 0; j < 8; ++j) {
          uint4 v = *(const uint4*)(rowp + 16 * j + 4 * q4);
          m = umax3(m, v.x, v.y);
          m = umax3(m, v.z, v.w);
        }
        m = umax_quad(m);
        const int n = 127 - (int)(m & 127u);
        if (((n >> 2) & 3) == q4) rowp[n] = 0u;
        if (q4 == (r & 3)) {
          TS[task * 16 + r] = mono_inv(m & ~127u);
          TI[task * 16 + r] = n;
        }
      }
    }
    __syncthreads();
    if (tid < 256) {
      const int t = tid >> 2, q4 = tid & 3;
      unsigned val[13];
#pragma unroll
      for (int e = 0; e < 13; ++e) {
        const int ci = q4 + 4 * e;
        const int i = CAND_I[ci], j = CAND_J[ci];
        const float sv = TS[t * 16 + i] + TS[(64 + t) * 16 + j];
        val[e] = (ci < 50) ? ((mono_key(sv) & ~255u) | (unsigned)(255 - (i * 16 + j))) : 0u;
      }
      unsigned mine[4] = {0u, 0u, 0u, 0u};
      unsigned first = 0u;
#pragma unroll
      for (int r = 0; r < 16; ++r) {
        unsigned m = umax3(val[0], val[1], val[2]);
        m = umax3(m, val[3], val[4]);
        m = umax3(m, val[5], val[6]);
        m = umax3(m, val[7], val[8]);
        m = umax3(m, val[9], val[10]);
        m = umax3(m, val[11], val[12]);
        m = umax_quad(m);
#pragma unroll
        for (int e = 0; e < 13; ++e) val[e] = (val[e] == m) ? 0u : val[e];
        if (r == 0) first = m;
        mine[r >> 2] = (q4 == (r & 3)) ? m : mine[r >> 2];
      }
      float smax;
      {
        const int cid = 255 - (int)(first & 255u);
        smax = TS[t * 16 + (cid >> 4)] + TS[(64 + t) * 16 + (cid & 15)];
      }
      float ex[4];
      int eid[4];
      float part = 0.f;
#pragma unroll
      for (int k = 0; k < 4; ++k) {
        const int cid = 255 - (int)(mine[k] & 255u);
        const int i = cid >> 4, j = cid & 15;
        const float sv = TS[t * 16 + i] + TS[(64 + t) * 16 + j];
        ex[k] = __expf(sv - smax);
        part += ex[k];
        eid[k] = TI[t * 16 + i] * 128 + TI[(64 + t) * 16 + j];
      }
      part = dpp_add(part, 0, 0);
      part = dpp_add(part, 1, 0);
      const float rden = 1.f / part;
      const size_t obase = ((size_t)(row0 + t) * 8 + h) * 16;
#pragma unroll
      for (int k = 0; k < 4; ++k) {
        p.idx()[obase + 4 * k + q4] = eid[k];
        p.gate()[obase + 4 * k + q4] = ex[k] * rden;
      }
    }
    __syncthreads();
  }
}

typedef int v8i_t __attribute__((ext_vector_type(8)));
__device__ __forceinline__ void ph_ffn(const P& p, float* __restrict__ dst, char* smem, int bid, int nb) {
  const int wid = tidx() >> 6, lane = tidx() & 63;
  const int hh = lane >> 5, li = lane & 31, m16 = lane & 15, kg = lane >> 4;
  unsigned char* h8 = (unsigned char*)smem + wid * 1024;
  const u16* H2N = p.hn();
  for (int row = bid * 8 + wid; row < NLAT; row += nb * 8) {
    float hinv;
    {
      const uint4 a = *(const uint4*)(H2N + (size_t)row * 1024 + lane * 16), b2 = *(const uint4*)(H2N + (size_t)row * 1024 + lane * 16 + 8);
      const unsigned au[8] = {a.x, a.y, a.z, a.w, b2.x, b2.y, b2.z, b2.w};
      float hv[16];
      float am = 0.f;
#pragma unroll
      for (int q = 0; q < 8; ++q) { hv[2 * q] = bflo(au[q]); hv[2 * q + 1] = bfhi(au[q]); am = fmaxf(am, fmaxf(fabsf(hv[2 * q]), fabsf(hv[2 * q + 1]))); }
#pragma unroll
      for (int m = 32; m >= 1; m >>= 1) am = fmaxf(am, __shfl_xor(am, m, 64));
      const float scl = am > 0.f ? 448.f / am : 1.f;
      hinv = am > 0.f ? am * (1.f / 448.f) : 1.f;
      unsigned o[4];
#pragma unroll
      for (int q = 0; q < 4; ++q) {
        int w = 0;
        w = __builtin_amdgcn_cvt_pk_fp8_f32(hv[4 * q] * scl, hv[4 * q + 1] * scl, w, false);
        w = __builtin_amdgcn_cvt_pk_fp8_f32(hv[4 * q + 2] * scl, hv[4 * q + 3] * scl, w, true);
        o[q] = (unsigned)w;
      }
      *(uint4*)(h8 + lane * 16) = make_uint4(o[0], o[1], o[2], o[3]);
    }
    v8i_t hb[8];
#pragma unroll
    for (int s2 = 0; s2 < 8; ++s2) {
      const uint4 x0 = *(const uint4*)(h8 + 128 * s2 + 16 * kg), x1 = *(const uint4*)(h8 + 128 * s2 + 64 + 16 * kg);
      hb[s2] = (v8i_t){(int)x0.x, (int)x0.y, (int)x0.z, (int)x0.w, (int)x1.x, (int)x1.y, (int)x1.z, (int)x1.w};
    }
    const int id0 = p.idx()[(size_t)row * 128 + lane], id1 = p.idx()[(size_t)row * 128 + 64 + lane];
    const float us0 = p.usc()[id0] * hinv, us1 = p.usc()[id1] * hinv;
    const float gv0 = p.gate()[(size_t)row * 128 + lane] * p.vsc()[id0], gv1 = p.gate()[(size_t)row * 128 + 64 + lane] * p.vsc()[id1];
    float oacc[32];
#pragma unroll
    for (int i = 0; i < 32; ++i) oacc[i] = 0.f;
#pragma unroll 1
    for (int bb = 0; bb < 8; ++bb) {
      const bool hf = bb >= 4;
      const int e0 = (bb & 3) * 16;
      const int idv = hf ? id1 : id0;
      const float usv = hf ? us1 : us0, gvv = hf ? gv1 : gv0;
      const int idm = __shfl(idv, e0 + m16, 64);
      uint4 ua[8];
#pragma unroll
      for (int s2 = 0; s2 < 8; ++s2) ua[s2] = *(const uint4*)(p.utab() + (size_t)idm * 1024 + 64 * s2 + 16 * kg);
      uint4 vr[8];
#pragma unroll
      for (int q = 0; q < 8; ++q) {
        const int ia = __builtin_amdgcn_readlane(idv, e0 + 2 * q), ib = __builtin_amdgcn_readlane(idv, e0 + 2 * q + 1);
        const int id = hh ? ib : ia;
        vr[q] = *(const uint4*)(p.utab() + (size_t)id * 1024 + 512 + li * 16);
      }
      f32x4 D = (f32x4){0.f, 0.f, 0.f, 0.f};
#pragma unroll
      for (int s2 = 0; s2 < 8; ++s2) {
        const v8i_t av = (v8i_t){(int)ua[s2].x, (int)ua[s2].y, (int)ua[s2].z, (int)ua[s2].w, 0, 0, 0, 0};
        D = __builtin_amdgcn_mfma_scale_f32_16x16x128_f8f6f4(av, hb[s2], D, 4  , 0  , 0, 0x7f7f7f7f, 0, 0x7f7f7f7f);
      }
      const int nn = m16 & 3;
      const float dotv = nn == 0 ? D[0] : (nn == 1 ? D[1] : (nn == 2 ? D[2] : D[3]));
      const int esrc = e0 + 4 * kg + nn;
      const float usx = __shfl(usv, esrc, 64), gvx = __shfl(gvv, esrc, 64);
      const float cfl = gvx * gelu_as(dotv * usx);
#pragma unroll
      for (int q = 0; q < 8; ++q) {
        int one_s;
        asm volatile("s_mov_b32 %0, 1" : "=s"(one_s));
        if (one_s == 0) continue;
        const int ma = 2 * q, mb = 2 * q + 1;
        const float cfa = __int_as_float(__builtin_amdgcn_readlane(__float_as_int(cfl), 16 * (ma >> 2) + (ma & 3)));
        const float cfb = __int_as_float(__builtin_amdgcn_readlane(__float_as_int(cfl), 16 * (mb >> 2) + (mb & 3)));
        const float cf = hh ? cfb : cfa;
        const unsigned vv[4] = {vr[q].x, vr[q].y, vr[q].z, vr[q].w};
#pragma unroll
        for (int k = 0; k < 4; ++k) {
          v2f p0 = __builtin_amdgcn_cvt_scalef32_pk_f32_fp4(vv[k], 1.0f, 0), p1 = __builtin_amdgcn_cvt_scalef32_pk_f32_fp4(vv[k], 1.0f, 1);
          v2f p2 = __builtin_amdgcn_cvt_scalef32_pk_f32_fp4(vv[k], 1.0f, 2), p3 = __builtin_amdgcn_cvt_scalef32_pk_f32_fp4(vv[k], 1.0f, 3);
          oacc[8 * k] += cf * p0[0]; oacc[8 * k + 1] += cf * p0[1];
          oacc[8 * k + 2] += cf * p1[0]; oacc[8 * k + 3] += cf * p1[1];
          oacc[8 * k + 4] += cf * p2[0]; oacc[8 * k + 5] += cf * p2[1];
          oacc[8 * k + 6] += cf * p3[0]; oacc[8 * k + 7] += cf * p3[1];
        }
      }
    }
    float mine[16];
#pragma unroll
    for (int i = 0; i < 16; ++i) {
      const float give = hh ? oacc[i] : oacc[16 + i];
      const float got = __shfl_xor(give, 32, 64);
      mine[i] = (hh ? oacc[16 + i] : oacc[i]) + got;
    }
    const int b = row >> 11;
    const int colb = li * 32 + hh * 16;
    float h3[16];
    float ss = 0.f;
#pragma unroll
    for (int q = 0; q < 4; ++q) {
      const int col = colb + q * 4;
      float4 a0 = *(const float4*)(p.out + (size_t)row * 1024 + col);
      float4 q0 = *(const float4*)(p.mod() + b * 6144 + 5 * 1024 + col);
      h3[q * 4 + 0] = a0.x + q0.x * mine[q * 4 + 0];
      h3[q * 4 + 1] = a0.y + q0.y * mine[q * 4 + 1];
      h3[q * 4 + 2] = a0.z + q0.z * mine[q * 4 + 2];
      h3[q * 4 + 3] = a0.w + q0.w * mine[q * 4 + 3];
      ss += h3[q * 4] * h3[q * 4] + h3[q * 4 + 1] * h3[q * 4 + 1] + h3[q * 4 + 2] * h3[q * 4 + 2] + h3[q * 4 + 3] * h3[q * 4 + 3];
    }
    ss = wave_sum_u(ss);
    const float rstd = rsqrtf(ss * (1.f / 1024.f) + 1e-6f);
#pragma unroll
    for (int q = 0; q < 4; ++q) {
      const int col = colb + q * 4;
      float4 n0 = *(const float4*)(p.norm_f_g + col);
      *(float4*)(dst + (size_t)row * 1024 + col) =
          make_float4(h3[q * 4] * rstd * n0.x, h3[q * 4 + 1] * rstd * n0.y, h3[q * 4 + 2] * rstd * n0.z, h3[q * 4 + 3] * rstd * n0.w);
    }
  }
}

#define XB_TMO      128
#define XB_XCNT(j)  (256  + 64 * (j))
#define XB_XSUB(j)  (1280 + 64 * (j))
#define XB_XGEN(j)  (2304 + 64 * (j))
#define XB_TOP      3328
#define XB_TOPGEN   3392
#define XCD_BAR_WORDS 3456
#define XB_SPIN_CAP (1u << 18)
#define LAS __attribute__((address_space(3)))

__device__ __forceinline__ unsigned xb_ld(unsigned* p)              { return __hip_atomic_load(p, __ATOMIC_RELAXED, __HIP_MEMORY_SCOPE_AGENT); }
__device__ __forceinline__ unsigned xb_add(unsigned* p, unsigned v) { return __hip_atomic_fetch_add(p, v, __ATOMIC_RELAXED, __HIP_MEMORY_SCOPE_AGENT); }
__device__ __forceinline__ unsigned xb_xcc_id() { return (unsigned)__builtin_amdgcn_s_getreg((3 << 11) | 20) & 0xFu; }
#define XB_SPIN(cond, bar) do { unsigned _sp = 0; while (cond) { __builtin_amdgcn_s_sleep(1); \
    if ((++_sp & 255u) == 0u) { if (xb_ld(&(bar)[XB_TMO])) break; if (_sp > XB_SPIN_CAP) { atomicAdd(&(bar)[XB_TMO], 1u); break; } } } } while (0)

struct XcdBarrier {
    unsigned* bar; unsigned x;
    volatile LAS unsigned* st;
};

__device__ __forceinline__ XcdBarrier xcd_barrier_post(unsigned* bar, volatile LAS unsigned* st) {
    XcdBarrier b; b.bar = bar; b.x = xb_xcc_id(); b.st = st;
    if (tidx() == 0) (void)xb_add(&bar[XB_XCNT(b.x)], 1u);
    return b;
}
__device__ __forceinline__ void xcd_barrier_complete(unsigned* bar, unsigned x, unsigned& nloc, unsigned& nx) {
    const unsigned G = gridDim.x * gridDim.y * gridDim.z;
    unsigned sum, cnt, mine, sp = 0u;
    for (;;) {
        sum = 0u; cnt = 0u; mine = 0u;
#pragma unroll
        for (unsigned j = 0; j < 16; ++j) { const unsigned c = xb_ld(&bar[XB_XCNT(j)]); sum += c; cnt += (c > 0u) ? 1u : 0u; mine = (j == x) ? c : mine; }
        if (sum == G) break;
        __builtin_amdgcn_s_sleep(1);
        if ((++sp & 255u) == 0u) { if (xb_ld(&bar[XB_TMO])) break; if (sp > XB_SPIN_CAP) { atomicAdd(&bar[XB_TMO], 1u); break; } }
    }
    nloc = mine > 0u ? mine : 1u; nx = cnt > 0u ? cnt : 1u;
}

__device__ __forceinline__ void xcd_barrier(const XcdBarrier& b) {
    asm volatile("s_waitcnt vmcnt(0)" ::: "memory");
    __syncthreads();
    if (tidx() == 0) {
        unsigned* bar = b.bar;
        __builtin_amdgcn_s_waitcnt(0);
        unsigned nloc = b.st[0], nx = b.st[1];
        if (nloc == 0u) { xcd_barrier_complete(bar, b.x, nloc, nx); b.st[0] = nloc; b.st[1] = nx; }
        const unsigned old = xb_add(&bar[XB_XSUB(b.x)], 1u);
        const unsigned gen = old / nloc;
        if (old + 1u == (gen + 1u) * nloc) {
            __builtin_amdgcn_fence(__ATOMIC_RELEASE, "agent");
            asm volatile("s_waitcnt vmcnt(0)" ::: "memory");
            const unsigned og = xb_add(&bar[XB_TOP], 1u);
            const unsigned tg = og / nx;
            if (og + 1u == (tg + 1u) * nx) xb_add(&bar[XB_TOPGEN], 1u);
            else XB_SPIN(xb_ld(&bar[XB_TOPGEN]) == tg, bar);
            __builtin_amdgcn_fence(__ATOMIC_ACQUIRE, "agent");
            xb_add(&bar[XB_XGEN(b.x)], 1u);
            asm volatile("s_waitcnt vmcnt(0)" ::: "memory");
        } else {
            XB_SPIN(xb_ld(&bar[XB_XGEN(b.x)]) == gen, bar);
            __builtin_amdgcn_fence(__ATOMIC_ACQUIRE, "agent");
            asm volatile("s_waitcnt vmcnt(0)" ::: "memory");
        }
    }
    __syncthreads();
}

typedef const __attribute__((address_space(4))) P* kargP_t;
__device__ __forceinline__ P load_params() {
  kargP_t q = (kargP_t)__builtin_amdgcn_kernarg_segment_ptr();
  asm volatile("" : "+s"(q));
  P r;
  r.x = q->x;
  r.c = q->c;
  r.ctx = q->ctx;
  r.c_ctx = q->c_ctx;
  r.w_ada = q->w_ada;
  r.b_ada = q->b_ada;
  r.norm1_g = q->norm1_g;
  r.norm2_g = q->norm2_g;
  r.w_in = q->w_in;
  r.s5_a_re = q->s5_a_re;
  r.s5_a_im = q->s5_a_im;
  r.s5_log_dt = q->s5_log_dt;
  r.s5_b_re = q->s5_b_re;
  r.s5_b_im = q->s5_b_im;
  r.s5_c_re = q->s5_c_re;
  r.s5_c_im = q->s5_c_im;
  r.s5_d = q->s5_d;
  r.s5_w_glu = q->s5_w_glu;
  r.s5_b_glu = q->s5_b_glu;
  r.rw_mu = q->rw_mu;
  r.rw_w0 = q->rw_w0;
  r.rw_w_w2 = q->rw_w_w2;
  r.rw_a0 = q->rw_a0;
  r.rw_w_a2 = q->rw_w_a2;
  r.rw_w_g2 = q->rw_w_g2;
  r.rw_k_k = q->rw_k_k;
  r.rw_k_a = q->rw_k_a;
  r.rw_r_k = q->rw_r_k;
  r.rw_ln_w = q->rw_ln_w;
  r.rw_ln_b = q->rw_ln_b;
  r.w_out = q->w_out;
  r.peer_w_q = q->peer_w_q;
  r.peer_keys = q->peer_keys;
  r.peer_u = q->peer_u;
  r.peer_v = q->peer_v;
  r.norm_f_g = q->norm_f_g;
  r.out = q->out;
  r.ws = q->ws;
  return r;
}
#define NPHASES 11
template <int PH>
__device__ __forceinline__ void run_phase(const P& p, char* smem, int bid, int nb, bool rep = false) {
  if (PH == 0) ph_prep(p, smem, bid, nb);
  if (PH == 1) ph_norm(p, 0, bid, nb);
  if (PH == 2) {
    pg8::StaticOrder S; S.init(NTOK, INCP, nb, bid);
    pg8::gemm_phase<pg8::EpiProjT, pg8::StaticOrder, false>((PG8_LAS unsigned char*)smem, pg8::Gemm{p.hn(), p.win_t(), NTOK, INCP, 1024}, S, pg8::EpiProjT{p.proj(), INC, INC}, nullptr);
  }
  if (PH == 3) { ph_s5scan2(p, smem, bid, nb); ph_rwscan2(p, smem, bid, nb); }
  if (PH == 4) ph_mixprep(p, bid, nb, rep ? p.hn() : p.ys5f(), rep ? p.hn() + (size_t)NLAT * 512 : p.yrwf());
  if (PH == 5) {
    {
      pg8::StaticOrder S; S.init(NLAT, 512, nb, bid);
      pg8::gemm_phase<pg8::EpiGluT, pg8::StaticOrder, false>((PG8_LAS unsigned char*)smem, pg8::Gemm{p.ys5f(), p.wglu_t(), NLAT, 512, 512}, S, pg8::EpiGluT{p.ys5f(), p.s5_b_glu, p.hn()}, nullptr);
    }
    {
      pg8::StaticOrder S; S.init(NLAT, 512, nb, bid);
      pg8::gemm_phase<pg8::EpiGateT, pg8::StaticOrder, false>((PG8_LAS unsigned char*)smem, pg8::Gemm{p.sg(), p.wg2_t(), NLAT, 512, 256}, S, pg8::EpiGateT{p.yrwf(), p.hn()}, nullptr);
    }
  }
  if (PH == 6) {
    pg8::StaticOrder S; S.init(NLAT, 1024, nb, bid);
    pg8::gemm_phase<pg8::EpiWoutT, pg8::StaticOrder, false>((PG8_LAS unsigned char*)smem, pg8::Gemm{p.hn(), p.wout_t(), NLAT, 1024, 1024}, S, pg8::EpiWoutT{p.x, p.mod(), p.out}, nullptr);
  }
  if (PH == 7) ph_norm(p, 1, bid, nb);
  if (PH == 8) {
    pg8::StaticOrder S; S.init(NLAT, 2048, nb, bid);
    pg8::gemm_phase<pg8::EpiProjT, pg8::StaticOrder, false>((PG8_LAS unsigned char*)smem, pg8::Gemm{p.hn(), p.wq_t(), NLAT, 2048, 1024}, S, pg8::EpiProjT{p.proj(), 2048, 2048}, nullptr);
  }
  if (PH == 9) ph_route(p, smem, bid, nb);
  if (PH == 10) ph_ffn(p, rep ? (float*)p.proj() : p.out, smem, bid, nb);
  if (PH == 11) ph_s5scan2(p, smem, bid, nb);
  if (PH == 12) ph_rwscan2(p, smem, bid, nb);
}
#ifndef REPMASK
#define REPMASK 0
#endif
#define REP(n) ((REPMASK >> (n)) & 1)
#define PHASE(n) if (ph_lo <= n && n < ph_hi) { if (n > ph_lo) { if (n == 1) grid.sync(); else xcd_barrier(xb); } if (REP(n)) { { const P lp_ = load_params(); run_phase<n>(lp_, smem, bid, nb, true); } __syncthreads(); } if (n == 3 && REP(11)) { run_phase<11>(p, smem, bid, nb); __syncthreads(); } if (n == 3 && REP(12)) { run_phase<12>(p, smem, bid, nb); __syncthreads(); } { const P lp_ = load_params(); run_phase<n>(lp_, smem, bid, nb); } }
__global__ void __launch_bounds__(NTHREADS) mega(P p, int ph_lo, int ph_hi) {
  char* smem = g_smem;
  if ((threadIdx.x & 63) == 0) *(int*)(g_smem + WAVETAB_OFF + 4 * hw_slot()) = (int)(threadIdx.x >> 6);
  cg::grid_group grid = cg::this_grid();
  const int bid = blockIdx.x, nb = gridDim.x;
  volatile LAS unsigned* xst = (volatile LAS unsigned*)(smem + LDS_BYTES - 16);
  if (threadIdx.x == 0) { xst[0] = 0u; xst[1] = 0u; }
  __syncthreads();
  XcdBarrier xb;
  {
    const P lp0 = load_params();
    xb.bar = lp0.bar(); xb.x = 0; xb.st = xst;
    if (ph_hi - ph_lo > 1) xb = xcd_barrier_post(lp0.bar(), xst);
  }
  PHASE(0) PHASE(1) PHASE(2) PHASE(3) PHASE(4) PHASE(5) PHASE(6) PHASE(7) PHASE(8) PHASE(9) PHASE(10)
}

extern "C" void kernel_launch(void* const* d_in, const int* in_sizes, int n_in, void* d_out, int out_size, void* d_ws,
                              size_t ws_size, hipStream_t stream) {
  static int grid_blocks = 0;
  if (!grid_blocks) {
    int dev = 0, cus = 0, per_cu = 0;
    hipGetDevice(&dev);
    hipDeviceGetAttribute(&cus, hipDeviceAttributeMultiprocessorCount, dev);
    hipFuncSetAttribute((const void*)mega, hipFuncAttributeMaxDynamicSharedMemorySize, LDS_BYTES);
    hipOccupancyMaxActiveBlocksPerMultiprocessor(&per_cu, (const void*)mega, NTHREADS, LDS_BYTES);
    if (per_cu < 1) { fprintf(stderr, "occupancy query returned %d\n", per_cu); per_cu = 1; }
    grid_blocks = cus;
  }
  P p{};
  const float** fp = (const float**)&p;
  for (int i = 0; i < 36; ++i) fp[i] = (const float*)d_in[i];
  p.out = (float*)d_out;
  p.ws = (char*)d_ws;
  if (WS_TOTAL > ws_size) { fprintf(stderr, "workspace too small: need %zu have %zu\n", (size_t)WS_TOTAL, ws_size); return; }
#if MEGA
  if (hipMemsetAsync((char*)d_ws + OFF_bar, 0, XCD_BAR_WORDS * 4, stream) != hipSuccess) fprintf(stderr, "memset of barrier words failed\n");
  int lo = 0, hi = NPHASES;
  void* args[] = {&p, &lo, &hi};
  hipError_t e = hipLaunchCooperativeKernel((const void*)mega, dim3(grid_blocks), dim3(NTHREADS), args, LDS_BYTES, stream);
  if (e != hipSuccess) fprintf(stderr, "cooperative launch failed: %s (grid %d)\n", hipGetErrorString(e), grid_blocks);
#else
  for (int ph = 0; ph < NPHASES; ++ph) {
    hipLaunchKernelGGL(mega, dim3(grid_blocks), dim3(NTHREADS), LDS_BYTES, stream, p, ph, ph + 1);
  }
#endif
}
```

```cpp
#include <hip/hip_runtime.h>
#include <hip/hip_cooperative_groups.h>
#include <stdint.h>
#include <stdio.h>
namespace cg = cooperative_groups;

#ifndef MEGA
#define MEGA 1
#endif

typedef unsigned short u16;
using bf16x8 = __attribute__((ext_vector_type(8))) short;
using f32x4 = __attribute__((ext_vector_type(4))) float;
using u32x4 = __attribute__((ext_vector_type(4))) unsigned;
using f32x16 = __attribute__((ext_vector_type(16))) float;

#define DM 1024
#define NLAT 65536
#define NCTX 8192
#define NTOK 73728
#define INC 2208
#define INCP 2304
#define NTHREADS 512
#define LDS_BYTES 163840

#define INC_FWD 1
constexpr size_t ws_al(size_t x) { return (x + 255) & ~(size_t)255; }
constexpr size_t OFF_mod = 0;
constexpr size_t OFF_win_t = OFF_mod + ws_al(33 * 6144 * 4);
constexpr size_t OFF_wout_t = OFF_win_t + ws_al((size_t)2304 * 1024 * 2);
constexpr size_t OFF_wq_t = OFF_wout_t + ws_al((size_t)1024 * 1024 * 2);
constexpr size_t OFF_wglu_t = OFF_wq_t + ws_al((size_t)2048 * 1024 * 2);
constexpr size_t OFF_wg2_t = OFF_wglu_t + ws_al((size_t)512 * 512 * 2);
constexpr size_t OFF_keys = OFF_wg2_t + ws_al((size_t)512 * 256 * 2);
constexpr size_t OFF_utab = OFF_keys + ws_al((size_t)8 * 2 * 128 * 128 * 2);
constexpr size_t OFF_usc = OFF_utab + ws_al((size_t)16384 * 1024);
constexpr size_t OFF_vsc = OFF_usc + ws_al(16384 * 4);
constexpr size_t OFF_s5ab = OFF_vsc + ws_al(16384 * 4);
constexpr size_t OFF_s5bb = OFF_s5ab + ws_al(4096 * 2 * 4);
constexpr size_t OFF_s5ct = OFF_s5bb + ws_al(4096 * 32 * 4);
constexpr size_t OFF_hn = OFF_s5ct + ws_al(2 * 32 * 16 * 128 * 2);
constexpr size_t OFF_proj = OFF_hn + ws_al((size_t)73728 * 1024 * 2);
constexpr size_t OFF_ys5f = OFF_proj + ws_al((size_t)73728 * 2208 * 2);
constexpr size_t OFF_ys5b = OFF_ys5f + ws_al((size_t)65536 * 512 * 2);
constexpr size_t OFF_yrwf = OFF_ys5b + ws_al((size_t)65536 * 512 * 2);
constexpr size_t OFF_yrwb = OFF_yrwf + ws_al((size_t)65536 * 512 * 2);
constexpr size_t OFF_bsc = OFF_yrwb + ws_al((size_t)65536 * 512 * 2);
constexpr size_t OFF_sg = OFF_bsc + ws_al((size_t)2 * 65536 * 8 * 4);
constexpr size_t OFF_bar = OFF_sg + ws_al((size_t)65536 * 256 * 2);
constexpr size_t OFF_wlf = OFF_bar + ws_al(3456 * 4);
constexpr size_t WS_TOTAL = OFF_wlf + ws_al(2 * 4096 * 16);

extern __shared__ __attribute__((aligned(16))) char g_smem[];
#define WAVETAB_OFF (LDS_BYTES - 16 - 256)
__device__ __forceinline__ int hw_slot() { return (int)(__builtin_amdgcn_s_getreg((5 << 11) | 4) & 63u); }
__device__ __forceinline__ int tidx() {
  const int w = *(const int*)(g_smem + WAVETAB_OFF + 4 * hw_slot());
  return __builtin_amdgcn_readfirstlane(w) * 64 + (int)__builtin_amdgcn_mbcnt_hi(~0u, __builtin_amdgcn_mbcnt_lo(~0u, 0u));
}
__device__ __forceinline__ int widx() { return __builtin_amdgcn_readfirstlane(*(const int*)(g_smem + WAVETAB_OFF + 4 * hw_slot())); }
__device__ __forceinline__ int lidx() { return (int)__builtin_amdgcn_mbcnt_hi(~0u, __builtin_amdgcn_mbcnt_lo(~0u, 0u)); }
struct P {
  const float *x, *c, *ctx, *c_ctx, *w_ada, *b_ada, *norm1_g, *norm2_g, *w_in, *s5_a_re, *s5_a_im, *s5_log_dt,
      *s5_b_re, *s5_b_im, *s5_c_re, *s5_c_im, *s5_d, *s5_w_glu, *s5_b_glu, *rw_mu, *rw_w0, *rw_w_w2, *rw_a0, *rw_w_a2,
      *rw_w_g2, *rw_k_k, *rw_k_a, *rw_r_k, *rw_ln_w, *rw_ln_b, *w_out, *peer_w_q, *peer_keys, *peer_u, *peer_v, *norm_f_g;
  float* out;
  char* ws;
  __device__ __forceinline__ float* mod() const { return (float*)(ws + OFF_mod); }
  __device__ __forceinline__ u16* win_t() const { return (u16*)(ws + OFF_win_t); }
  __device__ __forceinline__ u16* wout_t() const { return (u16*)(ws + OFF_wout_t); }
  __device__ __forceinline__ u16* wq_t() const { return (u16*)(ws + OFF_wq_t); }
  __device__ __forceinline__ u16* wglu_t() const { return (u16*)(ws + OFF_wglu_t); }
  __device__ __forceinline__ u16* wg2_t() const { return (u16*)(ws + OFF_wg2_t); }
  __device__ __forceinline__ u16* keys() const { return (u16*)(ws + OFF_keys); }
  __device__ __forceinline__ unsigned char* utab() const { return (unsigned char*)(ws + OFF_utab); }
  __device__ __forceinline__ float* usc() const { return (float*)(ws + OFF_usc); }
  __device__ __forceinline__ float* vsc() const { return (float*)(ws + OFF_vsc); }
  __device__ __forceinline__ float* s5ab() const { return (float*)(ws + OFF_s5ab); }
  __device__ __forceinline__ float* s5bb() const { return (float*)(ws + OFF_s5bb); }
  __device__ __forceinline__ u16* s5ct() const { return (u16*)(ws + OFF_s5ct); }
  __device__ __forceinline__ u16* hn() const { return (u16*)(ws + OFF_hn); }
  __device__ __forceinline__ u16* proj() const { return (u16*)(ws + OFF_proj); }
  __device__ __forceinline__ u16* ys5f() const { return (u16*)(ws + OFF_ys5f); }
  __device__ __forceinline__ u16* ys5b() const { return (u16*)(ws + OFF_ys5b); }
  __device__ __forceinline__ u16* yrwf() const { return (u16*)(ws + OFF_yrwf); }
  __device__ __forceinline__ u16* yrwb() const { return (u16*)(ws + OFF_yrwb); }
  __device__ __forceinline__ float* bsc() const { return (float*)(ws + OFF_bsc); }
  __device__ __forceinline__ u16* sg() const { return (u16*)(ws + OFF_sg); }
  __device__ __forceinline__ unsigned* bar() const { return (unsigned*)(ws + OFF_bar); }
  __device__ __forceinline__ u16* wlf() const { return (u16*)(ws + OFF_wlf); }
  __device__ __forceinline__ unsigned char* vtab() const { return utab() + 512; }
  __device__ __forceinline__ int* idx() const { return (int*)ys5b(); }
  __device__ __forceinline__ float* gate() const { return (float*)yrwb(); }
};

typedef float f32x2_t __attribute__((ext_vector_type(2)));
typedef __bf16 bf16x2_t __attribute__((ext_vector_type(2)));
__device__ __forceinline__ unsigned pack2(float a, float b) {
  f32x2_t v = {a, b};
  return __builtin_bit_cast(unsigned, __builtin_convertvector(v, bf16x2_t));
}
__device__ __forceinline__ u16 f2bf(float f) { return __builtin_bit_cast(u16, (__bf16)f); }
__device__ __forceinline__ float bf2f(u16 h) { return __uint_as_float(((unsigned)h) << 16); }
__device__ __forceinline__ float bflo(unsigned u) { return __uint_as_float(u << 16); }
__device__ __forceinline__ float bfhi(unsigned u) { return __uint_as_float(u & 0xffff0000u); }
__device__ __forceinline__ float wave_sum(float v) {
#pragma unroll
  for (int m = 32; m >= 1; m >>= 1) v += __shfl_xor(v, m, 64);
  return v;
}
__device__ __forceinline__ float gelu_exact(float x) { return 0.5f * x * (1.f + erff(x * 0.70710678118654752f)); }
__device__ __forceinline__ float gelu_as(float v) {
  const float av = fabsf(v), t = __builtin_amdgcn_rcpf(av * 0.2316418882f + 1.0f);
  float q = t * 0.5307027145f + (-0.7265760135f);
  q = q * t + 0.7107068705f; q = q * t + (-0.142248368f); q = q * t + 0.127414796f; q = q * t;
  const float e = __builtin_amdgcn_exp2f((v * v) * (-0.72134752044f));
  const float m = v * (q * e);
  return v < 0.f ? m : v - m;
}
__device__ __forceinline__ float sigmoidf(float x) { return 1.f / (1.f + __expf(-x)); }


typedef float v2f __attribute__((ext_vector_type(2)));
__device__ __forceinline__ float dpp_add(float v, const int ctrl, const int rmask) {
  int m;
  switch (ctrl) {
    case 0: m = __builtin_amdgcn_update_dpp(0, __float_as_int(v), 0xB1, 0xf, 0xf, true); break;
    case 1: m = __builtin_amdgcn_update_dpp(0, __float_as_int(v), 0x4E, 0xf, 0xf, true); break;
    case 2: m = __builtin_amdgcn_update_dpp(0, __float_as_int(v), 0x141, 0xf, 0xf, true); break;
    case 3: m = __builtin_amdgcn_update_dpp(0, __float_as_int(v), 0x140, 0xf, 0xf, true); break;
    case 4: m = __builtin_amdgcn_update_dpp(0, __float_as_int(v), 0x142, 0xa, 0xf, false); break;
    default: m = __builtin_amdgcn_update_dpp(0, __float_as_int(v), 0x143, 0xc, 0xf, false); break;
  }
  return v + __int_as_float(m);
}
__device__ __forceinline__ float wave_sum_u(float v) {
  v = dpp_add(v, 0, 0); v = dpp_add(v, 1, 0); v = dpp_add(v, 2, 0); v = dpp_add(v, 3, 0);
  v = dpp_add(v, 4, 0); v = dpp_add(v, 5, 0);
  return __int_as_float(__builtin_amdgcn_readlane(__float_as_int(v), 63));
}
__device__ __forceinline__ void convert_fp4_rows(const float* __restrict__ src, unsigned char* __restrict__ dst, float* __restrict__ sc,
                                                 int nrows, int bid, int nb) {
  const int wid = tidx() >> 6, lane = tidx() & 63;
  const int stride = nb * 8;
  for (int row0 = bid * 8 + wid; row0 < nrows; row0 += 4 * stride) {
    float4 v[4][4];
#pragma unroll
    for (int u = 0; u < 4; ++u) {
      int row = row0 + u * stride;
      if (row >= nrows) row = row0;
#pragma unroll
      for (int q = 0; q < 4; ++q) v[u][q] = *(const float4*)(src + (size_t)row * 1024 + lane * 16 + q * 4);
    }
#pragma unroll
    for (int u = 0; u < 4; ++u) {
      const int row = row0 + u * stride;
      if (row >= nrows) continue;
      float am = 0.f;
#pragma unroll
      for (int q = 0; q < 4; ++q)
        am = fmaxf(am, fmaxf(fmaxf(fabsf(v[u][q].x), fabsf(v[u][q].y)), fmaxf(fabsf(v[u][q].z), fabsf(v[u][q].w))));
#pragma unroll
      for (int m = 32; m >= 1; m >>= 1) am = fmaxf(am, __shfl_xor(am, m, 64));
      const float scl = am > 0.f ? 6.f / am : 1.f;
      unsigned w0 = 0u, w1 = 0u;
      w0 = __builtin_amdgcn_cvt_scalef32_pk_fp4_f32(w0, v[u][0].x * scl, v[u][0].y * scl, 1.0f, 0);
      w0 = __builtin_amdgcn_cvt_scalef32_pk_fp4_f32(w0, v[u][0].z * scl, v[u][0].w * scl, 1.0f, 1);
      w0 = __builtin_amdgcn_cvt_scalef32_pk_fp4_f32(w0, v[u][1].x * scl, v[u][1].y * scl, 1.0f, 2);
      w0 = __builtin_amdgcn_cvt_scalef32_pk_fp4_f32(w0, v[u][1].z * scl, v[u][1].w * scl, 1.0f, 3);
      w1 = __builtin_amdgcn_cvt_scalef32_pk_fp4_f32(w1, v[u][2].x * scl, v[u][2].y * scl, 1.0f, 0);
      w1 = __builtin_amdgcn_cvt_scalef32_pk_fp4_f32(w1, v[u][2].z * scl, v[u][2].w * scl, 1.0f, 1);
      w1 = __builtin_amdgcn_cvt_scalef32_pk_fp4_f32(w1, v[u][3].x * scl, v[u][3].y * scl, 1.0f, 2);
      w1 = __builtin_amdgcn_cvt_scalef32_pk_fp4_f32(w1, v[u][3].z * scl, v[u][3].w * scl, 1.0f, 3);
      *(uint2*)(dst + (size_t)row * 1024 + lane * 8) = make_uint2(w0, w1);
      if (lane == 0) sc[row] = am > 0.f ? am / 6.f : 1.f;
    }
  }
}

__device__ __forceinline__ void transpose_tiles(const float* __restrict__ src, int K, int N, u16* __restrict__ dst, int Kd, int Npad,
                                char* smem, int bid, int nb) {
  float* tile = (float*)smem;
  const int tid = tidx();
  const int nkt = Kd / 64, nnt = Npad / 64;
  for (int t = bid; t < nkt * nnt; t += nb) {
    int kt = t % nkt, nt = t / nkt;
    int k0 = kt * 64, n0 = nt * 64;
    __syncthreads();
#pragma unroll
    for (int it = 0; it < 8; ++it) {
      int i = (tid >> 6) + it * 8, j = tid & 63;
      int k = k0 + i, n = n0 + j;
      tile[i * 65 + j] = (k < K && n < N) ? src[(size_t)k * N + n] : 0.f;
    }
    __syncthreads();
    int n = tid >> 3, kc = (tid & 7) * 8;
    uint4 o;
    o.x = pack2(tile[(kc + 0) * 65 + n], tile[(kc + 1) * 65 + n]);
    o.y = pack2(tile[(kc + 2) * 65 + n], tile[(kc + 3) * 65 + n]);
    o.z = pack2(tile[(kc + 4) * 65 + n], tile[(kc + 5) * 65 + n]);
    o.w = pack2(tile[(kc + 6) * 65 + n], tile[(kc + 7) * 65 + n]);
    *(uint4*)(dst + (size_t)(n0 + n) * Kd + k0 + kc) = o;
  }
}

__device__ __forceinline__ void convert_bf16(const float* __restrict__ src, u16* __restrict__ dst, size_t n8, int bid, int nb) {
  for (size_t i = (size_t)bid * NTHREADS + tidx(); i < n8; i += (size_t)nb * NTHREADS) {
    float4 a = *(const float4*)(src + i * 8), b = *(const float4*)(src + i * 8 + 4);
    uint4 o;
    o.x = pack2(a.x, a.y); o.y = pack2(a.z, a.w); o.z = pack2(b.x, b.y); o.w = pack2(b.z, b.w);
    *(uint4*)(dst + i * 8) = o;
  }
}

__device__ __forceinline__ void ph_prep(const P& p, char* smem, int bid, int nb) {
  const int tid = tidx();
  {
    float* sc = (float*)smem;
    float* red = (float*)(smem + 33 * 256 * 4);
    for (int item = bid; item < 192; item += nb) {
      const int j0 = item * 32, kg = tid >> 5, col = tid & 31;
      float acc[33];
#pragma unroll
      for (int b = 0; b < 33; ++b) acc[b] = 0.f;
      for (int ch = 0; ch < 4; ++ch) {
        __syncthreads();
        for (int e = tid; e < 33 * 256; e += NTHREADS) {
          int b = e >> 8, kk = e & 255;
          float cv = (b < 32) ? p.c[b * 1024 + ch * 256 + kk] : p.c_ctx[ch * 256 + kk];
          sc[e] = cv / (1.f + expf(-cv));
        }
        float w[16];
#pragma unroll
        for (int i = 0; i < 16; ++i) w[i] = p.w_ada[(size_t)(ch * 256 + kg * 16 + i) * 6144 + j0 + col];
        __syncthreads();
#pragma unroll
        for (int i = 0; i < 16; ++i) {
          const int kk = kg * 16 + i;
#pragma unroll
          for (int b = 0; b < 33; ++b) acc[b] += sc[b * 256 + kk] * w[i];
        }
      }
#pragma unroll
      for (int b = 0; b < 33; ++b) red[(kg * 33 + b) * 32 + col] = acc[b];
      __syncthreads();
      for (int e = tid; e < 33 * 32; e += NTHREADS) {
        int b = e >> 5, cc = e & 31;
        float sv = p.b_ada[j0 + cc];
#pragma unroll
        for (int k2 = 0; k2 < 16; ++k2) sv += red[(k2 * 33 + b) * 32 + cc];
        p.mod()[b * 6144 + j0 + cc] = sv;
      }
      __syncthreads();
    }
  }
  transpose_tiles(p.w_in, 1024, INC, p.win_t(), 1024, INCP, smem, bid, nb);
  transpose_tiles(p.w_out, 1024, 1024, p.wout_t(), 1024, 1024, smem, bid, nb);
  transpose_tiles(p.peer_w_q, 1024, 2048, p.wq_t(), 1024, 2048, smem, bid, nb);
  transpose_tiles(p.s5_w_glu, 512, 512, p.wglu_t(), 512, 512, smem, bid, nb);
  transpose_tiles(p.rw_w_g2, 96, 512, p.wg2_t(), 256, 512, smem, bid, nb);
  convert_bf16(p.peer_keys, p.keys(), (size_t)8 * 2 * 128 * 128 / 8, bid, nb);
  convert_fp4_rows(p.peer_u, p.utab(), p.usc(), 16384, bid, nb);
  convert_fp4_rows(p.peer_v, p.vtab(), p.vsc(), 16384, bid, nb);
  for (int it = bid * NTHREADS + tid; it < 2 * 4096; it += nb * NTHREADS) {
    const int ln = it & 63, mt = (it >> 6) & 3, hh_ = (it >> 8) & 7, dd = (it >> 11) & 1, mm = it >> 12;
    const int tt = ln & 15, kq_ = ln >> 4;
    const float* W = mm ? p.rw_w_a2 : p.rw_w_w2;
    unsigned o[4];
#pragma unroll
    for (int q = 0; q < 4; ++q) {
      const size_t o0 = (size_t)(dd * 32 + 8 * kq_ + 2 * q) * 512 + hh_ * 64 + 16 * (tt >> 2) + 4 * mt + (tt & 3);
      o[q] = pack2(W[o0], W[o0 + 512]);
    }
    *(uint4*)(p.wlf() + (size_t)it * 8) = make_uint4(o[0], o[1], o[2], o[3]);
  }
  for (int it = bid * NTHREADS + tid; it < 4096; it += nb * NTHREADS) {
    int pp = it & 63, g = (it >> 6) & 31, d = it >> 11;
    float are = p.s5_a_re[it], aim = p.s5_a_im[it];
    float dt = expf(p.s5_log_dt[d * 32 + g]);
    float mag = expf(dt * are);
    float abr = mag * cosf(dt * aim), abi = mag * sinf(dt * aim);
    float nr = abr - 1.f, ni = abi;
    float den = are * are + aim * aim;
    float cfr = (nr * are + ni * aim) / den, cfi = (ni * are - nr * aim) / den;
    p.s5ab()[it * 2] = abr;
    p.s5ab()[it * 2 + 1] = abi;
    for (int h = 0; h < 16; ++h) {
      float br = p.s5_b_re[(size_t)it * 16 + h], bi = p.s5_b_im[(size_t)it * 16 + h];
      p.s5bb()[(size_t)it * 32 + h] = cfr * br - cfi * bi;
      p.s5bb()[(size_t)it * 32 + 16 + h] = cfr * bi + cfi * br;
    }
    for (int h = 0; h < 16; ++h) {
      size_t ci = ((size_t)(d * 32 + g) * 16 + h) * 64 + pp;
      p.s5ct()[((size_t)(d * 32 + g) * 16 + h) * 128 + 2 * pp] = f2bf(p.s5_c_re[ci]);
      p.s5ct()[((size_t)(d * 32 + g) * 16 + h) * 128 + 2 * pp + 1] = f2bf(-p.s5_c_im[ci]);
    }
  }
}

__device__ __forceinline__ void ph_norm(const P& p, int mode, int bid, int nb) {
  const int wid = tidx() >> 6, lane = tidx() & 63;
  const int nrows = mode == 0 ? NTOK : NLAT;
  const float* gvec = mode == 0 ? p.norm1_g : p.norm2_g;
  const int sh_off = mode == 0 ? 0 : 3 * 1024, sc_off = sh_off + 1024;
  const int stride = nb * 8;
  for (int row0 = bid * 8 + wid; row0 < nrows; row0 += 4 * stride) {
    float4 v[4][4];
    int bs[4];
#pragma unroll
    for (int u = 0; u < 4; ++u) {
      int row = row0 + u * stride;
      if (row >= nrows) row = row0;
      const float* src;
      if (mode == 0) {
        if (row < NLAT) { src = p.x + (size_t)row * 1024; bs[u] = row >> 11; }
        else { src = p.ctx + (size_t)(row - NLAT) * 1024; bs[u] = 32; }
      } else { src = p.out + (size_t)row * 1024; bs[u] = row >> 11; }
#pragma unroll
      for (int j = 0; j < 2; ++j) {
        v[u][2 * j] = *(const float4*)(src + j * 512 + lane * 8);
        v[u][2 * j + 1] = *(const float4*)(src + j * 512 + lane * 8 + 4);
      }
    }
#pragma unroll
    for (int u = 0; u < 4; ++u) {
      const int row = row0 + u * stride;
      if (row >= nrows) continue;
      float ss = 0.f;
#pragma unroll
      for (int j = 0; j < 4; ++j) ss += v[u][j].x * v[u][j].x + v[u][j].y * v[u][j].y + v[u][j].z * v[u][j].z + v[u][j].w * v[u][j].w;
      ss = wave_sum_u(ss);
      const float rstd = rsqrtf(ss * (1.f / 1024.f) + 1e-6f);
      const float* mrow = p.mod() + bs[u] * 6144;
#pragma unroll
      for (int j = 0; j < 2; ++j) {
        const int col = j * 512 + lane * 8;
        unsigned o[4];
#pragma unroll
        for (int hq = 0; hq < 2; ++hq) {
          const float4 x = v[u][2 * j + hq];
          const float4 g = *(const float4*)(gvec + col + 4 * hq);
          const float4 sh = *(const float4*)(mrow + sh_off + col + 4 * hq);
          const float4 sc = *(const float4*)(mrow + sc_off + col + 4 * hq);
          o[2 * hq] = pack2(x.x * rstd * g.x * (1.f + sc.x) + sh.x, x.y * rstd * g.y * (1.f + sc.y) + sh.y);
          o[2 * hq + 1] = pack2(x.z * rstd * g.z * (1.f + sc.z) + sh.z, x.w * rstd * g.w * (1.f + sc.w) + sh.w);
        }
        *(uint4*)(p.hn() + (size_t)row * 1024 + col) = make_uint4(o[0], o[1], o[2], o[3]);
      }
    }
  }
}

#define G_BM 256
#define G_BN 128
#define G_BK 64
#define G_LD 72
template <class Epi>
__device__ __forceinline__ void gemm_simple(const u16* __restrict__ A, int lda, const u16* __restrict__ Bt, int ldb, int K, int M, int N,
                           char* smem, int bid, int nb, Epi epi) {
  u16* As = (u16*)smem;
  u16* Bs = (u16*)(smem + 2 * G_BM * G_LD * 2);
  const int tid = tidx(), wid = tid >> 6, lane = tid & 63;
  const int wr = wid >> 1, wc = wid & 1, fr = lane & 15, fq = lane >> 4;
  const int ntn = N / G_BN, ntiles = (M / G_BM) * ntn, nk = K / G_BK;
  const int lrow = tid >> 3, lkc = (tid & 7) * 8;
  for (int tile = bid; tile < ntiles; tile += nb) {
    const int m0 = (tile / ntn) * G_BM, n0 = (tile % ntn) * G_BN;
    f32x4 acc[4][4];
#pragma unroll
    for (int i = 0; i < 4; ++i)
#pragma unroll
      for (int j = 0; j < 4; ++j) acc[i][j] = (f32x4){0.f, 0.f, 0.f, 0.f};
    u32x4 ra[4], rb[2];
    const u16* Ag = A + (size_t)(m0 + lrow) * lda + lkc;
    const u16* Bg = Bt + (size_t)(n0 + lrow) * ldb + lkc;
#pragma unroll
    for (int i = 0; i < 4; ++i) ra[i] = *(const u32x4*)(Ag + (size_t)(64 * i) * lda);
#pragma unroll
    for (int i = 0; i < 2; ++i) rb[i] = *(const u32x4*)(Bg + (size_t)(64 * i) * ldb);
    __syncthreads();
#pragma unroll
    for (int i = 0; i < 4; ++i) *(u32x4*)(As + (lrow + 64 * i) * G_LD + lkc) = ra[i];
#pragma unroll
    for (int i = 0; i < 2; ++i) *(u32x4*)(Bs + (lrow + 64 * i) * G_LD + lkc) = rb[i];
    __syncthreads();
    for (int kt = 0; kt < nk; ++kt) {
      const int buf = kt & 1;
      if (kt + 1 < nk) {
#pragma unroll
        for (int i = 0; i < 4; ++i) ra[i] = *(const u32x4*)(Ag + (size_t)(64 * i) * lda + (kt + 1) * G_BK);
#pragma unroll
        for (int i = 0; i < 2; ++i) rb[i] = *(const u32x4*)(Bg + (size_t)(64 * i) * ldb + (kt + 1) * G_BK);
      }
      const u16* as = As + buf * (G_BM * G_LD);
      const u16* bs = Bs + buf * (G_BN * G_LD);
#pragma unroll
      for (int ks = 0; ks < 2; ++ks) {
        bf16x8 af[4], bfr[4];
#pragma unroll
        for (int mi = 0; mi < 4; ++mi) af[mi] = *(const bf16x8*)(as + (wr * 64 + mi * 16 + fr) * G_LD + ks * 32 + fq * 8);
#pragma unroll
        for (int ni = 0; ni < 4; ++ni) bfr[ni] = *(const bf16x8*)(bs + (wc * 64 + ni * 16 + fr) * G_LD + ks * 32 + fq * 8);
#pragma unroll
        for (int mi = 0; mi < 4; ++mi)
#pragma unroll
          for (int ni = 0; ni < 4; ++ni)
            acc[mi][ni] = __builtin_amdgcn_mfma_f32_16x16x32_bf16(af[mi], bfr[ni], acc[mi][ni], 0, 0, 0);
      }
      if (kt + 1 < nk) {
        u16* as2 = As + (buf ^ 1) * (G_BM * G_LD);
        u16* bs2 = Bs + (buf ^ 1) * (G_BN * G_LD);
#pragma unroll
        for (int i = 0; i < 4; ++i) *(u32x4*)(as2 + (lrow + 64 * i) * G_LD + lkc) = ra[i];
#pragma unroll
        for (int i = 0; i < 2; ++i) *(u32x4*)(bs2 + (lrow + 64 * i) * G_LD + lkc) = rb[i];
      }
      __syncthreads();
    }
#pragma unroll
    for (int mi = 0; mi < 4; ++mi)
#pragma unroll
      for (int ni = 0; ni < 4; ++ni) epi(m0 + wr * 64 + mi * 16 + fq * 4, n0 + wc * 64 + ni * 16 + fr, acc[mi][ni]);
  }
}

namespace pg8 {
#define PG8_LAS __attribute__((address_space(3)))
typedef unsigned short bf16_t;
typedef short bf16x8 __attribute__((ext_vector_type(8)));
typedef float f32x4 __attribute__((ext_vector_type(4)));
typedef unsigned u32x4 __attribute__((ext_vector_type(4)));
constexpr int BM = 256, BK = 64, HALF = 128, HTB = HALF * BK * 2  , STAGE_BYTES = 8 * HTB, NXCD = 8, WGM = 8;

__host__ __device__ __forceinline__ int lds_byte(int r, int c) { const int st = (r >> 4) * 2 + (c >> 5), rr = r & 15, cc = c & 31, ob = rr * 64 + cc * 2; return st * 1024 + (ob ^ (((ob >> 9) & 1) << 5)); }
__host__ __device__ __forceinline__ void stage_rc(int b, int& R, int& C) { const int st = b / 1024, sb = b % 1024, swz = sb ^ (((sb >> 9) & 1) << 5); R = (st >> 1) * 16 + swz / 64; C = (st & 1) * 32 + (swz % 64) / 2; }
__host__ __device__ __forceinline__ int perm32(int rho) { const int n = rho >> 4, i = rho & 15; return 8 * (i >> 2) + 4 * n + (i & 3); }

struct Unit { int pm, pn; };
struct Gemm { const bf16_t* A; const bf16_t* Bt; int M, N, K; };

struct StaticOrder {
    int nM, nN, nwg, G, c;
    __host__ __device__ void init(int M, int N, int G_, int c_) { nM = M / BM; nN = N / BM; nwg = nM * nN; G = G_; c = c_; }
    __host__ __device__ bool next(int i, Unit& u) const {
        const long L = (long)i * G + c; if (L >= nwg) return false;
        int wgid = (int)L; { const int q = nwg / NXCD, r = nwg % NXCD, xcd = wgid % NXCD, off = wgid / NXCD; wgid = (xcd < r ? xcd * (q + 1) : r * (q + 1) + (xcd - r) * q) + off; }
        const int nig = WGM * nN, gid = wgid / nig, fm = gid * WGM, gsz = (nM - fm) < WGM ? (nM - fm) : WGM;
        u.pm = fm + ((wgid % nig) % gsz); u.pn = (wgid % nig) / gsz; return true;
    }
    __device__ __forceinline__ void a_ready(const Unit&) const {}
    __device__ __forceinline__ void done(const Unit&) const {}
};
__device__ __forceinline__ unsigned cvt_pk_bf16(float lo, float hi) { return ::pack2(lo, hi); }
typedef float f32x2 __attribute__((ext_vector_type(2)));
template <class Epi, class Sched, bool STAMP = false>
__device__ __forceinline__ void gemm_phase(PG8_LAS unsigned char* lds, const Gemm g, const Sched& S, const Epi& E, unsigned long long* stamps) {
    const int tid = tidx(), wid = __builtin_amdgcn_readfirstlane(tid >> 6), lane = tid & 63, wr = wid >> 2, wc = wid & 3, fr = lane & 15, fq = lane >> 4;
    const int K = g.K, nt = K / BK;
    int ts_lo = 0, ts_hi = 0, nts = 0; const unsigned long long rt_entry = STAMP ? (unsigned long long)wall_clock64() : 0ull;
#define PG8_STAMP() do { if (STAMP && wid == 0 && nts < 64) { const unsigned long long _c = (unsigned long long)clock64(); \
        ts_lo = (lane == nts) ? (int)(unsigned)_c : ts_lo; ts_hi = (lane == nts) ? (int)(unsigned)(_c >> 32) : ts_hi; ++nts; } } while (0)
    PG8_STAMP();
    unsigned voffA[2], voffB[2];
#pragma unroll
    for (int i = 0; i < 2; ++i) { int R, C; stage_rc(tid * 16 + i * 8192, R, C); const int Rb = Epi::PERM ? ((R & ~31) + perm32(R & 31)) : R;
        voffA[i] = (unsigned)(R * K + C) * 2u; voffB[i] = (unsigned)(Rb * K + C) * 2u; }
    const size_t kstep = (size_t)(BK * 2);
    const size_t hstep = (size_t)HALF * K * 2;
    const size_t tstep = 2 * hstep;
    const unsigned ldsw = (unsigned)wid * 1024u;
    const int aoff = lds_byte(wr * 64 + fr, fq * 8), boff = lds_byte(wc * 32 + fr, fq * 8);
#define PG8_SA(b, h) (((b) * 2 + (h)) * HTB)
#define PG8_SB(b, h) ((4 + (b) * 2 + (h)) * HTB)
#define PG8_STAGE(bufoff, gbase, voff) do { _Pragma("unroll") for (int _i = 0; _i < 2; ++_i) \
        __builtin_amdgcn_global_load_lds((const unsigned*)((const char*)(gbase) + (voff)[_i]), (PG8_LAS unsigned*)(lds + (bufoff) + ldsw + _i * 8192), 16, 0, 0); } while (0)
#define PG8_LDA(dst, b, h) do { _Pragma("unroll") for (int m = 0; m < 4; ++m) _Pragma("unroll") for (int k = 0; k < 2; ++k) dst[m][k] = *(const PG8_LAS bf16x8*)(lds + PG8_SA(b, h) + aoff + m * 2048 + k * 1024); } while (0)
#define PG8_LDB(dst, b, h) do { _Pragma("unroll") for (int n = 0; n < 2; ++n) _Pragma("unroll") for (int k = 0; k < 2; ++k) dst[n][k] = *(const PG8_LAS bf16x8*)(lds + PG8_SB(b, h) + boff + n * 2048 + k * 1024); } while (0)
#define PG8_MMA(ai, bj, At, Bt) do { __builtin_amdgcn_s_setprio(1); _Pragma("unroll") for (int m = 0; m < 4; ++m) _Pragma("unroll") for (int n = 0; n < 2; ++n) _Pragma("unroll") for (int k = 0; k < 2; ++k) \
        acc[ai][bj][m][n] = __builtin_amdgcn_mfma_f32_16x16x32_bf16(Bt[n][k], At[m][k], acc[ai][bj][m][n], 0, 0, 0); __builtin_amdgcn_s_setprio(0); } while (0)
#define PG8_WAIT_V(n) asm volatile("s_waitcnt vmcnt(" #n ")" ::: "memory")
#define PG8_WAIT_L(n) asm volatile("s_waitcnt lgkmcnt(" #n ")" ::: "memory")
#define PG8_BAR __builtin_amdgcn_s_barrier()
#define PG8_SCHED __builtin_amdgcn_sched_barrier(0)
    Unit cur, nxt; int ui = 0;
    if (!S.next(0, cur)) return;
    f32x4 acc[2][2][4][2];
#pragma unroll
    for (int a = 0; a < 2; ++a)
#pragma unroll
        for (int b = 0; b < 2; ++b)
#pragma unroll
            for (int m = 0; m < 4; ++m)
#pragma unroll
                for (int n = 0; n < 2; ++n) acc[a][b][m][n] = (f32x4){0.f, 0.f, 0.f, 0.f};
    bf16x8 At[4][2], B0[2][2], B1[2][2];
    const char* cA = (const char*)g.A + (size_t)cur.pm * tstep; const char* cB = (const char*)g.Bt + (size_t)cur.pn * tstep;
    S.a_ready(cur);
    PG8_STAGE(PG8_SB(0, 0), cB, voffB); PG8_STAGE(PG8_SA(0, 0), cA, voffA); PG8_STAGE(PG8_SB(0, 1), cB + hstep, voffB); PG8_STAGE(PG8_SA(0, 1), cA + hstep, voffA);
    if (wr == 1) PG8_BAR;
    PG8_WAIT_V(4); PG8_BAR;
    PG8_STAGE(PG8_SB(1, 0), cB + kstep, voffB); PG8_STAGE(PG8_SA(1, 0), cA + kstep, voffA); PG8_STAGE(PG8_SB(1, 1), cB + hstep + kstep, voffB);
    PG8_WAIT_V(6); PG8_BAR;
    PG8_STAMP();
    for (;;) {
        const bool has_next = S.next(ui + 1, nxt);
        const char* nA = has_next ? (const char*)g.A + (size_t)nxt.pm * tstep : cA; const char* nB = has_next ? (const char*)g.Bt + (size_t)nxt.pn * tstep : cB;
        for (int t = 0; t < nt; t += 2) {
            const bool last = (t == nt - 2);
            const char* a1 = cA + (size_t)(t + 1) * kstep;
            const char* a2 = last ? nA : cA + (size_t)(t + 2) * kstep; const char* b2 = last ? nB : cB + (size_t)(t + 2) * kstep;
            const char* a3 = a2 + kstep; const char* b3 = b2 + kstep;
            if (last && has_next) S.a_ready(nxt);
            PG8_LDB(B0, 0, 0); PG8_SCHED; PG8_LDA(At, 0, 0); PG8_STAGE(PG8_SA(1, 1), a1 + hstep, voffA);
            PG8_WAIT_L(8); PG8_BAR; PG8_WAIT_L(0); PG8_MMA(0, 0, At, B0); PG8_BAR; PG8_SCHED;
            PG8_LDB(B1, 0, 1); PG8_STAGE(PG8_SB(0, 0), b2, voffB);
            PG8_BAR; PG8_WAIT_L(0); PG8_MMA(0, 1, At, B1); PG8_BAR;
            PG8_LDA(At, 0, 1); PG8_STAGE(PG8_SA(0, 0), a2, voffA);
            PG8_BAR; PG8_WAIT_L(0); PG8_MMA(1, 0, At, B0); PG8_BAR; PG8_SCHED;
            PG8_STAGE(PG8_SB(0, 1), b2 + hstep, voffB);
            PG8_WAIT_V(6); PG8_BAR; PG8_MMA(1, 1, At, B1); PG8_BAR;
            PG8_LDB(B0, 1, 0); PG8_SCHED; PG8_LDA(At, 1, 0); PG8_STAGE(PG8_SA(0, 1), a2 + hstep, voffA);
            PG8_WAIT_L(8); PG8_BAR; PG8_WAIT_L(0); PG8_MMA(0, 0, At, B0); PG8_BAR; PG8_SCHED;
            PG8_LDB(B1, 1, 1); PG8_STAGE(PG8_SB(1, 0), b3, voffB);
            PG8_BAR; PG8_WAIT_L(0); PG8_MMA(0, 1, At, B1); PG8_BAR;
            PG8_LDA(At, 1, 1); PG8_STAGE(PG8_SA(1, 0), a3, voffA);
            PG8_BAR; PG8_WAIT_L(0); PG8_MMA(1, 0, At, B0); PG8_BAR; PG8_SCHED;
            PG8_STAGE(PG8_SB(1, 1), b3 + hstep, voffB);
            PG8_WAIT_V(6); PG8_BAR; PG8_MMA(1, 1, At, B1); PG8_BAR;
        }
        PG8_STAMP();
        if constexpr (!Epi::AFTER_DRAIN) { E(acc, cur, wr, wc, fr, fq); S.done(cur); }
        PG8_STAMP();
        if (!has_next) break;
#pragma unroll
        for (int a = 0; a < 2; ++a)
#pragma unroll
            for (int b = 0; b < 2; ++b)
#pragma unroll
                for (int m = 0; m < 4; ++m)
#pragma unroll
                    for (int n = 0; n < 2; ++n) acc[a][b][m][n] = (f32x4){0.f, 0.f, 0.f, 0.f};
        cur = nxt; cA = nA; cB = nB; ++ui;
    }
    PG8_WAIT_V(0);
    if (wr == 0) PG8_BAR;
    PG8_BAR;
    if constexpr (Epi::AFTER_DRAIN) { E.fused(acc, cur, wr, wc, fr, fq, lds, wid, lane); S.done(cur); }
    PG8_STAMP();
    if (STAMP && wid == 0) { stamps[lane] = lane < nts ? (((unsigned long long)(unsigned)ts_hi << 32) | (unsigned)ts_lo) : 0ull;
        if (lane == 62) stamps[62] = rt_entry; if (lane == 63) stamps[63] = (unsigned long long)wall_clock64(); }
#undef PG8_STAMP
#undef PG8_SA
#undef PG8_SB
#undef PG8_STAGE
#undef PG8_LDA
#undef PG8_LDB
#undef PG8_MMA
#undef PG8_WAIT_V
#undef PG8_WAIT_L
#undef PG8_BAR
#undef PG8_SCHED
}
}

namespace pg8 {
struct EpiProjT {
  static constexpr bool PERM = true, AFTER_DRAIN = false;
  bf16_t* O; int ldc; int ncols;
  __device__ __forceinline__ void operator()(const f32x4 (&acc)[2][2][4][2], const Unit& u, int wr, int wc, int fr, int fq) const {
    const int row0 = u.pm * BM + wr * 64 + fr, col0 = u.pn * BM + wc * 32 + 8 * fq;
#pragma unroll
    for (int ai = 0; ai < 2; ++ai)
#pragma unroll
      for (int m = 0; m < 4; ++m) {
        bf16_t* rowp = O + (size_t)(row0 + ai * HALF + m * 16) * ldc + col0;
#pragma unroll
        for (int bj = 0; bj < 2; ++bj) {
          if (col0 + bj * HALF < ncols) {
            const f32x4 v0 = acc[ai][bj][m][0], v1 = acc[ai][bj][m][1];
            u32x4 w; w.x = cvt_pk_bf16(v0[0], v0[1]); w.y = cvt_pk_bf16(v0[2], v0[3]); w.z = cvt_pk_bf16(v1[0], v1[1]); w.w = cvt_pk_bf16(v1[2], v1[3]);
            *(u32x4*)(rowp + bj * HALF) = w;
          }
        }
      }
  }
};
struct EpiGluT {
  static constexpr bool PERM = true, AFTER_DRAIN = false;
  const bf16_t* Y1; const float* bglu; bf16_t* O;
  __device__ __forceinline__ void operator()(const f32x4 (&acc)[2][2][4][2], const Unit& u, int wr, int wc, int fr, int fq) const {
    const int row0 = u.pm * BM + wr * 64 + fr, col0 = u.pn * BM + wc * 32 + 8 * fq;
    f32x4 bv[2][2];
#pragma unroll
    for (int bj = 0; bj < 2; ++bj)
#pragma unroll
      for (int n = 0; n < 2; ++n) bv[bj][n] = *(const f32x4*)(bglu + col0 + bj * HALF + 4 * n);
#pragma unroll
    for (int ai = 0; ai < 2; ++ai)
#pragma unroll
      for (int m = 0; m < 4; ++m) {
        const size_t r = (size_t)(row0 + ai * HALF + m * 16);
#pragma unroll
        for (int bj = 0; bj < 2; ++bj) {
          const u32x4 yv = *(const u32x4*)(Y1 + r * 512 + col0 + bj * HALF);
          const f32x4 v0 = acc[ai][bj][m][0] + bv[bj][0], v1 = acc[ai][bj][m][1] + bv[bj][1];
          float o[8];
#pragma unroll
          for (int q = 0; q < 4; ++q) {
            const float ylo = __uint_as_float(yv[q] << 16), yhi = __uint_as_float(yv[q] & 0xffff0000u);
            const float a0 = q < 2 ? v0[2 * q] : v1[2 * q - 4], a1 = q < 2 ? v0[2 * q + 1] : v1[2 * q - 3];
            o[2 * q] = ylo / (1.f + __expf(-a0));
            o[2 * q + 1] = yhi / (1.f + __expf(-a1));
          }
          u32x4 w; w.x = cvt_pk_bf16(o[0], o[1]); w.y = cvt_pk_bf16(o[2], o[3]); w.z = cvt_pk_bf16(o[4], o[5]); w.w = cvt_pk_bf16(o[6], o[7]);
          *(u32x4*)(O + r * 1024 + col0 + bj * HALF) = w;
        }
      }
  }
};
struct EpiGateT {
  static constexpr bool PERM = true, AFTER_DRAIN = false;
  const bf16_t* T1; bf16_t* O;
  __device__ __forceinline__ void operator()(const f32x4 (&acc)[2][2][4][2], const Unit& u, int wr, int wc, int fr, int fq) const {
    const int row0 = u.pm * BM + wr * 64 + fr, col0 = u.pn * BM + wc * 32 + 8 * fq;
#pragma unroll
    for (int ai = 0; ai < 2; ++ai)
#pragma unroll
      for (int m = 0; m < 4; ++m) {
        const size_t r = (size_t)(row0 + ai * HALF + m * 16);
#pragma unroll
        for (int bj = 0; bj < 2; ++bj) {
          const u32x4 tv = *(const u32x4*)(T1 + r * 512 + col0 + bj * HALF);
          const f32x4 v0 = acc[ai][bj][m][0], v1 = acc[ai][bj][m][1];
          u32x4 w;
          w.x = cvt_pk_bf16(__uint_as_float(tv[0] << 16) * v0[0], __uint_as_float(tv[0] & 0xffff0000u) * v0[1]);
          w.y = cvt_pk_bf16(__uint_as_float(tv[1] << 16) * v0[2], __uint_as_float(tv[1] & 0xffff0000u) * v0[3]);
          w.z = cvt_pk_bf16(__uint_as_float(tv[2] << 16) * v1[0], __uint_as_float(tv[2] & 0xffff0000u) * v1[1]);
          w.w = cvt_pk_bf16(__uint_as_float(tv[3] << 16) * v1[2], __uint_as_float(tv[3] & 0xffff0000u) * v1[3]);
          *(u32x4*)(O + r * 1024 + 512 + col0 + bj * HALF) = w;
        }
      }
  }
};
struct EpiWoutT {
  static constexpr bool PERM = false, AFTER_DRAIN = false;
  const float* X; const float* mod; float* H2;
  __device__ __forceinline__ void operator()(const f32x4 (&acc)[2][2][4][2], const Unit& u, int wr, int wc, int fr, int fq) const {
    const int row0 = u.pm * BM + wr * 64 + fr, col0 = u.pn * BM + wc * 32 + 4 * fq;
    const float* g1p = mod + ((u.pm * BM) >> 11) * 6144 + 2 * 1024 + col0;
    f32x4 gv[2][2];
#pragma unroll
    for (int bj = 0; bj < 2; ++bj)
#pragma unroll
      for (int n = 0; n < 2; ++n) gv[bj][n] = *(const f32x4*)(g1p + bj * HALF + n * 16);
#pragma unroll
    for (int ai = 0; ai < 2; ++ai)
#pragma unroll
      for (int m = 0; m < 4; ++m) {
        const size_t off = (size_t)(row0 + ai * HALF + m * 16) * 1024 + col0;
#pragma unroll
        for (int bj = 0; bj < 2; ++bj)
#pragma unroll
          for (int n = 0; n < 2; ++n) {
            const f32x4 xv = *(const f32x4*)(X + off + bj * HALF + n * 16);
            *(f32x4*)(H2 + off + bj * HALF + n * 16) = xv + gv[bj][n] * acc[ai][bj][m][n];
          }
      }
  }
};
}

struct EpiProj {
  u16* proj;
  __device__ __forceinline__ void operator()(int r, int c, f32x4 v) const {
    if (c < INC) {
#pragma unroll
      for (int j = 0; j < 4; ++j) proj[(size_t)(r + j) * INC + c] = f2bf(v[j]);
    }
  }
};
struct EpiGlu {
  const u16* y1; const float* bglu; u16* a2;
  __device__ __forceinline__ void operator()(int r, int c, f32x4 v) const {
    float bb = bglu[c];
#pragma unroll
    for (int j = 0; j < 4; ++j) {
      float y = bf2f(y1[(size_t)(r + j) * 512 + c]);
      a2[(size_t)(r + j) * 1024 + c] = f2bf(y * sigmoidf(v[j] + bb));
    }
  }
};
struct EpiGate {
  const u16* t1; u16* a2;
  __device__ __forceinline__ void operator()(int r, int c, f32x4 v) const {
#pragma unroll
    for (int j = 0; j < 4; ++j) {
      float t = bf2f(t1[(size_t)(r + j) * 512 + c]);
      a2[(size_t)(r + j) * 1024 + 512 + c] = f2bf(t * v[j]);
    }
  }
};
struct EpiWout {
  const float* x; const float* mod; float* h2;
  __device__ __forceinline__ void operator()(int r, int c, f32x4 v) const {
    float g1 = mod[(r >> 11) * 6144 + 2 * 1024 + c];
#pragma unroll
    for (int j = 0; j < 4; ++j) h2[(size_t)(r + j) * 1024 + c] = x[(size_t)(r + j) * 1024 + c] + g1 * v[j];
  }
};
struct EpiQ {
  u16* q;
  __device__ __forceinline__ void operator()(int r, int c, f32x4 v) const {
#pragma unroll
    for (int j = 0; j < 4; ++j) q[(size_t)(r + j) * 2048 + c] = f2bf(v[j]);
  }
};

__device__ __forceinline__ void ph_s5scan(const P& p, char* smem, int bid, int nb) {
  const int wid = tidx() >> 6, lane = tidx() & 63;
  float* U = (float*)(smem + wid * 8448);
  unsigned* H = (unsigned*)((char*)U + 4096);
  const int fr = lane & 15, fq = lane >> 4;
  for (int s = bid * 8 + wid; s < 2048; s += nb * 8) {
    const int g = s & 31, d = (s >> 5) & 1, b = s >> 6;
    const int ci = (d * 32 + g) * 64 + lane;
    const float abr = p.s5ab()[ci * 2], abi = p.s5ab()[ci * 2 + 1];
    float bbr[16], bbi[16];
#pragma unroll
    for (int q = 0; q < 4; ++q) {
      float4 t = *(const float4*)(p.s5bb() + (size_t)ci * 32 + q * 4);
      bbr[q * 4] = t.x; bbr[q * 4 + 1] = t.y; bbr[q * 4 + 2] = t.z; bbr[q * 4 + 3] = t.w;
      float4 t2 = *(const float4*)(p.s5bb() + (size_t)ci * 32 + 16 + q * 4);
      bbi[q * 4] = t2.x; bbi[q * 4 + 1] = t2.y; bbi[q * 4 + 2] = t2.z; bbi[q * 4 + 3] = t2.w;
    }
    bf16x8 cf[4];
#pragma unroll
    for (int kb = 0; kb < 4; ++kb)
      cf[kb] = *(const bf16x8*)(p.s5ct() + ((size_t)(d * 32 + g) * 16 + fr) * 128 + kb * 32 + fq * 8);
    const float dcoef = p.s5_d[g * 16 + fr];
    u16* ydst = d ? p.ys5b() : p.ys5f();
    float hr = 0.f, hi = 0.f;
    for (int seg = 0; seg < 2; ++seg) {
      const int L = seg ? 2048 : 256;
      const int rowbase = seg ? b * 2048 : NLAT + b * 256;
      for (int c0 = 0; c0 < L; c0 += 64) {
        {
          int pos = c0 + lane;
          int t = d ? (L - 1 - pos) : pos;
          const u16* src = p.proj() + (size_t)(rowbase + t) * INC + g * 16;
          uint4 v0 = *(const uint4*)src, v1 = *(const uint4*)(src + 8);
          float4* ud = (float4*)(U + lane * 16);
          ud[0] = make_float4(bflo(v0.x), bfhi(v0.x), bflo(v0.y), bfhi(v0.y));
          ud[1] = make_float4(bflo(v0.z), bfhi(v0.z), bflo(v0.w), bfhi(v0.w));
          ud[2] = make_float4(bflo(v1.x), bfhi(v1.x), bflo(v1.y), bfhi(v1.y));
          ud[3] = make_float4(bflo(v1.z), bfhi(v1.z), bflo(v1.w), bfhi(v1.w));
        }
        for (int sub = 0; sub < 4; ++sub) {
#pragma unroll 4
          for (int i = 0; i < 16; ++i) {
            const float4* up = (const float4*)(U + (sub * 16 + i) * 16);
            float4 u0 = up[0], u1 = up[1], u2 = up[2], u3 = up[3];
            float ur[16] = {u0.x, u0.y, u0.z, u0.w, u1.x, u1.y, u1.z, u1.w, u2.x, u2.y, u2.z, u2.w, u3.x, u3.y, u3.z, u3.w};
            float br0 = 0.f, br1 = 0.f, bi0 = 0.f, bi1 = 0.f;
#pragma unroll
            for (int h = 0; h < 16; h += 2) {
              br0 += bbr[h] * ur[h]; br1 += bbr[h + 1] * ur[h + 1];
              bi0 += bbi[h] * ur[h]; bi1 += bbi[h + 1] * ur[h + 1];
            }
            float nr = abr * hr - abi * hi + (br0 + br1);
            float ni = abr * hi + abi * hr + (bi0 + bi1);
            hr = nr; hi = ni;
            if (seg) H[i * 68 + lane] = pack2(hr, hi);
          }
          if (seg) {
            f32x4 acc = (f32x4){0.f, 0.f, 0.f, 0.f};
#pragma unroll
            for (int kb = 0; kb < 4; ++kb) {
              bf16x8 a = *(const bf16x8*)((const u16*)H + fr * 136 + kb * 32 + fq * 8);
              acc = __builtin_amdgcn_mfma_f32_16x16x32_bf16(a, cf[kb], acc, 0, 0, 0);
            }
#pragma unroll
            for (int j = 0; j < 4; ++j) {
              int pi = sub * 16 + fq * 4 + j;
              int pos = c0 + pi;
              int t = d ? (L - 1 - pos) : pos;
              float y = acc[j];
              if (d == 0) y += dcoef * U[pi * 16 + fr];
              ydst[(size_t)(b * 2048 + t) * 512 + g * 16 + fr] = f2bf(y);
            }
          }
        }
      }
    }
  }
}

#define S5_LD 168
__device__ __forceinline__ void ph_s5scan2(const P& p, char* smem, int bid, int nb) {
  const int wid = tidx() >> 6, lane = tidx() & 63;
  u16* H = (u16*)(smem + wid * (32 * S5_LD * 2));
  const int n = lane & 31, hh = lane >> 5, fr = lane & 15, fq = lane >> 4;
  for (int r = lane; r < 32; r += 64) {
    *(uint4*)(H + r * S5_LD + 144) = make_uint4(0u, 0u, 0u, 0u);
    *(uint4*)(H + r * S5_LD + 152) = make_uint4(0u, 0u, 0u, 0u);
    *(uint4*)(H + r * S5_LD + 160) = make_uint4(0u, 0u, 0u, 0u);
  }
  for (int s = bid * 8 + wid; s < 2048; s += nb * 8) {
    const int g = s & 31, d = (s >> 5) & 1, b = s >> 6;
    float ar[2][4], ai[2][4], a8r[2], a8i[2];
#pragma unroll
    for (int st = 0; st < 2; ++st) {
      const int ci = (d * 32 + g) * 64 + st * 32 + n;
      const float xr = p.s5ab()[ci * 2], xi = p.s5ab()[ci * 2 + 1];
      ar[st][0] = xr; ai[st][0] = xi;
#pragma unroll
      for (int k = 1; k < 4; ++k) {
        ar[st][k] = ar[st][k - 1] * xr - ai[st][k - 1] * xi;
        ai[st][k] = ar[st][k - 1] * xi + ai[st][k - 1] * xr;
      }
      a8r[st] = ar[st][3] * ar[st][3] - ai[st][3] * ai[st][3];
      a8i[st] = 2.f * ar[st][3] * ai[st][3];
    }
    bf16x8 bfr[4];
#pragma unroll
    for (int nt = 0; nt < 4; ++nt) {
      const int ci = (d * 32 + g) * 64 + (nt & 1) * 32 + n;
      const float4 t0 = *(const float4*)(p.s5bb() + (size_t)ci * 32 + (nt >> 1) * 16 + 8 * hh);
      const float4 t1 = *(const float4*)(p.s5bb() + (size_t)ci * 32 + (nt >> 1) * 16 + 8 * hh + 4);
      union { unsigned u[4]; bf16x8 v; } t;
      t.u[0] = pack2(t0.x, t0.y); t.u[1] = pack2(t0.z, t0.w); t.u[2] = pack2(t1.x, t1.y); t.u[3] = pack2(t1.z, t1.w);
      bfr[nt] = t.v;
    }
    bf16x8 cf[5];
#pragma unroll
    for (int kb = 0; kb < 4; ++kb)
      cf[kb] = *(const bf16x8*)(p.s5ct() + ((size_t)(d * 32 + g) * 16 + fr) * 128 + kb * 32 + fq * 8);
    {
      const float dv = (d == 0) ? p.s5_d[g * 16 + fr] : 0.f;
      union { u16 h[8]; bf16x8 v; } t;
#pragma unroll
      for (int j = 0; j < 8; ++j) t.h[j] = (8 * fq + j == fr) ? f2bf(dv) : (u16)0;
      cf[4] = t.v;
    }
    u16* ydst = d ? p.ys5b() : p.ys5f();
    float hcr[2] = {0.f, 0.f}, hci[2] = {0.f, 0.f};
    for (int seg = 0; seg < 2; ++seg) {
      const int L = seg ? 2048 : 256;
      const int rowbase = seg ? b * 2048 : NLAT + b * 256;
      uint4 anext;
      {
        const int pos = n;
        const int t = d ? (L - 1 - pos) : pos;
        anext = *(const uint4*)(p.proj() + (size_t)(rowbase + t) * INC + g * 16 + 8 * hh);
      }
      for (int c0 = 0; c0 < L; c0 += 32) {
        const uint4 acur = anext;
        if (c0 + 32 < L) {
          const int pos = c0 + 32 + n;
          const int t = d ? (L - 1 - pos) : pos;
          anext = *(const uint4*)(p.proj() + (size_t)(rowbase + t) * INC + g * 16 + 8 * hh);
        }
        union { uint4 q; bf16x8 v; } af;
        af.q = acur;
        f32x16 acc[4];
#pragma unroll
        for (int nt = 0; nt < 4; ++nt) {
          f32x16 z;
#pragma unroll
          for (int r = 0; r < 16; ++r) z[r] = 0.f;
          acc[nt] = __builtin_amdgcn_mfma_f32_32x32x16_bf16(af.v, bfr[nt], z, 0, 0, 0);
        }
#pragma unroll
        for (int st = 0; st < 2; ++st)
#pragma unroll
          for (int gg = 0; gg < 4; ++gg)
#pragma unroll
            for (int j = 1; j < 4; ++j) {
              const float pr = acc[st][4 * gg + j - 1], pi = acc[2 + st][4 * gg + j - 1];
              acc[st][4 * gg + j] += ar[st][0] * pr - ai[st][0] * pi;
              acc[2 + st][4 * gg + j] += ar[st][0] * pi + ai[st][0] * pr;
            }
        float sr[2][4], si[2][4];
        {
          float e0r[2][4], e0i[2][4], qpr[2][4], qpi[2][4], s1r[2][4], s1i[2][4];
#pragma unroll
          for (int st = 0; st < 2; ++st)
#pragma unroll
            for (int gg = 0; gg < 4; ++gg) {
              e0r[st][gg] = __shfl_xor(acc[st][4 * gg + 3], 32, 64);
              e0i[st][gg] = __shfl_xor(acc[2 + st][4 * gg + 3], 32, 64);
            }
#pragma unroll
          for (int st = 0; st < 2; ++st) {
            float qr = hcr[st], qi = hci[st];
#pragma unroll
            for (int gg = 0; gg < 4; ++gg) {
              const float er = acc[st][4 * gg + 3], ei = acc[2 + st][4 * gg + 3];
              qpr[st][gg] = qr; qpi[st][gg] = qi;
              s1r[st][gg] = ar[st][3] * qr - ai[st][3] * qi + e0r[st][gg];
              s1i[st][gg] = ar[st][3] * qi + ai[st][3] * qr + e0i[st][gg];
              const float nqr = ar[st][3] * s1r[st][gg] - ai[st][3] * s1i[st][gg] + er;
              const float nqi = ar[st][3] * s1i[st][gg] + ai[st][3] * s1r[st][gg] + ei;
              qr = nqr; qi = nqi;
            }
            hcr[st] = qr; hci[st] = qi;
          }
#pragma unroll
          for (int st = 0; st < 2; ++st)
#pragma unroll
            for (int gg = 0; gg < 4; ++gg) {
              const float s0r = __shfl_xor(qpr[st][gg], 32, 64), s0i = __shfl_xor(qpi[st][gg], 32, 64);
              sr[st][gg] = hh ? s1r[st][gg] : s0r;
              si[st][gg] = hh ? s1i[st][gg] : s0i;
            }
        }
        if (seg) {
#pragma unroll
          for (int st = 0; st < 2; ++st)
#pragma unroll
            for (int gg = 0; gg < 4; ++gg)
#pragma unroll
              for (int j = 0; j < 4; ++j) {
                const float hr_ = acc[st][4 * gg + j] + ar[st][j] * sr[st][gg] - ai[st][j] * si[st][gg];
                const float hi_ = acc[2 + st][4 * gg + j] + ar[st][j] * si[st][gg] + ai[st][j] * sr[st][gg];
                const int tok = 8 * gg + 4 * hh + j;
                *(unsigned*)(H + tok * S5_LD + 2 * (st * 32 + n)) = pack2(hr_, hi_);
              }
          *(uint4*)(H + n * S5_LD + 128 + 8 * hh) = acur;
#pragma unroll
          for (int mt = 0; mt < 2; ++mt) {
            f32x4 y = (f32x4){0.f, 0.f, 0.f, 0.f};
#pragma unroll
            for (int kb = 0; kb < 5; ++kb) {
              const bf16x8 a = *(const bf16x8*)(H + (16 * mt + fr) * S5_LD + kb * 32 + fq * 8);
              y = __builtin_amdgcn_mfma_f32_16x16x32_bf16(a, cf[kb], y, 0, 0, 0);
            }
#pragma unroll
            for (int j = 0; j < 4; ++j) {
              const int pos = c0 + 16 * mt + 4 * fq + j;
              const int t = d ? (L - 1 - pos) : pos;
              ydst[(size_t)(b * 2048 + t) * 512 + g * 16 + fr] = f2bf(y[j]);
            }
          }
        }
      }
    }
  }
}

__device__ __forceinline__ float4 mix_load4(const u16* __restrict__ proj, size_t row, int col, const size_t* nrow,
                                            const bool* nval, float4 mu) {
  uint2 cz = *(const uint2*)(proj + row * INC + col);
  float z[4] = {bflo(cz.x), bfhi(cz.x), bflo(cz.y), bfhi(cz.y)};
  float o[4];
  float m[4] = {mu.x, mu.y, mu.z, mu.w};
#pragma unroll
  for (int j = 0; j < 4; ++j) {
    float nbv = 0.f;
    if (nval[j]) {
      u16 t = proj[nrow[j] * INC + col + j];
      nbv = bf2f(t);
    }
    o[j] = z[j] + (nbv - z[j]) * m[j];
  }
  return make_float4(o[0], o[1], o[2], o[3]);
}
__device__ __forceinline__ void neighbours(bool isctx, size_t row, int t, size_t* nrow, bool* nval) {
  if (isctx) {
    nrow[0] = row - 1; nval[0] = t > 0;
    nrow[1] = row + 1; nval[1] = t < 255;
    nrow[2] = row - 1; nval[2] = t > 0;
    nrow[3] = row + 1; nval[3] = t < 255;
  } else {
    int col = t & 63, gr = t >> 6;
    nrow[0] = row - 1; nval[0] = col > 0;
    nrow[1] = row + 1; nval[1] = col < 63;
    nrow[2] = row - 64; nval[2] = gr > 0;
    nrow[3] = row + 64; nval[3] = gr < 31;
  }
}

__device__ __forceinline__ void ph_rwscan(const P& p, char* smem, int bid, int nb) {
  const int tid = tidx(), sl = tid >> 8, stid = tid & 255, wv = stid >> 6, lane = tid & 63;
  char* sb = smem + sl * 49152;
  float* OPS = (float*)sb;
  float* LW = (float*)(sb + 24576);
  float* LA = LW + 512;
  float* WW = (float*)(sb + 28672);
  float* WA = WW + 2048;
  float* YB = (float*)(sb + 45056);
  const int tt = stid >> 4, part = stid & 15;
  const int vrow = wv * 16 + (lane >> 2), kq = lane & 3;
  for (int sp = bid; sp < 256; sp += nb) {
    const int s = sp * 2 + sl;
    const int d = s & 1, h = (s >> 1) & 7, b = s >> 4;
    __syncthreads();
    for (int e = stid; e < 2048; e += 256) {
      int j = e >> 6, cc = e & 63;
      WW[e] = p.rw_w_w2[(size_t)(d * 32 + j) * 512 + h * 64 + cc];
      WA[e] = p.rw_w_a2[(size_t)(d * 32 + j) * 512 + h * 64 + cc];
    }
    const int hc = h * 64 + part * 4;
    const float4 w0v = *(const float4*)(p.rw_w0 + d * 512 + hc);
    const float4 a0v = *(const float4*)(p.rw_a0 + d * 512 + hc);
    const float4 kkv = *(const float4*)(p.rw_k_k + hc);
    const float4 kav = *(const float4*)(p.rw_k_a + hc);
    const float4 rkv = *(const float4*)(p.rw_r_k + hc);
    const float4 mur = *(const float4*)(p.rw_mu + hc);
    const float4 muk = *(const float4*)(p.rw_mu + 512 + hc);
    const float4 muv = *(const float4*)(p.rw_mu + 1024 + hc);
    const float4 mul = *(const float4*)(p.rw_mu + 1536 + part * 4);
    u16* ydst = d ? p.yrwb() : p.yrwf();
    float S[16];
#pragma unroll
    for (int i = 0; i < 16; ++i) S[i] = 0.f;
    for (int seg = 0; seg < 2; ++seg) {
      const int L = seg ? 2048 : 256;
      const size_t rowbase = seg ? (size_t)b * 2048 : (size_t)NLAT + b * 256;
      for (int c0 = 0; c0 < L; c0 += 16) {
        const int pos = c0 + tt;
        const int t = d ? (L - 1 - pos) : pos;
        const size_t row = rowbase + t;
        size_t nrow[4];
        bool nval[4];
        neighbours(seg == 0, row, t, nrow, nval);
        float4 r4 = mix_load4(p.proj(), row, 512 + hc, nrow, nval, mur);
        float4 k4 = mix_load4(p.proj(), row, 512 + 512 + hc, nrow, nval, muk);
        float4 v4 = mix_load4(p.proj(), row, 512 + 1024 + hc, nrow, nval, muv);
        float4 l4 = mix_load4(p.proj(), row, 512 + 1536 + part * 4, nrow, nval, mul);
        if (part < 8) {
          *(float4*)(LW + tt * 32 + part * 4) = make_float4(tanhf(l4.x), tanhf(l4.y), tanhf(l4.z), tanhf(l4.w));
        } else {
          *(float4*)(LA + tt * 32 + (part - 8) * 4) = l4;
        }
        __syncthreads();
        float wp[4] = {w0v.x, w0v.y, w0v.z, w0v.w};
        float ap[4] = {a0v.x, a0v.y, a0v.z, a0v.w};
#pragma unroll 8
        for (int j = 0; j < 32; ++j) {
          float lw = LW[tt * 32 + j], la = LA[tt * 32 + j];
          float4 ww = *(const float4*)(WW + j * 64 + part * 4);
          float4 wa = *(const float4*)(WA + j * 64 + part * 4);
          wp[0] += lw * ww.x; wp[1] += lw * ww.y; wp[2] += lw * ww.z; wp[3] += lw * ww.w;
          ap[0] += la * wa.x; ap[1] += la * wa.y; ap[2] += la * wa.z; ap[3] += la * wa.w;
        }
        float rr[4] = {r4.x, r4.y, r4.z, r4.w}, kk4[4] = {k4.x, k4.y, k4.z, k4.w};
        float kkc[4] = {kkv.x, kkv.y, kkv.z, kkv.w}, kac[4] = {kav.x, kav.y, kav.z, kav.w}, rkc[4] = {rkv.x, rkv.y, rkv.z, rkv.w};
        float dec[4], aa[4], kd[4], kkr[4];
        float ss = 0.f, bon = 0.f;
#pragma unroll
        for (int i = 0; i < 4; ++i) {
          float xw = -wp[i];
          float sp_ = fmaxf(xw, 0.f) + log1pf(expf(-fabsf(xw)));
          float wl = -sp_ - 0.5f;
          dec[i] = expf(-expf(wl));
          aa[i] = 1.f / (1.f + expf(-ap[i]));
          kd[i] = kk4[i] * (1.f + (aa[i] - 1.f) * kac[i]);
          kkr[i] = kk4[i] * kkc[i];
          ss += kkr[i] * kkr[i];
          bon += rr[i] * kd[i] * rkc[i];
        }
#pragma unroll
        for (int m = 0; m < 4; ++m) {
          ss = dpp_add(ss, m, 0);
          bon = dpp_add(bon, m, 0);
        }
        float inv = rsqrtf(ss + 1e-12f);
        float* o = OPS + tt * 384 + part * 4;
        *(float4*)(o + 0) = r4;
        *(float4*)(o + 64) = make_float4(dec[0], dec[1], dec[2], dec[3]);
        *(float4*)(o + 128) = make_float4(kd[0], kd[1], kd[2], kd[3]);
        *(float4*)(o + 192) = make_float4(-kkr[0] * inv, -kkr[1] * inv, -kkr[2] * inv, -kkr[3] * inv);
        *(float4*)(o + 256) = make_float4(kkr[0] * inv * aa[0], kkr[1] * inv * aa[1], kkr[2] * inv * aa[2], kkr[3] * inv * aa[3]);
        *(float4*)(o + 320) = v4;
        if (seg && part == 0) p.bsc()[((size_t)d * NLAT + row) * 8 + h] = bon;
        __syncthreads();
        for (int i = 0; i < 16; ++i) {
          const float* oo = OPS + i * 384 + kq * 16;
          float kn[16], wv_[16], bv[16], kdv[16];
#pragma unroll
          for (int q = 0; q < 4; ++q) {
            float4 a = *(const float4*)(oo + 192 + q * 4);
            kn[q * 4] = a.x; kn[q * 4 + 1] = a.y; kn[q * 4 + 2] = a.z; kn[q * 4 + 3] = a.w;
            float4 w_ = *(const float4*)(oo + 64 + q * 4);
            wv_[q * 4] = w_.x; wv_[q * 4 + 1] = w_.y; wv_[q * 4 + 2] = w_.z; wv_[q * 4 + 3] = w_.w;
            float4 b_ = *(const float4*)(oo + 256 + q * 4);
            bv[q * 4] = b_.x; bv[q * 4 + 1] = b_.y; bv[q * 4 + 2] = b_.z; bv[q * 4 + 3] = b_.w;
            float4 k_ = *(const float4*)(oo + 128 + q * 4);
            kdv[q * 4] = k_.x; kdv[q * 4 + 1] = k_.y; kdv[q * 4 + 2] = k_.z; kdv[q * 4 + 3] = k_.w;
          }
          float vv = OPS[i * 384 + 320 + vrow];
          float s0 = 0.f, s1 = 0.f, s2 = 0.f, s3 = 0.f;
#pragma unroll
          for (int q = 0; q < 16; q += 4) {
            s0 += S[q] * kn[q]; s1 += S[q + 1] * kn[q + 1]; s2 += S[q + 2] * kn[q + 2]; s3 += S[q + 3] * kn[q + 3];
          }
          float sa = (s0 + s1) + (s2 + s3);
          sa = dpp_add(sa, 0, 0);
          sa = dpp_add(sa, 1, 0);
#pragma unroll
          for (int q = 0; q < 16; ++q) S[q] = S[q] * wv_[q] + sa * bv[q] + vv * kdv[q];
          if (seg) {
            float rv[16];
#pragma unroll
            for (int q = 0; q < 4; ++q) {
              float4 a = *(const float4*)(oo + q * 4);
              rv[q * 4] = a.x; rv[q * 4 + 1] = a.y; rv[q * 4 + 2] = a.z; rv[q * 4 + 3] = a.w;
            }
            float y0 = 0.f, y1 = 0.f, y2 = 0.f, y3 = 0.f;
#pragma unroll
            for (int q = 0; q < 16; q += 4) {
              y0 += S[q] * rv[q]; y1 += S[q + 1] * rv[q + 1]; y2 += S[q + 2] * rv[q + 2]; y3 += S[q + 3] * rv[q + 3];
            }
            float y = (y0 + y1) + (y2 + y3);
            y = dpp_add(y, 0, 0);
            y = dpp_add(y, 1, 0);
            if (kq == 0) YB[i * 64 + vrow] = y;
          }
        }
        __syncthreads();
        if (seg) {
          float4 yv = *(const float4*)(YB + tt * 64 + part * 4);
          uint2 o2;
          o2.x = pack2(yv.x, yv.y); o2.y = pack2(yv.z, yv.w);
          *(uint2*)(ydst + row * 512 + hc) = o2;
        }
      }
    }
  }
}

#define LAS __attribute__((address_space(3)))
#define RW_AR_LD 68
#define RW_RM_LD 72
#define RW_SLOT_BYTES 13824
#define RW_SCR_BYTES 6912
#define RW_STREAM_BYTES (4 * RW_SLOT_BYTES + 3 * RW_SCR_BYTES + 2304 + 64)
__device__ __forceinline__ unsigned cvtpk(float lo, float hi) { return pack2(lo, hi); }
__device__ __forceinline__ float dpp_shr_add(float v, const int n) {
  int m;
  switch (n) {
    case 1: m = __builtin_amdgcn_update_dpp(0, __float_as_int(v), 0x111, 0xf, 0xf, true); break;
    case 2: m = __builtin_amdgcn_update_dpp(0, __float_as_int(v), 0x112, 0xf, 0xf, true); break;
    case 4: m = __builtin_amdgcn_update_dpp(0, __float_as_int(v), 0x114, 0xf, 0xf, true); break;
    default: m = __builtin_amdgcn_update_dpp(0, __float_as_int(v), 0x118, 0xf, 0xf, true); break;
  }
  return v + __int_as_float(m);
}
__device__ __forceinline__ unsigned dpp_row_shr1(unsigned old, unsigned v) { return (unsigned)__builtin_amdgcn_update_dpp((int)old, (int)v, 0x111, 0xf, 0xf, false); }
__device__ __forceinline__ unsigned dpp_row_shl1(unsigned old, unsigned v) { return (unsigned)__builtin_amdgcn_update_dpp((int)old, (int)v, 0x101, 0xf, 0xf, false); }
__device__ __forceinline__ void shift_src(unsigned c01, unsigned be01, unsigned up23, unsigned dn23, unsigned m01, unsigned& n01, unsigned& n23) {
  const unsigned S = dpp_row_shr1(be01, c01), H = dpp_row_shl1(be01, c01);
  n01 = (S & m01) | (H & ~m01);
  n23 = (up23 & 0xffffu) | (dn23 & 0xffff0000u);
}
__device__ __forceinline__ int opaque(int x) { asm volatile("" : "+v"(x)); return x; }
__device__ __forceinline__ float fsig(float x) { return __builtin_amdgcn_rcpf(1.f + __expf(-x)); }

__device__ __forceinline__ void ph_rwscan2(const P& p, char* smem, int bid, int nb) {
  const int wid = widx(), lane = lidx(), sl = wid >> 2, wv = wid & 3;
  char* sb = smem + sl * RW_STREAM_BYTES;
  float* CST = (float*)(sb + 4 * RW_SLOT_BYTES + 3 * RW_SCR_BYTES);
  volatile LAS int* FL = (volatile LAS int*)(sb + 4 * RW_SLOT_BYTES + 3 * RW_SCR_BYTES + 2304);
  const int scanw = sl;
  const int NCH = 144;
  for (int sp = bid; sp < 256; sp += nb) {
    const int s = sp * 2 + sl;
    const int d = s & 1, h = (s >> 1) & 7, b = s >> 4;
    __syncthreads();
    if (wv == 0) {
      const int cc = lane;
      CST[0 * 64 + cc] = p.rw_w0[d * 512 + h * 64 + cc];
      CST[1 * 64 + cc] = p.rw_a0[d * 512 + h * 64 + cc];
      CST[2 * 64 + cc] = p.rw_k_k[h * 64 + cc];
      CST[3 * 64 + cc] = p.rw_k_a[h * 64 + cc];
      CST[4 * 64 + cc] = p.rw_r_k[h * 64 + cc];
      CST[5 * 64 + cc] = p.rw_mu[h * 64 + cc];
      CST[6 * 64 + cc] = p.rw_mu[512 + h * 64 + cc];
      CST[7 * 64 + cc] = p.rw_mu[1024 + h * 64 + cc];
      CST[8 * 64 + cc] = p.rw_mu[1536 + cc];
      if (lane < 8) FL[lane] = 0;
    }
    __syncthreads();
    if (wv == scanw) {
      const int v32 = lane & 31, hh = lane >> 5;
      u16* ydst = d ? p.yrwb() : p.yrwf();
      f32x16 X[2][2];
#pragma unroll
      for (int mt = 0; mt < 2; ++mt)
#pragma unroll
        for (int vt = 0; vt < 2; ++vt)
#pragma unroll
          for (int r = 0; r < 16; ++r) X[mt][vt][r] = 0.f;
      for (int c = 0; c < NCH; ++c) {
        {
          while (__builtin_amdgcn_readfirstlane(FL[c & 3]) <= c) __builtin_amdgcn_s_sleep(1);
          asm volatile("" ::: "memory");
          const char* slot = sb + (c & 3) * RW_SLOT_BYTES;
          const u16* AR = (const u16*)slot;
          const u16* MG = (const u16*)(slot + 4352);
          const u16* BT = (const u16*)(slot + 5376);
          const u16* KT = (const u16*)(slot + 7424);
          const u16* VT = (const u16*)(slot + 9472);
          const float* WC = (const float*)(slot + 11520);
          {
            const float* Arb = (const float*)(slot + 11776);
            const float* Ark = Arb + 256;
            u16* ARw = (u16*)slot;
            u16* MGw = (u16*)(slot + 4352);
            const int ol = opaque(lane), oj = opaque(lane & 15);
            v2f am[16];
#pragma unroll
            for (int tt = 0; tt < 16; ++tt) {
              const int m0 = 8 * (tt >> 2) + (tt & 3);
              am[tt] = (v2f){bf2f(ARw[ol + m0 * RW_AR_LD]), bf2f(MGw[oj + m0 * 16])};
            }
#pragma unroll
            for (int tt = 0; tt < 16; ++tt) {
              const int m0 = 8 * (tt >> 2) + (tt & 3);
              v2f acc = (v2f){bf2f(ARw[ol + (m0 + 4) * RW_AR_LD]), Ark[oj + tt * 16]};
#pragma unroll
              for (int i4 = 0; i4 < (tt + 4) / 4; ++i4) {
                const float4 s4 = *(const float4*)(Arb + tt * 16 + 4 * i4);
                const float sv[4] = {s4.x, s4.y, s4.z, s4.w};
#pragma unroll
                for (int q = 0; q < 4; ++q) {
                  const int i = 4 * i4 + q;
                  if (i <= tt) acc += sv[q] * am[i];
                }
              }
              ARw[ol + (m0 + 4) * RW_AR_LD] = f2bf(acc[0]);
              if (lane < 16) MGw[oj + (m0 + 4) * 16] = f2bf(acc[1]);
            }
          }
          bf16x8 vtf[2];
#pragma unroll
          for (int vt = 0; vt < 2; ++vt) vtf[vt] = *(const bf16x8*)(VT + (32 * vt + v32) * 16 + 8 * hh);
          f32x16 UY[2];
#pragma unroll
          for (int vt = 0; vt < 2; ++vt)
#pragma unroll
            for (int r = 0; r < 16; ++r) UY[vt][r] = 0.f;
          {
            const bf16x8 mgf = *(const bf16x8*)(MG + v32 * 16 + 8 * hh);
#pragma unroll
            for (int vt = 0; vt < 2; ++vt) UY[vt] = __builtin_amdgcn_mfma_f32_32x32x16_bf16(mgf, vtf[vt], UY[vt], 0, 0, 0);
          }
#pragma unroll
          for (int mt = 0; mt < 2; ++mt)
#pragma unroll
            for (int ks = 0; ks < 2; ++ks) {
              const int base = 32 * mt + 16 * ks + 4 * hh;
              const uint2 a0 = *(const uint2*)(AR + v32 * RW_AR_LD + base);
              const uint2 a1 = *(const uint2*)(AR + v32 * RW_AR_LD + base + 8);
              union { unsigned u[4]; bf16x8 v; } af;
              af.u[0] = a0.x; af.u[1] = a0.y; af.u[2] = a1.x; af.u[3] = a1.y;
#pragma unroll
              for (int vt = 0; vt < 2; ++vt) {
                union { unsigned u[4]; bf16x8 v; } xf;
#pragma unroll
                for (int q = 0; q < 4; ++q) xf.u[q] = cvtpk(X[mt][vt][8 * ks + 2 * q], X[mt][vt][8 * ks + 2 * q + 1]);
                UY[vt] = __builtin_amdgcn_mfma_f32_32x32x16_bf16(af.v, xf.v, UY[vt], 0, 0, 0);
              }
            }
          if (c >= 16 && hh == 1) {
#pragma unroll
            for (int r = 0; r < 16; ++r) {
              const int pos = (c - 16) * 16 + r;
              const int tok = d ? (2047 - pos) : pos;
              u16* yp = ydst + ((size_t)b * 2048 + tok) * 512 + h * 64 + v32;
              yp[0] = f2bf(UY[0][r]);
              yp[32] = f2bf(UY[1][r]);
            }
          }
          bf16x8 uyf[2][2];
#pragma unroll
          for (int vt = 0; vt < 2; ++vt)
#pragma unroll
            for (int ks = 0; ks < 2; ++ks) {
              union { unsigned u[4]; bf16x8 v; } t_;
#pragma unroll
              for (int q = 0; q < 4; ++q) t_.u[q] = cvtpk(UY[vt][8 * ks + 2 * q], UY[vt][8 * ks + 2 * q + 1]);
              uyf[vt][ks] = t_.v;
            }
#pragma unroll
          for (int mt = 0; mt < 2; ++mt) {
            const int krow = 32 * mt + v32;
            const bf16x8 ktf = *(const bf16x8*)(KT + krow * 16 + 8 * hh);
            bf16x8 btf[2];
#pragma unroll
            for (int ks = 0; ks < 2; ++ks) {
              btf[ks] = *(const bf16x8*)(BT + krow * 16 + 8 * ks);
              if (hh) btf[ks] = (bf16x8){0, 0, 0, 0, 0, 0, 0, 0};
            }
#pragma unroll
            for (int vt = 0; vt < 2; ++vt) {
              X[mt][vt] = __builtin_amdgcn_mfma_f32_32x32x16_bf16(ktf, vtf[vt], X[mt][vt], 0, 0, 0);
#pragma unroll
              for (int ks = 0; ks < 2; ++ks) X[mt][vt] = __builtin_amdgcn_mfma_f32_32x32x16_bf16(btf[ks], uyf[vt][ks], X[mt][vt], 0, 0, 0);
            }
#pragma unroll
            for (int g = 0; g < 4; ++g) {
              const float4 w4 = *(const float4*)(WC + 32 * mt + 8 * g + 4 * hh);
#pragma unroll
              for (int vt = 0; vt < 2; ++vt) {
                X[mt][vt][4 * g + 0] *= w4.x; X[mt][vt][4 * g + 1] *= w4.y;
                X[mt][vt][4 * g + 2] *= w4.z; X[mt][vt][4 * g + 3] *= w4.w;
              }
            }
          }
        }
        asm volatile("s_waitcnt lgkmcnt(0)" ::: "memory");
        if (lane == 0) FL[4] = c + 1;
      }
    } else {
      const int pw = wv - (wv > scanw ? 1 : 0);
      const int t = lane & 15, kq = lane >> 4;
      char* scr = sb + 4 * RW_SLOT_BYTES + pw * RW_SCR_BYTES;
      u16* AL = (u16*)scr;
      u16* BE = AL + 16 * RW_RM_LD;
      u16* KA = BE + 16 * RW_RM_LD;
      float* AAs = (float*)BE;
      const int o_kq16 = opaque(16 * kq);
      const int o_tr = opaque(256 * kq + t);
      const int o_rm = opaque(t * RW_RM_LD + 16 * kq);
      const int o_ar = opaque((8 * (t >> 2) + (t & 3) + 4) * RW_AR_LD + 16 * kq);
      const int o_l = opaque(lane);
      const int o_j = opaque(lane & 15);
      const float* cstl = CST + o_kq16;
      const float* cstw = CST + 8 * 64 + opaque(8 * kq);
      const unsigned m01 = d ? 0xffff0000u : 0x0000ffffu;
      bf16x8 wwf[4], waf[4];
      {
        const int o_wl = (((d * 8 + h) * 4) * 64 + lane) * 8;
#pragma unroll
        for (int mt = 0; mt < 4; ++mt) {
          wwf[mt] = *(const bf16x8*)(p.wlf() + o_wl + mt * 512);
          waf[mt] = *(const bf16x8*)(p.wlf() + o_wl + 32768 + mt * 512);
        }
      }
      for (;;) {
        int c;
        {
          const unsigned fa = (unsigned)(unsigned long)(LAS char*)(sb + 4 * RW_SLOT_BYTES + 3 * RW_SCR_BYTES + 2304 + 20);
          const int inc = lane == 0 ? 1 : 0;
          asm volatile("ds_add_rtn_u32 %0, %1, %2\n\ts_waitcnt lgkmcnt(0)" : "=v"(c) : "v"(fa), "v"(inc) : "memory");
          c = __builtin_amdgcn_readfirstlane(c);
        }
        if (c >= NCH) break;
        while (__builtin_amdgcn_readfirstlane(FL[4]) < c - 3) __builtin_amdgcn_s_sleep(1);
        asm volatile("" ::: "memory");
        char* slot = sb + (c & 3) * RW_SLOT_BYTES;
        u16* AR = (u16*)slot;
        u16* MG = (u16*)(slot + 4352);
        u16* BT = (u16*)(slot + 5376);
        u16* KT = (u16*)(slot + 7424);
        u16* VT = (u16*)(slot + 9472);
        float* WC = (float*)(slot + 11520);
        const bool lat = c >= 16;
        const int L = lat ? 2048 : 256;
        const int pos = (lat ? (c - 16) : c) * 16 + t;
        const int tok = d ? (L - 1 - pos) : pos;
        const size_t row = (lat ? (size_t)b * 2048 : (size_t)NLAT + (size_t)b * 256) + tok;
        const u16* cbase = p.proj() + row * INC + 512;
        const u16 *ubase, *dbase, *ebase;
        float nmask[4];
        {
          size_t nrow[4];
          bool nval[4];
          neighbours(!lat, row, tok, nrow, nval);
#pragma unroll
          for (int j = 0; j < 4; ++j) nmask[j] = nval[j] ? 1.f : 0.f;
          ubase = p.proj() + (nval[2] ? nrow[2] : row) * INC + 512;
          dbase = p.proj() + (nval[3] ? nrow[3] : row) * INC + 512;
          const bool useup = (t == 0) != (d != 0);
          const size_t erow = useup ? (nval[0] ? nrow[0] : row) : (nval[1] ? nrow[1] : row);
          ebase = p.proj() + erow * INC + 512;
        }
        const int cl = 1536 + 8 * kq, cx = h * 64 + 16 * kq;
        u32x4 Cl[2], Ul[2], Dl[2], El[2];
        u32x4 Cx[3][2], Ux[3][2], Dx[3][2], Ex[3][2];
#pragma unroll
        for (int a = 0; a < 2; ++a) {
          Cl[a] = *(const u32x4*)(cbase + cl + 32 * a);
          Ul[a] = *(const u32x4*)(ubase + cl + 32 * a);
          Dl[a] = *(const u32x4*)(dbase + cl + 32 * a);
          El[a] = (u32x4){0u, 0u, 0u, 0u};
        }
#pragma unroll
        for (int a = 0; a < 3; ++a)
#pragma unroll
          for (int hf = 0; hf < 2; ++hf) {
            Cx[a][hf] = *(const u32x4*)(cbase + cx + 512 * a + 8 * hf);
            Ux[a][hf] = *(const u32x4*)(ubase + cx + 512 * a + 8 * hf);
            Dx[a][hf] = *(const u32x4*)(dbase + cx + 512 * a + 8 * hf);
            Ex[a][hf] = (u32x4){0u, 0u, 0u, 0u};
          }
        if (t == 0 || t == 15) {
#pragma unroll
          for (int a = 0; a < 2; ++a) El[a] = *(const u32x4*)(ebase + cl + 32 * a);
#pragma unroll
          for (int a = 0; a < 3; ++a)
#pragma unroll
            for (int hf = 0; hf < 2; ++hf) Ex[a][hf] = *(const u32x4*)(ebase + cx + 512 * a + 8 * hf);
        }
        bf16x8 lwf, laf;
        {
          float lw[8], la[8];
          const float4 ml0 = *(const float4*)(cstw), ml1 = *(const float4*)(cstw + 4);
          const float4 ma0 = *(const float4*)(cstw + 32), ma1 = *(const float4*)(cstw + 32 + 4);
          const float mul_[8] = {ml0.x, ml0.y, ml0.z, ml0.w, ml1.x, ml1.y, ml1.z, ml1.w};
          const float mua_[8] = {ma0.x, ma0.y, ma0.z, ma0.w, ma1.x, ma1.y, ma1.z, ma1.w};
#pragma unroll
          for (int g = 0; g < 2; ++g) {
            unsigned nw01, nw23, na01, na23;
            shift_src(Cl[0][2 * g], El[0][2 * g], Ul[0][2 * g + 1], Dl[0][2 * g + 1], m01, nw01, nw23);
            shift_src(Cl[1][2 * g], El[1][2 * g], Ul[1][2 * g + 1], Dl[1][2 * g + 1], m01, na01, na23);
            const float zw[4] = {bflo(Cl[0][2 * g]), bfhi(Cl[0][2 * g]), bflo(Cl[0][2 * g + 1]), bfhi(Cl[0][2 * g + 1])};
            const float za[4] = {bflo(Cl[1][2 * g]), bfhi(Cl[1][2 * g]), bflo(Cl[1][2 * g + 1]), bfhi(Cl[1][2 * g + 1])};
            const float nw[4] = {bflo(nw01), bfhi(nw01), bflo(nw23), bfhi(nw23)};
            const float na[4] = {bflo(na01), bfhi(na01), bflo(na23), bfhi(na23)};
#pragma unroll
            for (int j = 0; j < 4; ++j) {
              const int q = 4 * g + j;
              lw[q] = 1.f - 2.f * __builtin_amdgcn_rcpf(1.f + __expf(2.f * (zw[j] + (nw[j] * nmask[j] - zw[j]) * mul_[q])));
              la[q] = za[j] + (na[j] * nmask[j] - za[j]) * mua_[q];
            }
          }
          union { unsigned u[4]; bf16x8 v; } tw, ta;
#pragma unroll
          for (int q = 0; q < 4; ++q) { tw.u[q] = pack2(lw[2 * q], lw[2 * q + 1]); ta.u[q] = pack2(la[2 * q], la[2 * q + 1]); }
          lwf = tw.v; laf = ta.v;
        }
        float ee[16];
        unsigned rrp[8], aap[8], kxp[8];
        {
#pragma unroll
          for (int mt = 0; mt < 4; ++mt) {
            const float4 mr = *(const float4*)(cstl + 5 * 64 + 4 * mt), mk = *(const float4*)(cstl + 6 * 64 + 4 * mt), mv = *(const float4*)(cstl + 7 * 64 + 4 * mt);
            const float mrv[4] = {mr.x, mr.y, mr.z, mr.w}, mkv[4] = {mk.x, mk.y, mk.z, mk.w}, mvv[4] = {mv.x, mv.y, mv.z, mv.w};
            const int hf = mt >> 1, r0 = 2 * (mt & 1);
            float mix[3][4];
#pragma unroll
            for (int a = 0; a < 3; ++a) {
              unsigned n01, n23;
              shift_src(Cx[a][hf][r0], Ex[a][hf][r0], Ux[a][hf][r0 + 1], Dx[a][hf][r0 + 1], m01, n01, n23);
              const float z[4] = {bflo(Cx[a][hf][r0]), bfhi(Cx[a][hf][r0]), bflo(Cx[a][hf][r0 + 1]), bfhi(Cx[a][hf][r0 + 1])};
              const float n[4] = {bflo(n01), bfhi(n01), bflo(n23), bfhi(n23)};
              const float* mm = a == 0 ? mrv : (a == 1 ? mkv : mvv);
#pragma unroll
              for (int j = 0; j < 4; ++j) mix[a][j] = z[j] + (n[j] * nmask[j] - z[j]) * mm[j];
            }
#pragma unroll
            for (int j = 0; j < 4; ++j) VT[o_tr + (4 * mt + j) * 16] = f2bf(mix[2][j]);
            const f32x4 z4 = (f32x4){0.f, 0.f, 0.f, 0.f};
            const f32x4 aw = __builtin_amdgcn_mfma_f32_16x16x32_bf16(wwf[mt], lwf, z4, 0, 0, 0);
            const f32x4 a2 = __builtin_amdgcn_mfma_f32_16x16x32_bf16(waf[mt], laf, z4, 0, 0, 0);
            const float4 w0 = *(const float4*)(cstl + 0 * 64 + 4 * mt), a0 = *(const float4*)(cstl + 1 * 64 + 4 * mt);
            ee[4 * mt] = 0.60653066f * fsig(w0.x + aw[0]); ee[4 * mt + 1] = 0.60653066f * fsig(w0.y + aw[1]);
            ee[4 * mt + 2] = 0.60653066f * fsig(w0.z + aw[2]); ee[4 * mt + 3] = 0.60653066f * fsig(w0.w + aw[3]);
            float aav[4];
            aav[0] = fsig(a0.x + a2[0]); aav[1] = fsig(a0.y + a2[1]);
            aav[2] = fsig(a0.z + a2[2]); aav[3] = fsig(a0.w + a2[3]);
            rrp[2 * mt] = pack2(mix[0][0], mix[0][1]); rrp[2 * mt + 1] = pack2(mix[0][2], mix[0][3]);
            aap[2 * mt] = pack2(aav[0], aav[1]); aap[2 * mt + 1] = pack2(aav[2], aav[3]);
            kxp[2 * mt] = pack2(mix[1][0], mix[1][1]); kxp[2 * mt + 1] = pack2(mix[1][2], mix[1][3]);
          }
        }
        float kdf[16], kkf[16];
        float inv;
        {
          float ss = 0.f, bon = 0.f;
#pragma unroll
          for (int mt = 0; mt < 4; ++mt) {
            const float4 c2 = *(const float4*)(cstl + 2 * 64 + 4 * mt), c3 = *(const float4*)(cstl + 3 * 64 + 4 * mt), c4 = *(const float4*)(cstl + 4 * 64 + 4 * mt);
            const float kkc[4] = {c2.x, c2.y, c2.z, c2.w}, kac[4] = {c3.x, c3.y, c3.z, c3.w}, rkc[4] = {c4.x, c4.y, c4.z, c4.w};
#pragma unroll
            for (int j = 0; j < 4; ++j) {
              const int e = 4 * mt + j;
              const float kx = (e & 1) ? bfhi(kxp[e >> 1]) : bflo(kxp[e >> 1]);
              const float av = (e & 1) ? bfhi(aap[e >> 1]) : bflo(aap[e >> 1]);
              const float rv = (e & 1) ? bfhi(rrp[e >> 1]) : bflo(rrp[e >> 1]);
              kdf[e] = kx * (1.f + (av - 1.f) * kac[j]);
              kkf[e] = kx * kkc[j];
              ss += kkf[e] * kkf[e];
              bon += rv * kdf[e] * rkc[j];
            }
          }
          ss += __shfl_xor(ss, 16, 64); ss += __shfl_xor(ss, 32, 64);
          bon += __shfl_xor(bon, 16, 64); bon += __shfl_xor(bon, 32, 64);
          inv = rsqrtf(ss + 1e-12f);
          if (lat && kq == 0) p.bsc()[((size_t)d * NLAT + row) * 8 + h] = bon;
        }
#pragma unroll
        for (int mt = 0; mt < 4; ++mt) {
          float al4[4], rh4[4], be4[4], ka4[4];
#pragma unroll
          for (int j = 0; j < 4; ++j) {
            const int e = 4 * mt + j;
            float cs = ee[e];
            cs = dpp_shr_add(cs, 1); cs = dpp_shr_add(cs, 2); cs = dpp_shr_add(cs, 4); cs = dpp_shr_add(cs, 8);
            const float Ep = __expf(cs), Em = __builtin_amdgcn_rcpf(Ep), Ex = __expf(ee[e] - cs);
            const float kkn = kkf[e] * inv;
            al4[j] = -kkn * Ex;
            be4[j] = kkn * ((e & 1) ? bfhi(aap[e >> 1]) : bflo(aap[e >> 1])) * Ep;
            ka4[j] = kdf[e] * Ep;
            rh4[j] = ((e & 1) ? bfhi(rrp[e >> 1]) : bflo(rrp[e >> 1])) * Em;
            BT[o_tr + (4 * mt + j) * 16] = f2bf(be4[j]);
            KT[o_tr + (4 * mt + j) * 16] = f2bf(ka4[j]);
            if (t == 15) WC[o_kq16 + 4 * mt + j] = Em;
          }
          const int ko = o_rm + 4 * mt;
          *(uint2*)(AL + ko) = make_uint2(pack2(al4[0], al4[1]), pack2(al4[2], al4[3]));
          *(uint2*)(AR + o_ar + 4 * mt) = make_uint2(pack2(rh4[0], rh4[1]), pack2(rh4[2], rh4[3]));
          *(uint2*)(BE + ko) = make_uint2(pack2(be4[0], be4[1]), pack2(be4[2], be4[3]));
          *(uint2*)(KA + ko) = make_uint2(pack2(ka4[0], ka4[1]), pack2(ka4[2], ka4[3]));
        }
        {
          const int m = lane & 31, hh = lane >> 5;
          const int typ = (m >> 2) & 1, tt = 4 * (m >> 3) + (m & 3);
          const u16* arow = (typ ? AR + m * RW_AR_LD : AL + tt * RW_RM_LD) + 8 * hh;
          const u16* brow = ((m >> 4) ? KA : BE) + (m & 15) * RW_RM_LD + 8 * hh;
          f32x16 aa;
#pragma unroll
          for (int r = 0; r < 16; ++r) aa[r] = 0.f;
#pragma unroll
          for (int ks = 0; ks < 4; ++ks) {
            const uint2 a0 = *(const uint2*)(arow + 16 * ks), a1 = *(const uint2*)(arow + 16 * ks + 4);
            union { unsigned u[4]; bf16x8 v; } af;
            af.u[0] = a0.x; af.u[1] = a0.y; af.u[2] = a1.x; af.u[3] = a1.y;
            const bf16x8 bf_ = *(const bf16x8*)(brow + 16 * ks);
            aa = __builtin_amdgcn_mfma_f32_32x32x16_bf16(af.v, bf_, aa, 0, 0, 0);
          }
          const int i = m & 15;
          float* aad = (hh ? (float*)(slot + 11776) : AAs) + opaque((m >> 4) * 256 + i);
#pragma unroll
          for (int r = 0; r < 16; ++r) {
            const bool keep = hh ? (i <= r) : (i < r);
            aad[r * 16] = keep ? aa[r] : 0.f;
          }
        }
        asm volatile("" ::: "memory");
        {
          const float* Aab = AAs;
          const float* Aak = AAs + 256;
          v2f am[16];
#pragma unroll
          for (int tt = 0; tt < 16; ++tt) {
            v2f acc = (v2f){bf2f(AL[o_l + tt * RW_RM_LD]), Aak[o_j + tt * 16]};
#pragma unroll
            for (int i4 = 0; i4 < (tt + 3) / 4; ++i4) {
              const float4 s4 = *(const float4*)(Aab + tt * 16 + 4 * i4);
              const float sv[4] = {s4.x, s4.y, s4.z, s4.w};
#pragma unroll
              for (int q = 0; q < 4; ++q) {
                const int i = 4 * i4 + q;
                if (i < tt) acc += sv[q] * am[i];
              }
            }
            am[tt] = acc;
          }
#pragma unroll
          for (int tt = 0; tt < 16; ++tt) {
            const int m0 = 8 * (tt >> 2) + (tt & 3);
            AR[o_l + m0 * RW_AR_LD] = f2bf(am[tt][0]);
            if (lane < 16) MG[o_j + m0 * 16] = f2bf(am[tt][1]);
          }
        }
        asm volatile("s_waitcnt lgkmcnt(0)" ::: "memory");
        if (lane == 0) FL[c & 3] = c + 1;
      }
    }
  }
}

struct MixLd {
  uint4 s5f, s5b, rwf, rwb, vc, gc;
  u16 vn[8], gn[8];
  float bs0, bs1;
};
__device__ __forceinline__ void mix_load(const P& p, int row, int lane, MixLd& L, float (&nmask)[4]) {
  const int c8 = lane * 8, t = row & 2047;
  L.s5f = *(const uint4*)(p.ys5f() + (size_t)row * 512 + c8);
  L.s5b = *(const uint4*)(p.ys5b() + (size_t)row * 512 + c8);
  L.rwf = *(const uint4*)(p.yrwf() + (size_t)row * 512 + c8);
  L.rwb = *(const uint4*)(p.yrwb() + (size_t)row * 512 + c8);
  size_t nrow[4];
  bool nval[4];
  neighbours(false, (size_t)row, t, nrow, nval);
  const u16* nb_[4];
#pragma unroll
  for (int j = 0; j < 4; ++j) { nb_[j] = p.proj() + (nval[j] ? nrow[j] : (size_t)row) * INC + 512 + j; nmask[j] = nval[j] ? 1.f : 0.f; }
  const u16* cb = p.proj() + (size_t)row * INC + 512;
  L.vc = *(const uint4*)(cb + 1024 + c8);
#pragma unroll
  for (int i = 0; i < 8; ++i) L.vn[i] = nb_[i & 3][1024 + c8 + (i & 4)];
  const int g8 = (lane < 12) ? c8 : 0;
  L.gc = *(const uint4*)(cb + 1600 + g8);
#pragma unroll
  for (int i = 0; i < 8; ++i) L.gn[i] = nb_[i & 3][1600 + g8 + (i & 4)];
  const int head = lane >> 3;
  L.bs0 = p.bsc()[(size_t)row * 8 + head];
  L.bs1 = p.bsc()[((size_t)NLAT + row) * 8 + head];
}
__device__ __forceinline__ void mix_compute(const P& p, int row, int lane, const MixLd& L, const float (&nmask)[4], u16* y1dst, u16* t1dst) {
  const int c8 = lane * 8;
  {
    const unsigned au[4] = {L.s5f.x, L.s5f.y, L.s5f.z, L.s5f.w}, bu[4] = {L.s5b.x, L.s5b.y, L.s5b.z, L.s5b.w};
    unsigned ou[4];
#pragma unroll
    for (int q = 0; q < 4; ++q) ou[q] = pack2(gelu_as(bflo(au[q]) + bflo(bu[q])), gelu_as(bfhi(au[q]) + bfhi(bu[q])));
    *(uint4*)(y1dst + (size_t)row * 512 + c8) = make_uint4(ou[0], ou[1], ou[2], ou[3]);
  }
  float y[8];
  {
    const unsigned au[4] = {L.rwf.x, L.rwf.y, L.rwf.z, L.rwf.w}, bu[4] = {L.rwb.x, L.rwb.y, L.rwb.z, L.rwb.w};
#pragma unroll
    for (int q = 0; q < 4; ++q) { y[2 * q] = bflo(au[q]) + bflo(bu[q]); y[2 * q + 1] = bfhi(au[q]) + bfhi(bu[q]); }
  }
  float sm = 0.f;
#pragma unroll
  for (int i = 0; i < 8; ++i) sm += y[i];
  sm = dpp_add(sm, 0, 0); sm = dpp_add(sm, 1, 0); sm = dpp_add(sm, 2, 0);
  const float mu = sm * (1.f / 64.f);
  float sv = 0.f;
#pragma unroll
  for (int i = 0; i < 8; ++i) sv += (y[i] - mu) * (y[i] - mu);
  sv = dpp_add(sv, 0, 0); sv = dpp_add(sv, 1, 0); sv = dpp_add(sv, 2, 0);
  const float rs = rsqrtf(sv * (1.f / 64.f) + 64e-5f);
  float v[8];
  {
    const unsigned cu[4] = {L.vc.x, L.vc.y, L.vc.z, L.vc.w};
    const float4 m0 = *(const float4*)(p.rw_mu + 1024 + c8), m1 = *(const float4*)(p.rw_mu + 1024 + c8 + 4);
    const float mm[8] = {m0.x, m0.y, m0.z, m0.w, m1.x, m1.y, m1.z, m1.w};
#pragma unroll
    for (int i = 0; i < 8; ++i) {
      const float z = (i & 1) ? bfhi(cu[i >> 1]) : bflo(cu[i >> 1]);
      const float nbv = bf2f(L.vn[i]) * nmask[i & 3];
      v[i] = z + (nbv - z) * mm[i];
    }
  }
  const float bs = L.bs0 + L.bs1;
  {
    const float4 w0 = *(const float4*)(p.rw_ln_w + c8), w1 = *(const float4*)(p.rw_ln_w + c8 + 4);
    const float4 b0 = *(const float4*)(p.rw_ln_b + c8), b1 = *(const float4*)(p.rw_ln_b + c8 + 4);
    const float lw[8] = {w0.x, w0.y, w0.z, w0.w, w1.x, w1.y, w1.z, w1.w};
    const float lb[8] = {b0.x, b0.y, b0.z, b0.w, b1.x, b1.y, b1.z, b1.w};
    float o[8];
#pragma unroll
    for (int i = 0; i < 8; ++i) o[i] = (y[i] - mu) * rs * lw[i] + lb[i] + bs * v[i];
    *(uint4*)(t1dst + (size_t)row * 512 + c8) = make_uint4(pack2(o[0], o[1]), pack2(o[2], o[3]), pack2(o[4], o[5]), pack2(o[6], o[7]));
  }
  if (lane < 32) {
    unsigned ou[4] = {0u, 0u, 0u, 0u};
    if (lane < 12) {
      const unsigned cu[4] = {L.gc.x, L.gc.y, L.gc.z, L.gc.w};
      const float4 m0 = *(const float4*)(p.rw_mu + 1600 + c8), m1 = *(const float4*)(p.rw_mu + 1600 + c8 + 4);
      const float mm[8] = {m0.x, m0.y, m0.z, m0.w, m1.x, m1.y, m1.z, m1.w};
      float gsig[8];
#pragma unroll
      for (int i = 0; i < 8; ++i) {
        const float z = (i & 1) ? bfhi(cu[i >> 1]) : bflo(cu[i >> 1]);
        const float nbv = bf2f(L.gn[i]) * nmask[i & 3];
        gsig[i] = fsig(z + (nbv - z) * mm[i]);
      }
#pragma unroll
      for (int q = 0; q < 4; ++q) ou[q] = pack2(gsig[2 * q], gsig[2 * q + 1]);
    }
    *(uint4*)(p.sg() + (size_t)row * 256 + c8) = make_uint4(ou[0], ou[1], ou[2], ou[3]);
  }
}
__device__ __forceinline__ void ph_mixprep(const P& p, int bid, int nb, u16* y1dst, u16* t1dst) {
  const int wid = tidx() >> 6, lane = tidx() & 63;
  const int stride = nb * 8;
  for (int row = bid * 8 + wid; row < NLAT; row += 2 * stride) {
    const int rowB = row + stride;
    const bool hasB = rowB < NLAT;
    MixLd LA, LB;
    float mA[4], mB[4];
    mix_load(p, row, lane, LA, mA);
    mix_load(p, hasB ? rowB : row, lane, LB, mB);
    mix_compute(p, row, lane, LA, mA, y1dst, t1dst);
    if (hasB) mix_compute(p, rowB, lane, LB, mB, y1dst, t1dst);
  }
}

__constant__ unsigned char CAND_I[52] = {0,0,0,0,0,0,0,0,0,0,0,0,0,0,0,0, 1,1,1,1,1,1,1,1, 2,2,2,2,2, 3,3,3,3, 4,4,4, 5,5, 6,6, 7,7, 8,9,10,11,12,13,14,15, 0,0};
__constant__ unsigned char CAND_J[52] = {0,1,2,3,4,5,6,7,8,9,10,11,12,13,14,15, 0,1,2,3,4,5,6,7, 0,1,2,3,4, 0,1,2,3, 0,1,2, 0,1, 0,1, 0,1, 0,0,0,0,0,0,0,0, 0,0};

#define SC_LD 144
#define KL_LD 136
__device__ __forceinline__ unsigned umax_quad(unsigned v) {
  unsigned o = (unsigned)__builtin_amdgcn_update_dpp(0, (int)v, 0xB1, 0xf, 0xf, true);
  v = v > o ? v : o;
  o = (unsigned)__builtin_amdgcn_update_dpp(0, (int)v, 0x4E, 0xf, 0xf, true);
  return v > o ? v : o;
}
__device__ __forceinline__ unsigned mono_key(float f) {
  unsigned u = __float_as_uint(f);
  return u ^ ((u >> 31) ? 0xFFFFFFFFu : 0x80000000u);
}
__device__ __forceinline__ float mono_inv(unsigned k) {
  unsigned u = (k >> 31) ? (k ^ 0x80000000u) : ~k;
  return __uint_as_float(u);
}
__device__ __forceinline__ unsigned umax3(unsigned a, unsigned b, unsigned c) {
  unsigned m = a > b ? a : b;
  return m > c ? m : c;
}
__device__ __forceinline__ void ph_route(const P& p, char* smem, int bid, int nb) {
  u16* KL = (u16*)smem;
  unsigned* SC = (unsigned*)(smem + 2 * 128 * KL_LD * 2);
  float* TS = (float*)(SC + 2 * 64 * SC_LD);
  int* TI = (int*)(TS + 2 * 64 * 16);
  const u16* Q = p.proj();
  const int tid = tidx(), wid = tid >> 6, lane = tid & 63, fr = lane & 15, fq = lane >> 4;
  int cur_h = -1;
  bf16x8 an[4];
  {
    const int h0 = bid & 7, r0 = (bid >> 3) * 64, c0 = wid >> 2, m0 = (wid & 3) * 16;
#pragma unroll
    for (int ks = 0; ks < 4; ++ks)
      an[ks] = *(const bf16x8*)(Q + (size_t)(r0 + m0 + fr) * 2048 + h0 * 256 + c0 * 128 + ks * 32 + fq * 8);
  }
  for (int item = bid; item < 1024 * 8; item += nb) {
    const int h = item & 7, row0 = (item >> 3) * 64;
    if (h != cur_h) {
      __syncthreads();
      for (int e = tid; e < 2 * 128 * 16; e += NTHREADS) {
        int r = e >> 4, kc = (e & 15) * 8;
        *(uint4*)(KL + r * KL_LD + kc) = *(const uint4*)(p.keys() + ((size_t)h * 256 + r) * 128 + kc);
      }
      cur_h = h;
      __syncthreads();
    }
    {
      const int c = wid >> 2, mrow = (wid & 3) * 16;
      f32x4 acc[8];
#pragma unroll
      for (int ni = 0; ni < 8; ++ni) acc[ni] = (f32x4){0.f, 0.f, 0.f, 0.f};
      bf16x8 a[4];
#pragma unroll
      for (int ks = 0; ks < 4; ++ks) a[ks] = an[ks];
      {
        const int nit = (item + nb < 1024 * 8) ? item + nb : item;
        const int nh = nit & 7, nr0 = (nit >> 3) * 64;
#pragma unroll
        for (int ks = 0; ks < 4; ++ks)
          an[ks] = *(const bf16x8*)(Q + (size_t)(nr0 + mrow + fr) * 2048 + nh * 256 + c * 128 + ks * 32 + fq * 8);
      }
#pragma unroll
      for (int ks = 0; ks < 4; ++ks) {
#pragma unroll
        for (int ni = 0; ni < 8; ++ni) {
          bf16x8 bfr = *(const bf16x8*)(KL + (c * 128 + ni * 16 + fr) * KL_LD + ks * 32 + fq * 8);
          acc[ni] = __builtin_amdgcn_mfma_f32_16x16x32_bf16(a[ks], bfr, acc[ni], 0, 0, 0);
        }
      }
#pragma unroll
      for (int ni = 0; ni < 8; ++ni)
#pragma unroll
        for (int j = 0; j < 4; ++j) {
          const int n = ni * 16 + fr;
          SC[(c * 64 + mrow + fq * 4 + j) * SC_LD + n] = (mono_key(acc[ni][j]) & ~127u) | (unsigned)(127 - n);
        }
    }
    __syncthreads();
    {
      const int task = tid >> 2, q4 = tid & 3;
      unsigned* rowp = SC + task * SC_LD;
      for (int r = 0; r < 16; ++r) {
        unsigned m = 0;
#pragma unroll
        for (int j = 0; j < 8; ++j) {
          uint4 v = *(const uint4*)(rowp + 16 * j + 4 * q4);
          m = umax3(m, v.x, v.y);
          m = umax3(m, v.z, v.w);
        }
        m = umax_quad(m);
        const int n = 127 - (int)(m & 127u);
        if (((n >> 2) & 3) == q4) rowp[n] = 0u;
        if (q4 == (r & 3)) {
          TS[task * 16 + r] = mono_inv(m & ~127u);
          TI[task * 16 + r] = n;
        }
      }
    }
    __syncthreads();
    if (tid < 256) {
      const int t = tid >> 2, q4 = tid & 3;
      unsigned val[13];
#pragma unroll
      for (int e = 0; e < 13; ++e) {
        const int ci = q4 + 4 * e;
        const int i = CAND_I[ci], j = CAND_J[ci];
        const float sv = TS[t * 16 + i] + TS[(64 + t) * 16 + j];
        val[e] = (ci < 50) ? ((mono_key(sv) & ~255u) | (unsigned)(255 - (i * 16 + j))) : 0u;
      }
      unsigned mine[4] = {0u, 0u, 0u, 0u};
      unsigned first = 0u;
#pragma unroll
      for (int r = 0; r < 16; ++r) {
        unsigned m = umax3(val[0], val[1], val[2]);
        m = umax3(m, val[3], val[4]);
        m = umax3(m, val[5], val[6]);
        m = umax3(m, val[7], val[8]);
        m = umax3(m, val[9], val[10]);
        m = umax3(m, val[11], val[12]);
        m = umax_quad(m);
#pragma unroll
        for (int e = 0; e < 13; ++e) val[e] = (val[e] == m) ? 0u : val[e];
        if (r == 0) first = m;
        mine[r >> 2] = (q4 == (r & 3)) ? m : mine[r >> 2];
      }
      float smax;
      {
        const int cid = 255 - (int)(first & 255u);
        smax = TS[t * 16 + (cid >> 4)] + TS[(64 + t) * 16 + (cid & 15)];
      }
      float ex[4];
      int eid[4];
      float part = 0.f;
#pragma unroll
      for (int k = 0; k < 4; ++k) {
        const int cid = 255 - (int)(mine[k] & 255u);
        const int i = cid >> 4, j = cid & 15;
        const float sv = TS[t * 16 + i] + TS[(64 + t) * 16 + j];
        ex[k] = __expf(sv - smax);
        part += ex[k];
        eid[k] = TI[t * 16 + i] * 128 + TI[(64 + t) * 16 + j];
      }
      part = dpp_add(part, 0, 0);
      part = dpp_add(part, 1, 0);
      const float rden = 1.f / part;
      const size_t obase = ((size_t)(row0 + t) * 8 + h) * 16;
#pragma unroll
      for (int k = 0; k < 4; ++k) {
        p.idx()[obase + 4 * k + q4] = eid[k];
        p.gate()[obase + 4 * k + q4] = ex[k] * rden;
      }
    }
    __syncthreads();
  }
}

typedef int v8i_t __attribute__((ext_vector_type(8)));
__device__ __forceinline__ void ph_ffn(const P& p, float* __restrict__ dst, char* smem, int bid, int nb) {
  const int wid = tidx() >> 6, lane = tidx() & 63;
  const int hh = lane >> 5, li = lane & 31, m16 = lane & 15, kg = lane >> 4;
  unsigned char* h8 = (unsigned char*)smem + wid * 1024;
  const u16* H2N = p.hn();
  for (int row = bid * 8 + wid; row < NLAT; row += nb * 8) {
    float hinv;
    {
      const uint4 a = *(const uint4*)(H2N + (size_t)row * 1024 + lane * 16), b2 = *(const uint4*)(H2N + (size_t)row * 1024 + lane * 16 + 8);
      const unsigned au[8] = {a.x, a.y, a.z, a.w, b2.x, b2.y, b2.z, b2.w};
      float hv[16];
      float am = 0.f;
#pragma unroll
      for (int q = 0; q < 8; ++q) { hv[2 * q] = bflo(au[q]); hv[2 * q + 1] = bfhi(au[q]); am = fmaxf(am, fmaxf(fabsf(hv[2 * q]), fabsf(hv[2 * q + 1]))); }
#pragma unroll
      for (int m = 32; m >= 1; m >>= 1) am = fmaxf(am, __shfl_xor(am, m, 64));
      const float scl = am > 0.f ? 448.f / am : 1.f;
      hinv = am > 0.f ? am * (1.f / 448.f) : 1.f;
      unsigned o[4];
#pragma unroll
      for (int q = 0; q < 4; ++q) {
        int w = 0;
        w = __builtin_amdgcn_cvt_pk_fp8_f32(hv[4 * q] * scl, hv[4 * q + 1] * scl, w, false);
        w = __builtin_amdgcn_cvt_pk_fp8_f32(hv[4 * q + 2] * scl, hv[4 * q + 3] * scl, w, true);
        o[q] = (unsigned)w;
      }
      *(uint4*)(h8 + lane * 16) = make_uint4(o[0], o[1], o[2], o[3]);
    }
    v8i_t hb[8];
#pragma unroll
    for (int s2 = 0; s2 < 8; ++s2) {
      const uint4 x0 = *(const uint4*)(h8 + 128 * s2 + 16 * kg), x1 = *(const uint4*)(h8 + 128 * s2 + 64 + 16 * kg);
      hb[s2] = (v8i_t){(int)x0.x, (int)x0.y, (int)x0.z, (int)x0.w, (int)x1.x, (int)x1.y, (int)x1.z, (int)x1.w};
    }
    const int id0 = p.idx()[(size_t)row * 128 + lane], id1 = p.idx()[(size_t)row * 128 + 64 + lane];
    const float us0 = p.usc()[id0] * hinv, us1 = p.usc()[id1] * hinv;
    const float gv0 = p.gate()[(size_t)row * 128 + lane] * p.vsc()[id0], gv1 = p.gate()[(size_t)row * 128 + 64 + lane] * p.vsc()[id1];
    float oacc[32];
#pragma unroll
    for (int i = 0; i < 32; ++i) oacc[i] = 0.f;
#pragma unroll 1
    for (int bb = 0; bb < 8; ++bb) {
      const bool hf = bb >= 4;
      const int e0 = (bb & 3) * 16;
      const int idv = hf ? id1 : id0;
      const float usv = hf ? us1 : us0, gvv = hf ? gv1 : gv0;
      const int idm = __shfl(idv, e0 + m16, 64);
      uint4 ua[8];
#pragma unroll
      for (int s2 = 0; s2 < 8; ++s2) ua[s2] = *(const uint4*)(p.utab() + (size_t)idm * 1024 + 64 * s2 + 16 * kg);
      uint4 vr[8];
#pragma unroll
      for (int q = 0; q < 8; ++q) {
        const int ia = __builtin_amdgcn_readlane(idv, e0 + 2 * q), ib = __builtin_amdgcn_readlane(idv, e0 + 2 * q + 1);
        const int id = hh ? ib : ia;
        vr[q] = *(const uint4*)(p.utab() + (size_t)id * 1024 + 512 + li * 16);
      }
      f32x4 D = (f32x4){0.f, 0.f, 0.f, 0.f};
#pragma unroll
      for (int s2 = 0; s2 < 8; ++s2) {
        const v8i_t av = (v8i_t){(int)ua[s2].x, (int)ua[s2].y, (int)ua[s2].z, (int)ua[s2].w, 0, 0, 0, 0};
        D = __builtin_amdgcn_mfma_scale_f32_16x16x128_f8f6f4(av, hb[s2], D, 4  , 0  , 0, 0x7f7f7f7f, 0, 0x7f7f7f7f);
      }
      const int nn = m16 & 3;
      const float dotv = nn == 0 ? D[0] : (nn == 1 ? D[1] : (nn == 2 ? D[2] : D[3]));
      const int esrc = e0 + 4 * kg + nn;
      const float usx = __shfl(usv, esrc, 64), gvx = __shfl(gvv, esrc, 64);
      const float cfl = gvx * gelu_as(dotv * usx);
#pragma unroll
      for (int q = 0; q < 8; ++q) {
        int one_s;
        asm volatile("s_mov_b32 %0, 1" : "=s"(one_s));
        if (one_s == 0) continue;
        const int ma = 2 * q, mb = 2 * q + 1;
        const float cfa = __int_as_float(__builtin_amdgcn_readlane(__float_as_int(cfl), 16 * (ma >> 2) + (ma & 3)));
        const float cfb = __int_as_float(__builtin_amdgcn_readlane(__float_as_int(cfl), 16 * (mb >> 2) + (mb & 3)));
        const float cf = hh ? cfb : cfa;
        const unsigned vv[4] = {vr[q].x, vr[q].y, vr[q].z, vr[q].w};
#pragma unroll
        for (int k = 0; k < 4; ++k) {
          v2f p0 = __builtin_amdgcn_cvt_scalef32_pk_f32_fp4(vv[k], 1.0f, 0), p1 = __builtin_amdgcn_cvt_scalef32_pk_f32_fp4(vv[k], 1.0f, 1);
          v2f p2 = __builtin_amdgcn_cvt_scalef32_pk_f32_fp4(vv[k], 1.0f, 2), p3 = __builtin_amdgcn_cvt_scalef32_pk_f32_fp4(vv[k], 1.0f, 3);
          oacc[8 * k] += cf * p0[0]; oacc[8 * k + 1] += cf * p0[1];
          oacc[8 * k + 2] += cf * p1[0]; oacc[8 * k + 3] += cf * p1[1];
          oacc[8 * k + 4] += cf * p2[0]; oacc[8 * k + 5] += cf * p2[1];
          oacc[8 * k + 6] += cf * p3[0]; oacc[8 * k + 7] += cf * p3[1];
        }
      }
    }
    float mine[16];
#pragma unroll
    for (int i = 0; i < 16; ++i) {
      const float give = hh ? oacc[i] : oacc[16 + i];
      const float got = __shfl_xor(give, 32, 64);
      mine[i] = (hh ? oacc[16 + i] : oacc[i]) + got;
    }
    const int b = row >> 11;
    const int colb = li * 32 + hh * 16;
    float h3[16];
    float ss = 0.f;
#pragma unroll
    for (int q = 0; q < 4; ++q) {
      const int col = colb + q * 4;
      float4 a0 = *(const float4*)(p.out + (size_t)row * 1024 + col);
      float4 q0 = *(const float4*)(p.mod() + b * 6144 + 5 * 1024 + col);
      h3[q * 4 + 0] = a0.x + q0.x * mine[q * 4 + 0];
      h3[q * 4 + 1] = a0.y + q0.y * mine[q * 4 + 1];
      h3[q * 4 + 2] = a0.z + q0.z * mine[q * 4 + 2];
      h3[q * 4 + 3] = a0.w + q0.w * mine[q * 4 + 3];
      ss += h3[q * 4] * h3[q * 4] + h3[q * 4 + 1] * h3[q * 4 + 1] + h3[q * 4 + 2] * h3[q * 4 + 2] + h3[q * 4 + 3] * h3[q * 4 + 3];
    }
    ss = wave_sum_u(ss);
    const float rstd = rsqrtf(ss * (1.f / 1024.f) + 1e-6f);
#pragma unroll
    for (int q = 0; q < 4; ++q) {
      const int col = colb + q * 4;
      float4 n0 = *(const float4*)(p.norm_f_g + col);
      *(float4*)(dst + (size_t)row * 1024 + col) =
          make_float4(h3[q * 4] * rstd * n0.x, h3[q * 4 + 1] * rstd * n0.y, h3[q * 4 + 2] * rstd * n0.z, h3[q * 4 + 3] * rstd * n0.w);
    }
  }
}

#define XB_TMO      128
#define XB_XCNT(j)  (256  + 64 * (j))
#define XB_XSUB(j)  (1280 + 64 * (j))
#define XB_XGEN(j)  (2304 + 64 * (j))
#define XB_TOP      3328
#define XB_TOPGEN   3392
#define XCD_BAR_WORDS 3456
#define XB_SPIN_CAP (1u << 18)
#define LAS __attribute__((address_space(3)))

__device__ __forceinline__ unsigned xb_ld(unsigned* p)              { return __hip_atomic_load(p, __ATOMIC_RELAXED, __HIP_MEMORY_SCOPE_AGENT); }
__device__ __forceinline__ unsigned xb_add(unsigned* p, unsigned v) { return __hip_atomic_fetch_add(p, v, __ATOMIC_RELAXED, __HIP_MEMORY_SCOPE_AGENT); }
__device__ __forceinline__ unsigned xb_xcc_id() { return (unsigned)__builtin_amdgcn_s_getreg((3 << 11) | 20) & 0xFu; }
#define XB_SPIN(cond, bar) do { unsigned _sp = 0; while (cond) { __builtin_amdgcn_s_sleep(1); \
    if ((++_sp & 255u) == 0u) { if (xb_ld(&(bar)[XB_TMO])) break; if (_sp > XB_SPIN_CAP) { atomicAdd(&(bar)[XB_TMO], 1u); break; } } } } while (0)

struct XcdBarrier {
    unsigned* bar; unsigned x;
    volatile LAS unsigned* st;
};

__device__ __forceinline__ XcdBarrier xcd_barrier_post(unsigned* bar, volatile LAS unsigned* st) {
    XcdBarrier b; b.bar = bar; b.x = xb_xcc_id(); b.st = st;
    if (tidx() == 0) (void)xb_add(&bar[XB_XCNT(b.x)], 1u);
    return b;
}
__device__ __forceinline__ void xcd_barrier_complete(unsigned* bar, unsigned x, unsigned& nloc, unsigned& nx) {
    const unsigned G = gridDim.x * gridDim.y * gridDim.z;
    unsigned sum, cnt, mine, sp = 0u;
    for (;;) {
        sum = 0u; cnt = 0u; mine = 0u;
#pragma unroll
        for (unsigned j = 0; j < 16; ++j) { const unsigned c = xb_ld(&bar[XB_XCNT(j)]); sum += c; cnt += (c > 0u) ? 1u : 0u; mine = (j == x) ? c : mine; }
        if (sum == G) break;
        __builtin_amdgcn_s_sleep(1);
        if ((++sp & 255u) == 0u) { if (xb_ld(&bar[XB_TMO])) break; if (sp > XB_SPIN_CAP) { atomicAdd(&bar[XB_TMO], 1u); break; } }
    }
    nloc = mine > 0u ? mine : 1u; nx = cnt > 0u ? cnt : 1u;
}

__device__ __forceinline__ void xcd_barrier(const XcdBarrier& b) {
    asm volatile("s_waitcnt vmcnt(0)" ::: "memory");
    __syncthreads();
    if (tidx() == 0) {
        unsigned* bar = b.bar;
        __builtin_amdgcn_s_waitcnt(0);
        unsigned nloc = b.st[0], nx = b.st[1];
        if (nloc == 0u) { xcd_barrier_complete(bar, b.x, nloc, nx); b.st[0] = nloc; b.st[1] = nx; }
        const unsigned old = xb_add(&bar[XB_XSUB(b.x)], 1u);
        const unsigned gen = old / nloc;
        if (old + 1u == (gen + 1u) * nloc) {
            __builtin_amdgcn_fence(__ATOMIC_RELEASE, "agent");
            asm volatile("s_waitcnt vmcnt(0)" ::: "memory");
            const unsigned og = xb_add(&bar[XB_TOP], 1u);
            const unsigned tg = og / nx;
            if (og + 1u == (tg + 1u) * nx) xb_add(&bar[XB_TOPGEN], 1u);
            else XB_SPIN(xb_ld(&bar[XB_TOPGEN]) == tg, bar);
            __builtin_amdgcn_fence(__ATOMIC_ACQUIRE, "agent");
            xb_add(&bar[XB_XGEN(b.x)], 1u);
            asm volatile("s_waitcnt vmcnt(0)" ::: "memory");
        } else {
            XB_SPIN(xb_ld(&bar[XB_XGEN(b.x)]) == gen, bar);
            __builtin_amdgcn_fence(__ATOMIC_ACQUIRE, "agent");
            asm volatile("s_waitcnt vmcnt(0)" ::: "memory");
        }
    }
    __syncthreads();
}

typedef const __attribute__((address_space(4))) P* kargP_t;
__device__ __forceinline__ P load_params() {
  kargP_t q = (kargP_t)__builtin_amdgcn_kernarg_segment_ptr();
  asm volatile("" : "+s"(q));
  P r;
  r.x = q->x;
  r.c = q->c;
  r.ctx = q->ctx;
  r.c_ctx = q->c_ctx;
  r.w_ada = q->w_ada;
  r.b_ada = q->b_ada;
  r.norm1_g = q->norm1_g;
  r.norm2_g = q->norm2_g;
  r.w_in = q->w_in;
  r.s5_a_re = q->s5_a_re;
  r.s5_a_im = q->s5_a_im;
  r.s5_log_dt = q->s5_log_dt;
  r.s5_b_re = q->s5_b_re;
  r.s5_b_im = q->s5_b_im;
  r.s5_c_re = q->s5_c_re;
  r.s5_c_im = q->s5_c_im;
  r.s5_d = q->s5_d;
  r.s5_w_glu = q->s5_w_glu;
  r.s5_b_glu = q->s5_b_glu;
  r.rw_mu = q->rw_mu;
  r.rw_w0 = q->rw_w0;
  r.rw_w_w2 = q->rw_w_w2;
  r.rw_a0 = q->rw_a0;
  r.rw_w_a2 = q->rw_w_a2;
  r.rw_w_g2 = q->rw_w_g2;
  r.rw_k_k = q->rw_k_k;
  r.rw_k_a = q->rw_k_a;
  r.rw_r_k = q->rw_r_k;
  r.rw_ln_w = q->rw_ln_w;
  r.rw_ln_b = q->rw_ln_b;
  r.w_out = q->w_out;
  r.peer_w_q = q->peer_w_q;
  r.peer_keys = q->peer_keys;
  r.peer_u = q->peer_u;
  r.peer_v = q->peer_v;
  r.norm_f_g = q->norm_f_g;
  r.out = q->out;
  r.ws = q->ws;
  return r;
}
#define NPHASES 11
template <int PH>
__device__ __forceinline__ void run_phase(const P& p, char* smem, int bid, int nb, bool rep = false) {
  if (PH == 0) ph_prep(p, smem, bid, nb);
  if (PH == 1) ph_norm(p, 0, bid, nb);
  if (PH == 2) {
    pg8::StaticOrder S; S.init(NTOK, INCP, nb, bid);
    pg8::gemm_phase<pg8::EpiProjT, pg8::StaticOrder, false>((PG8_LAS unsigned char*)smem, pg8::Gemm{p.hn(), p.win_t(), NTOK, INCP, 1024}, S, pg8::EpiProjT{p.proj(), INC, INC}, nullptr);
  }
  if (PH == 3) { ph_s5scan2(p, smem, bid, nb); ph_rwscan2(p, smem, bid, nb); }
  if (PH == 4) ph_mixprep(p, bid, nb, rep ? p.hn() : p.ys5f(), rep ? p.hn() + (size_t)NLAT * 512 : p.yrwf());
  if (PH == 5) {
    {
      pg8::StaticOrder S; S.init(NLAT, 512, nb, bid);
      pg8::gemm_phase<pg8::EpiGluT, pg8::StaticOrder, false>((PG8_LAS unsigned char*)smem, pg8::Gemm{p.ys5f(), p.wglu_t(), NLAT, 512, 512}, S, pg8::EpiGluT{p.ys5f(), p.s5_b_glu, p.hn()}, nullptr);
    }
    {
      pg8::StaticOrder S; S.init(NLAT, 512, nb, bid);
      pg8::gemm_phase<pg8::EpiGateT, pg8::StaticOrder, false>((PG8_LAS unsigned char*)smem, pg8::Gemm{p.sg(), p.wg2_t(), NLAT, 512, 256}, S, pg8::EpiGateT{p.yrwf(), p.hn()}, nullptr);
    }
  }
  if (PH == 6) {
    pg8::StaticOrder S; S.init(NLAT, 1024, nb, bid);
    pg8::gemm_phase<pg8::EpiWoutT, pg8::StaticOrder, false>((PG8_LAS unsigned char*)smem, pg8::Gemm{p.hn(), p.wout_t(), NLAT, 1024, 1024}, S, pg8::EpiWoutT{p.x, p.mod(), p.out}, nullptr);
  }
  if (PH == 7) ph_norm(p, 1, bid, nb);
  if (PH == 8) {
    pg8::StaticOrder S; S.init(NLAT, 2048, nb, bid);
    pg8::gemm_phase<pg8::EpiProjT, pg8::StaticOrder, false>((PG8_LAS unsigned char*)smem, pg8::Gemm{p.hn(), p.wq_t(), NLAT, 2048, 1024}, S, pg8::EpiProjT{p.proj(), 2048, 2048}, nullptr);
  }
  if (PH == 9) ph_route(p, smem, bid, nb);
  if (PH == 10) ph_ffn(p, rep ? (float*)p.proj() : p.out, smem, bid, nb);
  if (PH == 11) ph_s5scan2(p, smem, bid, nb);
  if (PH == 12) ph_rwscan2(p, smem, bid, nb);
}
#ifndef REPMASK
#define REPMASK 0
#endif
#define REP(n) ((REPMASK >> (n)) & 1)
#define PHASE(n) if (ph_lo <= n && n < ph_hi) { if (n > ph_lo) { if (n == 1) grid.sync(); else xcd_barrier(xb); } if (REP(n)) { { const P lp_ = load_params(); run_phase<n>(lp_, smem, bid, nb, true); } __syncthreads(); } if (n == 3 && REP(11)) { run_phase<11>(p, smem, bid, nb); __syncthreads(); } if (n == 3 && REP(12)) { run_phase<12>(p, smem, bid, nb); __syncthreads(); } { const P lp_ = load_params(); run_phase<n>(lp_, smem, bid, nb); } }
__global__ void __launch_bounds__(NTHREADS) mega(P p, int ph_lo, int ph_hi) {
  char* smem = g_smem;
  if ((threadIdx.x & 63) == 0) *(int*)(g_smem + WAVETAB_OFF + 4 * hw_slot()) = (int)(threadIdx.x >> 6);
  cg::grid_group grid = cg::this_grid();
  const int bid = blockIdx.x, nb = gridDim.x;
  volatile LAS unsigned* xst = (volatile LAS unsigned*)(smem + LDS_BYTES - 16);
  if (threadIdx.x == 0) { xst[0] = 0u; xst[1] = 0u; }
  __syncthreads();
  XcdBarrier xb;
  {
    const P lp0 = load_params();
    xb.bar = lp0.bar(); xb.x = 0; xb.st = xst;
    if (ph_hi - ph_lo > 1) xb = xcd_barrier_post(lp0.bar(), xst);
  }
  PHASE(0) PHASE(1) PHASE(2) PHASE(3) PHASE(4) PHASE(5) PHASE(6) PHASE(7) PHASE(8) PHASE(9) PHASE(10)
}

extern "C" void kernel_launch(void* const* d_in, const int* in_sizes, int n_in, void* d_out, int out_size, void* d_ws,
                              size_t ws_size, hipStream_t stream) {
  static int grid_blocks = 0;
  if (!grid_blocks) {
    int dev = 0, cus = 0, per_cu = 0;
    hipGetDevice(&dev);
    hipDeviceGetAttribute(&cus, hipDeviceAttributeMultiprocessorCount, dev);
    hipFuncSetAttribute((const void*)mega, hipFuncAttributeMaxDynamicSharedMemorySize, LDS_BYTES);
    hipOccupancyMaxActiveBlocksPerMultiprocessor(&per_cu, (const void*)mega, NTHREADS, LDS_BYTES);
    if (per_cu < 1) { fprintf(stderr, "occupancy query returned %d\n", per_cu); per_cu = 1; }
    grid_blocks = cus;
  }
  P p{};
  const float** fp = (const float**)&p;
  for (int i = 0; i < 36; ++i) fp[i] = (const float*)d_in[i];
  p.out = (float*)d_out;
  p.ws = (char*)d_ws;
  if (WS_TOTAL > ws_size) { fprintf(stderr, "workspace too small: need %zu have %zu\n", (size_t)WS_TOTAL, ws_size); return; }
#if MEGA
  if (hipMemsetAsync((char*)d_ws + OFF_bar, 0, XCD_BAR_WORDS * 4, stream) != hipSuccess) fprintf(stderr, "memset of barrier words failed\n");
  int lo = 0, hi = NPHASES;
  void* args[] = {&p, &lo, &hi};
  hipError_t e = hipLaunchCooperativeKernel((const void*)mega, dim3(grid_blocks), dim3(NTHREADS), args, LDS_BYTES, stream);
  if (e != hipSuccess) fprintf(stderr, "cooperative launch failed: %s (grid %d)\n", hipGetErrorString(e), grid_blocks);
#else
  for (int ph = 0; ph < NPHASES; ++ph) {
    hipLaunchKernelGGL(mega, dim3(grid_blocks), dim3(NTHREADS), LDS_BYTES, stream, p, ph, ph + 1);
  }
#endif
}
```

```cpp
#include <hip/hip_runtime.h>
#include <hip/hip_cooperative_groups.h>
#include <stdint.h>
#include <stdio.h>
namespace cg = cooperative_groups;

#ifndef MEGA
#define MEGA 1
#endif

typedef unsigned short u16;
using bf16x8 = __attribute__((ext_vector_type(8))) short;
using f32x4 = __attribute__((ext_vector_type(4))) float;
using u32x4 = __attribute__((ext_vector_type(4))) unsigned;
using f32x16 = __attribute__((ext_vector_type(16))) float;

#define DM 1024
#define NLAT 65536
#define NCTX 8192
#define NTOK 73728
#define INC 2208
#define INCP 2304
#define NTHREADS 512
#define LDS_BYTES 163840

#define INC_FWD 1
constexpr size_t ws_al(size_t x) { return (x + 255) & ~(size_t)255; }
constexpr size_t OFF_mod = 0;
constexpr size_t OFF_win_t = OFF_mod + ws_al(33 * 6144 * 4);
constexpr size_t OFF_wout_t = OFF_win_t + ws_al((size_t)2304 * 1024 * 2);
constexpr size_t OFF_wq_t = OFF_wout_t + ws_al((size_t)1024 * 1024 * 2);
constexpr size_t OFF_wglu_t = OFF_wq_t + ws_al((size_t)2048 * 1024 * 2);
constexpr size_t OFF_wg2_t = OFF_wglu_t + ws_al((size_t)512 * 512 * 2);
constexpr size_t OFF_keys = OFF_wg2_t + ws_al((size_t)512 * 256 * 2);
constexpr size_t OFF_utab = OFF_keys + ws_al((size_t)8 * 2 * 128 * 128 * 2);
constexpr size_t OFF_usc = OFF_utab + ws_al((size_t)16384 * 1024);
constexpr size_t OFF_vsc = OFF_usc + ws_al(16384 * 4);
constexpr size_t OFF_s5ab = OFF_vsc + ws_al(16384 * 4);
constexpr size_t OFF_s5bb = OFF_s5ab + ws_al(4096 * 2 * 4);
constexpr size_t OFF_s5ct = OFF_s5bb + ws_al(4096 * 32 * 4);
constexpr size_t OFF_hn = OFF_s5ct + ws_al(2 * 32 * 16 * 128 * 2);
constexpr size_t OFF_proj = OFF_hn + ws_al((size_t)73728 * 1024 * 2);
constexpr size_t OFF_ys5f = OFF_proj + ws_al((size_t)73728 * 2208 * 2);
constexpr size_t OFF_ys5b = OFF_ys5f + ws_al((size_t)65536 * 512 * 2);
constexpr size_t OFF_yrwf = OFF_ys5b + ws_al((size_t)65536 * 512 * 2);
constexpr size_t OFF_yrwb = OFF_yrwf + ws_al((size_t)65536 * 512 * 2);
constexpr size_t OFF_bsc = OFF_yrwb + ws_al((size_t)65536 * 512 * 2);
constexpr size_t OFF_sg = OFF_bsc + ws_al((size_t)2 * 65536 * 8 * 4);
constexpr size_t OFF_bar = OFF_sg + ws_al((size_t)65536 * 256 * 2);
constexpr size_t OFF_wlf = OFF_bar + ws_al(3456 * 4);
constexpr size_t WS_TOTAL = OFF_wlf + ws_al(2 * 4096 * 16);

extern __shared__ __attribute__((aligned(16))) char g_smem[];
#define WAVETAB_OFF (LDS_BYTES - 16 - 256)
__device__ __forceinline__ int hw_slot() { return (int)(__builtin_amdgcn_s_getreg((5 << 11) | 4) & 63u); }
__device__ __forceinline__ int tidx() {
  const int w = *(const int*)(g_smem + WAVETAB_OFF + 4 * hw_slot());
  return __builtin_amdgcn_readfirstlane(w) * 64 + (int)__builtin_amdgcn_mbcnt_hi(~0u, __builtin_amdgcn_mbcnt_lo(~0u, 0u));
}
__device__ __forceinline__ int widx() { return __builtin_amdgcn_readfirstlane(*(const int*)(g_smem + WAVETAB_OFF + 4 * hw_slot())); }
__device__ __forceinline__ int lidx() { return (int)__builtin_amdgcn_mbcnt_hi(~0u, __builtin_amdgcn_mbcnt_lo(~0u, 0u)); }
struct P {
  const float *x, *c, *ctx, *c_ctx, *w_ada, *b_ada, *norm1_g, *norm2_g, *w_in, *s5_a_re, *s5_a_im, *s5_log_dt,
      *s5_b_re, *s5_b_im, *s5_c_re, *s5_c_im, *s5_d, *s5_w_glu, *s5_b_glu, *rw_mu, *rw_w0, *rw_w_w2, *rw_a0, *rw_w_a2,
      *rw_w_g2, *rw_k_k, *rw_k_a, *rw_r_k, *rw_ln_w, *rw_ln_b, *w_out, *peer_w_q, *peer_keys, *peer_u, *peer_v, *norm_f_g;
  float* out;
  char* ws;
  __device__ __forceinline__ float* mod() const { return (float*)(ws + OFF_mod); }
  __device__ __forceinline__ u16* win_t() const { return (u16*)(ws + OFF_win_t); }
  __device__ __forceinline__ u16* wout_t() const { return (u16*)(ws + OFF_wout_t); }
  __device__ __forceinline__ u16* wq_t() const { return (u16*)(ws + OFF_wq_t); }
  __device__ __forceinline__ u16* wglu_t() const { return (u16*)(ws + OFF_wglu_t); }
  __device__ __forceinline__ u16* wg2_t() const { return (u16*)(ws + OFF_wg2_t); }
  __device__ __forceinline__ u16* keys() const { return (u16*)(ws + OFF_keys); }
  __device__ __forceinline__ unsigned char* utab() const { return (unsigned char*)(ws + OFF_utab); }
  __device__ __forceinline__ float* usc() const { return (float*)(ws + OFF_usc); }
  __device__ __forceinline__ float* vsc() const { return (float*)(ws + OFF_vsc); }
  __device__ __forceinline__ float* s5ab() const { return (float*)(ws + OFF_s5ab); }
  __device__ __forceinline__ float* s5bb() const { return (float*)(ws + OFF_s5bb); }
  __device__ __forceinline__ u16* s5ct() const { return (u16*)(ws + OFF_s5ct); }
  __device__ __forceinline__ u16* hn() const { return (u16*)(ws + OFF_hn); }
  __device__ __forceinline__ u16* proj() const { return (u16*)(ws + OFF_proj); }
  __device__ __forceinline__ u16* ys5f() const { return (u16*)(ws + OFF_ys5f); }
  __device__ __forceinline__ u16* ys5b() const { return (u16*)(ws + OFF_ys5b); }
  __device__ __forceinline__ u16* yrwf() const { return (u16*)(ws + OFF_yrwf); }
  __device__ __forceinline__ u16* yrwb() const { return (u16*)(ws + OFF_yrwb); }
  __device__ __forceinline__ float* bsc() const { return (float*)(ws + OFF_bsc); }
  __device__ __forceinline__ u16* sg() const { return (u16*)(ws + OFF_sg); }
  __device__ __forceinline__ unsigned* bar() const { return (unsigned*)(ws + OFF_bar); }
  __device__ __forceinline__ u16* wlf() const { return (u16*)(ws + OFF_wlf); }
  __device__ __forceinline__ unsigned char* vtab() const { return utab() + 512; }
  __device__ __forceinline__ int* idx() const { return (int*)ys5b(); }
  __device__ __forceinline__ float* gate() const { return (float*)yrwb(); }
};

typedef float f32x2_t __attribute__((ext_vector_type(2)));
typedef __bf16 bf16x2_t __attribute__((ext_vector_type(2)));
__device__ __forceinline__ unsigned pack2(float a, float b) {
  f32x2_t v = {a, b};
  return __builtin_bit_cast(unsigned, __builtin_convertvector(v, bf16x2_t));
}
__device__ __forceinline__ u16 f2bf(float f) { return __builtin_bit_cast(u16, (__bf16)f); }
__device__ __forceinline__ float bf2f(u16 h) { return __uint_as_float(((unsigned)h) << 16); }
__device__ __forceinline__ float bflo(unsigned u) { return __uint_as_float(u << 16); }
__device__ __forceinline__ float bfhi(unsigned u) { return __uint_as_float(u & 0xffff0000u); }
__device__ __forceinline__ float wave_sum(float v) {
#pragma unroll
  for (int m = 32; m >= 1; m >>= 1) v += __shfl_xor(v, m, 64);
  return v;
}
__device__ __forceinline__ float gelu_exact(float x) { return 0.5f * x * (1.f + erff(x * 0.70710678118654752f)); }
__device__ __forceinline__ float gelu_as(float v) {
  const float av = fabsf(v), t = __builtin_amdgcn_rcpf(av * 0.2316418882f + 1.0f);
  float q = t * 0.5307027145f + (-0.7265760135f);
  q = q * t + 0.7107068705f; q = q * t + (-0.142248368f); q = q * t + 0.127414796f; q = q * t;
  const float e = __builtin_amdgcn_exp2f((v * v) * (-0.72134752044f));
  const float m = v * (q * e);
  return v < 0.f ? m : v - m;
}
__device__ __forceinline__ float sigmoidf(float x) { return 1.f / (1.f + __expf(-x)); }


typedef float v2f __attribute__((ext_vector_type(2)));
__device__ __forceinline__ float dpp_add(float v, const int ctrl, const int rmask) {
  int m;
  switch (ctrl) {
    case 0: m = __builtin_amdgcn_update_dpp(0, __float_as_int(v), 0xB1, 0xf, 0xf, true); break;
    case 1: m = __builtin_amdgcn_update_dpp(0, __float_as_int(v), 0x4E, 0xf, 0xf, true); break;
    case 2: m = __builtin_amdgcn_update_dpp(0, __float_as_int(v), 0x141, 0xf, 0xf, true); break;
    case 3: m = __builtin_amdgcn_update_dpp(0, __float_as_int(v), 0x140, 0xf, 0xf, true); break;
    case 4: m = __builtin_amdgcn_update_dpp(0, __float_as_int(v), 0x142, 0xa, 0xf, false); break;
    default: m = __builtin_amdgcn_update_dpp(0, __float_as_int(v), 0x143, 0xc, 0xf, false); break;
  }
  return v + __int_as_float(m);
}
__device__ __forceinline__ float wave_sum_u(float v) {
  v = dpp_add(v, 0, 0); v = dpp_add(v, 1, 0); v = dpp_add(v, 2, 0); v = dpp_add(v, 3, 0);
  v = dpp_add(v, 4, 0); v = dpp_add(v, 5, 0);
  return __int_as_float(__builtin_amdgcn_readlane(__float_as_int(v), 63));
}
__device__ __forceinline__ void convert_fp4_rows(const float* __restrict__ src, unsigned char* __restrict__ dst, float* __restrict__ sc,
                                                 int nrows, int bid, int nb) {
  const int wid = tidx() >> 6, lane = tidx() & 63;
  const int stride = nb * 8;
  for (int row0 = bid * 8 + wid; row0 < nrows; row0 += 4 * stride) {
    float4 v[4][4];
#pragma unroll
    for (int u = 0; u < 4; ++u) {
      int row = row0 + u * stride;
      if (row >= nrows) row = row0;
#pragma unroll
      for (int q = 0; q < 4; ++q) v[u][q] = *(const float4*)(src + (size_t)row * 1024 + lane * 16 + q * 4);
    }
#pragma unroll
    for (int u = 0; u < 4; ++u) {
      const int row = row0 + u * stride;
      if (row >= nrows) continue;
      float am = 0.f;
#pragma unroll
      for (int q = 0; q < 4; ++q)
        am = fmaxf(am, fmaxf(fmaxf(fabsf(v[u][q].x), fabsf(v[u][q].y)), fmaxf(fabsf(v[u][q].z), fabsf(v[u][q].w))));
#pragma unroll
      for (int m = 32; m >= 1; m >>= 1) am = fmaxf(am, __shfl_xor(am, m, 64));
      const float scl = am > 0.f ? 6.f / am : 1.f;
      unsigned w0 = 0u, w1 = 0u;
      w0 = __builtin_amdgcn_cvt_scalef32_pk_fp4_f32(w0, v[u][0].x * scl, v[u][0].y * scl, 1.0f, 0);
      w0 = __builtin_amdgcn_cvt_scalef32_pk_fp4_f32(w0, v[u][0].z * scl, v[u][0].w * scl, 1.0f, 1);
      w0 = __builtin_amdgcn_cvt_scalef32_pk_fp4_f32(w0, v[u][1].x * scl, v[u][1].y * scl, 1.0f, 2);
      w0 = __builtin_amdgcn_cvt_scalef32_pk_fp4_f32(w0, v[u][1].z * scl, v[u][1].w * scl, 1.0f, 3);
      w1 = __builtin_amdgcn_cvt_scalef32_pk_fp4_f32(w1, v[u][2].x * scl, v[u][2].y * scl, 1.0f, 0);
      w1 = __builtin_amdgcn_cvt_scalef32_pk_fp4_f32(w1, v[u][2].z * scl, v[u][2].w * scl, 1.0f, 1);
      w1 = __builtin_amdgcn_cvt_scalef32_pk_fp4_f32(w1, v[u][3].x * scl, v[u][3].y * scl, 1.0f, 2);
      w1 = __builtin_amdgcn_cvt_scalef32_pk_fp4_f32(w1, v[u][3].z * scl, v[u][3].w * scl, 1.0f, 3);
      *(uint2*)(dst + (size_t)row * 1024 + lane * 8) = make_uint2(w0, w1);
      if (lane == 0) sc[row] = am > 0.f ? am / 6.f : 1.f;
    }
  }
}

__device__ __forceinline__ void transpose_tiles(const float* __restrict__ src, int K, int N, u16* __restrict__ dst, int Kd, int Npad,
                                char* smem, int bid, int nb) {
  float* tile = (float*)smem;
  const int tid = tidx();
  const int nkt = Kd / 64, nnt = Npad / 64;
  for (int t = bid; t < nkt * nnt; t += nb) {
    int kt = t % nkt, nt = t / nkt;
    int k0 = kt * 64, n0 = nt * 64;
    __syncthreads();
#pragma unroll
    for (int it = 0; it < 8; ++it) {
      int i = (tid >> 6) + it * 8, j = tid & 63;
      int k = k0 + i, n = n0 + j;
      tile[i * 65 + j] = (k < K && n < N) ? src[(size_t)k * N + n] : 0.f;
    }
    __syncthreads();
    int n = tid >> 3, kc = (tid & 7) * 8;
    uint4 o;
    o.x = pack2(tile[(kc + 0) * 65 + n], tile[(kc + 1) * 65 + n]);
    o.y = pack2(tile[(kc + 2) * 65 + n], tile[(kc + 3) * 65 + n]);
    o.z = pack2(tile[(kc + 4) * 65 + n], tile[(kc + 5) * 65 + n]);
    o.w = pack2(tile[(kc + 6) * 65 + n], tile[(kc + 7) * 65 + n]);
    *(uint4*)(dst + (size_t)(n0 + n) * Kd + k0 + kc) = o;
  }
}

__device__ __forceinline__ void convert_bf16(const float* __restrict__ src, u16* __restrict__ dst, size_t n8, int bid, int nb) {
  for (size_t i = (size_t)bid * NTHREADS + tidx(); i < n8; i += (size_t)nb * NTHREADS) {
    float4 a = *(const float4*)(src + i * 8), b = *(const float4*)(src + i * 8 + 4);
    uint4 o;
    o.x = pack2(a.x, a.y); o.y = pack2(a.z, a.w); o.z = pack2(b.x, b.y); o.w = pack2(b.z, b.w);
    *(uint4*)(dst + i * 8) = o;
  }
}

__device__ __forceinline__ void ph_prep(const P& p, char* smem, int bid, int nb) {
  const int tid = tidx();
  {
    float* sc = (float*)smem;
    float* red = (float*)(smem + 33 * 256 * 4);
    for (int item = bid; item < 192; item += nb) {
      const int j0 = item * 32, kg = tid >> 5, col = tid & 31;
      float acc[33];
#pragma unroll
      for (int b = 0; b < 33; ++b) acc[b] = 0.f;
      for (int ch = 0; ch < 4; ++ch) {
        __syncthreads();
        for (int e = tid; e < 33 * 256; e += NTHREADS) {
          int b = e >> 8, kk = e & 255;
          float cv = (b < 32) ? p.c[b * 1024 + ch * 256 + kk] : p.c_ctx[ch * 256 + kk];
          sc[e] = cv / (1.f + expf(-cv));
        }
        float w[16];
#pragma unroll
        for (int i = 0; i < 16; ++i) w[i] = p.w_ada[(size_t)(ch * 256 + kg * 16 + i) * 6144 + j0 + col];
        __syncthreads();
#pragma unroll
        for (int i = 0; i < 16; ++i) {
          const int kk = kg * 16 + i;
#pragma unroll
          for (int b = 0; b < 33; ++b) acc[b] += sc[b * 256 + kk] * w[i];
        }
      }
#pragma unroll
      for (int b = 0; b < 33; ++b) red[(kg * 33 + b) * 32 + col] = acc[b];
      __syncthreads();
      for (int e = tid; e < 33 * 32; e += NTHREADS) {
        int b = e >> 5, cc = e & 31;
        float sv = p.b_ada[j0 + cc];
#pragma unroll
        for (int k2 = 0; k2 < 16; ++k2) sv += red[(k2 * 33 + b) * 32 + cc];
        p.mod()[b * 6144 + j0 + cc] = sv;
      }
      __syncthreads();
    }
  }
  transpose_tiles(p.w_in, 1024, INC, p.win_t(), 1024, INCP, smem, bid, nb);
  transpose_tiles(p.w_out, 1024, 1024, p.wout_t(), 1024, 1024, smem, bid, nb);
  transpose_tiles(p.peer_w_q, 1024, 2048, p.wq_t(), 1024, 2048, smem, bid, nb);
  transpose_tiles(p.s5_w_glu, 512, 512, p.wglu_t(), 512, 512, smem, bid, nb);
  transpose_tiles(p.rw_w_g2, 96, 512, p.wg2_t(), 256, 512, smem, bid, nb);
  convert_bf16(p.peer_keys, p.keys(), (size_t)8 * 2 * 128 * 128 / 8, bid, nb);
  convert_fp4_rows(p.peer_u, p.utab(), p.usc(), 16384, bid, nb);
  convert_fp4_rows(p.peer_v, p.vtab(), p.vsc(), 16384, bid, nb);
  for (int it = bid * NTHREADS + tid; it < 2 * 4096; it += nb * NTHREADS) {
    const int ln = it & 63, mt = (it >> 6) & 3, hh_ = (it >> 8) & 7, dd = (it >> 11) & 1, mm = it >> 12;
    const int tt = ln & 15, kq_ = ln >> 4;
    const float* W = mm ? p.rw_w_a2 : p.rw_w_w2;
    unsigned o[4];
#pragma unroll
    for (int q = 0; q < 4; ++q) {
      const size_t o0 = (size_t)(dd * 32 + 8 * kq_ + 2 * q) * 512 + hh_ * 64 + 16 * (tt >> 2) + 4 * mt + (tt & 3);
      o[q] = pack2(W[o0], W[o0 + 512]);
    }
    *(uint4*)(p.wlf() + (size_t)it * 8) = make_uint4(o[0], o[1], o[2], o[3]);
  }
  for (int it = bid * NTHREADS + tid; it < 4096; it += nb * NTHREADS) {
    int pp = it & 63, g = (it >> 6) & 31, d = it >> 11;
    float are = p.s5_a_re[it], aim = p.s5_a_im[it];
    float dt = expf(p.s5_log_dt[d * 32 + g]);
    float mag = expf(dt * are);
    float abr = mag * cosf(dt * aim), abi = mag * sinf(dt * aim);
    float nr = abr - 1.f, ni = abi;
    float den = are * are + aim * aim;
    float cfr = (nr * are + ni * aim) / den, cfi = (ni * are - nr * aim) / den;
    p.s5ab()[it * 2] = abr;
    p.s5ab()[it * 2 + 1] = abi;
    for (int h = 0; h < 16; ++h) {
      float br = p.s5_b_re[(size_t)it * 16 + h], bi = p.s5_b_im[(size_t)it * 16 + h];
      p.s5bb()[(size_t)it * 32 + h] = cfr * br - cfi * bi;
      p.s5bb()[(size_t)it * 32 + 16 + h] = cfr * bi + cfi * br;
    }
    for (int h = 0; h < 16; ++h) {
      size_t ci = ((size_t)(d * 32 + g) * 16 + h) * 64 + pp;
      p.s5ct()[((size_t)(d * 32 + g) * 16 + h) * 128 + 2 * pp] = f2bf(p.s5_c_re[ci]);
      p.s5ct()[((size_t)(d * 32 + g) * 16 + h) * 128 + 2 * pp + 1] = f2bf(-p.s5_c_im[ci]);
    }
  }
}

__device__ __forceinline__ void ph_norm(const P& p, int mode, int bid, int nb) {
  const int wid = tidx() >> 6, lane = tidx() & 63;
  const int nrows = mode == 0 ? NTOK : NLAT;
  const float* gvec = mode == 0 ? p.norm1_g : p.norm2_g;
  const int sh_off = mode == 0 ? 0 : 3 * 1024, sc_off = sh_off + 1024;
  const int stride = nb * 8;
  for (int row0 = bid * 8 + wid; row0 < nrows; row0 += 4 * stride) {
    float4 v[4][4];
    int bs[4];
#pragma unroll
    for (int u = 0; u < 4; ++u) {
      int row = row0 + u * stride;
      if (row >= nrows) row = row0;
      const float* src;
      if (mode == 0) {
        if (row < NLAT) { src = p.x + (size_t)row * 1024; bs[u] = row >> 11; }
        else { src = p.ctx + (size_t)(row - NLAT) * 1024; bs[u] = 32; }
      } else { src = nullptr; bs[u] = row >> 11; }
      if (mode == 0) {
#pragma unroll
        for (int j = 0; j < 2; ++j) {
          v[u][2 * j] = *(const float4*)(src + j * 512 + lane * 8);
          v[u][2 * j + 1] = *(const float4*)(src + j * 512 + lane * 8 + 4);
        }
      } else {
        const u16* s16 = (const u16*)p.out + (size_t)row * 2048 + 1024;
#pragma unroll
        for (int j = 0; j < 2; ++j) {
          const uint4 q = *(const uint4*)(s16 + j * 512 + lane * 8);
          v[u][2 * j] = make_float4(bflo(q.x), bfhi(q.x), bflo(q.y), bfhi(q.y));
          v[u][2 * j + 1] = make_float4(bflo(q.z), bfhi(q.z), bflo(q.w), bfhi(q.w));
        }
      }
    }
#pragma unroll
    for (int u = 0; u < 4; ++u) {
      const int row = row0 + u * stride;
      if (row >= nrows) continue;
      float ss = 0.f;
#pragma unroll
      for (int j = 0; j < 4; ++j) ss += v[u][j].x * v[u][j].x + v[u][j].y * v[u][j].y + v[u][j].z * v[u][j].z + v[u][j].w * v[u][j].w;
      ss = wave_sum_u(ss);
      const float rstd = rsqrtf(ss * (1.f / 1024.f) + 1e-6f);
      const float* mrow = p.mod() + bs[u] * 6144;
#pragma unroll
      for (int j = 0; j < 2; ++j) {
        const int col = j * 512 + lane * 8;
        unsigned o[4];
#pragma unroll
        for (int hq = 0; hq < 2; ++hq) {
          const float4 x = v[u][2 * j + hq];
          const float4 g = *(const float4*)(gvec + col + 4 * hq);
          const float4 sh = *(const float4*)(mrow + sh_off + col + 4 * hq);
          const float4 sc = *(const float4*)(mrow + sc_off + col + 4 * hq);
          o[2 * hq] = pack2(x.x * rstd * g.x * (1.f + sc.x) + sh.x, x.y * rstd * g.y * (1.f + sc.y) + sh.y);
          o[2 * hq + 1] = pack2(x.z * rstd * g.z * (1.f + sc.z) + sh.z, x.w * rstd * g.w * (1.f + sc.w) + sh.w);
        }
        *(uint4*)(p.hn() + (size_t)row * 1024 + col) = make_uint4(o[0], o[1], o[2], o[3]);
      }
    }
  }
}

#define G_BM 256
#define G_BN 128
#define G_BK 64
#define G_LD 72
template <class Epi>
__device__ __forceinline__ void gemm_simple(const u16* __restrict__ A, int lda, const u16* __restrict__ Bt, int ldb, int K, int M, int N,
                           char* smem, int bid, int nb, Epi epi) {
  u16* As = (u16*)smem;
  u16* Bs = (u16*)(smem + 2 * G_BM * G_LD * 2);
  const int tid = tidx(), wid = tid >> 6, lane = tid & 63;
  const int wr = wid >> 1, wc = wid & 1, fr = lane & 15, fq = lane >> 4;
  const int ntn = N / G_BN, ntiles = (M / G_BM) * ntn, nk = K / G_BK;
  const int lrow = tid >> 3, lkc = (tid & 7) * 8;
  for (int tile = bid; tile < ntiles; tile += nb) {
    const int m0 = (tile / ntn) * G_BM, n0 = (tile % ntn) * G_BN;
    f32x4 acc[4][4];
#pragma unroll
    for (int i = 0; i < 4; ++i)
#pragma unroll
      for (int j = 0; j < 4; ++j) acc[i][j] = (f32x4){0.f, 0.f, 0.f, 0.f};
    u32x4 ra[4], rb[2];
    const u16* Ag = A + (size_t)(m0 + lrow) * lda + lkc;
    const u16* Bg = Bt + (size_t)(n0 + lrow) * ldb + lkc;
#pragma unroll
    for (int i = 0; i < 4; ++i) ra[i] = *(const u32x4*)(Ag + (size_t)(64 * i) * lda);
#pragma unroll
    for (int i = 0; i < 2; ++i) rb[i] = *(const u32x4*)(Bg + (size_t)(64 * i) * ldb);
    __syncthreads();
#pragma unroll
    for (int i = 0; i < 4; ++i) *(u32x4*)(As + (lrow + 64 * i) * G_LD + lkc) = ra[i];
#pragma unroll
    for (int i = 0; i < 2; ++i) *(u32x4*)(Bs + (lrow + 64 * i) * G_LD + lkc) = rb[i];
    __syncthreads();
    for (int kt = 0; kt < nk; ++kt) {
      const int buf = kt & 1;
      if (kt + 1 < nk) {
#pragma unroll
        for (int i = 0; i < 4; ++i) ra[i] = *(const u32x4*)(Ag + (size_t)(64 * i) * lda + (kt + 1) * G_BK);
#pragma unroll
        for (int i = 0; i < 2; ++i) rb[i] = *(const u32x4*)(Bg + (size_t)(64 * i) * ldb + (kt + 1) * G_BK);
      }
      const u16* as = As + buf * (G_BM * G_LD);
      const u16* bs = Bs + buf * (G_BN * G_LD);
#pragma unroll
      for (int ks = 0; ks < 2; ++ks) {
        bf16x8 af[4], bfr[4];
#pragma unroll
        for (int mi = 0; mi < 4; ++mi) af[mi] = *(const bf16x8*)(as + (wr * 64 + mi * 16 + fr) * G_LD + ks * 32 + fq * 8);
#pragma unroll
        for (int ni = 0; ni < 4; ++ni) bfr[ni] = *(const bf16x8*)(bs + (wc * 64 + ni * 16 + fr) * G_LD + ks * 32 + fq * 8);
#pragma unroll
        for (int mi = 0; mi < 4; ++mi)
#pragma unroll
          for (int ni = 0; ni < 4; ++ni)
            acc[mi][ni] = __builtin_amdgcn_mfma_f32_16x16x32_bf16(af[mi], bfr[ni], acc[mi][ni], 0, 0, 0);
      }
      if (kt + 1 < nk) {
        u16* as2 = As + (buf ^ 1) * (G_BM * G_LD);
        u16* bs2 = Bs + (buf ^ 1) * (G_BN * G_LD);
#pragma unroll
        for (int i = 0; i < 4; ++i) *(u32x4*)(as2 + (lrow + 64 * i) * G_LD + lkc) = ra[i];
#pragma unroll
        for (int i = 0; i < 2; ++i) *(u32x4*)(bs2 + (lrow + 64 * i) * G_LD + lkc) = rb[i];
      }
      __syncthreads();
    }
#pragma unroll
    for (int mi = 0; mi < 4; ++mi)
#pragma unroll
      for (int ni = 0; ni < 4; ++ni) epi(m0 + wr * 64 + mi * 16 + fq * 4, n0 + wc * 64 + ni * 16 + fr, acc[mi][ni]);
  }
}

namespace pg8 {
#define PG8_LAS __attribute__((address_space(3)))
typedef unsigned short bf16_t;
typedef short bf16x8 __attribute__((ext_vector_type(8)));
typedef float f32x4 __attribute__((ext_vector_type(4)));
typedef unsigned u32x4 __attribute__((ext_vector_type(4)));
constexpr int BM = 256, BK = 64, HALF = 128, HTB = HALF * BK * 2  , STAGE_BYTES = 8 * HTB, NXCD = 8, WGM = 8;

__host__ __device__ __forceinline__ int lds_byte(int r, int c) { const int st = (r >> 4) * 2 + (c >> 5), rr = r & 15, cc = c & 31, ob = rr * 64 + cc * 2; return st * 1024 + (ob ^ (((ob >> 9) & 1) << 5)); }
__host__ __device__ __forceinline__ void stage_rc(int b, int& R, int& C) { const int st = b / 1024, sb = b % 1024, swz = sb ^ (((sb >> 9) & 1) << 5); R = (st >> 1) * 16 + swz / 64; C = (st & 1) * 32 + (swz % 64) / 2; }
__host__ __device__ __forceinline__ int perm32(int rho) { const int n = rho >> 4, i = rho & 15; return 8 * (i >> 2) + 4 * n + (i & 3); }

struct Unit { int pm, pn; };
struct Gemm { const bf16_t* A; const bf16_t* Bt; int M, N, K; };

struct StaticOrder {
    int nM, nN, nwg, G, c;
    __host__ __device__ void init(int M, int N, int G_, int c_) { nM = M / BM; nN = N / BM; nwg = nM * nN; G = G_; c = c_; }
    __host__ __device__ bool next(int i, Unit& u) const {
        const long L = (long)i * G + c; if (L >= nwg) return false;
        int wgid = (int)L; { const int q = nwg / NXCD, r = nwg % NXCD, xcd = wgid % NXCD, off = wgid / NXCD; wgid = (xcd < r ? xcd * (q + 1) : r * (q + 1) + (xcd - r) * q) + off; }
        const int nig = WGM * nN, gid = wgid / nig, fm = gid * WGM, gsz = (nM - fm) < WGM ? (nM - fm) : WGM;
        u.pm = fm + ((wgid % nig) % gsz); u.pn = (wgid % nig) / gsz; return true;
    }
    __device__ __forceinline__ void a_ready(const Unit&) const {}
    __device__ __forceinline__ void done(const Unit&) const {}
};
__device__ __forceinline__ unsigned cvt_pk_bf16(float lo, float hi) { return ::pack2(lo, hi); }
typedef float f32x2 __attribute__((ext_vector_type(2)));
template <class Epi, class Sched, bool STAMP = false>
__device__ __forceinline__ void gemm_phase(PG8_LAS unsigned char* lds, const Gemm g, const Sched& S, const Epi& E, unsigned long long* stamps) {
    const int tid = tidx(), wid = __builtin_amdgcn_readfirstlane(tid >> 6), lane = tid & 63, wr = wid >> 2, wc = wid & 3, fr = lane & 15, fq = lane >> 4;
    const int K = g.K, nt = K / BK;
    int ts_lo = 0, ts_hi = 0, nts = 0; const unsigned long long rt_entry = STAMP ? (unsigned long long)wall_clock64() : 0ull;
#define PG8_STAMP() do { if (STAMP && wid == 0 && nts < 64) { const unsigned long long _c = (unsigned long long)clock64(); \
        ts_lo = (lane == nts) ? (int)(unsigned)_c : ts_lo; ts_hi = (lane == nts) ? (int)(unsigned)(_c >> 32) : ts_hi; ++nts; } } while (0)
    PG8_STAMP();
    unsigned voffA[2], voffB[2];
#pragma unroll
    for (int i = 0; i < 2; ++i) { int R, C; stage_rc(tid * 16 + i * 8192, R, C); const int Rb = Epi::PERM ? ((R & ~31) + perm32(R & 31)) : R;
        voffA[i] = (unsigned)(R * K + C) * 2u; voffB[i] = (unsigned)(Rb * K + C) * 2u; }
    const size_t kstep = (size_t)(BK * 2);
    const size_t hstep = (size_t)HALF * K * 2;
    const size_t tstep = 2 * hstep;
    const unsigned ldsw = (unsigned)wid * 1024u;
    const int aoff = lds_byte(wr * 64 + fr, fq * 8), boff = lds_byte(wc * 32 + fr, fq * 8);
#define PG8_SA(b, h) (((b) * 2 + (h)) * HTB)
#define PG8_SB(b, h) ((4 + (b) * 2 + (h)) * HTB)
#define PG8_STAGE(bufoff, gbase, voff) do { _Pragma("unroll") for (int _i = 0; _i < 2; ++_i) \
        __builtin_amdgcn_global_load_lds((const unsigned*)((const char*)(gbase) + (voff)[_i]), (PG8_LAS unsigned*)(lds + (bufoff) + ldsw + _i * 8192), 16, 0, 0); } while (0)
#define PG8_LDA(dst, b, h) do { _Pragma("unroll") for (int m = 0; m < 4; ++m) _Pragma("unroll") for (int k = 0; k < 2; ++k) dst[m][k] = *(const PG8_LAS bf16x8*)(lds + PG8_SA(b, h) + aoff + m * 2048 + k * 1024); } while (0)
#define PG8_LDB(dst, b, h) do { _Pragma("unroll") for (int n = 0; n < 2; ++n) _Pragma("unroll") for (int k = 0; k < 2; ++k) dst[n][k] = *(const PG8_LAS bf16x8*)(lds + PG8_SB(b, h) + boff + n * 2048 + k * 1024); } while (0)
#define PG8_MMA(ai, bj, At, Bt) do { __builtin_amdgcn_s_setprio(1); _Pragma("unroll") for (int m = 0; m < 4; ++m) _Pragma("unroll") for (int n = 0; n < 2; ++n) _Pragma("unroll") for (int k = 0; k < 2; ++k) \
        acc[ai][bj][m][n] = __builtin_amdgcn_mfma_f32_16x16x32_bf16(Bt[n][k], At[m][k], acc[ai][bj][m][n], 0, 0, 0); __builtin_amdgcn_s_setprio(0); } while (0)
#define PG8_WAIT_V(n) asm volatile("s_waitcnt vmcnt(" #n ")" ::: "memory")
#define PG8_WAIT_L(n) asm volatile("s_waitcnt lgkmcnt(" #n ")" ::: "memory")
#define PG8_BAR __builtin_amdgcn_s_barrier()
#define PG8_SCHED __builtin_amdgcn_sched_barrier(0)
    Unit cur, nxt; int ui = 0;
    if (!S.next(0, cur)) return;
    f32x4 acc[2][2][4][2];
#pragma unroll
    for (int a = 0; a < 2; ++a)
#pragma unroll
        for (int b = 0; b < 2; ++b)
#pragma unroll
            for (int m = 0; m < 4; ++m)
#pragma unroll
                for (int n = 0; n < 2; ++n) acc[a][b][m][n] = (f32x4){0.f, 0.f, 0.f, 0.f};
    bf16x8 At[4][2], B0[2][2], B1[2][2];
    const char* cA = (const char*)g.A + (size_t)cur.pm * tstep; const char* cB = (const char*)g.Bt + (size_t)cur.pn * tstep;
    S.a_ready(cur);
    PG8_STAGE(PG8_SB(0, 0), cB, voffB); PG8_STAGE(PG8_SA(0, 0), cA, voffA); PG8_STAGE(PG8_SB(0, 1), cB + hstep, voffB); PG8_STAGE(PG8_SA(0, 1), cA + hstep, voffA);
    if (wr == 1) PG8_BAR;
    PG8_WAIT_V(4); PG8_BAR;
    PG8_STAGE(PG8_SB(1, 0), cB + kstep, voffB); PG8_STAGE(PG8_SA(1, 0), cA + kstep, voffA); PG8_STAGE(PG8_SB(1, 1), cB + hstep + kstep, voffB);
    PG8_WAIT_V(6); PG8_BAR;
    PG8_STAMP();
    for (;;) {
        const bool has_next = S.next(ui + 1, nxt);
        const char* nA = has_next ? (const char*)g.A + (size_t)nxt.pm * tstep : cA; const char* nB = has_next ? (const char*)g.Bt + (size_t)nxt.pn * tstep : cB;
        for (int t = 0; t < nt; t += 2) {
            const bool last = (t == nt - 2);
            const char* a1 = cA + (size_t)(t + 1) * kstep;
            const char* a2 = last ? nA : cA + (size_t)(t + 2) * kstep; const char* b2 = last ? nB : cB + (size_t)(t + 2) * kstep;
            const char* a3 = a2 + kstep; const char* b3 = b2 + kstep;
            if (last && has_next) S.a_ready(nxt);
            PG8_LDB(B0, 0, 0); PG8_SCHED; PG8_LDA(At, 0, 0); PG8_STAGE(PG8_SA(1, 1), a1 + hstep, voffA);
            PG8_WAIT_L(8); PG8_BAR; PG8_WAIT_L(0); PG8_MMA(0, 0, At, B0); PG8_BAR; PG8_SCHED;
            PG8_LDB(B1, 0, 1); PG8_STAGE(PG8_SB(0, 0), b2, voffB);
            PG8_BAR; PG8_WAIT_L(0); PG8_MMA(0, 1, At, B1); PG8_BAR;
            PG8_LDA(At, 0, 1); PG8_STAGE(PG8_SA(0, 0), a2, voffA);
            PG8_BAR; PG8_WAIT_L(0); PG8_MMA(1, 0, At, B0); PG8_BAR; PG8_SCHED;
            PG8_STAGE(PG8_SB(0, 1), b2 + hstep, voffB);
            PG8_WAIT_V(6); PG8_BAR; PG8_MMA(1, 1, At, B1); PG8_BAR;
            PG8_LDB(B0, 1, 0); PG8_SCHED; PG8_LDA(At, 1, 0); PG8_STAGE(PG8_SA(0, 1), a2 + hstep, voffA);
            PG8_WAIT_L(8); PG8_BAR; PG8_WAIT_L(0); PG8_MMA(0, 0, At, B0); PG8_BAR; PG8_SCHED;
            PG8_LDB(B1, 1, 1); PG8_STAGE(PG8_SB(1, 0), b3, voffB);
            PG8_BAR; PG8_WAIT_L(0); PG8_MMA(0, 1, At, B1); PG8_BAR;
            PG8_LDA(At, 1, 1); PG8_STAGE(PG8_SA(1, 0), a3, voffA);
            PG8_BAR; PG8_WAIT_L(0); PG8_MMA(1, 0, At, B0); PG8_BAR; PG8_SCHED;
            PG8_STAGE(PG8_SB(1, 1), b3 + hstep, voffB);
            PG8_WAIT_V(6); PG8_BAR; PG8_MMA(1, 1, At, B1); PG8_BAR;
        }
        PG8_STAMP();
        if constexpr (!Epi::AFTER_DRAIN) { E(acc, cur, wr, wc, fr, fq); S.done(cur); }
        PG8_STAMP();
        if (!has_next) break;
#pragma unroll
        for (int a = 0; a < 2; ++a)
#pragma unroll
            for (int b = 0; b < 2; ++b)
#pragma unroll
                for (int m = 0; m < 4; ++m)
#pragma unroll
                    for (int n = 0; n < 2; ++n) acc[a][b][m][n] = (f32x4){0.f, 0.f, 0.f, 0.f};
        cur = nxt; cA = nA; cB = nB; ++ui;
    }
    PG8_WAIT_V(0);
    if (wr == 0) PG8_BAR;
    PG8_BAR;
    if constexpr (Epi::AFTER_DRAIN) { E.fused(acc, cur, wr, wc, fr, fq, lds, wid, lane); S.done(cur); }
    PG8_STAMP();
    if (STAMP && wid == 0) { stamps[lane] = lane < nts ? (((unsigned long long)(unsigned)ts_hi << 32) | (unsigned)ts_lo) : 0ull;
        if (lane == 62) stamps[62] = rt_entry; if (lane == 63) stamps[63] = (unsigned long long)wall_clock64(); }
#undef PG8_STAMP
#undef PG8_SA
#undef PG8_SB
#undef PG8_STAGE
#undef PG8_LDA
#undef PG8_LDB
#undef PG8_MMA
#undef PG8_WAIT_V
#undef PG8_WAIT_L
#undef PG8_BAR
#undef PG8_SCHED
}
}

namespace pg8 {
struct EpiProjT {
  static constexpr bool PERM = true, AFTER_DRAIN = false;
  bf16_t* O; int ldc; int ncols;
  __device__ __forceinline__ void operator()(const f32x4 (&acc)[2][2][4][2], const Unit& u, int wr, int wc, int fr, int fq) const {
    const int row0 = u.pm * BM + wr * 64 + fr, col0 = u.pn * BM + wc * 32 + 8 * fq;
#pragma unroll
    for (int ai = 0; ai < 2; ++ai)
#pragma unroll
      for (int m = 0; m < 4; ++m) {
        bf16_t* rowp = O + (size_t)(row0 + ai * HALF + m * 16) * ldc + col0;
#pragma unroll
        for (int bj = 0; bj < 2; ++bj) {
          if (col0 + bj * HALF < ncols) {
            const f32x4 v0 = acc[ai][bj][m][0], v1 = acc[ai][bj][m][1];
            u32x4 w; w.x = cvt_pk_bf16(v0[0], v0[1]); w.y = cvt_pk_bf16(v0[2], v0[3]); w.z = cvt_pk_bf16(v1[0], v1[1]); w.w = cvt_pk_bf16(v1[2], v1[3]);
            *(u32x4*)(rowp + bj * HALF) = w;
          }
        }
      }
  }
};
struct EpiGluT {
  static constexpr bool PERM = true, AFTER_DRAIN = false;
  const bf16_t* Y1; const float* bglu; bf16_t* O;
  __device__ __forceinline__ void operator()(const f32x4 (&acc)[2][2][4][2], const Unit& u, int wr, int wc, int fr, int fq) const {
    const int row0 = u.pm * BM + wr * 64 + fr, col0 = u.pn * BM + wc * 32 + 8 * fq;
    f32x4 bv[2][2];
#pragma unroll
    for (int bj = 0; bj < 2; ++bj)
#pragma unroll
      for (int n = 0; n < 2; ++n) bv[bj][n] = *(const f32x4*)(bglu + col0 + bj * HALF + 4 * n);
#pragma unroll
    for (int ai = 0; ai < 2; ++ai)
#pragma unroll
      for (int m = 0; m < 4; ++m) {
        const size_t r = (size_t)(row0 + ai * HALF + m * 16);
#pragma unroll
        for (int bj = 0; bj < 2; ++bj) {
          const u32x4 yv = *(const u32x4*)(Y1 + r * 512 + col0 + bj * HALF);
          const f32x4 v0 = acc[ai][bj][m][0] + bv[bj][0], v1 = acc[ai][bj][m][1] + bv[bj][1];
          float o[8];
#pragma unroll
          for (int q = 0; q < 4; ++q) {
            const float ylo = __uint_as_float(yv[q] << 16), yhi = __uint_as_float(yv[q] & 0xffff0000u);
            const float a0 = q < 2 ? v0[2 * q] : v1[2 * q - 4], a1 = q < 2 ? v0[2 * q + 1] : v1[2 * q - 3];
            o[2 * q] = ylo / (1.f + __expf(-a0));
            o[2 * q + 1] = yhi / (1.f + __expf(-a1));
          }
          u32x4 w; w.x = cvt_pk_bf16(o[0], o[1]); w.y = cvt_pk_bf16(o[2], o[3]); w.z = cvt_pk_bf16(o[4], o[5]); w.w = cvt_pk_bf16(o[6], o[7]);
          *(u32x4*)(O + r * 1024 + col0 + bj * HALF) = w;
        }
      }
  }
};
struct EpiGateT {
  static constexpr bool PERM = true, AFTER_DRAIN = false;
  const bf16_t* T1; bf16_t* O;
  __device__ __forceinline__ void operator()(const f32x4 (&acc)[2][2][4][2], const Unit& u, int wr, int wc, int fr, int fq) const {
    const int row0 = u.pm * BM + wr * 64 + fr, col0 = u.pn * BM + wc * 32 + 8 * fq;
#pragma unroll
    for (int ai = 0; ai < 2; ++ai)
#pragma unroll
      for (int m = 0; m < 4; ++m) {
        const size_t r = (size_t)(row0 + ai * HALF + m * 16);
#pragma unroll
        for (int bj = 0; bj < 2; ++bj) {
          const u32x4 tv = *(const u32x4*)(T1 + r * 512 + col0 + bj * HALF);
          const f32x4 v0 = acc[ai][bj][m][0], v1 = acc[ai][bj][m][1];
          u32x4 w;
          w.x = cvt_pk_bf16(__uint_as_float(tv[0] << 16) * v0[0], __uint_as_float(tv[0] & 0xffff0000u) * v0[1]);
          w.y = cvt_pk_bf16(__uint_as_float(tv[1] << 16) * v0[2], __uint_as_float(tv[1] & 0xffff0000u) * v0[3]);
          w.z = cvt_pk_bf16(__uint_as_float(tv[2] << 16) * v1[0], __uint_as_float(tv[2] & 0xffff0000u) * v1[1]);
          w.w = cvt_pk_bf16(__uint_as_float(tv[3] << 16) * v1[2], __uint_as_float(tv[3] & 0xffff0000u) * v1[3]);
          *(u32x4*)(O + r * 1024 + 512 + col0 + bj * HALF) = w;
        }
      }
  }
};
struct EpiWoutT {
  static constexpr bool PERM = false, AFTER_DRAIN = false;
  const float* X; const float* mod; bf16_t* H2;
  __device__ __forceinline__ void operator()(const f32x4 (&acc)[2][2][4][2], const Unit& u, int wr, int wc, int fr, int fq) const {
    const int row0 = u.pm * BM + wr * 64 + fr, col0 = u.pn * BM + wc * 32 + 4 * fq;
    const float* g1p = mod + ((u.pm * BM) >> 11) * 6144 + 2 * 1024 + col0;
    f32x4 gv[2][2];
#pragma unroll
    for (int bj = 0; bj < 2; ++bj)
#pragma unroll
      for (int n = 0; n < 2; ++n) gv[bj][n] = *(const f32x4*)(g1p + bj * HALF + n * 16);
#pragma unroll
    for (int ai = 0; ai < 2; ++ai)
#pragma unroll
      for (int m = 0; m < 4; ++m) {
        const size_t off = (size_t)(row0 + ai * HALF + m * 16) * 1024 + col0;
        bf16_t* hrow = H2 + (size_t)(row0 + ai * HALF + m * 16) * 2048 + 1024 + col0;
#pragma unroll
        for (int bj = 0; bj < 2; ++bj)
#pragma unroll
          for (int n = 0; n < 2; ++n) {
            const f32x4 xv = *(const f32x4*)(X + off + bj * HALF + n * 16);
            const f32x4 hv = xv + gv[bj][n] * acc[ai][bj][m][n];
            *(uint2*)(hrow + bj * HALF + n * 16) = make_uint2(cvt_pk_bf16(hv[0], hv[1]), cvt_pk_bf16(hv[2], hv[3]));
          }
      }
  }
};
}

struct EpiProj {
  u16* proj;
  __device__ __forceinline__ void operator()(int r, int c, f32x4 v) const {
    if (c < INC) {
#pragma unroll
      for (int j = 0; j < 4; ++j) proj[(size_t)(r + j) * INC + c] = f2bf(v[j]);
    }
  }
};
struct EpiGlu {
  const u16* y1; const float* bglu; u16* a2;
  __device__ __forceinline__ void operator()(int r, int c, f32x4 v) const {
    float bb = bglu[c];
#pragma unroll
    for (int j = 0; j < 4; ++j) {
      float y = bf2f(y1[(size_t)(r + j) * 512 + c]);
      a2[(size_t)(r + j) * 1024 + c] = f2bf(y * sigmoidf(v[j] + bb));
    }
  }
};
struct EpiGate {
  const u16* t1; u16* a2;
  __device__ __forceinline__ void operator()(int r, int c, f32x4 v) const {
#pragma unroll
    for (int j = 0; j < 4; ++j) {
      float t = bf2f(t1[(size_t)(r + j) * 512 + c]);
      a2[(size_t)(r + j) * 1024 + 512 + c] = f2bf(t * v[j]);
    }
  }
};
struct EpiWout {
  const float* x; const float* mod; float* h2;
  __device__ __forceinline__ void operator()(int r, int c, f32x4 v) const {
    float g1 = mod[(r >> 11) * 6144 + 2 * 1024 + c];
#pragma unroll
    for (int j = 0; j < 4; ++j) h2[(size_t)(r + j) * 1024 + c] = x[(size_t)(r + j) * 1024 + c] + g1 * v[j];
  }
};
struct EpiQ {
  u16* q;
  __device__ __forceinline__ void operator()(int r, int c, f32x4 v) const {
#pragma unroll
    for (int j = 0; j < 4; ++j) q[(size_t)(r + j) * 2048 + c] = f2bf(v[j]);
  }
};

__device__ __forceinline__ void ph_s5scan(const P& p, char* smem, int bid, int nb) {
  const int wid = tidx() >> 6, lane = tidx() & 63;
  float* U = (float*)(smem + wid * 8448);
  unsigned* H = (unsigned*)((char*)U + 4096);
  const int fr = lane & 15, fq = lane >> 4;
  for (int s = bid * 8 + wid; s < 2048; s += nb * 8) {
    const int g = s & 31, d = (s >> 5) & 1, b = s >> 6;
    const int ci = (d * 32 + g) * 64 + lane;
    const float abr = p.s5ab()[ci * 2], abi = p.s5ab()[ci * 2 + 1];
    float bbr[16], bbi[16];
#pragma unroll
    for (int q = 0; q < 4; ++q) {
      float4 t = *(const float4*)(p.s5bb() + (size_t)ci * 32 + q * 4);
      bbr[q * 4] = t.x; bbr[q * 4 + 1] = t.y; bbr[q * 4 + 2] = t.z; bbr[q * 4 + 3] = t.w;
      float4 t2 = *(const float4*)(p.s5bb() + (size_t)ci * 32 + 16 + q * 4);
      bbi[q * 4] = t2.x; bbi[q * 4 + 1] = t2.y; bbi[q * 4 + 2] = t2.z; bbi[q * 4 + 3] = t2.w;
    }
    bf16x8 cf[4];
#pragma unroll
    for (int kb = 0; kb < 4; ++kb)
      cf[kb] = *(const bf16x8*)(p.s5ct() + ((size_t)(d * 32 + g) * 16 + fr) * 128 + kb * 32 + fq * 8);
    const float dcoef = p.s5_d[g * 16 + fr];
    u16* ydst = d ? p.ys5b() : p.ys5f();
    float hr = 0.f, hi = 0.f;
    for (int seg = 0; seg < 2; ++seg) {
      const int L = seg ? 2048 : 256;
      const int rowbase = seg ? b * 2048 : NLAT + b * 256;
      for (int c0 = 0; c0 < L; c0 += 64) {
        {
          int pos = c0 + lane;
          int t = d ? (L - 1 - pos) : pos;
          const u16* src = p.proj() + (size_t)(rowbase + t) * INC + g * 16;
          uint4 v0 = *(const uint4*)src, v1 = *(const uint4*)(src + 8);
          float4* ud = (float4*)(U + lane * 16);
          ud[0] = make_float4(bflo(v0.x), bfhi(v0.x), bflo(v0.y), bfhi(v0.y));
          ud[1] = make_float4(bflo(v0.z), bfhi(v0.z), bflo(v0.w), bfhi(v0.w));
          ud[2] = make_float4(bflo(v1.x), bfhi(v1.x), bflo(v1.y), bfhi(v1.y));
          ud[3] = make_float4(bflo(v1.z), bfhi(v1.z), bflo(v1.w), bfhi(v1.w));
        }
        for (int sub = 0; sub < 4; ++sub) {
#pragma unroll 4
          for (int i = 0; i < 16; ++i) {
            const float4* up = (const float4*)(U + (sub * 16 + i) * 16);
            float4 u0 = up[0], u1 = up[1], u2 = up[2], u3 = up[3];
            float ur[16] = {u0.x, u0.y, u0.z, u0.w, u1.x, u1.y, u1.z, u1.w, u2.x, u2.y, u2.z, u2.w, u3.x, u3.y, u3.z, u3.w};
            float br0 = 0.f, br1 = 0.f, bi0 = 0.f, bi1 = 0.f;
#pragma unroll
            for (int h = 0; h < 16; h += 2) {
              br0 += bbr[h] * ur[h]; br1 += bbr[h + 1] * ur[h + 1];
              bi0 += bbi[h] * ur[h]; bi1 += bbi[h + 1] * ur[h + 1];
            }
            float nr = abr * hr - abi * hi + (br0 + br1);
            float ni = abr * hi + abi * hr + (bi0 + bi1);
            hr = nr; hi = ni;
            if (seg) H[i * 68 + lane] = pack2(hr, hi);
          }
          if (seg) {
            f32x4 acc = (f32x4){0.f, 0.f, 0.f, 0.f};
#pragma unroll
            for (int kb = 0; kb < 4; ++kb) {
              bf16x8 a = *(const bf16x8*)((const u16*)H + fr * 136 + kb * 32 + fq * 8);
              acc = __builtin_amdgcn_mfma_f32_16x16x32_bf16(a, cf[kb], acc, 0, 0, 0);
            }
#pragma unroll
            for (int j = 0; j < 4; ++j) {
              int pi = sub * 16 + fq * 4 + j;
              int pos = c0 + pi;
              int t = d ? (L - 1 - pos) : pos;
              float y = acc[j];
              if (d == 0) y += dcoef * U[pi * 16 + fr];
              ydst[(size_t)(b * 2048 + t) * 512 + g * 16 + fr] = f2bf(y);
            }
          }
        }
      }
    }
  }
}

#define S5_LD 168
__device__ __forceinline__ void ph_s5scan2(const P& p, char* smem, int bid, int nb) {
  const int wid = tidx() >> 6, lane = tidx() & 63;
  u16* H = (u16*)(smem + wid * (32 * S5_LD * 2));
  const int n = lane & 31, hh = lane >> 5, fr = lane & 15, fq = lane >> 4;
  for (int r = lane; r < 32; r += 64) {
    *(uint4*)(H + r * S5_LD + 144) = make_uint4(0u, 0u, 0u, 0u);
    *(uint4*)(H + r * S5_LD + 152) = make_uint4(0u, 0u, 0u, 0u);
    *(uint4*)(H + r * S5_LD + 160) = make_uint4(0u, 0u, 0u, 0u);
  }
  for (int s = bid * 8 + wid; s < 2048; s += nb * 8) {
    const int g = s & 31, d = (s >> 5) & 1, b = s >> 6;
    float ar[2][4], ai[2][4], a8r[2], a8i[2];
#pragma unroll
    for (int st = 0; st < 2; ++st) {
      const int ci = (d * 32 + g) * 64 + st * 32 + n;
      const float xr = p.s5ab()[ci * 2], xi = p.s5ab()[ci * 2 + 1];
      ar[st][0] = xr; ai[st][0] = xi;
#pragma unroll
      for (int k = 1; k < 4; ++k) {
        ar[st][k] = ar[st][k - 1] * xr - ai[st][k - 1] * xi;
        ai[st][k] = ar[st][k - 1] * xi + ai[st][k - 1] * xr;
      }
      a8r[st] = ar[st][3] * ar[st][3] - ai[st][3] * ai[st][3];
      a8i[st] = 2.f * ar[st][3] * ai[st][3];
    }
    bf16x8 bfr[4];
#pragma unroll
    for (int nt = 0; nt < 4; ++nt) {
      const int ci = (d * 32 + g) * 64 + (nt & 1) * 32 + n;
      const float4 t0 = *(const float4*)(p.s5bb() + (size_t)ci * 32 + (nt >> 1) * 16 + 8 * hh);
      const float4 t1 = *(const float4*)(p.s5bb() + (size_t)ci * 32 + (nt >> 1) * 16 + 8 * hh + 4);
      union { unsigned u[4]; bf16x8 v; } t;
      t.u[0] = pack2(t0.x, t0.y); t.u[1] = pack2(t0.z, t0.w); t.u[2] = pack2(t1.x, t1.y); t.u[3] = pack2(t1.z, t1.w);
      bfr[nt] = t.v;
    }
    bf16x8 cf[5];
#pragma unroll
    for (int kb = 0; kb < 4; ++kb)
      cf[kb] = *(const bf16x8*)(p.s5ct() + ((size_t)(d * 32 + g) * 16 + fr) * 128 + kb * 32 + fq * 8);
    {
      const float dv = (d == 0) ? p.s5_d[g * 16 + fr] : 0.f;
      union { u16 h[8]; bf16x8 v; } t;
#pragma unroll
      for (int j = 0; j < 8; ++j) t.h[j] = (8 * fq + j == fr) ? f2bf(dv) : (u16)0;
      cf[4] = t.v;
    }
    u16* ydst = d ? p.ys5b() : p.ys5f();
    float hcr[2] = {0.f, 0.f}, hci[2] = {0.f, 0.f};
    for (int seg = 0; seg < 2; ++seg) {
      const int L = seg ? 2048 : 256;
      const int rowbase = seg ? b * 2048 : NLAT + b * 256;
      uint4 anext;
      {
        const int pos = n;
        const int t = d ? (L - 1 - pos) : pos;
        anext = *(const uint4*)(p.proj() + (size_t)(rowbase + t) * INC + g * 16 + 8 * hh);
      }
      for (int c0 = 0; c0 < L; c0 += 32) {
        const uint4 acur = anext;
        if (c0 + 32 < L) {
          const int pos = c0 + 32 + n;
          const int t = d ? (L - 1 - pos) : pos;
          anext = *(const uint4*)(p.proj() + (size_t)(rowbase + t) * INC + g * 16 + 8 * hh);
        }
        union { uint4 q; bf16x8 v; } af;
        af.q = acur;
        f32x16 acc[4];
#pragma unroll
        for (int nt = 0; nt < 4; ++nt) {
          f32x16 z;
#pragma unroll
          for (int r = 0; r < 16; ++r) z[r] = 0.f;
          acc[nt] = __builtin_amdgcn_mfma_f32_32x32x16_bf16(af.v, bfr[nt], z, 0, 0, 0);
        }
#pragma unroll
        for (int st = 0; st < 2; ++st)
#pragma unroll
          for (int gg = 0; gg < 4; ++gg)
#pragma unroll
            for (int j = 1; j < 4; ++j) {
              const float pr = acc[st][4 * gg + j - 1], pi = acc[2 + st][4 * gg + j - 1];
              acc[st][4 * gg + j] += ar[st][0] * pr - ai[st][0] * pi;
              acc[2 + st][4 * gg + j] += ar[st][0] * pi + ai[st][0] * pr;
            }
        float sr[2][4], si[2][4];
        {
          float e0r[2][4], e0i[2][4], qpr[2][4], qpi[2][4], s1r[2][4], s1i[2][4];
#pragma unroll
          for (int st = 0; st < 2; ++st)
#pragma unroll
            for (int gg = 0; gg < 4; ++gg) {
              e0r[st][gg] = __shfl_xor(acc[st][4 * gg + 3], 32, 64);
              e0i[st][gg] = __shfl_xor(acc[2 + st][4 * gg + 3], 32, 64);
            }
#pragma unroll
          for (int st = 0; st < 2; ++st) {
            float qr = hcr[st], qi = hci[st];
#pragma unroll
            for (int gg = 0; gg < 4; ++gg) {
              const float er = acc[st][4 * gg + 3], ei = acc[2 + st][4 * gg + 3];
              qpr[st][gg] = qr; qpi[st][gg] = qi;
              s1r[st][gg] = ar[st][3] * qr - ai[st][3] * qi + e0r[st][gg];
              s1i[st][gg] = ar[st][3] * qi + ai[st][3] * qr + e0i[st][gg];
              const float nqr = ar[st][3] * s1r[st][gg] - ai[st][3] * s1i[st][gg] + er;
              const float nqi = ar[st][3] * s1i[st][gg] + ai[st][3] * s1r[st][gg] + ei;
              qr = nqr; qi = nqi;
            }
            hcr[st] = qr; hci[st] = qi;
          }
#pragma unroll
          for (int st = 0; st < 2; ++st)
#pragma unroll
            for (int gg = 0; gg < 4; ++gg) {
              const float s0r = __shfl_xor(qpr[st][gg], 32, 64), s0i = __shfl_xor(qpi[st][gg], 32, 64);
              sr[st][gg] = hh ? s1r[st][gg] : s0r;
              si[st][gg] = hh ? s1i[st][gg] : s0i;
            }
        }
        if (seg) {
#pragma unroll
          for (int st = 0; st < 2; ++st)
#pragma unroll
            for (int gg = 0; gg < 4; ++gg)
#pragma unroll
              for (int j = 0; j < 4; ++j) {
                const float hr_ = acc[st][4 * gg + j] + ar[st][j] * sr[st][gg] - ai[st][j] * si[st][gg];
                const float hi_ = acc[2 + st][4 * gg + j] + ar[st][j] * si[st][gg] + ai[st][j] * sr[st][gg];
                const int tok = 8 * gg + 4 * hh + j;
                *(unsigned*)(H + tok * S5_LD + 2 * (st * 32 + n)) = pack2(hr_, hi_);
              }
          *(uint4*)(H + n * S5_LD + 128 + 8 * hh) = acur;
#pragma unroll
          for (int mt = 0; mt < 2; ++mt) {
            f32x4 y = (f32x4){0.f, 0.f, 0.f, 0.f};
#pragma unroll
            for (int kb = 0; kb < 5; ++kb) {
              const bf16x8 a = *(const bf16x8*)(H + (16 * mt + fr) * S5_LD + kb * 32 + fq * 8);
              y = __builtin_amdgcn_mfma_f32_16x16x32_bf16(a, cf[kb], y, 0, 0, 0);
            }
#pragma unroll
            for (int j = 0; j < 4; ++j) {
              const int pos = c0 + 16 * mt + 4 * fq + j;
              const int t = d ? (L - 1 - pos) : pos;
              ydst[(size_t)(b * 2048 + t) * 512 + g * 16 + fr] = f2bf(y[j]);
            }
          }
        }
      }
    }
  }
}

__device__ __forceinline__ float4 mix_load4(const u16* __restrict__ proj, size_t row, int col, const size_t* nrow,
                                            const bool* nval, float4 mu) {
  uint2 cz = *(const uint2*)(proj + row * INC + col);
  float z[4] = {bflo(cz.x), bfhi(cz.x), bflo(cz.y), bfhi(cz.y)};
  float o[4];
  float m[4] = {mu.x, mu.y, mu.z, mu.w};
#pragma unroll
  for (int j = 0; j < 4; ++j) {
    float nbv = 0.f;
    if (nval[j]) {
      u16 t = proj[nrow[j] * INC + col + j];
      nbv = bf2f(t);
    }
    o[j] = z[j] + (nbv - z[j]) * m[j];
  }
  return make_float4(o[0], o[1], o[2], o[3]);
}
__device__ __forceinline__ void neighbours(bool isctx, size_t row, int t, size_t* nrow, bool* nval) {
  if (isctx) {
    nrow[0] = row - 1; nval[0] = t > 0;
    nrow[1] = row + 1; nval[1] = t < 255;
    nrow[2] = row - 1; nval[2] = t > 0;
    nrow[3] = row + 1; nval[3] = t < 255;
  } else {
    int col = t & 63, gr = t >> 6;
    nrow[0] = row - 1; nval[0] = col > 0;
    nrow[1] = row + 1; nval[1] = col < 63;
    nrow[2] = row - 64; nval[2] = gr > 0;
    nrow[3] = row + 64; nval[3] = gr < 31;
  }
}

__device__ __forceinline__ void ph_rwscan(const P& p, char* smem, int bid, int nb) {
  const int tid = tidx(), sl = tid >> 8, stid = tid & 255, wv = stid >> 6, lane = tid & 63;
  char* sb = smem + sl * 49152;
  float* OPS = (float*)sb;
  float* LW = (float*)(sb + 24576);
  float* LA = LW + 512;
  float* WW = (float*)(sb + 28672);
  float* WA = WW + 2048;
  float* YB = (float*)(sb + 45056);
  const int tt = stid >> 4, part = stid & 15;
  const int vrow = wv * 16 + (lane >> 2), kq = lane & 3;
  for (int sp = bid; sp < 256; sp += nb) {
    const int s = sp * 2 + sl;
    const int d = s & 1, h = (s >> 1) & 7, b = s >> 4;
    __syncthreads();
    for (int e = stid; e < 2048; e += 256) {
      int j = e >> 6, cc = e & 63;
      WW[e] = p.rw_w_w2[(size_t)(d * 32 + j) * 512 + h * 64 + cc];
      WA[e] = p.rw_w_a2[(size_t)(d * 32 + j) * 512 + h * 64 + cc];
    }
    const int hc = h * 64 + part * 4;
    const float4 w0v = *(const float4*)(p.rw_w0 + d * 512 + hc);
    const float4 a0v = *(const float4*)(p.rw_a0 + d * 512 + hc);
    const float4 kkv = *(const float4*)(p.rw_k_k + hc);
    const float4 kav = *(const float4*)(p.rw_k_a + hc);
    const float4 rkv = *(const float4*)(p.rw_r_k + hc);
    const float4 mur = *(const float4*)(p.rw_mu + hc);
    const float4 muk = *(const float4*)(p.rw_mu + 512 + hc);
    const float4 muv = *(const float4*)(p.rw_mu + 1024 + hc);
    const float4 mul = *(const float4*)(p.rw_mu + 1536 + part * 4);
    u16* ydst = d ? p.yrwb() : p.yrwf();
    float S[16];
#pragma unroll
    for (int i = 0; i < 16; ++i) S[i] = 0.f;
    for (int seg = 0; seg < 2; ++seg) {
      const int L = seg ? 2048 : 256;
      const size_t rowbase = seg ? (size_t)b * 2048 : (size_t)NLAT + b * 256;
      for (int c0 = 0; c0 < L; c0 += 16) {
        const int pos = c0 + tt;
        const int t = d ? (L - 1 - pos) : pos;
        const size_t row = rowbase + t;
        size_t nrow[4];
        bool nval[4];
        neighbours(seg == 0, row, t, nrow, nval);
        float4 r4 = mix_load4(p.proj(), row, 512 + hc, nrow, nval, mur);
        float4 k4 = mix_load4(p.proj(), row, 512 + 512 + hc, nrow, nval, muk);
        float4 v4 = mix_load4(p.proj(), row, 512 + 1024 + hc, nrow, nval, muv);
        float4 l4 = mix_load4(p.proj(), row, 512 + 1536 + part * 4, nrow, nval, mul);
        if (part < 8) {
          *(float4*)(LW + tt * 32 + part * 4) = make_float4(tanhf(l4.x), tanhf(l4.y), tanhf(l4.z), tanhf(l4.w));
        } else {
          *(float4*)(LA + tt * 32 + (part - 8) * 4) = l4;
        }
        __syncthreads();
        float wp[4] = {w0v.x, w0v.y, w0v.z, w0v.w};
        float ap[4] = {a0v.x, a0v.y, a0v.z, a0v.w};
#pragma unroll 8
        for (int j = 0; j < 32; ++j) {
          float lw = LW[tt * 32 + j], la = LA[tt * 32 + j];
          float4 ww = *(const float4*)(WW + j * 64 + part * 4);
          float4 wa = *(const float4*)(WA + j * 64 + part * 4);
          wp[0] += lw * ww.x; wp[1] += lw * ww.y; wp[2] += lw * ww.z; wp[3] += lw * ww.w;
          ap[0] += la * wa.x; ap[1] += la * wa.y; ap[2] += la * wa.z; ap[3] += la * wa.w;
        }
        float rr[4] = {r4.x, r4.y, r4.z, r4.w}, kk4[4] = {k4.x, k4.y, k4.z, k4.w};
        float kkc[4] = {kkv.x, kkv.y, kkv.z, kkv.w}, kac[4] = {kav.x, kav.y, kav.z, kav.w}, rkc[4] = {rkv.x, rkv.y, rkv.z, rkv.w};
        float dec[4], aa[4], kd[4], kkr[4];
        float ss = 0.f, bon = 0.f;
#pragma unroll
        for (int i = 0; i < 4; ++i) {
          float xw = -wp[i];
          float sp_ = fmaxf(xw, 0.f) + log1pf(expf(-fabsf(xw)));
          float wl = -sp_ - 0.5f;
          dec[i] = expf(-expf(wl));
          aa[i] = 1.f / (1.f + expf(-ap[i]));
          kd[i] = kk4[i] * (1.f + (aa[i] - 1.f) * kac[i]);
          kkr[i] = kk4[i] * kkc[i];
          ss += kkr[i] * kkr[i];
          bon += rr[i] * kd[i] * rkc[i];
        }
#pragma unroll
        for (int m = 0; m < 4; ++m) {
          ss = dpp_add(ss, m, 0);
          bon = dpp_add(bon, m, 0);
        }
        float inv = rsqrtf(ss + 1e-12f);
        float* o = OPS + tt * 384 + part * 4;
        *(float4*)(o + 0) = r4;
        *(float4*)(o + 64) = make_float4(dec[0], dec[1], dec[2], dec[3]);
        *(float4*)(o + 128) = make_float4(kd[0], kd[1], kd[2], kd[3]);
        *(float4*)(o + 192) = make_float4(-kkr[0] * inv, -kkr[1] * inv, -kkr[2] * inv, -kkr[3] * inv);
        *(float4*)(o + 256) = make_float4(kkr[0] * inv * aa[0], kkr[1] * inv * aa[1], kkr[2] * inv * aa[2], kkr[3] * inv * aa[3]);
        *(float4*)(o + 320) = v4;
        if (seg && part == 0) p.bsc()[((size_t)d * NLAT + row) * 8 + h] = bon;
        __syncthreads();
        for (int i = 0; i < 16; ++i) {
          const float* oo = OPS + i * 384 + kq * 16;
          float kn[16], wv_[16], bv[16], kdv[16];
#pragma unroll
          for (int q = 0; q < 4; ++q) {
            float4 a = *(const float4*)(oo + 192 + q * 4);
            kn[q * 4] = a.x; kn[q * 4 + 1] = a.y; kn[q * 4 + 2] = a.z; kn[q * 4 + 3] = a.w;
            float4 w_ = *(const float4*)(oo + 64 + q * 4);
            wv_[q * 4] = w_.x; wv_[q * 4 + 1] = w_.y; wv_[q * 4 + 2] = w_.z; wv_[q * 4 + 3] = w_.w;
            float4 b_ = *(const float4*)(oo + 256 + q * 4);
            bv[q * 4] = b_.x; bv[q * 4 + 1] = b_.y; bv[q * 4 + 2] = b_.z; bv[q * 4 + 3] = b_.w;
            float4 k_ = *(const float4*)(oo + 128 + q * 4);
            kdv[q * 4] = k_.x; kdv[q * 4 + 1] = k_.y; kdv[q * 4 + 2] = k_.z; kdv[q * 4 + 3] = k_.w;
          }
          float vv = OPS[i * 384 + 320 + vrow];
          float s0 = 0.f, s1 = 0.f, s2 = 0.f, s3 = 0.f;
#pragma unroll
          for (int q = 0; q < 16; q += 4) {
            s0 += S[q] * kn[q]; s1 += S[q + 1] * kn[q + 1]; s2 += S[q + 2] * kn[q + 2]; s3 += S[q + 3] * kn[q + 3];
          }
          float sa = (s0 + s1) + (s2 + s3);
          sa = dpp_add(sa, 0, 0);
          sa = dpp_add(sa, 1, 0);
#pragma unroll
          for (int q = 0; q < 16; ++q) S[q] = S[q] * wv_[q] + sa * bv[q] + vv * kdv[q];
          if (seg) {
            float rv[16];
#pragma unroll
            for (int q = 0; q < 4; ++q) {
              float4 a = *(const float4*)(oo + q * 4);
              rv[q * 4] = a.x; rv[q * 4 + 1] = a.y; rv[q * 4 + 2] = a.z; rv[q * 4 + 3] = a.w;
            }
            float y0 = 0.f, y1 = 0.f, y2 = 0.f, y3 = 0.f;
#pragma unroll
            for (int q = 0; q < 16; q += 4) {
              y0 += S[q] * rv[q]; y1 += S[q + 1] * rv[q + 1]; y2 += S[q + 2] * rv[q + 2]; y3 += S[q + 3] * rv[q + 3];
            }
            float y = (y0 + y1) + (y2 + y3);
            y = dpp_add(y, 0, 0);
            y = dpp_add(y, 1, 0);
            if (kq == 0) YB[i * 64 + vrow] = y;
          }
        }
        __syncthreads();
        if (seg) {
          float4 yv = *(const float4*)(YB + tt * 64 + part * 4);
          uint2 o2;
          o2.x = pack2(yv.x, yv.y); o2.y = pack2(yv.z, yv.w);
          *(uint2*)(ydst + row * 512 + hc) = o2;
        }
      }
    }
  }
}

#define LAS __attribute__((address_space(3)))
#define RW_AR_LD 68
#define RW_RM_LD 72
#define RW_SLOT_BYTES 13824
#define RW_SCR_BYTES 6912
#define RW_STREAM_BYTES (4 * RW_SLOT_BYTES + 3 * RW_SCR_BYTES + 2304 + 64)
__device__ __forceinline__ unsigned cvtpk(float lo, float hi) { return pack2(lo, hi); }
__device__ __forceinline__ float dpp_shr_add(float v, const int n) {
  int m;
  switch (n) {
    case 1: m = __builtin_amdgcn_update_dpp(0, __float_as_int(v), 0x111, 0xf, 0xf, true); break;
    case 2: m = __builtin_amdgcn_update_dpp(0, __float_as_int(v), 0x112, 0xf, 0xf, true); break;
    case 4: m = __builtin_amdgcn_update_dpp(0, __float_as_int(v), 0x114, 0xf, 0xf, true); break;
    default: m = __builtin_amdgcn_update_dpp(0, __float_as_int(v), 0x118, 0xf, 0xf, true); break;
  }
  return v + __int_as_float(m);
}
__device__ __forceinline__ unsigned dpp_row_shr1(unsigned old, unsigned v) { return (unsigned)__builtin_amdgcn_update_dpp((int)old, (int)v, 0x111, 0xf, 0xf, false); }
__device__ __forceinline__ unsigned dpp_row_shl1(unsigned old, unsigned v) { return (unsigned)__builtin_amdgcn_update_dpp((int)old, (int)v, 0x101, 0xf, 0xf, false); }
__device__ __forceinline__ void shift_src(unsigned c01, unsigned be01, unsigned up23, unsigned dn23, unsigned m01, unsigned& n01, unsigned& n23) {
  const unsigned S = dpp_row_shr1(be01, c01), H = dpp_row_shl1(be01, c01);
  n01 = (S & m01) | (H & ~m01);
  n23 = (up23 & 0xffffu) | (dn23 & 0xffff0000u);
}
__device__ __forceinline__ int opaque(int x) { asm volatile("" : "+v"(x)); return x; }
__device__ __forceinline__ float fsig(float x) { return __builtin_amdgcn_rcpf(1.f + __expf(-x)); }

__device__ __forceinline__ void ph_rwscan2(const P& p, char* smem, int bid, int nb) {
  const int wid = widx(), lane = lidx(), sl = wid >> 2, wv = wid & 3;
  char* sb = smem + sl * RW_STREAM_BYTES;
  float* CST = (float*)(sb + 4 * RW_SLOT_BYTES + 3 * RW_SCR_BYTES);
  volatile LAS int* FL = (volatile LAS int*)(sb + 4 * RW_SLOT_BYTES + 3 * RW_SCR_BYTES + 2304);
  const int scanw = sl;
  const int NCH = 144;
  for (int sp = bid; sp < 256; sp += nb) {
    const int s = sp * 2 + sl;
    const int d = s & 1, h = (s >> 1) & 7, b = s >> 4;
    __syncthreads();
    if (wv == 0) {
      const int cc = lane;
      CST[0 * 64 + cc] = p.rw_w0[d * 512 + h * 64 + cc];
      CST[1 * 64 + cc] = p.rw_a0[d * 512 + h * 64 + cc];
      CST[2 * 64 + cc] = p.rw_k_k[h * 64 + cc];
      CST[3 * 64 + cc] = p.rw_k_a[h * 64 + cc];
      CST[4 * 64 + cc] = p.rw_r_k[h * 64 + cc];
      CST[5 * 64 + cc] = p.rw_mu[h * 64 + cc];
      CST[6 * 64 + cc] = p.rw_mu[512 + h * 64 + cc];
      CST[7 * 64 + cc] = p.rw_mu[1024 + h * 64 + cc];
      CST[8 * 64 + cc] = p.rw_mu[1536 + cc];
      if (lane < 8) FL[lane] = 0;
    }
    __syncthreads();
    if (wv == scanw) {
      const int v32 = lane & 31, hh = lane >> 5;
      u16* ydst = d ? p.yrwb() : p.yrwf();
      f32x16 X[2][2];
#pragma unroll
      for (int mt = 0; mt < 2; ++mt)
#pragma unroll
        for (int vt = 0; vt < 2; ++vt)
#pragma unroll
          for (int r = 0; r < 16; ++r) X[mt][vt][r] = 0.f;
      for (int c = 0; c < NCH; ++c) {
        {
          while (__builtin_amdgcn_readfirstlane(FL[c & 3]) <= c) __builtin_amdgcn_s_sleep(1);
          asm volatile("" ::: "memory");
          const char* slot = sb + (c & 3) * RW_SLOT_BYTES;
          const u16* AR = (const u16*)slot;
          const u16* MG = (const u16*)(slot + 4352);
          const u16* BT = (const u16*)(slot + 5376);
          const u16* KT = (const u16*)(slot + 7424);
          const u16* VT = (const u16*)(slot + 9472);
          const float* WC = (const float*)(slot + 11520);
          {
            const float* Arb = (const float*)(slot + 11776);
            const float* Ark = Arb + 256;
            u16* ARw = (u16*)slot;
            u16* MGw = (u16*)(slot + 4352);
            const int ol = opaque(lane), oj = opaque(lane & 15);
            v2f am[16];
#pragma unroll
            for (int tt = 0; tt < 16; ++tt) {
              const int m0 = 8 * (tt >> 2) + (tt & 3);
              am[tt] = (v2f){bf2f(ARw[ol + m0 * RW_AR_LD]), bf2f(MGw[oj + m0 * 16])};
            }
#pragma unroll
            for (int tt = 0; tt < 16; ++tt) {
              const int m0 = 8 * (tt >> 2) + (tt & 3);
              v2f acc = (v2f){bf2f(ARw[ol + (m0 + 4) * RW_AR_LD]), Ark[oj + tt * 16]};
#pragma unroll
              for (int i4 = 0; i4 < (tt + 4) / 4; ++i4) {
                const float4 s4 = *(const float4*)(Arb + tt * 16 + 4 * i4);
                const float sv[4] = {s4.x, s4.y, s4.z, s4.w};
#pragma unroll
                for (int q = 0; q < 4; ++q) {
                  const int i = 4 * i4 + q;
                  if (i <= tt) acc += sv[q] * am[i];
                }
              }
              ARw[ol + (m0 + 4) * RW_AR_LD] = f2bf(acc[0]);
              if (lane < 16) MGw[oj + (m0 + 4) * 16] = f2bf(acc[1]);
            }
          }
          bf16x8 vtf[2];
#pragma unroll
          for (int vt = 0; vt < 2; ++vt) vtf[vt] = *(const bf16x8*)(VT + (32 * vt + v32) * 16 + 8 * hh);
          f32x16 UY[2];
#pragma unroll
          for (int vt = 0; vt < 2; ++vt)
#pragma unroll
            for (int r = 0; r < 16; ++r) UY[vt][r] = 0.f;
          {
            const bf16x8 mgf = *(const bf16x8*)(MG + v32 * 16 + 8 * hh);
#pragma unroll
            for (int vt = 0; vt < 2; ++vt) UY[vt] = __builtin_amdgcn_mfma_f32_32x32x16_bf16(mgf, vtf[vt], UY[vt], 0, 0, 0);
          }
#pragma unroll
          for (int mt = 0; mt < 2; ++mt)
#pragma unroll
            for (int ks = 0; ks < 2; ++ks) {
              const int base = 32 * mt + 16 * ks + 4 * hh;
              const uint2 a0 = *(const uint2*)(AR + v32 * RW_AR_LD + base);
              const uint2 a1 = *(const uint2*)(AR + v32 * RW_AR_LD + base + 8);
              union { unsigned u[4]; bf16x8 v; } af;
              af.u[0] = a0.x; af.u[1] = a0.y; af.u[2] = a1.x; af.u[3] = a1.y;
#pragma unroll
              for (int vt = 0; vt < 2; ++vt) {
                union { unsigned u[4]; bf16x8 v; } xf;
#pragma unroll
                for (int q = 0; q < 4; ++q) xf.u[q] = cvtpk(X[mt][vt][8 * ks + 2 * q], X[mt][vt][8 * ks + 2 * q + 1]);
                UY[vt] = __builtin_amdgcn_mfma_f32_32x32x16_bf16(af.v, xf.v, UY[vt], 0, 0, 0);
              }
            }
          if (c >= 16 && hh == 1) {
#pragma unroll
            for (int r = 0; r < 16; ++r) {
              const int pos = (c - 16) * 16 + r;
              const int tok = d ? (2047 - pos) : pos;
              u16* yp = ydst + ((size_t)b * 2048 + tok) * 512 + h * 64 + v32;
              yp[0] = f2bf(UY[0][r]);
              yp[32] = f2bf(UY[1][r]);
            }
          }
          bf16x8 uyf[2][2];
#pragma unroll
          for (int vt = 0; vt < 2; ++vt)
#pragma unroll
            for (int ks = 0; ks < 2; ++ks) {
              union { unsigned u[4]; bf16x8 v; } t_;
#pragma unroll
              for (int q = 0; q < 4; ++q) t_.u[q] = cvtpk(UY[vt][8 * ks + 2 * q], UY[vt][8 * ks + 2 * q + 1]);
              uyf[vt][ks] = t_.v;
            }
#pragma unroll
          for (int mt = 0; mt < 2; ++mt) {
            const int krow = 32 * mt + v32;
            const bf16x8 ktf = *(const bf16x8*)(KT + krow * 16 + 8 * hh);
            bf16x8 btf[2];
#pragma unroll
            for (int ks = 0; ks < 2; ++ks) {
              btf[ks] = *(const bf16x8*)(BT + krow * 16 + 8 * ks);
              if (hh) btf[ks] = (bf16x8){0, 0, 0, 0, 0, 0, 0, 0};
            }
#pragma unroll
            for (int vt = 0; vt < 2; ++vt) {
              X[mt][vt] = __builtin_amdgcn_mfma_f32_32x32x16_bf16(ktf, vtf[vt], X[mt][vt], 0, 0, 0);
#pragma unroll
              for (int ks = 0; ks < 2; ++ks) X[mt][vt] = __builtin_amdgcn_mfma_f32_32x32x16_bf16(btf[ks], uyf[vt][ks], X[mt][vt], 0, 0, 0);
            }
#pragma unroll
            for (int g = 0; g < 4; ++g) {
              const float4 w4 = *(const float4*)(WC + 32 * mt + 8 * g + 4 * hh);
#pragma unroll
              for (int vt = 0; vt < 2; ++vt) {
                X[mt][vt][4 * g + 0] *= w4.x; X[mt][vt][4 * g + 1] *= w4.y;
                X[mt][vt][4 * g + 2] *= w4.z; X[mt][vt][4 * g + 3] *= w4.w;
              }
            }
          }
        }
        asm volatile("s_waitcnt lgkmcnt(0)" ::: "memory");
        if (lane == 0) FL[4] = c + 1;
      }
    } else {
      const int pw = wv - (wv > scanw ? 1 : 0);
      const int t = lane & 15, kq = lane >> 4;
      char* scr = sb + 4 * RW_SLOT_BYTES + pw * RW_SCR_BYTES;
      u16* AL = (u16*)scr;
      u16* BE = AL + 16 * RW_RM_LD;
      u16* KA = BE + 16 * RW_RM_LD;
      float* AAs = (float*)BE;
      const int o_kq16 = opaque(16 * kq);
      const int o_tr = opaque(256 * kq + t);
      const int o_rm = opaque(t * RW_RM_LD + 16 * kq);
      const int o_ar = opaque((8 * (t >> 2) + (t & 3) + 4) * RW_AR_LD + 16 * kq);
      const int o_l = opaque(lane);
      const int o_j = opaque(lane & 15);
      const float* cstl = CST + o_kq16;
      const float* cstw = CST + 8 * 64 + opaque(8 * kq);
      const unsigned m01 = d ? 0xffff0000u : 0x0000ffffu;
      bf16x8 wwf[4], waf[4];
      {
        const int o_wl = (((d * 8 + h) * 4) * 64 + lane) * 8;
#pragma unroll
        for (int mt = 0; mt < 4; ++mt) {
          wwf[mt] = *(const bf16x8*)(p.wlf() + o_wl + mt * 512);
          waf[mt] = *(const bf16x8*)(p.wlf() + o_wl + 32768 + mt * 512);
        }
      }
      for (;;) {
        int c;
        {
          const unsigned fa = (unsigned)(unsigned long)(LAS char*)(sb + 4 * RW_SLOT_BYTES + 3 * RW_SCR_BYTES + 2304 + 20);
          const int inc = lane == 0 ? 1 : 0;
          asm volatile("ds_add_rtn_u32 %0, %1, %2\n\ts_waitcnt lgkmcnt(0)" : "=v"(c) : "v"(fa), "v"(inc) : "memory");
          c = __builtin_amdgcn_readfirstlane(c);
        }
        if (c >= NCH) break;
        while (__builtin_amdgcn_readfirstlane(FL[4]) < c - 3) __builtin_amdgcn_s_sleep(1);
        asm volatile("" ::: "memory");
        char* slot = sb + (c & 3) * RW_SLOT_BYTES;
        u16* AR = (u16*)slot;
        u16* MG = (u16*)(slot + 4352);
        u16* BT = (u16*)(slot + 5376);
        u16* KT = (u16*)(slot + 7424);
        u16* VT = (u16*)(slot + 9472);
        float* WC = (float*)(slot + 11520);
        const bool lat = c >= 16;
        const int L = lat ? 2048 : 256;
        const int pos = (lat ? (c - 16) : c) * 16 + t;
        const int tok = d ? (L - 1 - pos) : pos;
        const size_t row = (lat ? (size_t)b * 2048 : (size_t)NLAT + (size_t)b * 256) + tok;
        const u16* cbase = p.proj() + row * INC + 512;
        const u16 *ubase, *dbase, *ebase;
        float nmask[4];
        {
          size_t nrow[4];
          bool nval[4];
          neighbours(!lat, row, tok, nrow, nval);
#pragma unroll
          for (int j = 0; j < 4; ++j) nmask[j] = nval[j] ? 1.f : 0.f;
          ubase = p.proj() + (nval[2] ? nrow[2] : row) * INC + 512;
          dbase = p.proj() + (nval[3] ? nrow[3] : row) * INC + 512;
          const bool useup = (t == 0) != (d != 0);
          const size_t erow = useup ? (nval[0] ? nrow[0] : row) : (nval[1] ? nrow[1] : row);
          ebase = p.proj() + erow * INC + 512;
        }
        const int cl = 1536 + 8 * kq, cx = h * 64 + 16 * kq;
        u32x4 Cl[2], Ul[2], Dl[2], El[2];
        u32x4 Cx[3][2], Ux[3][2], Dx[3][2], Ex[3][2];
#pragma unroll
        for (int a = 0; a < 2; ++a) {
          Cl[a] = *(const u32x4*)(cbase + cl + 32 * a);
          Ul[a] = *(const u32x4*)(ubase + cl + 32 * a);
          Dl[a] = *(const u32x4*)(dbase + cl + 32 * a);
          El[a] = (u32x4){0u, 0u, 0u, 0u};
        }
#pragma unroll
        for (int a = 0; a < 3; ++a)
#pragma unroll
          for (int hf = 0; hf < 2; ++hf) {
            Cx[a][hf] = *(const u32x4*)(cbase + cx + 512 * a + 8 * hf);
            Ux[a][hf] = *(const u32x4*)(ubase + cx + 512 * a + 8 * hf);
            Dx[a][hf] = *(const u32x4*)(dbase + cx + 512 * a + 8 * hf);
            Ex[a][hf] = (u32x4){0u, 0u, 0u, 0u};
          }
        if (t == 0 || t == 15) {
#pragma unroll
          for (int a = 0; a < 2; ++a) El[a] = *(const u32x4*)(ebase + cl + 32 * a);
#pragma unroll
          for (int a = 0; a < 3; ++a)
#pragma unroll
            for (int hf = 0; hf < 2; ++hf) Ex[a][hf] = *(const u32x4*)(ebase + cx + 512 * a + 8 * hf);
        }
        bf16x8 lwf, laf;
        {
          float lw[8], la[8];
          const float4 ml0 = *(const float4*)(cstw), ml1 = *(const float4*)(cstw + 4);
          const float4 ma0 = *(const float4*)(cstw + 32), ma1 = *(const float4*)(cstw + 32 + 4);
          const float mul_[8] = {ml0.x, ml0.y, ml0.z, ml0.w, ml1.x, ml1.y, ml1.z, ml1.w};
          const float mua_[8] = {ma0.x, ma0.y, ma0.z, ma0.w, ma1.x, ma1.y, ma1.z, ma1.w};
#pragma unroll
          for (int g = 0; g < 2; ++g) {
            unsigned nw01, nw23, na01, na23;
            shift_src(Cl[0][2 * g], El[0][2 * g], Ul[0][2 * g + 1], Dl[0][2 * g + 1], m01, nw01, nw23);
            shift_src(Cl[1][2 * g], El[1][2 * g], Ul[1][2 * g + 1], Dl[1][2 * g + 1], m01, na01, na23);
            const float zw[4] = {bflo(Cl[0][2 * g]), bfhi(Cl[0][2 * g]), bflo(Cl[0][2 * g + 1]), bfhi(Cl[0][2 * g + 1])};
            const float za[4] = {bflo(Cl[1][2 * g]), bfhi(Cl[1][2 * g]), bflo(Cl[1][2 * g + 1]), bfhi(Cl[1][2 * g + 1])};
            const float nw[4] = {bflo(nw01), bfhi(nw01), bflo(nw23), bfhi(nw23)};
            const float na[4] = {bflo(na01), bfhi(na01), bflo(na23), bfhi(na23)};
#pragma unroll
            for (int j = 0; j < 4; ++j) {
              const int q = 4 * g + j;
              lw[q] = 1.f - 2.f * __builtin_amdgcn_rcpf(1.f + __expf(2.f * (zw[j] + (nw[j] * nmask[j] - zw[j]) * mul_[q])));
              la[q] = za[j] + (na[j] * nmask[j] - za[j]) * mua_[q];
            }
          }
          union { unsigned u[4]; bf16x8 v; } tw, ta;
#pragma unroll
          for (int q = 0; q < 4; ++q) { tw.u[q] = pack2(lw[2 * q], lw[2 * q + 1]); ta.u[q] = pack2(la[2 * q], la[2 * q + 1]); }
          lwf = tw.v; laf = ta.v;
        }
        float ee[16];
        unsigned rrp[8], aap[8], kxp[8];
        {
#pragma unroll
          for (int mt = 0; mt < 4; ++mt) {
            const float4 mr = *(const float4*)(cstl + 5 * 64 + 4 * mt), mk = *(const float4*)(cstl + 6 * 64 + 4 * mt), mv = *(const float4*)(cstl + 7 * 64 + 4 * mt);
            const float mrv[4] = {mr.x, mr.y, mr.z, mr.w}, mkv[4] = {mk.x, mk.y, mk.z, mk.w}, mvv[4] = {mv.x, mv.y, mv.z, mv.w};
            const int hf = mt >> 1, r0 = 2 * (mt & 1);
            float mix[3][4];
#pragma unroll
            for (int a = 0; a < 3; ++a) {
              unsigned n01, n23;
              shift_src(Cx[a][hf][r0], Ex[a][hf][r0], Ux[a][hf][r0 + 1], Dx[a][hf][r0 + 1], m01, n01, n23);
              const float z[4] = {bflo(Cx[a][hf][r0]), bfhi(Cx[a][hf][r0]), bflo(Cx[a][hf][r0 + 1]), bfhi(Cx[a][hf][r0 + 1])};
              const float n[4] = {bflo(n01), bfhi(n01), bflo(n23), bfhi(n23)};
              const float* mm = a == 0 ? mrv : (a == 1 ? mkv : mvv);
#pragma unroll
              for (int j = 0; j < 4; ++j) mix[a][j] = z[j] + (n[j] * nmask[j] - z[j]) * mm[j];
            }
#pragma unroll
            for (int j = 0; j < 4; ++j) VT[o_tr + (4 * mt + j) * 16] = f2bf(mix[2][j]);
            const f32x4 z4 = (f32x4){0.f, 0.f, 0.f, 0.f};
            const f32x4 aw = __builtin_amdgcn_mfma_f32_16x16x32_bf16(wwf[mt], lwf, z4, 0, 0, 0);
            const f32x4 a2 = __builtin_amdgcn_mfma_f32_16x16x32_bf16(waf[mt], laf, z4, 0, 0, 0);
            const float4 w0 = *(const float4*)(cstl + 0 * 64 + 4 * mt), a0 = *(const float4*)(cstl + 1 * 64 + 4 * mt);
            ee[4 * mt] = 0.60653066f * fsig(w0.x + aw[0]); ee[4 * mt + 1] = 0.60653066f * fsig(w0.y + aw[1]);
            ee[4 * mt + 2] = 0.60653066f * fsig(w0.z + aw[2]); ee[4 * mt + 3] = 0.60653066f * fsig(w0.w + aw[3]);
            float aav[4];
            aav[0] = fsig(a0.x + a2[0]); aav[1] = fsig(a0.y + a2[1]);
            aav[2] = fsig(a0.z + a2[2]); aav[3] = fsig(a0.w + a2[3]);
            rrp[2 * mt] = pack2(mix[0][0], mix[0][1]); rrp[2 * mt + 1] = pack2(mix[0][2], mix[0][3]);
            aap[2 * mt] = pack2(aav[0], aav[1]); aap[2 * mt + 1] = pack2(aav[2], aav[3]);
            kxp[2 * mt] = pack2(mix[1][0], mix[1][1]); kxp[2 * mt + 1] = pack2(mix[1][2], mix[1][3]);
          }
        }
        float kdf[16], kkf[16];
        float inv;
        {
          float ss = 0.f, bon = 0.f;
#pragma unroll
          for (int mt = 0; mt < 4; ++mt) {
            const float4 c2 = *(const float4*)(cstl + 2 * 64 + 4 * mt), c3 = *(const float4*)(cstl + 3 * 64 + 4 * mt), c4 = *(const float4*)(cstl + 4 * 64 + 4 * mt);
            const float kkc[4] = {c2.x, c2.y, c2.z, c2.w}, kac[4] = {c3.x, c3.y, c3.z, c3.w}, rkc[4] = {c4.x, c4.y, c4.z, c4.w};
#pragma unroll
            for (int j = 0; j < 4; ++j) {
              const int e = 4 * mt + j;
              const float kx = (e & 1) ? bfhi(kxp[e >> 1]) : bflo(kxp[e >> 1]);
              const float av = (e & 1) ? bfhi(aap[e >> 1]) : bflo(aap[e >> 1]);
              const float rv = (e & 1) ? bfhi(rrp[e >> 1]) : bflo(rrp[e >> 1]);
              kdf[e] = kx * (1.f + (av - 1.f) * kac[j]);
              kkf[e] = kx * kkc[j];
              ss += kkf[e] * kkf[e];
              bon += rv * kdf[e] * rkc[j];
            }
          }
          ss += __shfl_xor(ss, 16, 64); ss += __shfl_xor(ss, 32, 64);
          bon += __shfl_xor(bon, 16, 64); bon += __shfl_xor(bon, 32, 64);
          inv = rsqrtf(ss + 1e-12f);
          if (lat && kq == 0) p.bsc()[((size_t)d * NLAT + row) * 8 + h] = bon;
        }
#pragma unroll
        for (int mt = 0; mt < 4; ++mt) {
          float al4[4], rh4[4], be4[4], ka4[4];
#pragma unroll
          for (int j = 0; j < 4; ++j) {
            const int e = 4 * mt + j;
            float cs = ee[e];
            cs = dpp_shr_add(cs, 1); cs = dpp_shr_add(cs, 2); cs = dpp_shr_add(cs, 4); cs = dpp_shr_add(cs, 8);
            const float Ep = __expf(cs), Em = __builtin_amdgcn_rcpf(Ep), Ex = __expf(ee[e] - cs);
            const float kkn = kkf[e] * inv;
            al4[j] = -kkn * Ex;
            be4[j] = kkn * ((e & 1) ? bfhi(aap[e >> 1]) : bflo(aap[e >> 1])) * Ep;
            ka4[j] = kdf[e] * Ep;
            rh4[j] = ((e & 1) ? bfhi(rrp[e >> 1]) : bflo(rrp[e >> 1])) * Em;
            BT[o_tr + (4 * mt + j) * 16] = f2bf(be4[j]);
            KT[o_tr + (4 * mt + j) * 16] = f2bf(ka4[j]);
            if (t == 15) WC[o_kq16 + 4 * mt + j] = Em;
          }
          const int ko = o_rm + 4 * mt;
          *(uint2*)(AL + ko) = make_uint2(pack2(al4[0], al4[1]), pack2(al4[2], al4[3]));
          *(uint2*)(AR + o_ar + 4 * mt) = make_uint2(pack2(rh4[0], rh4[1]), pack2(rh4[2], rh4[3]));
          *(uint2*)(BE + ko) = make_uint2(pack2(be4[0], be4[1]), pack2(be4[2], be4[3]));
          *(uint2*)(KA + ko) = make_uint2(pack2(ka4[0], ka4[1]), pack2(ka4[2], ka4[3]));
        }
        {
          const int m = lane & 31, hh = lane >> 5;
          const int typ = (m >> 2) & 1, tt = 4 * (m >> 3) + (m & 3);
          const u16* arow = (typ ? AR + m * RW_AR_LD : AL + tt * RW_RM_LD) + 8 * hh;
          const u16* brow = ((m >> 4) ? KA : BE) + (m & 15) * RW_RM_LD + 8 * hh;
          f32x16 aa;
#pragma unroll
          for (int r = 0; r < 16; ++r) aa[r] = 0.f;
#pragma unroll
          for (int ks = 0; ks < 4; ++ks) {
            const uint2 a0 = *(const uint2*)(arow + 16 * ks), a1 = *(const uint2*)(arow + 16 * ks + 4);
            union { unsigned u[4]; bf16x8 v; } af;
            af.u[0] = a0.x; af.u[1] = a0.y; af.u[2] = a1.x; af.u[3] = a1.y;
            const bf16x8 bf_ = *(const bf16x8*)(brow + 16 * ks);
            aa = __builtin_amdgcn_mfma_f32_32x32x16_bf16(af.v, bf_, aa, 0, 0, 0);
          }
          const int i = m & 15;
          float* aad = (hh ? (float*)(slot + 11776) : AAs) + opaque((m >> 4) * 256 + i);
#pragma unroll
          for (int r = 0; r < 16; ++r) {
            const bool keep = hh ? (i <= r) : (i < r);
            aad[r * 16] = keep ? aa[r] : 0.f;
          }
        }
        asm volatile("" ::: "memory");
        {
          const float* Aab = AAs;
          const float* Aak = AAs + 256;
          v2f am[16];
#pragma unroll
          for (int tt = 0; tt < 16; ++tt) {
            v2f acc = (v2f){bf2f(AL[o_l + tt * RW_RM_LD]), Aak[o_j + tt * 16]};
#pragma unroll
            for (int i4 = 0; i4 < (tt + 3) / 4; ++i4) {
              const float4 s4 = *(const float4*)(Aab + tt * 16 + 4 * i4);
              const float sv[4] = {s4.x, s4.y, s4.z, s4.w};
#pragma unroll
              for (int q = 0; q < 4; ++q) {
                const int i = 4 * i4 + q;
                if (i < tt) acc += sv[q] * am[i];
              }
            }
            am[tt] = acc;
          }
#pragma unroll
          for (int tt = 0; tt < 16; ++tt) {
            const int m0 = 8 * (tt >> 2) + (tt & 3);
            AR[o_l + m0 * RW_AR_LD] = f2bf(am[tt][0]);
            if (lane < 16) MG[o_j + m0 * 16] = f2bf(am[tt][1]);
          }
        }
        asm volatile("s_waitcnt lgkmcnt(0)" ::: "memory");
        if (lane == 0) FL[c & 3] = c + 1;
      }
    }
  }
}

struct MixLd {
  uint4 s5f, s5b, rwf, rwb, vc, gc;
  u16 vn[8], gn[8];
  float bs0, bs1;
};
__device__ __forceinline__ void mix_load(const P& p, int row, int lane, MixLd& L, float (&nmask)[4]) {
  const int c8 = lane * 8, t = row & 2047;
  L.s5f = *(const uint4*)(p.ys5f() + (size_t)row * 512 + c8);
  L.s5b = *(const uint4*)(p.ys5b() + (size_t)row * 512 + c8);
  L.rwf = *(const uint4*)(p.yrwf() + (size_t)row * 512 + c8);
  L.rwb = *(const uint4*)(p.yrwb() + (size_t)row * 512 + c8);
  size_t nrow[4];
  bool nval[4];
  neighbours(false, (size_t)row, t, nrow, nval);
  const u16* nb_[4];
#pragma unroll
  for (int j = 0; j < 4; ++j) { nb_[j] = p.proj() + (nval[j] ? nrow[j] : (size_t)row) * INC + 512 + j; nmask[j] = nval[j] ? 1.f : 0.f; }
  const u16* cb = p.proj() + (size_t)row * INC + 512;
  L.vc = *(const uint4*)(cb + 1024 + c8);
#pragma unroll
  for (int i = 0; i < 8; ++i) L.vn[i] = nb_[i & 3][1024 + c8 + (i & 4)];
  const int g8 = (lane < 12) ? c8 : 0;
  L.gc = *(const uint4*)(cb + 1600 + g8);
#pragma unroll
  for (int i = 0; i < 8; ++i) L.gn[i] = nb_[i & 3][1600 + g8 + (i & 4)];
  const int head = lane >> 3;
  L.bs0 = p.bsc()[(size_t)row * 8 + head];
  L.bs1 = p.bsc()[((size_t)NLAT + row) * 8 + head];
}
__device__ __forceinline__ void mix_compute(const P& p, int row, int lane, const MixLd& L, const float (&nmask)[4], u16* y1dst, u16* t1dst) {
  const int c8 = lane * 8;
  {
    const unsigned au[4] = {L.s5f.x, L.s5f.y, L.s5f.z, L.s5f.w}, bu[4] = {L.s5b.x, L.s5b.y, L.s5b.z, L.s5b.w};
    unsigned ou[4];
#pragma unroll
    for (int q = 0; q < 4; ++q) ou[q] = pack2(gelu_as(bflo(au[q]) + bflo(bu[q])), gelu_as(bfhi(au[q]) + bfhi(bu[q])));
    *(uint4*)(y1dst + (size_t)row * 512 + c8) = make_uint4(ou[0], ou[1], ou[2], ou[3]);
  }
  float y[8];
  {
    const unsigned au[4] = {L.rwf.x, L.rwf.y, L.rwf.z, L.rwf.w}, bu[4] = {L.rwb.x, L.rwb.y, L.rwb.z, L.rwb.w};
#pragma unroll
    for (int q = 0; q < 4; ++q) { y[2 * q] = bflo(au[q]) + bflo(bu[q]); y[2 * q + 1] = bfhi(au[q]) + bfhi(bu[q]); }
  }
  float sm = 0.f;
#pragma unroll
  for (int i = 0; i < 8; ++i) sm += y[i];
  sm = dpp_add(sm, 0, 0); sm = dpp_add(sm, 1, 0); sm = dpp_add(sm, 2, 0);
  const float mu = sm * (1.f / 64.f);
  float sv = 0.f;
#pragma unroll
  for (int i = 0; i < 8; ++i) sv += (y[i] - mu) * (y[i] - mu);
  sv = dpp_add(sv, 0, 0); sv = dpp_add(sv, 1, 0); sv = dpp_add(sv, 2, 0);
  const float rs = rsqrtf(sv * (1.f / 64.f) + 64e-5f);
  float v[8];
  {
    const unsigned cu[4] = {L.vc.x, L.vc.y, L.vc.z, L.vc.w};
    const float4 m0 = *(const float4*)(p.rw_mu + 1024 + c8), m1 = *(const float4*)(p.rw_mu + 1024 + c8 + 4);
    const float mm[8] = {m0.x, m0.y, m0.z, m0.w, m1.x, m1.y, m1.z, m1.w};
#pragma unroll
    for (int i = 0; i < 8; ++i) {
      const float z = (i & 1) ? bfhi(cu[i >> 1]) : bflo(cu[i >> 1]);
      const float nbv = bf2f(L.vn[i]) * nmask[i & 3];
      v[i] = z + (nbv - z) * mm[i];
    }
  }
  const float bs = L.bs0 + L.bs1;
  {
    const float4 w0 = *(const float4*)(p.rw_ln_w + c8), w1 = *(const float4*)(p.rw_ln_w + c8 + 4);
    const float4 b0 = *(const float4*)(p.rw_ln_b + c8), b1 = *(const float4*)(p.rw_ln_b + c8 + 4);
    const float lw[8] = {w0.x, w0.y, w0.z, w0.w, w1.x, w1.y, w1.z, w1.w};
    const float lb[8] = {b0.x, b0.y, b0.z, b0.w, b1.x, b1.y, b1.z, b1.w};
    float o[8];
#pragma unroll
    for (int i = 0; i < 8; ++i) o[i] = (y[i] - mu) * rs * lw[i] + lb[i] + bs * v[i];
    *(uint4*)(t1dst + (size_t)row * 512 + c8) = make_uint4(pack2(o[0], o[1]), pack2(o[2], o[3]), pack2(o[4], o[5]), pack2(o[6], o[7]));
  }
  if (lane < 32) {
    unsigned ou[4] = {0u, 0u, 0u, 0u};
    if (lane < 12) {
      const unsigned cu[4] = {L.gc.x, L.gc.y, L.gc.z, L.gc.w};
      const float4 m0 = *(const float4*)(p.rw_mu + 1600 + c8), m1 = *(const float4*)(p.rw_mu + 1600 + c8 + 4);
      const float mm[8] = {m0.x, m0.y, m0.z, m0.w, m1.x, m1.y, m1.z, m1.w};
      float gsig[8];
#pragma unroll
      for (int i = 0; i < 8; ++i) {
        const float z = (i & 1) ? bfhi(cu[i >> 1]) : bflo(cu[i >> 1]);
        const float nbv = bf2f(L.gn[i]) * nmask[i & 3];
        gsig[i] = fsig(z + (nbv - z) * mm[i]);
      }
#pragma unroll
      for (int q = 0; q < 4; ++q) ou[q] = pack2(gsig[2 * q], gsig[2 * q + 1]);
    }
    *(uint4*)(p.sg() + (size_t)row * 256 + c8) = make_uint4(ou[0], ou[1], ou[2], ou[3]);
  }
}
__device__ __forceinline__ void ph_mixprep(const P& p, int bid, int nb, u16* y1dst, u16* t1dst) {
  const int wid = tidx() >> 6, lane = tidx() & 63;
  const int stride = nb * 8;
  for (int row = bid * 8 + wid; row < NLAT; row += 2 * stride) {
    const int rowB = row + stride;
    const bool hasB = rowB < NLAT;
    MixLd LA, LB;
    float mA[4], mB[4];
    mix_load(p, row, lane, LA, mA);
    mix_load(p, hasB ? rowB : row, lane, LB, mB);
    mix_compute(p, row, lane, LA, mA, y1dst, t1dst);
    if (hasB) mix_compute(p, rowB, lane, LB, mB, y1dst, t1dst);
  }
}

__constant__ unsigned char CAND_I[52] = {0,0,0,0,0,0,0,0,0,0,0,0,0,0,0,0, 1,1,1,1,1,1,1,1, 2,2,2,2,2, 3,3,3,3, 4,4,4, 5,5, 6,6, 7,7, 8,9,10,11,12,13,14,15, 0,0};
__constant__ unsigned char CAND_J[52] = {0,1,2,3,4,5,6,7,8,9,10,11,12,13,14,15, 0,1,2,3,4,5,6,7, 0,1,2,3,4, 0,1,2,3, 0,1,2, 0,1, 0,1, 0,1, 0,0,0,0,0,0,0,0, 0,0};

#define SC_LD 144
#define KL_LD 136
__device__ __forceinline__ unsigned umax_quad(unsigned v) {
  unsigned o = (unsigned)__builtin_amdgcn_update_dpp(0, (int)v, 0xB1, 0xf, 0xf, true);
  v = v > o ? v : o;
  o = (unsigned)__builtin_amdgcn_update_dpp(0, (int)v, 0x4E, 0xf, 0xf, true);
  return v > o ? v : o;
}
__device__ __forceinline__ unsigned mono_key(float f) {
  unsigned u = __float_as_uint(f);
  return u ^ ((u >> 31) ? 0xFFFFFFFFu : 0x80000000u);
}
__device__ __forceinline__ float mono_inv(unsigned k) {
  unsigned u = (k >> 31) ? (k ^ 0x80000000u) : ~k;
  return __uint_as_float(u);
}
__device__ __forceinline__ unsigned umax3(unsigned a, unsigned b, unsigned c) {
  unsigned m = a > b ? a : b;
  return m > c ? m : c;
}
__device__ __forceinline__ void ph_route(const P& p, char* smem, int bid, int nb) {
  u16* KL = (u16*)smem;
  unsigned* SC = (unsigned*)(smem + 2 * 128 * KL_LD * 2);
  float* TS = (float*)(SC + 2 * 64 * SC_LD);
  int* TI = (int*)(TS + 2 * 64 * 16);
  const u16* Q = p.proj();
  const int tid = tidx(), wid = tid >> 6, lane = tid & 63, fr = lane & 15, fq = lane >> 4;
  int cur_h = -1;
  bf16x8 an[4];
  {
    const int h0 = bid & 7, r0 = (bid >> 3) * 64, c0 = wid >> 2, m0 = (wid & 3) * 16;
#pragma unroll
    for (int ks = 0; ks < 4; ++ks)
      an[ks] = *(const bf16x8*)(Q + (size_t)(r0 + m0 + fr) * 2048 + h0 * 256 + c0 * 128 + ks * 32 + fq * 8);
  }
  for (int item = bid; item < 1024 * 8; item += nb) {
    const int h = item & 7, row0 = (item >> 3) * 64;
    if (h != cur_h) {
      __syncthreads();
      for (int e = tid; e < 2 * 128 * 16; e += NTHREADS) {
        int r = e >> 4, kc = (e & 15) * 8;
        *(uint4*)(KL + r * KL_LD + kc) = *(const uint4*)(p.keys() + ((size_t)h * 256 + r) * 128 + kc);
      }
      cur_h = h;
      __syncthreads();
    }
    {
      const int c = wid >> 2, mrow = (wid & 3) * 16;
      f32x4 acc[8];
#pragma unroll
      for (int ni = 0; ni < 8; ++ni) acc[ni] = (f32x4){0.f, 0.f, 0.f, 0.f};
      bf16x8 a[4];
#pragma unroll
      for (int ks = 0; ks < 4; ++ks) a[ks] = an[ks];
      {
        const int nit = (item + nb < 1024 * 8) ? item + nb : item;
        const int nh = nit & 7, nr0 = (nit >> 3) * 64;
#pragma unroll
        for (int ks = 0; ks < 4; ++ks)
          an[ks] = *(const bf16x8*)(Q + (size_t)(nr0 + mrow + fr) * 2048 + nh * 256 + c * 128 + ks * 32 + fq * 8);
      }
#pragma unroll
      for (int ks = 0; ks < 4; ++ks) {
#pragma unroll
        for (int ni = 0; ni < 8; ++ni) {
          bf16x8 bfr = *(const bf16x8*)(KL + (c * 128 + ni * 16 + fr) * KL_LD + ks * 32 + fq * 8);
          acc[ni] = __builtin_amdgcn_mfma_f32_16x16x32_bf16(a[ks], bfr, acc[ni], 0, 0, 0);
        }
      }
#pragma unroll
      for (int ni = 0; ni < 8; ++ni)
#pragma unroll
        for (int j = 0; j < 4; ++j) {
          const int n = ni * 16 + fr;
          SC[(c * 64 + mrow + fq * 4 + j) * SC_LD + n] = (mono_key(acc[ni][j]) & ~127u) | (unsigned)(127 - n);
        }
    }
    __syncthreads();
    {
      const int task = tid >> 2, q4 = tid & 3;
      unsigned* rowp = SC + task * SC_LD;
      for (int r = 0; r < 16; ++r) {
        unsigned m = 0;
#pragma unroll
        for (int j = 0; j < 8; ++j) {
          uint4 v = *(const uint4*)(rowp + 16 * j + 4 * q4);
          m = umax3(m, v.x, v.y);
          m = umax3(m, v.z, v.w);
        }
        m = umax_quad(m);
        const int n = 127 - (int)(m & 127u);
        if (((n >> 2) & 3) == q4) rowp[n] = 0u;
        if (q4 == (r & 3)) {
          TS[task * 16 + r] = mono_inv(m & ~127u);
          TI[task * 16 + r] = n;
        }
      }
    }
    __syncthreads();
    if (tid < 256) {
      const int t = tid >> 2, q4 = tid & 3;
      unsigned val[13];
#pragma unroll
      for (int e = 0; e < 13; ++e) {
        const int ci = q4 + 4 * e;
        const int i = CAND_I[ci], j = CAND_J[ci];
        const float sv = TS[t * 16 + i] + TS[(64 + t) * 16 + j];
        val[e] = (ci < 50) ? ((mono_key(sv) & ~255u) | (unsigned)(255 - (i * 16 + j))) : 0u;
      }
      unsigned mine[4] = {0u, 0u, 0u, 0u};
      unsigned first = 0u;
#pragma unroll
      for (int r = 0; r < 16; ++r) {
        unsigned m = umax3(val[0], val[1], val[2]);
        m = umax3(m, val[3], val[4]);
        m = umax3(m, val[5], val[6]);
        m = umax3(m, val[7], val[8]);
        m = umax3(m, val[9], val[10]);
        m = umax3(m, val[11], val[12]);
        m = umax_quad(m);
#pragma unroll
        for (int e = 0; e < 13; ++e) val[e] = (val[e] == m) ? 0u : val[e];
        if (r == 0) first = m;
        mine[r >> 2] = (q4 == (r & 3)) ? m : mine[r >> 2];
      }
      float smax;
      {
        const int cid = 255 - (int)(first & 255u);
        smax = TS[t * 16 + (cid >> 4)] + TS[(64 + t) * 16 + (cid & 15)];
      }
      float ex[4];
      int eid[4];
      float part = 0.f;
#pragma unroll
      for (int k = 0; k < 4; ++k) {
        const int cid = 255 - (int)(mine[k] & 255u);
        const int i = cid >> 4, j = cid & 15;
        const float sv = TS[t * 16 + i] + TS[(64 + t) * 16 + j];
        ex[k] = __expf(sv - smax);
        part += ex[k];
        eid[k] = TI[t * 16 + i] * 128 + TI[(64 + t) * 16 + j];
      }
      part = dpp_add(part, 0, 0);
      part = dpp_add(part, 1, 0);
      const float rden = 1.f / part;
      const size_t obase = ((size_t)(row0 + t) * 8 + h) * 16;
#pragma unroll
      for (int k = 0; k < 4; ++k) {
        p.idx()[obase + 4 * k + q4] = eid[k];
        p.gate()[obase + 4 * k + q4] = ex[k] * rden;
      }
    }
    __syncthreads();
  }
}

typedef int v8i_t __attribute__((ext_vector_type(8)));
__device__ __forceinline__ void ph_ffn(const P& p, float* __restrict__ dst, char* smem, int bid, int nb) {
  const int wid = tidx() >> 6, lane = tidx() & 63;
  const int hh = lane >> 5, li = lane & 31, m16 = lane & 15, kg = lane >> 4;
  unsigned char* h8 = (unsigned char*)smem + wid * 1024;
  const u16* H2N = p.hn();
  for (int row = bid * 8 + wid; row < NLAT; row += nb * 8) {
    float hinv;
    {
      const uint4 a = *(const uint4*)(H2N + (size_t)row * 1024 + lane * 16), b2 = *(const uint4*)(H2N + (size_t)row * 1024 + lane * 16 + 8);
      const unsigned au[8] = {a.x, a.y, a.z, a.w, b2.x, b2.y, b2.z, b2.w};
      float hv[16];
      float am = 0.f;
#pragma unroll
      for (int q = 0; q < 8; ++q) { hv[2 * q] = bflo(au[q]); hv[2 * q + 1] = bfhi(au[q]); am = fmaxf(am, fmaxf(fabsf(hv[2 * q]), fabsf(hv[2 * q + 1]))); }
#pragma unroll
      for (int m = 32; m >= 1; m >>= 1) am = fmaxf(am, __shfl_xor(am, m, 64));
      const float scl = am > 0.f ? 448.f / am : 1.f;
      hinv = am > 0.f ? am * (1.f / 448.f) : 1.f;
      unsigned o[4];
#pragma unroll
      for (int q = 0; q < 4; ++q) {
        int w = 0;
        w = __builtin_amdgcn_cvt_pk_fp8_f32(hv[4 * q] * scl, hv[4 * q + 1] * scl, w, false);
        w = __builtin_amdgcn_cvt_pk_fp8_f32(hv[4 * q + 2] * scl, hv[4 * q + 3] * scl, w, true);
        o[q] = (unsigned)w;
      }
      *(uint4*)(h8 + lane * 16) = make_uint4(o[0], o[1], o[2], o[3]);
    }
    v8i_t hb[8];
#pragma unroll
    for (int s2 = 0; s2 < 8; ++s2) {
      const uint4 x0 = *(const uint4*)(h8 + 128 * s2 + 16 * kg), x1 = *(const uint4*)(h8 + 128 * s2 + 64 + 16 * kg);
      hb[s2] = (v8i_t){(int)x0.x, (int)x0.y, (int)x0.z, (int)x0.w, (int)x1.x, (int)x1.y, (int)x1.z, (int)x1.w};
    }
    const int id0 = p.idx()[(size_t)row * 128 + lane], id1 = p.idx()[(size_t)row * 128 + 64 + lane];
    const float us0 = p.usc()[id0] * hinv, us1 = p.usc()[id1] * hinv;
    const float gv0 = p.gate()[(size_t)row * 128 + lane] * p.vsc()[id0], gv1 = p.gate()[(size_t)row * 128 + 64 + lane] * p.vsc()[id1];
    float oacc[32];
#pragma unroll
    for (int i = 0; i < 32; ++i) oacc[i] = 0.f;
#pragma unroll 1
    for (int bb = 0; bb < 8; ++bb) {
      const bool hf = bb >= 4;
      const int e0 = (bb & 3) * 16;
      const int idv = hf ? id1 : id0;
      const float usv = hf ? us1 : us0, gvv = hf ? gv1 : gv0;
      const int idm = __shfl(idv, e0 + m16, 64);
      uint4 ua[8];
#pragma unroll
      for (int s2 = 0; s2 < 8; ++s2) ua[s2] = *(const uint4*)(p.utab() + (size_t)idm * 1024 + 64 * s2 + 16 * kg);
      uint4 vr[8];
#pragma unroll
      for (int q = 0; q < 8; ++q) {
        const int ia = __builtin_amdgcn_readlane(idv, e0 + 2 * q), ib = __builtin_amdgcn_readlane(idv, e0 + 2 * q + 1);
        const int id = hh ? ib : ia;
        vr[q] = *(const uint4*)(p.utab() + (size_t)id * 1024 + 512 + li * 16);
      }
      f32x4 D = (f32x4){0.f, 0.f, 0.f, 0.f};
#pragma unroll
      for (int s2 = 0; s2 < 8; ++s2) {
        const v8i_t av = (v8i_t){(int)ua[s2].x, (int)ua[s2].y, (int)ua[s2].z, (int)ua[s2].w, 0, 0, 0, 0};
        D = __builtin_amdgcn_mfma_scale_f32_16x16x128_f8f6f4(av, hb[s2], D, 4  , 0  , 0, 0x7f7f7f7f, 0, 0x7f7f7f7f);
      }
      const int nn = m16 & 3;
      const float dotv = nn == 0 ? D[0] : (nn == 1 ? D[1] : (nn == 2 ? D[2] : D[3]));
      const int esrc = e0 + 4 * kg + nn;
      const float usx = __shfl(usv, esrc, 64), gvx = __shfl(gvv, esrc, 64);
      const float cfl = gvx * gelu_as(dotv * usx);
#pragma unroll
      for (int q = 0; q < 8; ++q) {
        int one_s;
        asm volatile("s_mov_b32 %0, 1" : "=s"(one_s));
        if (one_s == 0) continue;
        const int ma = 2 * q, mb = 2 * q + 1;
        const float cfa = __int_as_float(__builtin_amdgcn_readlane(__float_as_int(cfl), 16 * (ma >> 2) + (ma & 3)));
        const float cfb = __int_as_float(__builtin_amdgcn_readlane(__float_as_int(cfl), 16 * (mb >> 2) + (mb & 3)));
        const float cf = hh ? cfb : cfa;
        const unsigned vv[4] = {vr[q].x, vr[q].y, vr[q].z, vr[q].w};
#pragma unroll
        for (int k = 0; k < 4; ++k) {
          v2f p0 = __builtin_amdgcn_cvt_scalef32_pk_f32_fp4(vv[k], 1.0f, 0), p1 = __builtin_amdgcn_cvt_scalef32_pk_f32_fp4(vv[k], 1.0f, 1);
          v2f p2 = __builtin_amdgcn_cvt_scalef32_pk_f32_fp4(vv[k], 1.0f, 2), p3 = __builtin_amdgcn_cvt_scalef32_pk_f32_fp4(vv[k], 1.0f, 3);
          oacc[8 * k] += cf * p0[0]; oacc[8 * k + 1] += cf * p0[1];
          oacc[8 * k + 2] += cf * p1[0]; oacc[8 * k + 3] += cf * p1[1];
          oacc[8 * k + 4] += cf * p2[0]; oacc[8 * k + 5] += cf * p2[1];
          oacc[8 * k + 6] += cf * p3[0]; oacc[8 * k + 7] += cf * p3[1];
        }
      }
    }
    float mine[16];
#pragma unroll
    for (int i = 0; i < 16; ++i) {
      const float give = hh ? oacc[i] : oacc[16 + i];
      const float got = __shfl_xor(give, 32, 64);
      mine[i] = (hh ? oacc[16 + i] : oacc[i]) + got;
    }
    const int b = row >> 11;
    const int colb = li * 32 + hh * 16;
    float h3[16];
    float ss = 0.f;
    const uint4 hA = *(const uint4*)((const u16*)p.out + (size_t)row * 2048 + 1024 + colb), hB = *(const uint4*)((const u16*)p.out + (size_t)row * 2048 + 1024 + colb + 8);
    const unsigned hw[8] = {hA.x, hA.y, hA.z, hA.w, hB.x, hB.y, hB.z, hB.w};
#pragma unroll
    for (int q = 0; q < 4; ++q) {
      const int col = colb + q * 4;
      const float4 a0 = make_float4(bflo(hw[2 * q]), bfhi(hw[2 * q]), bflo(hw[2 * q + 1]), bfhi(hw[2 * q + 1]));
      float4 q0 = *(const float4*)(p.mod() + b * 6144 + 5 * 1024 + col);
      h3[q * 4 + 0] = a0.x + q0.x * mine[q * 4 + 0];
      h3[q * 4 + 1] = a0.y + q0.y * mine[q * 4 + 1];
      h3[q * 4 + 2] = a0.z + q0.z * mine[q * 4 + 2];
      h3[q * 4 + 3] = a0.w + q0.w * mine[q * 4 + 3];
      ss += h3[q * 4] * h3[q * 4] + h3[q * 4 + 1] * h3[q * 4 + 1] + h3[q * 4 + 2] * h3[q * 4 + 2] + h3[q * 4 + 3] * h3[q * 4 + 3];
    }
    ss = wave_sum_u(ss);
    const float rstd = rsqrtf(ss * (1.f / 1024.f) + 1e-6f);
#pragma unroll
    for (int q = 0; q < 4; ++q) {
      const int col = colb + q * 4;
      float4 n0 = *(const float4*)(p.norm_f_g + col);
      *(float4*)(dst + (size_t)row * 1024 + col) =
          make_float4(h3[q * 4] * rstd * n0.x, h3[q * 4 + 1] * rstd * n0.y, h3[q * 4 + 2] * rstd * n0.z, h3[q * 4 + 3] * rstd * n0.w);
    }
  }
}

#define XB_TMO      128
#define XB_XCNT(j)  (256  + 64 * (j))
#define XB_XSUB(j)  (1280 + 64 * (j))
#define XB_XGEN(j)  (2304 + 64 * (j))
#define XB_TOP      3328
#define XB_TOPGEN   3392
#define XCD_BAR_WORDS 3456
#define XB_SPIN_CAP (1u << 18)
#define LAS __attribute__((address_space(3)))

__device__ __forceinline__ unsigned xb_ld(unsigned* p)              { return __hip_atomic_load(p, __ATOMIC_RELAXED, __HIP_MEMORY_SCOPE_AGENT); }
__device__ __forceinline__ unsigned xb_add(unsigned* p, unsigned v) { return __hip_atomic_fetch_add(p, v, __ATOMIC_RELAXED, __HIP_MEMORY_SCOPE_AGENT); }
__device__ __forceinline__ unsigned xb_xcc_id() { return (unsigned)__builtin_amdgcn_s_getreg((3 << 11) | 20) & 0xFu; }
#define XB_SPIN(cond, bar) do { unsigned _sp = 0; while (cond) { __builtin_amdgcn_s_sleep(1); \
    if ((++_sp & 255u) == 0u) { if (xb_ld(&(bar)[XB_TMO])) break; if (_sp > XB_SPIN_CAP) { atomicAdd(&(bar)[XB_TMO], 1u); break; } } } } while (0)

struct XcdBarrier {
    unsigned* bar; unsigned x;
    volatile LAS unsigned* st;
};

__device__ __forceinline__ XcdBarrier xcd_barrier_post(unsigned* bar, volatile LAS unsigned* st) {
    XcdBarrier b; b.bar = bar; b.x = xb_xcc_id(); b.st = st;
    if (tidx() == 0) (void)xb_add(&bar[XB_XCNT(b.x)], 1u);
    return b;
}
__device__ __forceinline__ void xcd_barrier_complete(unsigned* bar, unsigned x, unsigned& nloc, unsigned& nx) {
    const unsigned G = gridDim.x * gridDim.y * gridDim.z;
    unsigned sum, cnt, mine, sp = 0u;
    for (;;) {
        sum = 0u; cnt = 0u; mine = 0u;
#pragma unroll
        for (unsigned j = 0; j < 16; ++j) { const unsigned c = xb_ld(&bar[XB_XCNT(j)]); sum += c; cnt += (c > 0u) ? 1u : 0u; mine = (j == x) ? c : mine; }
        if (sum == G) break;
        __builtin_amdgcn_s_sleep(1);
        if ((++sp & 255u) == 0u) { if (xb_ld(&bar[XB_TMO])) break; if (sp > XB_SPIN_CAP) { atomicAdd(&bar[XB_TMO], 1u); break; } }
    }
    nloc = mine > 0u ? mine : 1u; nx = cnt > 0u ? cnt : 1u;
}

__device__ __forceinline__ void xcd_barrier(const XcdBarrier& b) {
    asm volatile("s_waitcnt vmcnt(0)" ::: "memory");
    __syncthreads();
    if (tidx() == 0) {
        unsigned* bar = b.bar;
        __builtin_amdgcn_s_waitcnt(0);
        unsigned nloc = b.st[0], nx = b.st[1];
        if (nloc == 0u) { xcd_barrier_complete(bar, b.x, nloc, nx); b.st[0] = nloc; b.st[1] = nx; }
        const unsigned old = xb_add(&bar[XB_XSUB(b.x)], 1u);
        const unsigned gen = old / nloc;
        if (old + 1u == (gen + 1u) * nloc) {
            __builtin_amdgcn_fence(__ATOMIC_RELEASE, "agent");
            asm volatile("s_waitcnt vmcnt(0)" ::: "memory");
            const unsigned og = xb_add(&bar[XB_TOP], 1u);
            const unsigned tg = og / nx;
            if (og + 1u == (tg + 1u) * nx) xb_add(&bar[XB_TOPGEN], 1u);
            else XB_SPIN(xb_ld(&bar[XB_TOPGEN]) == tg, bar);
            __builtin_amdgcn_fence(__ATOMIC_ACQUIRE, "agent");
            xb_add(&bar[XB_XGEN(b.x)], 1u);
            asm volatile("s_waitcnt vmcnt(0)" ::: "memory");
        } else {
            XB_SPIN(xb_ld(&bar[XB_XGEN(b.x)]) == gen, bar);
            __builtin_amdgcn_fence(__ATOMIC_ACQUIRE, "agent");
            asm volatile("s_waitcnt vmcnt(0)" ::: "memory");
        }
    }
    __syncthreads();
}

typedef const __attribute__((address_space(4))) P* kargP_t;
__device__ __forceinline__ P load_params() {
  kargP_t q = (kargP_t)__builtin_amdgcn_kernarg_segment_ptr();
  asm volatile("" : "+s"(q));
  P r;
  r.x = q->x;
  r.c = q->c;
  r.ctx = q->ctx;
  r.c_ctx = q->c_ctx;
  r.w_ada = q->w_ada;
  r.b_ada = q->b_ada;
  r.norm1_g = q->norm1_g;
  r.norm2_g = q->norm2_g;
  r.w_in = q->w_in;
  r.s5_a_re = q->s5_a_re;
  r.s5_a_im = q->s5_a_im;
  r.s5_log_dt = q->s5_log_dt;
  r.s5_b_re = q->s5_b_re;
  r.s5_b_im = q->s5_b_im;
  r.s5_c_re = q->s5_c_re;
  r.s5_c_im = q->s5_c_im;
  r.s5_d = q->s5_d;
  r.s5_w_glu = q->s5_w_glu;
  r.s5_b_glu = q->s5_b_glu;
  r.rw_mu = q->rw_mu;
  r.rw_w0 = q->rw_w0;
  r.rw_w_w2 = q->rw_w_w2;
  r.rw_a0 = q->rw_a0;
  r.rw_w_a2 = q->rw_w_a2;
  r.rw_w_g2 = q->rw_w_g2;
  r.rw_k_k = q->rw_k_k;
  r.rw_k_a = q->rw_k_a;
  r.rw_r_k = q->rw_r_k;
  r.rw_ln_w = q->rw_ln_w;
  r.rw_ln_b = q->rw_ln_b;
  r.w_out = q->w_out;
  r.peer_w_q = q->peer_w_q;
  r.peer_keys = q->peer_keys;
  r.peer_u = q->peer_u;
  r.peer_v = q->peer_v;
  r.norm_f_g = q->norm_f_g;
  r.out = q->out;
  r.ws = q->ws;
  return r;
}
#define NPHASES 11
template <int PH>
__device__ __forceinline__ void run_phase(const P& p, char* smem, int bid, int nb, bool rep = false) {
  if (PH == 0) ph_prep(p, smem, bid, nb);
  if (PH == 1) ph_norm(p, 0, bid, nb);
  if (PH == 2) {
    pg8::StaticOrder S; S.init(NTOK, INCP, nb, bid);
    pg8::gemm_phase<pg8::EpiProjT, pg8::StaticOrder, false>((PG8_LAS unsigned char*)smem, pg8::Gemm{p.hn(), p.win_t(), NTOK, INCP, 1024}, S, pg8::EpiProjT{p.proj(), INC, INC}, nullptr);
  }
  if (PH == 3) { ph_s5scan2(p, smem, bid, nb); ph_rwscan2(p, smem, bid, nb); }
  if (PH == 4) ph_mixprep(p, bid, nb, rep ? p.hn() : p.ys5f(), rep ? p.hn() + (size_t)NLAT * 512 : p.yrwf());
  if (PH == 5) {
    {
      pg8::StaticOrder S; S.init(NLAT, 512, nb, bid);
      pg8::gemm_phase<pg8::EpiGluT, pg8::StaticOrder, false>((PG8_LAS unsigned char*)smem, pg8::Gemm{p.ys5f(), p.wglu_t(), NLAT, 512, 512}, S, pg8::EpiGluT{p.ys5f(), p.s5_b_glu, p.hn()}, nullptr);
    }
    {
      pg8::StaticOrder S; S.init(NLAT, 512, nb, bid);
      pg8::gemm_phase<pg8::EpiGateT, pg8::StaticOrder, false>((PG8_LAS unsigned char*)smem, pg8::Gemm{p.sg(), p.wg2_t(), NLAT, 512, 256}, S, pg8::EpiGateT{p.yrwf(), p.hn()}, nullptr);
    }
  }
  if (PH == 6) {
    pg8::StaticOrder S; S.init(NLAT, 1024, nb, bid);
    pg8::gemm_phase<pg8::EpiWoutT, pg8::StaticOrder, false>((PG8_LAS unsigned char*)smem, pg8::Gemm{p.hn(), p.wout_t(), NLAT, 1024, 1024}, S, pg8::EpiWoutT{p.x, p.mod(), (pg8::bf16_t*)p.out}, nullptr);
  }
  if (PH == 7) ph_norm(p, 1, bid, nb);
  if (PH == 8) {
    pg8::StaticOrder S; S.init(NLAT, 2048, nb, bid);
    pg8::gemm_phase<pg8::EpiProjT, pg8::StaticOrder, false>((PG8_LAS unsigned char*)smem, pg8::Gemm{p.hn(), p.wq_t(), NLAT, 2048, 1024}, S, pg8::EpiProjT{p.proj(), 2048, 2048}, nullptr);
  }
  if (PH == 9) ph_route(p, smem, bid, nb);
  if (PH == 10) ph_ffn(p, rep ? (float*)p.proj() : p.out, smem, bid, nb);
  if (PH == 11) ph_s5scan2(p, smem, bid, nb);
  if (PH == 12) ph_rwscan2(p, smem, bid, nb);
}
#ifndef REPMASK
#define REPMASK 0
#endif
#define REP(n) ((REPMASK >> (n)) & 1)
#define PHASE(n) if (ph_lo <= n && n < ph_hi) { if (n > ph_lo) { if (n == 1) grid.sync(); else xcd_barrier(xb); } if (REP(n)) { { const P lp_ = load_params(); run_phase<n>(lp_, smem, bid, nb, true); } __syncthreads(); } if (n == 3 && REP(11)) { run_phase<11>(p, smem, bid, nb); __syncthreads(); } if (n == 3 && REP(12)) { run_phase<12>(p, smem, bid, nb); __syncthreads(); } { const P lp_ = load_params(); run_phase<n>(lp_, smem, bid, nb); } }
__global__ void __launch_bounds__(NTHREADS) mega(P p, int ph_lo, int ph_hi) {
  char* smem = g_smem;
  if ((threadIdx.x & 63) == 0) *(int*)(g_smem + WAVETAB_OFF + 4 * hw_slot()) = (int)(threadIdx.x >> 6);
  cg::grid_group grid = cg::this_grid();
  const int bid = blockIdx.x, nb = gridDim.x;
  volatile LAS unsigned* xst = (volatile LAS unsigned*)(smem + LDS_BYTES - 16);
  if (threadIdx.x == 0) { xst[0] = 0u; xst[1] = 0u; }
  __syncthreads();
  XcdBarrier xb;
  {
    const P lp0 = load_params();
    xb.bar = lp0.bar(); xb.x = 0; xb.st = xst;
    if (ph_hi - ph_lo > 1) xb = xcd_barrier_post(lp0.bar(), xst);
  }
  PHASE(0) PHASE(1) PHASE(2) PHASE(3) PHASE(4) PHASE(5) PHASE(6) PHASE(7) PHASE(8) PHASE(9) PHASE(10)
}

extern "C" void kernel_launch(void* const* d_in, const int* in_sizes, int n_in, void* d_out, int out_size, void* d_ws,
                              size_t ws_size, hipStream_t stream) {
  static int grid_blocks = 0;
  if (!grid_blocks) {
    int dev = 0, cus = 0, per_cu = 0;
    hipGetDevice(&dev);
    hipDeviceGetAttribute(&cus, hipDeviceAttributeMultiprocessorCount, dev);
    hipFuncSetAttribute((const void*)mega, hipFuncAttributeMaxDynamicSharedMemorySize, LDS_BYTES);
    hipOccupancyMaxActiveBlocksPerMultiprocessor(&per_cu, (const void*)mega, NTHREADS, LDS_BYTES);
    if (per_cu < 1) { fprintf(stderr, "occupancy query returned %d\n", per_cu); per_cu = 1; }
    grid_blocks = cus;
  }
  P p{};
  const float** fp = (const float**)&p;
  for (int i = 0; i < 36; ++i) fp[i] = (const float*)d_in[i];
  p.out = (float*)d_out;
  p.ws = (char*)d_ws;
  if (WS_TOTAL > ws_size) { fprintf(stderr, "workspace too small: need %zu have %zu\n", (size_t)WS_TOTAL, ws_size); return; }
#if MEGA
  if (hipMemsetAsync((char*)d_ws + OFF_bar, 0, XCD_BAR_WORDS * 4, stream) != hipSuccess) fprintf(stderr, "memset of barrier words failed\n");
  int lo = 0, hi = NPHASES;
  void* args[] = {&p, &lo, &hi};
  hipError_t e = hipLaunchCooperativeKernel((const void*)mega, dim3(grid_blocks), dim3(NTHREADS), args, LDS_BYTES, stream);
  if (e != hipSuccess) fprintf(stderr, "cooperative launch failed: %s (grid %d)\n", hipGetErrorString(e), grid_blocks);
#else
  for (int ph = 0; ph < NPHASES; ++ph) {
    hipLaunchKernelGGL(mega, dim3(grid_blocks), dim3(NTHREADS), LDS_BYTES, stream, p, ph, ph + 1);
  }
#endif
}
```

```cpp
#include <hip/hip_runtime.h>
#include <hip/hip_cooperative_groups.h>
#include <stdint.h>
#include <stdio.h>
namespace cg = cooperative_groups;

#ifndef MEGA
#define MEGA 1
#endif

typedef unsigned short u16;
using bf16x8 = __attribute__((ext_vector_type(8))) short;
using f32x4 = __attribute__((ext_vector_type(4))) float;
using u32x4 = __attribute__((ext_vector_type(4))) unsigned;
using f32x16 = __attribute__((ext_vector_type(16))) float;

#define DM 1024
#define NLAT 65536
#define NCTX 8192
#define NTOK 73728
#define INC 2208
#define INCP 2304
#define NTHREADS 512
#define LDS_BYTES 163840

#define INC_FWD 1
constexpr size_t ws_al(size_t x) { return (x + 255) & ~(size_t)255; }
constexpr size_t OFF_mod = 0;
constexpr size_t OFF_win_t = OFF_mod + ws_al(33 * 6144 * 4);
constexpr size_t OFF_wout_t = OFF_win_t + ws_al((size_t)2304 * 1024 * 2);
constexpr size_t OFF_wq_t = OFF_wout_t + ws_al((size_t)1024 * 1024 * 2);
constexpr size_t OFF_wglu_t = OFF_wq_t + ws_al((size_t)2048 * 1024 * 2);
constexpr size_t OFF_wg2_t = OFF_wglu_t + ws_al((size_t)512 * 512 * 2);
constexpr size_t OFF_keys = OFF_wg2_t + ws_al((size_t)512 * 256 * 2);
constexpr size_t OFF_utab = OFF_keys + ws_al((size_t)8 * 2 * 128 * 128 * 2);
constexpr size_t OFF_usc = OFF_utab + ws_al((size_t)16384 * 1024);
constexpr size_t OFF_vsc = OFF_usc + ws_al(16384 * 4);
constexpr size_t OFF_s5ab = OFF_vsc + ws_al(16384 * 4);
constexpr size_t OFF_s5bb = OFF_s5ab + ws_al(4096 * 2 * 4);
constexpr size_t OFF_s5ct = OFF_s5bb + ws_al(4096 * 32 * 4);
constexpr size_t OFF_hn = OFF_s5ct + ws_al(2 * 32 * 16 * 128 * 2);
constexpr size_t OFF_proj = OFF_hn + ws_al((size_t)73728 * 1024 * 2);
constexpr size_t OFF_ys5f = OFF_proj + ws_al((size_t)73728 * 2208 * 2);
constexpr size_t OFF_ys5b = OFF_ys5f + ws_al((size_t)65536 * 512 * 2);
constexpr size_t OFF_yrwf = OFF_ys5b + ws_al((size_t)65536 * 512 * 2);
constexpr size_t OFF_yrwb = OFF_yrwf + ws_al((size_t)65536 * 512 * 2);
constexpr size_t OFF_bsc = OFF_yrwb + ws_al((size_t)65536 * 512 * 2);
constexpr size_t OFF_sg = OFF_bsc + ws_al((size_t)2 * 65536 * 8 * 4);
constexpr size_t OFF_bar = OFF_sg + ws_al((size_t)65536 * 256 * 2);
constexpr size_t OFF_wlf = OFF_bar + ws_al(3456 * 4);
constexpr size_t WS_TOTAL = OFF_wlf + ws_al(2 * 4096 * 16);

extern __shared__ __attribute__((aligned(16))) char g_smem[];
#define WAVETAB_OFF (LDS_BYTES - 16 - 256)
__device__ __forceinline__ int hw_slot() { return (int)(__builtin_amdgcn_s_getreg((5 << 11) | 4) & 63u); }
__device__ __forceinline__ int tidx() {
  const int w = *(const int*)(g_smem + WAVETAB_OFF + 4 * hw_slot());
  return __builtin_amdgcn_readfirstlane(w) * 64 + (int)__builtin_amdgcn_mbcnt_hi(~0u, __builtin_amdgcn_mbcnt_lo(~0u, 0u));
}
__device__ __forceinline__ int widx() { return __builtin_amdgcn_readfirstlane(*(const int*)(g_smem + WAVETAB_OFF + 4 * hw_slot())); }
__device__ __forceinline__ int lidx() { return (int)__builtin_amdgcn_mbcnt_hi(~0u, __builtin_amdgcn_mbcnt_lo(~0u, 0u)); }
struct P {
  const float *x, *c, *ctx, *c_ctx, *w_ada, *b_ada, *norm1_g, *norm2_g, *w_in, *s5_a_re, *s5_a_im, *s5_log_dt,
      *s5_b_re, *s5_b_im, *s5_c_re, *s5_c_im, *s5_d, *s5_w_glu, *s5_b_glu, *rw_mu, *rw_w0, *rw_w_w2, *rw_a0, *rw_w_a2,
      *rw_w_g2, *rw_k_k, *rw_k_a, *rw_r_k, *rw_ln_w, *rw_ln_b, *w_out, *peer_w_q, *peer_keys, *peer_u, *peer_v, *norm_f_g;
  float* out;
  char* ws;
  __device__ __forceinline__ float* mod() const { return (float*)(ws + OFF_mod); }
  __device__ __forceinline__ u16* win_t() const { return (u16*)(ws + OFF_win_t); }
  __device__ __forceinline__ u16* wout_t() const { return (u16*)(ws + OFF_wout_t); }
  __device__ __forceinline__ u16* wq_t() const { return (u16*)(ws + OFF_wq_t); }
  __device__ __forceinline__ u16* wglu_t() const { return (u16*)(ws + OFF_wglu_t); }
  __device__ __forceinline__ u16* wg2_t() const { return (u16*)(ws + OFF_wg2_t); }
  __device__ __forceinline__ u16* keys() const { return (u16*)(ws + OFF_keys); }
  __device__ __forceinline__ unsigned char* utab() const { return (unsigned char*)(ws + OFF_utab); }
  __device__ __forceinline__ float* usc() const { return (float*)(ws + OFF_usc); }
  __device__ __forceinline__ float* vsc() const { return (float*)(ws + OFF_vsc); }
  __device__ __forceinline__ float* s5ab() const { return (float*)(ws + OFF_s5ab); }
  __device__ __forceinline__ float* s5bb() const { return (float*)(ws + OFF_s5bb); }
  __device__ __forceinline__ u16* s5ct() const { return (u16*)(ws + OFF_s5ct); }
  __device__ __forceinline__ u16* hn() const { return (u16*)(ws + OFF_hn); }
  __device__ __forceinline__ u16* proj() const { return (u16*)(ws + OFF_proj); }
  __device__ __forceinline__ u16* ys5f() const { return (u16*)(ws + OFF_ys5f); }
  __device__ __forceinline__ u16* ys5b() const { return (u16*)(ws + OFF_ys5b); }
  __device__ __forceinline__ u16* yrwf() const { return (u16*)(ws + OFF_yrwf); }
  __device__ __forceinline__ u16* yrwb() const { return (u16*)(ws + OFF_yrwb); }
  __device__ __forceinline__ float* bsc() const { return (float*)(ws + OFF_bsc); }
  __device__ __forceinline__ u16* sg() const { return (u16*)(ws + OFF_sg); }
  __device__ __forceinline__ unsigned* bar() const { return (unsigned*)(ws + OFF_bar); }
  __device__ __forceinline__ u16* wlf() const { return (u16*)(ws + OFF_wlf); }
  __device__ __forceinline__ unsigned char* vtab() const { return utab() + 512; }
  __device__ __forceinline__ int* idx() const { return (int*)ys5b(); }
  __device__ __forceinline__ float* gate() const { return (float*)yrwb(); }
};

typedef float f32x2_t __attribute__((ext_vector_type(2)));
typedef __bf16 bf16x2_t __attribute__((ext_vector_type(2)));
__device__ __forceinline__ unsigned pack2(float a, float b) {
  f32x2_t v = {a, b};
  return __builtin_bit_cast(unsigned, __builtin_convertvector(v, bf16x2_t));
}
__device__ __forceinline__ u16 f2bf(float f) { return __builtin_bit_cast(u16, (__bf16)f); }
__device__ __forceinline__ float bf2f(u16 h) { return __uint_as_float(((unsigned)h) << 16); }
__device__ __forceinline__ float bflo(unsigned u) { return __uint_as_float(u << 16); }
__device__ __forceinline__ float bfhi(unsigned u) { return __uint_as_float(u & 0xffff0000u); }
__device__ __forceinline__ float wave_sum(float v) {
#pragma unroll
  for (int m = 32; m >= 1; m >>= 1) v += __shfl_xor(v, m, 64);
  return v;
}
__device__ __forceinline__ float gelu_exact(float x) { return 0.5f * x * (1.f + erff(x * 0.70710678118654752f)); }
__device__ __forceinline__ float gelu_as(float v) {
  const float av = fabsf(v), t = __builtin_amdgcn_rcpf(av * 0.2316418882f + 1.0f);
  float q = t * 0.5307027145f + (-0.7265760135f);
  q = q * t + 0.7107068705f; q = q * t + (-0.142248368f); q = q * t + 0.127414796f; q = q * t;
  const float e = __builtin_amdgcn_exp2f((v * v) * (-0.72134752044f));
  const float m = v * (q * e);
  return v < 0.f ? m : v - m;
}
__device__ __forceinline__ float sigmoidf(float x) { return 1.f / (1.f + __expf(-x)); }


typedef float v2f __attribute__((ext_vector_type(2)));
__device__ __forceinline__ float dpp_add(float v, const int ctrl, const int rmask) {
  int m;
  switch (ctrl) {
    case 0: m = __builtin_amdgcn_update_dpp(0, __float_as_int(v), 0xB1, 0xf, 0xf, true); break;
    case 1: m = __builtin_amdgcn_update_dpp(0, __float_as_int(v), 0x4E, 0xf, 0xf, true); break;
    case 2: m = __builtin_amdgcn_update_dpp(0, __float_as_int(v), 0x141, 0xf, 0xf, true); break;
    case 3: m = __builtin_amdgcn_update_dpp(0, __float_as_int(v), 0x140, 0xf, 0xf, true); break;
    case 4: m = __builtin_amdgcn_update_dpp(0, __float_as_int(v), 0x142, 0xa, 0xf, false); break;
    default: m = __builtin_amdgcn_update_dpp(0, __float_as_int(v), 0x143, 0xc, 0xf, false); break;
  }
  return v + __int_as_float(m);
}
__device__ __forceinline__ float wave_sum_u(float v) {
  v = dpp_add(v, 0, 0); v = dpp_add(v, 1, 0); v = dpp_add(v, 2, 0); v = dpp_add(v, 3, 0);
  v = dpp_add(v, 4, 0); v = dpp_add(v, 5, 0);
  return __int_as_float(__builtin_amdgcn_readlane(__float_as_int(v), 63));
}
__device__ __forceinline__ void convert_fp4_rows(const float* __restrict__ src, unsigned char* __restrict__ dst, float* __restrict__ sc,
                                                 int nrows, int bid, int nb) {
  const int wid = tidx() >> 6, lane = tidx() & 63;
  const int stride = nb * 8;
  for (int row0 = bid * 8 + wid; row0 < nrows; row0 += 4 * stride) {
    float4 v[4][4];
#pragma unroll
    for (int u = 0; u < 4; ++u) {
      int row = row0 + u * stride;
      if (row >= nrows) row = row0;
#pragma unroll
      for (int q = 0; q < 4; ++q) v[u][q] = *(const float4*)(src + (size_t)row * 1024 + lane * 16 + q * 4);
    }
#pragma unroll
    for (int u = 0; u < 4; ++u) {
      const int row = row0 + u * stride;
      if (row >= nrows) continue;
      float am = 0.f;
#pragma unroll
      for (int q = 0; q < 4; ++q)
        am = fmaxf(am, fmaxf(fmaxf(fabsf(v[u][q].x), fabsf(v[u][q].y)), fmaxf(fabsf(v[u][q].z), fabsf(v[u][q].w))));
#pragma unroll
      for (int m = 32; m >= 1; m >>= 1) am = fmaxf(am, __shfl_xor(am, m, 64));
      const float scl = am > 0.f ? 6.f / am : 1.f;
      unsigned w0 = 0u, w1 = 0u;
      w0 = __builtin_amdgcn_cvt_scalef32_pk_fp4_f32(w0, v[u][0].x * scl, v[u][0].y * scl, 1.0f, 0);
      w0 = __builtin_amdgcn_cvt_scalef32_pk_fp4_f32(w0, v[u][0].z * scl, v[u][0].w * scl, 1.0f, 1);
      w0 = __builtin_amdgcn_cvt_scalef32_pk_fp4_f32(w0, v[u][1].x * scl, v[u][1].y * scl, 1.0f, 2);
      w0 = __builtin_amdgcn_cvt_scalef32_pk_fp4_f32(w0, v[u][1].z * scl, v[u][1].w * scl, 1.0f, 3);
      w1 = __builtin_amdgcn_cvt_scalef32_pk_fp4_f32(w1, v[u][2].x * scl, v[u][2].y * scl, 1.0f, 0);
      w1 = __builtin_amdgcn_cvt_scalef32_pk_fp4_f32(w1, v[u][2].z * scl, v[u][2].w * scl, 1.0f, 1);
      w1 = __builtin_amdgcn_cvt_scalef32_pk_fp4_f32(w1, v[u][3].x * scl, v[u][3].y * scl, 1.0f, 2);
      w1 = __builtin_amdgcn_cvt_scalef32_pk_fp4_f32(w1, v[u][3].z * scl, v[u][3].w * scl, 1.0f, 3);
      *(uint2*)(dst + (size_t)row * 1024 + lane * 8) = make_uint2(w0, w1);
      if (lane == 0) sc[row] = am > 0.f ? am / 6.f : 1.f;
    }
  }
}

__device__ __forceinline__ void transpose_tiles(const float* __restrict__ src, int K, int N, u16* __restrict__ dst, int Kd, int Npad,
                                char* smem, int bid, int nb) {
  float* tile = (float*)smem;
  const int tid = tidx();
  const int nkt = Kd / 64, nnt = Npad / 64;
  for (int t = bid; t < nkt * nnt; t += nb) {
    int kt = t % nkt, nt = t / nkt;
    int k0 = kt * 64, n0 = nt * 64;
    __syncthreads();
#pragma unroll
    for (int it = 0; it < 8; ++it) {
      int i = (tid >> 6) + it * 8, j = tid & 63;
      int k = k0 + i, n = n0 + j;
      tile[i * 65 + j] = (k < K && n < N) ? src[(size_t)k * N + n] : 0.f;
    }
    __syncthreads();
    int n = tid >> 3, kc = (tid & 7) * 8;
    uint4 o;
    o.x = pack2(tile[(kc + 0) * 65 + n], tile[(kc + 1) * 65 + n]);
    o.y = pack2(tile[(kc + 2) * 65 + n], tile[(kc + 3) * 65 + n]);
    o.z = pack2(tile[(kc + 4) * 65 + n], tile[(kc + 5) * 65 + n]);
    o.w = pack2(tile[(kc + 6) * 65 + n], tile[(kc + 7) * 65 + n]);
    *(uint4*)(dst + (size_t)(n0 + n) * Kd + k0 + kc) = o;
  }
}

__device__ __forceinline__ void convert_bf16(const float* __restrict__ src, u16* __restrict__ dst, size_t n8, int bid, int nb) {
  for (size_t i = (size_t)bid * NTHREADS + tidx(); i < n8; i += (size_t)nb * NTHREADS) {
    float4 a = *(const float4*)(src + i * 8), b = *(const float4*)(src + i * 8 + 4);
    uint4 o;
    o.x = pack2(a.x, a.y); o.y = pack2(a.z, a.w); o.z = pack2(b.x, b.y); o.w = pack2(b.z, b.w);
    *(uint4*)(dst + i * 8) = o;
  }
}

__device__ __forceinline__ void ph_prep(const P& p, char* smem, int bid, int nb) {
  const int tid = tidx();
  {
    float* sc = (float*)smem;
    float* red = (float*)(smem + 33 * 256 * 4);
    for (int item = bid; item < 192; item += nb) {
      const int j0 = item * 32, kg = tid >> 5, col = tid & 31;
      float acc[33];
#pragma unroll
      for (int b = 0; b < 33; ++b) acc[b] = 0.f;
      for (int ch = 0; ch < 4; ++ch) {
        __syncthreads();
        for (int e = tid; e < 33 * 256; e += NTHREADS) {
          int b = e >> 8, kk = e & 255;
          float cv = (b < 32) ? p.c[b * 1024 + ch * 256 + kk] : p.c_ctx[ch * 256 + kk];
          sc[e] = cv / (1.f + expf(-cv));
        }
        float w[16];
#pragma unroll
        for (int i = 0; i < 16; ++i) w[i] = p.w_ada[(size_t)(ch * 256 + kg * 16 + i) * 6144 + j0 + col];
        __syncthreads();
#pragma unroll
        for (int i = 0; i < 16; ++i) {
          const int kk = kg * 16 + i;
#pragma unroll
          for (int b = 0; b < 33; ++b) acc[b] += sc[b * 256 + kk] * w[i];
        }
      }
#pragma unroll
      for (int b = 0; b < 33; ++b) red[(kg * 33 + b) * 32 + col] = acc[b];
      __syncthreads();
      for (int e = tid; e < 33 * 32; e += NTHREADS) {
        int b = e >> 5, cc = e & 31;
        float sv = p.b_ada[j0 + cc];
#pragma unroll
        for (int k2 = 0; k2 < 16; ++k2) sv += red[(k2 * 33 + b) * 32 + cc];
        p.mod()[b * 6144 + j0 + cc] = sv;
      }
      __syncthreads();
    }
  }
  transpose_tiles(p.w_in, 1024, INC, p.win_t(), 1024, INCP, smem, bid, nb);
  transpose_tiles(p.w_out, 1024, 1024, p.wout_t(), 1024, 1024, smem, bid, nb);
  transpose_tiles(p.peer_w_q, 1024, 2048, p.wq_t(), 1024, 2048, smem, bid, nb);
  transpose_tiles(p.s5_w_glu, 512, 512, p.wglu_t(), 512, 512, smem, bid, nb);
  transpose_tiles(p.rw_w_g2, 96, 512, p.wg2_t(), 256, 512, smem, bid, nb);
  convert_bf16(p.peer_keys, p.keys(), (size_t)8 * 2 * 128 * 128 / 8, bid, nb);
  convert_fp4_rows(p.peer_u, p.utab(), p.usc(), 16384, bid, nb);
  convert_fp4_rows(p.peer_v, p.vtab(), p.vsc(), 16384, bid, nb);
  for (int it = bid * NTHREADS + tid; it < 2 * 4096; it += nb * NTHREADS) {
    const int ln = it & 63, mt = (it >> 6) & 3, hh_ = (it >> 8) & 7, dd = (it >> 11) & 1, mm = it >> 12;
    const int tt = ln & 15, kq_ = ln >> 4;
    const float* W = mm ? p.rw_w_a2 : p.rw_w_w2;
    unsigned o[4];
#pragma unroll
    for (int q = 0; q < 4; ++q) {
      const size_t o0 = (size_t)(dd * 32 + 8 * kq_ + 2 * q) * 512 + hh_ * 64 + 16 * (tt >> 2) + 4 * mt + (tt & 3);
      o[q] = pack2(W[o0], W[o0 + 512]);
    }
    *(uint4*)(p.wlf() + (size_t)it * 8) = make_uint4(o[0], o[1], o[2], o[3]);
  }
  for (int it = bid * NTHREADS + tid; it < 4096; it += nb * NTHREADS) {
    int pp = it & 63, g = (it >> 6) & 31, d = it >> 11;
    float are = p.s5_a_re[it], aim = p.s5_a_im[it];
    float dt = expf(p.s5_log_dt[d * 32 + g]);
    float mag = expf(dt * are);
    float abr = mag * cosf(dt * aim), abi = mag * sinf(dt * aim);
    float nr = abr - 1.f, ni = abi;
    float den = are * are + aim * aim;
    float cfr = (nr * are + ni * aim) / den, cfi = (ni * are - nr * aim) / den;
    p.s5ab()[it * 2] = abr;
    p.s5ab()[it * 2 + 1] = abi;
    for (int h = 0; h < 16; ++h) {
      float br = p.s5_b_re[(size_t)it * 16 + h], bi = p.s5_b_im[(size_t)it * 16 + h];
      p.s5bb()[(size_t)it * 32 + h] = cfr * br - cfi * bi;
      p.s5bb()[(size_t)it * 32 + 16 + h] = cfr * bi + cfi * br;
    }
    for (int h = 0; h < 16; ++h) {
      size_t ci = ((size_t)(d * 32 + g) * 16 + h) * 64 + pp;
      p.s5ct()[((size_t)(d * 32 + g) * 16 + h) * 128 + 2 * pp] = f2bf(p.s5_c_re[ci]);
      p.s5ct()[((size_t)(d * 32 + g) * 16 + h) * 128 + 2 * pp + 1] = f2bf(-p.s5_c_im[ci]);
    }
  }
}

__device__ __forceinline__ void ph_norm(const P& p, int mode, int bid, int nb) {
  const int wid = tidx() >> 6, lane = tidx() & 63;
  const int nrows = mode == 0 ? NTOK : NLAT;
  const float* gvec = mode == 0 ? p.norm1_g : p.norm2_g;
  const int sh_off = mode == 0 ? 0 : 3 * 1024, sc_off = sh_off + 1024;
  const int stride = nb * 8;
  for (int row0 = bid * 8 + wid; row0 < nrows; row0 += 4 * stride) {
    float4 v[4][4];
    int bs[4];
#pragma unroll
    for (int u = 0; u < 4; ++u) {
      int row = row0 + u * stride;
      if (row >= nrows) row = row0;
      const float* src;
      if (mode == 0) {
        if (row < NLAT) { src = p.x + (size_t)row * 1024; bs[u] = row >> 11; }
        else { src = p.ctx + (size_t)(row - NLAT) * 1024; bs[u] = 32; }
      } else { src = nullptr; bs[u] = row >> 11; }
      if (mode == 0) {
#pragma unroll
        for (int j = 0; j < 2; ++j) {
          v[u][2 * j] = *(const float4*)(src + j * 512 + lane * 8);
          v[u][2 * j + 1] = *(const float4*)(src + j * 512 + lane * 8 + 4);
        }
      } else {
        const u16* s16 = (const u16*)p.out + (size_t)row * 2048 + 1024;
#pragma unroll
        for (int j = 0; j < 2; ++j) {
          const uint4 q = *(const uint4*)(s16 + j * 512 + lane * 8);
          v[u][2 * j] = make_float4(bflo(q.x), bfhi(q.x), bflo(q.y), bfhi(q.y));
          v[u][2 * j + 1] = make_float4(bflo(q.z), bfhi(q.z), bflo(q.w), bfhi(q.w));
        }
      }
    }
#pragma unroll
    for (int u = 0; u < 4; ++u) {
      const int row = row0 + u * stride;
      if (row >= nrows) continue;
      float ss = 0.f;
#pragma unroll
      for (int j = 0; j < 4; ++j) ss += v[u][j].x * v[u][j].x + v[u][j].y * v[u][j].y + v[u][j].z * v[u][j].z + v[u][j].w * v[u][j].w;
      ss = wave_sum_u(ss);
      const float rstd = rsqrtf(ss * (1.f / 1024.f) + 1e-6f);
      const float* mrow = p.mod() + bs[u] * 6144;
#pragma unroll
      for (int j = 0; j < 2; ++j) {
        const int col = j * 512 + lane * 8;
        unsigned o[4];
#pragma unroll
        for (int hq = 0; hq < 2; ++hq) {
          const float4 x = v[u][2 * j + hq];
          const float4 g = *(const float4*)(gvec + col + 4 * hq);
          const float4 sh = *(const float4*)(mrow + sh_off + col + 4 * hq);
          const float4 sc = *(const float4*)(mrow + sc_off + col + 4 * hq);
          o[2 * hq] = pack2(x.x * rstd * g.x * (1.f + sc.x) + sh.x, x.y * rstd * g.y * (1.f + sc.y) + sh.y);
          o[2 * hq + 1] = pack2(x.z * rstd * g.z * (1.f + sc.z) + sh.z, x.w * rstd * g.w * (1.f + sc.w) + sh.w);
        }
        *(uint4*)(p.hn() + (size_t)row * 1024 + col) = make_uint4(o[0], o[1], o[2], o[3]);
      }
    }
  }
}

#define G_BM 256
#define G_BN 128
#define G_BK 64
#define G_LD 72
template <class Epi>
__device__ __forceinline__ void gemm_simple(const u16* __restrict__ A, int lda, const u16* __restrict__ Bt, int ldb, int K, int M, int N,
                           char* smem, int bid, int nb, Epi epi) {
  u16* As = (u16*)smem;
  u16* Bs = (u16*)(smem + 2 * G_BM * G_LD * 2);
  const int tid = tidx(), wid = tid >> 6, lane = tid & 63;
  const int wr = wid >> 1, wc = wid & 1, fr = lane & 15, fq = lane >> 4;
  const int ntn = N / G_BN, ntiles = (M / G_BM) * ntn, nk = K / G_BK;
  const int lrow = tid >> 3, lkc = (tid & 7) * 8;
  for (int tile = bid; tile < ntiles; tile += nb) {
    const int m0 = (tile / ntn) * G_BM, n0 = (tile % ntn) * G_BN;
    f32x4 acc[4][4];
#pragma unroll
    for (int i = 0; i < 4; ++i)
#pragma unroll
      for (int j = 0; j < 4; ++j) acc[i][j] = (f32x4){0.f, 0.f, 0.f, 0.f};
    u32x4 ra[4], rb[2];
    const u16* Ag = A + (size_t)(m0 + lrow) * lda + lkc;
    const u16* Bg = Bt + (size_t)(n0 + lrow) * ldb + lkc;
#pragma unroll
    for (int i = 0; i < 4; ++i) ra[i] = *(const u32x4*)(Ag + (size_t)(64 * i) * lda);
#pragma unroll
    for (int i = 0; i < 2; ++i) rb[i] = *(const u32x4*)(Bg + (size_t)(64 * i) * ldb);
    __syncthreads();
#pragma unroll
    for (int i = 0; i < 4; ++i) *(u32x4*)(As + (lrow + 64 * i) * G_LD + lkc) = ra[i];
#pragma unroll
    for (int i = 0; i < 2; ++i) *(u32x4*)(Bs + (lrow + 64 * i) * G_LD + lkc) = rb[i];
    __syncthreads();
    for (int kt = 0; kt < nk; ++kt) {
      const int buf = kt & 1;
      if (kt + 1 < nk) {
#pragma unroll
        for (int i = 0; i < 4; ++i) ra[i] = *(const u32x4*)(Ag + (size_t)(64 * i) * lda + (kt + 1) * G_BK);
#pragma unroll
        for (int i = 0; i < 2; ++i) rb[i] = *(const u32x4*)(Bg + (size_t)(64 * i) * ldb + (kt + 1) * G_BK);
      }
      const u16* as = As + buf * (G_BM * G_LD);
      const u16* bs = Bs + buf * (G_BN * G_LD);
#pragma unroll
      for (int ks = 0; ks < 2; ++ks) {
        bf16x8 af[4], bfr[4];
#pragma unroll
        for (int mi = 0; mi < 4; ++mi) af[mi] = *(const bf16x8*)(as + (wr * 64 + mi * 16 + fr) * G_LD + ks * 32 + fq * 8);
#pragma unroll
        for (int ni = 0; ni < 4; ++ni) bfr[ni] = *(const bf16x8*)(bs + (wc * 64 + ni * 16 + fr) * G_LD + ks * 32 + fq * 8);
#pragma unroll
        for (int mi = 0; mi < 4; ++mi)
#pragma unroll
          for (int ni = 0; ni < 4; ++ni)
            acc[mi][ni] = __builtin_amdgcn_mfma_f32_16x16x32_bf16(af[mi], bfr[ni], acc[mi][ni], 0, 0, 0);
      }
      if (kt + 1 < nk) {
        u16* as2 = As + (buf ^ 1) * (G_BM * G_LD);
        u16* bs2 = Bs + (buf ^ 1) * (G_BN * G_LD);
#pragma unroll
        for (int i = 0; i < 4; ++i) *(u32x4*)(as2 + (lrow + 64 * i) * G_LD + lkc) = ra[i];
#pragma unroll
        for (int i = 0; i < 2; ++i) *(u32x4*)(bs2 + (lrow + 64 * i) * G_LD + lkc) = rb[i];
      }
      __syncthreads();
    }
#pragma unroll
    for (int mi = 0; mi < 4; ++mi)
#pragma unroll
      for (int ni = 0; ni < 4; ++ni) epi(m0 + wr * 64 + mi * 16 + fq * 4, n0 + wc * 64 + ni * 16 + fr, acc[mi][ni]);
  }
}

namespace pg8 {
#define PG8_LAS __attribute__((address_space(3)))
typedef unsigned short bf16_t;
typedef short bf16x8 __attribute__((ext_vector_type(8)));
typedef float f32x4 __attribute__((ext_vector_type(4)));
typedef unsigned u32x4 __attribute__((ext_vector_type(4)));
constexpr int BM = 256, BK = 64, HALF = 128, HTB = HALF * BK * 2  , STAGE_BYTES = 8 * HTB, NXCD = 8, WGM = 8;

__host__ __device__ __forceinline__ int lds_byte(int r, int c) { const int st = (r >> 4) * 2 + (c >> 5), rr = r & 15, cc = c & 31, ob = rr * 64 + cc * 2; return st * 1024 + (ob ^ (((ob >> 9) & 1) << 5)); }
__host__ __device__ __forceinline__ void stage_rc(int b, int& R, int& C) { const int st = b / 1024, sb = b % 1024, swz = sb ^ (((sb >> 9) & 1) << 5); R = (st >> 1) * 16 + swz / 64; C = (st & 1) * 32 + (swz % 64) / 2; }
__host__ __device__ __forceinline__ int perm32(int rho) { const int n = rho >> 4, i = rho & 15; return 8 * (i >> 2) + 4 * n + (i & 3); }

struct Unit { int pm, pn; };
struct Gemm { const bf16_t* A; const bf16_t* Bt; int M, N, K; };

struct StaticOrder {
    int nM, nN, nwg, G, c;
    __host__ __device__ void init(int M, int N, int G_, int c_) { nM = M / BM; nN = N / BM; nwg = nM * nN; G = G_; c = c_; }
    __host__ __device__ bool next(int i, Unit& u) const {
        const long L = (long)i * G + c; if (L >= nwg) return false;
        int wgid = (int)L; { const int q = nwg / NXCD, r = nwg % NXCD, xcd = wgid % NXCD, off = wgid / NXCD; wgid = (xcd < r ? xcd * (q + 1) : r * (q + 1) + (xcd - r) * q) + off; }
        const int nig = WGM * nN, gid = wgid / nig, fm = gid * WGM, gsz = (nM - fm) < WGM ? (nM - fm) : WGM;
        u.pm = fm + ((wgid % nig) % gsz); u.pn = (wgid % nig) / gsz; return true;
    }
    __device__ __forceinline__ void a_ready(const Unit&) const {}
    __device__ __forceinline__ void done(const Unit&) const {}
};
__device__ __forceinline__ unsigned cvt_pk_bf16(float lo, float hi) { return ::pack2(lo, hi); }
typedef float f32x2 __attribute__((ext_vector_type(2)));
template <class Epi, class Sched, bool STAMP = false>
__device__ __forceinline__ void gemm_phase(PG8_LAS unsigned char* lds, const Gemm g, const Sched& S, const Epi& E, unsigned long long* stamps) {
    const int tid = tidx(), wid = __builtin_amdgcn_readfirstlane(tid >> 6), lane = tid & 63, wr = wid >> 2, wc = wid & 3, fr = lane & 15, fq = lane >> 4;
    const int K = g.K, nt = K / BK;
    int ts_lo = 0, ts_hi = 0, nts = 0; const unsigned long long rt_entry = STAMP ? (unsigned long long)wall_clock64() : 0ull;
#define PG8_STAMP() do { if (STAMP && wid == 0 && nts < 64) { const unsigned long long _c = (unsigned long long)clock64(); \
        ts_lo = (lane == nts) ? (int)(unsigned)_c : ts_lo; ts_hi = (lane == nts) ? (int)(unsigned)(_c >> 32) : ts_hi; ++nts; } } while (0)
    PG8_STAMP();
    unsigned voffA[2], voffB[2];
#pragma unroll
    for (int i = 0; i < 2; ++i) { int R, C; stage_rc(tid * 16 + i * 8192, R, C); const int Rb = Epi::PERM ? ((R & ~31) + perm32(R & 31)) : R;
        voffA[i] = (unsigned)(R * K + C) * 2u; voffB[i] = (unsigned)(Rb * K + C) * 2u; }
    const size_t kstep = (size_t)(BK * 2);
    const size_t hstep = (size_t)HALF * K * 2;
    const size_t tstep = 2 * hstep;
    const unsigned ldsw = (unsigned)wid * 1024u;
    const int aoff = lds_byte(wr * 64 + fr, fq * 8), boff = lds_byte(wc * 32 + fr, fq * 8);
#define PG8_SA(b, h) (((b) * 2 + (h)) * HTB)
#define PG8_SB(b, h) ((4 + (b) * 2 + (h)) * HTB)
#define PG8_STAGE(bufoff, gbase, voff) do { _Pragma("unroll") for (int _i = 0; _i < 2; ++_i) \
        __builtin_amdgcn_global_load_lds((const unsigned*)((const char*)(gbase) + (voff)[_i]), (PG8_LAS unsigned*)(lds + (bufoff) + ldsw + _i * 8192), 16, 0, 0); } while (0)
#define PG8_LDA(dst, b, h) do { _Pragma("unroll") for (int m = 0; m < 4; ++m) _Pragma("unroll") for (int k = 0; k < 2; ++k) dst[m][k] = *(const PG8_LAS bf16x8*)(lds + PG8_SA(b, h) + aoff + m * 2048 + k * 1024); } while (0)
#define PG8_LDB(dst, b, h) do { _Pragma("unroll") for (int n = 0; n < 2; ++n) _Pragma("unroll") for (int k = 0; k < 2; ++k) dst[n][k] = *(const PG8_LAS bf16x8*)(lds + PG8_SB(b, h) + boff + n * 2048 + k * 1024); } while (0)
#define PG8_MMA(ai, bj, At, Bt) do { __builtin_amdgcn_s_setprio(1); _Pragma("unroll") for (int m = 0; m < 4; ++m) _Pragma("unroll") for (int n = 0; n < 2; ++n) _Pragma("unroll") for (int k = 0; k < 2; ++k) \
        acc[ai][bj][m][n] = __builtin_amdgcn_mfma_f32_16x16x32_bf16(Bt[n][k], At[m][k], acc[ai][bj][m][n], 0, 0, 0); __builtin_amdgcn_s_setprio(0); } while (0)
#define PG8_WAIT_V(n) asm volatile("s_waitcnt vmcnt(" #n ")" ::: "memory")
#define PG8_WAIT_L(n) asm volatile("s_waitcnt lgkmcnt(" #n ")" ::: "memory")
#define PG8_BAR __builtin_amdgcn_s_barrier()
#define PG8_SCHED __builtin_amdgcn_sched_barrier(0)
    Unit cur, nxt; int ui = 0;
    if (!S.next(0, cur)) return;
    f32x4 acc[2][2][4][2];
#pragma unroll
    for (int a = 0; a < 2; ++a)
#pragma unroll
        for (int b = 0; b < 2; ++b)
#pragma unroll
            for (int m = 0; m < 4; ++m)
#pragma unroll
                for (int n = 0; n < 2; ++n) acc[a][b][m][n] = (f32x4){0.f, 0.f, 0.f, 0.f};
    bf16x8 At[4][2], B0[2][2], B1[2][2];
    const char* cA = (const char*)g.A + (size_t)cur.pm * tstep; const char* cB = (const char*)g.Bt + (size_t)cur.pn * tstep;
    S.a_ready(cur);
    PG8_STAGE(PG8_SB(0, 0), cB, voffB); PG8_STAGE(PG8_SA(0, 0), cA, voffA); PG8_STAGE(PG8_SB(0, 1), cB + hstep, voffB); PG8_STAGE(PG8_SA(0, 1), cA + hstep, voffA);
    if (wr == 1) PG8_BAR;
    PG8_WAIT_V(4); PG8_BAR;
    PG8_STAGE(PG8_SB(1, 0), cB + kstep, voffB); PG8_STAGE(PG8_SA(1, 0), cA + kstep, voffA); PG8_STAGE(PG8_SB(1, 1), cB + hstep + kstep, voffB);
    PG8_WAIT_V(6); PG8_BAR;
    PG8_STAMP();
    for (;;) {
        const bool has_next = S.next(ui + 1, nxt);
        const char* nA = has_next ? (const char*)g.A + (size_t)nxt.pm * tstep : cA; const char* nB = has_next ? (const char*)g.Bt + (size_t)nxt.pn * tstep : cB;
        for (int t = 0; t < nt; t += 2) {
            const bool last = (t == nt - 2);
            const char* a1 = cA + (size_t)(t + 1) * kstep;
            const char* a2 = last ? nA : cA + (size_t)(t + 2) * kstep; const char* b2 = last ? nB : cB + (size_t)(t + 2) * kstep;
            const char* a3 = a2 + kstep; const char* b3 = b2 + kstep;
            if (last && has_next) S.a_ready(nxt);
            PG8_LDB(B0, 0, 0); PG8_SCHED; PG8_LDA(At, 0, 0); PG8_STAGE(PG8_SA(1, 1), a1 + hstep, voffA);
            PG8_WAIT_L(8); PG8_BAR; PG8_WAIT_L(0); PG8_MMA(0, 0, At, B0); PG8_BAR; PG8_SCHED;
            PG8_LDB(B1, 0, 1); PG8_STAGE(PG8_SB(0, 0), b2, voffB);
            PG8_BAR; PG8_WAIT_L(0); PG8_MMA(0, 1, At, B1); PG8_BAR;
            PG8_LDA(At, 0, 1); PG8_STAGE(PG8_SA(0, 0), a2, voffA);
            PG8_BAR; PG8_WAIT_L(0); PG8_MMA(1, 0, At, B0); PG8_BAR; PG8_SCHED;
            PG8_STAGE(PG8_SB(0, 1), b2 + hstep, voffB);
            PG8_WAIT_V(6); PG8_BAR; PG8_MMA(1, 1, At, B1); PG8_BAR;
            PG8_LDB(B0, 1, 0); PG8_SCHED; PG8_LDA(At, 1, 0); PG8_STAGE(PG8_SA(0, 1), a2 + hstep, voffA);
            PG8_WAIT_L(8); PG8_BAR; PG8_WAIT_L(0); PG8_MMA(0, 0, At, B0); PG8_BAR; PG8_SCHED;
            PG8_LDB(B1, 1, 1); PG8_STAGE(PG8_SB(1, 0), b3, voffB);
            PG8_BAR; PG8_WAIT_L(0); PG8_MMA(0, 1, At, B1); PG8_BAR;
            PG8_LDA(At, 1, 1); PG8_STAGE(PG8_SA(1, 0), a3, voffA);
            PG8_BAR; PG8_WAIT_L(0); PG8_MMA(1, 0, At, B0); PG8_BAR; PG8_SCHED;
            PG8_STAGE(PG8_SB(1, 1), b3 + hstep, voffB);
            PG8_WAIT_V(6); PG8_BAR; PG8_MMA(1, 1, At, B1); PG8_BAR;
        }
        PG8_STAMP();
        if constexpr (!Epi::AFTER_DRAIN) { E(acc, cur, wr, wc, fr, fq); S.done(cur); }
        PG8_STAMP();
        if (!has_next) break;
#pragma unroll
        for (int a = 0; a < 2; ++a)
#pragma unroll
            for (int b = 0; b < 2; ++b)
#pragma unroll
                for (int m = 0; m < 4; ++m)
#pragma unroll
                    for (int n = 0; n < 2; ++n) acc[a][b][m][n] = (f32x4){0.f, 0.f, 0.f, 0.f};
        cur = nxt; cA = nA; cB = nB; ++ui;
    }
    PG8_WAIT_V(0);
    if (wr == 0) PG8_BAR;
    PG8_BAR;
    if constexpr (Epi::AFTER_DRAIN) { E.fused(acc, cur, wr, wc, fr, fq, lds, wid, lane); S.done(cur); }
    PG8_STAMP();
    if (STAMP && wid == 0) { stamps[lane] = lane < nts ? (((unsigned long long)(unsigned)ts_hi << 32) | (unsigned)ts_lo) : 0ull;
        if (lane == 62) stamps[62] = rt_entry; if (lane == 63) stamps[63] = (unsigned long long)wall_clock64(); }
#undef PG8_STAMP
#undef PG8_SA
#undef PG8_SB
#undef PG8_STAGE
#undef PG8_LDA
#undef PG8_LDB
#undef PG8_MMA
#undef PG8_WAIT_V
#undef PG8_WAIT_L
#undef PG8_BAR
#undef PG8_SCHED
}
}

namespace pg8 {
struct EpiProjT {
  static constexpr bool PERM = true, AFTER_DRAIN = false;
  bf16_t* O; int ldc; int ncols;
  __device__ __forceinline__ void operator()(const f32x4 (&acc)[2][2][4][2], const Unit& u, int wr, int wc, int fr, int fq) const {
    const int row0 = u.pm * BM + wr * 64 + fr, col0 = u.pn * BM + wc * 32 + 8 * fq;
#pragma unroll
    for (int ai = 0; ai < 2; ++ai)
#pragma unroll
      for (int m = 0; m < 4; ++m) {
        bf16_t* rowp = O + (size_t)(row0 + ai * HALF + m * 16) * ldc + col0;
#pragma unroll
        for (int bj = 0; bj < 2; ++bj) {
          if (col0 + bj * HALF < ncols) {
            const f32x4 v0 = acc[ai][bj][m][0], v1 = acc[ai][bj][m][1];
            u32x4 w; w.x = cvt_pk_bf16(v0[0], v0[1]); w.y = cvt_pk_bf16(v0[2], v0[3]); w.z = cvt_pk_bf16(v1[0], v1[1]); w.w = cvt_pk_bf16(v1[2], v1[3]);
            *(u32x4*)(rowp + bj * HALF) = w;
          }
        }
      }
  }
};
struct EpiGluT {
  static constexpr bool PERM = true, AFTER_DRAIN = false;
  const bf16_t* Y1; const float* bglu; bf16_t* O;
  __device__ __forceinline__ void operator()(const f32x4 (&acc)[2][2][4][2], const Unit& u, int wr, int wc, int fr, int fq) const {
    const int row0 = u.pm * BM + wr * 64 + fr, col0 = u.pn * BM + wc * 32 + 8 * fq;
    f32x4 bv[2][2];
#pragma unroll
    for (int bj = 0; bj < 2; ++bj)
#pragma unroll
      for (int n = 0; n < 2; ++n) bv[bj][n] = *(const f32x4*)(bglu + col0 + bj * HALF + 4 * n);
#pragma unroll
    for (int ai = 0; ai < 2; ++ai)
#pragma unroll
      for (int m = 0; m < 4; ++m) {
        const size_t r = (size_t)(row0 + ai * HALF + m * 16);
#pragma unroll
        for (int bj = 0; bj < 2; ++bj) {
          const u32x4 yv = *(const u32x4*)(Y1 + r * 512 + col0 + bj * HALF);
          const f32x4 v0 = acc[ai][bj][m][0] + bv[bj][0], v1 = acc[ai][bj][m][1] + bv[bj][1];
          float o[8];
#pragma unroll
          for (int q = 0; q < 4; ++q) {
            const float ylo = __uint_as_float(yv[q] << 16), yhi = __uint_as_float(yv[q] & 0xffff0000u);
            const float a0 = q < 2 ? v0[2 * q] : v1[2 * q - 4], a1 = q < 2 ? v0[2 * q + 1] : v1[2 * q - 3];
            o[2 * q] = ylo / (1.f + __expf(-a0));
            o[2 * q + 1] = yhi / (1.f + __expf(-a1));
          }
          u32x4 w; w.x = cvt_pk_bf16(o[0], o[1]); w.y = cvt_pk_bf16(o[2], o[3]); w.z = cvt_pk_bf16(o[4], o[5]); w.w = cvt_pk_bf16(o[6], o[7]);
          *(u32x4*)(O + r * 1024 + col0 + bj * HALF) = w;
        }
      }
  }
};
struct EpiGateT {
  static constexpr bool PERM = true, AFTER_DRAIN = false;
  const bf16_t* T1; bf16_t* O;
  __device__ __forceinline__ void operator()(const f32x4 (&acc)[2][2][4][2], const Unit& u, int wr, int wc, int fr, int fq) const {
    const int row0 = u.pm * BM + wr * 64 + fr, col0 = u.pn * BM + wc * 32 + 8 * fq;
#pragma unroll
    for (int ai = 0; ai < 2; ++ai)
#pragma unroll
      for (int m = 0; m < 4; ++m) {
        const size_t r = (size_t)(row0 + ai * HALF + m * 16);
#pragma unroll
        for (int bj = 0; bj < 2; ++bj) {
          const u32x4 tv = *(const u32x4*)(T1 + r * 512 + col0 + bj * HALF);
          const f32x4 v0 = acc[ai][bj][m][0], v1 = acc[ai][bj][m][1];
          u32x4 w;
          w.x = cvt_pk_bf16(__uint_as_float(tv[0] << 16) * v0[0], __uint_as_float(tv[0] & 0xffff0000u) * v0[1]);
          w.y = cvt_pk_bf16(__uint_as_float(tv[1] << 16) * v0[2], __uint_as_float(tv[1] & 0xffff0000u) * v0[3]);
          w.z = cvt_pk_bf16(__uint_as_float(tv[2] << 16) * v1[0], __uint_as_float(tv[2] & 0xffff0000u) * v1[1]);
          w.w = cvt_pk_bf16(__uint_as_float(tv[3] << 16) * v1[2], __uint_as_float(tv[3] & 0xffff0000u) * v1[3]);
          *(u32x4*)(O + r * 1024 + 512 + col0 + bj * HALF) = w;
        }
      }
  }
};
struct EpiWoutT {
  static constexpr bool PERM = false, AFTER_DRAIN = false;
  const float* X; const float* mod; bf16_t* H2;
  __device__ __forceinline__ void operator()(const f32x4 (&acc)[2][2][4][2], const Unit& u, int wr, int wc, int fr, int fq) const {
    const int row0 = u.pm * BM + wr * 64 + fr, col0 = u.pn * BM + wc * 32 + 4 * fq;
    const float* g1p = mod + ((u.pm * BM) >> 11) * 6144 + 2 * 1024 + col0;
    f32x4 gv[2][2];
#pragma unroll
    for (int bj = 0; bj < 2; ++bj)
#pragma unroll
      for (int n = 0; n < 2; ++n) gv[bj][n] = *(const f32x4*)(g1p + bj * HALF + n * 16);
#pragma unroll
    for (int ai = 0; ai < 2; ++ai)
#pragma unroll
      for (int m = 0; m < 4; ++m) {
        const size_t off = (size_t)(row0 + ai * HALF + m * 16) * 1024 + col0;
        bf16_t* hrow = H2 + (size_t)(row0 + ai * HALF + m * 16) * 2048 + 1024 + col0;
#pragma unroll
        for (int bj = 0; bj < 2; ++bj)
#pragma unroll
          for (int n = 0; n < 2; ++n) {
            const f32x4 xv = *(const f32x4*)(X + off + bj * HALF + n * 16);
            const f32x4 hv = xv + gv[bj][n] * acc[ai][bj][m][n];
            *(uint2*)(hrow + bj * HALF + n * 16) = make_uint2(cvt_pk_bf16(hv[0], hv[1]), cvt_pk_bf16(hv[2], hv[3]));
          }
      }
  }
};
}

struct EpiProj {
  u16* proj;
  __device__ __forceinline__ void operator()(int r, int c, f32x4 v) const {
    if (c < INC) {
#pragma unroll
      for (int j = 0; j < 4; ++j) proj[(size_t)(r + j) * INC + c] = f2bf(v[j]);
    }
  }
};
struct EpiGlu {
  const u16* y1; const float* bglu; u16* a2;
  __device__ __forceinline__ void operator()(int r, int c, f32x4 v) const {
    float bb = bglu[c];
#pragma unroll
    for (int j = 0; j < 4; ++j) {
      float y = bf2f(y1[(size_t)(r + j) * 512 + c]);
      a2[(size_t)(r + j) * 1024 + c] = f2bf(y * sigmoidf(v[j] + bb));
    }
  }
};
struct EpiGate {
  const u16* t1; u16* a2;
  __device__ __forceinline__ void operator()(int r, int c, f32x4 v) const {
#pragma unroll
    for (int j = 0; j < 4; ++j) {
      float t = bf2f(t1[(size_t)(r + j) * 512 + c]);
      a2[(size_t)(r + j) * 1024 + 512 + c] = f2bf(t * v[j]);
    }
  }
};
struct EpiWout {
  const float* x; const float* mod; float* h2;
  __device__ __forceinline__ void operator()(int r, int c, f32x4 v) const {
    float g1 = mod[(r >> 11) * 6144 + 2 * 1024 + c];
#pragma unroll
    for (int j = 0; j < 4; ++j) h2[(size_t)(r + j) * 1024 + c] = x[(size_t)(r + j) * 1024 + c] + g1 * v[j];
  }
};
struct EpiQ {
  u16* q;
  __device__ __forceinline__ void operator()(int r, int c, f32x4 v) const {
#pragma unroll
    for (int j = 0; j < 4; ++j) q[(size_t)(r + j) * 2048 + c] = f2bf(v[j]);
  }
};

__device__ __forceinline__ void ph_s5scan(const P& p, char* smem, int bid, int nb) {
  const int wid = tidx() >> 6, lane = tidx() & 63;
  float* U = (float*)(smem + wid * 8448);
  unsigned* H = (unsigned*)((char*)U + 4096);
  const int fr = lane & 15, fq = lane >> 4;
  for (int s = bid * 8 + wid; s < 2048; s += nb * 8) {
    const int g = s & 31, d = (s >> 5) & 1, b = s >> 6;
    const int ci = (d * 32 + g) * 64 + lane;
    const float abr = p.s5ab()[ci * 2], abi = p.s5ab()[ci * 2 + 1];
    float bbr[16], bbi[16];
#pragma unroll
    for (int q = 0; q < 4; ++q) {
      float4 t = *(const float4*)(p.s5bb() + (size_t)ci * 32 + q * 4);
      bbr[q * 4] = t.x; bbr[q * 4 + 1] = t.y; bbr[q * 4 + 2] = t.z; bbr[q * 4 + 3] = t.w;
      float4 t2 = *(const float4*)(p.s5bb() + (size_t)ci * 32 + 16 + q * 4);
      bbi[q * 4] = t2.x; bbi[q * 4 + 1] = t2.y; bbi[q * 4 + 2] = t2.z; bbi[q * 4 + 3] = t2.w;
    }
    bf16x8 cf[4];
#pragma unroll
    for (int kb = 0; kb < 4; ++kb)
      cf[kb] = *(const bf16x8*)(p.s5ct() + ((size_t)(d * 32 + g) * 16 + fr) * 128 + kb * 32 + fq * 8);
    const float dcoef = p.s5_d[g * 16 + fr];
    u16* ydst = d ? p.ys5b() : p.ys5f();
    float hr = 0.f, hi = 0.f;
    for (int seg = 0; seg < 2; ++seg) {
      const int L = seg ? 2048 : 256;
      const int rowbase = seg ? b * 2048 : NLAT + b * 256;
      for (int c0 = 0; c0 < L; c0 += 64) {
        {
          int pos = c0 + lane;
          int t = d ? (L - 1 - pos) : pos;
          const u16* src = p.proj() + (size_t)(rowbase + t) * INC + g * 16;
          uint4 v0 = *(const uint4*)src, v1 = *(const uint4*)(src + 8);
          float4* ud = (float4*)(U + lane * 16);
          ud[0] = make_float4(bflo(v0.x), bfhi(v0.x), bflo(v0.y), bfhi(v0.y));
          ud[1] = make_float4(bflo(v0.z), bfhi(v0.z), bflo(v0.w), bfhi(v0.w));
          ud[2] = make_float4(bflo(v1.x), bfhi(v1.x), bflo(v1.y), bfhi(v1.y));
          ud[3] = make_float4(bflo(v1.z), bfhi(v1.z), bflo(v1.w), bfhi(v1.w));
        }
        for (int sub = 0; sub < 4; ++sub) {
#pragma unroll 4
          for (int i = 0; i < 16; ++i) {
            const float4* up = (const float4*)(U + (sub * 16 + i) * 16);
            float4 u0 = up[0], u1 = up[1], u2 = up[2], u3 = up[3];
            float ur[16] = {u0.x, u0.y, u0.z, u0.w, u1.x, u1.y, u1.z, u1.w, u2.x, u2.y, u2.z, u2.w, u3.x, u3.y, u3.z, u3.w};
            float br0 = 0.f, br1 = 0.f, bi0 = 0.f, bi1 = 0.f;
#pragma unroll
            for (int h = 0; h < 16; h += 2) {
              br0 += bbr[h] * ur[h]; br1 += bbr[h + 1] * ur[h + 1];
              bi0 += bbi[h] * ur[h]; bi1 += bbi[h + 1] * ur[h + 1];
            }
            float nr = abr * hr - abi * hi + (br0 + br1);
            float ni = abr * hi + abi * hr + (bi0 + bi1);
            hr = nr; hi = ni;
            if (seg) H[i * 68 + lane] = pack2(hr, hi);
          }
          if (seg) {
            f32x4 acc = (f32x4){0.f, 0.f, 0.f, 0.f};
#pragma unroll
            for (int kb = 0; kb < 4; ++kb) {
              bf16x8 a = *(const bf16x8*)((const u16*)H + fr * 136 + kb * 32 + fq * 8);
              acc = __builtin_amdgcn_mfma_f32_16x16x32_bf16(a, cf[kb], acc, 0, 0, 0);
            }
#pragma unroll
            for (int j = 0; j < 4; ++j) {
              int pi = sub * 16 + fq * 4 + j;
              int pos = c0 + pi;
              int t = d ? (L - 1 - pos) : pos;
              float y = acc[j];
              if (d == 0) y += dcoef * U[pi * 16 + fr];
              ydst[(size_t)(b * 2048 + t) * 512 + g * 16 + fr] = f2bf(y);
            }
          }
        }
      }
    }
  }
}

#define S5_LD 168
__device__ __forceinline__ void ph_s5scan2(const P& p, char* smem, int bid, int nb) {
  const int wid = tidx() >> 6, lane = tidx() & 63;
  u16* H = (u16*)(smem + wid * (32 * S5_LD * 2));
  const int n = lane & 31, hh = lane >> 5, fr = lane & 15, fq = lane >> 4;
  for (int r = lane; r < 32; r += 64) {
    *(uint4*)(H + r * S5_LD + 144) = make_uint4(0u, 0u, 0u, 0u);
    *(uint4*)(H + r * S5_LD + 152) = make_uint4(0u, 0u, 0u, 0u);
    *(uint4*)(H + r * S5_LD + 160) = make_uint4(0u, 0u, 0u, 0u);
  }
  for (int s = bid * 8 + wid; s < 2048; s += nb * 8) {
    const int g = s & 31, d = (s >> 5) & 1, b = s >> 6;
    float ar[2][4], ai[2][4], a8r[2], a8i[2];
#pragma unroll
    for (int st = 0; st < 2; ++st) {
      const int ci = (d * 32 + g) * 64 + st * 32 + n;
      const float xr = p.s5ab()[ci * 2], xi = p.s5ab()[ci * 2 + 1];
      ar[st][0] = xr; ai[st][0] = xi;
#pragma unroll
      for (int k = 1; k < 4; ++k) {
        ar[st][k] = ar[st][k - 1] * xr - ai[st][k - 1] * xi;
        ai[st][k] = ar[st][k - 1] * xi + ai[st][k - 1] * xr;
      }
      a8r[st] = ar[st][3] * ar[st][3] - ai[st][3] * ai[st][3];
      a8i[st] = 2.f * ar[st][3] * ai[st][3];
    }
    bf16x8 bfr[4];
#pragma unroll
    for (int nt = 0; nt < 4; ++nt) {
      const int ci = (d * 32 + g) * 64 + (nt & 1) * 32 + n;
      const float4 t0 = *(const float4*)(p.s5bb() + (size_t)ci * 32 + (nt >> 1) * 16 + 8 * hh);
      const float4 t1 = *(const float4*)(p.s5bb() + (size_t)ci * 32 + (nt >> 1) * 16 + 8 * hh + 4);
      union { unsigned u[4]; bf16x8 v; } t;
      t.u[0] = pack2(t0.x, t0.y); t.u[1] = pack2(t0.z, t0.w); t.u[2] = pack2(t1.x, t1.y); t.u[3] = pack2(t1.z, t1.w);
      bfr[nt] = t.v;
    }
    bf16x8 cf[5];
#pragma unroll
    for (int kb = 0; kb < 4; ++kb)
      cf[kb] = *(const bf16x8*)(p.s5ct() + ((size_t)(d * 32 + g) * 16 + fr) * 128 + kb * 32 + fq * 8);
    {
      const float dv = (d == 0) ? p.s5_d[g * 16 + fr] : 0.f;
      union { u16 h[8]; bf16x8 v; } t;
#pragma unroll
      for (int j = 0; j < 8; ++j) t.h[j] = (8 * fq + j == fr) ? f2bf(dv) : (u16)0;
      cf[4] = t.v;
    }
    u16* ydst = d ? p.ys5b() : p.ys5f();
    float hcr[2] = {0.f, 0.f}, hci[2] = {0.f, 0.f};
    for (int seg = 0; seg < 2; ++seg) {
      const int L = seg ? 2048 : 256;
      const int rowbase = seg ? b * 2048 : NLAT + b * 256;
      uint4 anext;
      {
        const int pos = n;
        const int t = d ? (L - 1 - pos) : pos;
        anext = *(const uint4*)(p.proj() + (size_t)(rowbase + t) * INC + g * 16 + 8 * hh);
      }
      for (int c0 = 0; c0 < L; c0 += 32) {
        const uint4 acur = anext;
        if (c0 + 32 < L) {
          const int pos = c0 + 32 + n;
          const int t = d ? (L - 1 - pos) : pos;
          anext = *(const uint4*)(p.proj() + (size_t)(rowbase + t) * INC + g * 16 + 8 * hh);
        }
        union { uint4 q; bf16x8 v; } af;
        af.q = acur;
        f32x16 acc[4];
#pragma unroll
        for (int nt = 0; nt < 4; ++nt) {
          f32x16 z;
#pragma unroll
          for (int r = 0; r < 16; ++r) z[r] = 0.f;
          acc[nt] = __builtin_amdgcn_mfma_f32_32x32x16_bf16(af.v, bfr[nt], z, 0, 0, 0);
        }
#pragma unroll
        for (int st = 0; st < 2; ++st)
#pragma unroll
          for (int gg = 0; gg < 4; ++gg)
#pragma unroll
            for (int j = 1; j < 4; ++j) {
              const float pr = acc[st][4 * gg + j - 1], pi = acc[2 + st][4 * gg + j - 1];
              acc[st][4 * gg + j] += ar[st][0] * pr - ai[st][0] * pi;
              acc[2 + st][4 * gg + j] += ar[st][0] * pi + ai[st][0] * pr;
            }
        float sr[2][4], si[2][4];
        {
          float e0r[2][4], e0i[2][4], qpr[2][4], qpi[2][4], s1r[2][4], s1i[2][4];
#pragma unroll
          for (int st = 0; st < 2; ++st)
#pragma unroll
            for (int gg = 0; gg < 4; ++gg) {
              e0r[st][gg] = __shfl_xor(acc[st][4 * gg + 3], 32, 64);
              e0i[st][gg] = __shfl_xor(acc[2 + st][4 * gg + 3], 32, 64);
            }
#pragma unroll
          for (int st = 0; st < 2; ++st) {
            float qr = hcr[st], qi = hci[st];
#pragma unroll
            for (int gg = 0; gg < 4; ++gg) {
              const float er = acc[st][4 * gg + 3], ei = acc[2 + st][4 * gg + 3];
              qpr[st][gg] = qr; qpi[st][gg] = qi;
              s1r[st][gg] = ar[st][3] * qr - ai[st][3] * qi + e0r[st][gg];
              s1i[st][gg] = ar[st][3] * qi + ai[st][3] * qr + e0i[st][gg];
              const float nqr = ar[st][3] * s1r[st][gg] - ai[st][3] * s1i[st][gg] + er;
              const float nqi = ar[st][3] * s1i[st][gg] + ai[st][3] * s1r[st][gg] + ei;
              qr = nqr; qi = nqi;
            }
            hcr[st] = qr; hci[st] = qi;
          }
#pragma unroll
          for (int st = 0; st < 2; ++st)
#pragma unroll
            for (int gg = 0; gg < 4; ++gg) {
              const float s0r = __shfl_xor(qpr[st][gg], 32, 64), s0i = __shfl_xor(qpi[st][gg], 32, 64);
              sr[st][gg] = hh ? s1r[st][gg] : s0r;
              si[st][gg] = hh ? s1i[st][gg] : s0i;
            }
        }
        if (seg) {
#pragma unroll
          for (int st = 0; st < 2; ++st)
#pragma unroll
            for (int gg = 0; gg < 4; ++gg)
#pragma unroll
              for (int j = 0; j < 4; ++j) {
                const float hr_ = acc[st][4 * gg + j] + ar[st][j] * sr[st][gg] - ai[st][j] * si[st][gg];
                const float hi_ = acc[2 + st][4 * gg + j] + ar[st][j] * si[st][gg] + ai[st][j] * sr[st][gg];
                const int tok = 8 * gg + 4 * hh + j;
                *(unsigned*)(H + tok * S5_LD + 2 * (st * 32 + n)) = pack2(hr_, hi_);
              }
          *(uint4*)(H + n * S5_LD + 128 + 8 * hh) = acur;
#pragma unroll
          for (int mt = 0; mt < 2; ++mt) {
            f32x4 y = (f32x4){0.f, 0.f, 0.f, 0.f};
#pragma unroll
            for (int kb = 0; kb < 5; ++kb) {
              const bf16x8 a = *(const bf16x8*)(H + (16 * mt + fr) * S5_LD + kb * 32 + fq * 8);
              y = __builtin_amdgcn_mfma_f32_16x16x32_bf16(a, cf[kb], y, 0, 0, 0);
            }
#pragma unroll
            for (int j = 0; j < 4; ++j) {
              const int pos = c0 + 16 * mt + 4 * fq + j;
              const int t = d ? (L - 1 - pos) : pos;
              ydst[(size_t)(b * 2048 + t) * 512 + g * 16 + fr] = f2bf(y[j]);
            }
          }
        }
      }
    }
  }
}

__device__ __forceinline__ float4 mix_load4(const u16* __restrict__ proj, size_t row, int col, const size_t* nrow,
                                            const bool* nval, float4 mu) {
  uint2 cz = *(const uint2*)(proj + row * INC + col);
  float z[4] = {bflo(cz.x), bfhi(cz.x), bflo(cz.y), bfhi(cz.y)};
  float o[4];
  float m[4] = {mu.x, mu.y, mu.z, mu.w};
#pragma unroll
  for (int j = 0; j < 4; ++j) {
    float nbv = 0.f;
    if (nval[j]) {
      u16 t = proj[nrow[j] * INC + col + j];
      nbv = bf2f(t);
    }
    o[j] = z[j] + (nbv - z[j]) * m[j];
  }
  return make_float4(o[0], o[1], o[2], o[3]);
}
__device__ __forceinline__ void neighbours(bool isctx, size_t row, int t, size_t* nrow, bool* nval) {
  if (isctx) {
    nrow[0] = row - 1; nval[0] = t > 0;
    nrow[1] = row + 1; nval[1] = t < 255;
    nrow[2] = row - 1; nval[2] = t > 0;
    nrow[3] = row + 1; nval[3] = t < 255;
  } else {
    int col = t & 63, gr = t >> 6;
    nrow[0] = row - 1; nval[0] = col > 0;
    nrow[1] = row + 1; nval[1] = col < 63;
    nrow[2] = row - 64; nval[2] = gr > 0;
    nrow[3] = row + 64; nval[3] = gr < 31;
  }
}

__device__ __forceinline__ void ph_rwscan(const P& p, char* smem, int bid, int nb) {
  const int tid = tidx(), sl = tid >> 8, stid = tid & 255, wv = stid >> 6, lane = tid & 63;
  char* sb = smem + sl * 49152;
  float* OPS = (float*)sb;
  float* LW = (float*)(sb + 24576);
  float* LA = LW + 512;
  float* WW = (float*)(sb + 28672);
  float* WA = WW + 2048;
  float* YB = (float*)(sb + 45056);
  const int tt = stid >> 4, part = stid & 15;
  const int vrow = wv * 16 + (lane >> 2), kq = lane & 3;
  for (int sp = bid; sp < 256; sp += nb) {
    const int s = sp * 2 + sl;
    const int d = s & 1, h = (s >> 1) & 7, b = s >> 4;
    __syncthreads();
    for (int e = stid; e < 2048; e += 256) {
      int j = e >> 6, cc = e & 63;
      WW[e] = p.rw_w_w2[(size_t)(d * 32 + j) * 512 + h * 64 + cc];
      WA[e] = p.rw_w_a2[(size_t)(d * 32 + j) * 512 + h * 64 + cc];
    }
    const int hc = h * 64 + part * 4;
    const float4 w0v = *(const float4*)(p.rw_w0 + d * 512 + hc);
    const float4 a0v = *(const float4*)(p.rw_a0 + d * 512 + hc);
    const float4 kkv = *(const float4*)(p.rw_k_k + hc);
    const float4 kav = *(const float4*)(p.rw_k_a + hc);
    const float4 rkv = *(const float4*)(p.rw_r_k + hc);
    const float4 mur = *(const float4*)(p.rw_mu + hc);
    const float4 muk = *(const float4*)(p.rw_mu + 512 + hc);
    const float4 muv = *(const float4*)(p.rw_mu + 1024 + hc);
    const float4 mul = *(const float4*)(p.rw_mu + 1536 + part * 4);
    u16* ydst = d ? p.yrwb() : p.yrwf();
    float S[16];
#pragma unroll
    for (int i = 0; i < 16; ++i) S[i] = 0.f;
    for (int seg = 0; seg < 2; ++seg) {
      const int L = seg ? 2048 : 256;
      const size_t rowbase = seg ? (size_t)b * 2048 : (size_t)NLAT + b * 256;
      for (int c0 = 0; c0 < L; c0 += 16) {
        const int pos = c0 + tt;
        const int t = d ? (L - 1 - pos) : pos;
        const size_t row = rowbase + t;
        size_t nrow[4];
        bool nval[4];
        neighbours(seg == 0, row, t, nrow, nval);
        float4 r4 = mix_load4(p.proj(), row, 512 + hc, nrow, nval, mur);
        float4 k4 = mix_load4(p.proj(), row, 512 + 512 + hc, nrow, nval, muk);
        float4 v4 = mix_load4(p.proj(), row, 512 + 1024 + hc, nrow, nval, muv);
        float4 l4 = mix_load4(p.proj(), row, 512 + 1536 + part * 4, nrow, nval, mul);
        if (part < 8) {
          *(float4*)(LW + tt * 32 + part * 4) = make_float4(tanhf(l4.x), tanhf(l4.y), tanhf(l4.z), tanhf(l4.w));
        } else {
          *(float4*)(LA + tt * 32 + (part - 8) * 4) = l4;
        }
        __syncthreads();
        float wp[4] = {w0v.x, w0v.y, w0v.z, w0v.w};
        float ap[4] = {a0v.x, a0v.y, a0v.z, a0v.w};
#pragma unroll 8
        for (int j = 0; j < 32; ++j) {
          float lw = LW[tt * 32 + j], la = LA[tt * 32 + j];
          float4 ww = *(const float4*)(WW + j * 64 + part * 4);
          float4 wa = *(const float4*)(WA + j * 64 + part * 4);
          wp[0] += lw * ww.x; wp[1] += lw * ww.y; wp[2] += lw * ww.z; wp[3] += lw * ww.w;
          ap[0] += la * wa.x; ap[1] += la * wa.y; ap[2] += la * wa.z; ap[3] += la * wa.w;
        }
        float rr[4] = {r4.x, r4.y, r4.z, r4.w}, kk4[4] = {k4.x, k4.y, k4.z, k4.w};
        float kkc[4] = {kkv.x, kkv.y, kkv.z, kkv.w}, kac[4] = {kav.x, kav.y, kav.z, kav.w}, rkc[4] = {rkv.x, rkv.y, rkv.z, rkv.w};
        float dec[4], aa[4], kd[4], kkr[4];
        float ss = 0.f, bon = 0.f;
#pragma unroll
        for (int i = 0; i < 4; ++i) {
          float xw = -wp[i];
          float sp_ = fmaxf(xw, 0.f) + log1pf(expf(-fabsf(xw)));
          float wl = -sp_ - 0.5f;
          dec[i] = expf(-expf(wl));
          aa[i] = 1.f / (1.f + expf(-ap[i]));
          kd[i] = kk4[i] * (1.f + (aa[i] - 1.f) * kac[i]);
          kkr[i] = kk4[i] * kkc[i];
          ss += kkr[i] * kkr[i];
          bon += rr[i] * kd[i] * rkc[i];
        }
#pragma unroll
        for (int m = 0; m < 4; ++m) {
          ss = dpp_add(ss, m, 0);
          bon = dpp_add(bon, m, 0);
        }
        float inv = rsqrtf(ss + 1e-12f);
        float* o = OPS + tt * 384 + part * 4;
        *(float4*)(o + 0) = r4;
        *(float4*)(o + 64) = make_float4(dec[0], dec[1], dec[2], dec[3]);
        *(float4*)(o + 128) = make_float4(kd[0], kd[1], kd[2], kd[3]);
        *(float4*)(o + 192) = make_float4(-kkr[0] * inv, -kkr[1] * inv, -kkr[2] * inv, -kkr[3] * inv);
        *(float4*)(o + 256) = make_float4(kkr[0] * inv * aa[0], kkr[1] * inv * aa[1], kkr[2] * inv * aa[2], kkr[3] * inv * aa[3]);
        *(float4*)(o + 320) = v4;
        if (seg && part == 0) p.bsc()[((size_t)d * NLAT + row) * 8 + h] = bon;
        __syncthreads();
        for (int i = 0; i < 16; ++i) {
          const float* oo = OPS + i * 384 + kq * 16;
          float kn[16], wv_[16], bv[16], kdv[16];
#pragma unroll
          for (int q = 0; q < 4; ++q) {
            float4 a = *(const float4*)(oo + 192 + q * 4);
            kn[q * 4] = a.x; kn[q * 4 + 1] = a.y; kn[q * 4 + 2] = a.z; kn[q * 4 + 3] = a.w;
            float4 w_ = *(const float4*)(oo + 64 + q * 4);
            wv_[q * 4] = w_.x; wv_[q * 4 + 1] = w_.y; wv_[q * 4 + 2] = w_.z; wv_[q * 4 + 3] = w_.w;
            float4 b_ = *(const float4*)(oo + 256 + q * 4);
            bv[q * 4] = b_.x; bv[q * 4 + 1] = b_.y; bv[q * 4 + 2] = b_.z; bv[q * 4 + 3] = b_.w;
            float4 k_ = *(const float4*)(oo + 128 + q * 4);
            kdv[q * 4] = k_.x; kdv[q * 4 + 1] = k_.y; kdv[q * 4 + 2] = k_.z; kdv[q * 4 + 3] = k_.w;
          }
          float vv = OPS[i * 384 + 320 + vrow];
          float s0 = 0.f, s1 = 0.f, s2 = 0.f, s3 = 0.f;
#pragma unroll
          for (int q = 0; q < 16; q += 4) {
            s0 += S[q] * kn[q]; s1 += S[q + 1] * kn[q + 1]; s2 += S[q + 2] * kn[q + 2]; s3 += S[q + 3] * kn[q + 3];
          }
          float sa = (s0 + s1) + (s2 + s3);
          sa = dpp_add(sa, 0, 0);
          sa = dpp_add(sa, 1, 0);
#pragma unroll
          for (int q = 0; q < 16; ++q) S[q] = S[q] * wv_[q] + sa * bv[q] + vv * kdv[q];
          if (seg) {
            float rv[16];
#pragma unroll
            for (int q = 0; q < 4; ++q) {
              float4 a = *(const float4*)(oo + q * 4);
              rv[q * 4] = a.x; rv[q * 4 + 1] = a.y; rv[q * 4 + 2] = a.z; rv[q * 4 + 3] = a.w;
            }
            float y0 = 0.f, y1 = 0.f, y2 = 0.f, y3 = 0.f;
#pragma unroll
            for (int q = 0; q < 16; q += 4) {
              y0 += S[q] * rv[q]; y1 += S[q + 1] * rv[q + 1]; y2 += S[q + 2] * rv[q + 2]; y3 += S[q + 3] * rv[q + 3];
            }
            float y = (y0 + y1) + (y2 + y3);
            y = dpp_add(y, 0, 0);
            y = dpp_add(y, 1, 0);
            if (kq == 0) YB[i * 64 + vrow] = y;
          }
        }
        __syncthreads();
        if (seg) {
          float4 yv = *(const float4*)(YB + tt * 64 + part * 4);
          uint2 o2;
          o2.x = pack2(yv.x, yv.y); o2.y = pack2(yv.z, yv.w);
          *(uint2*)(ydst + row * 512 + hc) = o2;
        }
      }
    }
  }
}

#define LAS __attribute__((address_space(3)))
#define RW_AR_LD 68
#define RW_RM_LD 72
#define RW_SLOT_BYTES 13824
#define RW_SCR_BYTES 6912
#define RW_STREAM_BYTES (4 * RW_SLOT_BYTES + 3 * RW_SCR_BYTES + 2304 + 64)
__device__ __forceinline__ unsigned cvtpk(float lo, float hi) { return pack2(lo, hi); }
__device__ __forceinline__ float dpp_shr_add(float v, const int n) {
  int m;
  switch (n) {
    case 1: m = __builtin_amdgcn_update_dpp(0, __float_as_int(v), 0x111, 0xf, 0xf, true); break;
    case 2: m = __builtin_amdgcn_update_dpp(0, __float_as_int(v), 0x112, 0xf, 0xf, true); break;
    case 4: m = __builtin_amdgcn_update_dpp(0, __float_as_int(v), 0x114, 0xf, 0xf, true); break;
    default: m = __builtin_amdgcn_update_dpp(0, __float_as_int(v), 0x118, 0xf, 0xf, true); break;
  }
  return v + __int_as_float(m);
}
__device__ __forceinline__ unsigned dpp_row_shr1(unsigned old, unsigned v) { return (unsigned)__builtin_amdgcn_update_dpp((int)old, (int)v, 0x111, 0xf, 0xf, false); }
__device__ __forceinline__ unsigned dpp_row_shl1(unsigned old, unsigned v) { return (unsigned)__builtin_amdgcn_update_dpp((int)old, (int)v, 0x101, 0xf, 0xf, false); }
__device__ __forceinline__ void shift_src(unsigned c01, unsigned be01, unsigned up23, unsigned dn23, unsigned m01, unsigned& n01, unsigned& n23) {
  const unsigned S = dpp_row_shr1(be01, c01), H = dpp_row_shl1(be01, c01);
  n01 = (S & m01) | (H & ~m01);
  n23 = (up23 & 0xffffu) | (dn23 & 0xffff0000u);
}
__device__ __forceinline__ int opaque(int x) { asm volatile("" : "+v"(x)); return x; }
__device__ __forceinline__ float fsig(float x) { return __builtin_amdgcn_rcpf(1.f + __expf(-x)); }

__device__ __forceinline__ void ph_rwscan2(const P& p, char* smem, int bid, int nb) {
  const int wid = widx(), lane = lidx(), sl = wid >> 2, wv = wid & 3;
  char* sb = smem + sl * RW_STREAM_BYTES;
  float* CST = (float*)(sb + 4 * RW_SLOT_BYTES + 3 * RW_SCR_BYTES);
  volatile LAS int* FL = (volatile LAS int*)(sb + 4 * RW_SLOT_BYTES + 3 * RW_SCR_BYTES + 2304);
  const int scanw = sl;
  const int NCH = 144;
  for (int sp = bid; sp < 256; sp += nb) {
    const int s = sp * 2 + sl;
    const int d = s & 1, h = (s >> 1) & 7, b = s >> 4;
    __syncthreads();
    if (wv == 0) {
      const int cc = lane;
      CST[0 * 64 + cc] = p.rw_w0[d * 512 + h * 64 + cc];
      CST[1 * 64 + cc] = p.rw_a0[d * 512 + h * 64 + cc];
      CST[2 * 64 + cc] = p.rw_k_k[h * 64 + cc];
      CST[3 * 64 + cc] = p.rw_k_a[h * 64 + cc];
      CST[4 * 64 + cc] = p.rw_r_k[h * 64 + cc];
      CST[5 * 64 + cc] = p.rw_mu[h * 64 + cc];
      CST[6 * 64 + cc] = p.rw_mu[512 + h * 64 + cc];
      CST[7 * 64 + cc] = p.rw_mu[1024 + h * 64 + cc];
      CST[8 * 64 + cc] = p.rw_mu[1536 + cc];
      if (lane < 8) FL[lane] = 0;
    }
    __syncthreads();
    if (wv == scanw) {
      __builtin_amdgcn_s_setprio(3);
      const int v32 = lane & 31, hh = lane >> 5;
      u16* ydst = d ? p.yrwb() : p.yrwf();
      f32x16 X[2][2];
#pragma unroll
      for (int mt = 0; mt < 2; ++mt)
#pragma unroll
        for (int vt = 0; vt < 2; ++vt)
#pragma unroll
          for (int r = 0; r < 16; ++r) X[mt][vt][r] = 0.f;
      for (int c = 0; c < NCH; ++c) {
        {
          while (__builtin_amdgcn_readfirstlane(FL[c & 3]) <= c) __builtin_amdgcn_s_sleep(1);
          asm volatile("" ::: "memory");
          const char* slot = sb + (c & 3) * RW_SLOT_BYTES;
          const u16* AR = (const u16*)slot;
          const u16* MG = (const u16*)(slot + 4352);
          const u16* BT = (const u16*)(slot + 5376);
          const u16* KT = (const u16*)(slot + 7424);
          const u16* VT = (const u16*)(slot + 9472);
          const float* WC = (const float*)(slot + 11520);
          {
            const float* Arb = (const float*)(slot + 11776);
            const float* Ark = Arb + 256;
            u16* ARw = (u16*)slot;
            u16* MGw = (u16*)(slot + 4352);
            const int ol = opaque(lane), oj = opaque(lane & 15);
            v2f am[16];
#pragma unroll
            for (int tt = 0; tt < 16; ++tt) {
              const int m0 = 8 * (tt >> 2) + (tt & 3);
              am[tt] = (v2f){bf2f(ARw[ol + m0 * RW_AR_LD]), bf2f(MGw[oj + m0 * 16])};
            }
#pragma unroll
            for (int tt = 0; tt < 16; ++tt) {
              const int m0 = 8 * (tt >> 2) + (tt & 3);
              v2f acc = (v2f){bf2f(ARw[ol + (m0 + 4) * RW_AR_LD]), Ark[oj + tt * 16]};
#pragma unroll
              for (int i4 = 0; i4 < (tt + 4) / 4; ++i4) {
                const float4 s4 = *(const float4*)(Arb + tt * 16 + 4 * i4);
                const float sv[4] = {s4.x, s4.y, s4.z, s4.w};
#pragma unroll
                for (int q = 0; q < 4; ++q) {
                  const int i = 4 * i4 + q;
                  if (i <= tt) acc += sv[q] * am[i];
                }
              }
              ARw[ol + (m0 + 4) * RW_AR_LD] = f2bf(acc[0]);
              if (lane < 16) MGw[oj + (m0 + 4) * 16] = f2bf(acc[1]);
            }
          }
          bf16x8 vtf[2];
#pragma unroll
          for (int vt = 0; vt < 2; ++vt) vtf[vt] = *(const bf16x8*)(VT + (32 * vt + v32) * 16 + 8 * hh);
          f32x16 UY[2];
#pragma unroll
          for (int vt = 0; vt < 2; ++vt)
#pragma unroll
            for (int r = 0; r < 16; ++r) UY[vt][r] = 0.f;
          {
            const bf16x8 mgf = *(const bf16x8*)(MG + v32 * 16 + 8 * hh);
#pragma unroll
            for (int vt = 0; vt < 2; ++vt) UY[vt] = __builtin_amdgcn_mfma_f32_32x32x16_bf16(mgf, vtf[vt], UY[vt], 0, 0, 0);
          }
#pragma unroll
          for (int mt = 0; mt < 2; ++mt)
#pragma unroll
            for (int ks = 0; ks < 2; ++ks) {
              const int base = 32 * mt + 16 * ks + 4 * hh;
              const uint2 a0 = *(const uint2*)(AR + v32 * RW_AR_LD + base);
              const uint2 a1 = *(const uint2*)(AR + v32 * RW_AR_LD + base + 8);
              union { unsigned u[4]; bf16x8 v; } af;
              af.u[0] = a0.x; af.u[1] = a0.y; af.u[2] = a1.x; af.u[3] = a1.y;
#pragma unroll
              for (int vt = 0; vt < 2; ++vt) {
                union { unsigned u[4]; bf16x8 v; } xf;
#pragma unroll
                for (int q = 0; q < 4; ++q) xf.u[q] = cvtpk(X[mt][vt][8 * ks + 2 * q], X[mt][vt][8 * ks + 2 * q + 1]);
                UY[vt] = __builtin_amdgcn_mfma_f32_32x32x16_bf16(af.v, xf.v, UY[vt], 0, 0, 0);
              }
            }
          if (c >= 16 && hh == 1) {
#pragma unroll
            for (int r = 0; r < 16; ++r) {
              const int pos = (c - 16) * 16 + r;
              const int tok = d ? (2047 - pos) : pos;
              u16* yp = ydst + ((size_t)b * 2048 + tok) * 512 + h * 64 + v32;
              yp[0] = f2bf(UY[0][r]);
              yp[32] = f2bf(UY[1][r]);
            }
          }
          bf16x8 uyf[2][2];
#pragma unroll
          for (int vt = 0; vt < 2; ++vt)
#pragma unroll
            for (int ks = 0; ks < 2; ++ks) {
              union { unsigned u[4]; bf16x8 v; } t_;
#pragma unroll
              for (int q = 0; q < 4; ++q) t_.u[q] = cvtpk(UY[vt][8 * ks + 2 * q], UY[vt][8 * ks + 2 * q + 1]);
              uyf[vt][ks] = t_.v;
            }
#pragma unroll
          for (int mt = 0; mt < 2; ++mt) {
            const int krow = 32 * mt + v32;
            const bf16x8 ktf = *(const bf16x8*)(KT + krow * 16 + 8 * hh);
            bf16x8 btf[2];
#pragma unroll
            for (int ks = 0; ks < 2; ++ks) {
              btf[ks] = *(const bf16x8*)(BT + krow * 16 + 8 * ks);
              if (hh) btf[ks] = (bf16x8){0, 0, 0, 0, 0, 0, 0, 0};
            }
#pragma unroll
            for (int vt = 0; vt < 2; ++vt) {
              X[mt][vt] = __builtin_amdgcn_mfma_f32_32x32x16_bf16(ktf, vtf[vt], X[mt][vt], 0, 0, 0);
#pragma unroll
              for (int ks = 0; ks < 2; ++ks) X[mt][vt] = __builtin_amdgcn_mfma_f32_32x32x16_bf16(btf[ks], uyf[vt][ks], X[mt][vt], 0, 0, 0);
            }
#pragma unroll
            for (int g = 0; g < 4; ++g) {
              const float4 w4 = *(const float4*)(WC + 32 * mt + 8 * g + 4 * hh);
#pragma unroll
              for (int vt = 0; vt < 2; ++vt) {
                X[mt][vt][4 * g + 0] *= w4.x; X[mt][vt][4 * g + 1] *= w4.y;
                X[mt][vt][4 * g + 2] *= w4.z; X[mt][vt][4 * g + 3] *= w4.w;
              }
            }
          }
        }
        asm volatile("s_waitcnt lgkmcnt(0)" ::: "memory");
        if (lane == 0) FL[4] = c + 1;
      }
      __builtin_amdgcn_s_setprio(0);
    } else {
      const int pw = wv - (wv > scanw ? 1 : 0);
      const int t = lane & 15, kq = lane >> 4;
      char* scr = sb + 4 * RW_SLOT_BYTES + pw * RW_SCR_BYTES;
      u16* AL = (u16*)scr;
      u16* BE = AL + 16 * RW_RM_LD;
      u16* KA = BE + 16 * RW_RM_LD;
      float* AAs = (float*)BE;
      const int o_kq16 = opaque(16 * kq);
      const int o_tr = opaque(256 * kq + t);
      const int o_rm = opaque(t * RW_RM_LD + 16 * kq);
      const int o_ar = opaque((8 * (t >> 2) + (t & 3) + 4) * RW_AR_LD + 16 * kq);
      const int o_l = opaque(lane);
      const int o_j = opaque(lane & 15);
      const float* cstl = CST + o_kq16;
      const float* cstw = CST + 8 * 64 + opaque(8 * kq);
      const unsigned m01 = d ? 0xffff0000u : 0x0000ffffu;
      bf16x8 wwf[4], waf[4];
      {
        const int o_wl = (((d * 8 + h) * 4) * 64 + lane) * 8;
#pragma unroll
        for (int mt = 0; mt < 4; ++mt) {
          wwf[mt] = *(const bf16x8*)(p.wlf() + o_wl + mt * 512);
          waf[mt] = *(const bf16x8*)(p.wlf() + o_wl + 32768 + mt * 512);
        }
      }
      for (;;) {
        int c;
        {
          const unsigned fa = (unsigned)(unsigned long)(LAS char*)(sb + 4 * RW_SLOT_BYTES + 3 * RW_SCR_BYTES + 2304 + 20);
          const int inc = lane == 0 ? 1 : 0;
          asm volatile("ds_add_rtn_u32 %0, %1, %2\n\ts_waitcnt lgkmcnt(0)" : "=v"(c) : "v"(fa), "v"(inc) : "memory");
          c = __builtin_amdgcn_readfirstlane(c);
        }
        if (c >= NCH) break;
        while (__builtin_amdgcn_readfirstlane(FL[4]) < c - 3) __builtin_amdgcn_s_sleep(1);
        asm volatile("" ::: "memory");
        char* slot = sb + (c & 3) * RW_SLOT_BYTES;
        u16* AR = (u16*)slot;
        u16* MG = (u16*)(slot + 4352);
        u16* BT = (u16*)(slot + 5376);
        u16* KT = (u16*)(slot + 7424);
        u16* VT = (u16*)(slot + 9472);
        float* WC = (float*)(slot + 11520);
        const bool lat = c >= 16;
        const int L = lat ? 2048 : 256;
        const int pos = (lat ? (c - 16) : c) * 16 + t;
        const int tok = d ? (L - 1 - pos) : pos;
        const size_t row = (lat ? (size_t)b * 2048 : (size_t)NLAT + (size_t)b * 256) + tok;
        const u16* cbase = p.proj() + row * INC + 512;
        const u16 *ubase, *dbase, *ebase;
        float nmask[4];
        {
          size_t nrow[4];
          bool nval[4];
          neighbours(!lat, row, tok, nrow, nval);
#pragma unroll
          for (int j = 0; j < 4; ++j) nmask[j] = nval[j] ? 1.f : 0.f;
          ubase = p.proj() + (nval[2] ? nrow[2] : row) * INC + 512;
          dbase = p.proj() + (nval[3] ? nrow[3] : row) * INC + 512;
          const bool useup = (t == 0) != (d != 0);
          const size_t erow = useup ? (nval[0] ? nrow[0] : row) : (nval[1] ? nrow[1] : row);
          ebase = p.proj() + erow * INC + 512;
        }
        const int cl = 1536 + 8 * kq, cx = h * 64 + 16 * kq;
        u32x4 Cl[2], Ul[2], Dl[2], El[2];
        u32x4 Cx[3][2], Ux[3][2], Dx[3][2], Ex[3][2];
#pragma unroll
        for (int a = 0; a < 2; ++a) {
          Cl[a] = *(const u32x4*)(cbase + cl + 32 * a);
          Ul[a] = *(const u32x4*)(ubase + cl + 32 * a);
          Dl[a] = *(const u32x4*)(dbase + cl + 32 * a);
          El[a] = (u32x4){0u, 0u, 0u, 0u};
        }
#pragma unroll
        for (int a = 0; a < 3; ++a)
#pragma unroll
          for (int hf = 0; hf < 2; ++hf) {
            Cx[a][hf] = *(const u32x4*)(cbase + cx + 512 * a + 8 * hf);
            Ux[a][hf] = *(const u32x4*)(ubase + cx + 512 * a + 8 * hf);
            Dx[a][hf] = *(const u32x4*)(dbase + cx + 512 * a + 8 * hf);
            Ex[a][hf] = (u32x4){0u, 0u, 0u, 0u};
          }
        if (t == 0 || t == 15) {
#pragma unroll
          for (int a = 0; a < 2; ++a) El[a] = *(const u32x4*)(ebase + cl + 32 * a);
#pragma unroll
          for (int a = 0; a < 3; ++a)
#pragma unroll
            for (int hf = 0; hf < 2; ++hf) Ex[a][hf] = *(const u32x4*)(ebase + cx + 512 * a + 8 * hf);
        }
        bf16x8 lwf, laf;
        {
          float lw[8], la[8];
          const float4 ml0 = *(const float4*)(cstw), ml1 = *(const float4*)(cstw + 4);
          const float4 ma0 = *(const float4*)(cstw + 32), ma1 = *(const float4*)(cstw + 32 + 4);
          const float mul_[8] = {ml0.x, ml0.y, ml0.z, ml0.w, ml1.x, ml1.y, ml1.z, ml1.w};
          const float mua_[8] = {ma0.x, ma0.y, ma0.z, ma0.w, ma1.x, ma1.y, ma1.z, ma1.w};
#pragma unroll
          for (int g = 0; g < 2; ++g) {
            unsigned nw01, nw23, na01, na23;
            shift_src(Cl[0][2 * g], El[0][2 * g], Ul[0][2 * g + 1], Dl[0][2 * g + 1], m01, nw01, nw23);
            shift_src(Cl[1][2 * g], El[1][2 * g], Ul[1][2 * g + 1], Dl[1][2 * g + 1], m01, na01, na23);
            const float zw[4] = {bflo(Cl[0][2 * g]), bfhi(Cl[0][2 * g]), bflo(Cl[0][2 * g + 1]), bfhi(Cl[0][2 * g + 1])};
            const float za[4] = {bflo(Cl[1][2 * g]), bfhi(Cl[1][2 * g]), bflo(Cl[1][2 * g + 1]), bfhi(Cl[1][2 * g + 1])};
            const float nw[4] = {bflo(nw01), bfhi(nw01), bflo(nw23), bfhi(nw23)};
            const float na[4] = {bflo(na01), bfhi(na01), bflo(na23), bfhi(na23)};
#pragma unroll
            for (int j = 0; j < 4; ++j) {
              const int q = 4 * g + j;
              lw[q] = 1.f - 2.f * __builtin_amdgcn_rcpf(1.f + __expf(2.f * (zw[j] + (nw[j] * nmask[j] - zw[j]) * mul_[q])));
              la[q] = za[j] + (na[j] * nmask[j] - za[j]) * mua_[q];
            }
          }
          union { unsigned u[4]; bf16x8 v; } tw, ta;
#pragma unroll
          for (int q = 0; q < 4; ++q) { tw.u[q] = pack2(lw[2 * q], lw[2 * q + 1]); ta.u[q] = pack2(la[2 * q], la[2 * q + 1]); }
          lwf = tw.v; laf = ta.v;
        }
        float ee[16];
        unsigned rrp[8], aap[8], kxp[8];
        {
#pragma unroll
          for (int mt = 0; mt < 4; ++mt) {
            const float4 mr = *(const float4*)(cstl + 5 * 64 + 4 * mt), mk = *(const float4*)(cstl + 6 * 64 + 4 * mt), mv = *(const float4*)(cstl + 7 * 64 + 4 * mt);
            const float mrv[4] = {mr.x, mr.y, mr.z, mr.w}, mkv[4] = {mk.x, mk.y, mk.z, mk.w}, mvv[4] = {mv.x, mv.y, mv.z, mv.w};
            const int hf = mt >> 1, r0 = 2 * (mt & 1);
            float mix[3][4];
#pragma unroll
            for (int a = 0; a < 3; ++a) {
              unsigned n01, n23;
              shift_src(Cx[a][hf][r0], Ex[a][hf][r0], Ux[a][hf][r0 + 1], Dx[a][hf][r0 + 1], m01, n01, n23);
              const float z[4] = {bflo(Cx[a][hf][r0]), bfhi(Cx[a][hf][r0]), bflo(Cx[a][hf][r0 + 1]), bfhi(Cx[a][hf][r0 + 1])};
              const float n[4] = {bflo(n01), bfhi(n01), bflo(n23), bfhi(n23)};
              const float* mm = a == 0 ? mrv : (a == 1 ? mkv : mvv);
#pragma unroll
              for (int j = 0; j < 4; ++j) mix[a][j] = z[j] + (n[j] * nmask[j] - z[j]) * mm[j];
            }
#pragma unroll
            for (int j = 0; j < 4; ++j) VT[o_tr + (4 * mt + j) * 16] = f2bf(mix[2][j]);
            const f32x4 z4 = (f32x4){0.f, 0.f, 0.f, 0.f};
            const f32x4 aw = __builtin_amdgcn_mfma_f32_16x16x32_bf16(wwf[mt], lwf, z4, 0, 0, 0);
            const f32x4 a2 = __builtin_amdgcn_mfma_f32_16x16x32_bf16(waf[mt], laf, z4, 0, 0, 0);
            const float4 w0 = *(const float4*)(cstl + 0 * 64 + 4 * mt), a0 = *(const float4*)(cstl + 1 * 64 + 4 * mt);
            ee[4 * mt] = 0.60653066f * fsig(w0.x + aw[0]); ee[4 * mt + 1] = 0.60653066f * fsig(w0.y + aw[1]);
            ee[4 * mt + 2] = 0.60653066f * fsig(w0.z + aw[2]); ee[4 * mt + 3] = 0.60653066f * fsig(w0.w + aw[3]);
            float aav[4];
            aav[0] = fsig(a0.x + a2[0]); aav[1] = fsig(a0.y + a2[1]);
            aav[2] = fsig(a0.z + a2[2]); aav[3] = fsig(a0.w + a2[3]);
            rrp[2 * mt] = pack2(mix[0][0], mix[0][1]); rrp[2 * mt + 1] = pack2(mix[0][2], mix[0][3]);
            aap[2 * mt] = pack2(aav[0], aav[1]); aap[2 * mt + 1] = pack2(aav[2], aav[3]);
            kxp[2 * mt] = pack2(mix[1][0], mix[1][1]); kxp[2 * mt + 1] = pack2(mix[1][2], mix[1][3]);
          }
        }
        float kdf[16], kkf[16];
        float inv;
        {
          float ss = 0.f, bon = 0.f;
#pragma unroll
          for (int mt = 0; mt < 4; ++mt) {
            const float4 c2 = *(const float4*)(cstl + 2 * 64 + 4 * mt), c3 = *(const float4*)(cstl + 3 * 64 + 4 * mt), c4 = *(const float4*)(cstl + 4 * 64 + 4 * mt);
            const float kkc[4] = {c2.x, c2.y, c2.z, c2.w}, kac[4] = {c3.x, c3.y, c3.z, c3.w}, rkc[4] = {c4.x, c4.y, c4.z, c4.w};
#pragma unroll
            for (int j = 0; j < 4; ++j) {
              const int e = 4 * mt + j;
              const float kx = (e & 1) ? bfhi(kxp[e >> 1]) : bflo(kxp[e >> 1]);
              const float av = (e & 1) ? bfhi(aap[e >> 1]) : bflo(aap[e >> 1]);
              const float rv = (e & 1) ? bfhi(rrp[e >> 1]) : bflo(rrp[e >> 1]);
              kdf[e] = kx * (1.f + (av - 1.f) * kac[j]);
              kkf[e] = kx * kkc[j];
              ss += kkf[e] * kkf[e];
              bon += rv * kdf[e] * rkc[j];
            }
          }
          ss += __shfl_xor(ss, 16, 64); ss += __shfl_xor(ss, 32, 64);
          bon += __shfl_xor(bon, 16, 64); bon += __shfl_xor(bon, 32, 64);
          inv = rsqrtf(ss + 1e-12f);
          if (lat && kq == 0) p.bsc()[((size_t)d * NLAT + row) * 8 + h] = bon;
        }
#pragma unroll
        for (int mt = 0; mt < 4; ++mt) {
          float al4[4], rh4[4], be4[4], ka4[4];
#pragma unroll
          for (int j = 0; j < 4; ++j) {
            const int e = 4 * mt + j;
            float cs = ee[e];
            cs = dpp_shr_add(cs, 1); cs = dpp_shr_add(cs, 2); cs = dpp_shr_add(cs, 4); cs = dpp_shr_add(cs, 8);
            const float Ep = __expf(cs), Em = __builtin_amdgcn_rcpf(Ep), Ex = __expf(ee[e] - cs);
            const float kkn = kkf[e] * inv;
            al4[j] = -kkn * Ex;
            be4[j] = kkn * ((e & 1) ? bfhi(aap[e >> 1]) : bflo(aap[e >> 1])) * Ep;
            ka4[j] = kdf[e] * Ep;
            rh4[j] = ((e & 1) ? bfhi(rrp[e >> 1]) : bflo(rrp[e >> 1])) * Em;
            BT[o_tr + (4 * mt + j) * 16] = f2bf(be4[j]);
            KT[o_tr + (4 * mt + j) * 16] = f2bf(ka4[j]);
            if (t == 15) WC[o_kq16 + 4 * mt + j] = Em;
          }
          const int ko = o_rm + 4 * mt;
          *(uint2*)(AL + ko) = make_uint2(pack2(al4[0], al4[1]), pack2(al4[2], al4[3]));
          *(uint2*)(AR + o_ar + 4 * mt) = make_uint2(pack2(rh4[0], rh4[1]), pack2(rh4[2], rh4[3]));
          *(uint2*)(BE + ko) = make_uint2(pack2(be4[0], be4[1]), pack2(be4[2], be4[3]));
          *(uint2*)(KA + ko) = make_uint2(pack2(ka4[0], ka4[1]), pack2(ka4[2], ka4[3]));
        }
        {
          const int m = lane & 31, hh = lane >> 5;
          const int typ = (m >> 2) & 1, tt = 4 * (m >> 3) + (m & 3);
          const u16* arow = (typ ? AR + m * RW_AR_LD : AL + tt * RW_RM_LD) + 8 * hh;
          const u16* brow = ((m >> 4) ? KA : BE) + (m & 15) * RW_RM_LD + 8 * hh;
          f32x16 aa;
#pragma unroll
          for (int r = 0; r < 16; ++r) aa[r] = 0.f;
#pragma unroll
          for (int ks = 0; ks < 4; ++ks) {
            const uint2 a0 = *(const uint2*)(arow + 16 * ks), a1 = *(const uint2*)(arow + 16 * ks + 4);
            union { unsigned u[4]; bf16x8 v; } af;
            af.u[0] = a0.x; af.u[1] = a0.y; af.u[2] = a1.x; af.u[3] = a1.y;
            const bf16x8 bf_ = *(const bf16x8*)(brow + 16 * ks);
            aa = __builtin_amdgcn_mfma_f32_32x32x16_bf16(af.v, bf_, aa, 0, 0, 0);
          }
          const int i = m & 15;
          float* aad = (hh ? (float*)(slot + 11776) : AAs) + opaque((m >> 4) * 256 + i);
#pragma unroll
          for (int r = 0; r < 16; ++r) {
            const bool keep = hh ? (i <= r) : (i < r);
            aad[r * 16] = keep ? aa[r] : 0.f;
          }
        }
        asm volatile("" ::: "memory");
        {
          const float* Aab = AAs;
          const float* Aak = AAs + 256;
          v2f am[16];
#pragma unroll
          for (int tt = 0; tt < 16; ++tt) {
            v2f acc = (v2f){bf2f(AL[o_l + tt * RW_RM_LD]), Aak[o_j + tt * 16]};
#pragma unroll
            for (int i4 = 0; i4 < (tt + 3) / 4; ++i4) {
              const float4 s4 = *(const float4*)(Aab + tt * 16 + 4 * i4);
              const float sv[4] = {s4.x, s4.y, s4.z, s4.w};
#pragma unroll
              for (int q = 0; q < 4; ++q) {
                const int i = 4 * i4 + q;
                if (i < tt) acc += sv[q] * am[i];
              }
            }
            am[tt] = acc;
          }
#pragma unroll
          for (int tt = 0; tt < 16; ++tt) {
            const int m0 = 8 * (tt >> 2) + (tt & 3);
            AR[o_l + m0 * RW_AR_LD] = f2bf(am[tt][0]);
            if (lane < 16) MG[o_j + m0 * 16] = f2bf(am[tt][1]);
          }
        }
        asm volatile("s_waitcnt lgkmcnt(0)" ::: "memory");
        if (lane == 0) FL[c & 3] = c + 1;
      }
    }
  }
}

struct MixLd {
  uint4 s5f, s5b, rwf, rwb, vc, gc;
  u16 vn[8], gn[8];
  float bs0, bs1;
};
__device__ __forceinline__ void mix_load(const P& p, int row, int lane, MixLd& L, float (&nmask)[4]) {
  const int c8 = lane * 8, t = row & 2047;
  L.s5f = *(const uint4*)(p.ys5f() + (size_t)row * 512 + c8);
  L.s5b = *(const uint4*)(p.ys5b() + (size_t)row * 512 + c8);
  L.rwf = *(const uint4*)(p.yrwf() + (size_t)row * 512 + c8);
  L.rwb = *(const uint4*)(p.yrwb() + (size_t)row * 512 + c8);
  size_t nrow[4];
  bool nval[4];
  neighbours(false, (size_t)row, t, nrow, nval);
  const u16* nb_[4];
#pragma unroll
  for (int j = 0; j < 4; ++j) { nb_[j] = p.proj() + (nval[j] ? nrow[j] : (size_t)row) * INC + 512 + j; nmask[j] = nval[j] ? 1.f : 0.f; }
  const u16* cb = p.proj() + (size_t)row * INC + 512;
  L.vc = *(const uint4*)(cb + 1024 + c8);
#pragma unroll
  for (int i = 0; i < 8; ++i) L.vn[i] = nb_[i & 3][1024 + c8 + (i & 4)];
  const int g8 = (lane < 12) ? c8 : 0;
  L.gc = *(const uint4*)(cb + 1600 + g8);
#pragma unroll
  for (int i = 0; i < 8; ++i) L.gn[i] = nb_[i & 3][1600 + g8 + (i & 4)];
  const int head = lane >> 3;
  L.bs0 = p.bsc()[(size_t)row * 8 + head];
  L.bs1 = p.bsc()[((size_t)NLAT + row) * 8 + head];
}
__device__ __forceinline__ void mix_compute(const P& p, int row, int lane, const MixLd& L, const float (&nmask)[4], u16* y1dst, u16* t1dst) {
  const int c8 = lane * 8;
  {
    const unsigned au[4] = {L.s5f.x, L.s5f.y, L.s5f.z, L.s5f.w}, bu[4] = {L.s5b.x, L.s5b.y, L.s5b.z, L.s5b.w};
    unsigned ou[4];
#pragma unroll
    for (int q = 0; q < 4; ++q) ou[q] = pack2(gelu_as(bflo(au[q]) + bflo(bu[q])), gelu_as(bfhi(au[q]) + bfhi(bu[q])));
    *(uint4*)(y1dst + (size_t)row * 512 + c8) = make_uint4(ou[0], ou[1], ou[2], ou[3]);
  }
  float y[8];
  {
    const unsigned au[4] = {L.rwf.x, L.rwf.y, L.rwf.z, L.rwf.w}, bu[4] = {L.rwb.x, L.rwb.y, L.rwb.z, L.rwb.w};
#pragma unroll
    for (int q = 0; q < 4; ++q) { y[2 * q] = bflo(au[q]) + bflo(bu[q]); y[2 * q + 1] = bfhi(au[q]) + bfhi(bu[q]); }
  }
  float sm = 0.f;
#pragma unroll
  for (int i = 0; i < 8; ++i) sm += y[i];
  sm = dpp_add(sm, 0, 0); sm = dpp_add(sm, 1, 0); sm = dpp_add(sm, 2, 0);
  const float mu = sm * (1.f / 64.f);
  float sv = 0.f;
#pragma unroll
  for (int i = 0; i < 8; ++i) sv += (y[i] - mu) * (y[i] - mu);
  sv = dpp_add(sv, 0, 0); sv = dpp_add(sv, 1, 0); sv = dpp_add(sv, 2, 0);
  const float rs = rsqrtf(sv * (1.f / 64.f) + 64e-5f);
  float v[8];
  {
    const unsigned cu[4] = {L.vc.x, L.vc.y, L.vc.z, L.vc.w};
    const float4 m0 = *(const float4*)(p.rw_mu + 1024 + c8), m1 = *(const float4*)(p.rw_mu + 1024 + c8 + 4);
    const float mm[8] = {m0.x, m0.y, m0.z, m0.w, m1.x, m1.y, m1.z, m1.w};
#pragma unroll
    for (int i = 0; i < 8; ++i) {
      const float z = (i & 1) ? bfhi(cu[i >> 1]) : bflo(cu[i >> 1]);
      const float nbv = bf2f(L.vn[i]) * nmask[i & 3];
      v[i] = z + (nbv - z) * mm[i];
    }
  }
  const float bs = L.bs0 + L.bs1;
  {
    const float4 w0 = *(const float4*)(p.rw_ln_w + c8), w1 = *(const float4*)(p.rw_ln_w + c8 + 4);
    const float4 b0 = *(const float4*)(p.rw_ln_b + c8), b1 = *(const float4*)(p.rw_ln_b + c8 + 4);
    const float lw[8] = {w0.x, w0.y, w0.z, w0.w, w1.x, w1.y, w1.z, w1.w};
    const float lb[8] = {b0.x, b0.y, b0.z, b0.w, b1.x, b1.y, b1.z, b1.w};
    float o[8];
#pragma unroll
    for (int i = 0; i < 8; ++i) o[i] = (y[i] - mu) * rs * lw[i] + lb[i] + bs * v[i];
    *(uint4*)(t1dst + (size_t)row * 512 + c8) = make_uint4(pack2(o[0], o[1]), pack2(o[2], o[3]), pack2(o[4], o[5]), pack2(o[6], o[7]));
  }
  if (lane < 32) {
    unsigned ou[4] = {0u, 0u, 0u, 0u};
    if (lane < 12) {
      const unsigned cu[4] = {L.gc.x, L.gc.y, L.gc.z, L.gc.w};
      const float4 m0 = *(const float4*)(p.rw_mu + 1600 + c8), m1 = *(const float4*)(p.rw_mu + 1600 + c8 + 4);
      const float mm[8] = {m0.x, m0.y, m0.z, m0.w, m1.x, m1.y, m1.z, m1.w};
      float gsig[8];
#pragma unroll
      for (int i = 0; i < 8; ++i) {
        const float z = (i & 1) ? bfhi(cu[i >> 1]) : bflo(cu[i >> 1]);
        const float nbv = bf2f(L.gn[i]) * nmask[i & 3];
        gsig[i] = fsig(z + (nbv - z) * mm[i]);
      }
#pragma unroll
      for (int q = 0; q < 4; ++q) ou[q] = pack2(gsig[2 * q], gsig[2 * q + 1]);
    }
    *(uint4*)(p.sg() + (size_t)row * 256 + c8) = make_uint4(ou[0], ou[1], ou[2], ou[3]);
  }
}
__device__ __forceinline__ void ph_mixprep(const P& p, int bid, int nb, u16* y1dst, u16* t1dst) {
  const int wid = tidx() >> 6, lane = tidx() & 63;
  const int stride = nb * 8;
  for (int row = bid * 8 + wid; row < NLAT; row += 2 * stride) {
    const int rowB = row + stride;
    const bool hasB = rowB < NLAT;
    MixLd LA, LB;
    float mA[4], mB[4];
    mix_load(p, row, lane, LA, mA);
    mix_load(p, hasB ? rowB : row, lane, LB, mB);
    mix_compute(p, row, lane, LA, mA, y1dst, t1dst);
    if (hasB) mix_compute(p, rowB, lane, LB, mB, y1dst, t1dst);
  }
}

__constant__ unsigned char CAND_I[52] = {0,0,0,0,0,0,0,0,0,0,0,0,0,0,0,0, 1,1,1,1,1,1,1,1, 2,2,2,2,2, 3,3,3,3, 4,4,4, 5,5, 6,6, 7,7, 8,9,10,11,12,13,14,15, 0,0};
__constant__ unsigned char CAND_J[52] = {0,1,2,3,4,5,6,7,8,9,10,11,12,13,14,15, 0,1,2,3,4,5,6,7, 0,1,2,3,4, 0,1,2,3, 0,1,2, 0,1, 0,1, 0,1, 0,0,0,0,0,0,0,0, 0,0};

#define SC_LD 144
#define KL_LD 136
__device__ __forceinline__ unsigned umax_quad(unsigned v) {
  unsigned o = (unsigned)__builtin_amdgcn_update_dpp(0, (int)v, 0xB1, 0xf, 0xf, true);
  v = v > o ? v : o;
  o = (unsigned)__builtin_amdgcn_update_dpp(0, (int)v, 0x4E, 0xf, 0xf, true);
  return v > o ? v : o;
}
__device__ __forceinline__ unsigned mono_key(float f) {
  unsigned u = __float_as_uint(f);
  return u ^ ((u >> 31) ? 0xFFFFFFFFu : 0x80000000u);
}
__device__ __forceinline__ float mono_inv(unsigned k) {
  unsigned u = (k >> 31) ? (k ^ 0x80000000u) : ~k;
  return __uint_as_float(u);
}
__device__ __forceinline__ unsigned umax3(unsigned a, unsigned b, unsigned c) {
  unsigned m = a > b ? a : b;
  return m > c ? m : c;
}
__device__ __forceinline__ void ph_route(const P& p, char* smem, int bid, int nb) {
  u16* KL = (u16*)smem;
  unsigned* SC = (unsigned*)(smem + 2 * 128 * KL_LD * 2);
  float* TS = (float*)(SC + 2 * 64 * SC_LD);
  int* TI = (int*)(TS + 2 * 64 * 16);
  const u16* Q = p.proj();
  const int tid = tidx(), wid = tid >> 6, lane = tid & 63, fr = lane & 15, fq = lane >> 4;
  int cur_h = -1;
  bf16x8 an[4];
  {
    const int h0 = bid & 7, r0 = (bid >> 3) * 64, c0 = wid >> 2, m0 = (wid & 3) * 16;
#pragma unroll
    for (int ks = 0; ks < 4; ++ks)
      an[ks] = *(const bf16x8*)(Q + (size_t)(r0 + m0 + fr) * 2048 + h0 * 256 + c0 * 128 + ks * 32 + fq * 8);
  }
  for (int item = bid; item < 1024 * 8; item += nb) {
    const int h = item & 7, row0 = (item >> 3) * 64;
    if (h != cur_h) {
      __syncthreads();
      for (int e = tid; e < 2 * 128 * 16; e += NTHREADS) {
        int r = e >> 4, kc = (e & 15) * 8;
        *(uint4*)(KL + r * KL_LD + kc) = *(const uint4*)(p.keys() + ((size_t)h * 256 + r) * 128 + kc);
      }
      cur_h = h;
      __syncthreads();
    }
    {
      const int c = wid >> 2, mrow = (wid & 3) * 16;
      f32x4 acc[8];
#pragma unroll
      for (int ni = 0; ni < 8; ++ni) acc[ni] = (f32x4){0.f, 0.f, 0.f, 0.f};
      bf16x8 a[4];
#pragma unroll
      for (int ks = 0; ks < 4; ++ks) a[ks] = an[ks];
      {
        const int nit = (item + nb < 1024 * 8) ? item + nb : item;
        const int nh = nit & 7, nr0 = (nit >> 3) * 64;
#pragma unroll
        for (int ks = 0; ks < 4; ++ks)
          an[ks] = *(const bf16x8*)(Q + (size_t)(nr0 + mrow + fr) * 2048 + nh * 256 + c * 128 + ks * 32 + fq * 8);
      }
#pragma unroll
      for (int ks = 0; ks < 4; ++ks) {
#pragma unroll
        for (int ni = 0; ni < 8; ++ni) {
          bf16x8 bfr = *(const bf16x8*)(KL + (c * 128 + ni * 16 + fr) * KL_LD + ks * 32 + fq * 8);
          acc[ni] = __builtin_amdgcn_mfma_f32_16x16x32_bf16(a[ks], bfr, acc[ni], 0, 0, 0);
        }
      }
#pragma unroll
      for (int ni = 0; ni < 8; ++ni)
#pragma unroll
        for (int j = 0; j < 4; ++j) {
          const int n = ni * 16 + fr;
          SC[(c * 64 + mrow + fq * 4 + j) * SC_LD + n] = (mono_key(acc[ni][j]) & ~127u) | (unsigned)(127 - n);
        }
    }
    __syncthreads();
    {
      const int task = tid >> 2, q4 = tid & 3;
      unsigned* rowp = SC + task * SC_LD;
      for (int r = 0; r < 16; ++r) {
        unsigned m = 0;
#pragma unroll
        for (int j = 0; j < 8; ++j) {
          uint4 v = *(const uint4*)(rowp + 16 * j + 4 * q4);
          m = umax3(m, v.x, v.y);
          m = umax3(m, v.z, v.w);
        }
        m = umax_quad(m);
        const int n = 127 - (int)(m & 127u);
        if (((n >> 2) & 3) == q4) rowp[n] = 0u;
        if (q4 == (r & 3)) {
          TS[task * 16 + r] = mono_inv(m & ~127u);
          TI[task * 16 + r] = n;
        }
      }
    }
    __syncthreads();
    if (tid < 256) {
      const int t = tid >> 2, q4 = tid & 3;
      unsigned val[13];
#pragma unroll
      for (int e = 0; e < 13; ++e) {
        const int ci = q4 + 4 * e;
        const int i = CAND_I[ci], j = CAND_J[ci];
        const float sv = TS[t * 16 + i] + TS[(64 + t) * 16 + j];
        val[e] = (ci < 50) ? ((mono_key(sv) & ~255u) | (unsigned)(255 - (i * 16 + j))) : 0u;
      }
      unsigned mine[4] = {0u, 0u, 0u, 0u};
      unsigned first = 0u;
#pragma unroll
      for (int r = 0; r < 16; ++r) {
        unsigned m = umax3(val[0], val[1], val[2]);
        m = umax3(m, val[3], val[4]);
        m = umax3(m, val[5], val[6]);
        m = umax3(m, val[7], val[8]);
        m = umax3(m, val[9], val[10]);
        m = umax3(m, val[11], val[12]);
        m = umax_quad(m);
#pragma unroll
        for (int e = 0; e < 13; ++e) val[e] = (val[e] == m) ? 0u : val[e];
        if (r == 0) first = m;
        mine[r >> 2] = (q4 == (r & 3)) ? m : mine[r >> 2];
      }
      float smax;
      {
        const int cid = 255 - (int)(first & 255u);
        smax = TS[t * 16 + (cid >> 4)] + TS[(64 + t) * 16 + (cid & 15)];
      }
      float ex[4];
      int eid[4];
      float part = 0.f;
#pragma unroll
      for (int k = 0; k < 4; ++k) {
        const int cid = 255 - (int)(mine[k] & 255u);
        const int i = cid >> 4, j = cid & 15;
        const float sv = TS[t * 16 + i] + TS[(64 + t) * 16 + j];
        ex[k] = __expf(sv - smax);
        part += ex[k];
        eid[k] = TI[t * 16 + i] * 128 + TI[(64 + t) * 16 + j];
      }
      part = dpp_add(part, 0, 0);
      part = dpp_add(part, 1, 0);
      const float rden = 1.f / part;
      const size_t obase = ((size_t)(row0 + t) * 8 + h) * 16;
#pragma unroll
      for (int k = 0; k < 4; ++k) {
        p.idx()[obase + 4 * k + q4] = eid[k];
        p.gate()[obase + 4 * k + q4] = ex[k] * rden;
      }
    }
    __syncthreads();
  }
}

typedef int v8i_t __attribute__((ext_vector_type(8)));
__device__ __forceinline__ void ph_ffn(const P& p, float* __restrict__ dst, char* smem, int bid, int nb) {
  const int wid = tidx() >> 6, lane = tidx() & 63;
  const int hh = lane >> 5, li = lane & 31, m16 = lane & 15, kg = lane >> 4;
  unsigned char* h8 = (unsigned char*)smem + wid * 1024;
  const u16* H2N = p.hn();
  for (int row = bid * 8 + wid; row < NLAT; row += nb * 8) {
    float hinv;
    {
      const uint4 a = *(const uint4*)(H2N + (size_t)row * 1024 + lane * 16), b2 = *(const uint4*)(H2N + (size_t)row * 1024 + lane * 16 + 8);
      const unsigned au[8] = {a.x, a.y, a.z, a.w, b2.x, b2.y, b2.z, b2.w};
      float hv[16];
      float am = 0.f;
#pragma unroll
      for (int q = 0; q < 8; ++q) { hv[2 * q] = bflo(au[q]); hv[2 * q + 1] = bfhi(au[q]); am = fmaxf(am, fmaxf(fabsf(hv[2 * q]), fabsf(hv[2 * q + 1]))); }
#pragma unroll
      for (int m = 32; m >= 1; m >>= 1) am = fmaxf(am, __shfl_xor(am, m, 64));
      const float scl = am > 0.f ? 448.f / am : 1.f;
      hinv = am > 0.f ? am * (1.f / 448.f) : 1.f;
      unsigned o[4];
#pragma unroll
      for (int q = 0; q < 4; ++q) {
        int w = 0;
        w = __builtin_amdgcn_cvt_pk_fp8_f32(hv[4 * q] * scl, hv[4 * q + 1] * scl, w, false);
        w = __builtin_amdgcn_cvt_pk_fp8_f32(hv[4 * q + 2] * scl, hv[4 * q + 3] * scl, w, true);
        o[q] = (unsigned)w;
      }
      *(uint4*)(h8 + lane * 16) = make_uint4(o[0], o[1], o[2], o[3]);
    }
    v8i_t hb[8];
#pragma unroll
    for (int s2 = 0; s2 < 8; ++s2) {
      const uint4 x0 = *(const uint4*)(h8 + 128 * s2 + 16 * kg), x1 = *(const uint4*)(h8 + 128 * s2 + 64 + 16 * kg);
      hb[s2] = (v8i_t){(int)x0.x, (int)x0.y, (int)x0.z, (int)x0.w, (int)x1.x, (int)x1.y, (int)x1.z, (int)x1.w};
    }
    const int id0 = p.idx()[(size_t)row * 128 + lane], id1 = p.idx()[(size_t)row * 128 + 64 + lane];
    const float us0 = p.usc()[id0] * hinv, us1 = p.usc()[id1] * hinv;
    const float gv0 = p.gate()[(size_t)row * 128 + lane] * p.vsc()[id0], gv1 = p.gate()[(size_t)row * 128 + 64 + lane] * p.vsc()[id1];
    float oacc[32];
#pragma unroll
    for (int i = 0; i < 32; ++i) oacc[i] = 0.f;
#pragma unroll 1
    for (int bb = 0; bb < 8; ++bb) {
      const bool hf = bb >= 4;
      const int e0 = (bb & 3) * 16;
      const int idv = hf ? id1 : id0;
      const float usv = hf ? us1 : us0, gvv = hf ? gv1 : gv0;
      const int idm = __shfl(idv, e0 + m16, 64);
      uint4 ua[8];
#pragma unroll
      for (int s2 = 0; s2 < 8; ++s2) ua[s2] = *(const uint4*)(p.utab() + (size_t)idm * 1024 + 64 * s2 + 16 * kg);
      uint4 vr[8];
#pragma unroll
      for (int q = 0; q < 8; ++q) {
        const int ia = __builtin_amdgcn_readlane(idv, e0 + 2 * q), ib = __builtin_amdgcn_readlane(idv, e0 + 2 * q + 1);
        const int id = hh ? ib : ia;
        vr[q] = *(const uint4*)(p.utab() + (size_t)id * 1024 + 512 + li * 16);
      }
      f32x4 D = (f32x4){0.f, 0.f, 0.f, 0.f};
#pragma unroll
      for (int s2 = 0; s2 < 8; ++s2) {
        const v8i_t av = (v8i_t){(int)ua[s2].x, (int)ua[s2].y, (int)ua[s2].z, (int)ua[s2].w, 0, 0, 0, 0};
        D = __builtin_amdgcn_mfma_scale_f32_16x16x128_f8f6f4(av, hb[s2], D, 4  , 0  , 0, 0x7f7f7f7f, 0, 0x7f7f7f7f);
      }
      const int nn = m16 & 3;
      const float dotv = nn == 0 ? D[0] : (nn == 1 ? D[1] : (nn == 2 ? D[2] : D[3]));
      const int esrc = e0 + 4 * kg + nn;
      const float usx = __shfl(usv, esrc, 64), gvx = __shfl(gvv, esrc, 64);
      const float cfl = gvx * gelu_as(dotv * usx);
#pragma unroll
      for (int q = 0; q < 8; ++q) {
        int one_s;
        asm volatile("s_mov_b32 %0, 1" : "=s"(one_s));
        if (one_s == 0) continue;
        const int ma = 2 * q, mb = 2 * q + 1;
        const float cfa = __int_as_float(__builtin_amdgcn_readlane(__float_as_int(cfl), 16 * (ma >> 2) + (ma & 3)));
        const float cfb = __int_as_float(__builtin_amdgcn_readlane(__float_as_int(cfl), 16 * (mb >> 2) + (mb & 3)));
        const float cf = hh ? cfb : cfa;
        const unsigned vv[4] = {vr[q].x, vr[q].y, vr[q].z, vr[q].w};
#pragma unroll
        for (int k = 0; k < 4; ++k) {
          v2f p0 = __builtin_amdgcn_cvt_scalef32_pk_f32_fp4(vv[k], 1.0f, 0), p1 = __builtin_amdgcn_cvt_scalef32_pk_f32_fp4(vv[k], 1.0f, 1);
          v2f p2 = __builtin_amdgcn_cvt_scalef32_pk_f32_fp4(vv[k], 1.0f, 2), p3 = __builtin_amdgcn_cvt_scalef32_pk_f32_fp4(vv[k], 1.0f, 3);
          oacc[8 * k] += cf * p0[0]; oacc[8 * k + 1] += cf * p0[1];
          oacc[8 * k + 2] += cf * p1[0]; oacc[8 * k + 3] += cf * p1[1];
          oacc[8 * k + 4] += cf * p2[0]; oacc[8 * k + 5] += cf * p2[1];
          oacc[8 * k + 6] += cf * p3[0]; oacc[8 * k + 7] += cf * p3[1];
        }
      }
    }
    float mine[16];
#pragma unroll
    for (int i = 0; i < 16; ++i) {
      const float give = hh ? oacc[i] : oacc[16 + i];
      const float got = __shfl_xor(give, 32, 64);
      mine[i] = (hh ? oacc[16 + i] : oacc[i]) + got;
    }
    const int b = row >> 11;
    const int colb = li * 32 + hh * 16;
    float h3[16];
    float ss = 0.f;
    const uint4 hA = *(const uint4*)((const u16*)p.out + (size_t)row * 2048 + 1024 + colb), hB = *(const uint4*)((const u16*)p.out + (size_t)row * 2048 + 1024 + colb + 8);
    const unsigned hw[8] = {hA.x, hA.y, hA.z, hA.w, hB.x, hB.y, hB.z, hB.w};
#pragma unroll
    for (int q = 0; q < 4; ++q) {
      const int col = colb + q * 4;
      const float4 a0 = make_float4(bflo(hw[2 * q]), bfhi(hw[2 * q]), bflo(hw[2 * q + 1]), bfhi(hw[2 * q + 1]));
      float4 q0 = *(const float4*)(p.mod() + b * 6144 + 5 * 1024 + col);
      h3[q * 4 + 0] = a0.x + q0.x * mine[q * 4 + 0];
      h3[q * 4 + 1] = a0.y + q0.y * mine[q * 4 + 1];
      h3[q * 4 + 2] = a0.z + q0.z * mine[q * 4 + 2];
      h3[q * 4 + 3] = a0.w + q0.w * mine[q * 4 + 3];
      ss += h3[q * 4] * h3[q * 4] + h3[q * 4 + 1] * h3[q * 4 + 1] + h3[q * 4 + 2] * h3[q * 4 + 2] + h3[q * 4 + 3] * h3[q * 4 + 3];
    }
    ss = wave_sum_u(ss);
    const float rstd = rsqrtf(ss * (1.f / 1024.f) + 1e-6f);
#pragma unroll
    for (int q = 0; q < 4; ++q) {
      const int col = colb + q * 4;
      float4 n0 = *(const float4*)(p.norm_f_g + col);
      *(float4*)(dst + (size_t)row * 1024 + col) =
          make_float4(h3[q * 4] * rstd * n0.x, h3[q * 4 + 1] * rstd * n0.y, h3[q * 4 + 2] * rstd * n0.z, h3[q * 4 + 3] * rstd * n0.w);
    }
  }
}

#define XB_TMO      128
#define XB_XCNT(j)  (256  + 64 * (j))
#define XB_XSUB(j)  (1280 + 64 * (j))
#define XB_XGEN(j)  (2304 + 64 * (j))
#define XB_TOP      3328
#define XB_TOPGEN   3392
#define XCD_BAR_WORDS 3456
#define XB_SPIN_CAP (1u << 18)
#define LAS __attribute__((address_space(3)))

__device__ __forceinline__ unsigned xb_ld(unsigned* p)              { return __hip_atomic_load(p, __ATOMIC_RELAXED, __HIP_MEMORY_SCOPE_AGENT); }
__device__ __forceinline__ unsigned xb_add(unsigned* p, unsigned v) { return __hip_atomic_fetch_add(p, v, __ATOMIC_RELAXED, __HIP_MEMORY_SCOPE_AGENT); }
__device__ __forceinline__ unsigned xb_xcc_id() { return (unsigned)__builtin_amdgcn_s_getreg((3 << 11) | 20) & 0xFu; }
#define XB_SPIN(cond, bar) do { unsigned _sp = 0; while (cond) { __builtin_amdgcn_s_sleep(1); \
    if ((++_sp & 255u) == 0u) { if (xb_ld(&(bar)[XB_TMO])) break; if (_sp > XB_SPIN_CAP) { atomicAdd(&(bar)[XB_TMO], 1u); break; } } } } while (0)

struct XcdBarrier {
    unsigned* bar; unsigned x;
    volatile LAS unsigned* st;
};

__device__ __forceinline__ XcdBarrier xcd_barrier_post(unsigned* bar, volatile LAS unsigned* st) {
    XcdBarrier b; b.bar = bar; b.x = xb_xcc_id(); b.st = st;
    if (tidx() == 0) (void)xb_add(&bar[XB_XCNT(b.x)], 1u);
    return b;
}
__device__ __forceinline__ void xcd_barrier_complete(unsigned* bar, unsigned x, unsigned& nloc, unsigned& nx) {
    const unsigned G = gridDim.x * gridDim.y * gridDim.z;
    unsigned sum, cnt, mine, sp = 0u;
    for (;;) {
        sum = 0u; cnt = 0u; mine = 0u;
#pragma unroll
        for (unsigned j = 0; j < 16; ++j) { const unsigned c = xb_ld(&bar[XB_XCNT(j)]); sum += c; cnt += (c > 0u) ? 1u : 0u; mine = (j == x) ? c : mine; }
        if (sum == G) break;
        __builtin_amdgcn_s_sleep(1);
        if ((++sp & 255u) == 0u) { if (xb_ld(&bar[XB_TMO])) break; if (sp > XB_SPIN_CAP) { atomicAdd(&bar[XB_TMO], 1u); break; } }
    }
    nloc = mine > 0u ? mine : 1u; nx = cnt > 0u ? cnt : 1u;
}

__device__ __forceinline__ void xcd_barrier(const XcdBarrier& b) {
    asm volatile("s_waitcnt vmcnt(0)" ::: "memory");
    __syncthreads();
    if (tidx() == 0) {
        unsigned* bar = b.bar;
        __builtin_amdgcn_s_waitcnt(0);
        unsigned nloc = b.st[0], nx = b.st[1];
        if (nloc == 0u) { xcd_barrier_complete(bar, b.x, nloc, nx); b.st[0] = nloc; b.st[1] = nx; }
        const unsigned old = xb_add(&bar[XB_XSUB(b.x)], 1u);
        const unsigned gen = old / nloc;
        if (old + 1u == (gen + 1u) * nloc) {
            __builtin_amdgcn_fence(__ATOMIC_RELEASE, "agent");
            asm volatile("s_waitcnt vmcnt(0)" ::: "memory");
            const unsigned og = xb_add(&bar[XB_TOP], 1u);
            const unsigned tg = og / nx;
            if (og + 1u == (tg + 1u) * nx) xb_add(&bar[XB_TOPGEN], 1u);
            else XB_SPIN(xb_ld(&bar[XB_TOPGEN]) == tg, bar);
            __builtin_amdgcn_fence(__ATOMIC_ACQUIRE, "agent");
            xb_add(&bar[XB_XGEN(b.x)], 1u);
            asm volatile("s_waitcnt vmcnt(0)" ::: "memory");
        } else {
            XB_SPIN(xb_ld(&bar[XB_XGEN(b.x)]) == gen, bar);
            __builtin_amdgcn_fence(__ATOMIC_ACQUIRE, "agent");
            asm volatile("s_waitcnt vmcnt(0)" ::: "memory");
        }
    }
    __syncthreads();
}

typedef const __attribute__((address_space(4))) P* kargP_t;
__device__ __forceinline__ P load_params() {
  kargP_t q = (kargP_t)__builtin_amdgcn_kernarg_segment_ptr();
  asm volatile("" : "+s"(q));
  P r;
  r.x = q->x;
  r.c = q->c;
  r.ctx = q->ctx;
  r.c_ctx = q->c_ctx;
  r.w_ada = q->w_ada;
  r.b_ada = q->b_ada;
  r.norm1_g = q->norm1_g;
  r.norm2_g = q->norm2_g;
  r.w_in = q->w_in;
  r.s5_a_re = q->s5_a_re;
  r.s5_a_im = q->s5_a_im;
  r.s5_log_dt = q->s5_log_dt;
  r.s5_b_re = q->s5_b_re;
  r.s5_b_im = q->s5_b_im;
  r.s5_c_re = q->s5_c_re;
  r.s5_c_im = q->s5_c_im;
  r.s5_d = q->s5_d;
  r.s5_w_glu = q->s5_w_glu;
  r.s5_b_glu = q->s5_b_glu;
  r.rw_mu = q->rw_mu;
  r.rw_w0 = q->rw_w0;
  r.rw_w_w2 = q->rw_w_w2;
  r.rw_a0 = q->rw_a0;
  r.rw_w_a2 = q->rw_w_a2;
  r.rw_w_g2 = q->rw_w_g2;
  r.rw_k_k = q->rw_k_k;
  r.rw_k_a = q->rw_k_a;
  r.rw_r_k = q->rw_r_k;
  r.rw_ln_w = q->rw_ln_w;
  r.rw_ln_b = q->rw_ln_b;
  r.w_out = q->w_out;
  r.peer_w_q = q->peer_w_q;
  r.peer_keys = q->peer_keys;
  r.peer_u = q->peer_u;
  r.peer_v = q->peer_v;
  r.norm_f_g = q->norm_f_g;
  r.out = q->out;
  r.ws = q->ws;
  return r;
}
#define NPHASES 11
template <int PH>
__device__ __forceinline__ void run_phase(const P& p, char* smem, int bid, int nb, bool rep = false) {
  if (PH == 0) ph_prep(p, smem, bid, nb);
  if (PH == 1) ph_norm(p, 0, bid, nb);
  if (PH == 2) {
    pg8::StaticOrder S; S.init(NTOK, INCP, nb, bid);
    pg8::gemm_phase<pg8::EpiProjT, pg8::StaticOrder, false>((PG8_LAS unsigned char*)smem, pg8::Gemm{p.hn(), p.win_t(), NTOK, INCP, 1024}, S, pg8::EpiProjT{p.proj(), INC, INC}, nullptr);
  }
  if (PH == 3) { ph_s5scan2(p, smem, bid, nb); ph_rwscan2(p, smem, bid, nb); }
  if (PH == 4) ph_mixprep(p, bid, nb, rep ? p.hn() : p.ys5f(), rep ? p.hn() + (size_t)NLAT * 512 : p.yrwf());
  if (PH == 5) {
    {
      pg8::StaticOrder S; S.init(NLAT, 512, nb, bid);
      pg8::gemm_phase<pg8::EpiGluT, pg8::StaticOrder, false>((PG8_LAS unsigned char*)smem, pg8::Gemm{p.ys5f(), p.wglu_t(), NLAT, 512, 512}, S, pg8::EpiGluT{p.ys5f(), p.s5_b_glu, p.hn()}, nullptr);
    }
    {
      pg8::StaticOrder S; S.init(NLAT, 512, nb, bid);
      pg8::gemm_phase<pg8::EpiGateT, pg8::StaticOrder, false>((PG8_LAS unsigned char*)smem, pg8::Gemm{p.sg(), p.wg2_t(), NLAT, 512, 256}, S, pg8::EpiGateT{p.yrwf(), p.hn()}, nullptr);
    }
  }
  if (PH == 6) {
    pg8::StaticOrder S; S.init(NLAT, 1024, nb, bid);
    pg8::gemm_phase<pg8::EpiWoutT, pg8::StaticOrder, false>((PG8_LAS unsigned char*)smem, pg8::Gemm{p.hn(), p.wout_t(), NLAT, 1024, 1024}, S, pg8::EpiWoutT{p.x, p.mod(), (pg8::bf16_t*)p.out}, nullptr);
  }
  if (PH == 7) ph_norm(p, 1, bid, nb);
  if (PH == 8) {
    pg8::StaticOrder S; S.init(NLAT, 2048, nb, bid);
    pg8::gemm_phase<pg8::EpiProjT, pg8::StaticOrder, false>((PG8_LAS unsigned char*)smem, pg8::Gemm{p.hn(), p.wq_t(), NLAT, 2048, 1024}, S, pg8::EpiProjT{p.proj(), 2048, 2048}, nullptr);
  }
  if (PH == 9) ph_route(p, smem, bid, nb);
  if (PH == 10) ph_ffn(p, rep ? (float*)p.proj() : p.out, smem, bid, nb);
  if (PH == 11) ph_s5scan2(p, smem, bid, nb);
  if (PH == 12) ph_rwscan2(p, smem, bid, nb);
}
#ifndef REPMASK
#define REPMASK 0
#endif
#define REP(n) ((REPMASK >> (n)) & 1)
#define PHASE(n) if (ph_lo <= n && n < ph_hi) { if (n > ph_lo) { if (n == 1) grid.sync(); else xcd_barrier(xb); } if (REP(n)) { { const P lp_ = load_params(); run_phase<n>(lp_, smem, bid, nb, true); } __syncthreads(); } if (n == 3 && REP(11)) { run_phase<11>(p, smem, bid, nb); __syncthreads(); } if (n == 3 && REP(12)) { run_phase<12>(p, smem, bid, nb); __syncthreads(); } { const P lp_ = load_params(); run_phase<n>(lp_, smem, bid, nb); } }
__global__ void __launch_bounds__(NTHREADS) mega(P p, int ph_lo, int ph_hi) {
  char* smem = g_smem;
  if ((threadIdx.x & 63) == 0) *(int*)(g_smem + WAVETAB_OFF + 4 * hw_slot()) = (int)(threadIdx.x >> 6);
  cg::grid_group grid = cg::this_grid();
  const int bid = blockIdx.x, nb = gridDim.x;
  volatile LAS unsigned* xst = (volatile LAS unsigned*)(smem + LDS_BYTES - 16);
  if (threadIdx.x == 0) { xst[0] = 0u; xst[1] = 0u; }
  __syncthreads();
  XcdBarrier xb;
  {
    const P lp0 = load_params();
    xb.bar = lp0.bar(); xb.x = 0; xb.st = xst;
    if (ph_hi - ph_lo > 1) xb = xcd_barrier_post(lp0.bar(), xst);
  }
  PHASE(0) PHASE(1) PHASE(2) PHASE(3) PHASE(4) PHASE(5) PHASE(6) PHASE(7) PHASE(8) PHASE(9) PHASE(10)
}

extern "C" void kernel_launch(void* const* d_in, const int* in_sizes, int n_in, void* d_out, int out_size, void* d_ws,
                              size_t ws_size, hipStream_t stream) {
  static int grid_blocks = 0;
  if (!grid_blocks) {
    int dev = 0, cus = 0, per_cu = 0;
    hipGetDevice(&dev);
    hipDeviceGetAttribute(&cus, hipDeviceAttributeMultiprocessorCount, dev);
    hipFuncSetAttribute((const void*)mega, hipFuncAttributeMaxDynamicSharedMemorySize, LDS_BYTES);
    hipOccupancyMaxActiveBlocksPerMultiprocessor(&per_cu, (const void*)mega, NTHREADS, LDS_BYTES);
    if (per_cu < 1) { fprintf(stderr, "occupancy query returned %d\n", per_cu); per_cu = 1; }
    grid_blocks = cus;
  }
  P p{};
  const float** fp = (const float**)&p;
  for (int i = 0; i < 36; ++i) fp[i] = (const float*)d_in[i];
  p.out = (float*)d_out;
  p.ws = (char*)d_ws;
  if (WS_TOTAL > ws_size) { fprintf(stderr, "workspace too small: need %zu have %zu\n", (size_t)WS_TOTAL, ws_size); return; }
#if MEGA
  if (hipMemsetAsync((char*)d_ws + OFF_bar, 0, XCD_BAR_WORDS * 4, stream) != hipSuccess) fprintf(stderr, "memset of barrier words failed\n");
  int lo = 0, hi = NPHASES;
  void* args[] = {&p, &lo, &hi};
  hipError_t e = hipLaunchCooperativeKernel((const void*)mega, dim3(grid_blocks), dim3(NTHREADS), args, LDS_BYTES, stream);
  if (e != hipSuccess) fprintf(stderr, "cooperative launch failed: %s (grid %d)\n", hipGetErrorString(e), grid_blocks);
#else
  for (int ph = 0; ph < NPHASES; ++ph) {
    hipLaunchKernelGGL(mega, dim3(grid_blocks), dim3(NTHREADS), LDS_BYTES, stream, p, ph, ph + 1);
  }
#endif
}
```

```cpp
#include <hip/hip_runtime.h>
#include <hip/hip_cooperative_groups.h>
#include <stdint.h>
#include <stdio.h>
namespace cg = cooperative_groups;

#ifndef MEGA
#define MEGA 1
#endif

typedef unsigned short u16;
using bf16x8 = __attribute__((ext_vector_type(8))) short;
using f32x4 = __attribute__((ext_vector_type(4))) float;
using u32x4 = __attribute__((ext_vector_type(4))) unsigned;
using f32x16 = __attribute__((ext_vector_type(16))) float;

#define DM 1024
#define NLAT 65536
#define NCTX 8192
#define NTOK 73728
#define INC 2208
#define INCP 2304
#define NTHREADS 512
#define LDS_BYTES 163840

#define INC_FWD 1
constexpr size_t ws_al(size_t x) { return (x + 255) & ~(size_t)255; }
constexpr size_t OFF_mod = 0;
constexpr size_t OFF_win_t = OFF_mod + ws_al(33 * 6144 * 4);
constexpr size_t OFF_wout_t = OFF_win_t + ws_al((size_t)2304 * 1024 * 2);
constexpr size_t OFF_wq_t = OFF_wout_t + ws_al((size_t)1024 * 1024 * 2);
constexpr size_t OFF_wglu_t = OFF_wq_t + ws_al((size_t)2048 * 1024 * 2);
constexpr size_t OFF_wg2_t = OFF_wglu_t + ws_al((size_t)512 * 512 * 2);
constexpr size_t OFF_keys = OFF_wg2_t + ws_al((size_t)512 * 256 * 2);
constexpr size_t OFF_utab = OFF_keys + ws_al((size_t)8 * 2 * 128 * 128 * 2);
constexpr size_t OFF_usc = OFF_utab + ws_al((size_t)16384 * 1024);
constexpr size_t OFF_vsc = OFF_usc + ws_al(16384 * 4);
constexpr size_t OFF_s5ab = OFF_vsc + ws_al(16384 * 4);
constexpr size_t OFF_s5bb = OFF_s5ab + ws_al(4096 * 2 * 4);
constexpr size_t OFF_s5ct = OFF_s5bb + ws_al(4096 * 32 * 4);
constexpr size_t OFF_hn = OFF_s5ct + ws_al(2 * 32 * 16 * 128 * 2);
constexpr size_t OFF_proj = OFF_hn + ws_al((size_t)73728 * 1024 * 2);
constexpr size_t OFF_ys5f = OFF_proj + ws_al((size_t)73728 * 2208 * 2);
constexpr size_t OFF_ys5b = OFF_ys5f + ws_al((size_t)65536 * 512 * 2);
constexpr size_t OFF_yrwf = OFF_ys5b + ws_al((size_t)65536 * 512 * 2);
constexpr size_t OFF_yrwb = OFF_yrwf + ws_al((size_t)65536 * 512 * 2);
constexpr size_t OFF_bsc = OFF_yrwb + ws_al((size_t)65536 * 512 * 2);
constexpr size_t OFF_sg = OFF_bsc + ws_al((size_t)2 * 65536 * 8 * 4);
constexpr size_t OFF_bar = OFF_sg + ws_al((size_t)65536 * 256 * 2);
constexpr size_t OFF_wlf = OFF_bar + ws_al(3456 * 4);
constexpr size_t WS_TOTAL = OFF_wlf + ws_al(2 * 4096 * 16);

extern __shared__ __attribute__((aligned(16))) char g_smem[];
#define WAVETAB_OFF (LDS_BYTES - 16 - 256)
__device__ __forceinline__ int hw_slot() { return (int)(__builtin_amdgcn_s_getreg((5 << 11) | 4) & 63u); }
__device__ __forceinline__ int tidx() {
  const int w = *(const int*)(g_smem + WAVETAB_OFF + 4 * hw_slot());
  return __builtin_amdgcn_readfirstlane(w) * 64 + (int)__builtin_amdgcn_mbcnt_hi(~0u, __builtin_amdgcn_mbcnt_lo(~0u, 0u));
}
__device__ __forceinline__ int widx() { return __builtin_amdgcn_readfirstlane(*(const int*)(g_smem + WAVETAB_OFF + 4 * hw_slot())); }
__device__ __forceinline__ int lidx() { return (int)__builtin_amdgcn_mbcnt_hi(~0u, __builtin_amdgcn_mbcnt_lo(~0u, 0u)); }
struct P {
  const float *x, *c, *ctx, *c_ctx, *w_ada, *b_ada, *norm1_g, *norm2_g, *w_in, *s5_a_re, *s5_a_im, *s5_log_dt,
      *s5_b_re, *s5_b_im, *s5_c_re, *s5_c_im, *s5_d, *s5_w_glu, *s5_b_glu, *rw_mu, *rw_w0, *rw_w_w2, *rw_a0, *rw_w_a2,
      *rw_w_g2, *rw_k_k, *rw_k_a, *rw_r_k, *rw_ln_w, *rw_ln_b, *w_out, *peer_w_q, *peer_keys, *peer_u, *peer_v, *norm_f_g;
  float* out;
  char* ws;
  __device__ __forceinline__ float* mod() const { return (float*)(ws + OFF_mod); }
  __device__ __forceinline__ u16* win_t() const { return (u16*)(ws + OFF_win_t); }
  __device__ __forceinline__ u16* wout_t() const { return (u16*)(ws + OFF_wout_t); }
  __device__ __forceinline__ u16* wq_t() const { return (u16*)(ws + OFF_wq_t); }
  __device__ __forceinline__ u16* wglu_t() const { return (u16*)(ws + OFF_wglu_t); }
  __device__ __forceinline__ u16* wg2_t() const { return (u16*)(ws + OFF_wg2_t); }
  __device__ __forceinline__ u16* keys() const { return (u16*)(ws + OFF_keys); }
  __device__ __forceinline__ unsigned char* utab() const { return (unsigned char*)(ws + OFF_utab); }
  __device__ __forceinline__ float* usc() const { return (float*)(ws + OFF_usc); }
  __device__ __forceinline__ float* vsc() const { return (float*)(ws + OFF_vsc); }
  __device__ __forceinline__ float* s5ab() const { return (float*)(ws + OFF_s5ab); }
  __device__ __forceinline__ float* s5bb() const { return (float*)(ws + OFF_s5bb); }
  __device__ __forceinline__ u16* s5ct() const { return (u16*)(ws + OFF_s5ct); }
  __device__ __forceinline__ u16* hn() const { return (u16*)(ws + OFF_hn); }
  __device__ __forceinline__ u16* proj() const { return (u16*)(ws + OFF_proj); }
  __device__ __forceinline__ u16* ys5f() const { return (u16*)(ws + OFF_ys5f); }
  __device__ __forceinline__ u16* ys5b() const { return (u16*)(ws + OFF_ys5b); }
  __device__ __forceinline__ u16* yrwf() const { return (u16*)(ws + OFF_yrwf); }
  __device__ __forceinline__ u16* yrwb() const { return (u16*)(ws + OFF_yrwb); }
  __device__ __forceinline__ float* bsc() const { return (float*)(ws + OFF_bsc); }
  __device__ __forceinline__ u16* sg() const { return (u16*)(ws + OFF_sg); }
  __device__ __forceinline__ unsigned* bar() const { return (unsigned*)(ws + OFF_bar); }
  __device__ __forceinline__ u16* wlf() const { return (u16*)(ws + OFF_wlf); }
  __device__ __forceinline__ unsigned char* vtab() const { return utab() + 512; }
  __device__ __forceinline__ int* idx() const { return (int*)ys5b(); }
  __device__ __forceinline__ float* gate() const { return (float*)yrwb(); }
};

typedef float f32x2_t __attribute__((ext_vector_type(2)));
typedef __bf16 bf16x2_t __attribute__((ext_vector_type(2)));
__device__ __forceinline__ unsigned pack2(float a, float b) {
  f32x2_t v = {a, b};
  return __builtin_bit_cast(unsigned, __builtin_convertvector(v, bf16x2_t));
}
__device__ __forceinline__ u16 f2bf(float f) { return __builtin_bit_cast(u16, (__bf16)f); }
__device__ __forceinline__ float bf2f(u16 h) { return __uint_as_float(((unsigned)h) << 16); }
__device__ __forceinline__ float bflo(unsigned u) { return __uint_as_float(u << 16); }
__device__ __forceinline__ float bfhi(unsigned u) { return __uint_as_float(u & 0xffff0000u); }
__device__ __forceinline__ float wave_sum(float v) {
#pragma unroll
  for (int m = 32; m >= 1; m >>= 1) v += __shfl_xor(v, m, 64);
  return v;
}
__device__ __forceinline__ float gelu_exact(float x) { return 0.5f * x * (1.f + erff(x * 0.70710678118654752f)); }
__device__ __forceinline__ float gelu_as(float v) {
  const float av = fabsf(v), t = __builtin_amdgcn_rcpf(av * 0.2316418882f + 1.0f);
  float q = t * 0.5307027145f + (-0.7265760135f);
  q = q * t + 0.7107068705f; q = q * t + (-0.142248368f); q = q * t + 0.127414796f; q = q * t;
  const float e = __builtin_amdgcn_exp2f((v * v) * (-0.72134752044f));
  const float m = v * (q * e);
  return v < 0.f ? m : v - m;
}
__device__ __forceinline__ float sigmoidf(float x) { return 1.f / (1.f + __expf(-x)); }


typedef float v2f __attribute__((ext_vector_type(2)));
__device__ __forceinline__ float dpp_add(float v, const int ctrl, const int rmask) {
  int m;
  switch (ctrl) {
    case 0: m = __builtin_amdgcn_update_dpp(0, __float_as_int(v), 0xB1, 0xf, 0xf, true); break;
    case 1: m = __builtin_amdgcn_update_dpp(0, __float_as_int(v), 0x4E, 0xf, 0xf, true); break;
    case 2: m = __builtin_amdgcn_update_dpp(0, __float_as_int(v), 0x141, 0xf, 0xf, true); break;
    case 3: m = __builtin_amdgcn_update_dpp(0, __float_as_int(v), 0x140, 0xf, 0xf, true); break;
    case 4: m = __builtin_amdgcn_update_dpp(0, __float_as_int(v), 0x142, 0xa, 0xf, false); break;
    default: m = __builtin_amdgcn_update_dpp(0, __float_as_int(v), 0x143, 0xc, 0xf, false); break;
  }
  return v + __int_as_float(m);
}
__device__ __forceinline__ float wave_sum_u(float v) {
  v = dpp_add(v, 0, 0); v = dpp_add(v, 1, 0); v = dpp_add(v, 2, 0); v = dpp_add(v, 3, 0);
  v = dpp_add(v, 4, 0); v = dpp_add(v, 5, 0);
  return __int_as_float(__builtin_amdgcn_readlane(__float_as_int(v), 63));
}
__device__ __forceinline__ void convert_fp4_rows(const float* __restrict__ src, unsigned char* __restrict__ dst, float* __restrict__ sc,
                                                 int nrows, int bid, int nb) {
  const int wid = tidx() >> 6, lane = tidx() & 63;
  const int stride = nb * 8;
  for (int row0 = bid * 8 + wid; row0 < nrows; row0 += 4 * stride) {
    float4 v[4][4];
#pragma unroll
    for (int u = 0; u < 4; ++u) {
      int row = row0 + u * stride;
      if (row >= nrows) row = row0;
#pragma unroll
      for (int q = 0; q < 4; ++q) v[u][q] = *(const float4*)(src + (size_t)row * 1024 + lane * 16 + q * 4);
    }
#pragma unroll
    for (int u = 0; u < 4; ++u) {
      const int row = row0 + u * stride;
      if (row >= nrows) continue;
      float am = 0.f;
#pragma unroll
      for (int q = 0; q < 4; ++q)
        am = fmaxf(am, fmaxf(fmaxf(fabsf(v[u][q].x), fabsf(v[u][q].y)), fmaxf(fabsf(v[u][q].z), fabsf(v[u][q].w))));
#pragma unroll
      for (int m = 32; m >= 1; m >>= 1) am = fmaxf(am, __shfl_xor(am, m, 64));
      const float scl = am > 0.f ? 6.f / am : 1.f;
      unsigned w0 = 0u, w1 = 0u;
      w0 = __builtin_amdgcn_cvt_scalef32_pk_fp4_f32(w0, v[u][0].x * scl, v[u][0].y * scl, 1.0f, 0);
      w0 = __builtin_amdgcn_cvt_scalef32_pk_fp4_f32(w0, v[u][0].z * scl, v[u][0].w * scl, 1.0f, 1);
      w0 = __builtin_amdgcn_cvt_scalef32_pk_fp4_f32(w0, v[u][1].x * scl, v[u][1].y * scl, 1.0f, 2);
      w0 = __builtin_amdgcn_cvt_scalef32_pk_fp4_f32(w0, v[u][1].z * scl, v[u][1].w * scl, 1.0f, 3);
      w1 = __builtin_amdgcn_cvt_scalef32_pk_fp4_f32(w1, v[u][2].x * scl, v[u][2].y * scl, 1.0f, 0);
      w1 = __builtin_amdgcn_cvt_scalef32_pk_fp4_f32(w1, v[u][2].z * scl, v[u][2].w * scl, 1.0f, 1);
      w1 = __builtin_amdgcn_cvt_scalef32_pk_fp4_f32(w1, v[u][3].x * scl, v[u][3].y * scl, 1.0f, 2);
      w1 = __builtin_amdgcn_cvt_scalef32_pk_fp4_f32(w1, v[u][3].z * scl, v[u][3].w * scl, 1.0f, 3);
      *(uint2*)(dst + (size_t)row * 1024 + lane * 8) = make_uint2(w0, w1);
      if (lane == 0) sc[row] = am > 0.f ? am / 6.f : 1.f;
    }
  }
}

__device__ __forceinline__ void transpose_tiles(const float* __restrict__ src, int K, int N, u16* __restrict__ dst, int Kd, int Npad,
                                char* smem, int bid, int nb) {
  float* tile = (float*)smem;
  const int tid = tidx();
  const int nkt = Kd / 64, nnt = Npad / 64;
  for (int t = bid; t < nkt * nnt; t += nb) {
    int kt = t % nkt, nt = t / nkt;
    int k0 = kt * 64, n0 = nt * 64;
    __syncthreads();
#pragma unroll
    for (int it = 0; it < 8; ++it) {
      int i = (tid >> 6) + it * 8, j = tid & 63;
      int k = k0 + i, n = n0 + j;
      tile[i * 65 + j] = (k < K && n < N) ? src[(size_t)k * N + n] : 0.f;
    }
    __syncthreads();
    int n = tid >> 3, kc = (tid & 7) * 8;
    uint4 o;
    o.x = pack2(tile[(kc + 0) * 65 + n], tile[(kc + 1) * 65 + n]);
    o.y = pack2(tile[(kc + 2) * 65 + n], tile[(kc + 3) * 65 + n]);
    o.z = pack2(tile[(kc + 4) * 65 + n], tile[(kc + 5) * 65 + n]);
    o.w = pack2(tile[(kc + 6) * 65 + n], tile[(kc + 7) * 65 + n]);
    *(uint4*)(dst + (size_t)(n0 + n) * Kd + k0 + kc) = o;
  }
}

__device__ __forceinline__ void convert_bf16(const float* __restrict__ src, u16* __restrict__ dst, size_t n8, int bid, int nb) {
  for (size_t i = (size_t)bid * NTHREADS + tidx(); i < n8; i += (size_t)nb * NTHREADS) {
    float4 a = *(const float4*)(src + i * 8), b = *(const float4*)(src + i * 8 + 4);
    uint4 o;
    o.x = pack2(a.x, a.y); o.y = pack2(a.z, a.w); o.z = pack2(b.x, b.y); o.w = pack2(b.z, b.w);
    *(uint4*)(dst + i * 8) = o;
  }
}

__device__ __forceinline__ void ph_prep(const P& p, char* smem, int bid, int nb) {
  const int tid = tidx();
  {
    float* sc = (float*)smem;
    float* red = (float*)(smem + 33 * 256 * 4);
    for (int item = bid; item < 192; item += nb) {
      const int j0 = item * 32, kg = tid >> 5, col = tid & 31;
      float acc[33];
#pragma unroll
      for (int b = 0; b < 33; ++b) acc[b] = 0.f;
      for (int ch = 0; ch < 4; ++ch) {
        __syncthreads();
        for (int e = tid; e < 33 * 256; e += NTHREADS) {
          int b = e >> 8, kk = e & 255;
          float cv = (b < 32) ? p.c[b * 1024 + ch * 256 + kk] : p.c_ctx[ch * 256 + kk];
          sc[e] = cv / (1.f + expf(-cv));
        }
        float w[16];
#pragma unroll
        for (int i = 0; i < 16; ++i) w[i] = p.w_ada[(size_t)(ch * 256 + kg * 16 + i) * 6144 + j0 + col];
        __syncthreads();
#pragma unroll
        for (int i = 0; i < 16; ++i) {
          const int kk = kg * 16 + i;
#pragma unroll
          for (int b = 0; b < 33; ++b) acc[b] += sc[b * 256 + kk] * w[i];
        }
      }
#pragma unroll
      for (int b = 0; b < 33; ++b) red[(kg * 33 + b) * 32 + col] = acc[b];
      __syncthreads();
      for (int e = tid; e < 33 * 32; e += NTHREADS) {
        int b = e >> 5, cc = e & 31;
        float sv = p.b_ada[j0 + cc];
#pragma unroll
        for (int k2 = 0; k2 < 16; ++k2) sv += red[(k2 * 33 + b) * 32 + cc];
        p.mod()[b * 6144 + j0 + cc] = sv;
      }
      __syncthreads();
    }
  }
  transpose_tiles(p.w_in, 1024, INC, p.win_t(), 1024, INCP, smem, bid, nb);
  transpose_tiles(p.w_out, 1024, 1024, p.wout_t(), 1024, 1024, smem, bid, nb);
  transpose_tiles(p.peer_w_q, 1024, 2048, p.wq_t(), 1024, 2048, smem, bid, nb);
  transpose_tiles(p.s5_w_glu, 512, 512, p.wglu_t(), 512, 512, smem, bid, nb);
  transpose_tiles(p.rw_w_g2, 96, 512, p.wg2_t(), 256, 512, smem, bid, nb);
  convert_bf16(p.peer_keys, p.keys(), (size_t)8 * 2 * 128 * 128 / 8, bid, nb);
  convert_fp4_rows(p.peer_u, p.utab(), p.usc(), 16384, bid, nb);
  convert_fp4_rows(p.peer_v, p.vtab(), p.vsc(), 16384, bid, nb);
  for (int it = bid * NTHREADS + tid; it < 2 * 4096; it += nb * NTHREADS) {
    const int ln = it & 63, mt = (it >> 6) & 3, hh_ = (it >> 8) & 7, dd = (it >> 11) & 1, mm = it >> 12;
    const int tt = ln & 15, kq_ = ln >> 4;
    const float* W = mm ? p.rw_w_a2 : p.rw_w_w2;
    unsigned o[4];
#pragma unroll
    for (int q = 0; q < 4; ++q) {
      const size_t o0 = (size_t)(dd * 32 + 8 * kq_ + 2 * q) * 512 + hh_ * 64 + 16 * (tt >> 2) + 4 * mt + (tt & 3);
      o[q] = pack2(W[o0], W[o0 + 512]);
    }
    *(uint4*)(p.wlf() + (size_t)it * 8) = make_uint4(o[0], o[1], o[2], o[3]);
  }
  for (int it = bid * NTHREADS + tid; it < 4096; it += nb * NTHREADS) {
    int pp = it & 63, g = (it >> 6) & 31, d = it >> 11;
    float are = p.s5_a_re[it], aim = p.s5_a_im[it];
    float dt = expf(p.s5_log_dt[d * 32 + g]);
    float mag = expf(dt * are);
    float abr = mag * cosf(dt * aim), abi = mag * sinf(dt * aim);
    float nr = abr - 1.f, ni = abi;
    float den = are * are + aim * aim;
    float cfr = (nr * are + ni * aim) / den, cfi = (ni * are - nr * aim) / den;
    p.s5ab()[it * 2] = abr;
    p.s5ab()[it * 2 + 1] = abi;
    for (int h = 0; h < 16; ++h) {
      float br = p.s5_b_re[(size_t)it * 16 + h], bi = p.s5_b_im[(size_t)it * 16 + h];
      p.s5bb()[(size_t)it * 32 + h] = cfr * br - cfi * bi;
      p.s5bb()[(size_t)it * 32 + 16 + h] = cfr * bi + cfi * br;
    }
    for (int h = 0; h < 16; ++h) {
      size_t ci = ((size_t)(d * 32 + g) * 16 + h) * 64 + pp;
      p.s5ct()[((size_t)(d * 32 + g) * 16 + h) * 128 + 2 * pp] = f2bf(p.s5_c_re[ci]);
      p.s5ct()[((size_t)(d * 32 + g) * 16 + h) * 128 + 2 * pp + 1] = f2bf(-p.s5_c_im[ci]);
    }
  }
}

__device__ __forceinline__ void ph_norm(const P& p, int mode, int bid, int nb) {
  const int wid = tidx() >> 6, lane = tidx() & 63;
  const int nrows = mode == 0 ? NTOK : NLAT;
  const float* gvec = mode == 0 ? p.norm1_g : p.norm2_g;
  const int sh_off = mode == 0 ? 0 : 3 * 1024, sc_off = sh_off + 1024;
  const int stride = nb * 8;
  for (int row0 = bid * 8 + wid; row0 < nrows; row0 += 4 * stride) {
    float4 v[4][4];
    int bs[4];
#pragma unroll
    for (int u = 0; u < 4; ++u) {
      int row = row0 + u * stride;
      if (row >= nrows) row = row0;
      const float* src;
      if (mode == 0) {
        if (row < NLAT) { src = p.x + (size_t)row * 1024; bs[u] = row >> 11; }
        else { src = p.ctx + (size_t)(row - NLAT) * 1024; bs[u] = 32; }
      } else { src = nullptr; bs[u] = row >> 11; }
      if (mode == 0) {
#pragma unroll
        for (int j = 0; j < 2; ++j) {
          v[u][2 * j] = *(const float4*)(src + j * 512 + lane * 8);
          v[u][2 * j + 1] = *(const float4*)(src + j * 512 + lane * 8 + 4);
        }
      } else {
        const u16* s16 = (const u16*)p.out + (size_t)row * 2048 + 1024;
#pragma unroll
        for (int j = 0; j < 2; ++j) {
          const uint4 q = *(const uint4*)(s16 + j * 512 + lane * 8);
          v[u][2 * j] = make_float4(bflo(q.x), bfhi(q.x), bflo(q.y), bfhi(q.y));
          v[u][2 * j + 1] = make_float4(bflo(q.z), bfhi(q.z), bflo(q.w), bfhi(q.w));
        }
      }
    }
#pragma unroll
    for (int u = 0; u < 4; ++u) {
      const int row = row0 + u * stride;
      if (row >= nrows) continue;
      float ss = 0.f;
#pragma unroll
      for (int j = 0; j < 4; ++j) ss += v[u][j].x * v[u][j].x + v[u][j].y * v[u][j].y + v[u][j].z * v[u][j].z + v[u][j].w * v[u][j].w;
      ss = wave_sum_u(ss);
      const float rstd = rsqrtf(ss * (1.f / 1024.f) + 1e-6f);
      const float* mrow = p.mod() + bs[u] * 6144;
#pragma unroll
      for (int j = 0; j < 2; ++j) {
        const int col = j * 512 + lane * 8;
        unsigned o[4];
#pragma unroll
        for (int hq = 0; hq < 2; ++hq) {
          const float4 x = v[u][2 * j + hq];
          const float4 g = *(const float4*)(gvec + col + 4 * hq);
          const float4 sh = *(const float4*)(mrow + sh_off + col + 4 * hq);
          const float4 sc = *(const float4*)(mrow + sc_off + col + 4 * hq);
          o[2 * hq] = pack2(x.x * rstd * g.x * (1.f + sc.x) + sh.x, x.y * rstd * g.y * (1.f + sc.y) + sh.y);
          o[2 * hq + 1] = pack2(x.z * rstd * g.z * (1.f + sc.z) + sh.z, x.w * rstd * g.w * (1.f + sc.w) + sh.w);
        }
        *(uint4*)(p.hn() + (size_t)row * 1024 + col) = make_uint4(o[0], o[1], o[2], o[3]);
      }
    }
  }
}

#define G_BM 256
#define G_BN 128
#define G_BK 64
#define G_LD 72
template <class Epi>
__device__ __forceinline__ void gemm_simple(const u16* __restrict__ A, int lda, const u16* __restrict__ Bt, int ldb, int K, int M, int N,
                           char* smem, int bid, int nb, Epi epi) {
  u16* As = (u16*)smem;
  u16* Bs = (u16*)(smem + 2 * G_BM * G_LD * 2);
  const int tid = tidx(), wid = tid >> 6, lane = tid & 63;
  const int wr = wid >> 1, wc = wid & 1, fr = lane & 15, fq = lane >> 4;
  const int ntn = N / G_BN, ntiles = (M / G_BM) * ntn, nk = K / G_BK;
  const int lrow = tid >> 3, lkc = (tid & 7) * 8;
  for (int tile = bid; tile < ntiles; tile += nb) {
    const int m0 = (tile / ntn) * G_BM, n0 = (tile % ntn) * G_BN;
    f32x4 acc[4][4];
#pragma unroll
    for (int i = 0; i < 4; ++i)
#pragma unroll
      for (int j = 0; j < 4; ++j) acc[i][j] = (f32x4){0.f, 0.f, 0.f, 0.f};
    u32x4 ra[4], rb[2];
    const u16* Ag = A + (size_t)(m0 + lrow) * lda + lkc;
    const u16* Bg = Bt + (size_t)(n0 + lrow) * ldb + lkc;
#pragma unroll
    for (int i = 0; i < 4; ++i) ra[i] = *(const u32x4*)(Ag + (size_t)(64 * i) * lda);
#pragma unroll
    for (int i = 0; i < 2; ++i) rb[i] = *(const u32x4*)(Bg + (size_t)(64 * i) * ldb);
    __syncthreads();
#pragma unroll
    for (int i = 0; i < 4; ++i) *(u32x4*)(As + (lrow + 64 * i) * G_LD + lkc) = ra[i];
#pragma unroll
    for (int i = 0; i < 2; ++i) *(u32x4*)(Bs + (lrow + 64 * i) * G_LD + lkc) = rb[i];
    __syncthreads();
    for (int kt = 0; kt < nk; ++kt) {
      const int buf = kt & 1;
      if (kt + 1 < nk) {
#pragma unroll
        for (int i = 0; i < 4; ++i) ra[i] = *(const u32x4*)(Ag + (size_t)(64 * i) * lda + (kt + 1) * G_BK);
#pragma unroll
        for (int i = 0; i < 2; ++i) rb[i] = *(const u32x4*)(Bg + (size_t)(64 * i) * ldb + (kt + 1) * G_BK);
      }
      const u16* as = As + buf * (G_BM * G_LD);
      const u16* bs = Bs + buf * (G_BN * G_LD);
#pragma unroll
      for (int ks = 0; ks < 2; ++ks) {
        bf16x8 af[4], bfr[4];
#pragma unroll
        for (int mi = 0; mi < 4; ++mi) af[mi] = *(const bf16x8*)(as + (wr * 64 + mi * 16 + fr) * G_LD + ks * 32 + fq * 8);
#pragma unroll
        for (int ni = 0; ni < 4; ++ni) bfr[ni] = *(const bf16x8*)(bs + (wc * 64 + ni * 16 + fr) * G_LD + ks * 32 + fq * 8);
#pragma unroll
        for (int mi = 0; mi < 4; ++mi)
#pragma unroll
          for (int ni = 0; ni < 4; ++ni)
            acc[mi][ni] = __builtin_amdgcn_mfma_f32_16x16x32_bf16(af[mi], bfr[ni], acc[mi][ni], 0, 0, 0);
      }
      if (kt + 1 < nk) {
        u16* as2 = As + (buf ^ 1) * (G_BM * G_LD);
        u16* bs2 = Bs + (buf ^ 1) * (G_BN * G_LD);
#pragma unroll
        for (int i = 0; i < 4; ++i) *(u32x4*)(as2 + (lrow + 64 * i) * G_LD + lkc) = ra[i];
#pragma unroll
        for (int i = 0; i < 2; ++i) *(u32x4*)(bs2 + (lrow + 64 * i) * G_LD + lkc) = rb[i];
      }
      __syncthreads();
    }
#pragma unroll
    for (int mi = 0; mi < 4; ++mi)
#pragma unroll
      for (int ni = 0; ni < 4; ++ni) epi(m0 + wr * 64 + mi * 16 + fq * 4, n0 + wc * 64 + ni * 16 + fr, acc[mi][ni]);
  }
}

namespace pg8 {
#define PG8_LAS __attribute__((address_space(3)))
typedef unsigned short bf16_t;
typedef short bf16x8 __attribute__((ext_vector_type(8)));
typedef float f32x4 __attribute__((ext_vector_type(4)));
typedef unsigned u32x4 __attribute__((ext_vector_type(4)));
constexpr int BM = 256, BK = 64, HALF = 128, HTB = HALF * BK * 2  , STAGE_BYTES = 8 * HTB, NXCD = 8, WGM = 8;

__host__ __device__ __forceinline__ int lds_byte(int r, int c) { const int st = (r >> 4) * 2 + (c >> 5), rr = r & 15, cc = c & 31, ob = rr * 64 + cc * 2; return st * 1024 + (ob ^ (((ob >> 9) & 1) << 5)); }
__host__ __device__ __forceinline__ void stage_rc(int b, int& R, int& C) { const int st = b / 1024, sb = b % 1024, swz = sb ^ (((sb >> 9) & 1) << 5); R = (st >> 1) * 16 + swz / 64; C = (st & 1) * 32 + (swz % 64) / 2; }
__host__ __device__ __forceinline__ int perm32(int rho) { const int n = rho >> 4, i = rho & 15; return 8 * (i >> 2) + 4 * n + (i & 3); }

struct Unit { int pm, pn; };
struct Gemm { const bf16_t* A; const bf16_t* Bt; int M, N, K; };

struct StaticOrder {
    int nM, nN, nwg, G, c;
    __host__ __device__ void init(int M, int N, int G_, int c_) { nM = M / BM; nN = N / BM; nwg = nM * nN; G = G_; c = c_; }
    __host__ __device__ bool next(int i, Unit& u) const {
        const long L = (long)i * G + c; if (L >= nwg) return false;
        int wgid = (int)L; { const int q = nwg / NXCD, r = nwg % NXCD, xcd = wgid % NXCD, off = wgid / NXCD; wgid = (xcd < r ? xcd * (q + 1) : r * (q + 1) + (xcd - r) * q) + off; }
        const int nig = WGM * nN, gid = wgid / nig, fm = gid * WGM, gsz = (nM - fm) < WGM ? (nM - fm) : WGM;
        u.pm = fm + ((wgid % nig) % gsz); u.pn = (wgid % nig) / gsz; return true;
    }
    __device__ __forceinline__ void a_ready(const Unit&) const {}
    __device__ __forceinline__ void done(const Unit&) const {}
};
__device__ __forceinline__ unsigned cvt_pk_bf16(float lo, float hi) { return ::pack2(lo, hi); }
typedef float f32x2 __attribute__((ext_vector_type(2)));
template <class Epi, class Sched, bool STAMP = false>
__device__ __forceinline__ void gemm_phase(PG8_LAS unsigned char* lds, const Gemm g, const Sched& S, const Epi& E, unsigned long long* stamps) {
    const int tid = tidx(), wid = __builtin_amdgcn_readfirstlane(tid >> 6), lane = tid & 63, wr = wid >> 2, wc = wid & 3, fr = lane & 15, fq = lane >> 4;
    const int K = g.K, nt = K / BK;
    int ts_lo = 0, ts_hi = 0, nts = 0; const unsigned long long rt_entry = STAMP ? (unsigned long long)wall_clock64() : 0ull;
#define PG8_STAMP() do { if (STAMP && wid == 0 && nts < 64) { const unsigned long long _c = (unsigned long long)clock64(); \
        ts_lo = (lane == nts) ? (int)(unsigned)_c : ts_lo; ts_hi = (lane == nts) ? (int)(unsigned)(_c >> 32) : ts_hi; ++nts; } } while (0)
    PG8_STAMP();
    unsigned voffA[2], voffB[2];
#pragma unroll
    for (int i = 0; i < 2; ++i) { int R, C; stage_rc(tid * 16 + i * 8192, R, C); const int Rb = Epi::PERM ? ((R & ~31) + perm32(R & 31)) : R;
        voffA[i] = (unsigned)(R * K + C) * 2u; voffB[i] = (unsigned)(Rb * K + C) * 2u; }
    const size_t kstep = (size_t)(BK * 2);
    const size_t hstep = (size_t)HALF * K * 2;
    const size_t tstep = 2 * hstep;
    const unsigned ldsw = (unsigned)wid * 1024u;
    const int aoff = lds_byte(wr * 64 + fr, fq * 8), boff = lds_byte(wc * 32 + fr, fq * 8);
#define PG8_SA(b, h) (((b) * 2 + (h)) * HTB)
#define PG8_SB(b, h) ((4 + (b) * 2 + (h)) * HTB)
#define PG8_STAGE(bufoff, gbase, voff) do { _Pragma("unroll") for (int _i = 0; _i < 2; ++_i) \
        __builtin_amdgcn_global_load_lds((const unsigned*)((const char*)(gbase) + (voff)[_i]), (PG8_LAS unsigned*)(lds + (bufoff) + ldsw + _i * 8192), 16, 0, 0); } while (0)
#define PG8_LDA(dst, b, h) do { _Pragma("unroll") for (int m = 0; m < 4; ++m) _Pragma("unroll") for (int k = 0; k < 2; ++k) dst[m][k] = *(const PG8_LAS bf16x8*)(lds + PG8_SA(b, h) + aoff + m * 2048 + k * 1024); } while (0)
#define PG8_LDB(dst, b, h) do { _Pragma("unroll") for (int n = 0; n < 2; ++n) _Pragma("unroll") for (int k = 0; k < 2; ++k) dst[n][k] = *(const PG8_LAS bf16x8*)(lds + PG8_SB(b, h) + boff + n * 2048 + k * 1024); } while (0)
#define PG8_MMA(ai, bj, At, Bt) do { __builtin_amdgcn_s_setprio(1); _Pragma("unroll") for (int m = 0; m < 4; ++m) _Pragma("unroll") for (int n = 0; n < 2; ++n) _Pragma("unroll") for (int k = 0; k < 2; ++k) \
        acc[ai][bj][m][n] = __builtin_amdgcn_mfma_f32_16x16x32_bf16(Bt[n][k], At[m][k], acc[ai][bj][m][n], 0, 0, 0); __builtin_amdgcn_s_setprio(0); } while (0)
#define PG8_WAIT_V(n) asm volatile("s_waitcnt vmcnt(" #n ")" ::: "memory")
#define PG8_WAIT_L(n) asm volatile("s_waitcnt lgkmcnt(" #n ")" ::: "memory")
#define PG8_BAR __builtin_amdgcn_s_barrier()
#define PG8_SCHED __builtin_amdgcn_sched_barrier(0)
    Unit cur, nxt; int ui = 0;
    if (!S.next(0, cur)) return;
    f32x4 acc[2][2][4][2];
#pragma unroll
    for (int a = 0; a < 2; ++a)
#pragma unroll
        for (int b = 0; b < 2; ++b)
#pragma unroll
            for (int m = 0; m < 4; ++m)
#pragma unroll
                for (int n = 0; n < 2; ++n) acc[a][b][m][n] = (f32x4){0.f, 0.f, 0.f, 0.f};
    bf16x8 At[4][2], B0[2][2], B1[2][2];
    const char* cA = (const char*)g.A + (size_t)cur.pm * tstep; const char* cB = (const char*)g.Bt + (size_t)cur.pn * tstep;
    S.a_ready(cur);
    PG8_STAGE(PG8_SB(0, 0), cB, voffB); PG8_STAGE(PG8_SA(0, 0), cA, voffA); PG8_STAGE(PG8_SB(0, 1), cB + hstep, voffB); PG8_STAGE(PG8_SA(0, 1), cA + hstep, voffA);
    if (wr == 1) PG8_BAR;
    PG8_WAIT_V(4); PG8_BAR;
    PG8_STAGE(PG8_SB(1, 0), cB + kstep, voffB); PG8_STAGE(PG8_SA(1, 0), cA + kstep, voffA); PG8_STAGE(PG8_SB(1, 1), cB + hstep + kstep, voffB);
    PG8_WAIT_V(6); PG8_BAR;
    PG8_STAMP();
    for (;;) {
        const bool has_next = S.next(ui + 1, nxt);
        const char* nA = has_next ? (const char*)g.A + (size_t)nxt.pm * tstep : cA; const char* nB = has_next ? (const char*)g.Bt + (size_t)nxt.pn * tstep : cB;
        for (int t = 0; t < nt; t += 2) {
            const bool last = (t == nt - 2);
            const char* a1 = cA + (size_t)(t + 1) * kstep;
            const char* a2 = last ? nA : cA + (size_t)(t + 2) * kstep; const char* b2 = last ? nB : cB + (size_t)(t + 2) * kstep;
            const char* a3 = a2 + kstep; const char* b3 = b2 + kstep;
            if (last && has_next) S.a_ready(nxt);
            PG8_LDB(B0, 0, 0); PG8_SCHED; PG8_LDA(At, 0, 0); PG8_STAGE(PG8_SA(1, 1), a1 + hstep, voffA);
            PG8_WAIT_L(8); PG8_BAR; PG8_WAIT_L(0); PG8_MMA(0, 0, At, B0); PG8_BAR; PG8_SCHED;
            PG8_LDB(B1, 0, 1); PG8_STAGE(PG8_SB(0, 0), b2, voffB);
            PG8_BAR; PG8_WAIT_L(0); PG8_MMA(0, 1, At, B1); PG8_BAR;
            PG8_LDA(At, 0, 1); PG8_STAGE(PG8_SA(0, 0), a2, voffA);
            PG8_BAR; PG8_WAIT_L(0); PG8_MMA(1, 0, At, B0); PG8_BAR; PG8_SCHED;
            PG8_STAGE(PG8_SB(0, 1), b2 + hstep, voffB);
            PG8_WAIT_V(6); PG8_BAR; PG8_MMA(1, 1, At, B1); PG8_BAR;
            PG8_LDB(B0, 1, 0); PG8_SCHED; PG8_LDA(At, 1, 0); PG8_STAGE(PG8_SA(0, 1), a2 + hstep, voffA);
            PG8_WAIT_L(8); PG8_BAR; PG8_WAIT_L(0); PG8_MMA(0, 0, At, B0); PG8_BAR; PG8_SCHED;
            PG8_LDB(B1, 1, 1); PG8_STAGE(PG8_SB(1, 0), b3, voffB);
            PG8_BAR; PG8_WAIT_L(0); PG8_MMA(0, 1, At, B1); PG8_BAR;
            PG8_LDA(At, 1, 1); PG8_STAGE(PG8_SA(1, 0), a3, voffA);
            PG8_BAR; PG8_WAIT_L(0); PG8_MMA(1, 0, At, B0); PG8_BAR; PG8_SCHED;
            PG8_STAGE(PG8_SB(1, 1), b3 + hstep, voffB);
            PG8_WAIT_V(6); PG8_BAR; PG8_MMA(1, 1, At, B1); PG8_BAR;
        }
        PG8_STAMP();
        if constexpr (!Epi::AFTER_DRAIN) { E(acc, cur, wr, wc, fr, fq); S.done(cur); }
        PG8_STAMP();
        if (!has_next) break;
#pragma unroll
        for (int a = 0; a < 2; ++a)
#pragma unroll
            for (int b = 0; b < 2; ++b)
#pragma unroll
                for (int m = 0; m < 4; ++m)
#pragma unroll
                    for (int n = 0; n < 2; ++n) acc[a][b][m][n] = (f32x4){0.f, 0.f, 0.f, 0.f};
        cur = nxt; cA = nA; cB = nB; ++ui;
    }
    PG8_WAIT_V(0);
    if (wr == 0) PG8_BAR;
    PG8_BAR;
    if constexpr (Epi::AFTER_DRAIN) { E.fused(acc, cur, wr, wc, fr, fq, lds, wid, lane); S.done(cur); }
    PG8_STAMP();
    if (STAMP && wid == 0) { stamps[lane] = lane < nts ? (((unsigned long long)(unsigned)ts_hi << 32) | (unsigned)ts_lo) : 0ull;
        if (lane == 62) stamps[62] = rt_entry; if (lane == 63) stamps[63] = (unsigned long long)wall_clock64(); }
#undef PG8_STAMP
#undef PG8_SA
#undef PG8_SB
#undef PG8_STAGE
#undef PG8_LDA
#undef PG8_LDB
#undef PG8_MMA
#undef PG8_WAIT_V
#undef PG8_WAIT_L
#undef PG8_BAR
#undef PG8_SCHED
}
}

namespace pg8 {
struct EpiProjT {
  static constexpr bool PERM = true, AFTER_DRAIN = false;
  bf16_t* O; int ldc; int ncols;
  __device__ __forceinline__ void operator()(const f32x4 (&acc)[2][2][4][2], const Unit& u, int wr, int wc, int fr, int fq) const {
    const int row0 = u.pm * BM + wr * 64 + fr, col0 = u.pn * BM + wc * 32 + 8 * fq;
#pragma unroll
    for (int ai = 0; ai < 2; ++ai)
#pragma unroll
      for (int m = 0; m < 4; ++m) {
        bf16_t* rowp = O + (size_t)(row0 + ai * HALF + m * 16) * ldc + col0;
#pragma unroll
        for (int bj = 0; bj < 2; ++bj) {
          if (col0 + bj * HALF < ncols) {
            const f32x4 v0 = acc[ai][bj][m][0], v1 = acc[ai][bj][m][1];
            u32x4 w; w.x = cvt_pk_bf16(v0[0], v0[1]); w.y = cvt_pk_bf16(v0[2], v0[3]); w.z = cvt_pk_bf16(v1[0], v1[1]); w.w = cvt_pk_bf16(v1[2], v1[3]);
            *(u32x4*)(rowp + bj * HALF) = w;
          }
        }
      }
  }
};
struct EpiGluT {
  static constexpr bool PERM = true, AFTER_DRAIN = false;
  const bf16_t* Y1; const float* bglu; bf16_t* O;
  __device__ __forceinline__ void operator()(const f32x4 (&acc)[2][2][4][2], const Unit& u, int wr, int wc, int fr, int fq) const {
    const int row0 = u.pm * BM + wr * 64 + fr, col0 = u.pn * BM + wc * 32 + 8 * fq;
    f32x4 bv[2][2];
#pragma unroll
    for (int bj = 0; bj < 2; ++bj)
#pragma unroll
      for (int n = 0; n < 2; ++n) bv[bj][n] = *(const f32x4*)(bglu + col0 + bj * HALF + 4 * n);
#pragma unroll
    for (int ai = 0; ai < 2; ++ai)
#pragma unroll
      for (int m = 0; m < 4; ++m) {
        const size_t r = (size_t)(row0 + ai * HALF + m * 16);
#pragma unroll
        for (int bj = 0; bj < 2; ++bj) {
          const u32x4 yv = *(const u32x4*)(Y1 + r * 512 + col0 + bj * HALF);
          const f32x4 v0 = acc[ai][bj][m][0] + bv[bj][0], v1 = acc[ai][bj][m][1] + bv[bj][1];
          float o[8];
#pragma unroll
          for (int q = 0; q < 4; ++q) {
            const float ylo = __uint_as_float(yv[q] << 16), yhi = __uint_as_float(yv[q] & 0xffff0000u);
            const float a0 = q < 2 ? v0[2 * q] : v1[2 * q - 4], a1 = q < 2 ? v0[2 * q + 1] : v1[2 * q - 3];
            o[2 * q] = ylo / (1.f + __expf(-a0));
            o[2 * q + 1] = yhi / (1.f + __expf(-a1));
          }
          u32x4 w; w.x = cvt_pk_bf16(o[0], o[1]); w.y = cvt_pk_bf16(o[2], o[3]); w.z = cvt_pk_bf16(o[4], o[5]); w.w = cvt_pk_bf16(o[6], o[7]);
          *(u32x4*)(O + r * 1024 + col0 + bj * HALF) = w;
        }
      }
  }
};
struct EpiGateT {
  static constexpr bool PERM = true, AFTER_DRAIN = false;
  const bf16_t* T1; bf16_t* O;
  __device__ __forceinline__ void operator()(const f32x4 (&acc)[2][2][4][2], const Unit& u, int wr, int wc, int fr, int fq) const {
    const int row0 = u.pm * BM + wr * 64 + fr, col0 = u.pn * BM + wc * 32 + 8 * fq;
#pragma unroll
    for (int ai = 0; ai < 2; ++ai)
#pragma unroll
      for (int m = 0; m < 4; ++m) {
        const size_t r = (size_t)(row0 + ai * HALF + m * 16);
#pragma unroll
        for (int bj = 0; bj < 2; ++bj) {
          const u32x4 tv = *(const u32x4*)(T1 + r * 512 + col0 + bj * HALF);
          const f32x4 v0 = acc[ai][bj][m][0], v1 = acc[ai][bj][m][1];
          u32x4 w;
          w.x = cvt_pk_bf16(__uint_as_float(tv[0] << 16) * v0[0], __uint_as_float(tv[0] & 0xffff0000u) * v0[1]);
          w.y = cvt_pk_bf16(__uint_as_float(tv[1] << 16) * v0[2], __uint_as_float(tv[1] & 0xffff0000u) * v0[3]);
          w.z = cvt_pk_bf16(__uint_as_float(tv[2] << 16) * v1[0], __uint_as_float(tv[2] & 0xffff0000u) * v1[1]);
          w.w = cvt_pk_bf16(__uint_as_float(tv[3] << 16) * v1[2], __uint_as_float(tv[3] & 0xffff0000u) * v1[3]);
          *(u32x4*)(O + r * 1024 + 512 + col0 + bj * HALF) = w;
        }
      }
  }
};
struct EpiWoutT {
  static constexpr bool PERM = false, AFTER_DRAIN = false;
  const float* X; const float* mod; bf16_t* H2;
  __device__ __forceinline__ void operator()(const f32x4 (&acc)[2][2][4][2], const Unit& u, int wr, int wc, int fr, int fq) const {
    const int row0 = u.pm * BM + wr * 64 + fr, col0 = u.pn * BM + wc * 32 + 4 * fq;
    const float* g1p = mod + ((u.pm * BM) >> 11) * 6144 + 2 * 1024 + col0;
    f32x4 gv[2][2];
#pragma unroll
    for (int bj = 0; bj < 2; ++bj)
#pragma unroll
      for (int n = 0; n < 2; ++n) gv[bj][n] = *(const f32x4*)(g1p + bj * HALF + n * 16);
#pragma unroll
    for (int ai = 0; ai < 2; ++ai)
#pragma unroll
      for (int m = 0; m < 4; ++m) {
        const size_t off = (size_t)(row0 + ai * HALF + m * 16) * 1024 + col0;
        bf16_t* hrow = H2 + (size_t)(row0 + ai * HALF + m * 16) * 2048 + 1024 + col0;
#pragma unroll
        for (int bj = 0; bj < 2; ++bj)
#pragma unroll
          for (int n = 0; n < 2; ++n) {
            const f32x4 xv = *(const f32x4*)(X + off + bj * HALF + n * 16);
            const f32x4 hv = xv + gv[bj][n] * acc[ai][bj][m][n];
            *(uint2*)(hrow + bj * HALF + n * 16) = make_uint2(cvt_pk_bf16(hv[0], hv[1]), cvt_pk_bf16(hv[2], hv[3]));
          }
      }
  }
};
}

struct EpiProj {
  u16* proj;
  __device__ __forceinline__ void operator()(int r, int c, f32x4 v) const {
    if (c < INC) {
#pragma unroll
      for (int j = 0; j < 4; ++j) proj[(size_t)(r + j) * INC + c] = f2bf(v[j]);
    }
  }
};
struct EpiGlu {
  const u16* y1; const float* bglu; u16* a2;
  __device__ __forceinline__ void operator()(int r, int c, f32x4 v) const {
    float bb = bglu[c];
#pragma unroll
    for (int j = 0; j < 4; ++j) {
      float y = bf2f(y1[(size_t)(r + j) * 512 + c]);
      a2[(size_t)(r + j) * 1024 + c] = f2bf(y * sigmoidf(v[j] + bb));
    }
  }
};
struct EpiGate {
  const u16* t1; u16* a2;
  __device__ __forceinline__ void operator()(int r, int c, f32x4 v) const {
#pragma unroll
    for (int j = 0; j < 4; ++j) {
      float t = bf2f(t1[(size_t)(r + j) * 512 + c]);
      a2[(size_t)(r + j) * 1024 + 512 + c] = f2bf(t * v[j]);
    }
  }
};
struct EpiWout {
  const float* x; const float* mod; float* h2;
  __device__ __forceinline__ void operator()(int r, int c, f32x4 v) const {
    float g1 = mod[(r >> 11) * 6144 + 2 * 1024 + c];
#pragma unroll
    for (int j = 0; j < 4; ++j) h2[(size_t)(r + j) * 1024 + c] = x[(size_t)(r + j) * 1024 + c] + g1 * v[j];
  }
};
struct EpiQ {
  u16* q;
  __device__ __forceinline__ void operator()(int r, int c, f32x4 v) const {
#pragma unroll
    for (int j = 0; j < 4; ++j) q[(size_t)(r + j) * 2048 + c] = f2bf(v[j]);
  }
};

__device__ __forceinline__ void ph_s5scan(const P& p, char* smem, int bid, int nb) {
  const int wid = tidx() >> 6, lane = tidx() & 63;
  float* U = (float*)(smem + wid * 8448);
  unsigned* H = (unsigned*)((char*)U + 4096);
  const int fr = lane & 15, fq = lane >> 4;
  for (int s = bid * 8 + wid; s < 2048; s += nb * 8) {
    const int g = s & 31, d = (s >> 5) & 1, b = s >> 6;
    const int ci = (d * 32 + g) * 64 + lane;
    const float abr = p.s5ab()[ci * 2], abi = p.s5ab()[ci * 2 + 1];
    float bbr[16], bbi[16];
#pragma unroll
    for (int q = 0; q < 4; ++q) {
      float4 t = *(const float4*)(p.s5bb() + (size_t)ci * 32 + q * 4);
      bbr[q * 4] = t.x; bbr[q * 4 + 1] = t.y; bbr[q * 4 + 2] = t.z; bbr[q * 4 + 3] = t.w;
      float4 t2 = *(const float4*)(p.s5bb() + (size_t)ci * 32 + 16 + q * 4);
      bbi[q * 4] = t2.x; bbi[q * 4 + 1] = t2.y; bbi[q * 4 + 2] = t2.z; bbi[q * 4 + 3] = t2.w;
    }
    bf16x8 cf[4];
#pragma unroll
    for (int kb = 0; kb < 4; ++kb)
      cf[kb] = *(const bf16x8*)(p.s5ct() + ((size_t)(d * 32 + g) * 16 + fr) * 128 + kb * 32 + fq * 8);
    const float dcoef = p.s5_d[g * 16 + fr];
    u16* ydst = d ? p.ys5b() : p.ys5f();
    float hr = 0.f, hi = 0.f;
    for (int seg = 0; seg < 2; ++seg) {
      const int L = seg ? 2048 : 256;
      const int rowbase = seg ? b * 2048 : NLAT + b * 256;
      for (int c0 = 0; c0 < L; c0 += 64) {
        {
          int pos = c0 + lane;
          int t = d ? (L - 1 - pos) : pos;
          const u16* src = p.proj() + (size_t)(rowbase + t) * INC + g * 16;
          uint4 v0 = *(const uint4*)src, v1 = *(const uint4*)(src + 8);
          float4* ud = (float4*)(U + lane * 16);
          ud[0] = make_float4(bflo(v0.x), bfhi(v0.x), bflo(v0.y), bfhi(v0.y));
          ud[1] = make_float4(bflo(v0.z), bfhi(v0.z), bflo(v0.w), bfhi(v0.w));
          ud[2] = make_float4(bflo(v1.x), bfhi(v1.x), bflo(v1.y), bfhi(v1.y));
          ud[3] = make_float4(bflo(v1.z), bfhi(v1.z), bflo(v1.w), bfhi(v1.w));
        }
        for (int sub = 0; sub < 4; ++sub) {
#pragma unroll 4
          for (int i = 0; i < 16; ++i) {
            const float4* up = (const float4*)(U + (sub * 16 + i) * 16);
            float4 u0 = up[0], u1 = up[1], u2 = up[2], u3 = up[3];
            float ur[16] = {u0.x, u0.y, u0.z, u0.w, u1.x, u1.y, u1.z, u1.w, u2.x, u2.y, u2.z, u2.w, u3.x, u3.y, u3.z, u3.w};
            float br0 = 0.f, br1 = 0.f, bi0 = 0.f, bi1 = 0.f;
#pragma unroll
            for (int h = 0; h < 16; h += 2) {
              br0 += bbr[h] * ur[h]; br1 += bbr[h + 1] * ur[h + 1];
              bi0 += bbi[h] * ur[h]; bi1 += bbi[h + 1] * ur[h + 1];
            }
            float nr = abr * hr - abi * hi + (br0 + br1);
            float ni = abr * hi + abi * hr + (bi0 + bi1);
            hr = nr; hi = ni;
            if (seg) H[i * 68 + lane] = pack2(hr, hi);
          }
          if (seg) {
            f32x4 acc = (f32x4){0.f, 0.f, 0.f, 0.f};
#pragma unroll
            for (int kb = 0; kb < 4; ++kb) {
              bf16x8 a = *(const bf16x8*)((const u16*)H + fr * 136 + kb * 32 + fq * 8);
              acc = __builtin_amdgcn_mfma_f32_16x16x32_bf16(a, cf[kb], acc, 0, 0, 0);
            }
#pragma unroll
            for (int j = 0; j < 4; ++j) {
              int pi = sub * 16 + fq * 4 + j;
              int pos = c0 + pi;
              int t = d ? (L - 1 - pos) : pos;
              float y = acc[j];
              if (d == 0) y += dcoef * U[pi * 16 + fr];
              ydst[(size_t)(b * 2048 + t) * 512 + g * 16 + fr] = f2bf(y);
            }
          }
        }
      }
    }
  }
}

#define S5_LD 168
__device__ __forceinline__ void ph_s5scan2(const P& p, char* smem, int bid, int nb) {
  const int wid = tidx() >> 6, lane = tidx() & 63;
  u16* H = (u16*)(smem + wid * (32 * S5_LD * 2));
  const int n = lane & 31, hh = lane >> 5, fr = lane & 15, fq = lane >> 4;
  for (int r = lane; r < 32; r += 64) {
    *(uint4*)(H + r * S5_LD + 144) = make_uint4(0u, 0u, 0u, 0u);
    *(uint4*)(H + r * S5_LD + 152) = make_uint4(0u, 0u, 0u, 0u);
    *(uint4*)(H + r * S5_LD + 160) = make_uint4(0u, 0u, 0u, 0u);
  }
  for (int s = bid * 8 + wid; s < 2048; s += nb * 8) {
    const int g = s & 31, d = (s >> 5) & 1, b = s >> 6;
    float ar[2][4], ai[2][4], a8r[2], a8i[2];
#pragma unroll
    for (int st = 0; st < 2; ++st) {
      const int ci = (d * 32 + g) * 64 + st * 32 + n;
      const float xr = p.s5ab()[ci * 2], xi = p.s5ab()[ci * 2 + 1];
      ar[st][0] = xr; ai[st][0] = xi;
#pragma unroll
      for (int k = 1; k < 4; ++k) {
        ar[st][k] = ar[st][k - 1] * xr - ai[st][k - 1] * xi;
        ai[st][k] = ar[st][k - 1] * xi + ai[st][k - 1] * xr;
      }
      a8r[st] = ar[st][3] * ar[st][3] - ai[st][3] * ai[st][3];
      a8i[st] = 2.f * ar[st][3] * ai[st][3];
    }
    bf16x8 bfr[4];
#pragma unroll
    for (int nt = 0; nt < 4; ++nt) {
      const int ci = (d * 32 + g) * 64 + (nt & 1) * 32 + n;
      const float4 t0 = *(const float4*)(p.s5bb() + (size_t)ci * 32 + (nt >> 1) * 16 + 8 * hh);
      const float4 t1 = *(const float4*)(p.s5bb() + (size_t)ci * 32 + (nt >> 1) * 16 + 8 * hh + 4);
      union { unsigned u[4]; bf16x8 v; } t;
      t.u[0] = pack2(t0.x, t0.y); t.u[1] = pack2(t0.z, t0.w); t.u[2] = pack2(t1.x, t1.y); t.u[3] = pack2(t1.z, t1.w);
      bfr[nt] = t.v;
    }
    bf16x8 cf[5];
#pragma unroll
    for (int kb = 0; kb < 4; ++kb)
      cf[kb] = *(const bf16x8*)(p.s5ct() + ((size_t)(d * 32 + g) * 16 + fr) * 128 + kb * 32 + fq * 8);
    {
      const float dv = (d == 0) ? p.s5_d[g * 16 + fr] : 0.f;
      union { u16 h[8]; bf16x8 v; } t;
#pragma unroll
      for (int j = 0; j < 8; ++j) t.h[j] = (8 * fq + j == fr) ? f2bf(dv) : (u16)0;
      cf[4] = t.v;
    }
    u16* ydst = d ? p.ys5b() : p.ys5f();
    float hcr[2] = {0.f, 0.f}, hci[2] = {0.f, 0.f};
    for (int seg = 0; seg < 2; ++seg) {
      const int L = seg ? 2048 : 256;
      const int rowbase = seg ? b * 2048 : NLAT + b * 256;
      uint4 anext;
      {
        const int pos = n;
        const int t = d ? (L - 1 - pos) : pos;
        anext = *(const uint4*)(p.proj() + (size_t)(rowbase + t) * INC + g * 16 + 8 * hh);
      }
      for (int c0 = 0; c0 < L; c0 += 32) {
        const uint4 acur = anext;
        if (c0 + 32 < L) {
          const int pos = c0 + 32 + n;
          const int t = d ? (L - 1 - pos) : pos;
          anext = *(const uint4*)(p.proj() + (size_t)(rowbase + t) * INC + g * 16 + 8 * hh);
        }
        union { uint4 q; bf16x8 v; } af;
        af.q = acur;
        f32x16 acc[4];
#pragma unroll
        for (int nt = 0; nt < 4; ++nt) {
          f32x16 z;
#pragma unroll
          for (int r = 0; r < 16; ++r) z[r] = 0.f;
          acc[nt] = __builtin_amdgcn_mfma_f32_32x32x16_bf16(af.v, bfr[nt], z, 0, 0, 0);
        }
#pragma unroll
        for (int st = 0; st < 2; ++st)
#pragma unroll
          for (int gg = 0; gg < 4; ++gg)
#pragma unroll
            for (int j = 1; j < 4; ++j) {
              const float pr = acc[st][4 * gg + j - 1], pi = acc[2 + st][4 * gg + j - 1];
              acc[st][4 * gg + j] += ar[st][0] * pr - ai[st][0] * pi;
              acc[2 + st][4 * gg + j] += ar[st][0] * pi + ai[st][0] * pr;
            }
        float sr[2][4], si[2][4];
        {
          float e0r[2][4], e0i[2][4], qpr[2][4], qpi[2][4], s1r[2][4], s1i[2][4];
#pragma unroll
          for (int st = 0; st < 2; ++st)
#pragma unroll
            for (int gg = 0; gg < 4; ++gg) {
              e0r[st][gg] = __shfl_xor(acc[st][4 * gg + 3], 32, 64);
              e0i[st][gg] = __shfl_xor(acc[2 + st][4 * gg + 3], 32, 64);
            }
#pragma unroll
          for (int st = 0; st < 2; ++st) {
            float qr = hcr[st], qi = hci[st];
#pragma unroll
            for (int gg = 0; gg < 4; ++gg) {
              const float er = acc[st][4 * gg + 3], ei = acc[2 + st][4 * gg + 3];
              qpr[st][gg] = qr; qpi[st][gg] = qi;
              s1r[st][gg] = ar[st][3] * qr - ai[st][3] * qi + e0r[st][gg];
              s1i[st][gg] = ar[st][3] * qi + ai[st][3] * qr + e0i[st][gg];
              const float nqr = ar[st][3] * s1r[st][gg] - ai[st][3] * s1i[st][gg] + er;
              const float nqi = ar[st][3] * s1i[st][gg] + ai[st][3] * s1r[st][gg] + ei;
              qr = nqr; qi = nqi;
            }
            hcr[st] = qr; hci[st] = qi;
          }
#pragma unroll
          for (int st = 0; st < 2; ++st)
#pragma unroll
            for (int gg = 0; gg < 4; ++gg) {
              const float s0r = __shfl_xor(qpr[st][gg], 32, 64), s0i = __shfl_xor(qpi[st][gg], 32, 64);
              sr[st][gg] = hh ? s1r[st][gg] : s0r;
              si[st][gg] = hh ? s1i[st][gg] : s0i;
            }
        }
        if (seg) {
#pragma unroll
          for (int st = 0; st < 2; ++st)
#pragma unroll
            for (int gg = 0; gg < 4; ++gg)
#pragma unroll
              for (int j = 0; j < 4; ++j) {
                const float hr_ = acc[st][4 * gg + j] + ar[st][j] * sr[st][gg] - ai[st][j] * si[st][gg];
                const float hi_ = acc[2 + st][4 * gg + j] + ar[st][j] * si[st][gg] + ai[st][j] * sr[st][gg];
                const int tok = 8 * gg + 4 * hh + j;
                *(unsigned*)(H + tok * S5_LD + 2 * (st * 32 + n)) = pack2(hr_, hi_);
              }
          *(uint4*)(H + n * S5_LD + 128 + 8 * hh) = acur;
#pragma unroll
          for (int mt = 0; mt < 2; ++mt) {
            f32x4 y = (f32x4){0.f, 0.f, 0.f, 0.f};
#pragma unroll
            for (int kb = 0; kb < 5; ++kb) {
              const bf16x8 a = *(const bf16x8*)(H + (16 * mt + fr) * S5_LD + kb * 32 + fq * 8);
              y = __builtin_amdgcn_mfma_f32_16x16x32_bf16(a, cf[kb], y, 0, 0, 0);
            }
#pragma unroll
            for (int j = 0; j < 4; ++j) {
              const int pos = c0 + 16 * mt + 4 * fq + j;
              const int t = d ? (L - 1 - pos) : pos;
              ydst[(size_t)(b * 2048 + t) * 512 + g * 16 + fr] = f2bf(y[j]);
            }
          }
        }
      }
    }
  }
}

__device__ __forceinline__ float4 mix_load4(const u16* __restrict__ proj, size_t row, int col, const size_t* nrow,
                                            const bool* nval, float4 mu) {
  uint2 cz = *(const uint2*)(proj + row * INC + col);
  float z[4] = {bflo(cz.x), bfhi(cz.x), bflo(cz.y), bfhi(cz.y)};
  float o[4];
  float m[4] = {mu.x, mu.y, mu.z, mu.w};
#pragma unroll
  for (int j = 0; j < 4; ++j) {
    float nbv = 0.f;
    if (nval[j]) {
      u16 t = proj[nrow[j] * INC + col + j];
      nbv = bf2f(t);
    }
    o[j] = z[j] + (nbv - z[j]) * m[j];
  }
  return make_float4(o[0], o[1], o[2], o[3]);
}
__device__ __forceinline__ void neighbours(bool isctx, size_t row, int t, size_t* nrow, bool* nval) {
  if (isctx) {
    nrow[0] = row - 1; nval[0] = t > 0;
    nrow[1] = row + 1; nval[1] = t < 255;
    nrow[2] = row - 1; nval[2] = t > 0;
    nrow[3] = row + 1; nval[3] = t < 255;
  } else {
    int col = t & 63, gr = t >> 6;
    nrow[0] = row - 1; nval[0] = col > 0;
    nrow[1] = row + 1; nval[1] = col < 63;
    nrow[2] = row - 64; nval[2] = gr > 0;
    nrow[3] = row + 64; nval[3] = gr < 31;
  }
}

__device__ __forceinline__ void ph_rwscan(const P& p, char* smem, int bid, int nb) {
  const int tid = tidx(), sl = tid >> 8, stid = tid & 255, wv = stid >> 6, lane = tid & 63;
  char* sb = smem + sl * 49152;
  float* OPS = (float*)sb;
  float* LW = (float*)(sb + 24576);
  float* LA = LW + 512;
  float* WW = (float*)(sb + 28672);
  float* WA = WW + 2048;
  float* YB = (float*)(sb + 45056);
  const int tt = stid >> 4, part = stid & 15;
  const int vrow = wv * 16 + (lane >> 2), kq = lane & 3;
  for (int sp = bid; sp < 256; sp += nb) {
    const int s = sp * 2 + sl;
    const int d = s & 1, h = (s >> 1) & 7, b = s >> 4;
    __syncthreads();
    for (int e = stid; e < 2048; e += 256) {
      int j = e >> 6, cc = e & 63;
      WW[e] = p.rw_w_w2[(size_t)(d * 32 + j) * 512 + h * 64 + cc];
      WA[e] = p.rw_w_a2[(size_t)(d * 32 + j) * 512 + h * 64 + cc];
    }
    const int hc = h * 64 + part * 4;
    const float4 w0v = *(const float4*)(p.rw_w0 + d * 512 + hc);
    const float4 a0v = *(const float4*)(p.rw_a0 + d * 512 + hc);
    const float4 kkv = *(const float4*)(p.rw_k_k + hc);
    const float4 kav = *(const float4*)(p.rw_k_a + hc);
    const float4 rkv = *(const float4*)(p.rw_r_k + hc);
    const float4 mur = *(const float4*)(p.rw_mu + hc);
    const float4 muk = *(const float4*)(p.rw_mu + 512 + hc);
    const float4 muv = *(const float4*)(p.rw_mu + 1024 + hc);
    const float4 mul = *(const float4*)(p.rw_mu + 1536 + part * 4);
    u16* ydst = d ? p.yrwb() : p.yrwf();
    float S[16];
#pragma unroll
    for (int i = 0; i < 16; ++i) S[i] = 0.f;
    for (int seg = 0; seg < 2; ++seg) {
      const int L = seg ? 2048 : 256;
      const size_t rowbase = seg ? (size_t)b * 2048 : (size_t)NLAT + b * 256;
      for (int c0 = 0; c0 < L; c0 += 16) {
        const int pos = c0 + tt;
        const int t = d ? (L - 1 - pos) : pos;
        const size_t row = rowbase + t;
        size_t nrow[4];
        bool nval[4];
        neighbours(seg == 0, row, t, nrow, nval);
        float4 r4 = mix_load4(p.proj(), row, 512 + hc, nrow, nval, mur);
        float4 k4 = mix_load4(p.proj(), row, 512 + 512 + hc, nrow, nval, muk);
        float4 v4 = mix_load4(p.proj(), row, 512 + 1024 + hc, nrow, nval, muv);
        float4 l4 = mix_load4(p.proj(), row, 512 + 1536 + part * 4, nrow, nval, mul);
        if (part < 8) {
          *(float4*)(LW + tt * 32 + part * 4) = make_float4(tanhf(l4.x), tanhf(l4.y), tanhf(l4.z), tanhf(l4.w));
        } else {
          *(float4*)(LA + tt * 32 + (part - 8) * 4) = l4;
        }
        __syncthreads();
        float wp[4] = {w0v.x, w0v.y, w0v.z, w0v.w};
        float ap[4] = {a0v.x, a0v.y, a0v.z, a0v.w};
#pragma unroll 8
        for (int j = 0; j < 32; ++j) {
          float lw = LW[tt * 32 + j], la = LA[tt * 32 + j];
          float4 ww = *(const float4*)(WW + j * 64 + part * 4);
          float4 wa = *(const float4*)(WA + j * 64 + part * 4);
          wp[0] += lw * ww.x; wp[1] += lw * ww.y; wp[2] += lw * ww.z; wp[3] += lw * ww.w;
          ap[0] += la * wa.x; ap[1] += la * wa.y; ap[2] += la * wa.z; ap[3] += la * wa.w;
        }
        float rr[4] = {r4.x, r4.y, r4.z, r4.w}, kk4[4] = {k4.x, k4.y, k4.z, k4.w};
        float kkc[4] = {kkv.x, kkv.y, kkv.z, kkv.w}, kac[4] = {kav.x, kav.y, kav.z, kav.w}, rkc[4] = {rkv.x, rkv.y, rkv.z, rkv.w};
        float dec[4], aa[4], kd[4], kkr[4];
        float ss = 0.f, bon = 0.f;
#pragma unroll
        for (int i = 0; i < 4; ++i) {
          float xw = -wp[i];
          float sp_ = fmaxf(xw, 0.f) + log1pf(expf(-fabsf(xw)));
          float wl = -sp_ - 0.5f;
          dec[i] = expf(-expf(wl));
          aa[i] = 1.f / (1.f + expf(-ap[i]));
          kd[i] = kk4[i] * (1.f + (aa[i] - 1.f) * kac[i]);
          kkr[i] = kk4[i] * kkc[i];
          ss += kkr[i] * kkr[i];
          bon += rr[i] * kd[i] * rkc[i];
        }
#pragma unroll
        for (int m = 0; m < 4; ++m) {
          ss = dpp_add(ss, m, 0);
          bon = dpp_add(bon, m, 0);
        }
        float inv = rsqrtf(ss + 1e-12f);
        float* o = OPS + tt * 384 + part * 4;
        *(float4*)(o + 0) = r4;
        *(float4*)(o + 64) = make_float4(dec[0], dec[1], dec[2], dec[3]);
        *(float4*)(o + 128) = make_float4(kd[0], kd[1], kd[2], kd[3]);
        *(float4*)(o + 192) = make_float4(-kkr[0] * inv, -kkr[1] * inv, -kkr[2] * inv, -kkr[3] * inv);
        *(float4*)(o + 256) = make_float4(kkr[0] * inv * aa[0], kkr[1] * inv * aa[1], kkr[2] * inv * aa[2], kkr[3] * inv * aa[3]);
        *(float4*)(o + 320) = v4;
        if (seg && part == 0) p.bsc()[((size_t)d * NLAT + row) * 8 + h] = bon;
        __syncthreads();
        for (int i = 0; i < 16; ++i) {
          const float* oo = OPS + i * 384 + kq * 16;
          float kn[16], wv_[16], bv[16], kdv[16];
#pragma unroll
          for (int q = 0; q < 4; ++q) {
            float4 a = *(const float4*)(oo + 192 + q * 4);
            kn[q * 4] = a.x; kn[q * 4 + 1] = a.y; kn[q * 4 + 2] = a.z; kn[q * 4 + 3] = a.w;
            float4 w_ = *(const float4*)(oo + 64 + q * 4);
            wv_[q * 4] = w_.x; wv_[q * 4 + 1] = w_.y; wv_[q * 4 + 2] = w_.z; wv_[q * 4 + 3] = w_.w;
            float4 b_ = *(const float4*)(oo + 256 + q * 4);
            bv[q * 4] = b_.x; bv[q * 4 + 1] = b_.y; bv[q * 4 + 2] = b_.z; bv[q * 4 + 3] = b_.w;
            float4 k_ = *(const float4*)(oo + 128 + q * 4);
            kdv[q * 4] = k_.x; kdv[q * 4 + 1] = k_.y; kdv[q * 4 + 2] = k_.z; kdv[q * 4 + 3] = k_.w;
          }
          float vv = OPS[i * 384 + 320 + vrow];
          float s0 = 0.f, s1 = 0.f, s2 = 0.f, s3 = 0.f;
#pragma unroll
          for (int q = 0; q < 16; q += 4) {
            s0 += S[q] * kn[q]; s1 += S[q + 1] * kn[q + 1]; s2 += S[q + 2] * kn[q + 2]; s3 += S[q + 3] * kn[q + 3];
          }
          float sa = (s0 + s1) + (s2 + s3);
          sa = dpp_add(sa, 0, 0);
          sa = dpp_add(sa, 1, 0);
#pragma unroll
          for (int q = 0; q < 16; ++q) S[q] = S[q] * wv_[q] + sa * bv[q] + vv * kdv[q];
          if (seg) {
            float rv[16];
#pragma unroll
            for (int q = 0; q < 4; ++q) {
              float4 a = *(const float4*)(oo + q * 4);
              rv[q * 4] = a.x; rv[q * 4 + 1] = a.y; rv[q * 4 + 2] = a.z; rv[q * 4 + 3] = a.w;
            }
            float y0 = 0.f, y1 = 0.f, y2 = 0.f, y3 = 0.f;
#pragma unroll
            for (int q = 0; q < 16; q += 4) {
              y0 += S[q] * rv[q]; y1 += S[q + 1] * rv[q + 1]; y2 += S[q + 2] * rv[q + 2]; y3 += S[q + 3] * rv[q + 3];
            }
            float y = (y0 + y1) + (y2 + y3);
            y = dpp_add(y, 0, 0);
            y = dpp_add(y, 1, 0);
            if (kq == 0) YB[i * 64 + vrow] = y;
          }
        }
        __syncthreads();
        if (seg) {
          float4 yv = *(const float4*)(YB + tt * 64 + part * 4);
          uint2 o2;
          o2.x = pack2(yv.x, yv.y); o2.y = pack2(yv.z, yv.w);
          *(uint2*)(ydst + row * 512 + hc) = o2;
        }
      }
    }
  }
}

#define LAS __attribute__((address_space(3)))
#define RW_AR_LD 68
#define RW_RM_LD 72
#define RW_SLOT_BYTES 13824
#define RW_SCR_BYTES 6912
#define RW_STREAM_BYTES (4 * RW_SLOT_BYTES + 3 * RW_SCR_BYTES + 2304 + 64)
__device__ __forceinline__ unsigned cvtpk(float lo, float hi) { return pack2(lo, hi); }
__device__ __forceinline__ float dpp_shr_add(float v, const int n) {
  int m;
  switch (n) {
    case 1: m = __builtin_amdgcn_update_dpp(0, __float_as_int(v), 0x111, 0xf, 0xf, true); break;
    case 2: m = __builtin_amdgcn_update_dpp(0, __float_as_int(v), 0x112, 0xf, 0xf, true); break;
    case 4: m = __builtin_amdgcn_update_dpp(0, __float_as_int(v), 0x114, 0xf, 0xf, true); break;
    default: m = __builtin_amdgcn_update_dpp(0, __float_as_int(v), 0x118, 0xf, 0xf, true); break;
  }
  return v + __int_as_float(m);
}
__device__ __forceinline__ unsigned dpp_row_shr1(unsigned old, unsigned v) { return (unsigned)__builtin_amdgcn_update_dpp((int)old, (int)v, 0x111, 0xf, 0xf, false); }
__device__ __forceinline__ unsigned dpp_row_shl1(unsigned old, unsigned v) { return (unsigned)__builtin_amdgcn_update_dpp((int)old, (int)v, 0x101, 0xf, 0xf, false); }
__device__ __forceinline__ void shift_src(unsigned c01, unsigned be01, unsigned up23, unsigned dn23, unsigned m01, unsigned& n01, unsigned& n23) {
  const unsigned S = dpp_row_shr1(be01, c01), H = dpp_row_shl1(be01, c01);
  n01 = (S & m01) | (H & ~m01);
  n23 = (up23 & 0xffffu) | (dn23 & 0xffff0000u);
}
__device__ __forceinline__ int opaque(int x) { asm volatile("" : "+v"(x)); return x; }
__device__ __forceinline__ float fsig(float x) { return __builtin_amdgcn_rcpf(1.f + __expf(-x)); }

__device__ __forceinline__ void ph_rwscan2(const P& p, char* smem, int bid, int nb) {
  const int wid = widx(), lane = lidx(), sl = wid >> 2, wv = wid & 3;
  char* sb = smem + sl * RW_STREAM_BYTES;
  float* CST = (float*)(sb + 4 * RW_SLOT_BYTES + 3 * RW_SCR_BYTES);
  volatile LAS int* FL = (volatile LAS int*)(sb + 4 * RW_SLOT_BYTES + 3 * RW_SCR_BYTES + 2304);
  const int scanw = sl;
  const int NCH = 144;
  for (int sp = bid; sp < 256; sp += nb) {
    const int s = sp * 2 + sl;
    const int d = s & 1, h = (s >> 1) & 7, b = s >> 4;
    __syncthreads();
    if (wv == 0) {
      const int cc = lane;
      CST[0 * 64 + cc] = p.rw_w0[d * 512 + h * 64 + cc];
      CST[1 * 64 + cc] = p.rw_a0[d * 512 + h * 64 + cc];
      CST[2 * 64 + cc] = p.rw_k_k[h * 64 + cc];
      CST[3 * 64 + cc] = p.rw_k_a[h * 64 + cc];
      CST[4 * 64 + cc] = p.rw_r_k[h * 64 + cc];
      CST[5 * 64 + cc] = p.rw_mu[h * 64 + cc];
      CST[6 * 64 + cc] = p.rw_mu[512 + h * 64 + cc];
      CST[7 * 64 + cc] = p.rw_mu[1024 + h * 64 + cc];
      CST[8 * 64 + cc] = p.rw_mu[1536 + cc];
      if (lane < 8) FL[lane] = 0;
    }
    __syncthreads();
    if (wv == scanw) {
      __builtin_amdgcn_s_setprio(3);
      const int v32 = lane & 31, hh = lane >> 5;
      u16* ydst = d ? p.yrwb() : p.yrwf();
      f32x16 X[2][2];
#pragma unroll
      for (int mt = 0; mt < 2; ++mt)
#pragma unroll
        for (int vt = 0; vt < 2; ++vt)
#pragma unroll
          for (int r = 0; r < 16; ++r) X[mt][vt][r] = 0.f;
      for (int c = 0; c < NCH; ++c) {
        {
          while (__builtin_amdgcn_readfirstlane(FL[c & 3]) <= c) __builtin_amdgcn_s_sleep(1);
          asm volatile("" ::: "memory");
          const char* slot = sb + (c & 3) * RW_SLOT_BYTES;
          const u16* AR = (const u16*)slot;
          const u16* MG = (const u16*)(slot + 4352);
          const u16* BT = (const u16*)(slot + 5376);
          const u16* KT = (const u16*)(slot + 7424);
          const u16* VT = (const u16*)(slot + 9472);
          const float* WC = (const float*)(slot + 11520);
          {
            const float* Arb = (const float*)(slot + 11776);
            const float* Ark = Arb + 256;
            u16* ARw = (u16*)slot;
            u16* MGw = (u16*)(slot + 4352);
            const int ol = opaque(lane), oj = opaque(lane & 15);
            v2f am[16];
#pragma unroll
            for (int tt = 0; tt < 16; ++tt) {
              const int m0 = 8 * (tt >> 2) + (tt & 3);
              am[tt] = (v2f){bf2f(ARw[ol + m0 * RW_AR_LD]), bf2f(MGw[oj + m0 * 16])};
            }
#pragma unroll
            for (int tt = 0; tt < 16; ++tt) {
              const int m0 = 8 * (tt >> 2) + (tt & 3);
              v2f acc = (v2f){bf2f(ARw[ol + (m0 + 4) * RW_AR_LD]), Ark[oj + tt * 16]};
#pragma unroll
              for (int i4 = 0; i4 < (tt + 4) / 4; ++i4) {
                const float4 s4 = *(const float4*)(Arb + tt * 16 + 4 * i4);
                const float sv[4] = {s4.x, s4.y, s4.z, s4.w};
#pragma unroll
                for (int q = 0; q < 4; ++q) {
                  const int i = 4 * i4 + q;
                  if (i <= tt) acc += sv[q] * am[i];
                }
              }
              ARw[ol + (m0 + 4) * RW_AR_LD] = f2bf(acc[0]);
              if (lane < 16) MGw[oj + (m0 + 4) * 16] = f2bf(acc[1]);
            }
          }
          bf16x8 vtf[2];
#pragma unroll
          for (int vt = 0; vt < 2; ++vt) vtf[vt] = *(const bf16x8*)(VT + (32 * vt + v32) * 16 + 8 * hh);
          f32x16 UY[2];
#pragma unroll
          for (int vt = 0; vt < 2; ++vt)
#pragma unroll
            for (int r = 0; r < 16; ++r) UY[vt][r] = 0.f;
          {
            const bf16x8 mgf = *(const bf16x8*)(MG + v32 * 16 + 8 * hh);
#pragma unroll
            for (int vt = 0; vt < 2; ++vt) UY[vt] = __builtin_amdgcn_mfma_f32_32x32x16_bf16(mgf, vtf[vt], UY[vt], 0, 0, 0);
          }
#pragma unroll
          for (int mt = 0; mt < 2; ++mt)
#pragma unroll
            for (int ks = 0; ks < 2; ++ks) {
              const int base = 32 * mt + 16 * ks + 4 * hh;
              const uint2 a0 = *(const uint2*)(AR + v32 * RW_AR_LD + base);
              const uint2 a1 = *(const uint2*)(AR + v32 * RW_AR_LD + base + 8);
              union { unsigned u[4]; bf16x8 v; } af;
              af.u[0] = a0.x; af.u[1] = a0.y; af.u[2] = a1.x; af.u[3] = a1.y;
#pragma unroll
              for (int vt = 0; vt < 2; ++vt) {
                union { unsigned u[4]; bf16x8 v; } xf;
#pragma unroll
                for (int q = 0; q < 4; ++q) xf.u[q] = cvtpk(X[mt][vt][8 * ks + 2 * q], X[mt][vt][8 * ks + 2 * q + 1]);
                UY[vt] = __builtin_amdgcn_mfma_f32_32x32x16_bf16(af.v, xf.v, UY[vt], 0, 0, 0);
              }
            }
          if (c >= 16 && hh == 1) {
#pragma unroll
            for (int r = 0; r < 16; ++r) {
              const int pos = (c - 16) * 16 + r;
              const int tok = d ? (2047 - pos) : pos;
              u16* yp = ydst + ((size_t)b * 2048 + tok) * 512 + h * 64 + v32;
              yp[0] = f2bf(UY[0][r]);
              yp[32] = f2bf(UY[1][r]);
            }
          }
          bf16x8 uyf[2][2];
#pragma unroll
          for (int vt = 0; vt < 2; ++vt)
#pragma unroll
            for (int ks = 0; ks < 2; ++ks) {
              union { unsigned u[4]; bf16x8 v; } t_;
#pragma unroll
              for (int q = 0; q < 4; ++q) t_.u[q] = cvtpk(UY[vt][8 * ks + 2 * q], UY[vt][8 * ks + 2 * q + 1]);
              uyf[vt][ks] = t_.v;
            }
#pragma unroll
          for (int mt = 0; mt < 2; ++mt) {
            const int krow = 32 * mt + v32;
            const bf16x8 ktf = *(const bf16x8*)(KT + krow * 16 + 8 * hh);
            bf16x8 btf[2];
#pragma unroll
            for (int ks = 0; ks < 2; ++ks) {
              btf[ks] = *(const bf16x8*)(BT + krow * 16 + 8 * ks);
              if (hh) btf[ks] = (bf16x8){0, 0, 0, 0, 0, 0, 0, 0};
            }
#pragma unroll
            for (int vt = 0; vt < 2; ++vt) {
              X[mt][vt] = __builtin_amdgcn_mfma_f32_32x32x16_bf16(ktf, vtf[vt], X[mt][vt], 0, 0, 0);
#pragma unroll
              for (int ks = 0; ks < 2; ++ks) X[mt][vt] = __builtin_amdgcn_mfma_f32_32x32x16_bf16(btf[ks], uyf[vt][ks], X[mt][vt], 0, 0, 0);
            }
#pragma unroll
            for (int g = 0; g < 4; ++g) {
              const float4 w4 = *(const float4*)(WC + 32 * mt + 8 * g + 4 * hh);
#pragma unroll
              for (int vt = 0; vt < 2; ++vt) {
                X[mt][vt][4 * g + 0] *= w4.x; X[mt][vt][4 * g + 1] *= w4.y;
                X[mt][vt][4 * g + 2] *= w4.z; X[mt][vt][4 * g + 3] *= w4.w;
              }
            }
          }
        }
        asm volatile("s_waitcnt lgkmcnt(0)" ::: "memory");
        if (lane == 0) FL[4] = c + 1;
      }
      __builtin_amdgcn_s_setprio(0);
    } else {
      const int pw = wv - (wv > scanw ? 1 : 0);
      const int t = lane & 15, kq = lane >> 4;
      char* scr = sb + 4 * RW_SLOT_BYTES + pw * RW_SCR_BYTES;
      u16* AL = (u16*)scr;
      u16* BE = AL + 16 * RW_RM_LD;
      u16* KA = BE + 16 * RW_RM_LD;
      float* AAs = (float*)BE;
      const int o_kq16 = opaque(16 * kq);
      const int o_tr = opaque(256 * kq + t);
      const int o_rm = opaque(t * RW_RM_LD + 16 * kq);
      const int o_ar = opaque((8 * (t >> 2) + (t & 3) + 4) * RW_AR_LD + 16 * kq);
      const int o_l = opaque(lane);
      const int o_j = opaque(lane & 15);
      const float* cstl = CST + o_kq16;
      const float* cstw = CST + 8 * 64 + opaque(8 * kq);
      const unsigned m01 = d ? 0xffff0000u : 0x0000ffffu;
      bf16x8 wwf[4], waf[4];
      {
        const int o_wl = (((d * 8 + h) * 4) * 64 + lane) * 8;
#pragma unroll
        for (int mt = 0; mt < 4; ++mt) {
          wwf[mt] = *(const bf16x8*)(p.wlf() + o_wl + mt * 512);
          waf[mt] = *(const bf16x8*)(p.wlf() + o_wl + 32768 + mt * 512);
        }
      }
      for (;;) {
        int c;
        {
          const unsigned fa = (unsigned)(unsigned long)(LAS char*)(sb + 4 * RW_SLOT_BYTES + 3 * RW_SCR_BYTES + 2304 + 20);
          const int inc = lane == 0 ? 1 : 0;
          asm volatile("ds_add_rtn_u32 %0, %1, %2\n\ts_waitcnt lgkmcnt(0)" : "=v"(c) : "v"(fa), "v"(inc) : "memory");
          c = __builtin_amdgcn_readfirstlane(c);
        }
        if (c >= NCH) break;
        while (__builtin_amdgcn_readfirstlane(FL[4]) < c - 3) __builtin_amdgcn_s_sleep(1);
        asm volatile("" ::: "memory");
        char* slot = sb + (c & 3) * RW_SLOT_BYTES;
        u16* AR = (u16*)slot;
        u16* MG = (u16*)(slot + 4352);
        u16* BT = (u16*)(slot + 5376);
        u16* KT = (u16*)(slot + 7424);
        u16* VT = (u16*)(slot + 9472);
        float* WC = (float*)(slot + 11520);
        const bool lat = c >= 16;
        const int L = lat ? 2048 : 256;
        const int pos = (lat ? (c - 16) : c) * 16 + t;
        const int tok = d ? (L - 1 - pos) : pos;
        const size_t row = (lat ? (size_t)b * 2048 : (size_t)NLAT + (size_t)b * 256) + tok;
        const u16* cbase = p.proj() + row * INC + 512;
        const u16 *ubase, *dbase, *ebase;
        float nmask[4];
        {
          size_t nrow[4];
          bool nval[4];
          neighbours(!lat, row, tok, nrow, nval);
#pragma unroll
          for (int j = 0; j < 4; ++j) nmask[j] = nval[j] ? 1.f : 0.f;
          ubase = p.proj() + (nval[2] ? nrow[2] : row) * INC + 512;
          dbase = p.proj() + (nval[3] ? nrow[3] : row) * INC + 512;
          const bool useup = (t == 0) != (d != 0);
          const size_t erow = useup ? (nval[0] ? nrow[0] : row) : (nval[1] ? nrow[1] : row);
          ebase = p.proj() + erow * INC + 512;
        }
        const int cl = 1536 + 8 * kq, cx = h * 64 + 16 * kq;
        u32x4 Cl[2], Ul[2], Dl[2], El[2];
        u32x4 Cx[3][2], Ux[3][2], Dx[3][2], Ex[3][2];
#pragma unroll
        for (int a = 0; a < 2; ++a) {
          Cl[a] = *(const u32x4*)(cbase + cl + 32 * a);
          Ul[a] = *(const u32x4*)(ubase + cl + 32 * a);
          Dl[a] = *(const u32x4*)(dbase + cl + 32 * a);
          El[a] = (u32x4){0u, 0u, 0u, 0u};
        }
#pragma unroll
        for (int a = 0; a < 3; ++a)
#pragma unroll
          for (int hf = 0; hf < 2; ++hf) {
            Cx[a][hf] = *(const u32x4*)(cbase + cx + 512 * a + 8 * hf);
            Ux[a][hf] = *(const u32x4*)(ubase + cx + 512 * a + 8 * hf);
            Dx[a][hf] = *(const u32x4*)(dbase + cx + 512 * a + 8 * hf);
            Ex[a][hf] = (u32x4){0u, 0u, 0u, 0u};
          }
        if (t == 0 || t == 15) {
#pragma unroll
          for (int a = 0; a < 2; ++a) El[a] = *(const u32x4*)(ebase + cl + 32 * a);
#pragma unroll
          for (int a = 0; a < 3; ++a)
#pragma unroll
            for (int hf = 0; hf < 2; ++hf) Ex[a][hf] = *(const u32x4*)(ebase + cx + 512 * a + 8 * hf);
        }
        bf16x8 lwf, laf;
        {
          float lw[8], la[8];
          const float4 ml0 = *(const float4*)(cstw), ml1 = *(const float4*)(cstw + 4);
          const float4 ma0 = *(const float4*)(cstw + 32), ma1 = *(const float4*)(cstw + 32 + 4);
          const float mul_[8] = {ml0.x, ml0.y, ml0.z, ml0.w, ml1.x, ml1.y, ml1.z, ml1.w};
          const float mua_[8] = {ma0.x, ma0.y, ma0.z, ma0.w, ma1.x, ma1.y, ma1.z, ma1.w};
#pragma unroll
          for (int g = 0; g < 2; ++g) {
            unsigned nw01, nw23, na01, na23;
            shift_src(Cl[0][2 * g], El[0][2 * g], Ul[0][2 * g + 1], Dl[0][2 * g + 1], m01, nw01, nw23);
            shift_src(Cl[1][2 * g], El[1][2 * g], Ul[1][2 * g + 1], Dl[1][2 * g + 1], m01, na01, na23);
            const float zw[4] = {bflo(Cl[0][2 * g]), bfhi(Cl[0][2 * g]), bflo(Cl[0][2 * g + 1]), bfhi(Cl[0][2 * g + 1])};
            const float za[4] = {bflo(Cl[1][2 * g]), bfhi(Cl[1][2 * g]), bflo(Cl[1][2 * g + 1]), bfhi(Cl[1][2 * g + 1])};
            const float nw[4] = {bflo(nw01), bfhi(nw01), bflo(nw23), bfhi(nw23)};
            const float na[4] = {bflo(na01), bfhi(na01), bflo(na23), bfhi(na23)};
#pragma unroll
            for (int j = 0; j < 4; ++j) {
              const int q = 4 * g + j;
              lw[q] = 1.f - 2.f * __builtin_amdgcn_rcpf(1.f + __expf(2.f * (zw[j] + (nw[j] * nmask[j] - zw[j]) * mul_[q])));
              la[q] = za[j] + (na[j] * nmask[j] - za[j]) * mua_[q];
            }
          }
          union { unsigned u[4]; bf16x8 v; } tw, ta;
#pragma unroll
          for (int q = 0; q < 4; ++q) { tw.u[q] = pack2(lw[2 * q], lw[2 * q + 1]); ta.u[q] = pack2(la[2 * q], la[2 * q + 1]); }
          lwf = tw.v; laf = ta.v;
        }
        float ee[16];
        unsigned rrp[8], aap[8], kxp[8];
        {
#pragma unroll
          for (int mt = 0; mt < 4; ++mt) {
            const float4 mr = *(const float4*)(cstl + 5 * 64 + 4 * mt), mk = *(const float4*)(cstl + 6 * 64 + 4 * mt), mv = *(const float4*)(cstl + 7 * 64 + 4 * mt);
            const float mrv[4] = {mr.x, mr.y, mr.z, mr.w}, mkv[4] = {mk.x, mk.y, mk.z, mk.w}, mvv[4] = {mv.x, mv.y, mv.z, mv.w};
            const int hf = mt >> 1, r0 = 2 * (mt & 1);
            float mix[3][4];
#pragma unroll
            for (int a = 0; a < 3; ++a) {
              unsigned n01, n23;
              shift_src(Cx[a][hf][r0], Ex[a][hf][r0], Ux[a][hf][r0 + 1], Dx[a][hf][r0 + 1], m01, n01, n23);
              const float z[4] = {bflo(Cx[a][hf][r0]), bfhi(Cx[a][hf][r0]), bflo(Cx[a][hf][r0 + 1]), bfhi(Cx[a][hf][r0 + 1])};
              const float n[4] = {bflo(n01), bfhi(n01), bflo(n23), bfhi(n23)};
              const float* mm = a == 0 ? mrv : (a == 1 ? mkv : mvv);
#pragma unroll
              for (int j = 0; j < 4; ++j) mix[a][j] = z[j] + (n[j] * nmask[j] - z[j]) * mm[j];
            }
#pragma unroll
            for (int j = 0; j < 4; ++j) VT[o_tr + (4 * mt + j) * 16] = f2bf(mix[2][j]);
            const f32x4 z4 = (f32x4){0.f, 0.f, 0.f, 0.f};
            const f32x4 aw = __builtin_amdgcn_mfma_f32_16x16x32_bf16(wwf[mt], lwf, z4, 0, 0, 0);
            const f32x4 a2 = __builtin_amdgcn_mfma_f32_16x16x32_bf16(waf[mt], laf, z4, 0, 0, 0);
            const float4 w0 = *(const float4*)(cstl + 0 * 64 + 4 * mt), a0 = *(const float4*)(cstl + 1 * 64 + 4 * mt);
            ee[4 * mt] = 0.60653066f * fsig(w0.x + aw[0]); ee[4 * mt + 1] = 0.60653066f * fsig(w0.y + aw[1]);
            ee[4 * mt + 2] = 0.60653066f * fsig(w0.z + aw[2]); ee[4 * mt + 3] = 0.60653066f * fsig(w0.w + aw[3]);
            float aav[4];
            aav[0] = fsig(a0.x + a2[0]); aav[1] = fsig(a0.y + a2[1]);
            aav[2] = fsig(a0.z + a2[2]); aav[3] = fsig(a0.w + a2[3]);
            rrp[2 * mt] = pack2(mix[0][0], mix[0][1]); rrp[2 * mt + 1] = pack2(mix[0][2], mix[0][3]);
            aap[2 * mt] = pack2(aav[0], aav[1]); aap[2 * mt + 1] = pack2(aav[2], aav[3]);
            kxp[2 * mt] = pack2(mix[1][0], mix[1][1]); kxp[2 * mt + 1] = pack2(mix[1][2], mix[1][3]);
          }
        }
        float kdf[16], kkf[16];
        float inv;
        {
          float ss = 0.f, bon = 0.f;
#pragma unroll
          for (int mt = 0; mt < 4; ++mt) {
            const float4 c2 = *(const float4*)(cstl + 2 * 64 + 4 * mt), c3 = *(const float4*)(cstl + 3 * 64 + 4 * mt), c4 = *(const float4*)(cstl + 4 * 64 + 4 * mt);
            const float kkc[4] = {c2.x, c2.y, c2.z, c2.w}, kac[4] = {c3.x, c3.y, c3.z, c3.w}, rkc[4] = {c4.x, c4.y, c4.z, c4.w};
#pragma unroll
            for (int j = 0; j < 4; ++j) {
              const int e = 4 * mt + j;
              const float kx = (e & 1) ? bfhi(kxp[e >> 1]) : bflo(kxp[e >> 1]);
              const float av = (e & 1) ? bfhi(aap[e >> 1]) : bflo(aap[e >> 1]);
              const float rv = (e & 1) ? bfhi(rrp[e >> 1]) : bflo(rrp[e >> 1]);
              kdf[e] = kx * (1.f + (av - 1.f) * kac[j]);
              kkf[e] = kx * kkc[j];
              ss += kkf[e] * kkf[e];
              bon += rv * kdf[e] * rkc[j];
            }
          }
          ss += __shfl_xor(ss, 16, 64); ss += __shfl_xor(ss, 32, 64);
          bon += __shfl_xor(bon, 16, 64); bon += __shfl_xor(bon, 32, 64);
          inv = rsqrtf(ss + 1e-12f);
          if (lat && kq == 0) p.bsc()[((size_t)d * NLAT + row) * 8 + h] = bon;
        }
#pragma unroll
        for (int mt = 0; mt < 4; ++mt) {
          float al4[4], rh4[4], be4[4], ka4[4];
#pragma unroll
          for (int j = 0; j < 4; ++j) {
            const int e = 4 * mt + j;
            float cs = ee[e];
            cs = dpp_shr_add(cs, 1); cs = dpp_shr_add(cs, 2); cs = dpp_shr_add(cs, 4); cs = dpp_shr_add(cs, 8);
            const float Ep = __expf(cs), Em = __builtin_amdgcn_rcpf(Ep);
            const float Ex = __int_as_float(__builtin_amdgcn_update_dpp(__float_as_int(1.f), __float_as_int(Em), 0x111, 0xf, 0xf, false));
            const float kkn = kkf[e] * inv;
            al4[j] = -kkn * Ex;
            be4[j] = kkn * ((e & 1) ? bfhi(aap[e >> 1]) : bflo(aap[e >> 1])) * Ep;
            ka4[j] = kdf[e] * Ep;
            rh4[j] = ((e & 1) ? bfhi(rrp[e >> 1]) : bflo(rrp[e >> 1])) * Em;
            BT[o_tr + (4 * mt + j) * 16] = f2bf(be4[j]);
            KT[o_tr + (4 * mt + j) * 16] = f2bf(ka4[j]);
            if (t == 15) WC[o_kq16 + 4 * mt + j] = Em;
          }
          const int ko = o_rm + 4 * mt;
          *(uint2*)(AL + ko) = make_uint2(pack2(al4[0], al4[1]), pack2(al4[2], al4[3]));
          *(uint2*)(AR + o_ar + 4 * mt) = make_uint2(pack2(rh4[0], rh4[1]), pack2(rh4[2], rh4[3]));
          *(uint2*)(BE + ko) = make_uint2(pack2(be4[0], be4[1]), pack2(be4[2], be4[3]));
          *(uint2*)(KA + ko) = make_uint2(pack2(ka4[0], ka4[1]), pack2(ka4[2], ka4[3]));
        }
        {
          const int m = lane & 31, hh = lane >> 5;
          const int typ = (m >> 2) & 1, tt = 4 * (m >> 3) + (m & 3);
          const u16* arow = (typ ? AR + m * RW_AR_LD : AL + tt * RW_RM_LD) + 8 * hh;
          const u16* brow = ((m >> 4) ? KA : BE) + (m & 15) * RW_RM_LD + 8 * hh;
          f32x16 aa;
#pragma unroll
          for (int r = 0; r < 16; ++r) aa[r] = 0.f;
#pragma unroll
          for (int ks = 0; ks < 4; ++ks) {
            const uint2 a0 = *(const uint2*)(arow + 16 * ks), a1 = *(const uint2*)(arow + 16 * ks + 4);
            union { unsigned u[4]; bf16x8 v; } af;
            af.u[0] = a0.x; af.u[1] = a0.y; af.u[2] = a1.x; af.u[3] = a1.y;
            const bf16x8 bf_ = *(const bf16x8*)(brow + 16 * ks);
            aa = __builtin_amdgcn_mfma_f32_32x32x16_bf16(af.v, bf_, aa, 0, 0, 0);
          }
          const int i = m & 15;
          float* aad = (hh ? (float*)(slot + 11776) : AAs) + opaque((m >> 4) * 256 + i);
#pragma unroll
          for (int r = 0; r < 16; ++r) {
            const bool keep = hh ? (i <= r) : (i < r);
            aad[r * 16] = keep ? aa[r] : 0.f;
          }
        }
        asm volatile("" ::: "memory");
        {
          const float* Aab = AAs;
          const float* Aak = AAs + 256;
          v2f am[16];
#pragma unroll
          for (int tt = 0; tt < 16; ++tt) {
            v2f acc = (v2f){bf2f(AL[o_l + tt * RW_RM_LD]), Aak[o_j + tt * 16]};
#pragma unroll
            for (int i4 = 0; i4 < (tt + 3) / 4; ++i4) {
              const float4 s4 = *(const float4*)(Aab + tt * 16 + 4 * i4);
              const float sv[4] = {s4.x, s4.y, s4.z, s4.w};
#pragma unroll
              for (int q = 0; q < 4; ++q) {
                const int i = 4 * i4 + q;
                if (i < tt) acc += sv[q] * am[i];
              }
            }
            am[tt] = acc;
          }
#pragma unroll
          for (int tt = 0; tt < 16; ++tt) {
            const int m0 = 8 * (tt >> 2) + (tt & 3);
            AR[o_l + m0 * RW_AR_LD] = f2bf(am[tt][0]);
            if (lane < 16) MG[o_j + m0 * 16] = f2bf(am[tt][1]);
          }
        }
        asm volatile("s_waitcnt lgkmcnt(0)" ::: "memory");
        if (lane == 0) FL[c & 3] = c + 1;
      }
    }
  }
}

struct MixLd {
  uint4 s5f, s5b, rwf, rwb, vc, gc;
  u16 vn[8], gn[8];
  float bs0, bs1;
};
__device__ __forceinline__ void mix_load(const P& p, int row, int lane, MixLd& L, float (&nmask)[4]) {
  const int c8 = lane * 8, t = row & 2047;
  L.s5f = *(const uint4*)(p.ys5f() + (size_t)row * 512 + c8);
  L.s5b = *(const uint4*)(p.ys5b() + (size_t)row * 512 + c8);
  L.rwf = *(const uint4*)(p.yrwf() + (size_t)row * 512 + c8);
  L.rwb = *(const uint4*)(p.yrwb() + (size_t)row * 512 + c8);
  size_t nrow[4];
  bool nval[4];
  neighbours(false, (size_t)row, t, nrow, nval);
  const u16* nb_[4];
#pragma unroll
  for (int j = 0; j < 4; ++j) { nb_[j] = p.proj() + (nval[j] ? nrow[j] : (size_t)row) * INC + 512 + j; nmask[j] = nval[j] ? 1.f : 0.f; }
  const u16* cb = p.proj() + (size_t)row * INC + 512;
  L.vc = *(const uint4*)(cb + 1024 + c8);
#pragma unroll
  for (int i = 0; i < 8; ++i) L.vn[i] = nb_[i & 3][1024 + c8 + (i & 4)];
  const int g8 = (lane < 12) ? c8 : 0;
  L.gc = *(const uint4*)(cb + 1600 + g8);
#pragma unroll
  for (int i = 0; i < 8; ++i) L.gn[i] = nb_[i & 3][1600 + g8 + (i & 4)];
  const int head = lane >> 3;
  L.bs0 = p.bsc()[(size_t)row * 8 + head];
  L.bs1 = p.bsc()[((size_t)NLAT + row) * 8 + head];
}
__device__ __forceinline__ void mix_compute(const P& p, int row, int lane, const MixLd& L, const float (&nmask)[4], u16* y1dst, u16* t1dst) {
  const int c8 = lane * 8;
  {
    const unsigned au[4] = {L.s5f.x, L.s5f.y, L.s5f.z, L.s5f.w}, bu[4] = {L.s5b.x, L.s5b.y, L.s5b.z, L.s5b.w};
    unsigned ou[4];
#pragma unroll
    for (int q = 0; q < 4; ++q) ou[q] = pack2(gelu_as(bflo(au[q]) + bflo(bu[q])), gelu_as(bfhi(au[q]) + bfhi(bu[q])));
    *(uint4*)(y1dst + (size_t)row * 512 + c8) = make_uint4(ou[0], ou[1], ou[2], ou[3]);
  }
  float y[8];
  {
    const unsigned au[4] = {L.rwf.x, L.rwf.y, L.rwf.z, L.rwf.w}, bu[4] = {L.rwb.x, L.rwb.y, L.rwb.z, L.rwb.w};
#pragma unroll
    for (int q = 0; q < 4; ++q) { y[2 * q] = bflo(au[q]) + bflo(bu[q]); y[2 * q + 1] = bfhi(au[q]) + bfhi(bu[q]); }
  }
  float sm = 0.f;
#pragma unroll
  for (int i = 0; i < 8; ++i) sm += y[i];
  sm = dpp_add(sm, 0, 0); sm = dpp_add(sm, 1, 0); sm = dpp_add(sm, 2, 0);
  const float mu = sm * (1.f / 64.f);
  float sv = 0.f;
#pragma unroll
  for (int i = 0; i < 8; ++i) sv += (y[i] - mu) * (y[i] - mu);
  sv = dpp_add(sv, 0, 0); sv = dpp_add(sv, 1, 0); sv = dpp_add(sv, 2, 0);
  const float rs = rsqrtf(sv * (1.f / 64.f) + 64e-5f);
  float v[8];
  {
    const unsigned cu[4] = {L.vc.x, L.vc.y, L.vc.z, L.vc.w};
    const float4 m0 = *(const float4*)(p.rw_mu + 1024 + c8), m1 = *(const float4*)(p.rw_mu + 1024 + c8 + 4);
    const float mm[8] = {m0.x, m0.y, m0.z, m0.w, m1.x, m1.y, m1.z, m1.w};
#pragma unroll
    for (int i = 0; i < 8; ++i) {
      const float z = (i & 1) ? bfhi(cu[i >> 1]) : bflo(cu[i >> 1]);
      const float nbv = bf2f(L.vn[i]) * nmask[i & 3];
      v[i] = z + (nbv - z) * mm[i];
    }
  }
  const float bs = L.bs0 + L.bs1;
  {
    const float4 w0 = *(const float4*)(p.rw_ln_w + c8), w1 = *(const float4*)(p.rw_ln_w + c8 + 4);
    const float4 b0 = *(const float4*)(p.rw_ln_b + c8), b1 = *(const float4*)(p.rw_ln_b + c8 + 4);
    const float lw[8] = {w0.x, w0.y, w0.z, w0.w, w1.x, w1.y, w1.z, w1.w};
    const float lb[8] = {b0.x, b0.y, b0.z, b0.w, b1.x, b1.y, b1.z, b1.w};
    float o[8];
#pragma unroll
    for (int i = 0; i < 8; ++i) o[i] = (y[i] - mu) * rs * lw[i] + lb[i] + bs * v[i];
    *(uint4*)(t1dst + (size_t)row * 512 + c8) = make_uint4(pack2(o[0], o[1]), pack2(o[2], o[3]), pack2(o[4], o[5]), pack2(o[6], o[7]));
  }
  if (lane < 32) {
    unsigned ou[4] = {0u, 0u, 0u, 0u};
    if (lane < 12) {
      const unsigned cu[4] = {L.gc.x, L.gc.y, L.gc.z, L.gc.w};
      const float4 m0 = *(const float4*)(p.rw_mu + 1600 + c8), m1 = *(const float4*)(p.rw_mu + 1600 + c8 + 4);
      const float mm[8] = {m0.x, m0.y, m0.z, m0.w, m1.x, m1.y, m1.z, m1.w};
      float gsig[8];
#pragma unroll
      for (int i = 0; i < 8; ++i) {
        const float z = (i & 1) ? bfhi(cu[i >> 1]) : bflo(cu[i >> 1]);
        const float nbv = bf2f(L.gn[i]) * nmask[i & 3];
        gsig[i] = fsig(z + (nbv - z) * mm[i]);
      }
#pragma unroll
      for (int q = 0; q < 4; ++q) ou[q] = pack2(gsig[2 * q], gsig[2 * q + 1]);
    }
    *(uint4*)(p.sg() + (size_t)row * 256 + c8) = make_uint4(ou[0], ou[1], ou[2], ou[3]);
  }
}
__device__ __forceinline__ void ph_mixprep(const P& p, int bid, int nb, u16* y1dst, u16* t1dst) {
  const int wid = tidx() >> 6, lane = tidx() & 63;
  const int stride = nb * 8;
  for (int row = bid * 8 + wid; row < NLAT; row += 2 * stride) {
    const int rowB = row + stride;
    const bool hasB = rowB < NLAT;
    MixLd LA, LB;
    float mA[4], mB[4];
    mix_load(p, row, lane, LA, mA);
    mix_load(p, hasB ? rowB : row, lane, LB, mB);
    mix_compute(p, row, lane, LA, mA, y1dst, t1dst);
    if (hasB) mix_compute(p, rowB, lane, LB, mB, y1dst, t1dst);
  }
}

__constant__ unsigned char CAND_I[52] = {0,0,0,0,0,0,0,0,0,0,0,0,0,0,0,0, 1,1,1,1,1,1,1,1, 2,2,2,2,2, 3,3,3,3, 4,4,4, 5,5, 6,6, 7,7, 8,9,10,11,12,13,14,15, 0,0};
__constant__ unsigned char CAND_J[52] = {0,1,2,3,4,5,6,7,8,9,10,11,12,13,14,15, 0,1,2,3,4,5,6,7, 0,1,2,3,4, 0,1,2,3, 0,1,2, 0,1, 0,1, 0,1, 0,0,0,0,0,0,0,0, 0,0};

#define SC_LD 144
#define KL_LD 136
__device__ __forceinline__ unsigned umax_quad(unsigned v) {
  unsigned o = (unsigned)__builtin_amdgcn_update_dpp(0, (int)v, 0xB1, 0xf, 0xf, true);
  v = v > o ? v : o;
  o = (unsigned)__builtin_amdgcn_update_dpp(0, (int)v, 0x4E, 0xf, 0xf, true);
  return v > o ? v : o;
}
__device__ __forceinline__ unsigned mono_key(float f) {
  unsigned u = __float_as_uint(f);
  return u ^ ((u >> 31) ? 0xFFFFFFFFu : 0x80000000u);
}
__device__ __forceinline__ float mono_inv(unsigned k) {
  unsigned u = (k >> 31) ? (k ^ 0x80000000u) : ~k;
  return __uint_as_float(u);
}
__device__ __forceinline__ unsigned umax3(unsigned a, unsigned b, unsigned c) {
  unsigned m = a > b ? a : b;
  return m > c ? m : c;
}
__device__ __forceinline__ void ph_route(const P& p, char* smem, int bid, int nb) {
  u16* KL = (u16*)smem;
  unsigned* SC = (unsigned*)(smem + 2 * 128 * KL_LD * 2);
  float* TS = (float*)(SC + 2 * 64 * SC_LD);
  int* TI = (int*)(TS + 2 * 64 * 16);
  const u16* Q = p.proj();
  const int tid = tidx(), wid = tid >> 6, lane = tid & 63, fr = lane & 15, fq = lane >> 4;
  int cur_h = -1;
  bf16x8 an[4];
  {
    const int h0 = bid & 7, r0 = (bid >> 3) * 64, c0 = wid >> 2, m0 = (wid & 3) * 16;
#pragma unroll
    for (int ks = 0; ks < 4; ++ks)
      an[ks] = *(const bf16x8*)(Q + (size_t)(r0 + m0 + fr) * 2048 + h0 * 256 + c0 * 128 + ks * 32 + fq * 8);
  }
  for (int item = bid; item < 1024 * 8; item += nb) {
    const int h = item & 7, row0 = (item >> 3) * 64;
    if (h != cur_h) {
      __syncthreads();
      for (int e = tid; e < 2 * 128 * 16; e += NTHREADS) {
        int r = e >> 4, kc = (e & 15) * 8;
        *(uint4*)(KL + r * KL_LD + kc) = *(const uint4*)(p.keys() + ((size_t)h * 256 + r) * 128 + kc);
      }
      cur_h = h;
      __syncthreads();
    }
    {
      const int c = wid >> 2, mrow = (wid & 3) * 16;
      f32x4 acc[8];
#pragma unroll
      for (int ni = 0; ni < 8; ++ni) acc[ni] = (f32x4){0.f, 0.f, 0.f, 0.f};
      bf16x8 a[4];
#pragma unroll
      for (int ks = 0; ks < 4; ++ks) a[ks] = an[ks];
      {
        const int nit = (item + nb < 1024 * 8) ? item + nb : item;
        const int nh = nit & 7, nr0 = (nit >> 3) * 64;
#pragma unroll
        for (int ks = 0; ks < 4; ++ks)
          an[ks] = *(const bf16x8*)(Q + (size_t)(nr0 + mrow + fr) * 2048 + nh * 256 + c * 128 + ks * 32 + fq * 8);
      }
#pragma unroll
      for (int ks = 0; ks < 4; ++ks) {
#pragma unroll
        for (int ni = 0; ni < 8; ++ni) {
          bf16x8 bfr = *(const bf16x8*)(KL + (c * 128 + ni * 16 + fr) * KL_LD + ks * 32 + fq * 8);
          acc[ni] = __builtin_amdgcn_mfma_f32_16x16x32_bf16(a[ks], bfr, acc[ni], 0, 0, 0);
        }
      }
#pragma unroll
      for (int ni = 0; ni < 8; ++ni)
#pragma unroll
        for (int j = 0; j < 4; ++j) {
          const int n = ni * 16 + fr;
          SC[(c * 64 + mrow + fq * 4 + j) * SC_LD + n] = (mono_key(acc[ni][j]) & ~127u) | (unsigned)(127 - n);
        }
    }
    __syncthreads();
    {
      const int task = tid >> 2, q4 = tid & 3;
      unsigned* rowp = SC + task * SC_LD;
      for (int r = 0; r < 16; ++r) {
        unsigned m = 0;
#pragma unroll
        for (int j = 0; j < 8; ++j) {
          uint4 v = *(const uint4*)(rowp + 16 * j + 4 * q4);
          m = umax3(m, v.x, v.y);
          m = umax3(m, v.z, v.w);
        }
        m = umax_quad(m);
        const int n = 127 - (int)(m & 127u);
        if (((n >> 2) & 3) == q4) rowp[n] = 0u;
        if (q4 == (r & 3)) {
          TS[task * 16 + r] = mono_inv(m & ~127u);
          TI[task * 16 + r] = n;
        }
      }
    }
    __syncthreads();
    if (tid < 256) {
      const int t = tid >> 2, q4 = tid & 3;
      unsigned val[13];
#pragma unroll
      for (int e = 0; e < 13; ++e) {
        const int ci = q4 + 4 * e;
        const int i = CAND_I[ci], j = CAND_J[ci];
        const float sv = TS[t * 16 + i] + TS[(64 + t) * 16 + j];
        val[e] = (ci < 50) ? ((mono_key(sv) & ~255u) | (unsigned)(255 - (i * 16 + j))) : 0u;
      }
      unsigned mine[4] = {0u, 0u, 0u, 0u};
      unsigned first = 0u;
#pragma unroll
      for (int r = 0; r < 16; ++r) {
        unsigned m = umax3(val[0], val[1], val[2]);
        m = umax3(m, val[3], val[4]);
        m = umax3(m, val[5], val[6]);
        m = umax3(m, val[7], val[8]);
        m = umax3(m, val[9], val[10]);
        m = umax3(m, val[11], val[12]);
        m = umax_quad(m);
#pragma unroll
        for (int e = 0; e < 13; ++e) val[e] = (val[e] == m) ? 0u : val[e];
        if (r == 0) first = m;
        mine[r >> 2] = (q4 == (r & 3)) ? m : mine[r >> 2];
      }
      float smax;
      {
        const int cid = 255 - (int)(first & 255u);
        smax = TS[t * 16 + (cid >> 4)] + TS[(64 + t) * 16 + (cid & 15)];
      }
      float ex[4];
      int eid[4];
      float part = 0.f;
#pragma unroll
      for (int k = 0; k < 4; ++k) {
        const int cid = 255 - (int)(mine[k] & 255u);
        const int i = cid >> 4, j = cid & 15;
        const float sv = TS[t * 16 + i] + TS[(64 + t) * 16 + j];
        ex[k] = __expf(sv - smax);
        part += ex[k];
        eid[k] = TI[t * 16 + i] * 128 + TI[(64 + t) * 16 + j];
      }
      part = dpp_add(part, 0, 0);
      part = dpp_add(part, 1, 0);
      const float rden = 1.f / part;
      const size_t obase = ((size_t)(row0 + t) * 8 + h) * 16;
#pragma unroll
      for (int k = 0; k < 4; ++k) {
        p.idx()[obase + 4 * k + q4] = eid[k];
        p.gate()[obase + 4 * k + q4] = ex[k] * rden;
      }
    }
    __syncthreads();
  }
}

typedef int v8i_t __attribute__((ext_vector_type(8)));
__device__ __forceinline__ void ph_ffn(const P& p, float* __restrict__ dst, char* smem, int bid, int nb) {
  const int wid = tidx() >> 6, lane = tidx() & 63;
  const int hh = lane >> 5, li = lane & 31, m16 = lane & 15, kg = lane >> 4;
  unsigned char* h8 = (unsigned char*)smem + wid * 1024;
  const u16* H2N = p.hn();
  for (int row = bid * 8 + wid; row < NLAT; row += nb * 8) {
    float hinv;
    {
      const uint4 a = *(const uint4*)(H2N + (size_t)row * 1024 + lane * 16), b2 = *(const uint4*)(H2N + (size_t)row * 1024 + lane * 16 + 8);
      const unsigned au[8] = {a.x, a.y, a.z, a.w, b2.x, b2.y, b2.z, b2.w};
      float hv[16];
      float am = 0.f;
#pragma unroll
      for (int q = 0; q < 8; ++q) { hv[2 * q] = bflo(au[q]); hv[2 * q + 1] = bfhi(au[q]); am = fmaxf(am, fmaxf(fabsf(hv[2 * q]), fabsf(hv[2 * q + 1]))); }
#pragma unroll
      for (int m = 32; m >= 1; m >>= 1) am = fmaxf(am, __shfl_xor(am, m, 64));
      const float scl = am > 0.f ? 448.f / am : 1.f;
      hinv = am > 0.f ? am * (1.f / 448.f) : 1.f;
      unsigned o[4];
#pragma unroll
      for (int q = 0; q < 4; ++q) {
        int w = 0;
        w = __builtin_amdgcn_cvt_pk_fp8_f32(hv[4 * q] * scl, hv[4 * q + 1] * scl, w, false);
        w = __builtin_amdgcn_cvt_pk_fp8_f32(hv[4 * q + 2] * scl, hv[4 * q + 3] * scl, w, true);
        o[q] = (unsigned)w;
      }
      *(uint4*)(h8 + lane * 16) = make_uint4(o[0], o[1], o[2], o[3]);
    }
    v8i_t hb[8];
#pragma unroll
    for (int s2 = 0; s2 < 8; ++s2) {
      const uint4 x0 = *(const uint4*)(h8 + 128 * s2 + 16 * kg), x1 = *(const uint4*)(h8 + 128 * s2 + 64 + 16 * kg);
      hb[s2] = (v8i_t){(int)x0.x, (int)x0.y, (int)x0.z, (int)x0.w, (int)x1.x, (int)x1.y, (int)x1.z, (int)x1.w};
    }
    const int id0 = p.idx()[(size_t)row * 128 + lane], id1 = p.idx()[(size_t)row * 128 + 64 + lane];
    const float us0 = p.usc()[id0] * hinv, us1 = p.usc()[id1] * hinv;
    const float gv0 = p.gate()[(size_t)row * 128 + lane] * p.vsc()[id0], gv1 = p.gate()[(size_t)row * 128 + 64 + lane] * p.vsc()[id1];
    float oacc[32];
#pragma unroll
    for (int i = 0; i < 32; ++i) oacc[i] = 0.f;
#pragma unroll 1
    for (int bb = 0; bb < 8; ++bb) {
      const bool hf = bb >= 4;
      const int e0 = (bb & 3) * 16;
      const int idv = hf ? id1 : id0;
      const float usv = hf ? us1 : us0, gvv = hf ? gv1 : gv0;
      const int idm = __shfl(idv, e0 + m16, 64);
      uint4 ua[8];
#pragma unroll
      for (int s2 = 0; s2 < 8; ++s2) ua[s2] = *(const uint4*)(p.utab() + (size_t)idm * 1024 + 64 * s2 + 16 * kg);
      uint4 vr[8];
#pragma unroll
      for (int q = 0; q < 8; ++q) {
        const int ia = __builtin_amdgcn_readlane(idv, e0 + 2 * q), ib = __builtin_amdgcn_readlane(idv, e0 + 2 * q + 1);
        const int id = hh ? ib : ia;
        vr[q] = *(const uint4*)(p.utab() + (size_t)id * 1024 + 512 + li * 16);
      }
      f32x4 D = (f32x4){0.f, 0.f, 0.f, 0.f};
#pragma unroll
      for (int s2 = 0; s2 < 8; ++s2) {
        const v8i_t av = (v8i_t){(int)ua[s2].x, (int)ua[s2].y, (int)ua[s2].z, (int)ua[s2].w, 0, 0, 0, 0};
        D = __builtin_amdgcn_mfma_scale_f32_16x16x128_f8f6f4(av, hb[s2], D, 4  , 0  , 0, 0x7f7f7f7f, 0, 0x7f7f7f7f);
      }
      const int nn = m16 & 3;
      const float dotv = nn == 0 ? D[0] : (nn == 1 ? D[1] : (nn == 2 ? D[2] : D[3]));
      const int esrc = e0 + 4 * kg + nn;
      const float usx = __shfl(usv, esrc, 64), gvx = __shfl(gvv, esrc, 64);
      const float cfl = gvx * gelu_as(dotv * usx);
#pragma unroll
      for (int q = 0; q < 8; ++q) {
        int one_s;
        asm volatile("s_mov_b32 %0, 1" : "=s"(one_s));
        if (one_s == 0) continue;
        const int ma = 2 * q, mb = 2 * q + 1;
        const float cfa = __int_as_float(__builtin_amdgcn_readlane(__float_as_int(cfl), 16 * (ma >> 2) + (ma & 3)));
        const float cfb = __int_as_float(__builtin_amdgcn_readlane(__float_as_int(cfl), 16 * (mb >> 2) + (mb & 3)));
        const float cf = hh ? cfb : cfa;
        const unsigned vv[4] = {vr[q].x, vr[q].y, vr[q].z, vr[q].w};
#pragma unroll
        for (int k = 0; k < 4; ++k) {
          v2f p0 = __builtin_amdgcn_cvt_scalef32_pk_f32_fp4(vv[k], 1.0f, 0), p1 = __builtin_amdgcn_cvt_scalef32_pk_f32_fp4(vv[k], 1.0f, 1);
          v2f p2 = __builtin_amdgcn_cvt_scalef32_pk_f32_fp4(vv[k], 1.0f, 2), p3 = __builtin_amdgcn_cvt_scalef32_pk_f32_fp4(vv[k], 1.0f, 3);
          oacc[8 * k] += cf * p0[0]; oacc[8 * k + 1] += cf * p0[1];
          oacc[8 * k + 2] += cf * p1[0]; oacc[8 * k + 3] += cf * p1[1];
          oacc[8 * k + 4] += cf * p2[0]; oacc[8 * k + 5] += cf * p2[1];
          oacc[8 * k + 6] += cf * p3[0]; oacc[8 * k + 7] += cf * p3[1];
        }
      }
    }
    float mine[16];
#pragma unroll
    for (int i = 0; i < 16; ++i) {
      const float give = hh ? oacc[i] : oacc[16 + i];
      const float got = __shfl_xor(give, 32, 64);
      mine[i] = (hh ? oacc[16 + i] : oacc[i]) + got;
    }
    const int b = row >> 11;
    const int colb = li * 32 + hh * 16;
    float h3[16];
    float ss = 0.f;
    const uint4 hA = *(const uint4*)((const u16*)p.out + (size_t)row * 2048 + 1024 + colb), hB = *(const uint4*)((const u16*)p.out + (size_t)row * 2048 + 1024 + colb + 8);
    const unsigned hw[8] = {hA.x, hA.y, hA.z, hA.w, hB.x, hB.y, hB.z, hB.w};
#pragma unroll
    for (int q = 0; q < 4; ++q) {
      const int col = colb + q * 4;
      const float4 a0 = make_float4(bflo(hw[2 * q]), bfhi(hw[2 * q]), bflo(hw[2 * q + 1]), bfhi(hw[2 * q + 1]));
      float4 q0 = *(const float4*)(p.mod() + b * 6144 + 5 * 1024 + col);
      h3[q * 4 + 0] = a0.x + q0.x * mine[q * 4 + 0];
      h3[q * 4 + 1] = a0.y + q0.y * mine[q * 4 + 1];
      h3[q * 4 + 2] = a0.z + q0.z * mine[q * 4 + 2];
      h3[q * 4 + 3] = a0.w + q0.w * mine[q * 4 + 3];
      ss += h3[q * 4] * h3[q * 4] + h3[q * 4 + 1] * h3[q * 4 + 1] + h3[q * 4 + 2] * h3[q * 4 + 2] + h3[q * 4 + 3] * h3[q * 4 + 3];
    }
    ss = wave_sum_u(ss);
    const float rstd = rsqrtf(ss * (1.f / 1024.f) + 1e-6f);
#pragma unroll
    for (int q = 0; q < 4; ++q) {
      const int col = colb + q * 4;
      float4 n0 = *(const float4*)(p.norm_f_g + col);
      *(float4*)(dst + (size_t)row * 1024 + col) =
          make_float4(h3[q * 4] * rstd * n0.x, h3[q * 4 + 1] * rstd * n0.y, h3[q * 4 + 2] * rstd * n0.z, h3[q * 4 + 3] * rstd * n0.w);
    }
  }
}

#define XB_TMO      128
#define XB_XCNT(j)  (256  + 64 * (j))
#define XB_XSUB(j)  (1280 + 64 * (j))
#define XB_XGEN(j)  (2304 + 64 * (j))
#define XB_TOP      3328
#define XB_TOPGEN   3392
#define XCD_BAR_WORDS 3456
#define XB_SPIN_CAP (1u << 18)
#define LAS __attribute__((address_space(3)))

__device__ __forceinline__ unsigned xb_ld(unsigned* p)              { return __hip_atomic_load(p, __ATOMIC_RELAXED, __HIP_MEMORY_SCOPE_AGENT); }
__device__ __forceinline__ unsigned xb_add(unsigned* p, unsigned v) { return __hip_atomic_fetch_add(p, v, __ATOMIC_RELAXED, __HIP_MEMORY_SCOPE_AGENT); }
__device__ __forceinline__ unsigned xb_xcc_id() { return (unsigned)__builtin_amdgcn_s_getreg((3 << 11) | 20) & 0xFu; }
#define XB_SPIN(cond, bar) do { unsigned _sp = 0; while (cond) { __builtin_amdgcn_s_sleep(1); \
    if ((++_sp & 255u) == 0u) { if (xb_ld(&(bar)[XB_TMO])) break; if (_sp > XB_SPIN_CAP) { atomicAdd(&(bar)[XB_TMO], 1u); break; } } } } while (0)

struct XcdBarrier {
    unsigned* bar; unsigned x;
    volatile LAS unsigned* st;
};

__device__ __forceinline__ XcdBarrier xcd_barrier_post(unsigned* bar, volatile LAS unsigned* st) {
    XcdBarrier b; b.bar = bar; b.x = xb_xcc_id(); b.st = st;
    if (tidx() == 0) (void)xb_add(&bar[XB_XCNT(b.x)], 1u);
    return b;
}
__device__ __forceinline__ void xcd_barrier_complete(unsigned* bar, unsigned x, unsigned& nloc, unsigned& nx) {
    const unsigned G = gridDim.x * gridDim.y * gridDim.z;
    unsigned sum, cnt, mine, sp = 0u;
    for (;;) {
        sum = 0u; cnt = 0u; mine = 0u;
#pragma unroll
        for (unsigned j = 0; j < 16; ++j) { const unsigned c = xb_ld(&bar[XB_XCNT(j)]); sum += c; cnt += (c > 0u) ? 1u : 0u; mine = (j == x) ? c : mine; }
        if (sum == G) break;
        __builtin_amdgcn_s_sleep(1);
        if ((++sp & 255u) == 0u) { if (xb_ld(&bar[XB_TMO])) break; if (sp > XB_SPIN_CAP) { atomicAdd(&bar[XB_TMO], 1u); break; } }
    }
    nloc = mine > 0u ? mine : 1u; nx = cnt > 0u ? cnt : 1u;
}

__device__ __forceinline__ void xcd_barrier(const XcdBarrier& b) {
    asm volatile("s_waitcnt vmcnt(0)" ::: "memory");
    __syncthreads();
    if (tidx() == 0) {
        unsigned* bar = b.bar;
        __builtin_amdgcn_s_waitcnt(0);
        unsigned nloc = b.st[0], nx = b.st[1];
        if (nloc == 0u) { xcd_barrier_complete(bar, b.x, nloc, nx); b.st[0] = nloc; b.st[1] = nx; }
        const unsigned old = xb_add(&bar[XB_XSUB(b.x)], 1u);
        const unsigned gen = old / nloc;
        if (old + 1u == (gen + 1u) * nloc) {
            __builtin_amdgcn_fence(__ATOMIC_RELEASE, "agent");
            asm volatile("s_waitcnt vmcnt(0)" ::: "memory");
            const unsigned og = xb_add(&bar[XB_TOP], 1u);
            const unsigned tg = og / nx;
            if (og + 1u == (tg + 1u) * nx) xb_add(&bar[XB_TOPGEN], 1u);
            else XB_SPIN(xb_ld(&bar[XB_TOPGEN]) == tg, bar);
            __builtin_amdgcn_fence(__ATOMIC_ACQUIRE, "agent");
            xb_add(&bar[XB_XGEN(b.x)], 1u);
            asm volatile("s_waitcnt vmcnt(0)" ::: "memory");
        } else {
            XB_SPIN(xb_ld(&bar[XB_XGEN(b.x)]) == gen, bar);
            __builtin_amdgcn_fence(__ATOMIC_ACQUIRE, "agent");
            asm volatile("s_waitcnt vmcnt(0)" ::: "memory");
        }
    }
    __syncthreads();
}

typedef const __attribute__((address_space(4))) P* kargP_t;
__device__ __forceinline__ P load_params() {
  kargP_t q = (kargP_t)__builtin_amdgcn_kernarg_segment_ptr();
  asm volatile("" : "+s"(q));
  P r;
  r.x = q->x;
  r.c = q->c;
  r.ctx = q->ctx;
  r.c_ctx = q->c_ctx;
  r.w_ada = q->w_ada;
  r.b_ada = q->b_ada;
  r.norm1_g = q->norm1_g;
  r.norm2_g = q->norm2_g;
  r.w_in = q->w_in;
  r.s5_a_re = q->s5_a_re;
  r.s5_a_im = q->s5_a_im;
  r.s5_log_dt = q->s5_log_dt;
  r.s5_b_re = q->s5_b_re;
  r.s5_b_im = q->s5_b_im;
  r.s5_c_re = q->s5_c_re;
  r.s5_c_im = q->s5_c_im;
  r.s5_d = q->s5_d;
  r.s5_w_glu = q->s5_w_glu;
  r.s5_b_glu = q->s5_b_glu;
  r.rw_mu = q->rw_mu;
  r.rw_w0 = q->rw_w0;
  r.rw_w_w2 = q->rw_w_w2;
  r.rw_a0 = q->rw_a0;
  r.rw_w_a2 = q->rw_w_a2;
  r.rw_w_g2 = q->rw_w_g2;
  r.rw_k_k = q->rw_k_k;
  r.rw_k_a = q->rw_k_a;
  r.rw_r_k = q->rw_r_k;
  r.rw_ln_w = q->rw_ln_w;
  r.rw_ln_b = q->rw_ln_b;
  r.w_out = q->w_out;
  r.peer_w_q = q->peer_w_q;
  r.peer_keys = q->peer_keys;
  r.peer_u = q->peer_u;
  r.peer_v = q->peer_v;
  r.norm_f_g = q->norm_f_g;
  r.out = q->out;
  r.ws = q->ws;
  return r;
}
#define NPHASES 11
template <int PH>
__device__ __forceinline__ void run_phase(const P& p, char* smem, int bid, int nb, bool rep = false) {
  if (PH == 0) ph_prep(p, smem, bid, nb);
  if (PH == 1) ph_norm(p, 0, bid, nb);
  if (PH == 2) {
    pg8::StaticOrder S; S.init(NTOK, INCP, nb, bid);
    pg8::gemm_phase<pg8::EpiProjT, pg8::StaticOrder, false>((PG8_LAS unsigned char*)smem, pg8::Gemm{p.hn(), p.win_t(), NTOK, INCP, 1024}, S, pg8::EpiProjT{p.proj(), INC, INC}, nullptr);
  }
  if (PH == 3) { ph_s5scan2(p, smem, bid, nb); ph_rwscan2(p, smem, bid, nb); }
  if (PH == 4) ph_mixprep(p, bid, nb, rep ? p.hn() : p.ys5f(), rep ? p.hn() + (size_t)NLAT * 512 : p.yrwf());
  if (PH == 5) {
    {
      pg8::StaticOrder S; S.init(NLAT, 512, nb, bid);
      pg8::gemm_phase<pg8::EpiGluT, pg8::StaticOrder, false>((PG8_LAS unsigned char*)smem, pg8::Gemm{p.ys5f(), p.wglu_t(), NLAT, 512, 512}, S, pg8::EpiGluT{p.ys5f(), p.s5_b_glu, p.hn()}, nullptr);
    }
    {
      pg8::StaticOrder S; S.init(NLAT, 512, nb, bid);
      pg8::gemm_phase<pg8::EpiGateT, pg8::StaticOrder, false>((PG8_LAS unsigned char*)smem, pg8::Gemm{p.sg(), p.wg2_t(), NLAT, 512, 256}, S, pg8::EpiGateT{p.yrwf(), p.hn()}, nullptr);
    }
  }
  if (PH == 6) {
    pg8::StaticOrder S; S.init(NLAT, 1024, nb, bid);
    pg8::gemm_phase<pg8::EpiWoutT, pg8::StaticOrder, false>((PG8_LAS unsigned char*)smem, pg8::Gemm{p.hn(), p.wout_t(), NLAT, 1024, 1024}, S, pg8::EpiWoutT{p.x, p.mod(), (pg8::bf16_t*)p.out}, nullptr);
  }
  if (PH == 7) ph_norm(p, 1, bid, nb);
  if (PH == 8) {
    pg8::StaticOrder S; S.init(NLAT, 2048, nb, bid);
    pg8::gemm_phase<pg8::EpiProjT, pg8::StaticOrder, false>((PG8_LAS unsigned char*)smem, pg8::Gemm{p.hn(), p.wq_t(), NLAT, 2048, 1024}, S, pg8::EpiProjT{p.proj(), 2048, 2048}, nullptr);
  }
  if (PH == 9) ph_route(p, smem, bid, nb);
  if (PH == 10) ph_ffn(p, rep ? (float*)p.proj() : p.out, smem, bid, nb);
  if (PH == 11) ph_s5scan2(p, smem, bid, nb);
  if (PH == 12) ph_rwscan2(p, smem, bid, nb);
}
#ifndef REPMASK
#define REPMASK 0
#endif
#define REP(n) ((REPMASK >> (n)) & 1)
#define PHASE(n) if (ph_lo <= n && n < ph_hi) { if (n > ph_lo) { if (n == 1) grid.sync(); else xcd_barrier(xb); } if (REP(n)) { { const P lp_ = load_params(); run_phase<n>(lp_, smem, bid, nb, true); } __syncthreads(); } if (n == 3 && REP(11)) { run_phase<11>(p, smem, bid, nb); __syncthreads(); } if (n == 3 && REP(12)) { run_phase<12>(p, smem, bid, nb); __syncthreads(); } { const P lp_ = load_params(); run_phase<n>(lp_, smem, bid, nb); } }
__global__ void __launch_bounds__(NTHREADS) mega(P p, int ph_lo, int ph_hi) {
  char* smem = g_smem;
  if ((threadIdx.x & 63) == 0) *(int*)(g_smem + WAVETAB_OFF + 4 * hw_slot()) = (int)(threadIdx.x >> 6);
  cg::grid_group grid = cg::this_grid();
  const int bid = blockIdx.x, nb = gridDim.x;
  volatile LAS unsigned* xst = (volatile LAS unsigned*)(smem + LDS_BYTES - 16);
  if (threadIdx.x == 0) { xst[0] = 0u; xst[1] = 0u; }
  __syncthreads();
  XcdBarrier xb;
  {
    const P lp0 = load_params();
    xb.bar = lp0.bar(); xb.x = 0; xb.st = xst;
    if (ph_hi - ph_lo > 1) xb = xcd_barrier_post(lp0.bar(), xst);
  }
  PHASE(0) PHASE(1) PHASE(2) PHASE(3) PHASE(4) PHASE(5) PHASE(6) PHASE(7) PHASE(8) PHASE(9) PHASE(10)
}

extern "C" void kernel_launch(void* const* d_in, const int* in_sizes, int n_in, void* d_out, int out_size, void* d_ws,
                              size_t ws_size, hipStream_t stream) {
  static int grid_blocks = 0;
  if (!grid_blocks) {
    int dev = 0, cus = 0, per_cu = 0;
    hipGetDevice(&dev);
    hipDeviceGetAttribute(&cus, hipDeviceAttributeMultiprocessorCount, dev);
    hipFuncSetAttribute((const void*)mega, hipFuncAttributeMaxDynamicSharedMemorySize, LDS_BYTES);
    hipOccupancyMaxActiveBlocksPerMultiprocessor(&per_cu, (const void*)mega, NTHREADS, LDS_BYTES);
    if (per_cu < 1) { fprintf(stderr, "occupancy query returned %d\n", per_cu); per_cu = 1; }
    grid_blocks = cus;
  }
  P p{};
  const float** fp = (const float**)&p;
  for (int i = 0; i < 36; ++i) fp[i] = (const float*)d_in[i];
  p.out = (float*)d_out;
  p.ws = (char*)d_ws;
  if (WS_TOTAL > ws_size) { fprintf(stderr, "workspace too small: need %zu have %zu\n", (size_t)WS_TOTAL, ws_size); return; }
#if MEGA
  if (hipMemsetAsync((char*)d_ws + OFF_bar, 0, XCD_BAR_WORDS * 4, stream) != hipSuccess) fprintf(stderr, "memset of barrier words failed\n");
  int lo = 0, hi = NPHASES;
  void* args[] = {&p, &lo, &hi};
  hipError_t e = hipLaunchCooperativeKernel((const void*)mega, dim3(grid_blocks), dim3(NTHREADS), args, LDS_BYTES, stream);
  if (e != hipSuccess) fprintf(stderr, "cooperative launch failed: %s (grid %d)\n", hipGetErrorString(e), grid_blocks);
#else
  for (int ph = 0; ph < NPHASES; ++ph) {
    hipLaunchKernelGGL(mega, dim3(grid_blocks), dim3(NTHREADS), LDS_BYTES, stream, p, ph, ph + 1);
  }
#endif
}
```
